# Optimizing an MI355X kernel written in HIP

```python
import math
import jax
import jax.numpy as jnp
from jax import lax
import numpy as np

D_MODEL = 1024
BATCH = 16
SEQ = 4096
DEPTH = 1
DEC_BATCH = 8
DEC_SEQ = 2048
PAST_LEN = 128

N_META = 16
NORM_EPS = 1e-6
SSM_WIDTH = D_MODEL // 2
SSM_GROUP = 16
SSM_GROUPS = SSM_WIDTH // SSM_GROUP
SSM_STATE = 64
SSM_DT_MIN = 1e-3
SSM_DT_MAX = 1e-1
RET_HEADS = 4
RET_QK_DIM = 128
RET_V_DIM = 2 * RET_QK_DIM
RET_QK_WIDTH = RET_HEADS * RET_QK_DIM
RET_V_WIDTH = RET_HEADS * RET_V_DIM
RET_CHUNK = 128
ROPE_BASE = 10000.0
D_FF = ((-(-8 * D_MODEL // 3) + 255) // 256) * 256
IN_SPLITS = (SSM_WIDTH, RET_QK_WIDTH, RET_QK_WIDTH, RET_V_WIDTH, RET_V_WIDTH, D_MODEL, D_MODEL)
IN_WIDTH = sum(IN_SPLITS)
IN_SPLIT_POINTS = tuple(sum(IN_SPLITS[:i + 1]) for i in range(len(IN_SPLITS) - 1))

kernel_name = "hybrid_s5_retention_encoder"


def _rmsnorm(x, g):
    xf = x.astype(jnp.float32)
    return xf * lax.rsqrt(jnp.mean(xf * xf, axis=-1, keepdims=True) + NORM_EPS) * g.astype(jnp.float32)


def _rope(x, pos):
    half = x.shape[-1] // 2
    inv = ROPE_BASE ** (-jnp.arange(half, dtype=jnp.float32) / half)
    ang = pos[:, None] * inv[None, :]
    cos = jnp.cos(ang)[None, :, None, :]
    sin = jnp.sin(ang)[None, :, None, :]
    x1, x2 = x[..., :half], x[..., half:]
    return jnp.concatenate([x1 * cos - x2 * sin, x1 * sin + x2 * cos], axis=-1)


def _cplx_scan_combine(e1, e2):
    a1r, a1i, b1r, b1i = e1
    a2r, a2i, b2r, b2i = e2
    return (a1r * a2r - a1i * a2i,
            a1r * a2i + a1i * a2r,
            a2r * b1r - a2i * b1i + b2r,
            a2r * b1i + a2i * b1r + b2i)


def _s5_branch(u, lam_re, lam_im, log_step, b_re, b_im, c_re, c_im, d_skip):
    f32 = jnp.float32
    bsz, seq_len, _ = u.shape
    ug = u.astype(f32).reshape(bsz, seq_len, SSM_GROUPS, SSM_GROUP)
    y = ug * d_skip.astype(f32).reshape(SSM_GROUPS, SSM_GROUP)
    a_shape = (1, seq_len, SSM_GROUPS, SSM_STATE)
    for direction in range(2):
        lr = lam_re[direction].astype(f32)
        li = lam_im[direction].astype(f32)
        dt = jnp.exp(log_step[direction].astype(f32))[:, None]
        mag = jnp.exp(lr * dt)
        ab_re = mag * jnp.cos(li * dt)
        ab_im = mag * jnp.sin(li * dt)
        den = lr * lr + li * li
        nr = ab_re - 1.0
        coef_re = (nr * lr + ab_im * li) / den
        coef_im = (ab_im * lr - nr * li) / den
        br = b_re[direction].astype(f32)
        bi = b_im[direction].astype(f32)
        bb_re = coef_re[..., None] * br - coef_im[..., None] * bi
        bb_im = coef_re[..., None] * bi + coef_im[..., None] * br
        bu_re = jnp.einsum('blgh,gph->blgp', ug, bb_re)
        bu_im = jnp.einsum('blgh,gph->blgp', ug, bb_im)
        a_re = jnp.broadcast_to(ab_re, a_shape)
        a_im = jnp.broadcast_to(ab_im, a_shape)
        _, _, s_re, s_im = lax.associative_scan(
            _cplx_scan_combine, (a_re, a_im, bu_re, bu_im), reverse=(direction == 1), axis=1)
        y = (y + jnp.einsum('blgp,ghp->blgh', s_re, c_re[direction].astype(f32))
             - jnp.einsum('blgp,ghp->blgh', s_im, c_im[direction].astype(f32)))
    return y.reshape(bsz, seq_len, SSM_WIDTH)


def _decay_matrix(log_gf, log_gb, n):
    i = jnp.arange(n)[:, None]
    j = jnp.arange(n)[None, :]
    df = jnp.maximum(i - j, 0).astype(jnp.float32)
    db = jnp.maximum(j - i, 0).astype(jnp.float32)
    return jnp.where(i >= j,
                     jnp.exp(log_gf[:, None, None] * df),
                     jnp.exp(log_gb[:, None, None] * db))


def _retention(q, k, v, log_gf, log_gb):
    bsz, seq_len = q.shape[:2]
    C = RET_CHUNK
    n_chunks = (seq_len - N_META) // C
    qm, km, vm = q[:, :N_META], k[:, :N_META], v[:, :N_META]

    def chunked(t):
        return t[:, N_META:].reshape(bsz, n_chunks, C, RET_HEADS, t.shape[-1])

    qr, kr, vr = chunked(q), chunked(k), chunked(v)
    s_real = jnp.einsum('bnchd,bnshd->bnhcs', qr, kr) * _decay_matrix(log_gf, log_gb, C)
    o_real = jnp.einsum('bnhcs,bnshe->bnche', s_real, vr)
    s_meta = jnp.einsum('bchd,bshd->bhcs', qm, km) * _decay_matrix(log_gf, log_gb, N_META)
    o_meta = jnp.einsum('bhcs,bshe->bche', s_meta, vm)

    pos_c = jnp.arange(C, dtype=jnp.float32)[:, None]
    pos_m = jnp.arange(N_META, dtype=jnp.float32)[:, None]
    xs = (jnp.moveaxis(qr, 1, 0), jnp.moveaxis(kr, 1, 0), jnp.moveaxis(vr, 1, 0))

    wq_f = jnp.exp(log_gf * (pos_c + 1.0))
    wk_f = jnp.exp(log_gf * (C - 1.0 - pos_c))
    carry_f = jnp.exp(log_gf * C)[None, :, None, None]
    state0 = jnp.einsum('bshd,bshe,sh->bhde', km, vm, jnp.exp(log_gf * (N_META - 1.0 - pos_m)))

    def fwd_step(state, chunk):
        qn, kn, vn = chunk
        out = jnp.einsum('bchd,bhde,ch->bche', qn, state, wq_f)
        state = carry_f * state + jnp.einsum('bshd,bshe,sh->bhde', kn, vn, wk_f)
        return state, out

    _, o_fwd = lax.scan(fwd_step, state0, xs)

    wq_b = jnp.exp(log_gb * (C - pos_c))
    wk_b = jnp.exp(log_gb * pos_c)
    carry_b = jnp.exp(log_gb * C)[None, :, None, None]

    def bwd_step(state, chunk):
        qn, kn, vn = chunk
        out = jnp.einsum('bchd,bhde,ch->bche', qn, state, wq_b)
        state = jnp.einsum('bshd,bshe,sh->bhde', kn, vn, wk_b) + carry_b * state
        return state, out

    state_meta, o_bwd = lax.scan(bwd_step, jnp.zeros_like(state0), xs, reverse=True)
    o_meta = o_meta + jnp.einsum('bchd,bhde,ch->bche', qm, state_meta,
                                 jnp.exp(log_gb * (N_META - pos_m)))
    o_real = o_real + jnp.moveaxis(o_fwd + o_bwd, 0, 1)
    return jnp.concatenate(
        [o_meta, o_real.reshape(bsz, n_chunks * C, RET_HEADS, RET_V_DIM)], axis=1)


def _encoder(x, meta_tokens, norm_mix_g, w_in, ssm_lam_re, ssm_lam_im, ssm_log_step,
             ssm_b_re, ssm_b_im, ssm_c_re, ssm_c_im, ssm_d, w_ssm_glu, ret_decay_logit,
             w_ret_out, w_out, norm_ffn_g, w_ffn_in, w_ffn_out, norm_final_g):
    f32 = jnp.float32
    bsz, seq, _ = x.shape
    seq_len = N_META + seq
    h = jnp.concatenate(
        [jnp.broadcast_to(meta_tokens.astype(f32)[None], (bsz, N_META, D_MODEL)), x.astype(f32)], axis=1)
    pos = jnp.arange(seq_len, dtype=f32)
    for layer in range(DEPTH):
        n1 = _rmsnorm(h, norm_mix_g[layer])
        proj = n1 @ w_in[layer].astype(f32)
        u, q, k, v, g_ret, gate_a, gate_b = jnp.split(proj, IN_SPLIT_POINTS, axis=-1)
        y_ssm = jax.nn.gelu(_s5_branch(u, ssm_lam_re[layer], ssm_lam_im[layer], ssm_log_step[layer],
                                       ssm_b_re[layer], ssm_b_im[layer], ssm_c_re[layer],
                                       ssm_c_im[layer], ssm_d[layer]))
        a_val, a_gate = jnp.split(y_ssm @ w_ssm_glu[layer].astype(f32), 2, axis=-1)
        branch_a = a_val * jax.nn.sigmoid(a_gate)
        q = _rope(q.reshape(bsz, seq_len, RET_HEADS, RET_QK_DIM), pos) * (RET_QK_DIM ** -0.5)
        k = _rope(k.reshape(bsz, seq_len, RET_HEADS, RET_QK_DIM), pos)
        v = v.reshape(bsz, seq_len, RET_HEADS, RET_V_DIM)
        log_g = jax.nn.log_sigmoid(ret_decay_logit[layer].astype(f32))
        o = _retention(q, k, v, log_g[0], log_g[1])
        o = o * lax.rsqrt(jnp.mean(o * o, axis=-1, keepdims=True) + NORM_EPS)
        o = o.reshape(bsz, seq_len, RET_V_WIDTH) * jax.nn.silu(g_ret)
        branch_b = o @ w_ret_out[layer].astype(f32)
        mixed = jax.nn.sigmoid(gate_a) * branch_a + jax.nn.sigmoid(gate_b) * branch_b
        h = h + mixed @ w_out[layer].astype(f32)
        n2 = _rmsnorm(h, norm_ffn_g[layer])
        ff_gate, ff_up = jnp.split(n2 @ w_ffn_in[layer].astype(f32), 2, axis=-1)
        h = h + (jax.nn.silu(ff_gate) * ff_up) @ w_ffn_out[layer].astype(f32)
    out = _rmsnorm(h, norm_final_g)
    return out[:, N_META:].astype(x.dtype)


def setup_inputs(seed: int = 0) -> dict:
    key = jax.random.key(seed)
    ks = jax.random.split(key, 24)
    f32 = jnp.float32

    def normal(k, shape):
        return jax.random.normal(k, shape, f32)

    def dense(k, fan_in, fan_out):
        return normal(k, (DEPTH, fan_in, fan_out)) * fan_in ** -0.5

    def gain(k, shape):
        return 1.0 + 0.02 * normal(k, shape)

    ssm_shape = (DEPTH, 2, SSM_GROUPS, SSM_STATE)
    b_shape = (DEPTH, 2, SSM_GROUPS, SSM_STATE, SSM_GROUP)
    c_shape = (DEPTH, 2, SSM_GROUPS, SSM_GROUP, SSM_STATE)
    n_idx = jnp.arange(SSM_STATE, dtype=f32)
    heads = jnp.arange(RET_HEADS, dtype=f32)
    decay_init = jnp.log(2.0 ** (5.0 + heads) - 1.0)
    return {
        "x_prompt": normal(ks[0], (BATCH, SEQ, D_MODEL)),
        "x_sample": normal(ks[1], (DEC_BATCH, DEC_SEQ, D_MODEL)),
        "meta_tokens": 0.5 * normal(ks[2], (N_META, D_MODEL)),
        "norm_mix_g": gain(ks[3], (DEPTH, D_MODEL)),
        "w_in": dense(ks[4], D_MODEL, IN_WIDTH),
        "ssm_lam_re": -0.5 + 0.01 * normal(ks[5], ssm_shape),
        "ssm_lam_im": jnp.pi * n_idx + 0.01 * normal(ks[6], ssm_shape),
        "ssm_log_step": jax.random.uniform(ks[7], (DEPTH, 2, SSM_GROUPS), f32,
                                           math.log(SSM_DT_MIN), math.log(SSM_DT_MAX)),
        "ssm_b_re": normal(ks[8], b_shape) * (2 * SSM_GROUP) ** -0.5,
        "ssm_b_im": normal(ks[9], b_shape) * (2 * SSM_GROUP) ** -0.5,
        "ssm_c_re": 0.5 * normal(ks[10], c_shape),
        "ssm_c_im": 0.5 * normal(ks[11], c_shape),
        "ssm_d": normal(ks[12], (DEPTH, SSM_WIDTH)),
        "w_ssm_glu": dense(ks[13], SSM_WIDTH, 2 * D_MODEL),
        "ret_decay_logit": decay_init + 0.01 * normal(ks[14], (DEPTH, 2, RET_HEADS)),
        "w_ret_out": dense(ks[15], RET_V_WIDTH, D_MODEL),
        "w_out": dense(ks[16], D_MODEL, D_MODEL),
        "norm_ffn_g": gain(ks[17], (DEPTH, D_MODEL)),
        "w_ffn_in": dense(ks[18], D_MODEL, 2 * D_FF),
        "w_ffn_out": dense(ks[19], D_FF, D_MODEL),
        "norm_final_g": gain(ks[20], (D_MODEL,)),
    }


def reference(x_prompt, x_sample, meta_tokens, norm_mix_g, w_in, ssm_lam_re, ssm_lam_im,
              ssm_log_step, ssm_b_re, ssm_b_im, ssm_c_re, ssm_c_im, ssm_d, w_ssm_glu,
              ret_decay_logit, w_ret_out, w_out, norm_ffn_g, w_ffn_in, w_ffn_out, norm_final_g):
    params = (meta_tokens, norm_mix_g, w_in, ssm_lam_re, ssm_lam_im, ssm_log_step,
              ssm_b_re, ssm_b_im, ssm_c_re, ssm_c_im, ssm_d, w_ssm_glu, ret_decay_logit,
              w_ret_out, w_out, norm_ffn_g, w_ffn_in, w_ffn_out, norm_final_g)
    y_prompt = _encoder(x_prompt, *params)
    y_sample = _encoder(x_sample, *params)
    return (y_prompt, y_sample)
```

```cpp
#include <hip/hip_runtime.h>
#include <hip/hip_cooperative_groups.h>
#include <cstdio>
#include <cstdint>
namespace cg = cooperative_groups;

#ifndef COOP_MODE
#define COOP_MODE 1
#endif

#define LAS __attribute__((address_space(3)))
typedef unsigned short bf16_t;
typedef short bf16x8 __attribute__((ext_vector_type(8)));
typedef float f32x4 __attribute__((ext_vector_type(4)));
typedef unsigned u32x4 __attribute__((ext_vector_type(4)));
typedef unsigned u32x2 __attribute__((ext_vector_type(2)));

constexpr int D = 1024, NREAL = 81920, NPR = 65536, RPAD = 82432, NVALID = 82304;
constexpr int INW = 5632, DFF = 2816;
constexpr int T5 = 32, IT_REAL = 2560, IT_PAD = 2816, LDA5 = 768;
constexpr float EPS = 1e-6f;

constexpr size_t OFF_WIN = 0;
constexpr size_t OFF_WGLU = OFF_WIN + (size_t)INW * D * 2;
constexpr size_t OFF_WRET = OFF_WGLU + (size_t)2048 * 512 * 2;
constexpr size_t OFF_WOUT = OFF_WRET + (size_t)D * D * 2;
constexpr size_t OFF_WFFI = OFF_WOUT + (size_t)D * D * 2;
constexpr size_t OFF_WFFO = OFF_WFFI + (size_t)INW * D * 2;
constexpr size_t OFF_AT = OFF_WFFO + (size_t)D * DFF * 2;
constexpr size_t OFF_Q = OFF_AT + 65536;
constexpr size_t OFF_K = OFF_Q + (size_t)RPAD * 512 * 2;
constexpr size_t OFF_V = OFF_K + (size_t)RPAD * 512 * 2;
constexpr size_t OFF_GB = OFF_V + (size_t)RPAD * D * 2;
constexpr size_t OFF_SSQ1 = OFF_GB + (size_t)NREAL * D * 2;
constexpr size_t OFF_SSQ2 = OFF_SSQ1 + (size_t)NREAL * 16 * 4;
constexpr size_t OFF_X = OFF_SSQ2 + (size_t)NREAL * 16 * 4;
constexpr size_t OFF_N1 = OFF_X;
constexpr size_t OFF_YSSM = OFF_X;
constexpr size_t OFF_U5 = OFF_N1 + (size_t)RPAD * D * 2;
constexpr size_t OFF_BTY = OFF_U5 + (size_t)32 * IT_PAD * LDA5 * 2;
constexpr size_t OFF_BTS = OFF_BTY + (size_t)32 * 512 * 768 * 2;
constexpr size_t OFF_SLOC = OFF_BTS + (size_t)32 * 256 * 512 * 2;
constexpr size_t END_X03 = OFF_SLOC + (size_t)32 * IT_PAD * 256 * 4;
constexpr size_t OFF_ST = OFF_X;
constexpr size_t END_ST = OFF_ST + (size_t)664 * 8 * 65536;
constexpr size_t OFF_ACT = OFF_X;
constexpr size_t END_ACT = OFF_ACT + (size_t)NREAL * DFF * 2;
constexpr size_t OFF_MIXED = OFF_Q;
constexpr size_t OFF_H1B = OFF_V;
constexpr size_t cmax(size_t a, size_t b) { return a > b ? a : b; }
constexpr size_t WS_NEED = cmax(END_X03, cmax(END_ST, END_ACT));

constexpr int LDS_BYTES = 131072 + 1024;
constexpr int NPHASE = 13;

struct Args {
    const float* in[21];
    float* out;
    unsigned char* ws;
    int ph_lo, ph_hi;
};

__device__ __forceinline__ unsigned cvt_pk_bf16(float lo, float hi) { unsigned r; asm volatile("v_cvt_pk_bf16_f32 %0, %1, %2" : "=v"(r) : "v"(lo), "v"(hi)); return r; }
__device__ __forceinline__ bf16_t f2bf(float f) { return (bf16_t)(cvt_pk_bf16(f, 0.f) & 0xFFFFu); }
__device__ __forceinline__ float bflo(unsigned w) { return __uint_as_float(w << 16); }
__device__ __forceinline__ float bfhi(unsigned w) { return __uint_as_float(w & 0xFFFF0000u); }
__device__ __forceinline__ float sigmoidf_(float x) { return __fdividef(1.0f, 1.0f + __expf(-x)); }
__device__ __forceinline__ float siluf_(float x) { return x * sigmoidf_(x); }
__device__ __forceinline__ float gelu_tanh(float x) { const float z = 0.7978845608028654f * (x + 0.044715f * x * x * x); return x * sigmoidf_(2.0f * z); }
__device__ __forceinline__ float logsigf_(float x) { return fminf(x, 0.f) - log1pf(__expf(-fabsf(x))); }
__device__ __forceinline__ float wave_sum(float v) {
#pragma unroll
    for (int o = 1; o < 64; o <<= 1) v += __shfl_xor(v, o);
    return v;
}
__device__ __forceinline__ void sincos_rev(double ang, float& s, float& c) {
    double x = ang * 0.15915494309189535; x -= rint(x);
    const float xf = (float)x;
    s = __builtin_amdgcn_sinf(xf); c = __builtin_amdgcn_cosf(xf);
}

namespace pg8 {
constexpr int BM = 256, BK = 64, HALF = 128, HTB = HALF * BK * 2, STAGE_BYTES = 8 * HTB, NXCD = 8, WGM = 8;
__device__ __forceinline__ int lds_byte(int r, int c) { const int st = (r >> 4) * 2 + (c >> 5), rr = r & 15, cc = c & 31, ob = rr * 64 + cc * 2; return st * 1024 + (ob ^ (((ob >> 9) & 1) << 5)); }
__device__ __forceinline__ void stage_rc(int b, int& R, int& C) { const int st = b / 1024, sb = b % 1024, swz = sb ^ (((sb >> 9) & 1) << 5); R = (st >> 1) * 16 + swz / 64; C = (st & 1) * 32 + (swz % 64) / 2; }
__device__ __forceinline__ int perm32(int rho) { const int n = rho >> 4, i = rho & 15; return 8 * (i >> 2) + 4 * n + (i & 3); }

struct Unit { int pm, pn, g; };
struct Gemm { const bf16_t* A; const bf16_t* Bt; int lda, ldb, K, nM, nN, nb; size_t sA, sB; };

struct Order {
    int nM, nN, nwg, total, G, c;
    __device__ void init(int nM_, int nN_, int nb, int G_, int c_) { nM = nM_; nN = nN_; nwg = nM * nN; total = nwg * nb; G = G_; c = c_; }
    __device__ bool next(int i, Unit& u) const {
        const long L = (long)i * G + c; if (L >= total) return false;
        u.g = (int)(L / nwg); int wgid = (int)(L % nwg);
        { const int q = nwg / NXCD, r = nwg % NXCD, xcd = wgid % NXCD, off = wgid / NXCD; wgid = (xcd < r ? xcd * (q + 1) : r * (q + 1) + (xcd - r) * q) + off; }
        const int nig = WGM * nN, gid = wgid / nig, fm = gid * WGM, gsz = (nM - fm) < WGM ? (nM - fm) : WGM;
        u.pm = fm + ((wgid % nig) % gsz); u.pn = (wgid % nig) / gsz; return true;
    }
};

template <class Epi>
__device__ __forceinline__ void gemm_phase(LAS unsigned char* lds, const Gemm g, const Epi& E) {
    const int tid = threadIdx.x, wid = __builtin_amdgcn_readfirstlane(tid >> 6), lane = tid & 63, wr = wid >> 2, wc = wid & 3, fr = lane & 15, fq = lane >> 4;
    const int K = g.K, nt = K / BK;
    Order S; S.init(g.nM, g.nN, g.nb, (int)gridDim.x, (int)blockIdx.x);
    unsigned voffA[2], voffB[2];
#pragma unroll
    for (int i = 0; i < 2; ++i) { int R, C; stage_rc(tid * 16 + i * 8192, R, C); const int Rb = (R & ~31) + perm32(R & 31);
        voffA[i] = (unsigned)(R * g.lda + C) * 2u; voffB[i] = (unsigned)(Rb * g.ldb + C) * 2u; }
    const size_t kstep = (size_t)(BK * 2);
    const size_t hstepA = (size_t)HALF * g.lda * 2, hstepB = (size_t)HALF * g.ldb * 2;
    const size_t tstepA = 2 * hstepA, tstepB = 2 * hstepB;
    const unsigned ldsw = (unsigned)wid * 1024u;
    const int aoff = lds_byte(wr * 64 + fr, fq * 8), boff = lds_byte(wc * 32 + fr, fq * 8);
#define PG8_SA(b, h) (((b) * 2 + (h)) * HTB)
#define PG8_SB(b, h) ((4 + (b) * 2 + (h)) * HTB)
#define PG8_STAGE(bufoff, gbase, voff) do { _Pragma("unroll") for (int _i = 0; _i < 2; ++_i) \
        __builtin_amdgcn_global_load_lds((const unsigned*)((const char*)(gbase) + (voff)[_i]), (LAS unsigned*)(lds + (bufoff) + ldsw + _i * 8192), 16, 0, 0); } while (0)
#define PG8_LDA(dst, b, h) do { _Pragma("unroll") for (int m = 0; m < 4; ++m) _Pragma("unroll") for (int k = 0; k < 2; ++k) dst[m][k] = *(const LAS bf16x8*)(lds + PG8_SA(b, h) + aoff + m * 2048 + k * 1024); } while (0)
#define PG8_LDB(dst, b, h) do { _Pragma("unroll") for (int n = 0; n < 2; ++n) _Pragma("unroll") for (int k = 0; k < 2; ++k) dst[n][k] = *(const LAS bf16x8*)(lds + PG8_SB(b, h) + boff + n * 2048 + k * 1024); } while (0)
#define PG8_MMA(ai, bj, At, Bt) do { __builtin_amdgcn_s_setprio(1); _Pragma("unroll") for (int m = 0; m < 4; ++m) _Pragma("unroll") for (int n = 0; n < 2; ++n) _Pragma("unroll") for (int k = 0; k < 2; ++k) \
        acc[ai][bj][m][n] = __builtin_amdgcn_mfma_f32_16x16x32_bf16(Bt[n][k], At[m][k], acc[ai][bj][m][n], 0, 0, 0); __builtin_amdgcn_s_setprio(0); } while (0)
#define PG8_WAIT_V(n) asm volatile("s_waitcnt vmcnt(" #n ")" ::: "memory")
#define PG8_WAIT_L(n) asm volatile("s_waitcnt lgkmcnt(" #n ")" ::: "memory")
#define PG8_BAR __builtin_amdgcn_s_barrier()
#define PG8_SCHED __builtin_amdgcn_sched_barrier(0)
    Unit cur, nxt; int ui = 0;
    if (!S.next(0, cur)) return;
    f32x4 acc[2][2][4][2];
#pragma unroll
    for (int a = 0; a < 2; ++a)
#pragma unroll
        for (int b = 0; b < 2; ++b)
#pragma unroll
            for (int m = 0; m < 4; ++m)
#pragma unroll
                for (int n = 0; n < 2; ++n) acc[a][b][m][n] = (f32x4){0.f, 0.f, 0.f, 0.f};
    bf16x8 At[4][2], B0[2][2], B1[2][2];
    const char* cA = (const char*)g.A + ((size_t)cur.g * g.sA) * 2 + (size_t)cur.pm * tstepA;
    const char* cB = (const char*)g.Bt + ((size_t)cur.g * g.sB) * 2 + (size_t)cur.pn * tstepB;
    PG8_STAGE(PG8_SB(0, 0), cB, voffB); PG8_STAGE(PG8_SA(0, 0), cA, voffA); PG8_STAGE(PG8_SB(0, 1), cB + hstepB, voffB); PG8_STAGE(PG8_SA(0, 1), cA + hstepA, voffA);
    if (wr == 1) PG8_BAR;
    PG8_WAIT_V(4); PG8_BAR;
    PG8_STAGE(PG8_SB(1, 0), cB + kstep, voffB); PG8_STAGE(PG8_SA(1, 0), cA + kstep, voffA); PG8_STAGE(PG8_SB(1, 1), cB + hstepB + kstep, voffB);
    PG8_WAIT_V(6); PG8_BAR;
    for (;;) {
        const bool has_next = S.next(ui + 1, nxt);
        const char* nA = has_next ? (const char*)g.A + ((size_t)nxt.g * g.sA) * 2 + (size_t)nxt.pm * tstepA : cA;
        const char* nB = has_next ? (const char*)g.Bt + ((size_t)nxt.g * g.sB) * 2 + (size_t)nxt.pn * tstepB : cB;
        for (int t = 0; t < nt; t += 2) {
            const bool last = (t == nt - 2);
            const char* a1 = cA + (size_t)(t + 1) * kstep;
            const char* a2 = last ? nA : cA + (size_t)(t + 2) * kstep; const char* b2 = last ? nB : cB + (size_t)(t + 2) * kstep;
            const char* a3 = a2 + kstep; const char* b3 = b2 + kstep;
            PG8_LDB(B0, 0, 0); PG8_SCHED; PG8_LDA(At, 0, 0); PG8_STAGE(PG8_SA(1, 1), a1 + hstepA, voffA);
            PG8_WAIT_L(8); PG8_BAR; PG8_WAIT_L(0); PG8_MMA(0, 0, At, B0); PG8_BAR; PG8_SCHED;
            PG8_LDB(B1, 0, 1); PG8_STAGE(PG8_SB(0, 0), b2, voffB);
            PG8_BAR; PG8_WAIT_L(0); PG8_MMA(0, 1, At, B1); PG8_BAR;
            PG8_LDA(At, 0, 1); PG8_STAGE(PG8_SA(0, 0), a2, voffA);
            PG8_BAR; PG8_WAIT_L(0); PG8_MMA(1, 0, At, B0); PG8_BAR; PG8_SCHED;
            PG8_STAGE(PG8_SB(0, 1), b2 + hstepB, voffB);
            PG8_WAIT_V(6); PG8_BAR; PG8_MMA(1, 1, At, B1); PG8_BAR;
            PG8_LDB(B0, 1, 0); PG8_SCHED; PG8_LDA(At, 1, 0); PG8_STAGE(PG8_SA(0, 1), a2 + hstepA, voffA);
            PG8_WAIT_L(8); PG8_BAR; PG8_WAIT_L(0); PG8_MMA(0, 0, At, B0); PG8_BAR; PG8_SCHED;
            PG8_LDB(B1, 1, 1); PG8_STAGE(PG8_SB(1, 0), b3, voffB);
            PG8_BAR; PG8_WAIT_L(0); PG8_MMA(0, 1, At, B1); PG8_BAR;
            PG8_LDA(At, 1, 1); PG8_STAGE(PG8_SA(1, 0), a3, voffA);
            PG8_BAR; PG8_WAIT_L(0); PG8_MMA(1, 0, At, B0); PG8_BAR; PG8_SCHED;
            PG8_STAGE(PG8_SB(1, 1), b3 + hstepB, voffB);
            PG8_WAIT_V(6); PG8_BAR; PG8_MMA(1, 1, At, B1); PG8_BAR;
        }
        E(acc, cur, wr, wc, fr, fq);
        if (!has_next) break;
#pragma unroll
        for (int a = 0; a < 2; ++a)
#pragma unroll
            for (int b = 0; b < 2; ++b)
#pragma unroll
                for (int m = 0; m < 4; ++m)
#pragma unroll
                    for (int n = 0; n < 2; ++n) acc[a][b][m][n] = (f32x4){0.f, 0.f, 0.f, 0.f};
        cur = nxt; cA = nA; cB = nB; ++ui;
    }
    PG8_WAIT_V(0);
    if (wr == 0) PG8_BAR;
    PG8_BAR;
#undef PG8_SA
#undef PG8_SB
#undef PG8_STAGE
#undef PG8_LDA
#undef PG8_LDB
#undef PG8_MMA
#undef PG8_WAIT_V
#undef PG8_WAIT_L
#undef PG8_BAR
#undef PG8_SCHED
}
}
using pg8::Unit;
typedef const f32x4 (&AccRef)[2][2][4][2];

__device__ __forceinline__ u32x4 pack8(f32x4 a, f32x4 b) { u32x4 w; w.x = cvt_pk_bf16(a[0], a[1]); w.y = cvt_pk_bf16(a[2], a[3]); w.z = cvt_pk_bf16(b[0], b[1]); w.w = cvt_pk_bf16(b[2], b[3]); return w; }

struct EpiProj {
    bf16_t *u5, *q, *k, *v, *sg, *ga, *gb; const LAS double* ropef;
    __device__ __forceinline__ void operator()(AccRef acc, const Unit& u, int wr, int wc, int fr, int fq) const {
        const int pn = u.pn;
#pragma unroll
        for (int ai = 0; ai < 2; ++ai)
#pragma unroll
            for (int m = 0; m < 4; ++m) {
                const int row = u.pm * 256 + ai * 128 + wr * 64 + m * 16 + fr;
#pragma unroll
                for (int bj = 0; bj < 2; ++bj) {
                    const int col = pn * 256 + bj * 128 + wc * 32 + 8 * fq;
                    f32x4 v0 = acc[ai][bj][m][0], v1 = acc[ai][bj][m][1];
                    if (pn < 2) {
                        if (row < NVALID) {
                            int item, t;
                            if (row < NREAL) { item = row >> 5; t = row & 31; } else { const int mr = row - NREAL; item = IT_REAL + (mr >> 4); t = 16 + (mr & 15); }
                            const int g = col >> 4, h0 = col & 15;
                            *(u32x4*)(u5 + ((size_t)(g * IT_PAD + item) * LDA5 + t * 16 + h0)) = pack8(v0, v1);
                        }
                    } else if (pn < 6) {
                        const int cq = col - 512, isk = cq >> 9, cc = cq & 511, i0 = (cc & 127) >> 1;
                        const int pos = row < NPR ? 16 + (row & 4095) : (row < NREAL ? 16 + ((row - NPR) & 2047) : ((row - NREAL) & 15));
                        const float sc = isk ? 1.0f : 0.08838834764831845f;
                        float o[8];
#pragma unroll
                        for (int pi = 0; pi < 4; ++pi) {
                            float s, c; sincos_rev((double)pos * ropef[i0 + pi], s, c);
                            const float x1 = pi < 2 ? v0[2 * pi] : v1[2 * pi - 4], x2 = pi < 2 ? v0[2 * pi + 1] : v1[2 * pi - 3];
                            o[2 * pi] = (x1 * c - x2 * s) * sc; o[2 * pi + 1] = (x1 * s + x2 * c) * sc;
                        }
                        u32x4 w; w.x = cvt_pk_bf16(o[0], o[1]); w.y = cvt_pk_bf16(o[2], o[3]); w.z = cvt_pk_bf16(o[4], o[5]); w.w = cvt_pk_bf16(o[6], o[7]);
                        *(u32x4*)((isk ? k : q) + (size_t)row * 512 + cc) = w;
                    } else if (pn < 10) {
                        *(u32x4*)(v + (size_t)row * 1024 + (col - 1536)) = pack8(v0, v1);
                    } else if (row < NREAL) {
                        if (pn < 14) {
#pragma unroll
                            for (int j = 0; j < 4; ++j) { v0[j] = siluf_(v0[j]); v1[j] = siluf_(v1[j]); }
                            *(u32x4*)(sg + (size_t)row * 1024 + (col - 2560)) = pack8(v0, v1);
                        } else {
#pragma unroll
                            for (int j = 0; j < 4; ++j) { v0[j] = sigmoidf_(v0[j]); v1[j] = sigmoidf_(v1[j]); }
                            if (pn < 18) *(u32x4*)(ga + (size_t)row * 1024 + (col - 3584)) = pack8(v0, v1);
                            else *(u32x4*)(gb + (size_t)row * 1024 + (col - 4608)) = pack8(v0, v1);
                        }
                    }
                }
            }
    }
};

struct EpiSloc {
    float* sloc;
    __device__ __forceinline__ void operator()(AccRef acc, const Unit& u, int wr, int wc, int fr, int fq) const {
#pragma unroll
        for (int ai = 0; ai < 2; ++ai)
#pragma unroll
            for (int m = 0; m < 4; ++m) {
                const int row = u.pm * 256 + ai * 128 + wr * 64 + m * 16 + fr;
#pragma unroll
                for (int bj = 0; bj < 2; ++bj) {
                    const int col = bj * 128 + wc * 32 + 8 * fq;
                    float* p = sloc + ((size_t)u.g * IT_PAD + row) * 256 + col;
                    *(f32x4*)p = acc[ai][bj][m][0]; *(f32x4*)(p + 4) = acc[ai][bj][m][1];
                }
            }
    }
};

struct EpiY {
    bf16_t* y;
    __device__ __forceinline__ void operator()(AccRef acc, const Unit& u, int wr, int wc, int fr, int fq) const {
#pragma unroll
        for (int ai = 0; ai < 2; ++ai)
#pragma unroll
            for (int m = 0; m < 4; ++m) {
                const int item = u.pm * 256 + ai * 128 + wr * 64 + m * 16 + fr;
                if (item < IT_REAL) {
#pragma unroll
                    for (int bj = 0; bj < 2; ++bj) {
                        const int col = u.pn * 256 + bj * 128 + wc * 32 + 8 * fq, to = col >> 4, ho = col & 15;
                        f32x4 v0 = acc[ai][bj][m][0], v1 = acc[ai][bj][m][1];
#pragma unroll
                        for (int j = 0; j < 4; ++j) { v0[j] = gelu_tanh(v0[j]); v1[j] = gelu_tanh(v1[j]); }
                        *(u32x4*)(y + (size_t)(item * 32 + to) * 512 + u.g * 16 + ho) = pack8(v0, v1);
                    }
                }
            }
    }
};

struct EpiGlu {
    bf16_t* ga;
    __device__ __forceinline__ void operator()(AccRef acc, const Unit& u, int wr, int wc, int fr, int fq) const {
#pragma unroll
        for (int ai = 0; ai < 2; ++ai)
#pragma unroll
            for (int m = 0; m < 4; ++m) {
                const int row = u.pm * 256 + ai * 128 + wr * 64 + m * 16 + fr;
                bf16_t* p = ga + (size_t)row * 1024 + u.pn * 128 + wc * 32 + 8 * fq;
                const u32x4 gw = *(const u32x4*)p;
                const f32x4 a0 = acc[ai][0][m][0], a1 = acc[ai][0][m][1], g0 = acc[ai][1][m][0], g1 = acc[ai][1][m][1];
                f32x4 r0, r1;
                r0[0] = bflo(gw.x) * a0[0] * sigmoidf_(g0[0]); r0[1] = bfhi(gw.x) * a0[1] * sigmoidf_(g0[1]);
                r0[2] = bflo(gw.y) * a0[2] * sigmoidf_(g0[2]); r0[3] = bfhi(gw.y) * a0[3] * sigmoidf_(g0[3]);
                r1[0] = bflo(gw.z) * a1[0] * sigmoidf_(g1[0]); r1[1] = bfhi(gw.z) * a1[1] * sigmoidf_(g1[1]);
                r1[2] = bflo(gw.w) * a1[2] * sigmoidf_(g1[2]); r1[3] = bfhi(gw.w) * a1[3] * sigmoidf_(g1[3]);
                *(u32x4*)p = pack8(r0, r1);
            }
    }
};

struct EpiRet {
    const bf16_t *pa, *gb; bf16_t* mixed;
    __device__ __forceinline__ void operator()(AccRef acc, const Unit& u, int wr, int wc, int fr, int fq) const {
#pragma unroll
        for (int ai = 0; ai < 2; ++ai)
#pragma unroll
            for (int m = 0; m < 4; ++m) {
                const int row = u.pm * 256 + ai * 128 + wr * 64 + m * 16 + fr;
#pragma unroll
                for (int bj = 0; bj < 2; ++bj) {
                    const size_t o = (size_t)row * 1024 + u.pn * 256 + bj * 128 + wc * 32 + 8 * fq;
                    const u32x4 pw = *(const u32x4*)(pa + o), gw = *(const u32x4*)(gb + o);
                    const f32x4 a0 = acc[ai][bj][m][0], a1 = acc[ai][bj][m][1];
                    f32x4 r0, r1;
                    r0[0] = bflo(pw.x) + bflo(gw.x) * a0[0]; r0[1] = bfhi(pw.x) + bfhi(gw.x) * a0[1];
                    r0[2] = bflo(pw.y) + bflo(gw.y) * a0[2]; r0[3] = bfhi(pw.y) + bfhi(gw.y) * a0[3];
                    r1[0] = bflo(pw.z) + bflo(gw.z) * a1[0]; r1[1] = bfhi(pw.z) + bfhi(gw.z) * a1[1];
                    r1[2] = bflo(pw.w) + bflo(gw.w) * a1[2]; r1[3] = bfhi(pw.w) + bfhi(gw.w) * a1[3];
                    *(u32x4*)(mixed + o) = pack8(r0, r1);
                }
            }
    }
};

template <int MODE>
struct EpiRes {
    const float *xp, *xs; float* out; bf16_t* hb; float* ssq;
    __device__ __forceinline__ void operator()(AccRef acc, const Unit& u, int wr, int wc, int fr, int fq) const {
#pragma unroll
        for (int ai = 0; ai < 2; ++ai)
#pragma unroll
            for (int m = 0; m < 4; ++m) {
                const int row = u.pm * 256 + ai * 128 + wr * 64 + m * 16 + fr;
                float ss = 0.f;
#pragma unroll
                for (int bj = 0; bj < 2; ++bj) {
                    const int col = u.pn * 256 + bj * 128 + wc * 32 + 8 * fq;
                    const float* src = MODE == 0 ? (row < NPR ? xp + (size_t)row * 1024 : xs + (size_t)(row - NPR) * 1024) + col : out + (size_t)row * 1024 + col;
                    f32x4 h0 = *(const f32x4*)src + acc[ai][bj][m][0], h1 = *(const f32x4*)(src + 4) + acc[ai][bj][m][1];
                    float* dst = out + (size_t)row * 1024 + col;
                    *(f32x4*)dst = h0; *(f32x4*)(dst + 4) = h1;
                    if (MODE == 0) *(u32x4*)(hb + (size_t)row * 1024 + col) = pack8(h0, h1);
                    ss += (h0[0] * h0[0] + h0[1] * h0[1]) + (h0[2] * h0[2] + h0[3] * h0[3]) + (h1[0] * h1[0] + h1[1] * h1[1]) + (h1[2] * h1[2] + h1[3] * h1[3]);
                }
                ss += __shfl_xor(ss, 16); ss += __shfl_xor(ss, 32);
                if (fq == 0) ssq[(size_t)row * 16 + u.pn * 4 + wc] = ss;
            }
    }
};

struct EpiFfi {
    const float* ssq; bf16_t* act;
    __device__ __forceinline__ void operator()(AccRef acc, const Unit& u, int wr, int wc, int fr, int fq) const {
#pragma unroll
        for (int ai = 0; ai < 2; ++ai)
#pragma unroll
            for (int m = 0; m < 4; ++m) {
                const int row = u.pm * 256 + ai * 128 + wr * 64 + m * 16 + fr;
                const f32x4* sp = (const f32x4*)(ssq + (size_t)row * 16);
                const f32x4 s0 = sp[0], s1 = sp[1], s2 = sp[2], s3 = sp[3];
                const float tot = ((s0[0] + s0[1]) + (s0[2] + s0[3])) + ((s1[0] + s1[1]) + (s1[2] + s1[3])) + ((s2[0] + s2[1]) + (s2[2] + s2[3])) + ((s3[0] + s3[1]) + (s3[2] + s3[3]));
                const float rstd = rsqrtf(tot * (1.0f / 1024.0f) + EPS);
                const f32x4 g0 = acc[ai][0][m][0], g1 = acc[ai][0][m][1], u0 = acc[ai][1][m][0], u1 = acc[ai][1][m][1];
                f32x4 r0, r1;
#pragma unroll
                for (int j = 0; j < 4; ++j) { r0[j] = siluf_(rstd * g0[j]) * (rstd * u0[j]); r1[j] = siluf_(rstd * g1[j]) * (rstd * u1[j]); }
                *(u32x4*)(act + (size_t)row * DFF + u.pn * 128 + wc * 32 + 8 * fq) = pack8(r0, r1);
            }
    }
};

__device__ __forceinline__ void p0_s5gen(const Args& a, LAS float* L, int g) {
    const int tid = threadIdx.x;
    LAS float* Kt = L;
    LAS float* Ap = L + 16384;
    LAS float* Bb = Ap + 33 * 64 * 2;
    LAS float* Cc = Bb + 2048;
    bf16_t* bts = (bf16_t*)(a.ws + OFF_BTS) + (size_t)g * 256 * 512;
    bf16_t* bty = (bf16_t*)(a.ws + OFF_BTY) + (size_t)g * 512 * 768;
    float* attab = (float*)(a.ws + OFF_AT);
    bf16_t* u5 = (bf16_t*)(a.ws + OFF_U5);
    for (int e = tid; e < 24 * 256; e += 512) { const int b = e >> 8, kk = e & 255; u5[((size_t)g * IT_PAD + IT_REAL + b) * LDA5 + kk] = 0; }
    for (int dir = 0; dir < 2; ++dir) {
        const int pg = dir * 32 + g;
        const double dt = exp((double)a.in[7][pg]);
        for (int idx = tid; idx < 33 * 64; idx += 512) {
            const int p = idx & 63, d = idx >> 6;
            const double lr = a.in[5][pg * 64 + p], li = a.in[6][pg * 64 + p];
            const float mag = (float)exp(lr * dt * d);
            float s, c; sincos_rev(li * dt * d, s, c);
            Ap[idx * 2] = mag * c; Ap[idx * 2 + 1] = mag * s;
            if (d == 32) { attab[(pg * 64 + p) * 2] = mag * c; attab[(pg * 64 + p) * 2 + 1] = mag * s; }
        }
        for (int idx = tid; idx < 1024; idx += 512) {
            const int p = idx >> 4, h = idx & 15;
            const double lr = a.in[5][pg * 64 + p], li = a.in[6][pg * 64 + p];
            const double zr = lr * dt, zi = li * dt, mag = exp(zr);
            float sh, ch, s1, c1; sincos_rev(0.5 * zi, sh, ch); sincos_rev(zi, s1, c1);
            const double nr = mag * (-2.0 * (double)sh * (double)sh) + expm1(zr);
            const double abi = mag * (double)s1, den = lr * lr + li * li;
            const double cre = (nr * lr + abi * li) / den, cim = (abi * lr - nr * li) / den;
            const double br = a.in[8][(size_t)(pg * 64 + p) * 16 + h], bi = a.in[9][(size_t)(pg * 64 + p) * 16 + h];
            Bb[idx * 2] = (float)(cre * br - cim * bi); Bb[idx * 2 + 1] = (float)(cre * bi + cim * br);
        }
        for (int idx = tid; idx < 1024; idx += 512) {
            Cc[idx * 2] = a.in[10][(size_t)pg * 1024 + idx]; Cc[idx * 2 + 1] = a.in[11][(size_t)pg * 1024 + idx];
        }
        __syncthreads();
        for (int e = tid; e < 8192; e += 512) {
            const int d = e >> 8, ho = (e >> 4) & 15, hi = e & 15;
            float sum = 0.f;
            for (int p = 0; p < 64; ++p) {
                const float cr = Cc[(ho * 64 + p) * 2], ci = Cc[(ho * 64 + p) * 2 + 1], ar = Ap[(d * 64 + p) * 2], ai = Ap[(d * 64 + p) * 2 + 1];
                const float br = Bb[(p * 16 + hi) * 2], bi = Bb[(p * 16 + hi) * 2 + 1];
                const float car = cr * ar - ci * ai, cai = cr * ai + ci * ar;
                sum += car * br - cai * bi;
            }
            Kt[dir * 8192 + e] = sum;
        }
        for (int e = tid; e < 65536; e += 512) {
            const int k = e & 511, nn = e >> 9, c = nn >> 6, p = nn & 63, t = k >> 4, hi = k & 15;
            const int dd = dir == 0 ? (T5 - 1 - t) : t;
            const float ar = Ap[(dd * 64 + p) * 2], ai = Ap[(dd * 64 + p) * 2 + 1], br = Bb[(p * 16 + hi) * 2], bi = Bb[(p * 16 + hi) * 2 + 1];
            const float val = c ? (ar * bi + ai * br) : (ar * br - ai * bi);
            bts[(size_t)(dir * 128 + nn) * 512 + k] = f2bf(val);
        }
        for (int e = tid; e < 65536; e += 512) {
            const int kk = e & 127, n = e >> 7, c = kk >> 6, p = kk & 63, to = n >> 4, ho = n & 15;
            const int dd = dir == 0 ? (to + 1) : (T5 - to);
            const float cr = Cc[(ho * 64 + p) * 2], ci = Cc[(ho * 64 + p) * 2 + 1], ar = Ap[(dd * 64 + p) * 2], ai = Ap[(dd * 64 + p) * 2 + 1];
            const float val = c ? -(cr * ai + ci * ar) : (cr * ar - ci * ai);
            bty[(size_t)n * 768 + 512 + dir * 128 + kk] = f2bf(val);
        }
        __syncthreads();
    }
    for (int e = tid; e < 262144; e += 512) {
        const int k = e & 511, n = e >> 9, to = n >> 4, ho = n & 15, ti = k >> 4, hi = k & 15;
        float val = 0.f;
        if (to >= ti) val += Kt[((to - ti) * 16 + ho) * 16 + hi];
        if (ti >= to) val += Kt[8192 + ((ti - to) * 16 + ho) * 16 + hi];
        if (to == ti && ho == hi) val += a.in[12][g * 16 + ho];
        bty[(size_t)n * 768 + k] = f2bf(val);
    }
    __syncthreads();
}

__device__ __forceinline__ int src_col(int kind, int n) {
    if (kind == 1) { if (n >= 512 && n < 1536) { const int r = n - 512, seg = r >> 7, dp = r & 127; return 512 + seg * 128 + (dp >> 1) + 64 * (dp & 1); } return n; }
    if (kind == 2) { const int pn = n >> 8, bj = (n >> 7) & 1, cc = n & 127; return bj * 1024 + pn * 128 + cc; }
    if (kind == 3) { const int pn = n >> 8, bj = (n >> 7) & 1, cc = n & 127; return bj * DFF + pn * 128 + cc; }
    return n;
}
__device__ __forceinline__ void p0_wtile(const float* W, int K, int N, bf16_t* WT, int kind, const float* kscale, int tile, LAS float* L) {
    const int tid = threadIdx.x, nkt = K >> 6, nt_ = tile / nkt, kt = tile % nkt, n0 = nt_ * 64, k0 = kt * 64;
#pragma unroll
    for (int it = 0; it < 8; ++it) {
        const int idx = tid + it * 512, kk = idx >> 6, j = idx & 63;
        float v = W[(size_t)(k0 + kk) * N + src_col(kind, n0 + j)];
        if (kscale) v *= kscale[k0 + kk];
        L[kk * 65 + j] = v;
    }
    __syncthreads();
#pragma unroll
    for (int it = 0; it < 4; ++it) {
        const int idx = tid + it * 512, j = idx >> 5, kp = idx & 31;
        *(unsigned*)(WT + (size_t)(n0 + j) * K + k0 + 2 * kp) = cvt_pk_bf16(L[(2 * kp) * 65 + j], L[(2 * kp + 1) * 65 + j]);
    }
    __syncthreads();
}

__device__ __forceinline__ void phase0(const Args& a, LAS unsigned char* lds) {
    LAS float* L = (LAS float*)lds;
    const int tid = threadIdx.x, wave = tid >> 6, lane = tid & 63;
    constexpr int T_IN = 88 * 16, T_GLU = 32 * 8, T_RET = 256, T_OUT = 256, T_FFI = 88 * 16, T_FFO = 16 * 44;
    constexpr int NW = 32 + T_IN + T_GLU + T_RET + T_OUT + T_FFI + T_FFO, NRM = RPAD / 8;
    for (int w = blockIdx.x; w < NW + NRM; w += gridDim.x) {
        int r = w;
        if (r < 32) { p0_s5gen(a, L, r); continue; } r -= 32;
        if (r < T_IN) { p0_wtile(a.in[4], 1024, INW, (bf16_t*)(a.ws + OFF_WIN), 1, nullptr, r, L); continue; } r -= T_IN;
        if (r < T_GLU) { p0_wtile(a.in[13], 512, 2048, (bf16_t*)(a.ws + OFF_WGLU), 2, nullptr, r, L); continue; } r -= T_GLU;
        if (r < T_RET) { p0_wtile(a.in[15], 1024, 1024, (bf16_t*)(a.ws + OFF_WRET), 0, nullptr, r, L); continue; } r -= T_RET;
        if (r < T_OUT) { p0_wtile(a.in[16], 1024, 1024, (bf16_t*)(a.ws + OFF_WOUT), 0, nullptr, r, L); continue; } r -= T_OUT;
        if (r < T_FFI) { p0_wtile(a.in[18], 1024, INW, (bf16_t*)(a.ws + OFF_WFFI), 3, a.in[17], r, L); continue; } r -= T_FFI;
        if (r < T_FFO) { p0_wtile(a.in[19], DFF, 1024, (bf16_t*)(a.ws + OFF_WFFO), 0, nullptr, r, L); continue; } r -= T_FFO;
        const int row = r * 8 + wave;
        bf16_t* orow = (bf16_t*)(a.ws + OFF_N1) + (size_t)row * 1024;
        if (row >= NVALID) {
#pragma unroll
            for (int j = 0; j < 4; ++j) *(u32x2*)(orow + (j * 64 + lane) * 4) = (u32x2){0u, 0u};
        } else {
            const float* xr = row < NPR ? a.in[0] + (size_t)row * 1024 : (row < NREAL ? a.in[1] + (size_t)(row - NPR) * 1024 : a.in[2] + (size_t)((row - NREAL) & 15) * 1024);
            f32x4 v[4]; float s = 0.f;
#pragma unroll
            for (int j = 0; j < 4; ++j) { v[j] = *(const f32x4*)(xr + (j * 64 + lane) * 4); s += (v[j][0] * v[j][0] + v[j][1] * v[j][1]) + (v[j][2] * v[j][2] + v[j][3] * v[j][3]); }
            const float rstd = rsqrtf(wave_sum(s) * (1.0f / 1024.0f) + EPS);
#pragma unroll
            for (int j = 0; j < 4; ++j) {
                const f32x4 gg = *(const f32x4*)(a.in[3] + (j * 64 + lane) * 4);
                u32x2 o; o.x = cvt_pk_bf16(v[j][0] * rstd * gg[0], v[j][1] * rstd * gg[1]); o.y = cvt_pk_bf16(v[j][2] * rstd * gg[2], v[j][3] * rstd * gg[3]);
                *(u32x2*)(orow + (j * 64 + lane) * 4) = o;
            }
        }
    }
}

__device__ __forceinline__ void s5_scan(const Args& a) {
    const float* attab = (const float*)(a.ws + OFF_AT);
    const float* sloc = (const float*)(a.ws + OFF_SLOC);
    bf16_t* u5 = (bf16_t*)(a.ws + OFF_U5);
    for (int id = blockIdx.x * 512 + threadIdx.x; id < 24 * 32 * 2 * 64; id += gridDim.x * 512) {
        const int p = id & 63, dir = (id >> 6) & 1, g = (id >> 7) & 31, b = id >> 12;
        const float atr = attab[((dir * 32 + g) * 64 + p) * 2], ati = attab[((dir * 32 + g) * 64 + p) * 2 + 1];
        const int nck = b < 16 ? 128 : 64, base = b < 16 ? b * 128 : 2048 + (b - 16) * 64, mitem = IT_REAL + b;
        const float* sl = sloc + (size_t)g * IT_PAD * 256 + dir * 128 + p;
        bf16_t* ub = u5 + (size_t)g * IT_PAD * LDA5 + 512 + dir * 128 + p;
        float sr = 0.f, si = 0.f;
        if (dir == 0) {
            ub[(size_t)mitem * LDA5] = 0; ub[(size_t)mitem * LDA5 + 64] = 0;
            sr = sl[(size_t)mitem * 256]; si = sl[(size_t)mitem * 256 + 64];
            for (int c0 = 0; c0 < nck; c0 += 8) {
                float lr[8], li[8];
#pragma unroll
                for (int j = 0; j < 8; ++j) { lr[j] = sl[(size_t)(base + c0 + j) * 256]; li[j] = sl[(size_t)(base + c0 + j) * 256 + 64]; }
#pragma unroll
                for (int j = 0; j < 8; ++j) {
                    const size_t it = (size_t)(base + c0 + j);
                    ub[it * LDA5] = f2bf(sr); ub[it * LDA5 + 64] = f2bf(si);
                    const float nr = atr * sr - ati * si + lr[j], ni = atr * si + ati * sr + li[j];
                    sr = nr; si = ni;
                }
            }
        } else {
            for (int c0 = nck - 8; c0 >= 0; c0 -= 8) {
                float lr[8], li[8];
#pragma unroll
                for (int j = 0; j < 8; ++j) { lr[j] = sl[(size_t)(base + c0 + j) * 256]; li[j] = sl[(size_t)(base + c0 + j) * 256 + 64]; }
#pragma unroll
                for (int j = 7; j >= 0; --j) {
                    const size_t it = (size_t)(base + c0 + j);
                    ub[it * LDA5] = f2bf(sr); ub[it * LDA5 + 64] = f2bf(si);
                    const float nr = atr * sr - ati * si + lr[j], ni = atr * si + ati * sr + li[j];
                    sr = nr; si = ni;
                }
            }
            ub[(size_t)mitem * LDA5] = f2bf(sr); ub[(size_t)mitem * LDA5 + 64] = f2bf(si);
        }
    }
}

constexpr int LDR = 136;
__device__ __forceinline__ float bf2f(bf16_t h) { return __uint_as_float(((unsigned)h) << 16); }

__device__ __forceinline__ void ret_pass_a(const Args& a, LAS unsigned char* lds) {
    LAS bf16_t* KT = (LAS bf16_t*)lds;
    LAS bf16_t* VT = KT + 128 * LDR;
    const int tid = threadIdx.x, w = tid >> 6, lane = tid & 63, fr = lane & 15, fq = lane >> 4;
    const bf16_t* kb = (const bf16_t*)(a.ws + OFF_K); const bf16_t* vb = (const bf16_t*)(a.ws + OFF_V);
    bf16_t* stb = (bf16_t*)(a.ws + OFF_ST);
    for (int item = blockIdx.x; item < 192; item += gridDim.x) {
        int b, h, dir;
        if (item < 128) { b = item >> 3; h = (item >> 1) & 3; dir = item & 1; } else { const int j = item - 128; b = 16 + (j >> 3); h = (j >> 1) & 3; dir = j & 1; }
        const int NC = b < 16 ? 32 : 16, rbase = b < 16 ? b * 4096 : NPR + (b - 16) * 2048, ebase = b < 16 ? b * 33 : 528 + (b - 16) * 17;
        const float lg = logsigf_(a.in[14][dir * 4 + h]);
        const float carry = __expf(lg * 128.f);
        const int st_s = tid & 127, st_hi = tid >> 7;
        const float wk = dir == 0 ? __expf(lg * (float)(127 - st_s)) : __expf(lg * (float)st_s);
        f32x4 acc[2][8];
#pragma unroll
        for (int et = 0; et < 2; ++et)
#pragma unroll
            for (int dtl = 0; dtl < 8; ++dtl) acc[et][dtl] = (f32x4){0.f, 0.f, 0.f, 0.f};
        for (int step = 0; step <= NC; ++step) {
            const int n = dir == 0 ? step : NC - step;
            if (dir == 1 && step == NC) break;
            {
                bf16_t* sp = stb + ((size_t)((ebase + n) * 4 + h) * 2 + dir) * 32768;
#pragma unroll
                for (int et = 0; et < 2; ++et)
#pragma unroll
                    for (int dtl = 0; dtl < 8; ++dtl) {
                        u32x2 o; o.x = cvt_pk_bf16(acc[et][dtl][0], acc[et][dtl][1]); o.y = cvt_pk_bf16(acc[et][dtl][2], acc[et][dtl][3]);
                        *(u32x2*)(sp + (size_t)(32 * w + 16 * et + fr) * 128 + 16 * dtl + 4 * fq) = o;
                    }
            }
            if (step == NC) break;
            __syncthreads();
            {
                int row; bool valid = true;
                if (n == 0) { valid = st_s >= 112; row = NREAL + b * 16 + (st_s - 112); } else row = rbase + (n - 1) * 128 + st_s;
#pragma unroll
                for (int it = 0; it < 4; ++it) {
                    const int d0 = (st_hi + 4 * it) * 8;
                    u32x4 kw = (u32x4){0u, 0u, 0u, 0u};
                    if (valid) kw = *(const u32x4*)(kb + (size_t)row * 512 + h * 128 + d0);
                    KT[(d0 + 0) * LDR + st_s] = f2bf(bflo(kw.x) * wk); KT[(d0 + 1) * LDR + st_s] = f2bf(bfhi(kw.x) * wk);
                    KT[(d0 + 2) * LDR + st_s] = f2bf(bflo(kw.y) * wk); KT[(d0 + 3) * LDR + st_s] = f2bf(bfhi(kw.y) * wk);
                    KT[(d0 + 4) * LDR + st_s] = f2bf(bflo(kw.z) * wk); KT[(d0 + 5) * LDR + st_s] = f2bf(bfhi(kw.z) * wk);
                    KT[(d0 + 6) * LDR + st_s] = f2bf(bflo(kw.w) * wk); KT[(d0 + 7) * LDR + st_s] = f2bf(bfhi(kw.w) * wk);
                }
#pragma unroll
                for (int it = 0; it < 8; ++it) {
                    const int e0 = (st_hi + 4 * it) * 8;
                    u32x4 vw = (u32x4){0u, 0u, 0u, 0u};
                    if (valid) vw = *(const u32x4*)(vb + (size_t)row * 1024 + h * 256 + e0);
                    VT[(e0 + 0) * LDR + st_s] = (bf16_t)(vw.x & 0xFFFFu); VT[(e0 + 1) * LDR + st_s] = (bf16_t)(vw.x >> 16);
                    VT[(e0 + 2) * LDR + st_s] = (bf16_t)(vw.y & 0xFFFFu); VT[(e0 + 3) * LDR + st_s] = (bf16_t)(vw.y >> 16);
                    VT[(e0 + 4) * LDR + st_s] = (bf16_t)(vw.z & 0xFFFFu); VT[(e0 + 5) * LDR + st_s] = (bf16_t)(vw.z >> 16);
                    VT[(e0 + 6) * LDR + st_s] = (bf16_t)(vw.w & 0xFFFFu); VT[(e0 + 7) * LDR + st_s] = (bf16_t)(vw.w >> 16);
                }
            }
            __syncthreads();
#pragma unroll
            for (int et = 0; et < 2; ++et)
#pragma unroll
                for (int dtl = 0; dtl < 8; ++dtl) acc[et][dtl] = acc[et][dtl] * carry;
#pragma unroll
            for (int ks = 0; ks < 4; ++ks) {
                bf16x8 vf[2];
#pragma unroll
                for (int et = 0; et < 2; ++et) vf[et] = *(const LAS bf16x8*)(VT + (32 * w + 16 * et + fr) * LDR + 32 * ks + 8 * fq);
#pragma unroll
                for (int dtl = 0; dtl < 8; ++dtl) {
                    const bf16x8 kf = *(const LAS bf16x8*)(KT + (16 * dtl + fr) * LDR + 32 * ks + 8 * fq);
#pragma unroll
                    for (int et = 0; et < 2; ++et) acc[et][dtl] = __builtin_amdgcn_mfma_f32_16x16x32_bf16(kf, vf[et], acc[et][dtl], 0, 0, 0);
                }
            }
        }
        __syncthreads();
    }
}

__device__ __forceinline__ void ret_pass_b(const Args& a, LAS unsigned char* lds) {
    LAS bf16_t* KL = (LAS bf16_t*)lds;
    LAS bf16_t* BG = KL + 128 * LDR;
    const int tid0 = threadIdx.x;
    const bf16_t* qb = (const bf16_t*)(a.ws + OFF_Q); const bf16_t* kb = (const bf16_t*)(a.ws + OFF_K); const bf16_t* vb = (const bf16_t*)(a.ws + OFF_V);
    const bf16_t* stb = (const bf16_t*)(a.ws + OFF_ST);
    bf16_t* sg = (bf16_t*)a.out;
    for (int item = blockIdx.x; item < 2560; item += gridDim.x) {
        int tid = tid0; asm volatile("" : "+v"(tid));
        const int w = tid >> 6, lane = tid & 63, fr = lane & 15, fq = lane >> 4;
        const int rc = item >> 2, h = item & 3;
        int b, n; if (rc < 512) { b = rc >> 5; n = (rc & 31) + 1; } else { b = 16 + ((rc - 512) >> 4); n = ((rc - 512) & 15) + 1; }
        const int ebase = b < 16 ? b * 33 : 528 + (b - 16) * 17, r0 = rc * 128;
        const float lgf = logsigf_(a.in[14][h]), lgb = logsigf_(a.in[14][4 + h]);
        const int crow = 16 * w + fr;
        bf16x8 qf[4];
#pragma unroll
        for (int ks = 0; ks < 4; ++ks) qf[ks] = *(const bf16x8*)(qb + (size_t)(r0 + crow) * 512 + h * 128 + 32 * ks + 8 * fq);
        const bf16_t* sfp = stb + ((size_t)((ebase + n) * 4 + h) * 2 + 0) * 32768;
        const bf16_t* sbp = sfp + 32768;
        __syncthreads();
#pragma unroll
        for (int it = 0; it < 4; ++it) { const int idx = tid + it * 512, s = idx >> 4, pc = idx & 15;
            *(LAS u32x4*)(KL + s * LDR + pc * 8) = *(const u32x4*)(kb + (size_t)(r0 + s) * 512 + h * 128 + pc * 8); }
#pragma unroll
        for (int it = 0; it < 8; ++it) { const int idx = tid + it * 512, e = idx >> 4, pc = idx & 15;
            *(LAS u32x4*)(BG + e * LDR + pc * 8) = *(const u32x4*)(sfp + (size_t)e * 128 + pc * 8); }
        __syncthreads();
        f32x4 sacc[8];
#pragma unroll
        for (int st = 0; st < 8; ++st) sacc[st] = (f32x4){0.f, 0.f, 0.f, 0.f};
#pragma unroll
        for (int ks = 0; ks < 4; ++ks)
#pragma unroll
            for (int st = 0; st < 8; ++st) {
                const bf16x8 kf = *(const LAS bf16x8*)(KL + (16 * st + fr) * LDR + 32 * ks + 8 * fq);
                sacc[st] = __builtin_amdgcn_mfma_f32_16x16x32_bf16(kf, qf[ks], sacc[st], 0, 0, 0);
                if (st == 7) __builtin_amdgcn_sched_barrier(0);
            }
        bf16x8 pf[4];
#pragma unroll
        for (int t = 0; t < 4; ++t) {
            float pv[8];
#pragma unroll
            for (int hh = 0; hh < 2; ++hh)
#pragma unroll
                for (int j = 0; j < 4; ++j) {
                    const int sp = 16 * (2 * t + hh) + 4 * fq + j, diff = crow - sp;
                    const float dec = diff >= 0 ? __expf(lgf * (float)diff) : __expf(-lgb * (float)diff);
                    pv[hh * 4 + j] = sacc[2 * t + hh][j] * dec;
                }
            u32x4 pw; pw.x = cvt_pk_bf16(pv[0], pv[1]); pw.y = cvt_pk_bf16(pv[2], pv[3]); pw.z = cvt_pk_bf16(pv[4], pv[5]); pw.w = cvt_pk_bf16(pv[6], pv[7]);
            pf[t] = __builtin_bit_cast(bf16x8, pw);
        }
        f32x4 o[16];
#pragma unroll
        for (int et = 0; et < 16; ++et) o[et] = (f32x4){0.f, 0.f, 0.f, 0.f};
#pragma unroll
        for (int ks = 0; ks < 4; ++ks)
#pragma unroll
            for (int et = 0; et < 16; ++et) {
                const bf16x8 sf = *(const LAS bf16x8*)(BG + (16 * et + fr) * LDR + 32 * ks + 8 * fq);
                o[et] = __builtin_amdgcn_mfma_f32_16x16x32_bf16(sf, qf[ks], o[et], 0, 0, 0);
                if ((et & 7) == 7) __builtin_amdgcn_sched_barrier(0);
            }
        const float wqf = __expf(lgf * (float)(crow + 1)), wqb = __expf(lgb * (float)(128 - crow));
        const float ratio = wqf / wqb;
#pragma unroll
        for (int et = 0; et < 16; ++et) o[et] = o[et] * ratio;
        __syncthreads();
#pragma unroll
        for (int it = 0; it < 8; ++it) { const int idx = tid + it * 512, e = idx >> 4, pc = idx & 15;
            *(LAS u32x4*)(BG + e * LDR + pc * 8) = *(const u32x4*)(sbp + (size_t)e * 128 + pc * 8); }
        __syncthreads();
#pragma unroll
        for (int ks = 0; ks < 4; ++ks)
#pragma unroll
            for (int et = 0; et < 16; ++et) {
                const bf16x8 sf = *(const LAS bf16x8*)(BG + (16 * et + fr) * LDR + 32 * ks + 8 * fq);
                o[et] = __builtin_amdgcn_mfma_f32_16x16x32_bf16(sf, qf[ks], o[et], 0, 0, 0);
                if ((et & 7) == 7) __builtin_amdgcn_sched_barrier(0);
            }
#pragma unroll
        for (int et = 0; et < 16; ++et) o[et] = o[et] * wqb;
        __syncthreads();
        {
            const int st_s = tid & 127, st_hi = tid >> 7;
#pragma unroll
            for (int it = 0; it < 8; ++it) {
                const int e0 = (st_hi + 4 * it) * 8;
                const u32x4 vw = *(const u32x4*)(vb + (size_t)(r0 + st_s) * 1024 + h * 256 + e0);
                BG[(e0 + 0) * LDR + st_s] = (bf16_t)(vw.x & 0xFFFFu); BG[(e0 + 1) * LDR + st_s] = (bf16_t)(vw.x >> 16);
                BG[(e0 + 2) * LDR + st_s] = (bf16_t)(vw.y & 0xFFFFu); BG[(e0 + 3) * LDR + st_s] = (bf16_t)(vw.y >> 16);
                BG[(e0 + 4) * LDR + st_s] = (bf16_t)(vw.z & 0xFFFFu); BG[(e0 + 5) * LDR + st_s] = (bf16_t)(vw.z >> 16);
                BG[(e0 + 6) * LDR + st_s] = (bf16_t)(vw.w & 0xFFFFu); BG[(e0 + 7) * LDR + st_s] = (bf16_t)(vw.w >> 16);
            }
        }
        __syncthreads();
#pragma unroll
        for (int t = 0; t < 4; ++t)
#pragma unroll
            for (int et = 0; et < 16; ++et) {
                const u32x2 lo = *(const LAS u32x2*)(BG + (16 * et + fr) * LDR + 32 * t + 4 * fq);
                const u32x2 hi = *(const LAS u32x2*)(BG + (16 * et + fr) * LDR + 32 * t + 16 + 4 * fq);
                const u32x4 vw = (u32x4){lo.x, lo.y, hi.x, hi.y};
                o[et] = __builtin_amdgcn_mfma_f32_16x16x32_bf16(__builtin_bit_cast(bf16x8, vw), pf[t], o[et], 0, 0, 0);
                if ((et & 7) == 7) __builtin_amdgcn_sched_barrier(0);
            }
        float ss = 0.f;
#pragma unroll
        for (int et = 0; et < 16; ++et) ss += (o[et][0] * o[et][0] + o[et][1] * o[et][1]) + (o[et][2] * o[et][2] + o[et][3] * o[et][3]);
        ss += __shfl_xor(ss, 16); ss += __shfl_xor(ss, 32);
        const float rn = rsqrtf(ss * (1.0f / 256.0f) + EPS);
        bf16_t* gp = sg + (size_t)(r0 + crow) * 1024 + h * 256 + 4 * fq;
#pragma unroll
        for (int et = 0; et < 16; ++et) {
            const u32x2 gw = *(const u32x2*)(gp + 16 * et);
            u32x2 ow; ow.x = cvt_pk_bf16(o[et][0] * rn * bflo(gw.x), o[et][1] * rn * bfhi(gw.x)); ow.y = cvt_pk_bf16(o[et][2] * rn * bflo(gw.y), o[et][3] * rn * bfhi(gw.y));
            *(u32x2*)(gp + 16 * et) = ow;
        }
    }
    __syncthreads();
}

__device__ __forceinline__ void final_norm(const Args& a) {
    const int wave = threadIdx.x >> 6, lane = threadIdx.x & 63;
    const float* ssq = (const float*)(a.ws + OFF_SSQ2);
    for (int row = blockIdx.x * 8 + wave; row < NREAL; row += gridDim.x * 8) {
        const float part = lane < 16 ? ssq[(size_t)row * 16 + lane] : 0.f;
        const float rstd = rsqrtf(wave_sum(part) * (1.0f / 1024.0f) + EPS);
        float* orow = a.out + (size_t)row * 1024;
#pragma unroll
        for (int j = 0; j < 4; ++j) {
            f32x4 v = *(const f32x4*)(orow + (j * 64 + lane) * 4);
            const f32x4 gg = *(const f32x4*)(a.in[20] + (j * 64 + lane) * 4);
            v[0] *= rstd * gg[0]; v[1] *= rstd * gg[1]; v[2] *= rstd * gg[2]; v[3] *= rstd * gg[3];
            *(f32x4*)(orow + (j * 64 + lane) * 4) = v;
        }
    }
}

template <int ph>
__device__ __forceinline__ void run_phase(const Args& a, LAS unsigned char* lds) {
    unsigned char* ws = a.ws;
    bf16_t* dob = (bf16_t*)a.out;
    bf16_t* sgp = dob; bf16_t* gap = dob + (size_t)NREAL * 1024;
#ifdef ONLY_PH
    if (ph != ONLY_PH) return;
#endif
    switch (ph) {
    case 0: phase0(a, lds); break;
    case 1: {
        pg8::Gemm g{(const bf16_t*)(ws + OFF_N1), (const bf16_t*)(ws + OFF_WIN), 1024, 1024, 1024, RPAD / 256, INW / 256, 1, 0, 0};
        EpiProj E{(bf16_t*)(ws + OFF_U5), (bf16_t*)(ws + OFF_Q), (bf16_t*)(ws + OFF_K), (bf16_t*)(ws + OFF_V), sgp, gap, (bf16_t*)(ws + OFF_GB), (const LAS double*)(lds + 131072)};
        pg8::gemm_phase(lds, g, E);
    } break;
    case 2: {
        pg8::Gemm g{(const bf16_t*)(ws + OFF_U5), (const bf16_t*)(ws + OFF_BTS), LDA5, 512, 512, IT_PAD / 256, 1, 32, (size_t)IT_PAD * LDA5, (size_t)256 * 512};
        EpiSloc E{(float*)(ws + OFF_SLOC)};
        pg8::gemm_phase(lds, g, E);
    } break;
    case 3: s5_scan(a); break;
    case 4: {
        pg8::Gemm g{(const bf16_t*)(ws + OFF_U5), (const bf16_t*)(ws + OFF_BTY), LDA5, 768, 768, IT_PAD / 256, 2, 32, (size_t)IT_PAD * LDA5, (size_t)512 * 768};
        EpiY E{(bf16_t*)(ws + OFF_YSSM)};
        pg8::gemm_phase(lds, g, E);
    } break;
    case 5: {
        pg8::Gemm g{(const bf16_t*)(ws + OFF_YSSM), (const bf16_t*)(ws + OFF_WGLU), 512, 512, 512, NREAL / 256, 8, 1, 0, 0};
        EpiGlu E{gap};
        pg8::gemm_phase(lds, g, E);
    } break;
    case 6: ret_pass_a(a, lds); break;
    case 7: ret_pass_b(a, lds); break;
    case 8: {
        pg8::Gemm g{sgp, (const bf16_t*)(ws + OFF_WRET), 1024, 1024, 1024, NREAL / 256, 4, 1, 0, 0};
        EpiRet E{gap, (const bf16_t*)(ws + OFF_GB), (bf16_t*)(ws + OFF_MIXED)};
        pg8::gemm_phase(lds, g, E);
    } break;
    case 9: {
        pg8::Gemm g{(const bf16_t*)(ws + OFF_MIXED), (const bf16_t*)(ws + OFF_WOUT), 1024, 1024, 1024, NREAL / 256, 4, 1, 0, 0};
        EpiRes<0> E{a.in[0], a.in[1], a.out, (bf16_t*)(ws + OFF_H1B), (float*)(ws + OFF_SSQ1)};
        pg8::gemm_phase(lds, g, E);
    } break;
    case 10: {
        pg8::Gemm g{(const bf16_t*)(ws + OFF_H1B), (const bf16_t*)(ws + OFF_WFFI), 1024, 1024, 1024, NREAL / 256, INW / 256, 1, 0, 0};
        EpiFfi E{(const float*)(ws + OFF_SSQ1), (bf16_t*)(ws + OFF_ACT)};
        pg8::gemm_phase(lds, g, E);
    } break;
    case 11: {
        pg8::Gemm g{(const bf16_t*)(ws + OFF_ACT), (const bf16_t*)(ws + OFF_WFFO), DFF, DFF, DFF, NREAL / 256, 4, 1, 0, 0};
        EpiRes<1> E{nullptr, nullptr, a.out, nullptr, (float*)(ws + OFF_SSQ2)};
        pg8::gemm_phase(lds, g, E);
    } break;
    case 12: final_norm(a); break;
    default: break;
    }
}

template <bool COOP>
__global__ __launch_bounds__(512, 2) void fwd_kernel(Args a) {
    extern __shared__ __attribute__((aligned(16))) unsigned char shm[];
    LAS unsigned char* lds = (LAS unsigned char*)shm;
    if (threadIdx.x < 64) ((LAS double*)(lds + 131072))[threadIdx.x] = exp2(-(double)threadIdx.x * (13.287712379549449 / 64.0));
    __syncthreads();
#define RUN_PH(P) if (a.ph_lo <= P && P < a.ph_hi) { run_phase<P>(a, lds); if (COOP && P + 1 < a.ph_hi) { __threadfence(); cg::this_grid().sync(); } }
    RUN_PH(0) RUN_PH(1) RUN_PH(2) RUN_PH(3) RUN_PH(4) RUN_PH(5) RUN_PH(6) RUN_PH(7) RUN_PH(8) RUN_PH(9) RUN_PH(10) RUN_PH(11) RUN_PH(12)
#undef RUN_PH
}

extern "C" void kernel_launch(void* const* d_in, const int* in_sizes, int n_in, void* d_out, int out_size, void* d_ws, size_t ws_size, hipStream_t stream) {
    static int grid = 0;
    if (grid == 0) {
        if (n_in != 21 || ws_size < WS_NEED || out_size != NREAL * 1024) { fprintf(stderr, "kernel_launch: unexpected shapes (n_in %d, ws %zu need %zu, out %d)\n", n_in, ws_size, (size_t)WS_NEED, out_size); grid = -1; return; }
        int dev = 0, cus = 0;
        hipGetDevice(&dev); hipDeviceGetAttribute(&cus, hipDeviceAttributeMultiprocessorCount, dev);
        hipFuncSetAttribute((const void*)fwd_kernel<true>, hipFuncAttributeMaxDynamicSharedMemorySize, LDS_BYTES);
        hipFuncSetAttribute((const void*)fwd_kernel<false>, hipFuncAttributeMaxDynamicSharedMemorySize, LDS_BYTES);
        int per_cu = 0;
        hipOccupancyMaxActiveBlocksPerMultiprocessor(&per_cu, (const void*)fwd_kernel<true>, 512, LDS_BYTES);
        if (per_cu < 1) { fprintf(stderr, "kernel_launch: occupancy query says %d blocks per CU\n", per_cu); per_cu = 1; }
        (void)hipGetLastError();
        grid = cus * 1;
    }
    if (grid < 0) return;
    Args a{};
    for (int i = 0; i < 21; ++i) a.in[i] = (const float*)d_in[i];
    a.out = (float*)d_out; a.ws = (unsigned char*)d_ws;
#if COOP_MODE
    a.ph_lo = 0; a.ph_hi = NPHASE;
    void* args[] = {&a};
    hipError_t e = hipLaunchCooperativeKernel((const void*)fwd_kernel<true>, dim3(grid), dim3(512), args, LDS_BYTES, stream);
    if (e != hipSuccess) fprintf(stderr, "cooperative launch failed: %s (grid %d)\n", hipGetErrorString(e), grid);
#else
    for (int ph = 0; ph < NPHASE; ++ph) {
        a.ph_lo = ph; a.ph_hi = ph + 1;
        hipLaunchKernelGGL(fwd_kernel<false>, dim3(grid), dim3(512), LDS_BYTES, stream, a);
    }
#endif
}
```

```cpp
#include <hip/hip_runtime.h>
#include <hip/hip_cooperative_groups.h>
#include <cstdio>
#include <cstdint>
namespace cg = cooperative_groups;

#ifndef COOP_MODE
#define COOP_MODE 1
#endif

#define LAS __attribute__((address_space(3)))
typedef unsigned short bf16_t;
typedef short bf16x8 __attribute__((ext_vector_type(8)));
typedef float f32x4 __attribute__((ext_vector_type(4)));
typedef unsigned u32x4 __attribute__((ext_vector_type(4)));
typedef unsigned u32x2 __attribute__((ext_vector_type(2)));

constexpr int D = 1024, NREAL = 81920, NPR = 65536, RPAD = 82432, NVALID = 82304;
constexpr int INW = 5632, DFF = 2816;
constexpr int T5 = 32, IT_REAL = 2560, IT_PAD = 2816, LDA5 = 768;
constexpr float EPS = 1e-6f;

constexpr size_t OFF_WIN = 0;
constexpr size_t OFF_WGLU = OFF_WIN + (size_t)INW * D * 2;
constexpr size_t OFF_WRET = OFF_WGLU + (size_t)2048 * 512 * 2;
constexpr size_t OFF_WOUT = OFF_WRET + (size_t)D * D * 2;
constexpr size_t OFF_WFFI = OFF_WOUT + (size_t)D * D * 2;
constexpr size_t OFF_WFFO = OFF_WFFI + (size_t)INW * D * 2;
constexpr size_t OFF_AT = OFF_WFFO + (size_t)D * DFF * 2;
constexpr size_t OFF_BAR = OFF_AT + 32768;
constexpr size_t OFF_Q = OFF_AT + 65536;
constexpr size_t OFF_K = OFF_Q + (size_t)RPAD * 512 * 2;
constexpr size_t OFF_V = OFF_K + (size_t)RPAD * 512 * 2;
constexpr size_t OFF_GB = OFF_V + (size_t)RPAD * D * 2;
constexpr size_t OFF_SSQ1 = OFF_GB + (size_t)NREAL * D * 2;
constexpr size_t OFF_SSQ2 = OFF_SSQ1 + (size_t)NREAL * 16 * 4;
constexpr size_t OFF_X = OFF_SSQ2 + (size_t)NREAL * 16 * 4;
constexpr size_t OFF_N1 = OFF_X;
constexpr size_t OFF_YSSM = OFF_X;
constexpr size_t OFF_U5 = OFF_N1 + (size_t)RPAD * D * 2;
constexpr size_t OFF_BTY = OFF_U5 + (size_t)32 * IT_PAD * LDA5 * 2;
constexpr size_t OFF_BTS = OFF_BTY + (size_t)32 * 512 * 768 * 2;
constexpr size_t OFF_SLOC = OFF_BTS + (size_t)32 * 256 * 512 * 2;
constexpr size_t END_X03 = OFF_SLOC + (size_t)32 * IT_PAD * 256 * 4;
constexpr size_t OFF_ST = OFF_X;
constexpr size_t END_ST = OFF_ST + (size_t)664 * 8 * 65536;
constexpr size_t OFF_ACT = OFF_X;
constexpr size_t END_ACT = OFF_ACT + (size_t)NREAL * DFF * 2;
constexpr size_t OFF_MIXED = OFF_Q;
constexpr size_t OFF_H1B = OFF_V;
constexpr size_t cmax(size_t a, size_t b) { return a > b ? a : b; }
constexpr size_t WS_NEED = cmax(END_X03, cmax(END_ST, END_ACT));

constexpr int LDS_BYTES = 131072 + 1024;
constexpr int NPHASE = 13;

struct Args {
    const float* in[21];
    float* out;
    unsigned char* ws;
    int ph_lo, ph_hi;
};

__device__ __forceinline__ unsigned cvt_pk_bf16(float lo, float hi) { unsigned r; asm volatile("v_cvt_pk_bf16_f32 %0, %1, %2" : "=v"(r) : "v"(lo), "v"(hi)); return r; }
__device__ __forceinline__ bf16_t f2bf(float f) { return (bf16_t)(cvt_pk_bf16(f, 0.f) & 0xFFFFu); }
__device__ __forceinline__ float bflo(unsigned w) { return __uint_as_float(w << 16); }
__device__ __forceinline__ float bfhi(unsigned w) { return __uint_as_float(w & 0xFFFF0000u); }
__device__ __forceinline__ float sigmoidf_(float x) { return __fdividef(1.0f, 1.0f + __expf(-x)); }
__device__ __forceinline__ float siluf_(float x) { return x * sigmoidf_(x); }
__device__ __forceinline__ float gelu_tanh(float x) { const float z = 0.7978845608028654f * (x + 0.044715f * x * x * x); return x * sigmoidf_(2.0f * z); }
__device__ __forceinline__ float logsigf_(float x) { return fminf(x, 0.f) - log1pf(__expf(-fabsf(x))); }
__device__ __forceinline__ float wave_sum(float v) {
#pragma unroll
    for (int o = 1; o < 64; o <<= 1) v += __shfl_xor(v, o);
    return v;
}
__device__ __forceinline__ void sincos_rev(double ang, float& s, float& c) {
    double x = ang * 0.15915494309189535; x -= rint(x);
    const float xf = (float)x;
    s = __builtin_amdgcn_sinf(xf); c = __builtin_amdgcn_cosf(xf);
}

namespace pg8 {
constexpr int BM = 256, BK = 64, HALF = 128, HTB = HALF * BK * 2, STAGE_BYTES = 8 * HTB, NXCD = 8, WGM = 8;
__device__ __forceinline__ int lds_byte(int r, int c) { const int st = (r >> 4) * 2 + (c >> 5), rr = r & 15, cc = c & 31, ob = rr * 64 + cc * 2; return st * 1024 + (ob ^ (((ob >> 9) & 1) << 5)); }
__device__ __forceinline__ void stage_rc(int b, int& R, int& C) { const int st = b / 1024, sb = b % 1024, swz = sb ^ (((sb >> 9) & 1) << 5); R = (st >> 1) * 16 + swz / 64; C = (st & 1) * 32 + (swz % 64) / 2; }
__device__ __forceinline__ int perm32(int rho) { const int n = rho >> 4, i = rho & 15; return 8 * (i >> 2) + 4 * n + (i & 3); }

struct Unit { int pm, pn, g; };
struct Gemm { const bf16_t* A; const bf16_t* Bt; int lda, ldb, K, nM, nN, nb; size_t sA, sB; };

struct Order {
    int nM, nN, nwg, total, G, c;
    __device__ void init(int nM_, int nN_, int nb, int G_, int c_) { nM = nM_; nN = nN_; nwg = nM * nN; total = nwg * nb; G = G_; c = c_; }
    __device__ bool next(int i, Unit& u) const {
        const long L = (long)i * G + c; if (L >= total) return false;
        u.g = (int)(L / nwg); int wgid = (int)(L % nwg);
        { const int q = nwg / NXCD, r = nwg % NXCD, xcd = wgid % NXCD, off = wgid / NXCD; wgid = (xcd < r ? xcd * (q + 1) : r * (q + 1) + (xcd - r) * q) + off; }
        const int nig = WGM * nN, gid = wgid / nig, fm = gid * WGM, gsz = (nM - fm) < WGM ? (nM - fm) : WGM;
        u.pm = fm + ((wgid % nig) % gsz); u.pn = (wgid % nig) / gsz; return true;
    }
};

template <class Epi>
__device__ __forceinline__ void gemm_phase(LAS unsigned char* lds, const Gemm g, const Epi& E) {
    const int tid = threadIdx.x, wid = __builtin_amdgcn_readfirstlane(tid >> 6), lane = tid & 63, wr = wid >> 2, wc = wid & 3, fr = lane & 15, fq = lane >> 4;
    const int K = g.K, nt = K / BK;
    Order S; S.init(g.nM, g.nN, g.nb, (int)gridDim.x, (int)blockIdx.x);
    unsigned voffA[2], voffB[2];
#pragma unroll
    for (int i = 0; i < 2; ++i) { int R, C; stage_rc(tid * 16 + i * 8192, R, C); const int Rb = (R & ~31) + perm32(R & 31);
        voffA[i] = (unsigned)(R * g.lda + C) * 2u; voffB[i] = (unsigned)(Rb * g.ldb + C) * 2u; }
    const size_t kstep = (size_t)(BK * 2);
    const size_t hstepA = (size_t)HALF * g.lda * 2, hstepB = (size_t)HALF * g.ldb * 2;
    const size_t tstepA = 2 * hstepA, tstepB = 2 * hstepB;
    const unsigned ldsw = (unsigned)wid * 1024u;
    const int aoff = lds_byte(wr * 64 + fr, fq * 8), boff = lds_byte(wc * 32 + fr, fq * 8);
#define PG8_SA(b, h) (((b) * 2 + (h)) * HTB)
#define PG8_SB(b, h) ((4 + (b) * 2 + (h)) * HTB)
#define PG8_STAGE(bufoff, gbase, voff) do { _Pragma("unroll") for (int _i = 0; _i < 2; ++_i) \
        __builtin_amdgcn_global_load_lds((const unsigned*)((const char*)(gbase) + (voff)[_i]), (LAS unsigned*)(lds + (bufoff) + ldsw + _i * 8192), 16, 0, 0); } while (0)
#define PG8_LDA(dst, b, h) do { _Pragma("unroll") for (int m = 0; m < 4; ++m) _Pragma("unroll") for (int k = 0; k < 2; ++k) dst[m][k] = *(const LAS bf16x8*)(lds + PG8_SA(b, h) + aoff + m * 2048 + k * 1024); } while (0)
#define PG8_LDB(dst, b, h) do { _Pragma("unroll") for (int n = 0; n < 2; ++n) _Pragma("unroll") for (int k = 0; k < 2; ++k) dst[n][k] = *(const LAS bf16x8*)(lds + PG8_SB(b, h) + boff + n * 2048 + k * 1024); } while (0)
#define PG8_MMA(ai, bj, At, Bt) do { __builtin_amdgcn_s_setprio(1); _Pragma("unroll") for (int m = 0; m < 4; ++m) _Pragma("unroll") for (int n = 0; n < 2; ++n) _Pragma("unroll") for (int k = 0; k < 2; ++k) \
        acc[ai][bj][m][n] = __builtin_amdgcn_mfma_f32_16x16x32_bf16(Bt[n][k], At[m][k], acc[ai][bj][m][n], 0, 0, 0); __builtin_amdgcn_s_setprio(0); } while (0)
#define PG8_WAIT_V(n) asm volatile("s_waitcnt vmcnt(" #n ")" ::: "memory")
#define PG8_WAIT_L(n) asm volatile("s_waitcnt lgkmcnt(" #n ")" ::: "memory")
#define PG8_BAR __builtin_amdgcn_s_barrier()
#define PG8_SCHED __builtin_amdgcn_sched_barrier(0)
    Unit cur, nxt; int ui = 0;
    if (!S.next(0, cur)) return;
    f32x4 acc[2][2][4][2];
#pragma unroll
    for (int a = 0; a < 2; ++a)
#pragma unroll
        for (int b = 0; b < 2; ++b)
#pragma unroll
            for (int m = 0; m < 4; ++m)
#pragma unroll
                for (int n = 0; n < 2; ++n) acc[a][b][m][n] = (f32x4){0.f, 0.f, 0.f, 0.f};
    bf16x8 At[4][2], B0[2][2], B1[2][2];
    const char* cA = (const char*)g.A + ((size_t)cur.g * g.sA) * 2 + (size_t)cur.pm * tstepA;
    const char* cB = (const char*)g.Bt + ((size_t)cur.g * g.sB) * 2 + (size_t)cur.pn * tstepB;
    PG8_STAGE(PG8_SB(0, 0), cB, voffB); PG8_STAGE(PG8_SA(0, 0), cA, voffA); PG8_STAGE(PG8_SB(0, 1), cB + hstepB, voffB); PG8_STAGE(PG8_SA(0, 1), cA + hstepA, voffA);
    if (wr == 1) PG8_BAR;
    PG8_WAIT_V(4); PG8_BAR;
    PG8_STAGE(PG8_SB(1, 0), cB + kstep, voffB); PG8_STAGE(PG8_SA(1, 0), cA + kstep, voffA); PG8_STAGE(PG8_SB(1, 1), cB + hstepB + kstep, voffB);
    PG8_WAIT_V(6); PG8_BAR;
    for (;;) {
        const bool has_next = S.next(ui + 1, nxt);
        const char* nA = has_next ? (const char*)g.A + ((size_t)nxt.g * g.sA) * 2 + (size_t)nxt.pm * tstepA : cA;
        const char* nB = has_next ? (const char*)g.Bt + ((size_t)nxt.g * g.sB) * 2 + (size_t)nxt.pn * tstepB : cB;
        for (int t = 0; t < nt; t += 2) {
            const bool last = (t == nt - 2);
            const char* a1 = cA + (size_t)(t + 1) * kstep;
            const char* a2 = last ? nA : cA + (size_t)(t + 2) * kstep; const char* b2 = last ? nB : cB + (size_t)(t + 2) * kstep;
            const char* a3 = a2 + kstep; const char* b3 = b2 + kstep;
            PG8_LDB(B0, 0, 0); PG8_SCHED; PG8_LDA(At, 0, 0); PG8_STAGE(PG8_SA(1, 1), a1 + hstepA, voffA);
            PG8_WAIT_L(8); PG8_BAR; PG8_WAIT_L(0); PG8_MMA(0, 0, At, B0); PG8_BAR; PG8_SCHED;
            PG8_LDB(B1, 0, 1); PG8_STAGE(PG8_SB(0, 0), b2, voffB);
            PG8_BAR; PG8_WAIT_L(0); PG8_MMA(0, 1, At, B1); PG8_BAR;
            PG8_LDA(At, 0, 1); PG8_STAGE(PG8_SA(0, 0), a2, voffA);
            PG8_BAR; PG8_WAIT_L(0); PG8_MMA(1, 0, At, B0); PG8_BAR; PG8_SCHED;
            PG8_STAGE(PG8_SB(0, 1), b2 + hstepB, voffB);
            PG8_WAIT_V(6); PG8_BAR; PG8_MMA(1, 1, At, B1); PG8_BAR;
            PG8_LDB(B0, 1, 0); PG8_SCHED; PG8_LDA(At, 1, 0); PG8_STAGE(PG8_SA(0, 1), a2 + hstepA, voffA);
            PG8_WAIT_L(8); PG8_BAR; PG8_WAIT_L(0); PG8_MMA(0, 0, At, B0); PG8_BAR; PG8_SCHED;
            PG8_LDB(B1, 1, 1); PG8_STAGE(PG8_SB(1, 0), b3, voffB);
            PG8_BAR; PG8_WAIT_L(0); PG8_MMA(0, 1, At, B1); PG8_BAR;
            PG8_LDA(At, 1, 1); PG8_STAGE(PG8_SA(1, 0), a3, voffA);
            PG8_BAR; PG8_WAIT_L(0); PG8_MMA(1, 0, At, B0); PG8_BAR; PG8_SCHED;
            PG8_STAGE(PG8_SB(1, 1), b3 + hstepB, voffB);
            PG8_WAIT_V(6); PG8_BAR; PG8_MMA(1, 1, At, B1); PG8_BAR;
        }
        E(acc, cur, wr, wc, fr, fq);
        if (!has_next) break;
#pragma unroll
        for (int a = 0; a < 2; ++a)
#pragma unroll
            for (int b = 0; b < 2; ++b)
#pragma unroll
                for (int m = 0; m < 4; ++m)
#pragma unroll
                    for (int n = 0; n < 2; ++n) acc[a][b][m][n] = (f32x4){0.f, 0.f, 0.f, 0.f};
        cur = nxt; cA = nA; cB = nB; ++ui;
    }
    PG8_WAIT_V(0);
    if (wr == 0) PG8_BAR;
    PG8_BAR;
#undef PG8_SA
#undef PG8_SB
#undef PG8_STAGE
#undef PG8_LDA
#undef PG8_LDB
#undef PG8_MMA
#undef PG8_WAIT_V
#undef PG8_WAIT_L
#undef PG8_BAR
#undef PG8_SCHED
}
}
using pg8::Unit;
typedef const f32x4 (&AccRef)[2][2][4][2];

__device__ __forceinline__ u32x4 pack8(f32x4 a, f32x4 b) { u32x4 w; w.x = cvt_pk_bf16(a[0], a[1]); w.y = cvt_pk_bf16(a[2], a[3]); w.z = cvt_pk_bf16(b[0], b[1]); w.w = cvt_pk_bf16(b[2], b[3]); return w; }

struct EpiProj {
    bf16_t *u5, *q, *k, *v, *sg, *ga, *gb; const LAS double* ropef;
    __device__ __forceinline__ void operator()(AccRef acc, const Unit& u, int wr, int wc, int fr, int fq) const {
        const int pn = u.pn;
#pragma unroll
        for (int ai = 0; ai < 2; ++ai)
#pragma unroll
            for (int m = 0; m < 4; ++m) {
                const int row = u.pm * 256 + ai * 128 + wr * 64 + m * 16 + fr;
#pragma unroll
                for (int bj = 0; bj < 2; ++bj) {
                    const int col = pn * 256 + bj * 128 + wc * 32 + 8 * fq;
                    f32x4 v0 = acc[ai][bj][m][0], v1 = acc[ai][bj][m][1];
                    if (pn < 2) {
                        if (row < NVALID) {
                            int item, t;
                            if (row < NREAL) { item = row >> 5; t = row & 31; } else { const int mr = row - NREAL; item = IT_REAL + (mr >> 4); t = 16 + (mr & 15); }
                            const int g = col >> 4, h0 = col & 15;
                            *(u32x4*)(u5 + ((size_t)(g * IT_PAD + item) * LDA5 + t * 16 + h0)) = pack8(v0, v1);
                        }
                    } else if (pn < 6) {
                        const int cq = col - 512, isk = cq >> 9, cc = cq & 511, i0 = (cc & 127) >> 1;
                        const int pos = row < NPR ? 16 + (row & 4095) : (row < NREAL ? 16 + ((row - NPR) & 2047) : ((row - NREAL) & 15));
                        const float sc = isk ? 1.0f : 0.08838834764831845f;
                        float o[8];
#pragma unroll
                        for (int pi = 0; pi < 4; ++pi) {
                            float s, c; sincos_rev((double)pos * ropef[i0 + pi], s, c);
                            const float x1 = pi < 2 ? v0[2 * pi] : v1[2 * pi - 4], x2 = pi < 2 ? v0[2 * pi + 1] : v1[2 * pi - 3];
                            o[2 * pi] = (x1 * c - x2 * s) * sc; o[2 * pi + 1] = (x1 * s + x2 * c) * sc;
                        }
                        u32x4 w; w.x = cvt_pk_bf16(o[0], o[1]); w.y = cvt_pk_bf16(o[2], o[3]); w.z = cvt_pk_bf16(o[4], o[5]); w.w = cvt_pk_bf16(o[6], o[7]);
                        *(u32x4*)((isk ? k : q) + (size_t)row * 512 + cc) = w;
                    } else if (pn < 10) {
                        *(u32x4*)(v + (size_t)row * 1024 + (col - 1536)) = pack8(v0, v1);
                    } else if (row < NREAL) {
                        if (pn < 14) {
#pragma unroll
                            for (int j = 0; j < 4; ++j) { v0[j] = siluf_(v0[j]); v1[j] = siluf_(v1[j]); }
                            *(u32x4*)(sg + (size_t)row * 1024 + (col - 2560)) = pack8(v0, v1);
                        } else {
#pragma unroll
                            for (int j = 0; j < 4; ++j) { v0[j] = sigmoidf_(v0[j]); v1[j] = sigmoidf_(v1[j]); }
                            if (pn < 18) *(u32x4*)(ga + (size_t)row * 1024 + (col - 3584)) = pack8(v0, v1);
                            else *(u32x4*)(gb + (size_t)row * 1024 + (col - 4608)) = pack8(v0, v1);
                        }
                    }
                }
            }
    }
};

struct EpiSloc {
    float* sloc;
    __device__ __forceinline__ void operator()(AccRef acc, const Unit& u, int wr, int wc, int fr, int fq) const {
#pragma unroll
        for (int ai = 0; ai < 2; ++ai)
#pragma unroll
            for (int m = 0; m < 4; ++m) {
                const int row = u.pm * 256 + ai * 128 + wr * 64 + m * 16 + fr;
#pragma unroll
                for (int bj = 0; bj < 2; ++bj) {
                    const int col = bj * 128 + wc * 32 + 8 * fq;
                    float* p = sloc + ((size_t)u.g * IT_PAD + row) * 256 + col;
                    *(f32x4*)p = acc[ai][bj][m][0]; *(f32x4*)(p + 4) = acc[ai][bj][m][1];
                }
            }
    }
};

struct EpiY {
    bf16_t* y;
    __device__ __forceinline__ void operator()(AccRef acc, const Unit& u, int wr, int wc, int fr, int fq) const {
#pragma unroll
        for (int ai = 0; ai < 2; ++ai)
#pragma unroll
            for (int m = 0; m < 4; ++m) {
                const int item = u.pm * 256 + ai * 128 + wr * 64 + m * 16 + fr;
                if (item < IT_REAL) {
#pragma unroll
                    for (int bj = 0; bj < 2; ++bj) {
                        const int col = u.pn * 256 + bj * 128 + wc * 32 + 8 * fq, to = col >> 4, ho = col & 15;
                        f32x4 v0 = acc[ai][bj][m][0], v1 = acc[ai][bj][m][1];
#pragma unroll
                        for (int j = 0; j < 4; ++j) { v0[j] = gelu_tanh(v0[j]); v1[j] = gelu_tanh(v1[j]); }
                        *(u32x4*)(y + (size_t)(item * 32 + to) * 512 + u.g * 16 + ho) = pack8(v0, v1);
                    }
                }
            }
    }
};

struct EpiGlu {
    bf16_t* ga;
    __device__ __forceinline__ void operator()(AccRef acc, const Unit& u, int wr, int wc, int fr, int fq) const {
#pragma unroll
        for (int ai = 0; ai < 2; ++ai)
#pragma unroll
            for (int m = 0; m < 4; ++m) {
                const int row = u.pm * 256 + ai * 128 + wr * 64 + m * 16 + fr;
                bf16_t* p = ga + (size_t)row * 1024 + u.pn * 128 + wc * 32 + 8 * fq;
                const u32x4 gw = *(const u32x4*)p;
                const f32x4 a0 = acc[ai][0][m][0], a1 = acc[ai][0][m][1], g0 = acc[ai][1][m][0], g1 = acc[ai][1][m][1];
                f32x4 r0, r1;
                r0[0] = bflo(gw.x) * a0[0] * sigmoidf_(g0[0]); r0[1] = bfhi(gw.x) * a0[1] * sigmoidf_(g0[1]);
                r0[2] = bflo(gw.y) * a0[2] * sigmoidf_(g0[2]); r0[3] = bfhi(gw.y) * a0[3] * sigmoidf_(g0[3]);
                r1[0] = bflo(gw.z) * a1[0] * sigmoidf_(g1[0]); r1[1] = bfhi(gw.z) * a1[1] * sigmoidf_(g1[1]);
                r1[2] = bflo(gw.w) * a1[2] * sigmoidf_(g1[2]); r1[3] = bfhi(gw.w) * a1[3] * sigmoidf_(g1[3]);
                *(u32x4*)p = pack8(r0, r1);
            }
    }
};

struct EpiRet {
    const bf16_t *pa, *gb; bf16_t* mixed;
    __device__ __forceinline__ void operator()(AccRef acc, const Unit& u, int wr, int wc, int fr, int fq) const {
#pragma unroll
        for (int ai = 0; ai < 2; ++ai)
#pragma unroll
            for (int m = 0; m < 4; ++m) {
                const int row = u.pm * 256 + ai * 128 + wr * 64 + m * 16 + fr;
#pragma unroll
                for (int bj = 0; bj < 2; ++bj) {
                    const size_t o = (size_t)row * 1024 + u.pn * 256 + bj * 128 + wc * 32 + 8 * fq;
                    const u32x4 pw = *(const u32x4*)(pa + o), gw = *(const u32x4*)(gb + o);
                    const f32x4 a0 = acc[ai][bj][m][0], a1 = acc[ai][bj][m][1];
                    f32x4 r0, r1;
                    r0[0] = bflo(pw.x) + bflo(gw.x) * a0[0]; r0[1] = bfhi(pw.x) + bfhi(gw.x) * a0[1];
                    r0[2] = bflo(pw.y) + bflo(gw.y) * a0[2]; r0[3] = bfhi(pw.y) + bfhi(gw.y) * a0[3];
                    r1[0] = bflo(pw.z) + bflo(gw.z) * a1[0]; r1[1] = bfhi(pw.z) + bfhi(gw.z) * a1[1];
                    r1[2] = bflo(pw.w) + bflo(gw.w) * a1[2]; r1[3] = bfhi(pw.w) + bfhi(gw.w) * a1[3];
                    *(u32x4*)(mixed + o) = pack8(r0, r1);
                }
            }
    }
};

template <int MODE>
struct EpiRes {
    const float *xp, *xs; float* out; bf16_t* hb; float* ssq;
    __device__ __forceinline__ void operator()(AccRef acc, const Unit& u, int wr, int wc, int fr, int fq) const {
#pragma unroll
        for (int ai = 0; ai < 2; ++ai)
#pragma unroll
            for (int m = 0; m < 4; ++m) {
                const int row = u.pm * 256 + ai * 128 + wr * 64 + m * 16 + fr;
                float ss = 0.f;
#pragma unroll
                for (int bj = 0; bj < 2; ++bj) {
                    const int col = u.pn * 256 + bj * 128 + wc * 32 + 8 * fq;
                    const float* src = MODE == 0 ? (row < NPR ? xp + (size_t)row * 1024 : xs + (size_t)(row - NPR) * 1024) + col : out + (size_t)row * 1024 + col;
                    f32x4 h0 = *(const f32x4*)src + acc[ai][bj][m][0], h1 = *(const f32x4*)(src + 4) + acc[ai][bj][m][1];
                    float* dst = out + (size_t)row * 1024 + col;
                    *(f32x4*)dst = h0; *(f32x4*)(dst + 4) = h1;
                    if (MODE == 0) *(u32x4*)(hb + (size_t)row * 1024 + col) = pack8(h0, h1);
                    ss += (h0[0] * h0[0] + h0[1] * h0[1]) + (h0[2] * h0[2] + h0[3] * h0[3]) + (h1[0] * h1[0] + h1[1] * h1[1]) + (h1[2] * h1[2] + h1[3] * h1[3]);
                }
                ss += __shfl_xor(ss, 16); ss += __shfl_xor(ss, 32);
                if (fq == 0) ssq[(size_t)row * 16 + u.pn * 4 + wc] = ss;
            }
    }
};

struct EpiFfi {
    const float* ssq; bf16_t* act;
    __device__ __forceinline__ void operator()(AccRef acc, const Unit& u, int wr, int wc, int fr, int fq) const {
#pragma unroll
        for (int ai = 0; ai < 2; ++ai)
#pragma unroll
            for (int m = 0; m < 4; ++m) {
                const int row = u.pm * 256 + ai * 128 + wr * 64 + m * 16 + fr;
                const f32x4* sp = (const f32x4*)(ssq + (size_t)row * 16);
                const f32x4 s0 = sp[0], s1 = sp[1], s2 = sp[2], s3 = sp[3];
                const float tot = ((s0[0] + s0[1]) + (s0[2] + s0[3])) + ((s1[0] + s1[1]) + (s1[2] + s1[3])) + ((s2[0] + s2[1]) + (s2[2] + s2[3])) + ((s3[0] + s3[1]) + (s3[2] + s3[3]));
                const float rstd = rsqrtf(tot * (1.0f / 1024.0f) + EPS);
                const f32x4 g0 = acc[ai][0][m][0], g1 = acc[ai][0][m][1], u0 = acc[ai][1][m][0], u1 = acc[ai][1][m][1];
                f32x4 r0, r1;
#pragma unroll
                for (int j = 0; j < 4; ++j) { r0[j] = siluf_(rstd * g0[j]) * (rstd * u0[j]); r1[j] = siluf_(rstd * g1[j]) * (rstd * u1[j]); }
                *(u32x4*)(act + (size_t)row * DFF + u.pn * 128 + wc * 32 + 8 * fq) = pack8(r0, r1);
            }
    }
};

__device__ __forceinline__ void p0_s5gen(const Args& a, LAS float* L, int g) {
    const int tid = threadIdx.x;
    LAS float* Kt = L;
    LAS float* Ap = L + 16384;
    LAS float* Bb = Ap + 33 * 64 * 2;
    LAS float* Cc = Bb + 2048;
    bf16_t* bts = (bf16_t*)(a.ws + OFF_BTS) + (size_t)g * 256 * 512;
    bf16_t* bty = (bf16_t*)(a.ws + OFF_BTY) + (size_t)g * 512 * 768;
    float* attab = (float*)(a.ws + OFF_AT);
    bf16_t* u5 = (bf16_t*)(a.ws + OFF_U5);
    for (int e = tid; e < 24 * 256; e += 512) { const int b = e >> 8, kk = e & 255; u5[((size_t)g * IT_PAD + IT_REAL + b) * LDA5 + kk] = 0; }
    for (int dir = 0; dir < 2; ++dir) {
        const int pg = dir * 32 + g;
        const double dt = exp((double)a.in[7][pg]);
        for (int idx = tid; idx < 33 * 64; idx += 512) {
            const int p = idx & 63, d = idx >> 6;
            const double lr = a.in[5][pg * 64 + p], li = a.in[6][pg * 64 + p];
            const float mag = (float)exp(lr * dt * d);
            float s, c; sincos_rev(li * dt * d, s, c);
            Ap[idx * 2] = mag * c; Ap[idx * 2 + 1] = mag * s;
            if (d == 32) { attab[(pg * 64 + p) * 2] = mag * c; attab[(pg * 64 + p) * 2 + 1] = mag * s; }
        }
        for (int idx = tid; idx < 1024; idx += 512) {
            const int p = idx >> 4, h = idx & 15;
            const double lr = a.in[5][pg * 64 + p], li = a.in[6][pg * 64 + p];
            const double zr = lr * dt, zi = li * dt, mag = exp(zr);
            float sh, ch, s1, c1; sincos_rev(0.5 * zi, sh, ch); sincos_rev(zi, s1, c1);
            const double nr = mag * (-2.0 * (double)sh * (double)sh) + expm1(zr);
            const double abi = mag * (double)s1, den = lr * lr + li * li;
            const double cre = (nr * lr + abi * li) / den, cim = (abi * lr - nr * li) / den;
            const double br = a.in[8][(size_t)(pg * 64 + p) * 16 + h], bi = a.in[9][(size_t)(pg * 64 + p) * 16 + h];
            Bb[idx * 2] = (float)(cre * br - cim * bi); Bb[idx * 2 + 1] = (float)(cre * bi + cim * br);
        }
        for (int idx = tid; idx < 1024; idx += 512) {
            Cc[idx * 2] = a.in[10][(size_t)pg * 1024 + idx]; Cc[idx * 2 + 1] = a.in[11][(size_t)pg * 1024 + idx];
        }
        __syncthreads();
        for (int e = tid; e < 8192; e += 512) {
            const int d = e >> 8, ho = (e >> 4) & 15, hi = e & 15;
            float sum = 0.f;
            for (int p = 0; p < 64; ++p) {
                const float cr = Cc[(ho * 64 + p) * 2], ci = Cc[(ho * 64 + p) * 2 + 1], ar = Ap[(d * 64 + p) * 2], ai = Ap[(d * 64 + p) * 2 + 1];
                const float br = Bb[(p * 16 + hi) * 2], bi = Bb[(p * 16 + hi) * 2 + 1];
                const float car = cr * ar - ci * ai, cai = cr * ai + ci * ar;
                sum += car * br - cai * bi;
            }
            Kt[dir * 8192 + e] = sum;
        }
        for (int e = tid; e < 65536; e += 512) {
            const int k = e & 511, nn = e >> 9, c = nn >> 6, p = nn & 63, t = k >> 4, hi = k & 15;
            const int dd = dir == 0 ? (T5 - 1 - t) : t;
            const float ar = Ap[(dd * 64 + p) * 2], ai = Ap[(dd * 64 + p) * 2 + 1], br = Bb[(p * 16 + hi) * 2], bi = Bb[(p * 16 + hi) * 2 + 1];
            const float val = c ? (ar * bi + ai * br) : (ar * br - ai * bi);
            bts[(size_t)(dir * 128 + nn) * 512 + k] = f2bf(val);
        }
        for (int e = tid; e < 65536; e += 512) {
            const int kk = e & 127, n = e >> 7, c = kk >> 6, p = kk & 63, to = n >> 4, ho = n & 15;
            const int dd = dir == 0 ? (to + 1) : (T5 - to);
            const float cr = Cc[(ho * 64 + p) * 2], ci = Cc[(ho * 64 + p) * 2 + 1], ar = Ap[(dd * 64 + p) * 2], ai = Ap[(dd * 64 + p) * 2 + 1];
            const float val = c ? -(cr * ai + ci * ar) : (cr * ar - ci * ai);
            bty[(size_t)n * 768 + 512 + dir * 128 + kk] = f2bf(val);
        }
        __syncthreads();
    }
    for (int e = tid; e < 262144; e += 512) {
        const int k = e & 511, n = e >> 9, to = n >> 4, ho = n & 15, ti = k >> 4, hi = k & 15;
        float val = 0.f;
        if (to >= ti) val += Kt[((to - ti) * 16 + ho) * 16 + hi];
        if (ti >= to) val += Kt[8192 + ((ti - to) * 16 + ho) * 16 + hi];
        if (to == ti && ho == hi) val += a.in[12][g * 16 + ho];
        bty[(size_t)n * 768 + k] = f2bf(val);
    }
    __syncthreads();
}

__device__ __forceinline__ int src_col(int kind, int n) {
    if (kind == 1) { if (n >= 512 && n < 1536) { const int r = n - 512, seg = r >> 7, dp = r & 127; return 512 + seg * 128 + (dp >> 1) + 64 * (dp & 1); } return n; }
    if (kind == 2) { const int pn = n >> 8, bj = (n >> 7) & 1, cc = n & 127; return bj * 1024 + pn * 128 + cc; }
    if (kind == 3) { const int pn = n >> 8, bj = (n >> 7) & 1, cc = n & 127; return bj * DFF + pn * 128 + cc; }
    return n;
}
__device__ __forceinline__ void p0_wtile(const float* W, int K, int N, bf16_t* WT, int kind, const float* kscale, int tile, LAS float* L) {
    const int tid = threadIdx.x, nkt = K >> 6, nt_ = tile / nkt, kt = tile % nkt, n0 = nt_ * 64, k0 = kt * 64;
#pragma unroll
    for (int it = 0; it < 8; ++it) {
        const int idx = tid + it * 512, kk = idx >> 6, j = idx & 63;
        float v = W[(size_t)(k0 + kk) * N + src_col(kind, n0 + j)];
        if (kscale) v *= kscale[k0 + kk];
        L[kk * 65 + j] = v;
    }
    __syncthreads();
#pragma unroll
    for (int it = 0; it < 4; ++it) {
        const int idx = tid + it * 512, j = idx >> 5, kp = idx & 31;
        *(unsigned*)(WT + (size_t)(n0 + j) * K + k0 + 2 * kp) = cvt_pk_bf16(L[(2 * kp) * 65 + j], L[(2 * kp + 1) * 65 + j]);
    }
    __syncthreads();
}

__device__ __forceinline__ void phase0(const Args& a, LAS unsigned char* lds) {
    LAS float* L = (LAS float*)lds;
    const int tid = threadIdx.x, wave = tid >> 6, lane = tid & 63;
    constexpr int T_IN = 88 * 16, T_GLU = 32 * 8, T_RET = 256, T_OUT = 256, T_FFI = 88 * 16, T_FFO = 16 * 44;
    constexpr int NW = 32 + T_IN + T_GLU + T_RET + T_OUT + T_FFI + T_FFO, NRM = RPAD / 8;
    for (int w = blockIdx.x; w < NW + NRM; w += gridDim.x) {
        int r = w;
        if (r < 32) { p0_s5gen(a, L, r); continue; } r -= 32;
        if (r < T_IN) { p0_wtile(a.in[4], 1024, INW, (bf16_t*)(a.ws + OFF_WIN), 1, nullptr, r, L); continue; } r -= T_IN;
        if (r < T_GLU) { p0_wtile(a.in[13], 512, 2048, (bf16_t*)(a.ws + OFF_WGLU), 2, nullptr, r, L); continue; } r -= T_GLU;
        if (r < T_RET) { p0_wtile(a.in[15], 1024, 1024, (bf16_t*)(a.ws + OFF_WRET), 0, nullptr, r, L); continue; } r -= T_RET;
        if (r < T_OUT) { p0_wtile(a.in[16], 1024, 1024, (bf16_t*)(a.ws + OFF_WOUT), 0, nullptr, r, L); continue; } r -= T_OUT;
        if (r < T_FFI) { p0_wtile(a.in[18], 1024, INW, (bf16_t*)(a.ws + OFF_WFFI), 3, a.in[17], r, L); continue; } r -= T_FFI;
        if (r < T_FFO) { p0_wtile(a.in[19], DFF, 1024, (bf16_t*)(a.ws + OFF_WFFO), 0, nullptr, r, L); continue; } r -= T_FFO;
        const int row = r * 8 + wave;
        bf16_t* orow = (bf16_t*)(a.ws + OFF_N1) + (size_t)row * 1024;
        if (row >= NVALID) {
#pragma unroll
            for (int j = 0; j < 4; ++j) *(u32x2*)(orow + (j * 64 + lane) * 4) = (u32x2){0u, 0u};
        } else {
            const float* xr = row < NPR ? a.in[0] + (size_t)row * 1024 : (row < NREAL ? a.in[1] + (size_t)(row - NPR) * 1024 : a.in[2] + (size_t)((row - NREAL) & 15) * 1024);
            f32x4 v[4]; float s = 0.f;
#pragma unroll
            for (int j = 0; j < 4; ++j) { v[j] = *(const f32x4*)(xr + (j * 64 + lane) * 4); s += (v[j][0] * v[j][0] + v[j][1] * v[j][1]) + (v[j][2] * v[j][2] + v[j][3] * v[j][3]); }
            const float rstd = rsqrtf(wave_sum(s) * (1.0f / 1024.0f) + EPS);
#pragma unroll
            for (int j = 0; j < 4; ++j) {
                const f32x4 gg = *(const f32x4*)(a.in[3] + (j * 64 + lane) * 4);
                u32x2 o; o.x = cvt_pk_bf16(v[j][0] * rstd * gg[0], v[j][1] * rstd * gg[1]); o.y = cvt_pk_bf16(v[j][2] * rstd * gg[2], v[j][3] * rstd * gg[3]);
                *(u32x2*)(orow + (j * 64 + lane) * 4) = o;
            }
        }
    }
}

__device__ __forceinline__ void s5_scan(const Args& a) {
    const float* attab = (const float*)(a.ws + OFF_AT);
    const float* sloc = (const float*)(a.ws + OFF_SLOC);
    bf16_t* u5 = (bf16_t*)(a.ws + OFF_U5);
    for (int id = blockIdx.x * 512 + threadIdx.x; id < 24 * 32 * 2 * 64; id += gridDim.x * 512) {
        const int p = id & 63, dir = (id >> 6) & 1, g = (id >> 7) & 31, b = id >> 12;
        const float atr = attab[((dir * 32 + g) * 64 + p) * 2], ati = attab[((dir * 32 + g) * 64 + p) * 2 + 1];
        const int nck = b < 16 ? 128 : 64, base = b < 16 ? b * 128 : 2048 + (b - 16) * 64, mitem = IT_REAL + b;
        const float* sl = sloc + (size_t)g * IT_PAD * 256 + dir * 128 + p;
        bf16_t* ub = u5 + (size_t)g * IT_PAD * LDA5 + 512 + dir * 128 + p;
        float sr = 0.f, si = 0.f;
        if (dir == 0) {
            ub[(size_t)mitem * LDA5] = 0; ub[(size_t)mitem * LDA5 + 64] = 0;
            sr = sl[(size_t)mitem * 256]; si = sl[(size_t)mitem * 256 + 64];
            for (int c0 = 0; c0 < nck; c0 += 8) {
                float lr[8], li[8];
#pragma unroll
                for (int j = 0; j < 8; ++j) { lr[j] = sl[(size_t)(base + c0 + j) * 256]; li[j] = sl[(size_t)(base + c0 + j) * 256 + 64]; }
#pragma unroll
                for (int j = 0; j < 8; ++j) {
                    const size_t it = (size_t)(base + c0 + j);
                    ub[it * LDA5] = f2bf(sr); ub[it * LDA5 + 64] = f2bf(si);
                    const float nr = atr * sr - ati * si + lr[j], ni = atr * si + ati * sr + li[j];
                    sr = nr; si = ni;
                }
            }
        } else {
            for (int c0 = nck - 8; c0 >= 0; c0 -= 8) {
                float lr[8], li[8];
#pragma unroll
                for (int j = 0; j < 8; ++j) { lr[j] = sl[(size_t)(base + c0 + j) * 256]; li[j] = sl[(size_t)(base + c0 + j) * 256 + 64]; }
#pragma unroll
                for (int j = 7; j >= 0; --j) {
                    const size_t it = (size_t)(base + c0 + j);
                    ub[it * LDA5] = f2bf(sr); ub[it * LDA5 + 64] = f2bf(si);
                    const float nr = atr * sr - ati * si + lr[j], ni = atr * si + ati * sr + li[j];
                    sr = nr; si = ni;
                }
            }
            ub[(size_t)mitem * LDA5] = f2bf(sr); ub[(size_t)mitem * LDA5 + 64] = f2bf(si);
        }
    }
}

constexpr int LDR = 136;
__device__ __forceinline__ float bf2f(bf16_t h) { return __uint_as_float(((unsigned)h) << 16); }

__device__ __forceinline__ void ret_pass_a(const Args& a, LAS unsigned char* lds) {
    LAS bf16_t* KT = (LAS bf16_t*)lds;
    LAS bf16_t* VT = KT + 128 * LDR;
    const int tid = threadIdx.x, w = tid >> 6, lane = tid & 63, fr = lane & 15, fq = lane >> 4;
    const bf16_t* kb = (const bf16_t*)(a.ws + OFF_K); const bf16_t* vb = (const bf16_t*)(a.ws + OFF_V);
    bf16_t* stb = (bf16_t*)(a.ws + OFF_ST);
    for (int item = blockIdx.x; item < 192; item += gridDim.x) {
        int b, h, dir;
        if (item < 128) { b = item >> 3; h = (item >> 1) & 3; dir = item & 1; } else { const int j = item - 128; b = 16 + (j >> 3); h = (j >> 1) & 3; dir = j & 1; }
        const int NC = b < 16 ? 32 : 16, rbase = b < 16 ? b * 4096 : NPR + (b - 16) * 2048, ebase = b < 16 ? b * 33 : 528 + (b - 16) * 17;
        const float lg = logsigf_(a.in[14][dir * 4 + h]);
        const float carry = __expf(lg * 128.f);
        const int st_s = tid & 127, st_hi = tid >> 7;
        const float wk = dir == 0 ? __expf(lg * (float)(127 - st_s)) : __expf(lg * (float)st_s);
        f32x4 acc[2][8];
#pragma unroll
        for (int et = 0; et < 2; ++et)
#pragma unroll
            for (int dtl = 0; dtl < 8; ++dtl) acc[et][dtl] = (f32x4){0.f, 0.f, 0.f, 0.f};
        for (int step = 0; step <= NC; ++step) {
            const int n = dir == 0 ? step : NC - step;
            if (dir == 1 && step == NC) break;
            {
                bf16_t* sp = stb + ((size_t)((ebase + n) * 4 + h) * 2 + dir) * 32768;
#pragma unroll
                for (int et = 0; et < 2; ++et)
#pragma unroll
                    for (int dtl = 0; dtl < 8; ++dtl) {
                        u32x2 o; o.x = cvt_pk_bf16(acc[et][dtl][0], acc[et][dtl][1]); o.y = cvt_pk_bf16(acc[et][dtl][2], acc[et][dtl][3]);
                        *(u32x2*)(sp + (size_t)(32 * w + 16 * et + fr) * 128 + 16 * dtl + 4 * fq) = o;
                    }
            }
            if (step == NC) break;
            __syncthreads();
            {
                int row; bool valid = true;
                if (n == 0) { valid = st_s >= 112; row = NREAL + b * 16 + (st_s - 112); } else row = rbase + (n - 1) * 128 + st_s;
#pragma unroll
                for (int it = 0; it < 4; ++it) {
                    const int d0 = (st_hi + 4 * it) * 8;
                    u32x4 kw = (u32x4){0u, 0u, 0u, 0u};
                    if (valid) kw = *(const u32x4*)(kb + (size_t)row * 512 + h * 128 + d0);
                    KT[(d0 + 0) * LDR + st_s] = f2bf(bflo(kw.x) * wk); KT[(d0 + 1) * LDR + st_s] = f2bf(bfhi(kw.x) * wk);
                    KT[(d0 + 2) * LDR + st_s] = f2bf(bflo(kw.y) * wk); KT[(d0 + 3) * LDR + st_s] = f2bf(bfhi(kw.y) * wk);
                    KT[(d0 + 4) * LDR + st_s] = f2bf(bflo(kw.z) * wk); KT[(d0 + 5) * LDR + st_s] = f2bf(bfhi(kw.z) * wk);
                    KT[(d0 + 6) * LDR + st_s] = f2bf(bflo(kw.w) * wk); KT[(d0 + 7) * LDR + st_s] = f2bf(bfhi(kw.w) * wk);
                }
#pragma unroll
                for (int it = 0; it < 8; ++it) {
                    const int e0 = (st_hi + 4 * it) * 8;
                    u32x4 vw = (u32x4){0u, 0u, 0u, 0u};
                    if (valid) vw = *(const u32x4*)(vb + (size_t)row * 1024 + h * 256 + e0);
                    VT[(e0 + 0) * LDR + st_s] = (bf16_t)(vw.x & 0xFFFFu); VT[(e0 + 1) * LDR + st_s] = (bf16_t)(vw.x >> 16);
                    VT[(e0 + 2) * LDR + st_s] = (bf16_t)(vw.y & 0xFFFFu); VT[(e0 + 3) * LDR + st_s] = (bf16_t)(vw.y >> 16);
                    VT[(e0 + 4) * LDR + st_s] = (bf16_t)(vw.z & 0xFFFFu); VT[(e0 + 5) * LDR + st_s] = (bf16_t)(vw.z >> 16);
                    VT[(e0 + 6) * LDR + st_s] = (bf16_t)(vw.w & 0xFFFFu); VT[(e0 + 7) * LDR + st_s] = (bf16_t)(vw.w >> 16);
                }
            }
            __syncthreads();
#pragma unroll
            for (int et = 0; et < 2; ++et)
#pragma unroll
                for (int dtl = 0; dtl < 8; ++dtl) acc[et][dtl] = acc[et][dtl] * carry;
#pragma unroll
            for (int ks = 0; ks < 4; ++ks) {
                bf16x8 vf[2];
#pragma unroll
                for (int et = 0; et < 2; ++et) vf[et] = *(const LAS bf16x8*)(VT + (32 * w + 16 * et + fr) * LDR + 32 * ks + 8 * fq);
#pragma unroll
                for (int dtl = 0; dtl < 8; ++dtl) {
                    const bf16x8 kf = *(const LAS bf16x8*)(KT + (16 * dtl + fr) * LDR + 32 * ks + 8 * fq);
#pragma unroll
                    for (int et = 0; et < 2; ++et) acc[et][dtl] = __builtin_amdgcn_mfma_f32_16x16x32_bf16(kf, vf[et], acc[et][dtl], 0, 0, 0);
                }
            }
        }
        __syncthreads();
    }
}

__device__ __forceinline__ void ret_pass_b(const Args& a, LAS unsigned char* lds) {
    LAS bf16_t* KL = (LAS bf16_t*)lds;
    LAS bf16_t* BG = KL + 128 * LDR;
    const int tid0 = threadIdx.x;
    const bf16_t* qb = (const bf16_t*)(a.ws + OFF_Q); const bf16_t* kb = (const bf16_t*)(a.ws + OFF_K); const bf16_t* vb = (const bf16_t*)(a.ws + OFF_V);
    const bf16_t* stb = (const bf16_t*)(a.ws + OFF_ST);
    bf16_t* sg = (bf16_t*)a.out;
    for (int item = blockIdx.x; item < 2560; item += gridDim.x) {
        int tid = tid0; asm volatile("" : "+v"(tid));
        const int w = tid >> 6, lane = tid & 63, fr = lane & 15, fq = lane >> 4;
        const int rc = item >> 2, h = item & 3;
        int b, n; if (rc < 512) { b = rc >> 5; n = (rc & 31) + 1; } else { b = 16 + ((rc - 512) >> 4); n = ((rc - 512) & 15) + 1; }
        const int ebase = b < 16 ? b * 33 : 528 + (b - 16) * 17, r0 = rc * 128;
        const float lgf = logsigf_(a.in[14][h]), lgb = logsigf_(a.in[14][4 + h]);
        const int crow = 16 * w + fr;
        bf16x8 qf[4];
#pragma unroll
        for (int ks = 0; ks < 4; ++ks) qf[ks] = *(const bf16x8*)(qb + (size_t)(r0 + crow) * 512 + h * 128 + 32 * ks + 8 * fq);
        const bf16_t* sfp = stb + ((size_t)((ebase + n) * 4 + h) * 2 + 0) * 32768;
        const bf16_t* sbp = sfp + 32768;
        __syncthreads();
#pragma unroll
        for (int it = 0; it < 4; ++it) { const int idx = tid + it * 512, s = idx >> 4, pc = idx & 15;
            *(LAS u32x4*)(KL + s * LDR + pc * 8) = *(const u32x4*)(kb + (size_t)(r0 + s) * 512 + h * 128 + pc * 8); }
#pragma unroll
        for (int it = 0; it < 8; ++it) { const int idx = tid + it * 512, e = idx >> 4, pc = idx & 15;
            *(LAS u32x4*)(BG + e * LDR + pc * 8) = *(const u32x4*)(sfp + (size_t)e * 128 + pc * 8); }
        __syncthreads();
        f32x4 sacc[8];
#pragma unroll
        for (int st = 0; st < 8; ++st) sacc[st] = (f32x4){0.f, 0.f, 0.f, 0.f};
#pragma unroll
        for (int ks = 0; ks < 4; ++ks)
#pragma unroll
            for (int st = 0; st < 8; ++st) {
                const bf16x8 kf = *(const LAS bf16x8*)(KL + (16 * st + fr) * LDR + 32 * ks + 8 * fq);
                sacc[st] = __builtin_amdgcn_mfma_f32_16x16x32_bf16(kf, qf[ks], sacc[st], 0, 0, 0);
                if (st == 7) __builtin_amdgcn_sched_barrier(0);
            }
        bf16x8 pf[4];
#pragma unroll
        for (int t = 0; t < 4; ++t) {
            float pv[8];
#pragma unroll
            for (int hh = 0; hh < 2; ++hh)
#pragma unroll
                for (int j = 0; j < 4; ++j) {
                    const int sp = 16 * (2 * t + hh) + 4 * fq + j, diff = crow - sp;
                    const float dec = diff >= 0 ? __expf(lgf * (float)diff) : __expf(-lgb * (float)diff);
                    pv[hh * 4 + j] = sacc[2 * t + hh][j] * dec;
                }
            u32x4 pw; pw.x = cvt_pk_bf16(pv[0], pv[1]); pw.y = cvt_pk_bf16(pv[2], pv[3]); pw.z = cvt_pk_bf16(pv[4], pv[5]); pw.w = cvt_pk_bf16(pv[6], pv[7]);
            pf[t] = __builtin_bit_cast(bf16x8, pw);
        }
        f32x4 o[16];
#pragma unroll
        for (int et = 0; et < 16; ++et) o[et] = (f32x4){0.f, 0.f, 0.f, 0.f};
#pragma unroll
        for (int ks = 0; ks < 4; ++ks)
#pragma unroll
            for (int et = 0; et < 16; ++et) {
                const bf16x8 sf = *(const LAS bf16x8*)(BG + (16 * et + fr) * LDR + 32 * ks + 8 * fq);
                o[et] = __builtin_amdgcn_mfma_f32_16x16x32_bf16(sf, qf[ks], o[et], 0, 0, 0);
                if ((et & 7) == 7) __builtin_amdgcn_sched_barrier(0);
            }
        const float wqf = __expf(lgf * (float)(crow + 1)), wqb = __expf(lgb * (float)(128 - crow));
        const float ratio = wqf / wqb;
#pragma unroll
        for (int et = 0; et < 16; ++et) o[et] = o[et] * ratio;
        __syncthreads();
#pragma unroll
        for (int it = 0; it < 8; ++it) { const int idx = tid + it * 512, e = idx >> 4, pc = idx & 15;
            *(LAS u32x4*)(BG + e * LDR + pc * 8) = *(const u32x4*)(sbp + (size_t)e * 128 + pc * 8); }
        __syncthreads();
#pragma unroll
        for (int ks = 0; ks < 4; ++ks)
#pragma unroll
            for (int et = 0; et < 16; ++et) {
                const bf16x8 sf = *(const LAS bf16x8*)(BG + (16 * et + fr) * LDR + 32 * ks + 8 * fq);
                o[et] = __builtin_amdgcn_mfma_f32_16x16x32_bf16(sf, qf[ks], o[et], 0, 0, 0);
                if ((et & 7) == 7) __builtin_amdgcn_sched_barrier(0);
            }
#pragma unroll
        for (int et = 0; et < 16; ++et) o[et] = o[et] * wqb;
        __syncthreads();
        {
            const int st_s = tid & 127, st_hi = tid >> 7;
#pragma unroll
            for (int it = 0; it < 8; ++it) {
                const int e0 = (st_hi + 4 * it) * 8;
                const u32x4 vw = *(const u32x4*)(vb + (size_t)(r0 + st_s) * 1024 + h * 256 + e0);
                BG[(e0 + 0) * LDR + st_s] = (bf16_t)(vw.x & 0xFFFFu); BG[(e0 + 1) * LDR + st_s] = (bf16_t)(vw.x >> 16);
                BG[(e0 + 2) * LDR + st_s] = (bf16_t)(vw.y & 0xFFFFu); BG[(e0 + 3) * LDR + st_s] = (bf16_t)(vw.y >> 16);
                BG[(e0 + 4) * LDR + st_s] = (bf16_t)(vw.z & 0xFFFFu); BG[(e0 + 5) * LDR + st_s] = (bf16_t)(vw.z >> 16);
                BG[(e0 + 6) * LDR + st_s] = (bf16_t)(vw.w & 0xFFFFu); BG[(e0 + 7) * LDR + st_s] = (bf16_t)(vw.w >> 16);
            }
        }
        __syncthreads();
#pragma unroll
        for (int t = 0; t < 4; ++t)
#pragma unroll
            for (int et = 0; et < 16; ++et) {
                const u32x2 lo = *(const LAS u32x2*)(BG + (16 * et + fr) * LDR + 32 * t + 4 * fq);
                const u32x2 hi = *(const LAS u32x2*)(BG + (16 * et + fr) * LDR + 32 * t + 16 + 4 * fq);
                const u32x4 vw = (u32x4){lo.x, lo.y, hi.x, hi.y};
                o[et] = __builtin_amdgcn_mfma_f32_16x16x32_bf16(__builtin_bit_cast(bf16x8, vw), pf[t], o[et], 0, 0, 0);
                if ((et & 7) == 7) __builtin_amdgcn_sched_barrier(0);
            }
        float ss = 0.f;
#pragma unroll
        for (int et = 0; et < 16; ++et) ss += (o[et][0] * o[et][0] + o[et][1] * o[et][1]) + (o[et][2] * o[et][2] + o[et][3] * o[et][3]);
        ss += __shfl_xor(ss, 16); ss += __shfl_xor(ss, 32);
        const float rn = rsqrtf(ss * (1.0f / 256.0f) + EPS);
        bf16_t* gp = sg + (size_t)(r0 + crow) * 1024 + h * 256 + 4 * fq;
#pragma unroll
        for (int et = 0; et < 16; ++et) {
            const u32x2 gw = *(const u32x2*)(gp + 16 * et);
            u32x2 ow; ow.x = cvt_pk_bf16(o[et][0] * rn * bflo(gw.x), o[et][1] * rn * bfhi(gw.x)); ow.y = cvt_pk_bf16(o[et][2] * rn * bflo(gw.y), o[et][3] * rn * bfhi(gw.y));
            *(u32x2*)(gp + 16 * et) = ow;
        }
    }
    __syncthreads();
}

__device__ __forceinline__ void final_norm(const Args& a) {
    const int wave = threadIdx.x >> 6, lane = threadIdx.x & 63;
    const float* ssq = (const float*)(a.ws + OFF_SSQ2);
    for (int row = blockIdx.x * 8 + wave; row < NREAL; row += gridDim.x * 8) {
        const float part = lane < 16 ? ssq[(size_t)row * 16 + lane] : 0.f;
        const float rstd = rsqrtf(wave_sum(part) * (1.0f / 1024.0f) + EPS);
        float* orow = a.out + (size_t)row * 1024;
#pragma unroll
        for (int j = 0; j < 4; ++j) {
            f32x4 v = *(const f32x4*)(orow + (j * 64 + lane) * 4);
            const f32x4 gg = *(const f32x4*)(a.in[20] + (j * 64 + lane) * 4);
            v[0] *= rstd * gg[0]; v[1] *= rstd * gg[1]; v[2] *= rstd * gg[2]; v[3] *= rstd * gg[3];
            *(f32x4*)(orow + (j * 64 + lane) * 4) = v;
        }
    }
}

template <int ph>
__device__ __forceinline__ void run_phase(const Args& a, LAS unsigned char* lds) {
    unsigned char* ws = a.ws;
    bf16_t* dob = (bf16_t*)a.out;
    bf16_t* sgp = dob; bf16_t* gap = dob + (size_t)NREAL * 1024;
#ifdef ONLY_PH
    if (ph != ONLY_PH) return;
#endif
    switch (ph) {
    case 0: phase0(a, lds); break;
    case 1: {
        pg8::Gemm g{(const bf16_t*)(ws + OFF_N1), (const bf16_t*)(ws + OFF_WIN), 1024, 1024, 1024, RPAD / 256, INW / 256, 1, 0, 0};
        EpiProj E{(bf16_t*)(ws + OFF_U5), (bf16_t*)(ws + OFF_Q), (bf16_t*)(ws + OFF_K), (bf16_t*)(ws + OFF_V), sgp, gap, (bf16_t*)(ws + OFF_GB), (const LAS double*)(lds + 131072)};
        pg8::gemm_phase(lds, g, E);
    } break;
    case 2: {
        pg8::Gemm g{(const bf16_t*)(ws + OFF_U5), (const bf16_t*)(ws + OFF_BTS), LDA5, 512, 512, IT_PAD / 256, 1, 32, (size_t)IT_PAD * LDA5, (size_t)256 * 512};
        EpiSloc E{(float*)(ws + OFF_SLOC)};
        pg8::gemm_phase(lds, g, E);
    } break;
    case 3: s5_scan(a); break;
    case 4: {
        pg8::Gemm g{(const bf16_t*)(ws + OFF_U5), (const bf16_t*)(ws + OFF_BTY), LDA5, 768, 768, IT_PAD / 256, 2, 32, (size_t)IT_PAD * LDA5, (size_t)512 * 768};
        EpiY E{(bf16_t*)(ws + OFF_YSSM)};
        pg8::gemm_phase(lds, g, E);
    } break;
    case 5: {
        pg8::Gemm g{(const bf16_t*)(ws + OFF_YSSM), (const bf16_t*)(ws + OFF_WGLU), 512, 512, 512, NREAL / 256, 8, 1, 0, 0};
        EpiGlu E{gap};
        pg8::gemm_phase(lds, g, E);
    } break;
    case 6: ret_pass_a(a, lds); break;
    case 7: ret_pass_b(a, lds); break;
    case 8: {
        pg8::Gemm g{sgp, (const bf16_t*)(ws + OFF_WRET), 1024, 1024, 1024, NREAL / 256, 4, 1, 0, 0};
        EpiRet E{gap, (const bf16_t*)(ws + OFF_GB), (bf16_t*)(ws + OFF_MIXED)};
        pg8::gemm_phase(lds, g, E);
    } break;
    case 9: {
        pg8::Gemm g{(const bf16_t*)(ws + OFF_MIXED), (const bf16_t*)(ws + OFF_WOUT), 1024, 1024, 1024, NREAL / 256, 4, 1, 0, 0};
        EpiRes<0> E{a.in[0], a.in[1], a.out, (bf16_t*)(ws + OFF_H1B), (float*)(ws + OFF_SSQ1)};
        pg8::gemm_phase(lds, g, E);
    } break;
    case 10: {
        pg8::Gemm g{(const bf16_t*)(ws + OFF_H1B), (const bf16_t*)(ws + OFF_WFFI), 1024, 1024, 1024, NREAL / 256, INW / 256, 1, 0, 0};
        EpiFfi E{(const float*)(ws + OFF_SSQ1), (bf16_t*)(ws + OFF_ACT)};
        pg8::gemm_phase(lds, g, E);
    } break;
    case 11: {
        pg8::Gemm g{(const bf16_t*)(ws + OFF_ACT), (const bf16_t*)(ws + OFF_WFFO), DFF, DFF, DFF, NREAL / 256, 4, 1, 0, 0};
        EpiRes<1> E{nullptr, nullptr, a.out, nullptr, (float*)(ws + OFF_SSQ2)};
        pg8::gemm_phase(lds, g, E);
    } break;
    case 12: final_norm(a); break;
    default: break;
    }
}

__device__ __forceinline__ void grid_barrier(unsigned* ctr, unsigned target) {
    asm volatile("s_waitcnt vmcnt(0) lgkmcnt(0)" ::: "memory");
    __syncthreads();
    if (threadIdx.x == 0) {
        __builtin_amdgcn_fence(__ATOMIC_RELEASE, "agent");
        asm volatile("s_waitcnt vmcnt(0)" ::: "memory");
        __hip_atomic_fetch_add(ctr, 1u, __ATOMIC_RELAXED, __HIP_MEMORY_SCOPE_AGENT);
        unsigned spins = 0;
        while (__hip_atomic_load(ctr, __ATOMIC_RELAXED, __HIP_MEMORY_SCOPE_AGENT) < target && ++spins < (1u << 24)) __builtin_amdgcn_s_sleep(2);
        __builtin_amdgcn_fence(__ATOMIC_ACQUIRE, "agent");
        asm volatile("s_waitcnt vmcnt(0)" ::: "memory");
    }
    __syncthreads();
}

template <bool COOP>
__global__ __launch_bounds__(512, 2) void fwd_kernel(Args a) {
    extern __shared__ __attribute__((aligned(16))) unsigned char shm[];
    LAS unsigned char* lds = (LAS unsigned char*)shm;
    if (threadIdx.x < 64) ((LAS double*)(lds + 131072))[threadIdx.x] = exp2(-(double)threadIdx.x * (13.287712379549449 / 64.0));
    __syncthreads();
#define RUN_PH(P) if (a.ph_lo <= P && P < a.ph_hi) { run_phase<P>(a, lds); if (COOP && P + 1 < a.ph_hi) { if (P == 0) { __threadfence(); cg::this_grid().sync(); } else grid_barrier((unsigned*)(a.ws + OFF_BAR), (unsigned)P * gridDim.x); } }
    RUN_PH(0) RUN_PH(1) RUN_PH(2) RUN_PH(3) RUN_PH(4) RUN_PH(5) RUN_PH(6) RUN_PH(7) RUN_PH(8) RUN_PH(9) RUN_PH(10) RUN_PH(11) RUN_PH(12)
#undef RUN_PH
}

extern "C" void kernel_launch(void* const* d_in, const int* in_sizes, int n_in, void* d_out, int out_size, void* d_ws, size_t ws_size, hipStream_t stream) {
    static int grid = 0;
    if (grid == 0) {
        if (n_in != 21 || ws_size < WS_NEED || out_size != NREAL * 1024) { fprintf(stderr, "kernel_launch: unexpected shapes (n_in %d, ws %zu need %zu, out %d)\n", n_in, ws_size, (size_t)WS_NEED, out_size); grid = -1; return; }
        int dev = 0, cus = 0;
        hipGetDevice(&dev); hipDeviceGetAttribute(&cus, hipDeviceAttributeMultiprocessorCount, dev);
        hipFuncSetAttribute((const void*)fwd_kernel<true>, hipFuncAttributeMaxDynamicSharedMemorySize, LDS_BYTES);
        hipFuncSetAttribute((const void*)fwd_kernel<false>, hipFuncAttributeMaxDynamicSharedMemorySize, LDS_BYTES);
        int per_cu = 0;
        hipOccupancyMaxActiveBlocksPerMultiprocessor(&per_cu, (const void*)fwd_kernel<true>, 512, LDS_BYTES);
        if (per_cu < 1) { fprintf(stderr, "kernel_launch: occupancy query says %d blocks per CU\n", per_cu); per_cu = 1; }
        (void)hipGetLastError();
        grid = cus * 1;
    }
    if (grid < 0) return;
    Args a{};
    for (int i = 0; i < 21; ++i) a.in[i] = (const float*)d_in[i];
    a.out = (float*)d_out; a.ws = (unsigned char*)d_ws;
#if COOP_MODE
    hipMemsetAsync((char*)d_ws + OFF_BAR, 0, 256, stream);
    a.ph_lo = 0; a.ph_hi = NPHASE;
    void* args[] = {&a};
    hipError_t e = hipLaunchCooperativeKernel((const void*)fwd_kernel<true>, dim3(grid), dim3(512), args, LDS_BYTES, stream);
    if (e != hipSuccess) fprintf(stderr, "cooperative launch failed: %s (grid %d)\n", hipGetErrorString(e), grid);
#else
    for (int ph = 0; ph < NPHASE; ++ph) {
        a.ph_lo = ph; a.ph_hi = ph + 1;
        hipLaunchKernelGGL(fwd_kernel<false>, dim3(grid), dim3(512), LDS_BYTES, stream, a);
    }
#endif
}
```

```cpp
#include <hip/hip_runtime.h>
#include <hip/hip_cooperative_groups.h>
#include <cstdio>
#include <cstdint>
namespace cg = cooperative_groups;

#ifndef COOP_MODE
#define COOP_MODE 1
#endif

#define DBL_MASK 0x0
#define LAS __attribute__((address_space(3)))
typedef unsigned short bf16_t;
typedef short bf16x8 __attribute__((ext_vector_type(8)));
typedef float f32x4 __attribute__((ext_vector_type(4)));
typedef unsigned u32x4 __attribute__((ext_vector_type(4)));
typedef unsigned u32x2 __attribute__((ext_vector_type(2)));

constexpr int D = 1024, NREAL = 81920, NPR = 65536, RPAD = 82432, NVALID = 82304;
constexpr int INW = 5632, DFF = 2816;
constexpr int T5 = 32, IT_REAL = 2560, IT_PAD = 2816, LDA5 = 768;
constexpr float EPS = 1e-6f;

constexpr size_t OFF_WIN = 0;
constexpr size_t OFF_WGLU = OFF_WIN + (size_t)INW * D * 2;
constexpr size_t OFF_WRET = OFF_WGLU + (size_t)2048 * 512 * 2;
constexpr size_t OFF_WOUT = OFF_WRET + (size_t)D * D * 2;
constexpr size_t OFF_WFFI = OFF_WOUT + (size_t)D * D * 2;
constexpr size_t OFF_WFFO = OFF_WFFI + (size_t)INW * D * 2;
constexpr size_t OFF_AT = OFF_WFFO + (size_t)D * DFF * 2;
constexpr size_t OFF_BAR = OFF_AT + 32768;
constexpr size_t OFF_Q = OFF_AT + 65536;
constexpr size_t OFF_K = OFF_Q + (size_t)RPAD * 512 * 2;
constexpr size_t OFF_V = OFF_K + (size_t)RPAD * 512 * 2;
constexpr size_t OFF_GB = OFF_V + (size_t)RPAD * D * 2;
constexpr size_t OFF_SSQ1 = OFF_GB + (size_t)NREAL * D * 2;
constexpr size_t OFF_SSQ2 = OFF_SSQ1 + (size_t)NREAL * 16 * 4;
constexpr size_t OFF_X = OFF_SSQ2 + (size_t)NREAL * 16 * 4;
constexpr size_t OFF_N1 = OFF_X;
constexpr size_t OFF_YSSM = OFF_X;
constexpr size_t OFF_U5 = OFF_N1 + (size_t)RPAD * D * 2;
constexpr size_t OFF_BTY = OFF_U5 + (size_t)32 * IT_PAD * LDA5 * 2;
constexpr size_t OFF_BTS = OFF_BTY + (size_t)32 * 512 * 768 * 2;
constexpr size_t OFF_SLOC = OFF_BTS + (size_t)32 * 256 * 512 * 2;
constexpr size_t END_X03 = OFF_SLOC + (size_t)32 * IT_PAD * 256 * 4;
constexpr size_t OFF_ST = OFF_X;
constexpr size_t END_ST = OFF_ST + (size_t)664 * 8 * 65536;
constexpr size_t OFF_ACT = OFF_X;
constexpr size_t END_ACT = OFF_ACT + (size_t)NREAL * DFF * 2;
constexpr size_t OFF_MIXED = OFF_Q;
constexpr size_t OFF_H1B = OFF_V;
constexpr size_t cmax(size_t a, size_t b) { return a > b ? a : b; }
constexpr size_t WS_NEED = cmax(END_X03, cmax(END_ST, END_ACT));

constexpr int LDS_BYTES = 131072 + 1024;
constexpr int NPHASE = 13;
constexpr int STG = 0;

struct Args {
    const float* in[21];
    float* out;
    unsigned char* ws;
    int ph_lo, ph_hi;
};

__device__ __forceinline__ unsigned cvt_pk_bf16(float lo, float hi) { unsigned r; asm volatile("v_cvt_pk_bf16_f32 %0, %1, %2" : "=v"(r) : "v"(lo), "v"(hi)); return r; }
__device__ __forceinline__ bf16_t f2bf(float f) { return (bf16_t)(cvt_pk_bf16(f, 0.f) & 0xFFFFu); }
__device__ __forceinline__ float bflo(unsigned w) { return __uint_as_float(w << 16); }
__device__ __forceinline__ float bfhi(unsigned w) { return __uint_as_float(w & 0xFFFF0000u); }
__device__ __forceinline__ float sigmoidf_(float x) { return __fdividef(1.0f, 1.0f + __expf(-x)); }
__device__ __forceinline__ float siluf_(float x) { return x * sigmoidf_(x); }
__device__ __forceinline__ float gelu_tanh(float x) { const float z = 0.7978845608028654f * (x + 0.044715f * x * x * x); return x * sigmoidf_(2.0f * z); }
__device__ __forceinline__ float logsigf_(float x) { return fminf(x, 0.f) - log1pf(__expf(-fabsf(x))); }
__device__ __forceinline__ float wave_sum(float v) {
#pragma unroll
    for (int o = 1; o < 64; o <<= 1) v += __shfl_xor(v, o);
    return v;
}
__device__ __forceinline__ void sincos_rev(double ang, float& s, float& c) {
    double x = ang * 0.15915494309189535; x -= rint(x);
    const float xf = (float)x;
    s = __builtin_amdgcn_sinf(xf); c = __builtin_amdgcn_cosf(xf);
}

namespace pg8 {
constexpr int BM = 256, BK = 64, HALF = 128, HTB = HALF * BK * 2, STAGE_BYTES = 8 * HTB, NXCD = 8, WGM = 8;
__device__ __forceinline__ int lds_byte(int r, int c) { const int st = (r >> 4) * 2 + (c >> 5), rr = r & 15, cc = c & 31, ob = rr * 64 + cc * 2; return st * 1024 + (ob ^ (((ob >> 9) & 1) << 5)); }
__device__ __forceinline__ void stage_rc(int b, int& R, int& C) { const int st = b / 1024, sb = b % 1024, swz = sb ^ (((sb >> 9) & 1) << 5); R = (st >> 1) * 16 + swz / 64; C = (st & 1) * 32 + (swz % 64) / 2; }
__device__ __forceinline__ int perm32(int rho) { const int n = rho >> 4, i = rho & 15; return 8 * (i >> 2) + 4 * n + (i & 3); }

struct Unit { int pm, pn, g; };
struct Gemm { const bf16_t* A; const bf16_t* Bt; int lda, ldb, K, nM, nN, nb; size_t sA, sB; int stagger; };

struct Order {
    int nM, nN, nwg, total, G, c;
    __device__ void init(int nM_, int nN_, int nb, int G_, int c_) { nM = nM_; nN = nN_; nwg = nM * nN; total = nwg * nb; G = G_; c = c_; }
    __device__ bool next(int i, Unit& u) const {
        const long L = (long)i * G + c; if (L >= total) return false;
        u.g = (int)(L / nwg); int wgid = (int)(L % nwg);
        { const int q = nwg / NXCD, r = nwg % NXCD, xcd = wgid % NXCD, off = wgid / NXCD; wgid = (xcd < r ? xcd * (q + 1) : r * (q + 1) + (xcd - r) * q) + off; }
        const int nig = WGM * nN, gid = wgid / nig, fm = gid * WGM, gsz = (nM - fm) < WGM ? (nM - fm) : WGM;
        u.pm = fm + ((wgid % nig) % gsz); u.pn = (wgid % nig) / gsz; return true;
    }
};

template <class Epi>
__device__ __forceinline__ void gemm_phase(LAS unsigned char* lds, const Gemm g, const Epi& E) {
    const int tid = threadIdx.x, wid = __builtin_amdgcn_readfirstlane(tid >> 6), lane = tid & 63, wr = wid >> 2, wc = wid & 3, fr = lane & 15, fq = lane >> 4;
    const int K = g.K, nt = K / BK;
    Order S; S.init(g.nM, g.nN, g.nb, (int)gridDim.x, (int)blockIdx.x);
    unsigned voffA[2], voffB[2];
#pragma unroll
    for (int i = 0; i < 2; ++i) { int R, C; stage_rc(tid * 16 + i * 8192, R, C); const int Rb = (R & ~31) + perm32(R & 31);
        voffA[i] = (unsigned)(R * g.lda + C) * 2u; voffB[i] = (unsigned)(Rb * g.ldb + C) * 2u; }
    const size_t kstep = (size_t)(BK * 2);
    const size_t hstepA = (size_t)HALF * g.lda * 2, hstepB = (size_t)HALF * g.ldb * 2;
    const size_t tstepA = 2 * hstepA, tstepB = 2 * hstepB;
    const unsigned ldsw = (unsigned)wid * 1024u;
    const int aoff = lds_byte(wr * 64 + fr, fq * 8), boff = lds_byte(wc * 32 + fr, fq * 8);
#define PG8_SA(b, h) (((b) * 2 + (h)) * HTB)
#define PG8_SB(b, h) ((4 + (b) * 2 + (h)) * HTB)
#define PG8_STAGE(bufoff, gbase, voff) do { _Pragma("unroll") for (int _i = 0; _i < 2; ++_i) \
        __builtin_amdgcn_global_load_lds((const unsigned*)((const char*)(gbase) + (voff)[_i]), (LAS unsigned*)(lds + (bufoff) + ldsw + _i * 8192), 16, 0, 0); } while (0)
#define PG8_LDA(dst, b, h) do { _Pragma("unroll") for (int m = 0; m < 4; ++m) _Pragma("unroll") for (int k = 0; k < 2; ++k) dst[m][k] = *(const LAS bf16x8*)(lds + PG8_SA(b, h) + aoff + m * 2048 + k * 1024); } while (0)
#define PG8_LDB(dst, b, h) do { _Pragma("unroll") for (int n = 0; n < 2; ++n) _Pragma("unroll") for (int k = 0; k < 2; ++k) dst[n][k] = *(const LAS bf16x8*)(lds + PG8_SB(b, h) + boff + n * 2048 + k * 1024); } while (0)
#define PG8_MMA(ai, bj, At, Bt) do { __builtin_amdgcn_s_setprio(1); _Pragma("unroll") for (int m = 0; m < 4; ++m) _Pragma("unroll") for (int n = 0; n < 2; ++n) _Pragma("unroll") for (int k = 0; k < 2; ++k) \
        acc[ai][bj][m][n] = __builtin_amdgcn_mfma_f32_16x16x32_bf16(Bt[n][k], At[m][k], acc[ai][bj][m][n], 0, 0, 0); __builtin_amdgcn_s_setprio(0); } while (0)
#define PG8_WAIT_V(n) asm volatile("s_waitcnt vmcnt(" #n ")" ::: "memory")
#define PG8_WAIT_L(n) asm volatile("s_waitcnt lgkmcnt(" #n ")" ::: "memory")
#define PG8_BAR __builtin_amdgcn_s_barrier()
#define PG8_SCHED __builtin_amdgcn_sched_barrier(0)
    Unit cur, nxt; int ui = 0;
    if (!S.next(0, cur)) return;
    if (g.stagger) {
        const unsigned long long t0 = __builtin_amdgcn_s_memrealtime(), wt = (unsigned long long)((blockIdx.x & 3) * g.stagger);
        while (__builtin_amdgcn_s_memrealtime() - t0 < wt) __builtin_amdgcn_s_sleep(16);
    }
    f32x4 acc[2][2][4][2];
#pragma unroll
    for (int a = 0; a < 2; ++a)
#pragma unroll
        for (int b = 0; b < 2; ++b)
#pragma unroll
            for (int m = 0; m < 4; ++m)
#pragma unroll
                for (int n = 0; n < 2; ++n) acc[a][b][m][n] = (f32x4){0.f, 0.f, 0.f, 0.f};
    bf16x8 At[4][2], B0[2][2], B1[2][2];
    const char* cA = (const char*)g.A + ((size_t)cur.g * g.sA) * 2 + (size_t)cur.pm * tstepA;
    const char* cB = (const char*)g.Bt + ((size_t)cur.g * g.sB) * 2 + (size_t)cur.pn * tstepB;
    PG8_STAGE(PG8_SB(0, 0), cB, voffB); PG8_STAGE(PG8_SA(0, 0), cA, voffA); PG8_STAGE(PG8_SB(0, 1), cB + hstepB, voffB); PG8_STAGE(PG8_SA(0, 1), cA + hstepA, voffA);
    if (wr == 1) PG8_BAR;
    PG8_WAIT_V(4); PG8_BAR;
    PG8_STAGE(PG8_SB(1, 0), cB + kstep, voffB); PG8_STAGE(PG8_SA(1, 0), cA + kstep, voffA); PG8_STAGE(PG8_SB(1, 1), cB + hstepB + kstep, voffB);
    PG8_WAIT_V(6); PG8_BAR;
    for (;;) {
        const bool has_next = S.next(ui + 1, nxt);
        const char* nA = has_next ? (const char*)g.A + ((size_t)nxt.g * g.sA) * 2 + (size_t)nxt.pm * tstepA : cA;
        const char* nB = has_next ? (const char*)g.Bt + ((size_t)nxt.g * g.sB) * 2 + (size_t)nxt.pn * tstepB : cB;
        for (int t = 0; t < nt; t += 2) {
            const bool last = (t == nt - 2);
            const char* a1 = cA + (size_t)(t + 1) * kstep;
            const char* a2 = last ? nA : cA + (size_t)(t + 2) * kstep; const char* b2 = last ? nB : cB + (size_t)(t + 2) * kstep;
            const char* a3 = a2 + kstep; const char* b3 = b2 + kstep;
            PG8_LDB(B0, 0, 0); PG8_SCHED; PG8_LDA(At, 0, 0); PG8_STAGE(PG8_SA(1, 1), a1 + hstepA, voffA);
            PG8_WAIT_L(8); PG8_BAR; PG8_WAIT_L(0); PG8_MMA(0, 0, At, B0); PG8_BAR; PG8_SCHED;
            PG8_LDB(B1, 0, 1); PG8_STAGE(PG8_SB(0, 0), b2, voffB);
            PG8_BAR; PG8_WAIT_L(0); PG8_MMA(0, 1, At, B1); PG8_BAR;
            PG8_LDA(At, 0, 1); PG8_STAGE(PG8_SA(0, 0), a2, voffA);
            PG8_BAR; PG8_WAIT_L(0); PG8_MMA(1, 0, At, B0); PG8_BAR; PG8_SCHED;
            PG8_STAGE(PG8_SB(0, 1), b2 + hstepB, voffB);
            PG8_WAIT_V(6); PG8_BAR; PG8_MMA(1, 1, At, B1); PG8_BAR;
            PG8_LDB(B0, 1, 0); PG8_SCHED; PG8_LDA(At, 1, 0); PG8_STAGE(PG8_SA(0, 1), a2 + hstepA, voffA);
            PG8_WAIT_L(8); PG8_BAR; PG8_WAIT_L(0); PG8_MMA(0, 0, At, B0); PG8_BAR; PG8_SCHED;
            PG8_LDB(B1, 1, 1); PG8_STAGE(PG8_SB(1, 0), b3, voffB);
            PG8_BAR; PG8_WAIT_L(0); PG8_MMA(0, 1, At, B1); PG8_BAR;
            PG8_LDA(At, 1, 1); PG8_STAGE(PG8_SA(1, 0), a3, voffA);
            PG8_BAR; PG8_WAIT_L(0); PG8_MMA(1, 0, At, B0); PG8_BAR; PG8_SCHED;
            PG8_STAGE(PG8_SB(1, 1), b3 + hstepB, voffB);
            PG8_WAIT_V(6); PG8_BAR; PG8_MMA(1, 1, At, B1); PG8_BAR;
        }
        E(acc, cur, wr, wc, fr, fq);
        if (!has_next) break;
#pragma unroll
        for (int a = 0; a < 2; ++a)
#pragma unroll
            for (int b = 0; b < 2; ++b)
#pragma unroll
                for (int m = 0; m < 4; ++m)
#pragma unroll
                    for (int n = 0; n < 2; ++n) acc[a][b][m][n] = (f32x4){0.f, 0.f, 0.f, 0.f};
        cur = nxt; cA = nA; cB = nB; ++ui;
    }
    PG8_WAIT_V(0);
    if (wr == 0) PG8_BAR;
    PG8_BAR;
#undef PG8_SA
#undef PG8_SB
#undef PG8_STAGE
#undef PG8_LDA
#undef PG8_LDB
#undef PG8_MMA
#undef PG8_WAIT_V
#undef PG8_WAIT_L
#undef PG8_BAR
#undef PG8_SCHED
}
}
using pg8::Unit;
typedef const f32x4 (&AccRef)[2][2][4][2];

__device__ __forceinline__ u32x4 pack8(f32x4 a, f32x4 b) { u32x4 w; w.x = cvt_pk_bf16(a[0], a[1]); w.y = cvt_pk_bf16(a[2], a[3]); w.z = cvt_pk_bf16(b[0], b[1]); w.w = cvt_pk_bf16(b[2], b[3]); return w; }

struct EpiProj {
    bf16_t *u5, *q, *k, *v, *sg, *ga, *gb; const LAS double* ropef;
    __device__ __forceinline__ void operator()(AccRef acc, const Unit& u, int wr, int wc, int fr, int fq) const {
        const int pn = u.pn;
#pragma unroll
        for (int ai = 0; ai < 2; ++ai)
#pragma unroll
            for (int m = 0; m < 4; ++m) {
                const int row = u.pm * 256 + ai * 128 + wr * 64 + m * 16 + fr;
#pragma unroll
                for (int bj = 0; bj < 2; ++bj) {
                    const int col = pn * 256 + bj * 128 + wc * 32 + 8 * fq;
                    f32x4 v0 = acc[ai][bj][m][0], v1 = acc[ai][bj][m][1];
                    if (pn < 2) {
                        if (row < NVALID) {
                            int item, t;
                            if (row < NREAL) { item = row >> 5; t = row & 31; } else { const int mr = row - NREAL; item = IT_REAL + (mr >> 4); t = 16 + (mr & 15); }
                            const int g = col >> 4, h0 = col & 15;
                            *(u32x4*)(u5 + ((size_t)(g * IT_PAD + item) * LDA5 + t * 16 + h0)) = pack8(v0, v1);
                        }
                    } else if (pn < 6) {
                        const int cq = col - 512, isk = cq >> 9, cc = cq & 511, i0 = (cc & 127) >> 1;
                        const int pos = row < NPR ? 16 + (row & 4095) : (row < NREAL ? 16 + ((row - NPR) & 2047) : ((row - NREAL) & 15));
                        const float sc = isk ? 1.0f : 0.08838834764831845f;
                        float o[8];
#pragma unroll
                        for (int pi = 0; pi < 4; ++pi) {
                            float s, c; sincos_rev((double)pos * ropef[i0 + pi], s, c);
                            const float x1 = pi < 2 ? v0[2 * pi] : v1[2 * pi - 4], x2 = pi < 2 ? v0[2 * pi + 1] : v1[2 * pi - 3];
                            o[2 * pi] = (x1 * c - x2 * s) * sc; o[2 * pi + 1] = (x1 * s + x2 * c) * sc;
                        }
                        u32x4 w; w.x = cvt_pk_bf16(o[0], o[1]); w.y = cvt_pk_bf16(o[2], o[3]); w.z = cvt_pk_bf16(o[4], o[5]); w.w = cvt_pk_bf16(o[6], o[7]);
                        *(u32x4*)((isk ? k : q) + (size_t)row * 512 + cc) = w;
                    } else if (pn < 10) {
                        *(u32x4*)(v + (size_t)row * 1024 + (col - 1536)) = pack8(v0, v1);
                    } else if (row < NREAL) {
                        if (pn < 14) {
#pragma unroll
                            for (int j = 0; j < 4; ++j) { v0[j] = siluf_(v0[j]); v1[j] = siluf_(v1[j]); }
                            *(u32x4*)(sg + (size_t)row * 1024 + (col - 2560)) = pack8(v0, v1);
                        } else {
#pragma unroll
                            for (int j = 0; j < 4; ++j) { v0[j] = sigmoidf_(v0[j]); v1[j] = sigmoidf_(v1[j]); }
                            if (pn < 18) *(u32x4*)(ga + (size_t)row * 1024 + (col - 3584)) = pack8(v0, v1);
                            else *(u32x4*)(gb + (size_t)row * 1024 + (col - 4608)) = pack8(v0, v1);
                        }
                    }
                }
            }
    }
};

struct EpiSink {
    float* p; int flag;
    __device__ __forceinline__ void operator()(AccRef acc, const Unit& u, int wr, int wc, int fr, int fq) const {
        if (flag) {
#pragma unroll
            for (int ai = 0; ai < 2; ++ai)
#pragma unroll
                for (int m = 0; m < 4; ++m)
#pragma unroll
                    for (int bj = 0; bj < 2; ++bj) { p[(ai * 8 + m * 2 + bj) * 8 + fr] = acc[ai][bj][m][0][0] + acc[ai][bj][m][1][1]; }
        }
    }
};

struct EpiSloc {
    float* sloc;
    __device__ __forceinline__ void operator()(AccRef acc, const Unit& u, int wr, int wc, int fr, int fq) const {
#pragma unroll
        for (int ai = 0; ai < 2; ++ai)
#pragma unroll
            for (int m = 0; m < 4; ++m) {
                const int row = u.pm * 256 + ai * 128 + wr * 64 + m * 16 + fr;
#pragma unroll
                for (int bj = 0; bj < 2; ++bj) {
                    const int col = bj * 128 + wc * 32 + 8 * fq;
                    float* p = sloc + ((size_t)u.g * IT_PAD + row) * 256 + col;
                    *(f32x4*)p = acc[ai][bj][m][0]; *(f32x4*)(p + 4) = acc[ai][bj][m][1];
                }
            }
    }
};

struct EpiY {
    bf16_t* y;
    __device__ __forceinline__ void operator()(AccRef acc, const Unit& u, int wr, int wc, int fr, int fq) const {
#pragma unroll
        for (int ai = 0; ai < 2; ++ai)
#pragma unroll
            for (int m = 0; m < 4; ++m) {
                const int item = u.pm * 256 + ai * 128 + wr * 64 + m * 16 + fr;
                if (item < IT_REAL) {
#pragma unroll
                    for (int bj = 0; bj < 2; ++bj) {
                        const int col = u.pn * 256 + bj * 128 + wc * 32 + 8 * fq, to = col >> 4, ho = col & 15;
                        f32x4 v0 = acc[ai][bj][m][0], v1 = acc[ai][bj][m][1];
#pragma unroll
                        for (int j = 0; j < 4; ++j) { v0[j] = gelu_tanh(v0[j]); v1[j] = gelu_tanh(v1[j]); }
                        *(u32x4*)(y + (size_t)(item * 32 + to) * 512 + u.g * 16 + ho) = pack8(v0, v1);
                    }
                }
            }
    }
};

struct EpiGlu {
    bf16_t* ga;
    __device__ __forceinline__ void operator()(AccRef acc, const Unit& u, int wr, int wc, int fr, int fq) const {
        u32x4 gw[2][4];
#pragma unroll
        for (int ai = 0; ai < 2; ++ai)
#pragma unroll
            for (int m = 0; m < 4; ++m) {
                const int row = u.pm * 256 + ai * 128 + wr * 64 + m * 16 + fr;
                gw[ai][m] = *(const u32x4*)(ga + (size_t)row * 1024 + u.pn * 128 + wc * 32 + 8 * fq);
            }
#pragma unroll
        for (int ai = 0; ai < 2; ++ai)
#pragma unroll
            for (int m = 0; m < 4; ++m) {
                const int row = u.pm * 256 + ai * 128 + wr * 64 + m * 16 + fr;
                bf16_t* p = ga + (size_t)row * 1024 + u.pn * 128 + wc * 32 + 8 * fq;
                const u32x4 g = gw[ai][m];
                const f32x4 a0 = acc[ai][0][m][0], a1 = acc[ai][0][m][1], g0 = acc[ai][1][m][0], g1 = acc[ai][1][m][1];
                f32x4 r0, r1;
                r0[0] = bflo(g.x) * a0[0] * sigmoidf_(g0[0]); r0[1] = bfhi(g.x) * a0[1] * sigmoidf_(g0[1]);
                r0[2] = bflo(g.y) * a0[2] * sigmoidf_(g0[2]); r0[3] = bfhi(g.y) * a0[3] * sigmoidf_(g0[3]);
                r1[0] = bflo(g.z) * a1[0] * sigmoidf_(g1[0]); r1[1] = bfhi(g.z) * a1[1] * sigmoidf_(g1[1]);
                r1[2] = bflo(g.w) * a1[2] * sigmoidf_(g1[2]); r1[3] = bfhi(g.w) * a1[3] * sigmoidf_(g1[3]);
                *(u32x4*)p = pack8(r0, r1);
            }
    }
};

struct EpiRet {
    const bf16_t *pa, *gb; bf16_t* mixed;
    __device__ __forceinline__ void operator()(AccRef acc, const Unit& u, int wr, int wc, int fr, int fq) const {
#pragma unroll
        for (int ai = 0; ai < 2; ++ai) {
            u32x4 pw[4][2], gw[4][2];
#pragma unroll
            for (int m = 0; m < 4; ++m)
#pragma unroll
                for (int bj = 0; bj < 2; ++bj) {
                    const int row = u.pm * 256 + ai * 128 + wr * 64 + m * 16 + fr;
                    const size_t o = (size_t)row * 1024 + u.pn * 256 + bj * 128 + wc * 32 + 8 * fq;
                    pw[m][bj] = *(const u32x4*)(pa + o); gw[m][bj] = *(const u32x4*)(gb + o);
                }
#pragma unroll
            for (int m = 0; m < 4; ++m)
#pragma unroll
                for (int bj = 0; bj < 2; ++bj) {
                    const int row = u.pm * 256 + ai * 128 + wr * 64 + m * 16 + fr;
                    const size_t o = (size_t)row * 1024 + u.pn * 256 + bj * 128 + wc * 32 + 8 * fq;
                    const u32x4 p = pw[m][bj], g = gw[m][bj];
                    const f32x4 a0 = acc[ai][bj][m][0], a1 = acc[ai][bj][m][1];
                    f32x4 r0, r1;
                    r0[0] = bflo(p.x) + bflo(g.x) * a0[0]; r0[1] = bfhi(p.x) + bfhi(g.x) * a0[1];
                    r0[2] = bflo(p.y) + bflo(g.y) * a0[2]; r0[3] = bfhi(p.y) + bfhi(g.y) * a0[3];
                    r1[0] = bflo(p.z) + bflo(g.z) * a1[0]; r1[1] = bfhi(p.z) + bfhi(g.z) * a1[1];
                    r1[2] = bflo(p.w) + bflo(g.w) * a1[2]; r1[3] = bfhi(p.w) + bfhi(g.w) * a1[3];
                    *(u32x4*)(mixed + o) = pack8(r0, r1);
                }
            __builtin_amdgcn_sched_barrier(0);
        }
    }
};

template <int MODE>
struct EpiRes {
    const float *xp, *xs; bf16_t* hb; float* ssq;
    __device__ __forceinline__ void operator()(AccRef acc, const Unit& u, int wr, int wc, int fr, int fq) const {
#pragma unroll
        for (int ai = 0; ai < 2; ++ai) {
            f32x4 x0[4][2], x1[4][2]; u32x4 hw[4][2];
#pragma unroll
            for (int m = 0; m < 4; ++m)
#pragma unroll
                for (int bj = 0; bj < 2; ++bj) {
                    const int row = u.pm * 256 + ai * 128 + wr * 64 + m * 16 + fr, col = u.pn * 256 + bj * 128 + wc * 32 + 8 * fq;
                    if (MODE == 0) {
                        const float* src = (row < NPR ? xp + (size_t)row * 1024 : xs + (size_t)(row - NPR) * 1024) + col;
                        x0[m][bj] = *(const f32x4*)src; x1[m][bj] = *(const f32x4*)(src + 4);
                    } else hw[m][bj] = *(const u32x4*)(hb + (size_t)row * 1024 + col);
                }
#pragma unroll
            for (int m = 0; m < 4; ++m) {
                const int row = u.pm * 256 + ai * 128 + wr * 64 + m * 16 + fr;
                float ss = 0.f;
#pragma unroll
                for (int bj = 0; bj < 2; ++bj) {
                    const int col = u.pn * 256 + bj * 128 + wc * 32 + 8 * fq;
                    f32x4 h0, h1;
                    if (MODE == 0) { h0 = x0[m][bj]; h1 = x1[m][bj]; }
                    else { const u32x4 w = hw[m][bj]; h0 = (f32x4){bflo(w.x), bfhi(w.x), bflo(w.y), bfhi(w.y)}; h1 = (f32x4){bflo(w.z), bfhi(w.z), bflo(w.w), bfhi(w.w)}; }
                    h0 = h0 + acc[ai][bj][m][0]; h1 = h1 + acc[ai][bj][m][1];
                    *(u32x4*)(hb + (size_t)row * 1024 + col) = pack8(h0, h1);
                    ss += (h0[0] * h0[0] + h0[1] * h0[1]) + (h0[2] * h0[2] + h0[3] * h0[3]) + (h1[0] * h1[0] + h1[1] * h1[1]) + (h1[2] * h1[2] + h1[3] * h1[3]);
                }
                ss += __shfl_xor(ss, 16); ss += __shfl_xor(ss, 32);
                if (fq == 0) ssq[(size_t)row * 16 + u.pn * 4 + wc] = ss;
            }
            __builtin_amdgcn_sched_barrier(0);
        }
    }
};

struct EpiFfi {
    const float* ssq; bf16_t* act;
    __device__ __forceinline__ void operator()(AccRef acc, const Unit& u, int wr, int wc, int fr, int fq) const {
        f32x4 sp[2][4];
#pragma unroll
        for (int ai = 0; ai < 2; ++ai)
#pragma unroll
            for (int m = 0; m < 4; ++m) {
                const int row = u.pm * 256 + ai * 128 + wr * 64 + m * 16 + fr;
                sp[ai][m] = *(const f32x4*)(ssq + (size_t)row * 16 + 4 * fq);
            }
#pragma unroll
        for (int ai = 0; ai < 2; ++ai)
#pragma unroll
            for (int m = 0; m < 4; ++m) {
                const int row = u.pm * 256 + ai * 128 + wr * 64 + m * 16 + fr;
                float tot = (sp[ai][m][0] + sp[ai][m][1]) + (sp[ai][m][2] + sp[ai][m][3]);
                tot += __shfl_xor(tot, 16); tot += __shfl_xor(tot, 32);
                const float rstd = rsqrtf(tot * (1.0f / 1024.0f) + EPS);
                const f32x4 g0 = acc[ai][0][m][0], g1 = acc[ai][0][m][1], u0 = acc[ai][1][m][0], u1 = acc[ai][1][m][1];
                f32x4 r0, r1;
#pragma unroll
                for (int j = 0; j < 4; ++j) { r0[j] = siluf_(rstd * g0[j]) * (rstd * u0[j]); r1[j] = siluf_(rstd * g1[j]) * (rstd * u1[j]); }
                *(u32x4*)(act + (size_t)row * DFF + u.pn * 128 + wc * 32 + 8 * fq) = pack8(r0, r1);
            }
    }
};

__device__ __forceinline__ void p0_s5gen(const Args& a, LAS float* L, int g, int qd) {
    const int tid = threadIdx.x;
    LAS float* Kt = L;
    LAS float* Ap = L + 16384;
    LAS float* Bb = Ap + 33 * 64 * 2;
    LAS float* Cc = Bb + 2048;
    bf16_t* bts = (bf16_t*)(a.ws + OFF_BTS) + (size_t)g * 256 * 512;
    bf16_t* bty = (bf16_t*)(a.ws + OFF_BTY) + (size_t)g * 512 * 768;
    float* attab = (float*)(a.ws + OFF_AT);
    bf16_t* u5 = (bf16_t*)(a.ws + OFF_U5);
    if (qd == 0) for (int e = tid; e < 24 * 256; e += 512) { const int b = e >> 8, kk = e & 255; u5[((size_t)g * IT_PAD + IT_REAL + b) * LDA5 + kk] = 0; }
    for (int dir = 0; dir < 2; ++dir) {
        const int pg = dir * 32 + g;
        const double dt = exp((double)a.in[7][pg]);
        for (int idx = tid; idx < 33 * 64; idx += 512) {
            const int p = idx & 63, d = idx >> 6;
            const double lr = a.in[5][pg * 64 + p], li = a.in[6][pg * 64 + p];
            const float mag = (float)exp(lr * dt * d);
            float s, c; sincos_rev(li * dt * d, s, c);
            Ap[idx * 2] = mag * c; Ap[idx * 2 + 1] = mag * s;
            if (d == 32 && qd == 0) { attab[(pg * 64 + p) * 2] = mag * c; attab[(pg * 64 + p) * 2 + 1] = mag * s; }
        }
        for (int idx = tid; idx < 1024; idx += 512) {
            const int p = idx >> 4, h = idx & 15;
            const double lr = a.in[5][pg * 64 + p], li = a.in[6][pg * 64 + p];
            const double zr = lr * dt, zi = li * dt, mag = exp(zr);
            float sh, ch, s1, c1; sincos_rev(0.5 * zi, sh, ch); sincos_rev(zi, s1, c1);
            const double nr = mag * (-2.0 * (double)sh * (double)sh) + expm1(zr);
            const double abi = mag * (double)s1, den = lr * lr + li * li;
            const double cre = (nr * lr + abi * li) / den, cim = (abi * lr - nr * li) / den;
            const double br = a.in[8][(size_t)(pg * 64 + p) * 16 + h], bi = a.in[9][(size_t)(pg * 64 + p) * 16 + h];
            Bb[idx * 2] = (float)(cre * br - cim * bi); Bb[idx * 2 + 1] = (float)(cre * bi + cim * br);
        }
        for (int idx = tid; idx < 1024; idx += 512) {
            Cc[idx * 2] = a.in[10][(size_t)pg * 1024 + idx]; Cc[idx * 2 + 1] = a.in[11][(size_t)pg * 1024 + idx];
        }
        __syncthreads();
        for (int e = tid; e < 8192; e += 512) {
            const int d = e >> 8, ho = (e >> 4) & 15, hi = e & 15;
            float sum = 0.f;
            for (int p = 0; p < 64; ++p) {
                const float cr = Cc[(ho * 64 + p) * 2], ci = Cc[(ho * 64 + p) * 2 + 1], ar = Ap[(d * 64 + p) * 2], ai = Ap[(d * 64 + p) * 2 + 1];
                const float br = Bb[(p * 16 + hi) * 2], bi = Bb[(p * 16 + hi) * 2 + 1];
                const float car = cr * ar - ci * ai, cai = cr * ai + ci * ar;
                sum += car * br - cai * bi;
            }
            Kt[dir * 8192 + e] = sum;
        }
        for (int e = qd * 16384 + tid; e < (qd + 1) * 16384; e += 512) {
            const int k = e & 511, nn = e >> 9, c = nn >> 6, p = nn & 63, t = k >> 4, hi = k & 15;
            const int dd = dir == 0 ? (T5 - 1 - t) : t;
            const float ar = Ap[(dd * 64 + p) * 2], ai = Ap[(dd * 64 + p) * 2 + 1], br = Bb[(p * 16 + hi) * 2], bi = Bb[(p * 16 + hi) * 2 + 1];
            const float val = c ? (ar * bi + ai * br) : (ar * br - ai * bi);
            bts[(size_t)(dir * 128 + nn) * 512 + k] = f2bf(val);
        }
        for (int e = qd * 16384 + tid; e < (qd + 1) * 16384; e += 512) {
            const int kk = e & 127, n = e >> 7, c = kk >> 6, p = kk & 63, to = n >> 4, ho = n & 15;
            const int dd = dir == 0 ? (to + 1) : (T5 - to);
            const float cr = Cc[(ho * 64 + p) * 2], ci = Cc[(ho * 64 + p) * 2 + 1], ar = Ap[(dd * 64 + p) * 2], ai = Ap[(dd * 64 + p) * 2 + 1];
            const float val = c ? -(cr * ai + ci * ar) : (cr * ar - ci * ai);
            bty[(size_t)n * 768 + 512 + dir * 128 + kk] = f2bf(val);
        }
        __syncthreads();
    }
    for (int e = qd * 65536 + tid; e < (qd + 1) * 65536; e += 512) {
        const int k = e & 511, n = e >> 9, to = n >> 4, ho = n & 15, ti = k >> 4, hi = k & 15;
        float val = 0.f;
        if (to >= ti) val += Kt[((to - ti) * 16 + ho) * 16 + hi];
        if (ti >= to) val += Kt[8192 + ((ti - to) * 16 + ho) * 16 + hi];
        if (to == ti && ho == hi) val += a.in[12][g * 16 + ho];
        bty[(size_t)n * 768 + k] = f2bf(val);
    }
    __syncthreads();
}

__device__ __forceinline__ int src_col(int kind, int n) {
    if (kind == 1) { if (n >= 512 && n < 1536) { const int r = n - 512, seg = r >> 7, dp = r & 127; return 512 + seg * 128 + (dp >> 1) + 64 * (dp & 1); } return n; }
    if (kind == 2) { const int pn = n >> 8, bj = (n >> 7) & 1, cc = n & 127; return bj * 1024 + pn * 128 + cc; }
    if (kind == 3) { const int pn = n >> 8, bj = (n >> 7) & 1, cc = n & 127; return bj * DFF + pn * 128 + cc; }
    return n;
}
__device__ __forceinline__ void p0_wtile(const float* W, int K, int N, bf16_t* WT, int kind, const float* kscale, int tile, LAS float* L) {
    const int tid = threadIdx.x, nkt = K >> 6, nt_ = tile / nkt, kt = tile % nkt, n0 = nt_ * 64, k0 = kt * 64;
#pragma unroll
    for (int it = 0; it < 8; ++it) {
        const int idx = tid + it * 512, kk = idx >> 6, j = idx & 63;
        float v = W[(size_t)(k0 + kk) * N + src_col(kind, n0 + j)];
        if (kscale) v *= kscale[k0 + kk];
        L[kk * 65 + j] = v;
    }
    __syncthreads();
#pragma unroll
    for (int it = 0; it < 4; ++it) {
        const int idx = tid + it * 512, j = idx >> 5, kp = idx & 31;
        *(unsigned*)(WT + (size_t)(n0 + j) * K + k0 + 2 * kp) = cvt_pk_bf16(L[(2 * kp) * 65 + j], L[(2 * kp + 1) * 65 + j]);
    }
    __syncthreads();
}

__device__ __forceinline__ void phase0(const Args& a, LAS unsigned char* lds) {
    LAS float* L = (LAS float*)lds;
    const int tid = threadIdx.x, wave = tid >> 6, lane = tid & 63;
    constexpr int T_IN = 88 * 16, T_GLU = 32 * 8, T_RET = 256, T_OUT = 256, T_FFI = 88 * 16, T_FFO = 16 * 44;
    constexpr int NW = 128 + T_IN + T_GLU + T_RET + T_OUT + T_FFI + T_FFO, NRM = RPAD / 8;
    for (int w = blockIdx.x; w < NW + NRM; w += gridDim.x) {
        int r = w;
        if (r < 128) { p0_s5gen(a, L, r >> 2, r & 3); continue; } r -= 128;
        if (r < T_IN) { p0_wtile(a.in[4], 1024, INW, (bf16_t*)(a.ws + OFF_WIN), 1, nullptr, r, L); continue; } r -= T_IN;
        if (r < T_GLU) { p0_wtile(a.in[13], 512, 2048, (bf16_t*)(a.ws + OFF_WGLU), 2, nullptr, r, L); continue; } r -= T_GLU;
        if (r < T_RET) { p0_wtile(a.in[15], 1024, 1024, (bf16_t*)(a.ws + OFF_WRET), 0, nullptr, r, L); continue; } r -= T_RET;
        if (r < T_OUT) { p0_wtile(a.in[16], 1024, 1024, (bf16_t*)(a.ws + OFF_WOUT), 0, nullptr, r, L); continue; } r -= T_OUT;
        if (r < T_FFI) { p0_wtile(a.in[18], 1024, INW, (bf16_t*)(a.ws + OFF_WFFI), 3, a.in[17], r, L); continue; } r -= T_FFI;
        if (r < T_FFO) { p0_wtile(a.in[19], DFF, 1024, (bf16_t*)(a.ws + OFF_WFFO), 0, nullptr, r, L); continue; } r -= T_FFO;
        const int row = r * 8 + wave;
        bf16_t* orow = (bf16_t*)(a.ws + OFF_N1) + (size_t)row * 1024;
        if (row >= NVALID) {
#pragma unroll
            for (int j = 0; j < 4; ++j) *(u32x2*)(orow + (j * 64 + lane) * 4) = (u32x2){0u, 0u};
        } else {
            const float* xr = row < NPR ? a.in[0] + (size_t)row * 1024 : (row < NREAL ? a.in[1] + (size_t)(row - NPR) * 1024 : a.in[2] + (size_t)((row - NREAL) & 15) * 1024);
            f32x4 v[4]; float s = 0.f;
#pragma unroll
            for (int j = 0; j < 4; ++j) { v[j] = *(const f32x4*)(xr + (j * 64 + lane) * 4); s += (v[j][0] * v[j][0] + v[j][1] * v[j][1]) + (v[j][2] * v[j][2] + v[j][3] * v[j][3]); }
            const float rstd = rsqrtf(wave_sum(s) * (1.0f / 1024.0f) + EPS);
#pragma unroll
            for (int j = 0; j < 4; ++j) {
                const f32x4 gg = *(const f32x4*)(a.in[3] + (j * 64 + lane) * 4);
                u32x2 o; o.x = cvt_pk_bf16(v[j][0] * rstd * gg[0], v[j][1] * rstd * gg[1]); o.y = cvt_pk_bf16(v[j][2] * rstd * gg[2], v[j][3] * rstd * gg[3]);
                *(u32x2*)(orow + (j * 64 + lane) * 4) = o;
            }
        }
    }
}

__device__ __forceinline__ void s5_scan(const Args& a) {
    const float* attab = (const float*)(a.ws + OFF_AT);
    const float* sloc = (const float*)(a.ws + OFF_SLOC);
    bf16_t* u5 = (bf16_t*)(a.ws + OFF_U5);
    for (int id = blockIdx.x * 512 + threadIdx.x; id < 24 * 32 * 2 * 64; id += gridDim.x * 512) {
        const int p = id & 63, dir = (id >> 6) & 1, g = (id >> 7) & 31, b = id >> 12;
        const float atr = attab[((dir * 32 + g) * 64 + p) * 2], ati = attab[((dir * 32 + g) * 64 + p) * 2 + 1];
        const int nck = b < 16 ? 128 : 64, base = b < 16 ? b * 128 : 2048 + (b - 16) * 64, mitem = IT_REAL + b;
        const float* sl = sloc + (size_t)g * IT_PAD * 256 + dir * 128 + p;
        bf16_t* ub = u5 + (size_t)g * IT_PAD * LDA5 + 512 + dir * 128 + p;
        float sr = 0.f, si = 0.f;
        if (dir == 0) {
            ub[(size_t)mitem * LDA5] = 0; ub[(size_t)mitem * LDA5 + 64] = 0;
            sr = sl[(size_t)mitem * 256]; si = sl[(size_t)mitem * 256 + 64];
            for (int c0 = 0; c0 < nck; c0 += 8) {
                float lr[8], li[8];
#pragma unroll
                for (int j = 0; j < 8; ++j) { lr[j] = sl[(size_t)(base + c0 + j) * 256]; li[j] = sl[(size_t)(base + c0 + j) * 256 + 64]; }
#pragma unroll
                for (int j = 0; j < 8; ++j) {
                    const size_t it = (size_t)(base + c0 + j);
                    ub[it * LDA5] = f2bf(sr); ub[it * LDA5 + 64] = f2bf(si);
                    const float nr = atr * sr - ati * si + lr[j], ni = atr * si + ati * sr + li[j];
                    sr = nr; si = ni;
                }
            }
        } else {
            for (int c0 = nck - 8; c0 >= 0; c0 -= 8) {
                float lr[8], li[8];
#pragma unroll
                for (int j = 0; j < 8; ++j) { lr[j] = sl[(size_t)(base + c0 + j) * 256]; li[j] = sl[(size_t)(base + c0 + j) * 256 + 64]; }
#pragma unroll
                for (int j = 7; j >= 0; --j) {
                    const size_t it = (size_t)(base + c0 + j);
                    ub[it * LDA5] = f2bf(sr); ub[it * LDA5 + 64] = f2bf(si);
                    const float nr = atr * sr - ati * si + lr[j], ni = atr * si + ati * sr + li[j];
                    sr = nr; si = ni;
                }
            }
            ub[(size_t)mitem * LDA5] = f2bf(sr); ub[(size_t)mitem * LDA5 + 64] = f2bf(si);
        }
    }
}

constexpr int LDR = 136;
__device__ __forceinline__ float bf2f(bf16_t h) { return __uint_as_float(((unsigned)h) << 16); }

__device__ __forceinline__ void tr_store_pair(LAS bf16_t* img, int f0, int s2, u32x4 r0, u32x4 r1) {
    LAS unsigned* p = (LAS unsigned*)(img + f0 * LDR + s2);
    p[0 * (LDR / 2)] = (r0.x & 0xFFFFu) | (r1.x << 16); p[1 * (LDR / 2)] = (r0.x >> 16) | (r1.x & 0xFFFF0000u);
    p[2 * (LDR / 2)] = (r0.y & 0xFFFFu) | (r1.y << 16); p[3 * (LDR / 2)] = (r0.y >> 16) | (r1.y & 0xFFFF0000u);
    p[4 * (LDR / 2)] = (r0.z & 0xFFFFu) | (r1.z << 16); p[5 * (LDR / 2)] = (r0.z >> 16) | (r1.z & 0xFFFF0000u);
    p[6 * (LDR / 2)] = (r0.w & 0xFFFFu) | (r1.w << 16); p[7 * (LDR / 2)] = (r0.w >> 16) | (r1.w & 0xFFFF0000u);
}
__device__ __forceinline__ void tr_store_pair_scaled(LAS bf16_t* img, int f0, int s2, u32x4 r0, u32x4 r1, float w0, float w1) {
    LAS unsigned* p = (LAS unsigned*)(img + f0 * LDR + s2);
    p[0 * (LDR / 2)] = cvt_pk_bf16(bflo(r0.x) * w0, bflo(r1.x) * w1); p[1 * (LDR / 2)] = cvt_pk_bf16(bfhi(r0.x) * w0, bfhi(r1.x) * w1);
    p[2 * (LDR / 2)] = cvt_pk_bf16(bflo(r0.y) * w0, bflo(r1.y) * w1); p[3 * (LDR / 2)] = cvt_pk_bf16(bfhi(r0.y) * w0, bfhi(r1.y) * w1);
    p[4 * (LDR / 2)] = cvt_pk_bf16(bflo(r0.z) * w0, bflo(r1.z) * w1); p[5 * (LDR / 2)] = cvt_pk_bf16(bfhi(r0.z) * w0, bfhi(r1.z) * w1);
    p[6 * (LDR / 2)] = cvt_pk_bf16(bflo(r0.w) * w0, bflo(r1.w) * w1); p[7 * (LDR / 2)] = cvt_pk_bf16(bfhi(r0.w) * w0, bfhi(r1.w) * w1);
}

#define LDS_BARRIER() do { asm volatile("s_waitcnt lgkmcnt(0)" ::: "memory"); __builtin_amdgcn_s_barrier(); asm volatile("" ::: "memory"); } while (0)
__device__ __forceinline__ void ret_pass_a(const Args& a, LAS unsigned char* lds) {
    LAS bf16_t* KT = (LAS bf16_t*)lds;
    LAS bf16_t* VT = KT + 128 * LDR;
    const int tid0 = threadIdx.x;
    const bf16_t* kb = (const bf16_t*)(a.ws + OFF_K); const bf16_t* vb = (const bf16_t*)(a.ws + OFF_V);
    bf16_t* stb = (bf16_t*)(a.ws + OFF_ST);
    for (int item = blockIdx.x; item < 192; item += gridDim.x) {
        int tid = tid0; asm volatile("" : "+v"(tid));
        const int w = tid >> 6, lane = tid & 63, fr = lane & 15, fq = lane >> 4;
        int b, h, dir;
        if (item < 128) { b = item >> 3; h = (item >> 1) & 3; dir = item & 1; } else { const int j = item - 128; b = 16 + (j >> 3); h = (j >> 1) & 3; dir = j & 1; }
        const int NC = b < 16 ? 32 : 16, rbase = b < 16 ? b * 4096 : NPR + (b - 16) * 2048, ebase = b < 16 ? b * 33 : 528 + (b - 16) * 17;
        const float lg = logsigf_(a.in[14][dir * 4 + h]);
        const float carry = __expf(lg * 128.f);
        const int sp = lane, s2 = 2 * sp, pg = w;
        const float wk0 = dir == 0 ? __expf(lg * (float)(127 - s2)) : __expf(lg * (float)s2);
        const float wk1 = dir == 0 ? __expf(lg * (float)(126 - s2)) : __expf(lg * (float)(s2 + 1));
        f32x4 acc[2][8];
#pragma unroll
        for (int et = 0; et < 2; ++et)
#pragma unroll
            for (int dtl = 0; dtl < 8; ++dtl) acc[et][dtl] = (f32x4){0.f, 0.f, 0.f, 0.f};
        const int nsteps = dir == 0 ? NC : NC;
        u32x4 rk[2][2], rv[4][2];
        auto load_chunk = [&](int n) {
            int row0; bool valid = true;
            if (n == 0) { valid = s2 >= 112; row0 = NREAL + b * 16 + (s2 - 112); } else row0 = rbase + (n - 1) * 128 + s2;
#pragma unroll
            for (int it = 0; it < 2; ++it)
#pragma unroll
                for (int r = 0; r < 2; ++r) {
                    rk[it][r] = (u32x4){0u, 0u, 0u, 0u};
                    if (valid) rk[it][r] = *(const u32x4*)(kb + (size_t)(row0 + r) * 512 + h * 128 + (pg + 8 * it) * 8);
                }
#pragma unroll
            for (int it = 0; it < 4; ++it)
#pragma unroll
                for (int r = 0; r < 2; ++r) {
                    rv[it][r] = (u32x4){0u, 0u, 0u, 0u};
                    if (valid) rv[it][r] = *(const u32x4*)(vb + (size_t)(row0 + r) * 1024 + h * 256 + (pg + 8 * it) * 8);
                }
        };
        load_chunk(dir == 0 ? 0 : NC);
        for (int step = 0; step < nsteps; ++step) {
            const int n = dir == 0 ? step : NC - step;
            {
                bf16_t* spn = stb + ((size_t)((ebase + n) * 4 + h) * 2 + dir) * 32768;
#pragma unroll
                for (int et = 0; et < 2; ++et)
#pragma unroll
                    for (int dtl = 0; dtl < 8; ++dtl) {
                        u32x2 o; o.x = cvt_pk_bf16(acc[et][dtl][0], acc[et][dtl][1]); o.y = cvt_pk_bf16(acc[et][dtl][2], acc[et][dtl][3]);
                        *(u32x2*)(spn + (size_t)(32 * w + 16 * et + fr) * 128 + 16 * dtl + 4 * fq) = o;
                    }
            }
            LDS_BARRIER();
#pragma unroll
            for (int it = 0; it < 2; ++it) tr_store_pair_scaled(KT, (pg + 8 * it) * 8, s2, rk[it][0], rk[it][1], wk0, wk1);
#pragma unroll
            for (int it = 0; it < 4; ++it) tr_store_pair(VT, (pg + 8 * it) * 8, s2, rv[it][0], rv[it][1]);
            if (step + 1 < nsteps) load_chunk(dir == 0 ? step + 1 : NC - step - 1);
            LDS_BARRIER();
#pragma unroll
            for (int et = 0; et < 2; ++et)
#pragma unroll
                for (int dtl = 0; dtl < 8; ++dtl) acc[et][dtl] = acc[et][dtl] * carry;
#pragma unroll
            for (int ks = 0; ks < 4; ++ks) {
                bf16x8 vf[2];
#pragma unroll
                for (int et = 0; et < 2; ++et) vf[et] = *(const LAS bf16x8*)(VT + (32 * w + 16 * et + fr) * LDR + 32 * ks + 8 * fq);
#pragma unroll
                for (int dtl = 0; dtl < 8; ++dtl) {
                    const bf16x8 kf = *(const LAS bf16x8*)(KT + (16 * dtl + fr) * LDR + 32 * ks + 8 * fq);
#pragma unroll
                    for (int et = 0; et < 2; ++et) acc[et][dtl] = __builtin_amdgcn_mfma_f32_16x16x32_bf16(kf, vf[et], acc[et][dtl], 0, 0, 0);
                }
            }
        }
        if (dir == 0) {
            bf16_t* spn = stb + ((size_t)((ebase + NC) * 4 + h) * 2 + dir) * 32768;
#pragma unroll
            for (int et = 0; et < 2; ++et)
#pragma unroll
                for (int dtl = 0; dtl < 8; ++dtl) {
                    u32x2 o; o.x = cvt_pk_bf16(acc[et][dtl][0], acc[et][dtl][1]); o.y = cvt_pk_bf16(acc[et][dtl][2], acc[et][dtl][3]);
                    *(u32x2*)(spn + (size_t)(32 * w + 16 * et + fr) * 128 + 16 * dtl + 4 * fq) = o;
                }
        }
        LDS_BARRIER();
    }
}

__device__ __forceinline__ void ret_pass_b(const Args& a, LAS unsigned char* lds) {
    LAS bf16_t* KL = (LAS bf16_t*)lds;
    LAS bf16_t* BG = KL + 128 * LDR;
    const int tid0 = threadIdx.x;
    const bf16_t* qb = (const bf16_t*)(a.ws + OFF_Q); const bf16_t* kb = (const bf16_t*)(a.ws + OFF_K); const bf16_t* vb = (const bf16_t*)(a.ws + OFF_V);
    const bf16_t* stb = (const bf16_t*)(a.ws + OFF_ST);
    bf16_t* sg = (bf16_t*)a.out;
    u32x4 rk[4], rb[8]; bf16x8 qf[4];
    auto item_info = [&](int item, int& r0, int& h, const bf16_t*& sfp) {
        const int rc = item >> 2; h = item & 3;
        int b, n; if (rc < 512) { b = rc >> 5; n = (rc & 31) + 1; } else { b = 16 + ((rc - 512) >> 4); n = ((rc - 512) & 15) + 1; }
        const int ebase = b < 16 ? b * 33 : 528 + (b - 16) * 17; r0 = rc * 128;
        sfp = stb + ((size_t)((ebase + n) * 4 + h) * 2 + 0) * 32768;
    };
    auto load_item_head = [&](int item, int tid) {
        int r0, h; const bf16_t* sfp; item_info(item, r0, h, sfp);
#pragma unroll
        for (int it = 0; it < 8; ++it) { const int idx = tid + it * 512, e = idx >> 4, pc = idx & 15; rb[it] = *(const u32x4*)(sfp + (size_t)e * 128 + pc * 8); }
    };
    if ((int)blockIdx.x < 2560) load_item_head(blockIdx.x, tid0);
    for (int item = blockIdx.x; item < 2560; item += gridDim.x) {
        int tid = tid0; asm volatile("" : "+v"(tid));
        const int w = tid >> 6, lane = tid & 63, fr = lane & 15, fq = lane >> 4;
        int r0, h; const bf16_t* sfp; item_info(item, r0, h, sfp);
        const bf16_t* sbp = sfp + 32768;
        const float lgf = logsigf_(a.in[14][h]), lgb = logsigf_(a.in[14][4 + h]);
        const int crow = 16 * w + fr;
#pragma unroll
        for (int it = 0; it < 4; ++it) { const int idx = tid + it * 512, s = idx >> 4, pc = idx & 15; rk[it] = *(const u32x4*)(kb + (size_t)(r0 + s) * 512 + h * 128 + pc * 8); }
#pragma unroll
        for (int ks = 0; ks < 4; ++ks) qf[ks] = *(const bf16x8*)(qb + (size_t)(r0 + crow) * 512 + h * 128 + 32 * ks + 8 * fq);
        LDS_BARRIER();
#pragma unroll
        for (int it = 0; it < 4; ++it) { const int idx = tid + it * 512, s = idx >> 4, pc = idx & 15; *(LAS u32x4*)(KL + s * LDR + pc * 8) = rk[it]; }
#pragma unroll
        for (int it = 0; it < 8; ++it) { const int idx = tid + it * 512, e = idx >> 4, pc = idx & 15; *(LAS u32x4*)(BG + e * LDR + pc * 8) = rb[it]; }
#pragma unroll
        for (int it = 0; it < 8; ++it) { const int idx = tid + it * 512, e = idx >> 4, pc = idx & 15; rb[it] = *(const u32x4*)(sbp + (size_t)e * 128 + pc * 8); }
        LDS_BARRIER();
        f32x4 sacc[8];
#pragma unroll
        for (int st = 0; st < 8; ++st) sacc[st] = (f32x4){0.f, 0.f, 0.f, 0.f};
#pragma unroll
        for (int ks = 0; ks < 4; ++ks)
#pragma unroll
            for (int st = 0; st < 8; ++st) {
                const bf16x8 kf = *(const LAS bf16x8*)(KL + (16 * st + fr) * LDR + 32 * ks + 8 * fq);
                sacc[st] = __builtin_amdgcn_mfma_f32_16x16x32_bf16(kf, qf[ks], sacc[st], 0, 0, 0);
                if (st == 7) __builtin_amdgcn_sched_barrier(0);
            }
        bf16x8 pf[4];
#pragma unroll
        for (int t = 0; t < 4; ++t) {
            float pv[8];
#pragma unroll
            for (int hh = 0; hh < 2; ++hh)
#pragma unroll
                for (int j = 0; j < 4; ++j) {
                    const int spp = 16 * (2 * t + hh) + 4 * fq + j, diff = crow - spp;
                    const float dec = diff >= 0 ? __expf(lgf * (float)diff) : __expf(-lgb * (float)diff);
                    pv[hh * 4 + j] = sacc[2 * t + hh][j] * dec;
                }
            u32x4 pw; pw.x = cvt_pk_bf16(pv[0], pv[1]); pw.y = cvt_pk_bf16(pv[2], pv[3]); pw.z = cvt_pk_bf16(pv[4], pv[5]); pw.w = cvt_pk_bf16(pv[6], pv[7]);
            pf[t] = __builtin_bit_cast(bf16x8, pw);
        }
        f32x4 o[16];
#pragma unroll
        for (int et = 0; et < 16; ++et) o[et] = (f32x4){0.f, 0.f, 0.f, 0.f};
#pragma unroll
        for (int ks = 0; ks < 4; ++ks)
#pragma unroll
            for (int et = 0; et < 16; ++et) {
                const bf16x8 sf = *(const LAS bf16x8*)(BG + (16 * et + fr) * LDR + 32 * ks + 8 * fq);
                o[et] = __builtin_amdgcn_mfma_f32_16x16x32_bf16(sf, qf[ks], o[et], 0, 0, 0);
                if ((et & 7) == 7) __builtin_amdgcn_sched_barrier(0);
            }
        const float wqf = __expf(lgf * (float)(crow + 1)), wqb = __expf(lgb * (float)(128 - crow));
        const float ratio = wqf / wqb;
#pragma unroll
        for (int et = 0; et < 16; ++et) o[et] = o[et] * ratio;
        LDS_BARRIER();
#pragma unroll
        for (int it = 0; it < 8; ++it) { const int idx = tid + it * 512, e = idx >> 4, pc = idx & 15; *(LAS u32x4*)(BG + e * LDR + pc * 8) = rb[it]; }
        {
            const int s2 = 2 * lane;
#pragma unroll
            for (int it = 0; it < 4; ++it)
#pragma unroll
                for (int r = 0; r < 2; ++r) rb[it * 2 + r] = *(const u32x4*)(vb + (size_t)(r0 + s2 + r) * 1024 + h * 256 + (w + 8 * it) * 8);
        }
        LDS_BARRIER();
#pragma unroll
        for (int ks = 0; ks < 4; ++ks)
#pragma unroll
            for (int et = 0; et < 16; ++et) {
                const bf16x8 sf = *(const LAS bf16x8*)(BG + (16 * et + fr) * LDR + 32 * ks + 8 * fq);
                o[et] = __builtin_amdgcn_mfma_f32_16x16x32_bf16(sf, qf[ks], o[et], 0, 0, 0);
                if ((et & 7) == 7) __builtin_amdgcn_sched_barrier(0);
            }
#pragma unroll
        for (int et = 0; et < 16; ++et) o[et] = o[et] * wqb;
        LDS_BARRIER();
#pragma unroll
        for (int it = 0; it < 4; ++it) tr_store_pair(BG, (w + 8 * it) * 8, 2 * lane, rb[it * 2], rb[it * 2 + 1]);
        if (item + (int)gridDim.x < 2560) load_item_head(item + gridDim.x, tid);
        LDS_BARRIER();
#pragma unroll
        for (int t = 0; t < 4; ++t)
#pragma unroll
            for (int et = 0; et < 16; ++et) {
                const u32x2 lo = *(const LAS u32x2*)(BG + (16 * et + fr) * LDR + 32 * t + 4 * fq);
                const u32x2 hi = *(const LAS u32x2*)(BG + (16 * et + fr) * LDR + 32 * t + 16 + 4 * fq);
                const u32x4 vw = (u32x4){lo.x, lo.y, hi.x, hi.y};
                o[et] = __builtin_amdgcn_mfma_f32_16x16x32_bf16(__builtin_bit_cast(bf16x8, vw), pf[t], o[et], 0, 0, 0);
                if ((et & 7) == 7) __builtin_amdgcn_sched_barrier(0);
            }
        float ss = 0.f;
#pragma unroll
        for (int et = 0; et < 16; ++et) ss += (o[et][0] * o[et][0] + o[et][1] * o[et][1]) + (o[et][2] * o[et][2] + o[et][3] * o[et][3]);
        ss += __shfl_xor(ss, 16); ss += __shfl_xor(ss, 32);
        const float rn = rsqrtf(ss * (1.0f / 256.0f) + EPS);
        bf16_t* gp = sg + (size_t)(r0 + crow) * 1024 + h * 256 + 4 * fq;
#pragma unroll
        for (int et = 0; et < 16; ++et) {
            const u32x2 gw = *(const u32x2*)(gp + 16 * et);
            u32x2 ow; ow.x = cvt_pk_bf16(o[et][0] * rn * bflo(gw.x), o[et][1] * rn * bfhi(gw.x)); ow.y = cvt_pk_bf16(o[et][2] * rn * bflo(gw.y), o[et][3] * rn * bfhi(gw.y));
            *(u32x2*)(gp + 16 * et) = ow;
            if ((et & 3) == 3) __builtin_amdgcn_sched_barrier(0);
        }
    }
    LDS_BARRIER();
}

__device__ __forceinline__ void final_norm(const Args& a) {
    const int wave = threadIdx.x >> 6, lane = threadIdx.x & 63;
    const float* ssq = (const float*)(a.ws + OFF_SSQ2);
    for (int row = blockIdx.x * 8 + wave; row < NREAL; row += gridDim.x * 8) {
        const float part = lane < 16 ? ssq[(size_t)row * 16 + lane] : 0.f;
        const float rstd = rsqrtf(wave_sum(part) * (1.0f / 1024.0f) + EPS);
        float* orow = a.out + (size_t)row * 1024;
        const bf16_t* hrow = (const bf16_t*)(a.ws + OFF_H1B) + (size_t)row * 1024;
#pragma unroll
        for (int j = 0; j < 4; ++j) {
            const u32x2 w = *(const u32x2*)(hrow + (j * 64 + lane) * 4);
            const f32x4 gg = *(const f32x4*)(a.in[20] + (j * 64 + lane) * 4);
            f32x4 v;
            v[0] = bflo(w.x) * rstd * gg[0]; v[1] = bfhi(w.x) * rstd * gg[1]; v[2] = bflo(w.y) * rstd * gg[2]; v[3] = bfhi(w.y) * rstd * gg[3];
            *(f32x4*)(orow + (j * 64 + lane) * 4) = v;
        }
    }
}

template <int ph>
__device__ __forceinline__ void run_phase(const Args& a, LAS unsigned char* lds) {
    unsigned char* ws = a.ws;
    bf16_t* dob = (bf16_t*)a.out;
    bf16_t* sgp = dob; bf16_t* gap = dob + (size_t)NREAL * 1024;
#ifdef ONLY_PH
    if (ph != ONLY_PH) return;
#endif
    switch (ph) {
    case 0: phase0(a, lds); break;
    case 1: {
        pg8::Gemm g{(const bf16_t*)(ws + OFF_N1), (const bf16_t*)(ws + OFF_WIN), 1024, 1024, 1024, RPAD / 256, INW / 256, 1, 0, 0, STG};
        EpiProj E{(bf16_t*)(ws + OFF_U5), (bf16_t*)(ws + OFF_Q), (bf16_t*)(ws + OFF_K), (bf16_t*)(ws + OFF_V), sgp, gap, (bf16_t*)(ws + OFF_GB), (const LAS double*)(lds + 131072)};
        pg8::gemm_phase(lds, g, E);
    } break;
    case 2: {
        pg8::Gemm g{(const bf16_t*)(ws + OFF_U5), (const bf16_t*)(ws + OFF_BTS), LDA5, 512, 512, IT_PAD / 256, 1, 32, (size_t)IT_PAD * LDA5, (size_t)256 * 512, 0};
        EpiSloc E{(float*)(ws + OFF_SLOC)};
        pg8::gemm_phase(lds, g, E);
    } break;
    case 3: s5_scan(a); break;
    case 4: {
        pg8::Gemm g{(const bf16_t*)(ws + OFF_U5), (const bf16_t*)(ws + OFF_BTY), LDA5, 768, 768, IT_PAD / 256, 2, 32, (size_t)IT_PAD * LDA5, (size_t)512 * 768, 0};
        EpiY E{(bf16_t*)(ws + OFF_YSSM)};
        pg8::gemm_phase(lds, g, E);
    } break;
    case 5: {
        pg8::Gemm g{(const bf16_t*)(ws + OFF_YSSM), (const bf16_t*)(ws + OFF_WGLU), 512, 512, 512, NREAL / 256, 8, 1, 0, 0, STG};
        EpiGlu E{gap};
        pg8::gemm_phase(lds, g, E);
    } break;
    case 6: ret_pass_a(a, lds); break;
    case 7: ret_pass_b(a, lds); break;
    case 8: {
        pg8::Gemm g{sgp, (const bf16_t*)(ws + OFF_WRET), 1024, 1024, 1024, NREAL / 256, 4, 1, 0, 0, STG};
        EpiRet E{gap, (const bf16_t*)(ws + OFF_GB), (bf16_t*)(ws + OFF_MIXED)};
        pg8::gemm_phase(lds, g, E);
    } break;
    case 9: {
        pg8::Gemm g{(const bf16_t*)(ws + OFF_MIXED), (const bf16_t*)(ws + OFF_WOUT), 1024, 1024, 1024, NREAL / 256, 4, 1, 0, 0, STG};
        EpiRes<0> E{a.in[0], a.in[1], (bf16_t*)(ws + OFF_H1B), (float*)(ws + OFF_SSQ1)};
        pg8::gemm_phase(lds, g, E);
    } break;
    case 10: {
        pg8::Gemm g{(const bf16_t*)(ws + OFF_H1B), (const bf16_t*)(ws + OFF_WFFI), 1024, 1024, 1024, NREAL / 256, INW / 256, 1, 0, 0, STG};
        EpiFfi E{(const float*)(ws + OFF_SSQ1), (bf16_t*)(ws + OFF_ACT)};
        pg8::gemm_phase(lds, g, E);
    } break;
    case 11: {
        pg8::Gemm g{(const bf16_t*)(ws + OFF_ACT), (const bf16_t*)(ws + OFF_WFFO), DFF, DFF, DFF, NREAL / 256, 4, 1, 0, 0, STG};
        EpiRes<1> E{nullptr, nullptr, (bf16_t*)(ws + OFF_H1B), (float*)(ws + OFF_SSQ2)};
        pg8::gemm_phase(lds, g, E);
    } break;
    case 12: final_norm(a); break;
    default: break;
    }
}

__device__ __forceinline__ void grid_barrier(unsigned* ctr, unsigned target) {
    asm volatile("s_waitcnt vmcnt(0) lgkmcnt(0)" ::: "memory");
    __syncthreads();
    if (threadIdx.x == 0) {
        __builtin_amdgcn_fence(__ATOMIC_RELEASE, "agent");
        asm volatile("s_waitcnt vmcnt(0)" ::: "memory");
        __hip_atomic_fetch_add(ctr, 1u, __ATOMIC_RELAXED, __HIP_MEMORY_SCOPE_AGENT);
        unsigned spins = 0;
        while (__hip_atomic_load(ctr, __ATOMIC_RELAXED, __HIP_MEMORY_SCOPE_AGENT) < target && ++spins < (1u << 24)) __builtin_amdgcn_s_sleep(2);
        __builtin_amdgcn_fence(__ATOMIC_ACQUIRE, "agent");
        asm volatile("s_waitcnt vmcnt(0)" ::: "memory");
    }
    __syncthreads();
}

template <bool COOP>
__global__ __launch_bounds__(512, 2) void fwd_kernel(Args a) {
    extern __shared__ __attribute__((aligned(16))) unsigned char shm[];
    LAS unsigned char* lds = (LAS unsigned char*)shm;
    if (threadIdx.x < 64) ((LAS double*)(lds + 131072))[threadIdx.x] = exp2(-(double)threadIdx.x * (13.287712379549449 / 64.0));
    __syncthreads();
#define RUN_PH(P) if (a.ph_lo <= P && P < a.ph_hi) { run_phase<P>(a, lds); if ((DBL_MASK >> P) & 1) run_phase<P>(a, lds); if (COOP && P + 1 < a.ph_hi) { if (P == 0) { __threadfence(); cg::this_grid().sync(); } else grid_barrier((unsigned*)(a.ws + OFF_BAR), (unsigned)P * gridDim.x); } }
    RUN_PH(0) RUN_PH(1) RUN_PH(2) RUN_PH(3) RUN_PH(4) RUN_PH(5) RUN_PH(6) RUN_PH(7) RUN_PH(8) RUN_PH(9) RUN_PH(10) RUN_PH(11) RUN_PH(12)
#undef RUN_PH
}

extern "C" void kernel_launch(void* const* d_in, const int* in_sizes, int n_in, void* d_out, int out_size, void* d_ws, size_t ws_size, hipStream_t stream) {
    static int grid = 0;
    if (grid == 0) {
        if (n_in != 21 || ws_size < WS_NEED || out_size != NREAL * 1024) { fprintf(stderr, "kernel_launch: unexpected shapes (n_in %d, ws %zu need %zu, out %d)\n", n_in, ws_size, (size_t)WS_NEED, out_size); grid = -1; return; }
        int dev = 0, cus = 0;
        hipGetDevice(&dev); hipDeviceGetAttribute(&cus, hipDeviceAttributeMultiprocessorCount, dev);
        hipFuncSetAttribute((const void*)fwd_kernel<true>, hipFuncAttributeMaxDynamicSharedMemorySize, LDS_BYTES);
        hipFuncSetAttribute((const void*)fwd_kernel<false>, hipFuncAttributeMaxDynamicSharedMemorySize, LDS_BYTES);
        int per_cu = 0;
        hipOccupancyMaxActiveBlocksPerMultiprocessor(&per_cu, (const void*)fwd_kernel<true>, 512, LDS_BYTES);
        if (per_cu < 1) { fprintf(stderr, "kernel_launch: occupancy query says %d blocks per CU\n", per_cu); per_cu = 1; }
        (void)hipGetLastError();
        grid = cus * 1;
    }
    if (grid < 0) return;
    Args a{};
    for (int i = 0; i < 21; ++i) a.in[i] = (const float*)d_in[i];
    a.out = (float*)d_out; a.ws = (unsigned char*)d_ws;
#if COOP_MODE
    hipMemsetAsync((char*)d_ws + OFF_BAR, 0, 256, stream);
    a.ph_lo = 0; a.ph_hi = NPHASE;
    void* args[] = {&a};
    hipError_t e = hipLaunchCooperativeKernel((const void*)fwd_kernel<true>, dim3(grid), dim3(512), args, LDS_BYTES, stream);
    if (e != hipSuccess) fprintf(stderr, "cooperative launch failed: %s (grid %d)\n", hipGetErrorString(e), grid);
#else
    for (int ph = 0; ph < NPHASE; ++ph) {
        a.ph_lo = ph; a.ph_hi = ph + 1;
        hipLaunchKernelGGL(fwd_kernel<false>, dim3(grid), dim3(512), LDS_BYTES, stream, a);
    }
#endif
}
```

```cpp
#include <hip/hip_runtime.h>
#include <hip/hip_cooperative_groups.h>
#include <cstdio>
#include <cstdint>
namespace cg = cooperative_groups;

#ifndef COOP_MODE
#define COOP_MODE 1
#endif

#define DBL_MASK 0x0
#define LAS __attribute__((address_space(3)))
typedef unsigned short bf16_t;
typedef short bf16x8 __attribute__((ext_vector_type(8)));
typedef float f32x4 __attribute__((ext_vector_type(4)));
typedef unsigned u32x4 __attribute__((ext_vector_type(4)));
typedef unsigned u32x2 __attribute__((ext_vector_type(2)));

constexpr int D = 1024, NREAL = 81920, NPR = 65536, RPAD = 82432, NVALID = 82304;
constexpr int INW = 5632, DFF = 2816;
constexpr int T5 = 32, IT_REAL = 2560, IT_PAD = 2816, LDA5 = 768;
constexpr float EPS = 1e-6f;

constexpr size_t OFF_WIN = 0;
constexpr size_t OFF_WGLU = OFF_WIN + (size_t)INW * D * 2;
constexpr size_t OFF_WRET = OFF_WGLU + (size_t)2048 * 512 * 2;
constexpr size_t OFF_WOUT = OFF_WRET + (size_t)D * D * 2;
constexpr size_t OFF_WFFI = OFF_WOUT + (size_t)D * D * 2;
constexpr size_t OFF_WFFO = OFF_WFFI + (size_t)INW * D * 2;
constexpr size_t OFF_AT = OFF_WFFO + (size_t)D * DFF * 2;
constexpr size_t OFF_BAR = OFF_AT + 32768;
constexpr size_t OFF_Q = OFF_AT + 65536;
constexpr size_t OFF_K = OFF_Q + (size_t)RPAD * 512 * 2;
constexpr size_t OFF_V = OFF_K + (size_t)RPAD * 512 * 2;
constexpr size_t OFF_GB = OFF_V + (size_t)RPAD * D * 2;
constexpr size_t OFF_SSQ1 = OFF_GB + (size_t)NREAL * D * 2;
constexpr size_t OFF_SSQ2 = OFF_SSQ1 + (size_t)NREAL * 16 * 4;
constexpr size_t OFF_X = OFF_SSQ2 + (size_t)NREAL * 16 * 4;
constexpr size_t OFF_N1 = OFF_X;
constexpr size_t OFF_YSSM = OFF_X;
constexpr size_t OFF_U5 = OFF_N1 + (size_t)RPAD * D * 2;
constexpr size_t OFF_BTY = OFF_U5 + (size_t)32 * IT_PAD * LDA5 * 2;
constexpr size_t OFF_BTS = OFF_BTY + (size_t)32 * 512 * 768 * 2;
constexpr size_t OFF_SLOC = OFF_BTS + (size_t)32 * 256 * 512 * 2;
constexpr size_t END_X03 = OFF_SLOC + (size_t)32 * IT_PAD * 256 * 4;
constexpr size_t OFF_ST = OFF_X;
constexpr size_t END_ST = OFF_ST + (size_t)664 * 8 * 65536;
constexpr size_t OFF_ACT = OFF_X;
constexpr size_t END_ACT = OFF_ACT + (size_t)NREAL * DFF * 2;
constexpr size_t OFF_MIXED = OFF_Q;
constexpr size_t OFF_H1B = OFF_V;
constexpr size_t cmax(size_t a, size_t b) { return a > b ? a : b; }
constexpr size_t WS_NEED = cmax(END_X03, cmax(END_ST, END_ACT));

constexpr int LDS_BYTES = 131072 + 1024;
constexpr int NPHASE = 13;
constexpr int STG = 0;

struct Args {
    const float* in[21];
    float* out;
    unsigned char* ws;
    int ph_lo, ph_hi;
};

__device__ __forceinline__ unsigned cvt_pk_bf16(float lo, float hi) { unsigned r; asm volatile("v_cvt_pk_bf16_f32 %0, %1, %2" : "=v"(r) : "v"(lo), "v"(hi)); return r; }
__device__ __forceinline__ bf16_t f2bf(float f) { return (bf16_t)(cvt_pk_bf16(f, 0.f) & 0xFFFFu); }
__device__ __forceinline__ float bflo(unsigned w) { return __uint_as_float(w << 16); }
__device__ __forceinline__ float bfhi(unsigned w) { return __uint_as_float(w & 0xFFFF0000u); }
__device__ __forceinline__ float sigmoidf_(float x) { return __fdividef(1.0f, 1.0f + __expf(-x)); }
__device__ __forceinline__ float siluf_(float x) { return x * sigmoidf_(x); }
__device__ __forceinline__ float gelu_tanh(float x) { const float z = 0.7978845608028654f * (x + 0.044715f * x * x * x); return x * sigmoidf_(2.0f * z); }
__device__ __forceinline__ float logsigf_(float x) { return fminf(x, 0.f) - log1pf(__expf(-fabsf(x))); }
__device__ __forceinline__ float wave_sum(float v) {
#pragma unroll
    for (int o = 1; o < 64; o <<= 1) v += __shfl_xor(v, o);
    return v;
}
__device__ __forceinline__ void sincos_rev(double ang, float& s, float& c) {
    double x = ang * 0.15915494309189535; x -= rint(x);
    const float xf = (float)x;
    s = __builtin_amdgcn_sinf(xf); c = __builtin_amdgcn_cosf(xf);
}

namespace pg8 {
constexpr int BM = 256, BK = 64, HALF = 128, HTB = HALF * BK * 2, STAGE_BYTES = 8 * HTB, NXCD = 8, WGM = 8;
__device__ __forceinline__ int lds_byte(int r, int c) { const int st = (r >> 4) * 2 + (c >> 5), rr = r & 15, cc = c & 31, ob = rr * 64 + cc * 2; return st * 1024 + (ob ^ (((ob >> 9) & 1) << 5)); }
__device__ __forceinline__ void stage_rc(int b, int& R, int& C) { const int st = b / 1024, sb = b % 1024, swz = sb ^ (((sb >> 9) & 1) << 5); R = (st >> 1) * 16 + swz / 64; C = (st & 1) * 32 + (swz % 64) / 2; }
__device__ __forceinline__ int perm32(int rho) { const int n = rho >> 4, i = rho & 15; return 8 * (i >> 2) + 4 * n + (i & 3); }

struct Unit { int pm, pn, g; };
struct Gemm { const bf16_t* A; const bf16_t* Bt; int lda, ldb, K, nM, nN, nb; size_t sA, sB; int stagger; };

struct Order {
    int nM, nN, nwg, total, G, c;
    __device__ void init(int nM_, int nN_, int nb, int G_, int c_) { nM = nM_; nN = nN_; nwg = nM * nN; total = nwg * nb; G = G_; c = c_; }
    __device__ bool next(int i, Unit& u) const {
        const long L = (long)i * G + c; if (L >= total) return false;
        u.g = (int)(L / nwg); int wgid = (int)(L % nwg);
        { const int q = nwg / NXCD, r = nwg % NXCD, xcd = wgid % NXCD, off = wgid / NXCD; wgid = (xcd < r ? xcd * (q + 1) : r * (q + 1) + (xcd - r) * q) + off; }
        const int nig = WGM * nN, gid = wgid / nig, fm = gid * WGM, gsz = (nM - fm) < WGM ? (nM - fm) : WGM;
        u.pm = fm + ((wgid % nig) % gsz); u.pn = (wgid % nig) / gsz; return true;
    }
};

template <class Epi>
__device__ __forceinline__ void gemm_phase(LAS unsigned char* lds, const Gemm g, const Epi& E) {
    const int tid = threadIdx.x, wid = __builtin_amdgcn_readfirstlane(tid >> 6), lane = tid & 63, wr = wid >> 2, wc = wid & 3, fr = lane & 15, fq = lane >> 4;
    const int K = g.K, nt = K / BK;
    Order S; S.init(g.nM, g.nN, g.nb, (int)gridDim.x, (int)blockIdx.x);
    unsigned voffA[2], voffB[2];
#pragma unroll
    for (int i = 0; i < 2; ++i) { int R, C; stage_rc(tid * 16 + i * 8192, R, C); const int Rb = (R & ~31) + perm32(R & 31);
        voffA[i] = (unsigned)(R * g.lda + C) * 2u; voffB[i] = (unsigned)(Rb * g.ldb + C) * 2u; }
    const size_t kstep = (size_t)(BK * 2);
    const size_t hstepA = (size_t)HALF * g.lda * 2, hstepB = (size_t)HALF * g.ldb * 2;
    const size_t tstepA = 2 * hstepA, tstepB = 2 * hstepB;
    const unsigned ldsw = (unsigned)wid * 1024u;
    const int aoff = lds_byte(wr * 64 + fr, fq * 8), boff = lds_byte(wc * 32 + fr, fq * 8);
#define PG8_SA(b, h) (((b) * 2 + (h)) * HTB)
#define PG8_SB(b, h) ((4 + (b) * 2 + (h)) * HTB)
#define PG8_STAGE(bufoff, gbase, voff) do { _Pragma("unroll") for (int _i = 0; _i < 2; ++_i) \
        __builtin_amdgcn_global_load_lds((const unsigned*)((const char*)(gbase) + (voff)[_i]), (LAS unsigned*)(lds + (bufoff) + ldsw + _i * 8192), 16, 0, 0); } while (0)
#define PG8_LDA(dst, b, h) do { _Pragma("unroll") for (int m = 0; m < 4; ++m) _Pragma("unroll") for (int k = 0; k < 2; ++k) dst[m][k] = *(const LAS bf16x8*)(lds + PG8_SA(b, h) + aoff + m * 2048 + k * 1024); } while (0)
#define PG8_LDB(dst, b, h) do { _Pragma("unroll") for (int n = 0; n < 2; ++n) _Pragma("unroll") for (int k = 0; k < 2; ++k) dst[n][k] = *(const LAS bf16x8*)(lds + PG8_SB(b, h) + boff + n * 2048 + k * 1024); } while (0)
#define PG8_MMA(ai, bj, At, Bt) do { __builtin_amdgcn_s_setprio(1); _Pragma("unroll") for (int m = 0; m < 4; ++m) _Pragma("unroll") for (int n = 0; n < 2; ++n) _Pragma("unroll") for (int k = 0; k < 2; ++k) \
        acc[ai][bj][m][n] = __builtin_amdgcn_mfma_f32_16x16x32_bf16(Bt[n][k], At[m][k], acc[ai][bj][m][n], 0, 0, 0); __builtin_amdgcn_s_setprio(0); } while (0)
#define PG8_WAIT_V(n) asm volatile("s_waitcnt vmcnt(" #n ")" ::: "memory")
#define PG8_WAIT_L(n) asm volatile("s_waitcnt lgkmcnt(" #n ")" ::: "memory")
#define PG8_BAR __builtin_amdgcn_s_barrier()
#define PG8_SCHED __builtin_amdgcn_sched_barrier(0)
    Unit cur, nxt; int ui = 0;
    if (!S.next(0, cur)) return;
    if (g.stagger) {
        const unsigned long long t0 = __builtin_amdgcn_s_memrealtime(), wt = (unsigned long long)((blockIdx.x & 3) * g.stagger);
        while (__builtin_amdgcn_s_memrealtime() - t0 < wt) __builtin_amdgcn_s_sleep(16);
    }
    f32x4 acc[2][2][4][2];
#pragma unroll
    for (int a = 0; a < 2; ++a)
#pragma unroll
        for (int b = 0; b < 2; ++b)
#pragma unroll
            for (int m = 0; m < 4; ++m)
#pragma unroll
                for (int n = 0; n < 2; ++n) acc[a][b][m][n] = (f32x4){0.f, 0.f, 0.f, 0.f};
    bf16x8 At[4][2], B0[2][2], B1[2][2];
    const char* cA = (const char*)g.A + ((size_t)cur.g * g.sA) * 2 + (size_t)cur.pm * tstepA;
    const char* cB = (const char*)g.Bt + ((size_t)cur.g * g.sB) * 2 + (size_t)cur.pn * tstepB;
    PG8_STAGE(PG8_SB(0, 0), cB, voffB); PG8_STAGE(PG8_SA(0, 0), cA, voffA); PG8_STAGE(PG8_SB(0, 1), cB + hstepB, voffB); PG8_STAGE(PG8_SA(0, 1), cA + hstepA, voffA);
    if (wr == 1) PG8_BAR;
    PG8_WAIT_V(4); PG8_BAR;
    PG8_STAGE(PG8_SB(1, 0), cB + kstep, voffB); PG8_STAGE(PG8_SA(1, 0), cA + kstep, voffA); PG8_STAGE(PG8_SB(1, 1), cB + hstepB + kstep, voffB);
    PG8_WAIT_V(6); PG8_BAR;
    for (;;) {
        const bool has_next = S.next(ui + 1, nxt);
        const char* nA = has_next ? (const char*)g.A + ((size_t)nxt.g * g.sA) * 2 + (size_t)nxt.pm * tstepA : cA;
        const char* nB = has_next ? (const char*)g.Bt + ((size_t)nxt.g * g.sB) * 2 + (size_t)nxt.pn * tstepB : cB;
        for (int t = 0; t < nt; t += 2) {
            const bool last = (t == nt - 2);
            const char* a1 = cA + (size_t)(t + 1) * kstep;
            const char* a2 = last ? nA : cA + (size_t)(t + 2) * kstep; const char* b2 = last ? nB : cB + (size_t)(t + 2) * kstep;
            const char* a3 = a2 + kstep; const char* b3 = b2 + kstep;
            PG8_LDB(B0, 0, 0); PG8_SCHED; PG8_LDA(At, 0, 0); PG8_STAGE(PG8_SA(1, 1), a1 + hstepA, voffA);
            PG8_WAIT_L(8); PG8_BAR; PG8_WAIT_L(0); PG8_MMA(0, 0, At, B0); PG8_BAR; PG8_SCHED;
            PG8_LDB(B1, 0, 1); PG8_STAGE(PG8_SB(0, 0), b2, voffB);
            PG8_BAR; PG8_WAIT_L(0); PG8_MMA(0, 1, At, B1); PG8_BAR;
            PG8_LDA(At, 0, 1); PG8_STAGE(PG8_SA(0, 0), a2, voffA);
            PG8_BAR; PG8_WAIT_L(0); PG8_MMA(1, 0, At, B0); PG8_BAR; PG8_SCHED;
            PG8_STAGE(PG8_SB(0, 1), b2 + hstepB, voffB);
            PG8_WAIT_V(6); PG8_BAR; PG8_MMA(1, 1, At, B1); PG8_BAR;
            PG8_LDB(B0, 1, 0); PG8_SCHED; PG8_LDA(At, 1, 0); PG8_STAGE(PG8_SA(0, 1), a2 + hstepA, voffA);
            PG8_WAIT_L(8); PG8_BAR; PG8_WAIT_L(0); PG8_MMA(0, 0, At, B0); PG8_BAR; PG8_SCHED;
            PG8_LDB(B1, 1, 1); PG8_STAGE(PG8_SB(1, 0), b3, voffB);
            PG8_BAR; PG8_WAIT_L(0); PG8_MMA(0, 1, At, B1); PG8_BAR;
            PG8_LDA(At, 1, 1); PG8_STAGE(PG8_SA(1, 0), a3, voffA);
            PG8_BAR; PG8_WAIT_L(0); PG8_MMA(1, 0, At, B0); PG8_BAR; PG8_SCHED;
            PG8_STAGE(PG8_SB(1, 1), b3 + hstepB, voffB);
            PG8_WAIT_V(6); PG8_BAR; PG8_MMA(1, 1, At, B1); PG8_BAR;
        }
        E(acc, cur, wr, wc, fr, fq);
        if (!has_next) break;
#pragma unroll
        for (int a = 0; a < 2; ++a)
#pragma unroll
            for (int b = 0; b < 2; ++b)
#pragma unroll
                for (int m = 0; m < 4; ++m)
#pragma unroll
                    for (int n = 0; n < 2; ++n) acc[a][b][m][n] = (f32x4){0.f, 0.f, 0.f, 0.f};
        cur = nxt; cA = nA; cB = nB; ++ui;
    }
    PG8_WAIT_V(0);
    if (wr == 0) PG8_BAR;
    PG8_BAR;
#undef PG8_SA
#undef PG8_SB
#undef PG8_STAGE
#undef PG8_LDA
#undef PG8_LDB
#undef PG8_MMA
#undef PG8_WAIT_V
#undef PG8_WAIT_L
#undef PG8_BAR
#undef PG8_SCHED
}
}
using pg8::Unit;
typedef const f32x4 (&AccRef)[2][2][4][2];

__device__ __forceinline__ u32x4 pack8(f32x4 a, f32x4 b) { u32x4 w; w.x = cvt_pk_bf16(a[0], a[1]); w.y = cvt_pk_bf16(a[2], a[3]); w.z = cvt_pk_bf16(b[0], b[1]); w.w = cvt_pk_bf16(b[2], b[3]); return w; }

struct EpiProj {
    bf16_t *u5, *q, *k, *v, *sg, *ga, *gb; const LAS double* ropef;
    __device__ __forceinline__ void operator()(AccRef acc, const Unit& u, int wr, int wc, int fr, int fq) const {
        const int pn = u.pn;
#pragma unroll
        for (int ai = 0; ai < 2; ++ai)
#pragma unroll
            for (int m = 0; m < 4; ++m) {
                const int row = u.pm * 256 + ai * 128 + wr * 64 + m * 16 + fr;
#pragma unroll
                for (int bj = 0; bj < 2; ++bj) {
                    const int col = pn * 256 + bj * 128 + wc * 32 + 8 * fq;
                    f32x4 v0 = acc[ai][bj][m][0], v1 = acc[ai][bj][m][1];
                    if (pn < 2) {
                        if (row < NVALID) {
                            int item, t;
                            if (row < NREAL) { item = row >> 5; t = row & 31; } else { const int mr = row - NREAL; item = IT_REAL + (mr >> 4); t = 16 + (mr & 15); }
                            const int g = col >> 4, h0 = col & 15;
                            *(u32x4*)(u5 + ((size_t)(g * IT_PAD + item) * LDA5 + t * 16 + h0)) = pack8(v0, v1);
                        }
                    } else if (pn < 6) {
                        const int cq = col - 512, isk = cq >> 9, cc = cq & 511, i0 = (cc & 127) >> 1;
                        const int pos = row < NPR ? 16 + (row & 4095) : (row < NREAL ? 16 + ((row - NPR) & 2047) : ((row - NREAL) & 15));
                        const float sc = isk ? 1.0f : 0.08838834764831845f;
                        float o[8];
#pragma unroll
                        for (int pi = 0; pi < 4; ++pi) {
                            float s, c; sincos_rev((double)pos * ropef[i0 + pi], s, c);
                            const float x1 = pi < 2 ? v0[2 * pi] : v1[2 * pi - 4], x2 = pi < 2 ? v0[2 * pi + 1] : v1[2 * pi - 3];
                            o[2 * pi] = (x1 * c - x2 * s) * sc; o[2 * pi + 1] = (x1 * s + x2 * c) * sc;
                        }
                        u32x4 w; w.x = cvt_pk_bf16(o[0], o[1]); w.y = cvt_pk_bf16(o[2], o[3]); w.z = cvt_pk_bf16(o[4], o[5]); w.w = cvt_pk_bf16(o[6], o[7]);
                        *(u32x4*)((isk ? k : q) + (size_t)row * 512 + cc) = w;
                    } else if (pn < 10) {
                        *(u32x4*)(v + (size_t)row * 1024 + (col - 1536)) = pack8(v0, v1);
                    } else if (row < NREAL) {
                        if (pn < 14) {
#pragma unroll
                            for (int j = 0; j < 4; ++j) { v0[j] = siluf_(v0[j]); v1[j] = siluf_(v1[j]); }
                            *(u32x4*)(sg + (size_t)row * 1024 + (col - 2560)) = pack8(v0, v1);
                        } else {
#pragma unroll
                            for (int j = 0; j < 4; ++j) { v0[j] = sigmoidf_(v0[j]); v1[j] = sigmoidf_(v1[j]); }
                            if (pn < 18) *(u32x4*)(ga + (size_t)row * 1024 + (col - 3584)) = pack8(v0, v1);
                            else *(u32x4*)(gb + (size_t)row * 1024 + (col - 4608)) = pack8(v0, v1);
                        }
                    }
                }
            }
    }
};

struct EpiSink {
    float* p; int flag;
    __device__ __forceinline__ void operator()(AccRef acc, const Unit& u, int wr, int wc, int fr, int fq) const {
        if (flag) {
#pragma unroll
            for (int ai = 0; ai < 2; ++ai)
#pragma unroll
                for (int m = 0; m < 4; ++m)
#pragma unroll
                    for (int bj = 0; bj < 2; ++bj) { p[(ai * 8 + m * 2 + bj) * 8 + fr] = acc[ai][bj][m][0][0] + acc[ai][bj][m][1][1]; }
        }
    }
};

struct EpiSloc {
    float* sloc;
    __device__ __forceinline__ void operator()(AccRef acc, const Unit& u, int wr, int wc, int fr, int fq) const {
#pragma unroll
        for (int ai = 0; ai < 2; ++ai)
#pragma unroll
            for (int m = 0; m < 4; ++m) {
                const int row = u.pm * 256 + ai * 128 + wr * 64 + m * 16 + fr;
#pragma unroll
                for (int bj = 0; bj < 2; ++bj) {
                    const int col = bj * 128 + wc * 32 + 8 * fq;
                    float* p = sloc + ((size_t)u.g * IT_PAD + row) * 256 + col;
                    *(f32x4*)p = acc[ai][bj][m][0]; *(f32x4*)(p + 4) = acc[ai][bj][m][1];
                }
            }
    }
};

struct EpiY {
    bf16_t* y;
    __device__ __forceinline__ void operator()(AccRef acc, const Unit& u, int wr, int wc, int fr, int fq) const {
#pragma unroll
        for (int ai = 0; ai < 2; ++ai)
#pragma unroll
            for (int m = 0; m < 4; ++m) {
                const int item = u.pm * 256 + ai * 128 + wr * 64 + m * 16 + fr;
                if (item < IT_REAL) {
#pragma unroll
                    for (int bj = 0; bj < 2; ++bj) {
                        const int col = u.pn * 256 + bj * 128 + wc * 32 + 8 * fq, to = col >> 4, ho = col & 15;
                        f32x4 v0 = acc[ai][bj][m][0], v1 = acc[ai][bj][m][1];
#pragma unroll
                        for (int j = 0; j < 4; ++j) { v0[j] = gelu_tanh(v0[j]); v1[j] = gelu_tanh(v1[j]); }
                        *(u32x4*)(y + (size_t)(item * 32 + to) * 512 + u.g * 16 + ho) = pack8(v0, v1);
                    }
                }
            }
    }
};

struct EpiGlu {
    bf16_t* ga;
    __device__ __forceinline__ void operator()(AccRef acc, const Unit& u, int wr, int wc, int fr, int fq) const {
        u32x4 gw[2][4];
#pragma unroll
        for (int ai = 0; ai < 2; ++ai)
#pragma unroll
            for (int m = 0; m < 4; ++m) {
                const int row = u.pm * 256 + ai * 128 + wr * 64 + m * 16 + fr;
                gw[ai][m] = *(const u32x4*)(ga + (size_t)row * 1024 + u.pn * 128 + wc * 32 + 8 * fq);
            }
#pragma unroll
        for (int ai = 0; ai < 2; ++ai)
#pragma unroll
            for (int m = 0; m < 4; ++m) {
                const int row = u.pm * 256 + ai * 128 + wr * 64 + m * 16 + fr;
                bf16_t* p = ga + (size_t)row * 1024 + u.pn * 128 + wc * 32 + 8 * fq;
                const u32x4 g = gw[ai][m];
                const f32x4 a0 = acc[ai][0][m][0], a1 = acc[ai][0][m][1], g0 = acc[ai][1][m][0], g1 = acc[ai][1][m][1];
                f32x4 r0, r1;
                r0[0] = bflo(g.x) * a0[0] * sigmoidf_(g0[0]); r0[1] = bfhi(g.x) * a0[1] * sigmoidf_(g0[1]);
                r0[2] = bflo(g.y) * a0[2] * sigmoidf_(g0[2]); r0[3] = bfhi(g.y) * a0[3] * sigmoidf_(g0[3]);
                r1[0] = bflo(g.z) * a1[0] * sigmoidf_(g1[0]); r1[1] = bfhi(g.z) * a1[1] * sigmoidf_(g1[1]);
                r1[2] = bflo(g.w) * a1[2] * sigmoidf_(g1[2]); r1[3] = bfhi(g.w) * a1[3] * sigmoidf_(g1[3]);
                *(u32x4*)p = pack8(r0, r1);
            }
    }
};

struct EpiRet {
    const bf16_t *pa, *gb; bf16_t* mixed;
    __device__ __forceinline__ void operator()(AccRef acc, const Unit& u, int wr, int wc, int fr, int fq) const {
#pragma unroll
        for (int ai = 0; ai < 2; ++ai) {
            u32x4 pw[4][2], gw[4][2];
#pragma unroll
            for (int m = 0; m < 4; ++m)
#pragma unroll
                for (int bj = 0; bj < 2; ++bj) {
                    const int row = u.pm * 256 + ai * 128 + wr * 64 + m * 16 + fr;
                    const size_t o = (size_t)row * 1024 + u.pn * 256 + bj * 128 + wc * 32 + 8 * fq;
                    pw[m][bj] = *(const u32x4*)(pa + o); gw[m][bj] = *(const u32x4*)(gb + o);
                }
#pragma unroll
            for (int m = 0; m < 4; ++m)
#pragma unroll
                for (int bj = 0; bj < 2; ++bj) {
                    const int row = u.pm * 256 + ai * 128 + wr * 64 + m * 16 + fr;
                    const size_t o = (size_t)row * 1024 + u.pn * 256 + bj * 128 + wc * 32 + 8 * fq;
                    const u32x4 p = pw[m][bj], g = gw[m][bj];
                    const f32x4 a0 = acc[ai][bj][m][0], a1 = acc[ai][bj][m][1];
                    f32x4 r0, r1;
                    r0[0] = bflo(p.x) + bflo(g.x) * a0[0]; r0[1] = bfhi(p.x) + bfhi(g.x) * a0[1];
                    r0[2] = bflo(p.y) + bflo(g.y) * a0[2]; r0[3] = bfhi(p.y) + bfhi(g.y) * a0[3];
                    r1[0] = bflo(p.z) + bflo(g.z) * a1[0]; r1[1] = bfhi(p.z) + bfhi(g.z) * a1[1];
                    r1[2] = bflo(p.w) + bflo(g.w) * a1[2]; r1[3] = bfhi(p.w) + bfhi(g.w) * a1[3];
                    *(u32x4*)(mixed + o) = pack8(r0, r1);
                }
            __builtin_amdgcn_sched_barrier(0);
        }
    }
};

template <int MODE>
struct EpiRes {
    const float *xp, *xs; bf16_t* hb; float* ssq;
    __device__ __forceinline__ void operator()(AccRef acc, const Unit& u, int wr, int wc, int fr, int fq) const {
#pragma unroll
        for (int ai = 0; ai < 2; ++ai) {
            f32x4 x0[4][2], x1[4][2]; u32x4 hw[4][2];
#pragma unroll
            for (int m = 0; m < 4; ++m)
#pragma unroll
                for (int bj = 0; bj < 2; ++bj) {
                    const int row = u.pm * 256 + ai * 128 + wr * 64 + m * 16 + fr, col = u.pn * 256 + bj * 128 + wc * 32 + 8 * fq;
                    if (MODE == 0) {
                        const float* src = (row < NPR ? xp + (size_t)row * 1024 : xs + (size_t)(row - NPR) * 1024) + col;
                        x0[m][bj] = *(const f32x4*)src; x1[m][bj] = *(const f32x4*)(src + 4);
                    } else hw[m][bj] = *(const u32x4*)(hb + (size_t)row * 1024 + col);
                }
#pragma unroll
            for (int m = 0; m < 4; ++m) {
                const int row = u.pm * 256 + ai * 128 + wr * 64 + m * 16 + fr;
                float ss = 0.f;
#pragma unroll
                for (int bj = 0; bj < 2; ++bj) {
                    const int col = u.pn * 256 + bj * 128 + wc * 32 + 8 * fq;
                    f32x4 h0, h1;
                    if (MODE == 0) { h0 = x0[m][bj]; h1 = x1[m][bj]; }
                    else { const u32x4 w = hw[m][bj]; h0 = (f32x4){bflo(w.x), bfhi(w.x), bflo(w.y), bfhi(w.y)}; h1 = (f32x4){bflo(w.z), bfhi(w.z), bflo(w.w), bfhi(w.w)}; }
                    h0 = h0 + acc[ai][bj][m][0]; h1 = h1 + acc[ai][bj][m][1];
                    *(u32x4*)(hb + (size_t)row * 1024 + col) = pack8(h0, h1);
                    ss += (h0[0] * h0[0] + h0[1] * h0[1]) + (h0[2] * h0[2] + h0[3] * h0[3]) + (h1[0] * h1[0] + h1[1] * h1[1]) + (h1[2] * h1[2] + h1[3] * h1[3]);
                }
                ss += __shfl_xor(ss, 16); ss += __shfl_xor(ss, 32);
                if (fq == 0) ssq[(size_t)row * 16 + u.pn * 4 + wc] = ss;
            }
            __builtin_amdgcn_sched_barrier(0);
        }
    }
};

struct EpiFfi {
    const float* ssq; bf16_t* act;
    __device__ __forceinline__ void operator()(AccRef acc, const Unit& u, int wr, int wc, int fr, int fq) const {
        f32x4 sp[2][4];
#pragma unroll
        for (int ai = 0; ai < 2; ++ai)
#pragma unroll
            for (int m = 0; m < 4; ++m) {
                const int row = u.pm * 256 + ai * 128 + wr * 64 + m * 16 + fr;
                sp[ai][m] = *(const f32x4*)(ssq + (size_t)row * 16 + 4 * fq);
            }
#pragma unroll
        for (int ai = 0; ai < 2; ++ai)
#pragma unroll
            for (int m = 0; m < 4; ++m) {
                const int row = u.pm * 256 + ai * 128 + wr * 64 + m * 16 + fr;
                float tot = (sp[ai][m][0] + sp[ai][m][1]) + (sp[ai][m][2] + sp[ai][m][3]);
                tot += __shfl_xor(tot, 16); tot += __shfl_xor(tot, 32);
                const float rstd = rsqrtf(tot * (1.0f / 1024.0f) + EPS);
                const f32x4 g0 = acc[ai][0][m][0], g1 = acc[ai][0][m][1], u0 = acc[ai][1][m][0], u1 = acc[ai][1][m][1];
                f32x4 r0, r1;
#pragma unroll
                for (int j = 0; j < 4; ++j) { r0[j] = siluf_(rstd * g0[j]) * (rstd * u0[j]); r1[j] = siluf_(rstd * g1[j]) * (rstd * u1[j]); }
                *(u32x4*)(act + (size_t)row * DFF + u.pn * 128 + wc * 32 + 8 * fq) = pack8(r0, r1);
            }
    }
};

__device__ __forceinline__ void p0_s5gen(const Args& a, LAS float* L, int g, int qd) {
    const int tid = threadIdx.x;
    LAS float* Kt = L;
    LAS float* Ap = L + 16384;
    LAS float* Bb = Ap + 33 * 64 * 2;
    LAS float* Cc = Bb + 2048;
    bf16_t* bts = (bf16_t*)(a.ws + OFF_BTS) + (size_t)g * 256 * 512;
    bf16_t* bty = (bf16_t*)(a.ws + OFF_BTY) + (size_t)g * 512 * 768;
    float* attab = (float*)(a.ws + OFF_AT);
    bf16_t* u5 = (bf16_t*)(a.ws + OFF_U5);
    if (qd == 0) for (int e = tid; e < 24 * 256; e += 512) { const int b = e >> 8, kk = e & 255; u5[((size_t)g * IT_PAD + IT_REAL + b) * LDA5 + kk] = 0; }
    for (int dir = 0; dir < 2; ++dir) {
        const int pg = dir * 32 + g;
        const double dt = exp((double)a.in[7][pg]);
        for (int idx = tid; idx < 33 * 64; idx += 512) {
            const int p = idx & 63, d = idx >> 6;
            const double lr = a.in[5][pg * 64 + p], li = a.in[6][pg * 64 + p];
            const float mag = (float)exp(lr * dt * d);
            float s, c; sincos_rev(li * dt * d, s, c);
            Ap[idx * 2] = mag * c; Ap[idx * 2 + 1] = mag * s;
            if (d == 32 && qd == 0) { attab[(pg * 64 + p) * 2] = mag * c; attab[(pg * 64 + p) * 2 + 1] = mag * s; }
        }
        for (int idx = tid; idx < 1024; idx += 512) {
            const int p = idx >> 4, h = idx & 15;
            const double lr = a.in[5][pg * 64 + p], li = a.in[6][pg * 64 + p];
            const double zr = lr * dt, zi = li * dt, mag = exp(zr);
            float sh, ch, s1, c1; sincos_rev(0.5 * zi, sh, ch); sincos_rev(zi, s1, c1);
            const double nr = mag * (-2.0 * (double)sh * (double)sh) + expm1(zr);
            const double abi = mag * (double)s1, den = lr * lr + li * li;
            const double cre = (nr * lr + abi * li) / den, cim = (abi * lr - nr * li) / den;
            const double br = a.in[8][(size_t)(pg * 64 + p) * 16 + h], bi = a.in[9][(size_t)(pg * 64 + p) * 16 + h];
            Bb[idx * 2] = (float)(cre * br - cim * bi); Bb[idx * 2 + 1] = (float)(cre * bi + cim * br);
        }
        for (int idx = tid; idx < 1024; idx += 512) {
            Cc[idx * 2] = a.in[10][(size_t)pg * 1024 + idx]; Cc[idx * 2 + 1] = a.in[11][(size_t)pg * 1024 + idx];
        }
        __syncthreads();
        for (int e = tid; e < 8192; e += 512) {
            const int d = e >> 8, ho = (e >> 4) & 15, hi = e & 15;
            float sum = 0.f;
            for (int p = 0; p < 64; ++p) {
                const float cr = Cc[(ho * 64 + p) * 2], ci = Cc[(ho * 64 + p) * 2 + 1], ar = Ap[(d * 64 + p) * 2], ai = Ap[(d * 64 + p) * 2 + 1];
                const float br = Bb[(p * 16 + hi) * 2], bi = Bb[(p * 16 + hi) * 2 + 1];
                const float car = cr * ar - ci * ai, cai = cr * ai + ci * ar;
                sum += car * br - cai * bi;
            }
            Kt[dir * 8192 + e] = sum;
        }
        for (int e = qd * 16384 + tid; e < (qd + 1) * 16384; e += 512) {
            const int k = e & 511, nn = e >> 9, c = nn >> 6, p = nn & 63, t = k >> 4, hi = k & 15;
            const int dd = dir == 0 ? (T5 - 1 - t) : t;
            const float ar = Ap[(dd * 64 + p) * 2], ai = Ap[(dd * 64 + p) * 2 + 1], br = Bb[(p * 16 + hi) * 2], bi = Bb[(p * 16 + hi) * 2 + 1];
            const float val = c ? (ar * bi + ai * br) : (ar * br - ai * bi);
            bts[(size_t)(dir * 128 + nn) * 512 + k] = f2bf(val);
        }
        for (int e = qd * 16384 + tid; e < (qd + 1) * 16384; e += 512) {
            const int kk = e & 127, n = e >> 7, c = kk >> 6, p = kk & 63, to = n >> 4, ho = n & 15;
            const int dd = dir == 0 ? (to + 1) : (T5 - to);
            const float cr = Cc[(ho * 64 + p) * 2], ci = Cc[(ho * 64 + p) * 2 + 1], ar = Ap[(dd * 64 + p) * 2], ai = Ap[(dd * 64 + p) * 2 + 1];
            const float val = c ? -(cr * ai + ci * ar) : (cr * ar - ci * ai);
            bty[(size_t)n * 768 + 512 + dir * 128 + kk] = f2bf(val);
        }
        __syncthreads();
    }
    for (int e = qd * 65536 + tid; e < (qd + 1) * 65536; e += 512) {
        const int k = e & 511, n = e >> 9, to = n >> 4, ho = n & 15, ti = k >> 4, hi = k & 15;
        float val = 0.f;
        if (to >= ti) val += Kt[((to - ti) * 16 + ho) * 16 + hi];
        if (ti >= to) val += Kt[8192 + ((ti - to) * 16 + ho) * 16 + hi];
        if (to == ti && ho == hi) val += a.in[12][g * 16 + ho];
        bty[(size_t)n * 768 + k] = f2bf(val);
    }
    __syncthreads();
}

__device__ __forceinline__ int src_col(int kind, int n) {
    if (kind == 1) { if (n >= 512 && n < 1536) { const int r = n - 512, seg = r >> 7, dp = r & 127; return 512 + seg * 128 + (dp >> 1) + 64 * (dp & 1); } return n; }
    if (kind == 2) { const int pn = n >> 8, bj = (n >> 7) & 1, cc = n & 127; return bj * 1024 + pn * 128 + cc; }
    if (kind == 3) { const int pn = n >> 8, bj = (n >> 7) & 1, cc = n & 127; return bj * DFF + pn * 128 + cc; }
    return n;
}
__device__ __forceinline__ void p0_wtile(const float* W, int K, int N, bf16_t* WT, int kind, const float* kscale, int tile, LAS float* L) {
    const int tid = threadIdx.x, nkt = K >> 6, nt_ = tile / nkt, kt = tile % nkt, n0 = nt_ * 64, k0 = kt * 64;
#pragma unroll
    for (int it = 0; it < 8; ++it) {
        const int idx = tid + it * 512, kk = idx >> 6, j = idx & 63;
        float v = W[(size_t)(k0 + kk) * N + src_col(kind, n0 + j)];
        if (kscale) v *= kscale[k0 + kk];
        L[kk * 65 + j] = v;
    }
    __syncthreads();
#pragma unroll
    for (int it = 0; it < 4; ++it) {
        const int idx = tid + it * 512, j = idx >> 5, kp = idx & 31;
        *(unsigned*)(WT + (size_t)(n0 + j) * K + k0 + 2 * kp) = cvt_pk_bf16(L[(2 * kp) * 65 + j], L[(2 * kp + 1) * 65 + j]);
    }
    __syncthreads();
}

__device__ __forceinline__ void phase0(const Args& a, LAS unsigned char* lds) {
    LAS float* L = (LAS float*)lds;
    const int tid = threadIdx.x, wave = tid >> 6, lane = tid & 63;
    constexpr int T_IN = 88 * 16, T_GLU = 32 * 8, T_RET = 256, T_OUT = 256, T_FFI = 88 * 16, T_FFO = 16 * 44;
    constexpr int NW = 128 + T_IN + T_GLU + T_RET + T_OUT + T_FFI + T_FFO, NRM = RPAD / 32;
    for (int w = blockIdx.x; w < NW + NRM; w += gridDim.x) {
        int r = w;
        if (r < 128) { p0_s5gen(a, L, r >> 2, r & 3); continue; } r -= 128;
        if (r < T_IN) { p0_wtile(a.in[4], 1024, INW, (bf16_t*)(a.ws + OFF_WIN), 1, nullptr, r, L); continue; } r -= T_IN;
        if (r < T_GLU) { p0_wtile(a.in[13], 512, 2048, (bf16_t*)(a.ws + OFF_WGLU), 2, nullptr, r, L); continue; } r -= T_GLU;
        if (r < T_RET) { p0_wtile(a.in[15], 1024, 1024, (bf16_t*)(a.ws + OFF_WRET), 0, nullptr, r, L); continue; } r -= T_RET;
        if (r < T_OUT) { p0_wtile(a.in[16], 1024, 1024, (bf16_t*)(a.ws + OFF_WOUT), 0, nullptr, r, L); continue; } r -= T_OUT;
        if (r < T_FFI) { p0_wtile(a.in[18], 1024, INW, (bf16_t*)(a.ws + OFF_WFFI), 3, a.in[17], r, L); continue; } r -= T_FFI;
        if (r < T_FFO) { p0_wtile(a.in[19], DFF, 1024, (bf16_t*)(a.ws + OFF_WFFO), 0, nullptr, r, L); continue; } r -= T_FFO;
        const int rowb = r * 32 + wave * 4;
        const float* xr[4]; f32x4 v[4][4];
#pragma unroll
        for (int q = 0; q < 4; ++q) {
            const int row = rowb + q;
            xr[q] = row < NPR ? a.in[0] + (size_t)row * 1024 : (row < NREAL ? a.in[1] + (size_t)(row - NPR) * 1024 : a.in[2] + (size_t)((row - NREAL) & 15) * 1024);
#pragma unroll
            for (int j = 0; j < 4; ++j) v[q][j] = (row < NVALID) ? *(const f32x4*)(xr[q] + (j * 64 + lane) * 4) : (f32x4){0.f, 0.f, 0.f, 0.f};
        }
        f32x4 gg[4];
#pragma unroll
        for (int j = 0; j < 4; ++j) gg[j] = *(const f32x4*)(a.in[3] + (j * 64 + lane) * 4);
#pragma unroll
        for (int q = 0; q < 4; ++q) {
            float sq = 0.f;
#pragma unroll
            for (int j = 0; j < 4; ++j) sq += (v[q][j][0] * v[q][j][0] + v[q][j][1] * v[q][j][1]) + (v[q][j][2] * v[q][j][2] + v[q][j][3] * v[q][j][3]);
            const float rstd = rsqrtf(wave_sum(sq) * (1.0f / 1024.0f) + EPS);
            bf16_t* orow = (bf16_t*)(a.ws + OFF_N1) + (size_t)(rowb + q) * 1024;
#pragma unroll
            for (int j = 0; j < 4; ++j) {
                u32x2 o; o.x = cvt_pk_bf16(v[q][j][0] * rstd * gg[j][0], v[q][j][1] * rstd * gg[j][1]); o.y = cvt_pk_bf16(v[q][j][2] * rstd * gg[j][2], v[q][j][3] * rstd * gg[j][3]);
                *(u32x2*)(orow + (j * 64 + lane) * 4) = o;
            }
        }
    }
}

__device__ __forceinline__ void s5_scan(const Args& a) {
    const float* attab = (const float*)(a.ws + OFF_AT);
    const float* sloc = (const float*)(a.ws + OFF_SLOC);
    bf16_t* u5 = (bf16_t*)(a.ws + OFF_U5);
    for (int id = blockIdx.x * 512 + threadIdx.x; id < 24 * 32 * 2 * 64; id += gridDim.x * 512) {
        const int p = id & 63, dir = (id >> 6) & 1, g = (id >> 7) & 31, b = id >> 12;
        const float atr = attab[((dir * 32 + g) * 64 + p) * 2], ati = attab[((dir * 32 + g) * 64 + p) * 2 + 1];
        const int nck = b < 16 ? 128 : 64, base = b < 16 ? b * 128 : 2048 + (b - 16) * 64, mitem = IT_REAL + b;
        const float* sl = sloc + (size_t)g * IT_PAD * 256 + dir * 128 + p;
        bf16_t* ub = u5 + (size_t)g * IT_PAD * LDA5 + 512 + dir * 128 + p;
        float sr = 0.f, si = 0.f;
        if (dir == 0) {
            ub[(size_t)mitem * LDA5] = 0; ub[(size_t)mitem * LDA5 + 64] = 0;
            sr = sl[(size_t)mitem * 256]; si = sl[(size_t)mitem * 256 + 64];
            for (int c0 = 0; c0 < nck; c0 += 8) {
                float lr[8], li[8];
#pragma unroll
                for (int j = 0; j < 8; ++j) { lr[j] = sl[(size_t)(base + c0 + j) * 256]; li[j] = sl[(size_t)(base + c0 + j) * 256 + 64]; }
#pragma unroll
                for (int j = 0; j < 8; ++j) {
                    const size_t it = (size_t)(base + c0 + j);
                    ub[it * LDA5] = f2bf(sr); ub[it * LDA5 + 64] = f2bf(si);
                    const float nr = atr * sr - ati * si + lr[j], ni = atr * si + ati * sr + li[j];
                    sr = nr; si = ni;
                }
            }
        } else {
            for (int c0 = nck - 8; c0 >= 0; c0 -= 8) {
                float lr[8], li[8];
#pragma unroll
                for (int j = 0; j < 8; ++j) { lr[j] = sl[(size_t)(base + c0 + j) * 256]; li[j] = sl[(size_t)(base + c0 + j) * 256 + 64]; }
#pragma unroll
                for (int j = 7; j >= 0; --j) {
                    const size_t it = (size_t)(base + c0 + j);
                    ub[it * LDA5] = f2bf(sr); ub[it * LDA5 + 64] = f2bf(si);
                    const float nr = atr * sr - ati * si + lr[j], ni = atr * si + ati * sr + li[j];
                    sr = nr; si = ni;
                }
            }
            ub[(size_t)mitem * LDA5] = f2bf(sr); ub[(size_t)mitem * LDA5 + 64] = f2bf(si);
        }
    }
}

constexpr int LDR = 136;
__device__ __forceinline__ float bf2f(bf16_t h) { return __uint_as_float(((unsigned)h) << 16); }

__device__ __forceinline__ void tr_store_pair(LAS bf16_t* img, int f0, int s2, u32x4 r0, u32x4 r1) {
    LAS unsigned* p = (LAS unsigned*)(img + f0 * LDR + s2);
    p[0 * (LDR / 2)] = (r0.x & 0xFFFFu) | (r1.x << 16); p[1 * (LDR / 2)] = (r0.x >> 16) | (r1.x & 0xFFFF0000u);
    p[2 * (LDR / 2)] = (r0.y & 0xFFFFu) | (r1.y << 16); p[3 * (LDR / 2)] = (r0.y >> 16) | (r1.y & 0xFFFF0000u);
    p[4 * (LDR / 2)] = (r0.z & 0xFFFFu) | (r1.z << 16); p[5 * (LDR / 2)] = (r0.z >> 16) | (r1.z & 0xFFFF0000u);
    p[6 * (LDR / 2)] = (r0.w & 0xFFFFu) | (r1.w << 16); p[7 * (LDR / 2)] = (r0.w >> 16) | (r1.w & 0xFFFF0000u);
}
__device__ __forceinline__ void tr_store_pair_scaled(LAS bf16_t* img, int f0, int s2, u32x4 r0, u32x4 r1, float w0, float w1) {
    LAS unsigned* p = (LAS unsigned*)(img + f0 * LDR + s2);
    p[0 * (LDR / 2)] = cvt_pk_bf16(bflo(r0.x) * w0, bflo(r1.x) * w1); p[1 * (LDR / 2)] = cvt_pk_bf16(bfhi(r0.x) * w0, bfhi(r1.x) * w1);
    p[2 * (LDR / 2)] = cvt_pk_bf16(bflo(r0.y) * w0, bflo(r1.y) * w1); p[3 * (LDR / 2)] = cvt_pk_bf16(bfhi(r0.y) * w0, bfhi(r1.y) * w1);
    p[4 * (LDR / 2)] = cvt_pk_bf16(bflo(r0.z) * w0, bflo(r1.z) * w1); p[5 * (LDR / 2)] = cvt_pk_bf16(bfhi(r0.z) * w0, bfhi(r1.z) * w1);
    p[6 * (LDR / 2)] = cvt_pk_bf16(bflo(r0.w) * w0, bflo(r1.w) * w1); p[7 * (LDR / 2)] = cvt_pk_bf16(bfhi(r0.w) * w0, bfhi(r1.w) * w1);
}

#define LDS_BARRIER() do { asm volatile("s_waitcnt lgkmcnt(0)" ::: "memory"); __builtin_amdgcn_s_barrier(); asm volatile("" ::: "memory"); } while (0)
__device__ __forceinline__ void ret_pass_a(const Args& a, LAS unsigned char* lds) {
    LAS bf16_t* KT = (LAS bf16_t*)lds;
    LAS bf16_t* VT = KT + 128 * LDR;
    const int tid0 = threadIdx.x;
    const bf16_t* kb = (const bf16_t*)(a.ws + OFF_K); const bf16_t* vb = (const bf16_t*)(a.ws + OFF_V);
    bf16_t* stb = (bf16_t*)(a.ws + OFF_ST);
    for (int item = blockIdx.x; item < 192; item += gridDim.x) {
        int tid = tid0; asm volatile("" : "+v"(tid));
        const int w = tid >> 6, lane = tid & 63, fr = lane & 15, fq = lane >> 4;
        int b, h, dir;
        if (item < 128) { b = item >> 3; h = (item >> 1) & 3; dir = item & 1; } else { const int j = item - 128; b = 16 + (j >> 3); h = (j >> 1) & 3; dir = j & 1; }
        const int NC = b < 16 ? 32 : 16, rbase = b < 16 ? b * 4096 : NPR + (b - 16) * 2048, ebase = b < 16 ? b * 33 : 528 + (b - 16) * 17;
        const float lg = logsigf_(a.in[14][dir * 4 + h]);
        const float carry = __expf(lg * 128.f);
        const int s2 = 2 * (8 * w + (lane & 7)), pg = lane >> 3;
        const float wk0 = dir == 0 ? __expf(lg * (float)(127 - s2)) : __expf(lg * (float)s2);
        const float wk1 = dir == 0 ? __expf(lg * (float)(126 - s2)) : __expf(lg * (float)(s2 + 1));
        f32x4 acc[2][8];
#pragma unroll
        for (int et = 0; et < 2; ++et)
#pragma unroll
            for (int dtl = 0; dtl < 8; ++dtl) acc[et][dtl] = (f32x4){0.f, 0.f, 0.f, 0.f};
        const int nsteps = dir == 0 ? NC : NC;
        u32x4 rk[2][2], rv[4][2];
        auto load_chunk = [&](int n) {
            int row0; bool valid = true;
            if (n == 0) { valid = s2 >= 112; row0 = NREAL + b * 16 + (s2 - 112); } else row0 = rbase + (n - 1) * 128 + s2;
#pragma unroll
            for (int it = 0; it < 2; ++it)
#pragma unroll
                for (int r = 0; r < 2; ++r) {
                    rk[it][r] = (u32x4){0u, 0u, 0u, 0u};
                    if (valid) rk[it][r] = *(const u32x4*)(kb + (size_t)(row0 + r) * 512 + h * 128 + (pg + 8 * it) * 8);
                }
#pragma unroll
            for (int it = 0; it < 4; ++it)
#pragma unroll
                for (int r = 0; r < 2; ++r) {
                    rv[it][r] = (u32x4){0u, 0u, 0u, 0u};
                    if (valid) rv[it][r] = *(const u32x4*)(vb + (size_t)(row0 + r) * 1024 + h * 256 + (pg + 8 * it) * 8);
                }
        };
        load_chunk(dir == 0 ? 0 : NC);
        for (int step = 0; step < nsteps; ++step) {
            const int n = dir == 0 ? step : NC - step;
            {
                bf16_t* spn = stb + ((size_t)((ebase + n) * 4 + h) * 2 + dir) * 32768;
#pragma unroll
                for (int et = 0; et < 2; ++et)
#pragma unroll
                    for (int dtl = 0; dtl < 8; ++dtl) {
                        u32x2 o; o.x = cvt_pk_bf16(acc[et][dtl][0], acc[et][dtl][1]); o.y = cvt_pk_bf16(acc[et][dtl][2], acc[et][dtl][3]);
                        *(u32x2*)(spn + (size_t)(32 * w + 16 * et + fr) * 128 + 16 * dtl + 4 * fq) = o;
                    }
            }
            LDS_BARRIER();
#pragma unroll
            for (int it = 0; it < 2; ++it) tr_store_pair_scaled(KT, (pg + 8 * it) * 8, s2, rk[it][0], rk[it][1], wk0, wk1);
#pragma unroll
            for (int it = 0; it < 4; ++it) tr_store_pair(VT, (pg + 8 * it) * 8, s2, rv[it][0], rv[it][1]);
            if (step + 1 < nsteps) load_chunk(dir == 0 ? step + 1 : NC - step - 1);
            LDS_BARRIER();
#pragma unroll
            for (int et = 0; et < 2; ++et)
#pragma unroll
                for (int dtl = 0; dtl < 8; ++dtl) acc[et][dtl] = acc[et][dtl] * carry;
#pragma unroll
            for (int ks = 0; ks < 4; ++ks) {
                bf16x8 vf[2];
#pragma unroll
                for (int et = 0; et < 2; ++et) vf[et] = *(const LAS bf16x8*)(VT + (32 * w + 16 * et + fr) * LDR + 32 * ks + 8 * fq);
#pragma unroll
                for (int dtl = 0; dtl < 8; ++dtl) {
                    const bf16x8 kf = *(const LAS bf16x8*)(KT + (16 * dtl + fr) * LDR + 32 * ks + 8 * fq);
#pragma unroll
                    for (int et = 0; et < 2; ++et) acc[et][dtl] = __builtin_amdgcn_mfma_f32_16x16x32_bf16(kf, vf[et], acc[et][dtl], 0, 0, 0);
                }
            }
        }
        if (dir == 0) {
            bf16_t* spn = stb + ((size_t)((ebase + NC) * 4 + h) * 2 + dir) * 32768;
#pragma unroll
            for (int et = 0; et < 2; ++et)
#pragma unroll
                for (int dtl = 0; dtl < 8; ++dtl) {
                    u32x2 o; o.x = cvt_pk_bf16(acc[et][dtl][0], acc[et][dtl][1]); o.y = cvt_pk_bf16(acc[et][dtl][2], acc[et][dtl][3]);
                    *(u32x2*)(spn + (size_t)(32 * w + 16 * et + fr) * 128 + 16 * dtl + 4 * fq) = o;
                }
        }
        LDS_BARRIER();
    }
}

__device__ __forceinline__ void ret_pass_b(const Args& a, LAS unsigned char* lds) {
    LAS bf16_t* KL = (LAS bf16_t*)lds;
    LAS bf16_t* BG = KL + 128 * LDR;
    const int tid0 = threadIdx.x;
    const bf16_t* qb = (const bf16_t*)(a.ws + OFF_Q); const bf16_t* kb = (const bf16_t*)(a.ws + OFF_K); const bf16_t* vb = (const bf16_t*)(a.ws + OFF_V);
    const bf16_t* stb = (const bf16_t*)(a.ws + OFF_ST);
    bf16_t* sg = (bf16_t*)a.out;
    u32x4 rk[4], rb[8]; bf16x8 qf[4];
    auto item_info = [&](int item, int& r0, int& h, const bf16_t*& sfp) {
        const int rc = item >> 2; h = item & 3;
        int b, n; if (rc < 512) { b = rc >> 5; n = (rc & 31) + 1; } else { b = 16 + ((rc - 512) >> 4); n = ((rc - 512) & 15) + 1; }
        const int ebase = b < 16 ? b * 33 : 528 + (b - 16) * 17; r0 = rc * 128;
        sfp = stb + ((size_t)((ebase + n) * 4 + h) * 2 + 0) * 32768;
    };
    auto load_item_head = [&](int item, int tid) {
        int r0, h; const bf16_t* sfp; item_info(item, r0, h, sfp);
#pragma unroll
        for (int it = 0; it < 8; ++it) { const int idx = tid + it * 512, e = idx >> 4, pc = idx & 15; rb[it] = *(const u32x4*)(sfp + (size_t)e * 128 + pc * 8); }
    };
    if ((int)blockIdx.x < 2560) load_item_head(blockIdx.x, tid0);
    for (int item = blockIdx.x; item < 2560; item += gridDim.x) {
        int tid = tid0; asm volatile("" : "+v"(tid));
        const int w = tid >> 6, lane = tid & 63, fr = lane & 15, fq = lane >> 4;
        int r0, h; const bf16_t* sfp; item_info(item, r0, h, sfp);
        const bf16_t* sbp = sfp + 32768;
        const float lgf = logsigf_(a.in[14][h]), lgb = logsigf_(a.in[14][4 + h]);
        const int crow = 16 * w + fr;
#pragma unroll
        for (int it = 0; it < 4; ++it) { const int idx = tid + it * 512, s = idx >> 4, pc = idx & 15; rk[it] = *(const u32x4*)(kb + (size_t)(r0 + s) * 512 + h * 128 + pc * 8); }
#pragma unroll
        for (int ks = 0; ks < 4; ++ks) qf[ks] = *(const bf16x8*)(qb + (size_t)(r0 + crow) * 512 + h * 128 + 32 * ks + 8 * fq);
        LDS_BARRIER();
#pragma unroll
        for (int it = 0; it < 4; ++it) { const int idx = tid + it * 512, s = idx >> 4, pc = idx & 15; *(LAS u32x4*)(KL + s * LDR + pc * 8) = rk[it]; }
#pragma unroll
        for (int it = 0; it < 8; ++it) { const int idx = tid + it * 512, e = idx >> 4, pc = idx & 15; *(LAS u32x4*)(BG + e * LDR + pc * 8) = rb[it]; }
#pragma unroll
        for (int it = 0; it < 8; ++it) { const int idx = tid + it * 512, e = idx >> 4, pc = idx & 15; rb[it] = *(const u32x4*)(sbp + (size_t)e * 128 + pc * 8); }
        LDS_BARRIER();
        f32x4 sacc[8];
#pragma unroll
        for (int st = 0; st < 8; ++st) sacc[st] = (f32x4){0.f, 0.f, 0.f, 0.f};
#pragma unroll
        for (int ks = 0; ks < 4; ++ks)
#pragma unroll
            for (int st = 0; st < 8; ++st) {
                const bf16x8 kf = *(const LAS bf16x8*)(KL + (16 * st + fr) * LDR + 32 * ks + 8 * fq);
                sacc[st] = __builtin_amdgcn_mfma_f32_16x16x32_bf16(kf, qf[ks], sacc[st], 0, 0, 0);
                if (st == 7) __builtin_amdgcn_sched_barrier(0);
            }
        bf16x8 pf[4];
#pragma unroll
        for (int t = 0; t < 4; ++t) {
            float pv[8];
#pragma unroll
            for (int hh = 0; hh < 2; ++hh)
#pragma unroll
                for (int j = 0; j < 4; ++j) {
                    const int spp = 16 * (2 * t + hh) + 4 * fq + j, diff = crow - spp;
                    const float dec = diff >= 0 ? __expf(lgf * (float)diff) : __expf(-lgb * (float)diff);
                    pv[hh * 4 + j] = sacc[2 * t + hh][j] * dec;
                }
            u32x4 pw; pw.x = cvt_pk_bf16(pv[0], pv[1]); pw.y = cvt_pk_bf16(pv[2], pv[3]); pw.z = cvt_pk_bf16(pv[4], pv[5]); pw.w = cvt_pk_bf16(pv[6], pv[7]);
            pf[t] = __builtin_bit_cast(bf16x8, pw);
        }
        f32x4 o[16];
#pragma unroll
        for (int et = 0; et < 16; ++et) o[et] = (f32x4){0.f, 0.f, 0.f, 0.f};
#pragma unroll
        for (int ks = 0; ks < 4; ++ks)
#pragma unroll
            for (int et = 0; et < 16; ++et) {
                const bf16x8 sf = *(const LAS bf16x8*)(BG + (16 * et + fr) * LDR + 32 * ks + 8 * fq);
                o[et] = __builtin_amdgcn_mfma_f32_16x16x32_bf16(sf, qf[ks], o[et], 0, 0, 0);
                if ((et & 7) == 7) __builtin_amdgcn_sched_barrier(0);
            }
        const float wqf = __expf(lgf * (float)(crow + 1)), wqb = __expf(lgb * (float)(128 - crow));
        const float ratio = wqf / wqb;
#pragma unroll
        for (int et = 0; et < 16; ++et) o[et] = o[et] * ratio;
        LDS_BARRIER();
#pragma unroll
        for (int it = 0; it < 8; ++it) { const int idx = tid + it * 512, e = idx >> 4, pc = idx & 15; *(LAS u32x4*)(BG + e * LDR + pc * 8) = rb[it]; }
        {
            const int s2 = 2 * (8 * w + (lane & 7));
#pragma unroll
            for (int it = 0; it < 4; ++it)
#pragma unroll
                for (int r = 0; r < 2; ++r) rb[it * 2 + r] = *(const u32x4*)(vb + (size_t)(r0 + s2 + r) * 1024 + h * 256 + ((lane >> 3) + 8 * it) * 8);
        }
        LDS_BARRIER();
#pragma unroll
        for (int ks = 0; ks < 4; ++ks)
#pragma unroll
            for (int et = 0; et < 16; ++et) {
                const bf16x8 sf = *(const LAS bf16x8*)(BG + (16 * et + fr) * LDR + 32 * ks + 8 * fq);
                o[et] = __builtin_amdgcn_mfma_f32_16x16x32_bf16(sf, qf[ks], o[et], 0, 0, 0);
                if ((et & 7) == 7) __builtin_amdgcn_sched_barrier(0);
            }
#pragma unroll
        for (int et = 0; et < 16; ++et) o[et] = o[et] * wqb;
        LDS_BARRIER();
#pragma unroll
        for (int it = 0; it < 4; ++it) tr_store_pair(BG, ((lane >> 3) + 8 * it) * 8, 2 * (8 * w + (lane & 7)), rb[it * 2], rb[it * 2 + 1]);
        if (item + (int)gridDim.x < 2560) load_item_head(item + gridDim.x, tid);
        LDS_BARRIER();
#pragma unroll
        for (int t = 0; t < 4; ++t)
#pragma unroll
            for (int et = 0; et < 16; ++et) {
                const u32x2 lo = *(const LAS u32x2*)(BG + (16 * et + fr) * LDR + 32 * t + 4 * fq);
                const u32x2 hi = *(const LAS u32x2*)(BG + (16 * et + fr) * LDR + 32 * t + 16 + 4 * fq);
                const u32x4 vw = (u32x4){lo.x, lo.y, hi.x, hi.y};
                o[et] = __builtin_amdgcn_mfma_f32_16x16x32_bf16(__builtin_bit_cast(bf16x8, vw), pf[t], o[et], 0, 0, 0);
                if ((et & 7) == 7) __builtin_amdgcn_sched_barrier(0);
            }
        float ss = 0.f;
#pragma unroll
        for (int et = 0; et < 16; ++et) ss += (o[et][0] * o[et][0] + o[et][1] * o[et][1]) + (o[et][2] * o[et][2] + o[et][3] * o[et][3]);
        ss += __shfl_xor(ss, 16); ss += __shfl_xor(ss, 32);
        const float rn = rsqrtf(ss * (1.0f / 256.0f) + EPS);
        bf16_t* gp = sg + (size_t)(r0 + crow) * 1024 + h * 256 + 4 * fq;
        u32x2 gwv[16];
#pragma unroll
        for (int et = 0; et < 16; ++et) gwv[et] = *(const u32x2*)(gp + 16 * et);
#pragma unroll
        for (int et = 0; et < 16; ++et) {
            const u32x2 gw = gwv[et];
            u32x2 ow; ow.x = cvt_pk_bf16(o[et][0] * rn * bflo(gw.x), o[et][1] * rn * bfhi(gw.x)); ow.y = cvt_pk_bf16(o[et][2] * rn * bflo(gw.y), o[et][3] * rn * bfhi(gw.y));
            *(u32x2*)(gp + 16 * et) = ow;
        }
    }
    LDS_BARRIER();
}

__device__ __forceinline__ void final_norm(const Args& a) {
    const int wave = threadIdx.x >> 6, lane = threadIdx.x & 63;
    const float* ssq = (const float*)(a.ws + OFF_SSQ2);
    f32x4 gg[4];
#pragma unroll
    for (int j = 0; j < 4; ++j) gg[j] = *(const f32x4*)(a.in[20] + (j * 64 + lane) * 4);
    for (int rowb = (blockIdx.x * 8 + wave) * 4; rowb < NREAL; rowb += gridDim.x * 32) {
        float part[4]; u32x2 w[4][4];
#pragma unroll
        for (int q = 0; q < 4; ++q) {
            part[q] = lane < 16 ? ssq[(size_t)(rowb + q) * 16 + lane] : 0.f;
            const bf16_t* hrow = (const bf16_t*)(a.ws + OFF_H1B) + (size_t)(rowb + q) * 1024;
#pragma unroll
            for (int j = 0; j < 4; ++j) w[q][j] = *(const u32x2*)(hrow + (j * 64 + lane) * 4);
        }
#pragma unroll
        for (int q = 0; q < 4; ++q) {
            const float rstd = rsqrtf(wave_sum(part[q]) * (1.0f / 1024.0f) + EPS);
            float* orow = a.out + (size_t)(rowb + q) * 1024;
#pragma unroll
            for (int j = 0; j < 4; ++j) {
                f32x4 v;
                v[0] = bflo(w[q][j].x) * rstd * gg[j][0]; v[1] = bfhi(w[q][j].x) * rstd * gg[j][1]; v[2] = bflo(w[q][j].y) * rstd * gg[j][2]; v[3] = bfhi(w[q][j].y) * rstd * gg[j][3];
                *(f32x4*)(orow + (j * 64 + lane) * 4) = v;
            }
        }
    }
}

template <int ph>
__device__ __forceinline__ void run_phase(const Args& a, LAS unsigned char* lds) {
    unsigned char* ws = a.ws;
    bf16_t* dob = (bf16_t*)a.out;
    bf16_t* sgp = dob; bf16_t* gap = dob + (size_t)NREAL * 1024;
#ifdef ONLY_PH
    if (ph != ONLY_PH) return;
#endif
    switch (ph) {
    case 0: phase0(a, lds); break;
    case 1: {
        pg8::Gemm g{(const bf16_t*)(ws + OFF_N1), (const bf16_t*)(ws + OFF_WIN), 1024, 1024, 1024, RPAD / 256, INW / 256, 1, 0, 0, STG};
        EpiProj E{(bf16_t*)(ws + OFF_U5), (bf16_t*)(ws + OFF_Q), (bf16_t*)(ws + OFF_K), (bf16_t*)(ws + OFF_V), sgp, gap, (bf16_t*)(ws + OFF_GB), (const LAS double*)(lds + 131072)};
        pg8::gemm_phase(lds, g, E);
    } break;
    case 2: {
        pg8::Gemm g{(const bf16_t*)(ws + OFF_U5), (const bf16_t*)(ws + OFF_BTS), LDA5, 512, 512, IT_PAD / 256, 1, 32, (size_t)IT_PAD * LDA5, (size_t)256 * 512, 0};
        EpiSloc E{(float*)(ws + OFF_SLOC)};
        pg8::gemm_phase(lds, g, E);
    } break;
    case 3: s5_scan(a); break;
    case 4: {
        pg8::Gemm g{(const bf16_t*)(ws + OFF_U5), (const bf16_t*)(ws + OFF_BTY), LDA5, 768, 768, IT_PAD / 256, 2, 32, (size_t)IT_PAD * LDA5, (size_t)512 * 768, 0};
        EpiY E{(bf16_t*)(ws + OFF_YSSM)};
        pg8::gemm_phase(lds, g, E);
    } break;
    case 5: {
        pg8::Gemm g{(const bf16_t*)(ws + OFF_YSSM), (const bf16_t*)(ws + OFF_WGLU), 512, 512, 512, NREAL / 256, 8, 1, 0, 0, STG};
        EpiGlu E{gap};
        pg8::gemm_phase(lds, g, E);
    } break;
    case 6: ret_pass_a(a, lds); break;
    case 7: ret_pass_b(a, lds); break;
    case 8: {
        pg8::Gemm g{sgp, (const bf16_t*)(ws + OFF_WRET), 1024, 1024, 1024, NREAL / 256, 4, 1, 0, 0, STG};
        EpiRet E{gap, (const bf16_t*)(ws + OFF_GB), (bf16_t*)(ws + OFF_MIXED)};
        pg8::gemm_phase(lds, g, E);
    } break;
    case 9: {
        pg8::Gemm g{(const bf16_t*)(ws + OFF_MIXED), (const bf16_t*)(ws + OFF_WOUT), 1024, 1024, 1024, NREAL / 256, 4, 1, 0, 0, STG};
        EpiRes<0> E{a.in[0], a.in[1], (bf16_t*)(ws + OFF_H1B), (float*)(ws + OFF_SSQ1)};
        pg8::gemm_phase(lds, g, E);
    } break;
    case 10: {
        pg8::Gemm g{(const bf16_t*)(ws + OFF_H1B), (const bf16_t*)(ws + OFF_WFFI), 1024, 1024, 1024, NREAL / 256, INW / 256, 1, 0, 0, STG};
        EpiFfi E{(const float*)(ws + OFF_SSQ1), (bf16_t*)(ws + OFF_ACT)};
        pg8::gemm_phase(lds, g, E);
    } break;
    case 11: {
        pg8::Gemm g{(const bf16_t*)(ws + OFF_ACT), (const bf16_t*)(ws + OFF_WFFO), DFF, DFF, DFF, NREAL / 256, 4, 1, 0, 0, STG};
        EpiRes<1> E{nullptr, nullptr, (bf16_t*)(ws + OFF_H1B), (float*)(ws + OFF_SSQ2)};
        pg8::gemm_phase(lds, g, E);
    } break;
    case 12: final_norm(a); break;
    default: break;
    }
}

__device__ __forceinline__ void grid_barrier(unsigned* ctr, unsigned target) {
    asm volatile("s_waitcnt vmcnt(0) lgkmcnt(0)" ::: "memory");
    __syncthreads();
    if (threadIdx.x == 0) {
        __builtin_amdgcn_fence(__ATOMIC_RELEASE, "agent");
        asm volatile("s_waitcnt vmcnt(0)" ::: "memory");
        __hip_atomic_fetch_add(ctr, 1u, __ATOMIC_RELAXED, __HIP_MEMORY_SCOPE_AGENT);
        unsigned spins = 0;
        while (__hip_atomic_load(ctr, __ATOMIC_RELAXED, __HIP_MEMORY_SCOPE_AGENT) < target && ++spins < (1u << 24)) __builtin_amdgcn_s_sleep(2);
        __builtin_amdgcn_fence(__ATOMIC_ACQUIRE, "agent");
        asm volatile("s_waitcnt vmcnt(0)" ::: "memory");
    }
    __syncthreads();
}

template <bool COOP>
__global__ __launch_bounds__(512, 2) void fwd_kernel(Args a) {
    extern __shared__ __attribute__((aligned(16))) unsigned char shm[];
    LAS unsigned char* lds = (LAS unsigned char*)shm;
    if (threadIdx.x < 64) ((LAS double*)(lds + 131072))[threadIdx.x] = exp2(-(double)threadIdx.x * (13.287712379549449 / 64.0));
    __syncthreads();
#define RUN_PH(P) if (a.ph_lo <= P && P < a.ph_hi) { run_phase<P>(a, lds); if ((DBL_MASK >> P) & 1) run_phase<P>(a, lds); if (COOP && P + 1 < a.ph_hi) { if (P == 0) { __threadfence(); cg::this_grid().sync(); } else grid_barrier((unsigned*)(a.ws + OFF_BAR), (unsigned)P * gridDim.x); } }
    RUN_PH(0) RUN_PH(1) RUN_PH(2) RUN_PH(3) RUN_PH(4) RUN_PH(5) RUN_PH(6) RUN_PH(7) RUN_PH(8) RUN_PH(9) RUN_PH(10) RUN_PH(11) RUN_PH(12)
#undef RUN_PH
}

extern "C" void kernel_launch(void* const* d_in, const int* in_sizes, int n_in, void* d_out, int out_size, void* d_ws, size_t ws_size, hipStream_t stream) {
    static int grid = 0;
    if (grid == 0) {
        if (n_in != 21 || ws_size < WS_NEED || out_size != NREAL * 1024) { fprintf(stderr, "kernel_launch: unexpected shapes (n_in %d, ws %zu need %zu, out %d)\n", n_in, ws_size, (size_t)WS_NEED, out_size); grid = -1; return; }
        int dev = 0, cus = 0;
        hipGetDevice(&dev); hipDeviceGetAttribute(&cus, hipDeviceAttributeMultiprocessorCount, dev);
        hipFuncSetAttribute((const void*)fwd_kernel<true>, hipFuncAttributeMaxDynamicSharedMemorySize, LDS_BYTES);
        hipFuncSetAttribute((const void*)fwd_kernel<false>, hipFuncAttributeMaxDynamicSharedMemorySize, LDS_BYTES);
        int per_cu = 0;
        hipOccupancyMaxActiveBlocksPerMultiprocessor(&per_cu, (const void*)fwd_kernel<true>, 512, LDS_BYTES);
        if (per_cu < 1) { fprintf(stderr, "kernel_launch: occupancy query says %d blocks per CU\n", per_cu); per_cu = 1; }
        (void)hipGetLastError();
        grid = cus * 1;
    }
    if (grid < 0) return;
    Args a{};
    for (int i = 0; i < 21; ++i) a.in[i] = (const float*)d_in[i];
    a.out = (float*)d_out; a.ws = (unsigned char*)d_ws;
#if COOP_MODE
    hipMemsetAsync((char*)d_ws + OFF_BAR, 0, 256, stream);
    a.ph_lo = 0; a.ph_hi = NPHASE;
    void* args[] = {&a};
    hipError_t e = hipLaunchCooperativeKernel((const void*)fwd_kernel<true>, dim3(grid), dim3(512), args, LDS_BYTES, stream);
    if (e != hipSuccess) fprintf(stderr, "cooperative launch failed: %s (grid %d)\n", hipGetErrorString(e), grid);
#else
    for (int ph = 0; ph < NPHASE; ++ph) {
        a.ph_lo = ph; a.ph_hi = ph + 1;
        hipLaunchKernelGGL(fwd_kernel<false>, dim3(grid), dim3(512), LDS_BYTES, stream, a);
    }
#endif
}
```

```cpp
#include <hip/hip_runtime.h>
#include <hip/hip_cooperative_groups.h>
#include <cstdio>
#include <cstdint>
namespace cg = cooperative_groups;

#ifndef COOP_MODE
#define COOP_MODE 1
#endif

#define DBL_MASK 0x0
#define LAS __attribute__((address_space(3)))
typedef unsigned short bf16_t;
typedef short bf16x8 __attribute__((ext_vector_type(8)));
typedef float f32x4 __attribute__((ext_vector_type(4)));
typedef unsigned u32x4 __attribute__((ext_vector_type(4)));
typedef unsigned u32x2 __attribute__((ext_vector_type(2)));

constexpr int D = 1024, NREAL = 81920, NPR = 65536, RPAD = 82432, NVALID = 82304;
constexpr int INW = 5632, DFF = 2816;
constexpr int T5 = 32, IT_REAL = 2560, IT_PAD = 2816, LDA5 = 768;
constexpr float EPS = 1e-6f;

constexpr size_t OFF_WIN = 0;
constexpr size_t OFF_WGLU = OFF_WIN + (size_t)INW * D * 2;
constexpr size_t OFF_WRET = OFF_WGLU + (size_t)2048 * 512 * 2;
constexpr size_t OFF_WOUT = OFF_WRET + (size_t)D * D * 2;
constexpr size_t OFF_WFFI = OFF_WOUT + (size_t)D * D * 2;
constexpr size_t OFF_WFFO = OFF_WFFI + (size_t)INW * D * 2;
constexpr size_t OFF_AT = OFF_WFFO + (size_t)D * DFF * 2;
constexpr size_t OFF_BAR = OFF_AT + 32768;
constexpr size_t OFF_Q = OFF_AT + 65536;
constexpr size_t OFF_K = OFF_Q + (size_t)RPAD * 512 * 2;
constexpr size_t OFF_V = OFF_K + (size_t)RPAD * 512 * 2;
constexpr size_t OFF_GB = OFF_V + (size_t)RPAD * D * 2;
constexpr size_t OFF_SSQ1 = OFF_GB + (size_t)NREAL * D * 2;
constexpr size_t OFF_SSQ2 = OFF_SSQ1 + (size_t)NREAL * 16 * 4;
constexpr size_t OFF_X = OFF_SSQ2 + (size_t)NREAL * 16 * 4;
constexpr size_t OFF_N1 = OFF_X;
constexpr size_t OFF_YSSM = OFF_X;
constexpr size_t OFF_U5 = OFF_N1 + (size_t)RPAD * D * 2;
constexpr size_t OFF_BTY = OFF_U5 + (size_t)32 * IT_PAD * LDA5 * 2;
constexpr size_t OFF_BTS = OFF_BTY + (size_t)32 * 512 * 768 * 2;
constexpr size_t OFF_SLOC = OFF_BTS + (size_t)32 * 256 * 512 * 2;
constexpr size_t END_X03 = OFF_SLOC + (size_t)32 * IT_PAD * 256 * 4;
constexpr size_t OFF_ST = OFF_X;
constexpr size_t END_ST = OFF_ST + (size_t)664 * 8 * 65536;
constexpr size_t OFF_ACT = OFF_X;
constexpr size_t END_ACT = OFF_ACT + (size_t)NREAL * DFF * 2;
constexpr size_t OFF_MIXED = OFF_Q;
constexpr size_t OFF_H1B = OFF_V;
constexpr size_t cmax(size_t a, size_t b) { return a > b ? a : b; }
constexpr size_t WS_NEED = cmax(END_X03, cmax(END_ST, END_ACT));

constexpr int LDS_BYTES = 131072 + 1024;
constexpr int NPHASE = 13;
constexpr int STG = 0;

struct Args {
    const float* in[21];
    float* out;
    unsigned char* ws;
    int ph_lo, ph_hi;
};

__device__ __forceinline__ unsigned cvt_pk_bf16(float lo, float hi) { unsigned r; asm volatile("v_cvt_pk_bf16_f32 %0, %1, %2" : "=v"(r) : "v"(lo), "v"(hi)); return r; }
__device__ __forceinline__ bf16_t f2bf(float f) { return (bf16_t)(cvt_pk_bf16(f, 0.f) & 0xFFFFu); }
__device__ __forceinline__ float bflo(unsigned w) { return __uint_as_float(w << 16); }
__device__ __forceinline__ float bfhi(unsigned w) { return __uint_as_float(w & 0xFFFF0000u); }
__device__ __forceinline__ float sigmoidf_(float x) { return __fdividef(1.0f, 1.0f + __expf(-x)); }
__device__ __forceinline__ float siluf_(float x) { return x * sigmoidf_(x); }
__device__ __forceinline__ float gelu_tanh(float x) { const float z = 0.7978845608028654f * (x + 0.044715f * x * x * x); return x * sigmoidf_(2.0f * z); }
__device__ __forceinline__ float logsigf_(float x) { return fminf(x, 0.f) - log1pf(__expf(-fabsf(x))); }
__device__ __forceinline__ float wave_sum(float v) {
#pragma unroll
    for (int o = 1; o < 64; o <<= 1) v += __shfl_xor(v, o);
    return v;
}
__device__ __forceinline__ void sincos_rev(double ang, float& s, float& c) {
    double x = ang * 0.15915494309189535; x -= rint(x);
    const float xf = (float)x;
    s = __builtin_amdgcn_sinf(xf); c = __builtin_amdgcn_cosf(xf);
}

namespace pg8 {
constexpr int BM = 256, BK = 64, HALF = 128, HTB = HALF * BK * 2, STAGE_BYTES = 8 * HTB, NXCD = 8, WGM = 8;
__device__ __forceinline__ int lds_byte(int r, int c) { const int st = (r >> 4) * 2 + (c >> 5), rr = r & 15, cc = c & 31, ob = rr * 64 + cc * 2; return st * 1024 + (ob ^ (((ob >> 9) & 1) << 5)); }
__device__ __forceinline__ void stage_rc(int b, int& R, int& C) { const int st = b / 1024, sb = b % 1024, swz = sb ^ (((sb >> 9) & 1) << 5); R = (st >> 1) * 16 + swz / 64; C = (st & 1) * 32 + (swz % 64) / 2; }
__device__ __forceinline__ int perm32(int rho) { const int n = rho >> 4, i = rho & 15; return 8 * (i >> 2) + 4 * n + (i & 3); }

struct Unit { int pm, pn, g; };
struct Gemm { const bf16_t* A; const bf16_t* Bt; int lda, ldb, K, nM, nN, nb; size_t sA, sB; int stagger; };

struct Order {
    int nM, nN, nwg, total, G, c;
    __device__ void init(int nM_, int nN_, int nb, int G_, int c_) { nM = nM_; nN = nN_; nwg = nM * nN; total = nwg * nb; G = G_; c = c_; }
    __device__ bool next(int i, Unit& u) const {
        const long L = (long)i * G + c; if (L >= total) return false;
        u.g = (int)(L / nwg); int wgid = (int)(L % nwg);
        { const int q = nwg / NXCD, r = nwg % NXCD, xcd = wgid % NXCD, off = wgid / NXCD; wgid = (xcd < r ? xcd * (q + 1) : r * (q + 1) + (xcd - r) * q) + off; }
        const int nig = WGM * nN, gid = wgid / nig, fm = gid * WGM, gsz = (nM - fm) < WGM ? (nM - fm) : WGM;
        u.pm = fm + ((wgid % nig) % gsz); u.pn = (wgid % nig) / gsz; return true;
    }
};

template <class Epi>
__device__ __forceinline__ void gemm_phase(LAS unsigned char* lds, const Gemm g, const Epi& E) {
    const int tid = threadIdx.x, wid = __builtin_amdgcn_readfirstlane(tid >> 6), lane = tid & 63, wr = wid >> 2, wc = wid & 3, fr = lane & 15, fq = lane >> 4;
    const int K = g.K, nt = K / BK;
    Order S; S.init(g.nM, g.nN, g.nb, (int)gridDim.x, (int)blockIdx.x);
    unsigned voffA[2], voffB[2];
#pragma unroll
    for (int i = 0; i < 2; ++i) { int R, C; stage_rc(tid * 16 + i * 8192, R, C); const int Rb = (R & ~31) + perm32(R & 31);
        voffA[i] = (unsigned)(R * g.lda + C) * 2u; voffB[i] = (unsigned)(Rb * g.ldb + C) * 2u; }
    const size_t kstep = (size_t)(BK * 2);
    const size_t hstepA = (size_t)HALF * g.lda * 2, hstepB = (size_t)HALF * g.ldb * 2;
    const size_t tstepA = 2 * hstepA, tstepB = 2 * hstepB;
    const unsigned ldsw = (unsigned)wid * 1024u;
    const int aoff = lds_byte(wr * 64 + fr, fq * 8), boff = lds_byte(wc * 32 + fr, fq * 8);
#define PG8_SA(b, h) (((b) * 2 + (h)) * HTB)
#define PG8_SB(b, h) ((4 + (b) * 2 + (h)) * HTB)
#define PG8_STAGE(bufoff, gbase, voff) do { _Pragma("unroll") for (int _i = 0; _i < 2; ++_i) \
        __builtin_amdgcn_global_load_lds((const unsigned*)((const char*)(gbase) + (voff)[_i]), (LAS unsigned*)(lds + (bufoff) + ldsw + _i * 8192), 16, 0, 0); } while (0)
#define PG8_LDA(dst, b, h) do { _Pragma("unroll") for (int m = 0; m < 4; ++m) _Pragma("unroll") for (int k = 0; k < 2; ++k) dst[m][k] = *(const LAS bf16x8*)(lds + PG8_SA(b, h) + aoff + m * 2048 + k * 1024); } while (0)
#define PG8_LDB(dst, b, h) do { _Pragma("unroll") for (int n = 0; n < 2; ++n) _Pragma("unroll") for (int k = 0; k < 2; ++k) dst[n][k] = *(const LAS bf16x8*)(lds + PG8_SB(b, h) + boff + n * 2048 + k * 1024); } while (0)
#define PG8_MMA(ai, bj, At, Bt) do { __builtin_amdgcn_s_setprio(1); _Pragma("unroll") for (int m = 0; m < 4; ++m) _Pragma("unroll") for (int n = 0; n < 2; ++n) _Pragma("unroll") for (int k = 0; k < 2; ++k) \
        acc[ai][bj][m][n] = __builtin_amdgcn_mfma_f32_16x16x32_bf16(Bt[n][k], At[m][k], acc[ai][bj][m][n], 0, 0, 0); __builtin_amdgcn_s_setprio(0); } while (0)
#define PG8_WAIT_V(n) asm volatile("s_waitcnt vmcnt(" #n ")" ::: "memory")
#define PG8_WAIT_L(n) asm volatile("s_waitcnt lgkmcnt(" #n ")" ::: "memory")
#define PG8_BAR __builtin_amdgcn_s_barrier()
#define PG8_SCHED __builtin_amdgcn_sched_barrier(0)
    Unit cur, nxt; int ui = 0;
    if (!S.next(0, cur)) return;
    if (g.stagger) {
        const unsigned long long t0 = __builtin_amdgcn_s_memrealtime(), wt = (unsigned long long)((blockIdx.x & 3) * g.stagger);
        while (__builtin_amdgcn_s_memrealtime() - t0 < wt) __builtin_amdgcn_s_sleep(16);
    }
    f32x4 acc[2][2][4][2];
#pragma unroll
    for (int a = 0; a < 2; ++a)
#pragma unroll
        for (int b = 0; b < 2; ++b)
#pragma unroll
            for (int m = 0; m < 4; ++m)
#pragma unroll
                for (int n = 0; n < 2; ++n) acc[a][b][m][n] = (f32x4){0.f, 0.f, 0.f, 0.f};
    bf16x8 At[4][2], B0[2][2], B1[2][2];
    const char* cA = (const char*)g.A + ((size_t)cur.g * g.sA) * 2 + (size_t)cur.pm * tstepA;
    const char* cB = (const char*)g.Bt + ((size_t)cur.g * g.sB) * 2 + (size_t)cur.pn * tstepB;
    PG8_STAGE(PG8_SB(0, 0), cB, voffB); PG8_STAGE(PG8_SA(0, 0), cA, voffA); PG8_STAGE(PG8_SB(0, 1), cB + hstepB, voffB); PG8_STAGE(PG8_SA(0, 1), cA + hstepA, voffA);
    if (wr == 1) PG8_BAR;
    PG8_WAIT_V(4); PG8_BAR;
    PG8_STAGE(PG8_SB(1, 0), cB + kstep, voffB); PG8_STAGE(PG8_SA(1, 0), cA + kstep, voffA); PG8_STAGE(PG8_SB(1, 1), cB + hstepB + kstep, voffB);
    PG8_WAIT_V(6); PG8_BAR;
    for (;;) {
        const bool has_next = S.next(ui + 1, nxt);
        const char* nA = has_next ? (const char*)g.A + ((size_t)nxt.g * g.sA) * 2 + (size_t)nxt.pm * tstepA : cA;
        const char* nB = has_next ? (const char*)g.Bt + ((size_t)nxt.g * g.sB) * 2 + (size_t)nxt.pn * tstepB : cB;
        for (int t = 0; t < nt; t += 2) {
            const bool last = (t == nt - 2);
            const char* a1 = cA + (size_t)(t + 1) * kstep;
            const char* a2 = last ? nA : cA + (size_t)(t + 2) * kstep; const char* b2 = last ? nB : cB + (size_t)(t + 2) * kstep;
            const char* a3 = a2 + kstep; const char* b3 = b2 + kstep;
            PG8_LDB(B0, 0, 0); PG8_SCHED; PG8_LDA(At, 0, 0); PG8_STAGE(PG8_SA(1, 1), a1 + hstepA, voffA);
            PG8_WAIT_L(8); PG8_BAR; PG8_WAIT_L(0); PG8_MMA(0, 0, At, B0); PG8_BAR; PG8_SCHED;
            PG8_LDB(B1, 0, 1); PG8_STAGE(PG8_SB(0, 0), b2, voffB);
            PG8_BAR; PG8_WAIT_L(0); PG8_MMA(0, 1, At, B1); PG8_BAR;
            PG8_LDA(At, 0, 1); PG8_STAGE(PG8_SA(0, 0), a2, voffA);
            PG8_BAR; PG8_WAIT_L(0); PG8_MMA(1, 0, At, B0); PG8_BAR; PG8_SCHED;
            PG8_STAGE(PG8_SB(0, 1), b2 + hstepB, voffB);
            PG8_WAIT_V(6); PG8_BAR; PG8_MMA(1, 1, At, B1); PG8_BAR;
            PG8_LDB(B0, 1, 0); PG8_SCHED; PG8_LDA(At, 1, 0); PG8_STAGE(PG8_SA(0, 1), a2 + hstepA, voffA);
            PG8_WAIT_L(8); PG8_BAR; PG8_WAIT_L(0); PG8_MMA(0, 0, At, B0); PG8_BAR; PG8_SCHED;
            PG8_LDB(B1, 1, 1); PG8_STAGE(PG8_SB(1, 0), b3, voffB);
            PG8_BAR; PG8_WAIT_L(0); PG8_MMA(0, 1, At, B1); PG8_BAR;
            PG8_LDA(At, 1, 1); PG8_STAGE(PG8_SA(1, 0), a3, voffA);
            PG8_BAR; PG8_WAIT_L(0); PG8_MMA(1, 0, At, B0); PG8_BAR; PG8_SCHED;
            PG8_STAGE(PG8_SB(1, 1), b3 + hstepB, voffB);
            PG8_WAIT_V(6); PG8_BAR; PG8_MMA(1, 1, At, B1); PG8_BAR;
        }
        E(acc, cur, wr, wc, fr, fq);
        if (!has_next) break;
#pragma unroll
        for (int a = 0; a < 2; ++a)
#pragma unroll
            for (int b = 0; b < 2; ++b)
#pragma unroll
                for (int m = 0; m < 4; ++m)
#pragma unroll
                    for (int n = 0; n < 2; ++n) acc[a][b][m][n] = (f32x4){0.f, 0.f, 0.f, 0.f};
        cur = nxt; cA = nA; cB = nB; ++ui;
    }
    PG8_WAIT_V(0);
    if (wr == 0) PG8_BAR;
    PG8_BAR;
#undef PG8_SA
#undef PG8_SB
#undef PG8_STAGE
#undef PG8_LDA
#undef PG8_LDB
#undef PG8_MMA
#undef PG8_WAIT_V
#undef PG8_WAIT_L
#undef PG8_BAR
#undef PG8_SCHED
}
}
using pg8::Unit;
typedef const f32x4 (&AccRef)[2][2][4][2];

__device__ __forceinline__ u32x4 pack8(f32x4 a, f32x4 b) { u32x4 w; w.x = cvt_pk_bf16(a[0], a[1]); w.y = cvt_pk_bf16(a[2], a[3]); w.z = cvt_pk_bf16(b[0], b[1]); w.w = cvt_pk_bf16(b[2], b[3]); return w; }

struct EpiProj {
    bf16_t *u5, *q, *k, *v, *sg, *ga, *gb; const LAS double* ropef;
    __device__ __forceinline__ void operator()(AccRef acc, const Unit& u, int wr, int wc, int fr, int fq) const {
        const int pn = u.pn;
#pragma unroll
        for (int ai = 0; ai < 2; ++ai)
#pragma unroll
            for (int m = 0; m < 4; ++m) {
                const int row = u.pm * 256 + ai * 128 + wr * 64 + m * 16 + fr;
#pragma unroll
                for (int bj = 0; bj < 2; ++bj) {
                    const int col = pn * 256 + bj * 128 + wc * 32 + 8 * fq;
                    f32x4 v0 = acc[ai][bj][m][0], v1 = acc[ai][bj][m][1];
                    if (pn < 2) {
                        if (row < NVALID) {
                            int item, t;
                            if (row < NREAL) { item = row >> 5; t = row & 31; } else { const int mr = row - NREAL; item = IT_REAL + (mr >> 4); t = 16 + (mr & 15); }
                            const int g = col >> 4, h0 = col & 15;
                            *(u32x4*)(u5 + ((size_t)(g * IT_PAD + item) * LDA5 + t * 16 + h0)) = pack8(v0, v1);
                        }
                    } else if (pn < 6) {
                        const int cq = col - 512, isk = cq >> 9, cc = cq & 511, i0 = (cc & 127) >> 1;
                        const int pos = row < NPR ? 16 + (row & 4095) : (row < NREAL ? 16 + ((row - NPR) & 2047) : ((row - NREAL) & 15));
                        const float sc = isk ? 1.0f : 0.08838834764831845f;
                        float o[8];
#pragma unroll
                        for (int pi = 0; pi < 4; ++pi) {
                            float s, c; sincos_rev((double)pos * ropef[i0 + pi], s, c);
                            const float x1 = pi < 2 ? v0[2 * pi] : v1[2 * pi - 4], x2 = pi < 2 ? v0[2 * pi + 1] : v1[2 * pi - 3];
                            o[2 * pi] = (x1 * c - x2 * s) * sc; o[2 * pi + 1] = (x1 * s + x2 * c) * sc;
                        }
                        u32x4 w; w.x = cvt_pk_bf16(o[0], o[1]); w.y = cvt_pk_bf16(o[2], o[3]); w.z = cvt_pk_bf16(o[4], o[5]); w.w = cvt_pk_bf16(o[6], o[7]);
                        *(u32x4*)((isk ? k : q) + (size_t)row * 512 + cc) = w;
                    } else if (pn < 10) {
                        *(u32x4*)(v + (size_t)row * 1024 + (col - 1536)) = pack8(v0, v1);
                    } else if (row < NREAL) {
                        if (pn < 14) {
#pragma unroll
                            for (int j = 0; j < 4; ++j) { v0[j] = siluf_(v0[j]); v1[j] = siluf_(v1[j]); }
                            *(u32x4*)(sg + (size_t)row * 1024 + (col - 2560)) = pack8(v0, v1);
                        } else {
#pragma unroll
                            for (int j = 0; j < 4; ++j) { v0[j] = sigmoidf_(v0[j]); v1[j] = sigmoidf_(v1[j]); }
                            if (pn < 18) *(u32x4*)(ga + (size_t)row * 1024 + (col - 3584)) = pack8(v0, v1);
                            else *(u32x4*)(gb + (size_t)row * 1024 + (col - 4608)) = pack8(v0, v1);
                        }
                    }
                }
            }
    }
};

struct EpiSink {
    float* p; int flag;
    __device__ __forceinline__ void operator()(AccRef acc, const Unit& u, int wr, int wc, int fr, int fq) const {
        if (flag) {
#pragma unroll
            for (int ai = 0; ai < 2; ++ai)
#pragma unroll
                for (int m = 0; m < 4; ++m)
#pragma unroll
                    for (int bj = 0; bj < 2; ++bj) { p[(ai * 8 + m * 2 + bj) * 8 + fr] = acc[ai][bj][m][0][0] + acc[ai][bj][m][1][1]; }
        }
    }
};

struct EpiSloc {
    float* sloc;
    __device__ __forceinline__ void operator()(AccRef acc, const Unit& u, int wr, int wc, int fr, int fq) const {
#pragma unroll
        for (int ai = 0; ai < 2; ++ai)
#pragma unroll
            for (int m = 0; m < 4; ++m) {
                const int row = u.pm * 256 + ai * 128 + wr * 64 + m * 16 + fr;
#pragma unroll
                for (int bj = 0; bj < 2; ++bj) {
                    const int col = bj * 128 + wc * 32 + 8 * fq;
                    float* p = sloc + ((size_t)u.g * IT_PAD + row) * 256 + col;
                    *(f32x4*)p = acc[ai][bj][m][0]; *(f32x4*)(p + 4) = acc[ai][bj][m][1];
                }
            }
    }
};

struct EpiY {
    bf16_t* y;
    __device__ __forceinline__ void operator()(AccRef acc, const Unit& u, int wr, int wc, int fr, int fq) const {
#pragma unroll
        for (int ai = 0; ai < 2; ++ai)
#pragma unroll
            for (int m = 0; m < 4; ++m) {
                const int item = u.pm * 256 + ai * 128 + wr * 64 + m * 16 + fr;
                if (item < IT_REAL) {
#pragma unroll
                    for (int bj = 0; bj < 2; ++bj) {
                        const int col = u.pn * 256 + bj * 128 + wc * 32 + 8 * fq, to = col >> 4, ho = col & 15;
                        f32x4 v0 = acc[ai][bj][m][0], v1 = acc[ai][bj][m][1];
#pragma unroll
                        for (int j = 0; j < 4; ++j) { v0[j] = gelu_tanh(v0[j]); v1[j] = gelu_tanh(v1[j]); }
                        *(u32x4*)(y + (size_t)(item * 32 + to) * 512 + u.g * 16 + ho) = pack8(v0, v1);
                    }
                }
            }
    }
};

struct EpiGlu {
    bf16_t* ga;
    __device__ __forceinline__ void operator()(AccRef acc, const Unit& u, int wr, int wc, int fr, int fq) const {
        u32x4 gw[2][4];
#pragma unroll
        for (int ai = 0; ai < 2; ++ai)
#pragma unroll
            for (int m = 0; m < 4; ++m) {
                const int row = u.pm * 256 + ai * 128 + wr * 64 + m * 16 + fr;
                gw[ai][m] = *(const u32x4*)(ga + (size_t)row * 1024 + u.pn * 128 + wc * 32 + 8 * fq);
            }
#pragma unroll
        for (int ai = 0; ai < 2; ++ai)
#pragma unroll
            for (int m = 0; m < 4; ++m) {
                const int row = u.pm * 256 + ai * 128 + wr * 64 + m * 16 + fr;
                bf16_t* p = ga + (size_t)row * 1024 + u.pn * 128 + wc * 32 + 8 * fq;
                const u32x4 g = gw[ai][m];
                const f32x4 a0 = acc[ai][0][m][0], a1 = acc[ai][0][m][1], g0 = acc[ai][1][m][0], g1 = acc[ai][1][m][1];
                f32x4 r0, r1;
                r0[0] = bflo(g.x) * a0[0] * sigmoidf_(g0[0]); r0[1] = bfhi(g.x) * a0[1] * sigmoidf_(g0[1]);
                r0[2] = bflo(g.y) * a0[2] * sigmoidf_(g0[2]); r0[3] = bfhi(g.y) * a0[3] * sigmoidf_(g0[3]);
                r1[0] = bflo(g.z) * a1[0] * sigmoidf_(g1[0]); r1[1] = bfhi(g.z) * a1[1] * sigmoidf_(g1[1]);
                r1[2] = bflo(g.w) * a1[2] * sigmoidf_(g1[2]); r1[3] = bfhi(g.w) * a1[3] * sigmoidf_(g1[3]);
                *(u32x4*)p = pack8(r0, r1);
            }
    }
};

struct EpiRet {
    const bf16_t *pa, *gb; bf16_t* mixed;
    __device__ __forceinline__ void operator()(AccRef acc, const Unit& u, int wr, int wc, int fr, int fq) const {
#pragma unroll
        for (int ai = 0; ai < 2; ++ai) {
            u32x4 pw[4][2], gw[4][2];
#pragma unroll
            for (int m = 0; m < 4; ++m)
#pragma unroll
                for (int bj = 0; bj < 2; ++bj) {
                    const int row = u.pm * 256 + ai * 128 + wr * 64 + m * 16 + fr;
                    const size_t o = (size_t)row * 1024 + u.pn * 256 + bj * 128 + wc * 32 + 8 * fq;
                    pw[m][bj] = *(const u32x4*)(pa + o); gw[m][bj] = *(const u32x4*)(gb + o);
                }
#pragma unroll
            for (int m = 0; m < 4; ++m)
#pragma unroll
                for (int bj = 0; bj < 2; ++bj) {
                    const int row = u.pm * 256 + ai * 128 + wr * 64 + m * 16 + fr;
                    const size_t o = (size_t)row * 1024 + u.pn * 256 + bj * 128 + wc * 32 + 8 * fq;
                    const u32x4 p = pw[m][bj], g = gw[m][bj];
                    const f32x4 a0 = acc[ai][bj][m][0], a1 = acc[ai][bj][m][1];
                    f32x4 r0, r1;
                    r0[0] = bflo(p.x) + bflo(g.x) * a0[0]; r0[1] = bfhi(p.x) + bfhi(g.x) * a0[1];
                    r0[2] = bflo(p.y) + bflo(g.y) * a0[2]; r0[3] = bfhi(p.y) + bfhi(g.y) * a0[3];
                    r1[0] = bflo(p.z) + bflo(g.z) * a1[0]; r1[1] = bfhi(p.z) + bfhi(g.z) * a1[1];
                    r1[2] = bflo(p.w) + bflo(g.w) * a1[2]; r1[3] = bfhi(p.w) + bfhi(g.w) * a1[3];
                    *(u32x4*)(mixed + o) = pack8(r0, r1);
                }
            __builtin_amdgcn_sched_barrier(0);
        }
    }
};

template <int MODE>
struct EpiRes {
    const float *xp, *xs; bf16_t* hb; float* ssq;
    __device__ __forceinline__ void operator()(AccRef acc, const Unit& u, int wr, int wc, int fr, int fq) const {
#pragma unroll
        for (int ai = 0; ai < 2; ++ai) {
            f32x4 x0[4][2], x1[4][2]; u32x4 hw[4][2];
#pragma unroll
            for (int m = 0; m < 4; ++m)
#pragma unroll
                for (int bj = 0; bj < 2; ++bj) {
                    const int row = u.pm * 256 + ai * 128 + wr * 64 + m * 16 + fr, col = u.pn * 256 + bj * 128 + wc * 32 + 8 * fq;
                    if (MODE == 0) {
                        const float* src = (row < NPR ? xp + (size_t)row * 1024 : xs + (size_t)(row - NPR) * 1024) + col;
                        x0[m][bj] = *(const f32x4*)src; x1[m][bj] = *(const f32x4*)(src + 4);
                    } else hw[m][bj] = *(const u32x4*)(hb + (size_t)row * 1024 + col);
                }
#pragma unroll
            for (int m = 0; m < 4; ++m) {
                const int row = u.pm * 256 + ai * 128 + wr * 64 + m * 16 + fr;
                float ss = 0.f;
#pragma unroll
                for (int bj = 0; bj < 2; ++bj) {
                    const int col = u.pn * 256 + bj * 128 + wc * 32 + 8 * fq;
                    f32x4 h0, h1;
                    if (MODE == 0) { h0 = x0[m][bj]; h1 = x1[m][bj]; }
                    else { const u32x4 w = hw[m][bj]; h0 = (f32x4){bflo(w.x), bfhi(w.x), bflo(w.y), bfhi(w.y)}; h1 = (f32x4){bflo(w.z), bfhi(w.z), bflo(w.w), bfhi(w.w)}; }
                    h0 = h0 + acc[ai][bj][m][0]; h1 = h1 + acc[ai][bj][m][1];
                    *(u32x4*)(hb + (size_t)row * 1024 + col) = pack8(h0, h1);
                    ss += (h0[0] * h0[0] + h0[1] * h0[1]) + (h0[2] * h0[2] + h0[3] * h0[3]) + (h1[0] * h1[0] + h1[1] * h1[1]) + (h1[2] * h1[2] + h1[3] * h1[3]);
                }
                ss += __shfl_xor(ss, 16); ss += __shfl_xor(ss, 32);
                if (fq == 0) ssq[(size_t)row * 16 + u.pn * 4 + wc] = ss;
            }
            __builtin_amdgcn_sched_barrier(0);
        }
    }
};

struct EpiFfi {
    const float* ssq; bf16_t* act;
    __device__ __forceinline__ void operator()(AccRef acc, const Unit& u, int wr, int wc, int fr, int fq) const {
        f32x4 sp[2][4];
#pragma unroll
        for (int ai = 0; ai < 2; ++ai)
#pragma unroll
            for (int m = 0; m < 4; ++m) {
                const int row = u.pm * 256 + ai * 128 + wr * 64 + m * 16 + fr;
                sp[ai][m] = *(const f32x4*)(ssq + (size_t)row * 16 + 4 * fq);
            }
#pragma unroll
        for (int ai = 0; ai < 2; ++ai)
#pragma unroll
            for (int m = 0; m < 4; ++m) {
                const int row = u.pm * 256 + ai * 128 + wr * 64 + m * 16 + fr;
                float tot = (sp[ai][m][0] + sp[ai][m][1]) + (sp[ai][m][2] + sp[ai][m][3]);
                tot += __shfl_xor(tot, 16); tot += __shfl_xor(tot, 32);
                const float rstd = rsqrtf(tot * (1.0f / 1024.0f) + EPS);
                const f32x4 g0 = acc[ai][0][m][0], g1 = acc[ai][0][m][1], u0 = acc[ai][1][m][0], u1 = acc[ai][1][m][1];
                f32x4 r0, r1;
#pragma unroll
                for (int j = 0; j < 4; ++j) { r0[j] = siluf_(rstd * g0[j]) * (rstd * u0[j]); r1[j] = siluf_(rstd * g1[j]) * (rstd * u1[j]); }
                *(u32x4*)(act + (size_t)row * DFF + u.pn * 128 + wc * 32 + 8 * fq) = pack8(r0, r1);
            }
    }
};

__device__ __forceinline__ void p0_s5gen(const Args& a, LAS float* L, int g, int qd) {
    const int tid = threadIdx.x;
    LAS float* Kt = L;
    LAS float* Ap = L + 16384;
    LAS float* Bb = Ap + 33 * 64 * 2;
    LAS float* Cc = Bb + 2048;
    bf16_t* bts = (bf16_t*)(a.ws + OFF_BTS) + (size_t)g * 256 * 512;
    bf16_t* bty = (bf16_t*)(a.ws + OFF_BTY) + (size_t)g * 512 * 768;
    float* attab = (float*)(a.ws + OFF_AT);
    bf16_t* u5 = (bf16_t*)(a.ws + OFF_U5);
    if (qd == 0) for (int e = tid; e < 24 * 256; e += 512) { const int b = e >> 8, kk = e & 255; u5[((size_t)g * IT_PAD + IT_REAL + b) * LDA5 + kk] = 0; }
    for (int dir = 0; dir < 2; ++dir) {
        const int pg = dir * 32 + g;
        const double dt = exp((double)a.in[7][pg]);
        for (int idx = tid; idx < 33 * 64; idx += 512) {
            const int p = idx & 63, d = idx >> 6;
            const double lr = a.in[5][pg * 64 + p], li = a.in[6][pg * 64 + p];
            const float mag = (float)exp(lr * dt * d);
            float s, c; sincos_rev(li * dt * d, s, c);
            Ap[idx * 2] = mag * c; Ap[idx * 2 + 1] = mag * s;
            if (d == 32 && qd == 0) { attab[(pg * 64 + p) * 2] = mag * c; attab[(pg * 64 + p) * 2 + 1] = mag * s; }
        }
        for (int idx = tid; idx < 1024; idx += 512) {
            const int p = idx >> 4, h = idx & 15;
            const double lr = a.in[5][pg * 64 + p], li = a.in[6][pg * 64 + p];
            const double zr = lr * dt, zi = li * dt, mag = exp(zr);
            float sh, ch, s1, c1; sincos_rev(0.5 * zi, sh, ch); sincos_rev(zi, s1, c1);
            const double nr = mag * (-2.0 * (double)sh * (double)sh) + expm1(zr);
            const double abi = mag * (double)s1, den = lr * lr + li * li;
            const double cre = (nr * lr + abi * li) / den, cim = (abi * lr - nr * li) / den;
            const double br = a.in[8][(size_t)(pg * 64 + p) * 16 + h], bi = a.in[9][(size_t)(pg * 64 + p) * 16 + h];
            Bb[idx * 2] = (float)(cre * br - cim * bi); Bb[idx * 2 + 1] = (float)(cre * bi + cim * br);
        }
        for (int idx = tid; idx < 1024; idx += 512) {
            Cc[idx * 2] = a.in[10][(size_t)pg * 1024 + idx]; Cc[idx * 2 + 1] = a.in[11][(size_t)pg * 1024 + idx];
        }
        __syncthreads();
        for (int e = tid; e < 8192; e += 512) {
            const int d = e >> 8, ho = (e >> 4) & 15, hi = e & 15;
            float sum = 0.f;
            for (int p = 0; p < 64; ++p) {
                const float cr = Cc[(ho * 64 + p) * 2], ci = Cc[(ho * 64 + p) * 2 + 1], ar = Ap[(d * 64 + p) * 2], ai = Ap[(d * 64 + p) * 2 + 1];
                const float br = Bb[(p * 16 + hi) * 2], bi = Bb[(p * 16 + hi) * 2 + 1];
                const float car = cr * ar - ci * ai, cai = cr * ai + ci * ar;
                sum += car * br - cai * bi;
            }
            Kt[dir * 8192 + e] = sum;
        }
        for (int e = qd * 16384 + tid; e < (qd + 1) * 16384; e += 512) {
            const int k = e & 511, nn = e >> 9, c = nn >> 6, p = nn & 63, t = k >> 4, hi = k & 15;
            const int dd = dir == 0 ? (T5 - 1 - t) : t;
            const float ar = Ap[(dd * 64 + p) * 2], ai = Ap[(dd * 64 + p) * 2 + 1], br = Bb[(p * 16 + hi) * 2], bi = Bb[(p * 16 + hi) * 2 + 1];
            const float val = c ? (ar * bi + ai * br) : (ar * br - ai * bi);
            bts[(size_t)(dir * 128 + nn) * 512 + k] = f2bf(val);
        }
        for (int e = qd * 16384 + tid; e < (qd + 1) * 16384; e += 512) {
            const int kk = e & 127, n = e >> 7, c = kk >> 6, p = kk & 63, to = n >> 4, ho = n & 15;
            const int dd = dir == 0 ? (to + 1) : (T5 - to);
            const float cr = Cc[(ho * 64 + p) * 2], ci = Cc[(ho * 64 + p) * 2 + 1], ar = Ap[(dd * 64 + p) * 2], ai = Ap[(dd * 64 + p) * 2 + 1];
            const float val = c ? -(cr * ai + ci * ar) : (cr * ar - ci * ai);
            bty[(size_t)n * 768 + 512 + dir * 128 + kk] = f2bf(val);
        }
        __syncthreads();
    }
    for (int e = qd * 65536 + tid; e < (qd + 1) * 65536; e += 512) {
        const int k = e & 511, n = e >> 9, to = n >> 4, ho = n & 15, ti = k >> 4, hi = k & 15;
        float val = 0.f;
        if (to >= ti) val += Kt[((to - ti) * 16 + ho) * 16 + hi];
        if (ti >= to) val += Kt[8192 + ((ti - to) * 16 + ho) * 16 + hi];
        if (to == ti && ho == hi) val += a.in[12][g * 16 + ho];
        bty[(size_t)n * 768 + k] = f2bf(val);
    }
    __syncthreads();
}

__device__ __forceinline__ int src_col(int kind, int n) {
    if (kind == 1) { if (n >= 512 && n < 1536) { const int r = n - 512, seg = r >> 7, dp = r & 127; return 512 + seg * 128 + (dp >> 1) + 64 * (dp & 1); } return n; }
    if (kind == 2) { const int pn = n >> 8, bj = (n >> 7) & 1, cc = n & 127; return bj * 1024 + pn * 128 + cc; }
    if (kind == 3) { const int pn = n >> 8, bj = (n >> 7) & 1, cc = n & 127; return bj * DFF + pn * 128 + cc; }
    return n;
}
__device__ __forceinline__ void p0_wtile(const float* W, int K, int N, bf16_t* WT, int kind, const float* kscale, int tile2, LAS float* L) {
    const int tid = threadIdx.x, nkt = K >> 6;
    int n0[2], k0[2];
#pragma unroll
    for (int q = 0; q < 2; ++q) { const int tile = 2 * tile2 + q; n0[q] = (tile / nkt) * 64; k0[q] = (tile % nkt) * 64; }
    float v[2][8];
#pragma unroll
    for (int q = 0; q < 2; ++q)
#pragma unroll
        for (int it = 0; it < 8; ++it) {
            const int idx = tid + it * 512, kk = idx >> 6, j = idx & 63;
            v[q][it] = W[(size_t)(k0[q] + kk) * N + src_col(kind, n0[q] + j)];
        }
#pragma unroll
    for (int q = 0; q < 2; ++q)
#pragma unroll
        for (int it = 0; it < 8; ++it) {
            const int idx = tid + it * 512, kk = idx >> 6, j = idx & 63;
            float x = v[q][it];
            if (kscale) x *= kscale[k0[q] + kk];
            L[q * 4160 + kk * 65 + j] = x;
        }
    __syncthreads();
#pragma unroll
    for (int q = 0; q < 2; ++q)
#pragma unroll
        for (int it = 0; it < 4; ++it) {
            const int idx = tid + it * 512, j = idx >> 5, kp = idx & 31;
            *(unsigned*)(WT + (size_t)(n0[q] + j) * K + k0[q] + 2 * kp) = cvt_pk_bf16(L[q * 4160 + (2 * kp) * 65 + j], L[q * 4160 + (2 * kp + 1) * 65 + j]);
        }
    __syncthreads();
}

__device__ __forceinline__ void phase0(const Args& a, LAS unsigned char* lds) {
    LAS float* L = (LAS float*)lds;
    const int tid = threadIdx.x, wave = tid >> 6, lane = tid & 63;
    constexpr int T_IN = 88 * 16 / 2, T_GLU = 32 * 8 / 2, T_RET = 128, T_OUT = 128, T_FFI = 88 * 16 / 2, T_FFO = 16 * 44 / 2;
    constexpr int NW = 128 + T_IN + T_GLU + T_RET + T_OUT + T_FFI + T_FFO, NRM = RPAD / 32;
    unsigned* qctr = (unsigned*)(a.ws + OFF_BAR) + 32;
    LAS int* qslot = (LAS int*)(lds + 131072 + 512);
    for (;;) {
        __syncthreads();
        if (tid == 0) *qslot = (int)__hip_atomic_fetch_add(qctr, 1u, __ATOMIC_RELAXED, __HIP_MEMORY_SCOPE_AGENT);
        __syncthreads();
        const int w = *qslot;
        if (w >= NW + NRM) break;
        int r = w;
        if (r < 128) { p0_s5gen(a, L, r >> 2, r & 3); continue; } r -= 128;
        if (r < T_IN) { p0_wtile(a.in[4], 1024, INW, (bf16_t*)(a.ws + OFF_WIN), 1, nullptr, r, L); continue; } r -= T_IN;
        if (r < T_GLU) { p0_wtile(a.in[13], 512, 2048, (bf16_t*)(a.ws + OFF_WGLU), 2, nullptr, r, L); continue; } r -= T_GLU;
        if (r < T_RET) { p0_wtile(a.in[15], 1024, 1024, (bf16_t*)(a.ws + OFF_WRET), 0, nullptr, r, L); continue; } r -= T_RET;
        if (r < T_OUT) { p0_wtile(a.in[16], 1024, 1024, (bf16_t*)(a.ws + OFF_WOUT), 0, nullptr, r, L); continue; } r -= T_OUT;
        if (r < T_FFI) { p0_wtile(a.in[18], 1024, INW, (bf16_t*)(a.ws + OFF_WFFI), 3, a.in[17], r, L); continue; } r -= T_FFI;
        if (r < T_FFO) { p0_wtile(a.in[19], DFF, 1024, (bf16_t*)(a.ws + OFF_WFFO), 0, nullptr, r, L); continue; } r -= T_FFO;
        const int rowb = r * 32 + wave * 4;
        const float* xr[4]; f32x4 v[4][4];
#pragma unroll
        for (int q = 0; q < 4; ++q) {
            const int row = rowb + q;
            xr[q] = row < NPR ? a.in[0] + (size_t)row * 1024 : (row < NREAL ? a.in[1] + (size_t)(row - NPR) * 1024 : a.in[2] + (size_t)((row - NREAL) & 15) * 1024);
#pragma unroll
            for (int j = 0; j < 4; ++j) v[q][j] = (row < NVALID) ? *(const f32x4*)(xr[q] + (j * 64 + lane) * 4) : (f32x4){0.f, 0.f, 0.f, 0.f};
        }
        f32x4 gg[4];
#pragma unroll
        for (int j = 0; j < 4; ++j) gg[j] = *(const f32x4*)(a.in[3] + (j * 64 + lane) * 4);
#pragma unroll
        for (int q = 0; q < 4; ++q) {
            float sq = 0.f;
#pragma unroll
            for (int j = 0; j < 4; ++j) sq += (v[q][j][0] * v[q][j][0] + v[q][j][1] * v[q][j][1]) + (v[q][j][2] * v[q][j][2] + v[q][j][3] * v[q][j][3]);
            const float rstd = rsqrtf(wave_sum(sq) * (1.0f / 1024.0f) + EPS);
            bf16_t* orow = (bf16_t*)(a.ws + OFF_N1) + (size_t)(rowb + q) * 1024;
#pragma unroll
            for (int j = 0; j < 4; ++j) {
                u32x2 o; o.x = cvt_pk_bf16(v[q][j][0] * rstd * gg[j][0], v[q][j][1] * rstd * gg[j][1]); o.y = cvt_pk_bf16(v[q][j][2] * rstd * gg[j][2], v[q][j][3] * rstd * gg[j][3]);
                *(u32x2*)(orow + (j * 64 + lane) * 4) = o;
            }
        }
    }
}

__device__ __forceinline__ void s5_scan(const Args& a) {
    const float* attab = (const float*)(a.ws + OFF_AT);
    const float* sloc = (const float*)(a.ws + OFF_SLOC);
    bf16_t* u5 = (bf16_t*)(a.ws + OFF_U5);
    for (int id = blockIdx.x * 512 + threadIdx.x; id < 24 * 32 * 2 * 64; id += gridDim.x * 512) {
        const int p = id & 63, dir = (id >> 6) & 1, g = (id >> 7) & 31, b = id >> 12;
        const float atr = attab[((dir * 32 + g) * 64 + p) * 2], ati = attab[((dir * 32 + g) * 64 + p) * 2 + 1];
        const int nck = b < 16 ? 128 : 64, base = b < 16 ? b * 128 : 2048 + (b - 16) * 64, mitem = IT_REAL + b;
        const float* sl = sloc + (size_t)g * IT_PAD * 256 + dir * 128 + p;
        bf16_t* ub = u5 + (size_t)g * IT_PAD * LDA5 + 512 + dir * 128 + p;
        float sr = 0.f, si = 0.f;
        if (dir == 0) {
            ub[(size_t)mitem * LDA5] = 0; ub[(size_t)mitem * LDA5 + 64] = 0;
            sr = sl[(size_t)mitem * 256]; si = sl[(size_t)mitem * 256 + 64];
            for (int c0 = 0; c0 < nck; c0 += 16) {
                float lr[16], li[16];
#pragma unroll
                for (int j = 0; j < 16; ++j) { lr[j] = sl[(size_t)(base + c0 + j) * 256]; li[j] = sl[(size_t)(base + c0 + j) * 256 + 64]; }
#pragma unroll
                for (int j = 0; j < 16; ++j) {
                    const size_t it = (size_t)(base + c0 + j);
                    ub[it * LDA5] = f2bf(sr); ub[it * LDA5 + 64] = f2bf(si);
                    const float nr = atr * sr - ati * si + lr[j], ni = atr * si + ati * sr + li[j];
                    sr = nr; si = ni;
                }
            }
        } else {
            for (int c0 = nck - 16; c0 >= 0; c0 -= 16) {
                float lr[16], li[16];
#pragma unroll
                for (int j = 0; j < 16; ++j) { lr[j] = sl[(size_t)(base + c0 + j) * 256]; li[j] = sl[(size_t)(base + c0 + j) * 256 + 64]; }
#pragma unroll
                for (int j = 15; j >= 0; --j) {
                    const size_t it = (size_t)(base + c0 + j);
                    ub[it * LDA5] = f2bf(sr); ub[it * LDA5 + 64] = f2bf(si);
                    const float nr = atr * sr - ati * si + lr[j], ni = atr * si + ati * sr + li[j];
                    sr = nr; si = ni;
                }
            }
            ub[(size_t)mitem * LDA5] = f2bf(sr); ub[(size_t)mitem * LDA5 + 64] = f2bf(si);
        }
    }
}

constexpr int LDR = 136;
__device__ __forceinline__ float bf2f(bf16_t h) { return __uint_as_float(((unsigned)h) << 16); }

__device__ __forceinline__ void tr_store_pair(LAS bf16_t* img, int f0, int s2, u32x4 r0, u32x4 r1) {
    LAS unsigned* p = (LAS unsigned*)(img + f0 * LDR + s2);
    p[0 * (LDR / 2)] = (r0.x & 0xFFFFu) | (r1.x << 16); p[1 * (LDR / 2)] = (r0.x >> 16) | (r1.x & 0xFFFF0000u);
    p[2 * (LDR / 2)] = (r0.y & 0xFFFFu) | (r1.y << 16); p[3 * (LDR / 2)] = (r0.y >> 16) | (r1.y & 0xFFFF0000u);
    p[4 * (LDR / 2)] = (r0.z & 0xFFFFu) | (r1.z << 16); p[5 * (LDR / 2)] = (r0.z >> 16) | (r1.z & 0xFFFF0000u);
    p[6 * (LDR / 2)] = (r0.w & 0xFFFFu) | (r1.w << 16); p[7 * (LDR / 2)] = (r0.w >> 16) | (r1.w & 0xFFFF0000u);
}
__device__ __forceinline__ void tr_store_pair_scaled(LAS bf16_t* img, int f0, int s2, u32x4 r0, u32x4 r1, float w0, float w1) {
    LAS unsigned* p = (LAS unsigned*)(img + f0 * LDR + s2);
    p[0 * (LDR / 2)] = cvt_pk_bf16(bflo(r0.x) * w0, bflo(r1.x) * w1); p[1 * (LDR / 2)] = cvt_pk_bf16(bfhi(r0.x) * w0, bfhi(r1.x) * w1);
    p[2 * (LDR / 2)] = cvt_pk_bf16(bflo(r0.y) * w0, bflo(r1.y) * w1); p[3 * (LDR / 2)] = cvt_pk_bf16(bfhi(r0.y) * w0, bfhi(r1.y) * w1);
    p[4 * (LDR / 2)] = cvt_pk_bf16(bflo(r0.z) * w0, bflo(r1.z) * w1); p[5 * (LDR / 2)] = cvt_pk_bf16(bfhi(r0.z) * w0, bfhi(r1.z) * w1);
    p[6 * (LDR / 2)] = cvt_pk_bf16(bflo(r0.w) * w0, bflo(r1.w) * w1); p[7 * (LDR / 2)] = cvt_pk_bf16(bfhi(r0.w) * w0, bfhi(r1.w) * w1);
}

#define LDS_BARRIER() do { asm volatile("s_waitcnt lgkmcnt(0)" ::: "memory"); __builtin_amdgcn_s_barrier(); asm volatile("" ::: "memory"); } while (0)
__device__ __forceinline__ void ret_pass_a(const Args& a, LAS unsigned char* lds) {
    LAS bf16_t* KT = (LAS bf16_t*)lds;
    LAS bf16_t* VT = KT + 128 * LDR;
    const int tid0 = threadIdx.x;
    const bf16_t* kb = (const bf16_t*)(a.ws + OFF_K); const bf16_t* vb = (const bf16_t*)(a.ws + OFF_V);
    bf16_t* stb = (bf16_t*)(a.ws + OFF_ST);
    for (int item = blockIdx.x; item < 192; item += gridDim.x) {
        int tid = tid0; asm volatile("" : "+v"(tid));
        const int w = tid >> 6, lane = tid & 63, fr = lane & 15, fq = lane >> 4;
        int b, h, dir;
        if (item < 128) { b = item >> 3; h = (item >> 1) & 3; dir = item & 1; } else { const int j = item - 128; b = 16 + (j >> 3); h = (j >> 1) & 3; dir = j & 1; }
        const int NC = b < 16 ? 32 : 16, rbase = b < 16 ? b * 4096 : NPR + (b - 16) * 2048, ebase = b < 16 ? b * 33 : 528 + (b - 16) * 17;
        const float lg = logsigf_(a.in[14][dir * 4 + h]);
        const float carry = __expf(lg * 128.f);
        const int s2 = 2 * (8 * w + (lane & 7)), pg = lane >> 3;
        const float wk0 = dir == 0 ? __expf(lg * (float)(127 - s2)) : __expf(lg * (float)s2);
        const float wk1 = dir == 0 ? __expf(lg * (float)(126 - s2)) : __expf(lg * (float)(s2 + 1));
        f32x4 acc[2][8];
#pragma unroll
        for (int et = 0; et < 2; ++et)
#pragma unroll
            for (int dtl = 0; dtl < 8; ++dtl) acc[et][dtl] = (f32x4){0.f, 0.f, 0.f, 0.f};
        const int nsteps = dir == 0 ? NC : NC;
        u32x4 rk[2][2], rv[4][2];
        auto load_chunk = [&](int n) {
            int row0; bool valid = true;
            if (n == 0) { valid = s2 >= 112; row0 = NREAL + b * 16 + (s2 - 112); } else row0 = rbase + (n - 1) * 128 + s2;
#pragma unroll
            for (int it = 0; it < 2; ++it)
#pragma unroll
                for (int r = 0; r < 2; ++r) {
                    rk[it][r] = (u32x4){0u, 0u, 0u, 0u};
                    if (valid) rk[it][r] = *(const u32x4*)(kb + (size_t)(row0 + r) * 512 + h * 128 + (pg + 8 * it) * 8);
                }
#pragma unroll
            for (int it = 0; it < 4; ++it)
#pragma unroll
                for (int r = 0; r < 2; ++r) {
                    rv[it][r] = (u32x4){0u, 0u, 0u, 0u};
                    if (valid) rv[it][r] = *(const u32x4*)(vb + (size_t)(row0 + r) * 1024 + h * 256 + (pg + 8 * it) * 8);
                }
        };
        load_chunk(dir == 0 ? 0 : NC);
        for (int step = 0; step < nsteps; ++step) {
            const int n = dir == 0 ? step : NC - step;
            {
                bf16_t* spn = stb + ((size_t)((ebase + n) * 4 + h) * 2 + dir) * 32768;
#pragma unroll
                for (int et = 0; et < 2; ++et)
#pragma unroll
                    for (int dtl = 0; dtl < 8; ++dtl) {
                        u32x2 o; o.x = cvt_pk_bf16(acc[et][dtl][0], acc[et][dtl][1]); o.y = cvt_pk_bf16(acc[et][dtl][2], acc[et][dtl][3]);
                        *(u32x2*)(spn + (size_t)(32 * w + 16 * et + fr) * 128 + 16 * dtl + 4 * fq) = o;
                    }
            }
            LDS_BARRIER();
#pragma unroll
            for (int it = 0; it < 2; ++it) tr_store_pair_scaled(KT, (pg + 8 * it) * 8, s2, rk[it][0], rk[it][1], wk0, wk1);
#pragma unroll
            for (int it = 0; it < 4; ++it) tr_store_pair(VT, (pg + 8 * it) * 8, s2, rv[it][0], rv[it][1]);
            if (step + 1 < nsteps) load_chunk(dir == 0 ? step + 1 : NC - step - 1);
            LDS_BARRIER();
#pragma unroll
            for (int et = 0; et < 2; ++et)
#pragma unroll
                for (int dtl = 0; dtl < 8; ++dtl) acc[et][dtl] = acc[et][dtl] * carry;
#pragma unroll
            for (int ks = 0; ks < 4; ++ks) {
                bf16x8 vf[2];
#pragma unroll
                for (int et = 0; et < 2; ++et) vf[et] = *(const LAS bf16x8*)(VT + (32 * w + 16 * et + fr) * LDR + 32 * ks + 8 * fq);
#pragma unroll
                for (int dtl = 0; dtl < 8; ++dtl) {
                    const bf16x8 kf = *(const LAS bf16x8*)(KT + (16 * dtl + fr) * LDR + 32 * ks + 8 * fq);
#pragma unroll
                    for (int et = 0; et < 2; ++et) acc[et][dtl] = __builtin_amdgcn_mfma_f32_16x16x32_bf16(kf, vf[et], acc[et][dtl], 0, 0, 0);
                }
            }
        }
        if (dir == 0) {
            bf16_t* spn = stb + ((size_t)((ebase + NC) * 4 + h) * 2 + dir) * 32768;
#pragma unroll
            for (int et = 0; et < 2; ++et)
#pragma unroll
                for (int dtl = 0; dtl < 8; ++dtl) {
                    u32x2 o; o.x = cvt_pk_bf16(acc[et][dtl][0], acc[et][dtl][1]); o.y = cvt_pk_bf16(acc[et][dtl][2], acc[et][dtl][3]);
                    *(u32x2*)(spn + (size_t)(32 * w + 16 * et + fr) * 128 + 16 * dtl + 4 * fq) = o;
                }
        }
        LDS_BARRIER();
    }
}

__device__ __forceinline__ void ret_pass_b(const Args& a, LAS unsigned char* lds) {
    LAS bf16_t* KL = (LAS bf16_t*)lds;
    LAS bf16_t* BG = KL + 128 * LDR;
    const int tid0 = threadIdx.x;
    const bf16_t* qb = (const bf16_t*)(a.ws + OFF_Q); const bf16_t* kb = (const bf16_t*)(a.ws + OFF_K); const bf16_t* vb = (const bf16_t*)(a.ws + OFF_V);
    const bf16_t* stb = (const bf16_t*)(a.ws + OFF_ST);
    bf16_t* sg = (bf16_t*)a.out;
    u32x4 rk[4], rb[8]; bf16x8 qf[4];
    auto item_info = [&](int item, int& r0, int& h, const bf16_t*& sfp) {
        const int rc = item >> 2; h = item & 3;
        int b, n; if (rc < 512) { b = rc >> 5; n = (rc & 31) + 1; } else { b = 16 + ((rc - 512) >> 4); n = ((rc - 512) & 15) + 1; }
        const int ebase = b < 16 ? b * 33 : 528 + (b - 16) * 17; r0 = rc * 128;
        sfp = stb + ((size_t)((ebase + n) * 4 + h) * 2 + 0) * 32768;
    };
    auto load_item_head = [&](int item, int tid) {
        int r0, h; const bf16_t* sfp; item_info(item, r0, h, sfp);
#pragma unroll
        for (int it = 0; it < 8; ++it) { const int idx = tid + it * 512, e = idx >> 4, pc = idx & 15; rb[it] = *(const u32x4*)(sfp + (size_t)e * 128 + pc * 8); }
    };
    if ((int)blockIdx.x < 2560) load_item_head(blockIdx.x, tid0);
    for (int item = blockIdx.x; item < 2560; item += gridDim.x) {
        int tid = tid0; asm volatile("" : "+v"(tid));
        const int w = tid >> 6, lane = tid & 63, fr = lane & 15, fq = lane >> 4;
        int r0, h; const bf16_t* sfp; item_info(item, r0, h, sfp);
        const bf16_t* sbp = sfp + 32768;
        const float lgf = logsigf_(a.in[14][h]), lgb = logsigf_(a.in[14][4 + h]);
        const int crow = 16 * w + fr;
#pragma unroll
        for (int it = 0; it < 4; ++it) { const int idx = tid + it * 512, s = idx >> 4, pc = idx & 15; rk[it] = *(const u32x4*)(kb + (size_t)(r0 + s) * 512 + h * 128 + pc * 8); }
#pragma unroll
        for (int ks = 0; ks < 4; ++ks) qf[ks] = *(const bf16x8*)(qb + (size_t)(r0 + crow) * 512 + h * 128 + 32 * ks + 8 * fq);
        LDS_BARRIER();
#pragma unroll
        for (int it = 0; it < 4; ++it) { const int idx = tid + it * 512, s = idx >> 4, pc = idx & 15; *(LAS u32x4*)(KL + s * LDR + pc * 8) = rk[it]; }
#pragma unroll
        for (int it = 0; it < 8; ++it) { const int idx = tid + it * 512, e = idx >> 4, pc = idx & 15; *(LAS u32x4*)(BG + e * LDR + pc * 8) = rb[it]; }
#pragma unroll
        for (int it = 0; it < 8; ++it) { const int idx = tid + it * 512, e = idx >> 4, pc = idx & 15; rb[it] = *(const u32x4*)(sbp + (size_t)e * 128 + pc * 8); }
        LDS_BARRIER();
        f32x4 sacc[8];
#pragma unroll
        for (int st = 0; st < 8; ++st) sacc[st] = (f32x4){0.f, 0.f, 0.f, 0.f};
#pragma unroll
        for (int ks = 0; ks < 4; ++ks)
#pragma unroll
            for (int st = 0; st < 8; ++st) {
                const bf16x8 kf = *(const LAS bf16x8*)(KL + (16 * st + fr) * LDR + 32 * ks + 8 * fq);
                sacc[st] = __builtin_amdgcn_mfma_f32_16x16x32_bf16(kf, qf[ks], sacc[st], 0, 0, 0);
                if (st == 7) __builtin_amdgcn_sched_barrier(0);
            }
        bf16x8 pf[4];
#pragma unroll
        for (int t = 0; t < 4; ++t) {
            float pv[8];
#pragma unroll
            for (int hh = 0; hh < 2; ++hh)
#pragma unroll
                for (int j = 0; j < 4; ++j) {
                    const int spp = 16 * (2 * t + hh) + 4 * fq + j, diff = crow - spp;
                    const float dec = diff >= 0 ? __expf(lgf * (float)diff) : __expf(-lgb * (float)diff);
                    pv[hh * 4 + j] = sacc[2 * t + hh][j] * dec;
                }
            u32x4 pw; pw.x = cvt_pk_bf16(pv[0], pv[1]); pw.y = cvt_pk_bf16(pv[2], pv[3]); pw.z = cvt_pk_bf16(pv[4], pv[5]); pw.w = cvt_pk_bf16(pv[6], pv[7]);
            pf[t] = __builtin_bit_cast(bf16x8, pw);
        }
        f32x4 o[16];
#pragma unroll
        for (int et = 0; et < 16; ++et) o[et] = (f32x4){0.f, 0.f, 0.f, 0.f};
#pragma unroll
        for (int ks = 0; ks < 4; ++ks)
#pragma unroll
            for (int et = 0; et < 16; ++et) {
                const bf16x8 sf = *(const LAS bf16x8*)(BG + (16 * et + fr) * LDR + 32 * ks + 8 * fq);
                o[et] = __builtin_amdgcn_mfma_f32_16x16x32_bf16(sf, qf[ks], o[et], 0, 0, 0);
                if ((et & 7) == 7) __builtin_amdgcn_sched_barrier(0);
            }
        const float wqf = __expf(lgf * (float)(crow + 1)), wqb = __expf(lgb * (float)(128 - crow));
        const float ratio = wqf / wqb;
#pragma unroll
        for (int et = 0; et < 16; ++et) o[et] = o[et] * ratio;
        LDS_BARRIER();
#pragma unroll
        for (int it = 0; it < 8; ++it) { const int idx = tid + it * 512, e = idx >> 4, pc = idx & 15; *(LAS u32x4*)(BG + e * LDR + pc * 8) = rb[it]; }
        {
            const int s2 = 2 * (8 * w + (lane & 7));
#pragma unroll
            for (int it = 0; it < 4; ++it)
#pragma unroll
                for (int r = 0; r < 2; ++r) rb[it * 2 + r] = *(const u32x4*)(vb + (size_t)(r0 + s2 + r) * 1024 + h * 256 + ((lane >> 3) + 8 * it) * 8);
        }
        LDS_BARRIER();
#pragma unroll
        for (int ks = 0; ks < 4; ++ks)
#pragma unroll
            for (int et = 0; et < 16; ++et) {
                const bf16x8 sf = *(const LAS bf16x8*)(BG + (16 * et + fr) * LDR + 32 * ks + 8 * fq);
                o[et] = __builtin_amdgcn_mfma_f32_16x16x32_bf16(sf, qf[ks], o[et], 0, 0, 0);
                if ((et & 7) == 7) __builtin_amdgcn_sched_barrier(0);
            }
#pragma unroll
        for (int et = 0; et < 16; ++et) o[et] = o[et] * wqb;
        LDS_BARRIER();
#pragma unroll
        for (int it = 0; it < 4; ++it) tr_store_pair(BG, ((lane >> 3) + 8 * it) * 8, 2 * (8 * w + (lane & 7)), rb[it * 2], rb[it * 2 + 1]);
        if (item + (int)gridDim.x < 2560) load_item_head(item + gridDim.x, tid);
        LDS_BARRIER();
#pragma unroll
        for (int t = 0; t < 4; ++t)
#pragma unroll
            for (int et = 0; et < 16; ++et) {
                const u32x2 lo = *(const LAS u32x2*)(BG + (16 * et + fr) * LDR + 32 * t + 4 * fq);
                const u32x2 hi = *(const LAS u32x2*)(BG + (16 * et + fr) * LDR + 32 * t + 16 + 4 * fq);
                const u32x4 vw = (u32x4){lo.x, lo.y, hi.x, hi.y};
                o[et] = __builtin_amdgcn_mfma_f32_16x16x32_bf16(__builtin_bit_cast(bf16x8, vw), pf[t], o[et], 0, 0, 0);
                if ((et & 7) == 7) __builtin_amdgcn_sched_barrier(0);
            }
        float ss = 0.f;
#pragma unroll
        for (int et = 0; et < 16; ++et) ss += (o[et][0] * o[et][0] + o[et][1] * o[et][1]) + (o[et][2] * o[et][2] + o[et][3] * o[et][3]);
        ss += __shfl_xor(ss, 16); ss += __shfl_xor(ss, 32);
        const float rn = rsqrtf(ss * (1.0f / 256.0f) + EPS);
        bf16_t* gp = sg + (size_t)(r0 + crow) * 1024 + h * 256 + 4 * fq;
        u32x2 gwv[16];
#pragma unroll
        for (int et = 0; et < 16; ++et) gwv[et] = *(const u32x2*)(gp + 16 * et);
#pragma unroll
        for (int et = 0; et < 16; ++et) {
            const u32x2 gw = gwv[et];
            u32x2 ow; ow.x = cvt_pk_bf16(o[et][0] * rn * bflo(gw.x), o[et][1] * rn * bfhi(gw.x)); ow.y = cvt_pk_bf16(o[et][2] * rn * bflo(gw.y), o[et][3] * rn * bfhi(gw.y));
            *(u32x2*)(gp + 16 * et) = ow;
        }
    }
    LDS_BARRIER();
}

__device__ __forceinline__ void final_norm(const Args& a) {
    const int wave = threadIdx.x >> 6, lane = threadIdx.x & 63;
    const float* ssq = (const float*)(a.ws + OFF_SSQ2);
    f32x4 gg[4];
#pragma unroll
    for (int j = 0; j < 4; ++j) gg[j] = *(const f32x4*)(a.in[20] + (j * 64 + lane) * 4);
    for (int rowb = (blockIdx.x * 8 + wave) * 4; rowb < NREAL; rowb += gridDim.x * 32) {
        float part[4]; u32x2 w[4][4];
#pragma unroll
        for (int q = 0; q < 4; ++q) {
            part[q] = lane < 16 ? ssq[(size_t)(rowb + q) * 16 + lane] : 0.f;
            const bf16_t* hrow = (const bf16_t*)(a.ws + OFF_H1B) + (size_t)(rowb + q) * 1024;
#pragma unroll
            for (int j = 0; j < 4; ++j) w[q][j] = *(const u32x2*)(hrow + (j * 64 + lane) * 4);
        }
#pragma unroll
        for (int q = 0; q < 4; ++q) {
            const float rstd = rsqrtf(wave_sum(part[q]) * (1.0f / 1024.0f) + EPS);
            float* orow = a.out + (size_t)(rowb + q) * 1024;
#pragma unroll
            for (int j = 0; j < 4; ++j) {
                f32x4 v;
                v[0] = bflo(w[q][j].x) * rstd * gg[j][0]; v[1] = bfhi(w[q][j].x) * rstd * gg[j][1]; v[2] = bflo(w[q][j].y) * rstd * gg[j][2]; v[3] = bfhi(w[q][j].y) * rstd * gg[j][3];
                *(f32x4*)(orow + (j * 64 + lane) * 4) = v;
            }
        }
    }
}

template <int ph>
__device__ __forceinline__ void run_phase(const Args& a, LAS unsigned char* lds) {
    unsigned char* ws = a.ws;
    bf16_t* dob = (bf16_t*)a.out;
    bf16_t* sgp = dob; bf16_t* gap = dob + (size_t)NREAL * 1024;
#ifdef ONLY_PH
    if (ph != ONLY_PH) return;
#endif
    switch (ph) {
    case 0: phase0(a, lds); break;
    case 1: {
        pg8::Gemm g{(const bf16_t*)(ws + OFF_N1), (const bf16_t*)(ws + OFF_WIN), 1024, 1024, 1024, RPAD / 256, INW / 256, 1, 0, 0, STG};
        EpiProj E{(bf16_t*)(ws + OFF_U5), (bf16_t*)(ws + OFF_Q), (bf16_t*)(ws + OFF_K), (bf16_t*)(ws + OFF_V), sgp, gap, (bf16_t*)(ws + OFF_GB), (const LAS double*)(lds + 131072)};
        pg8::gemm_phase(lds, g, E);
    } break;
    case 2: {
        pg8::Gemm g{(const bf16_t*)(ws + OFF_U5), (const bf16_t*)(ws + OFF_BTS), LDA5, 512, 512, IT_PAD / 256, 1, 32, (size_t)IT_PAD * LDA5, (size_t)256 * 512, 0};
        EpiSloc E{(float*)(ws + OFF_SLOC)};
        pg8::gemm_phase(lds, g, E);
    } break;
    case 3: s5_scan(a); break;
    case 4: {
        pg8::Gemm g{(const bf16_t*)(ws + OFF_U5), (const bf16_t*)(ws + OFF_BTY), LDA5, 768, 768, IT_PAD / 256, 2, 32, (size_t)IT_PAD * LDA5, (size_t)512 * 768, 0};
        EpiY E{(bf16_t*)(ws + OFF_YSSM)};
        pg8::gemm_phase(lds, g, E);
    } break;
    case 5: {
        pg8::Gemm g{(const bf16_t*)(ws + OFF_YSSM), (const bf16_t*)(ws + OFF_WGLU), 512, 512, 512, NREAL / 256, 8, 1, 0, 0, STG};
        EpiGlu E{gap};
        pg8::gemm_phase(lds, g, E);
    } break;
    case 6: ret_pass_a(a, lds); break;
    case 7: ret_pass_b(a, lds); break;
    case 8: {
        pg8::Gemm g{sgp, (const bf16_t*)(ws + OFF_WRET), 1024, 1024, 1024, NREAL / 256, 4, 1, 0, 0, STG};
        EpiRet E{gap, (const bf16_t*)(ws + OFF_GB), (bf16_t*)(ws + OFF_MIXED)};
        pg8::gemm_phase(lds, g, E);
    } break;
    case 9: {
        pg8::Gemm g{(const bf16_t*)(ws + OFF_MIXED), (const bf16_t*)(ws + OFF_WOUT), 1024, 1024, 1024, NREAL / 256, 4, 1, 0, 0, STG};
        EpiRes<0> E{a.in[0], a.in[1], (bf16_t*)(ws + OFF_H1B), (float*)(ws + OFF_SSQ1)};
        pg8::gemm_phase(lds, g, E);
    } break;
    case 10: {
        pg8::Gemm g{(const bf16_t*)(ws + OFF_H1B), (const bf16_t*)(ws + OFF_WFFI), 1024, 1024, 1024, NREAL / 256, INW / 256, 1, 0, 0, STG};
        EpiFfi E{(const float*)(ws + OFF_SSQ1), (bf16_t*)(ws + OFF_ACT)};
        pg8::gemm_phase(lds, g, E);
    } break;
    case 11: {
        pg8::Gemm g{(const bf16_t*)(ws + OFF_ACT), (const bf16_t*)(ws + OFF_WFFO), DFF, DFF, DFF, NREAL / 256, 4, 1, 0, 0, STG};
        EpiRes<1> E{nullptr, nullptr, (bf16_t*)(ws + OFF_H1B), (float*)(ws + OFF_SSQ2)};
        pg8::gemm_phase(lds, g, E);
    } break;
    case 12: final_norm(a); break;
    default: break;
    }
}

__device__ __forceinline__ void grid_barrier(unsigned* ctr, unsigned target) {
    asm volatile("s_waitcnt vmcnt(0) lgkmcnt(0)" ::: "memory");
    __syncthreads();
    if (threadIdx.x == 0) {
        __builtin_amdgcn_fence(__ATOMIC_RELEASE, "agent");
        asm volatile("s_waitcnt vmcnt(0)" ::: "memory");
        __hip_atomic_fetch_add(ctr, 1u, __ATOMIC_RELAXED, __HIP_MEMORY_SCOPE_AGENT);
        unsigned spins = 0;
        while (__hip_atomic_load(ctr, __ATOMIC_RELAXED, __HIP_MEMORY_SCOPE_AGENT) < target && ++spins < (1u << 24)) __builtin_amdgcn_s_sleep(2);
        __builtin_amdgcn_fence(__ATOMIC_ACQUIRE, "agent");
        asm volatile("s_waitcnt vmcnt(0)" ::: "memory");
    }
    __syncthreads();
}

template <bool COOP>
__global__ __launch_bounds__(512, 2) void fwd_kernel(Args a) {
    extern __shared__ __attribute__((aligned(16))) unsigned char shm[];
    LAS unsigned char* lds = (LAS unsigned char*)shm;
    if (threadIdx.x < 64) ((LAS double*)(lds + 131072))[threadIdx.x] = exp2(-(double)threadIdx.x * (13.287712379549449 / 64.0));
    __syncthreads();
#define RUN_PH(P) if (a.ph_lo <= P && P < a.ph_hi) { run_phase<P>(a, lds); if ((DBL_MASK >> P) & 1) run_phase<P>(a, lds); if (COOP && P + 1 < a.ph_hi) { if (P == 0) { __threadfence(); cg::this_grid().sync(); } else grid_barrier((unsigned*)(a.ws + OFF_BAR), (unsigned)P * gridDim.x); } }
    RUN_PH(0) RUN_PH(1) RUN_PH(2) RUN_PH(3) RUN_PH(4) RUN_PH(5) RUN_PH(6) RUN_PH(7) RUN_PH(8) RUN_PH(9) RUN_PH(10) RUN_PH(11) RUN_PH(12)
#undef RUN_PH
}

extern "C" void kernel_launch(void* const* d_in, const int* in_sizes, int n_in, void* d_out, int out_size, void* d_ws, size_t ws_size, hipStream_t stream) {
    static int grid = 0;
    if (grid == 0) {
        if (n_in != 21 || ws_size < WS_NEED || out_size != NREAL * 1024) { fprintf(stderr, "kernel_launch: unexpected shapes (n_in %d, ws %zu need %zu, out %d)\n", n_in, ws_size, (size_t)WS_NEED, out_size); grid = -1; return; }
        int dev = 0, cus = 0;
        hipGetDevice(&dev); hipDeviceGetAttribute(&cus, hipDeviceAttributeMultiprocessorCount, dev);
        hipFuncSetAttribute((const void*)fwd_kernel<true>, hipFuncAttributeMaxDynamicSharedMemorySize, LDS_BYTES);
        hipFuncSetAttribute((const void*)fwd_kernel<false>, hipFuncAttributeMaxDynamicSharedMemorySize, LDS_BYTES);
        int per_cu = 0;
        hipOccupancyMaxActiveBlocksPerMultiprocessor(&per_cu, (const void*)fwd_kernel<true>, 512, LDS_BYTES);
        if (per_cu < 1) { fprintf(stderr, "kernel_launch: occupancy query says %d blocks per CU\n", per_cu); per_cu = 1; }
        (void)hipGetLastError();
        grid = cus * 1;
    }
    if (grid < 0) return;
    Args a{};
    for (int i = 0; i < 21; ++i) a.in[i] = (const float*)d_in[i];
    a.out = (float*)d_out; a.ws = (unsigned char*)d_ws;
#if COOP_MODE
    hipMemsetAsync((char*)d_ws + OFF_BAR, 0, 256, stream);
    a.ph_lo = 0; a.ph_hi = NPHASE;
    void* args[] = {&a};
    hipError_t e = hipLaunchCooperativeKernel((const void*)fwd_kernel<true>, dim3(grid), dim3(512), args, LDS_BYTES, stream);
    if (e != hipSuccess) fprintf(stderr, "cooperative launch failed: %s (grid %d)\n", hipGetErrorString(e), grid);
#else
    for (int ph = 0; ph < NPHASE; ++ph) {
        a.ph_lo = ph; a.ph_hi = ph + 1;
        hipLaunchKernelGGL(fwd_kernel<false>, dim3(grid), dim3(512), LDS_BYTES, stream, a);
    }
#endif
}
```

```cpp
#include <hip/hip_runtime.h>
#include <hip/hip_cooperative_groups.h>
#include <cstdio>
#include <cstdint>
namespace cg = cooperative_groups;

#ifndef COOP_MODE
#define COOP_MODE 1
#endif

#define DBL_MASK 0x0
#define LAS __attribute__((address_space(3)))
typedef unsigned short bf16_t;
typedef short bf16x8 __attribute__((ext_vector_type(8)));
typedef float f32x4 __attribute__((ext_vector_type(4)));
typedef unsigned u32x4 __attribute__((ext_vector_type(4)));
typedef unsigned u32x2 __attribute__((ext_vector_type(2)));

constexpr int D = 1024, NREAL = 81920, NPR = 65536, RPAD = 82432, NVALID = 82304;
constexpr int INW = 5632, DFF = 2816;
constexpr int T5 = 32, IT_REAL = 2560, IT_PAD = 2816, LDA5 = 768;
constexpr float EPS = 1e-6f;

constexpr size_t OFF_WIN = 0;
constexpr size_t OFF_WGLU = OFF_WIN + (size_t)INW * D * 2;
constexpr size_t OFF_WRET = OFF_WGLU + (size_t)2048 * 512 * 2;
constexpr size_t OFF_WOUT = OFF_WRET + (size_t)D * D * 2;
constexpr size_t OFF_WFFI = OFF_WOUT + (size_t)D * D * 2;
constexpr size_t OFF_WFFO = OFF_WFFI + (size_t)INW * D * 2;
constexpr size_t OFF_AT = OFF_WFFO + (size_t)D * DFF * 2;
constexpr size_t OFF_BAR = OFF_AT + 32768;
constexpr size_t OFF_Q = OFF_AT + 65536;
constexpr size_t OFF_K = OFF_Q + (size_t)RPAD * 512 * 2;
constexpr size_t OFF_V = OFF_K + (size_t)RPAD * 512 * 2;
constexpr size_t OFF_GB = OFF_V + (size_t)RPAD * D * 2;
constexpr size_t OFF_SSQ1 = OFF_GB + (size_t)NREAL * D * 2;
constexpr size_t OFF_SSQ2 = OFF_SSQ1 + (size_t)NREAL * 16 * 4;
constexpr size_t OFF_X = OFF_SSQ2 + (size_t)NREAL * 16 * 4;
constexpr size_t OFF_N1 = OFF_X;
constexpr size_t OFF_YSSM = OFF_X;
constexpr size_t OFF_U5 = OFF_N1 + (size_t)RPAD * D * 2;
constexpr size_t OFF_BTY = OFF_U5 + (size_t)32 * IT_PAD * LDA5 * 2;
constexpr size_t OFF_BTS = OFF_BTY + (size_t)32 * 512 * 768 * 2;
constexpr size_t OFF_SLOC = OFF_BTS + (size_t)32 * 256 * 512 * 2;
constexpr size_t END_X03 = OFF_SLOC + (size_t)32 * IT_PAD * 256 * 4;
constexpr size_t OFF_ST = OFF_X;
constexpr size_t END_ST = OFF_ST + (size_t)664 * 8 * 65536;
constexpr size_t OFF_ACT = OFF_X;
constexpr size_t END_ACT = OFF_ACT + (size_t)NREAL * DFF * 2;
constexpr size_t OFF_MIXED = OFF_Q;
constexpr size_t OFF_H1B = OFF_V;
constexpr size_t cmax(size_t a, size_t b) { return a > b ? a : b; }
constexpr size_t WS_NEED = cmax(END_X03, cmax(END_ST, END_ACT));

constexpr int LDS_BYTES = 131072 + 1024;
constexpr int NPHASE = 13;
constexpr int STG = 0;

struct Args {
    const float* in[21];
    float* out;
    unsigned char* ws;
    int ph_lo, ph_hi;
};

__device__ __forceinline__ unsigned cvt_pk_bf16(float lo, float hi) { unsigned r; asm volatile("v_cvt_pk_bf16_f32 %0, %1, %2" : "=v"(r) : "v"(lo), "v"(hi)); return r; }
__device__ __forceinline__ bf16_t f2bf(float f) { return (bf16_t)(cvt_pk_bf16(f, 0.f) & 0xFFFFu); }
__device__ __forceinline__ float bflo(unsigned w) { return __uint_as_float(w << 16); }
__device__ __forceinline__ float bfhi(unsigned w) { return __uint_as_float(w & 0xFFFF0000u); }
__device__ __forceinline__ float sigmoidf_(float x) { return __fdividef(1.0f, 1.0f + __expf(-x)); }
__device__ __forceinline__ float siluf_(float x) { return x * sigmoidf_(x); }
__device__ __forceinline__ float gelu_tanh(float x) { const float z = 0.7978845608028654f * (x + 0.044715f * x * x * x); return x * sigmoidf_(2.0f * z); }
__device__ __forceinline__ float logsigf_(float x) { return fminf(x, 0.f) - log1pf(__expf(-fabsf(x))); }
__device__ __forceinline__ float wave_sum(float v) {
#pragma unroll
    for (int o = 1; o < 64; o <<= 1) v += __shfl_xor(v, o);
    return v;
}
__device__ __forceinline__ void sincos_rev(double ang, float& s, float& c) {
    double x = ang * 0.15915494309189535; x -= rint(x);
    const float xf = (float)x;
    s = __builtin_amdgcn_sinf(xf); c = __builtin_amdgcn_cosf(xf);
}

namespace pg8 {
constexpr int BM = 256, BK = 64, HALF = 128, HTB = HALF * BK * 2, STAGE_BYTES = 8 * HTB, NXCD = 8, WGM = 8;
__device__ __forceinline__ int lds_byte(int r, int c) { const int st = (r >> 4) * 2 + (c >> 5), rr = r & 15, cc = c & 31, ob = rr * 64 + cc * 2; return st * 1024 + (ob ^ (((ob >> 9) & 1) << 5)); }
__device__ __forceinline__ void stage_rc(int b, int& R, int& C) { const int st = b / 1024, sb = b % 1024, swz = sb ^ (((sb >> 9) & 1) << 5); R = (st >> 1) * 16 + swz / 64; C = (st & 1) * 32 + (swz % 64) / 2; }
__device__ __forceinline__ int perm32(int rho) { const int n = rho >> 4, i = rho & 15; return 8 * (i >> 2) + 4 * n + (i & 3); }

struct Unit { int pm, pn, g; };
struct Gemm { const bf16_t* A; const bf16_t* Bt; int lda, ldb, K, nM, nN, nb; size_t sA, sB; int stagger; };

struct Order {
    int nM, nN, nwg, total, G, c;
    __device__ void init(int nM_, int nN_, int nb, int G_, int c_) { nM = nM_; nN = nN_; nwg = nM * nN; total = nwg * nb; G = G_; c = c_; }
    __device__ bool next(int i, Unit& u) const {
        const long L = (long)i * G + c; if (L >= total) return false;
        u.g = (int)(L / nwg); int wgid = (int)(L % nwg);
        { const int q = nwg / NXCD, r = nwg % NXCD, xcd = wgid % NXCD, off = wgid / NXCD; wgid = (xcd < r ? xcd * (q + 1) : r * (q + 1) + (xcd - r) * q) + off; }
        const int nig = WGM * nN, gid = wgid / nig, fm = gid * WGM, gsz = (nM - fm) < WGM ? (nM - fm) : WGM;
        u.pm = fm + ((wgid % nig) % gsz); u.pn = (wgid % nig) / gsz; return true;
    }
};

template <class Epi>
__device__ __forceinline__ void gemm_phase(LAS unsigned char* lds, const Gemm g, const Epi& E) {
    const int tid = threadIdx.x, wid = __builtin_amdgcn_readfirstlane(tid >> 6), lane = tid & 63, wr = wid >> 2, wc = wid & 3, fr = lane & 15, fq = lane >> 4;
    const int K = g.K, nt = K / BK;
    Order S; S.init(g.nM, g.nN, g.nb, (int)gridDim.x, (int)blockIdx.x);
    unsigned voffA[2], voffB[2];
#pragma unroll
    for (int i = 0; i < 2; ++i) { int R, C; stage_rc(tid * 16 + i * 8192, R, C); const int Rb = (R & ~31) + perm32(R & 31);
        voffA[i] = (unsigned)(R * g.lda + C) * 2u; voffB[i] = (unsigned)(Rb * g.ldb + C) * 2u; }
    const size_t kstep = (size_t)(BK * 2);
    const size_t hstepA = (size_t)HALF * g.lda * 2, hstepB = (size_t)HALF * g.ldb * 2;
    const size_t tstepA = 2 * hstepA, tstepB = 2 * hstepB;
    const unsigned ldsw = (unsigned)wid * 1024u;
    const int aoff = lds_byte(wr * 64 + fr, fq * 8), boff = lds_byte(wc * 32 + fr, fq * 8);
#define PG8_SA(b, h) (((b) * 2 + (h)) * HTB)
#define PG8_SB(b, h) ((4 + (b) * 2 + (h)) * HTB)
#define PG8_STAGE(bufoff, gbase, voff) do { _Pragma("unroll") for (int _i = 0; _i < 2; ++_i) \
        __builtin_amdgcn_global_load_lds((const unsigned*)((const char*)(gbase) + (voff)[_i]), (LAS unsigned*)(lds + (bufoff) + ldsw + _i * 8192), 16, 0, 0); } while (0)
#define PG8_LDA(dst, b, h) do { _Pragma("unroll") for (int m = 0; m < 4; ++m) _Pragma("unroll") for (int k = 0; k < 2; ++k) dst[m][k] = *(const LAS bf16x8*)(lds + PG8_SA(b, h) + aoff + m * 2048 + k * 1024); } while (0)
#define PG8_LDB(dst, b, h) do { _Pragma("unroll") for (int n = 0; n < 2; ++n) _Pragma("unroll") for (int k = 0; k < 2; ++k) dst[n][k] = *(const LAS bf16x8*)(lds + PG8_SB(b, h) + boff + n * 2048 + k * 1024); } while (0)
#define PG8_MMA(ai, bj, At, Bt) do { __builtin_amdgcn_s_setprio(1); _Pragma("unroll") for (int m = 0; m < 4; ++m) _Pragma("unroll") for (int n = 0; n < 2; ++n) _Pragma("unroll") for (int k = 0; k < 2; ++k) \
        acc[ai][bj][m][n] = __builtin_amdgcn_mfma_f32_16x16x32_bf16(Bt[n][k], At[m][k], acc[ai][bj][m][n], 0, 0, 0); __builtin_amdgcn_s_setprio(0); } while (0)
#define PG8_WAIT_V(n) asm volatile("s_waitcnt vmcnt(" #n ")" ::: "memory")
#define PG8_WAIT_L(n) asm volatile("s_waitcnt lgkmcnt(" #n ")" ::: "memory")
#define PG8_BAR __builtin_amdgcn_s_barrier()
#define PG8_SCHED __builtin_amdgcn_sched_barrier(0)
    Unit cur, nxt; int ui = 0;
    if (!S.next(0, cur)) return;
    if (g.stagger) {
        const unsigned long long t0 = __builtin_amdgcn_s_memrealtime(), wt = (unsigned long long)((blockIdx.x & 3) * g.stagger);
        while (__builtin_amdgcn_s_memrealtime() - t0 < wt) __builtin_amdgcn_s_sleep(16);
    }
    f32x4 acc[2][2][4][2];
#pragma unroll
    for (int a = 0; a < 2; ++a)
#pragma unroll
        for (int b = 0; b < 2; ++b)
#pragma unroll
            for (int m = 0; m < 4; ++m)
#pragma unroll
                for (int n = 0; n < 2; ++n) acc[a][b][m][n] = (f32x4){0.f, 0.f, 0.f, 0.f};
    bf16x8 At[4][2], B0[2][2], B1[2][2];
    const char* cA = (const char*)g.A + ((size_t)cur.g * g.sA) * 2 + (size_t)cur.pm * tstepA;
    const char* cB = (const char*)g.Bt + ((size_t)cur.g * g.sB) * 2 + (size_t)cur.pn * tstepB;
    PG8_STAGE(PG8_SB(0, 0), cB, voffB); PG8_STAGE(PG8_SA(0, 0), cA, voffA); PG8_STAGE(PG8_SB(0, 1), cB + hstepB, voffB); PG8_STAGE(PG8_SA(0, 1), cA + hstepA, voffA);
    if (wr == 1) PG8_BAR;
    PG8_WAIT_V(4); PG8_BAR;
    PG8_STAGE(PG8_SB(1, 0), cB + kstep, voffB); PG8_STAGE(PG8_SA(1, 0), cA + kstep, voffA); PG8_STAGE(PG8_SB(1, 1), cB + hstepB + kstep, voffB);
    PG8_WAIT_V(6); PG8_BAR;
    for (;;) {
        const bool has_next = S.next(ui + 1, nxt);
        const char* nA = has_next ? (const char*)g.A + ((size_t)nxt.g * g.sA) * 2 + (size_t)nxt.pm * tstepA : cA;
        const char* nB = has_next ? (const char*)g.Bt + ((size_t)nxt.g * g.sB) * 2 + (size_t)nxt.pn * tstepB : cB;
        for (int t = 0; t < nt; t += 2) {
            const bool last = (t == nt - 2);
            const char* a1 = cA + (size_t)(t + 1) * kstep;
            const char* a2 = last ? nA : cA + (size_t)(t + 2) * kstep; const char* b2 = last ? nB : cB + (size_t)(t + 2) * kstep;
            const char* a3 = a2 + kstep; const char* b3 = b2 + kstep;
            PG8_LDB(B0, 0, 0); PG8_SCHED; PG8_LDA(At, 0, 0); PG8_STAGE(PG8_SA(1, 1), a1 + hstepA, voffA);
            PG8_WAIT_L(8); PG8_BAR; PG8_WAIT_L(0); PG8_MMA(0, 0, At, B0); PG8_BAR; PG8_SCHED;
            PG8_LDB(B1, 0, 1); PG8_STAGE(PG8_SB(0, 0), b2, voffB);
            PG8_BAR; PG8_WAIT_L(0); PG8_MMA(0, 1, At, B1); PG8_BAR;
            PG8_LDA(At, 0, 1); PG8_STAGE(PG8_SA(0, 0), a2, voffA);
            PG8_BAR; PG8_WAIT_L(0); PG8_MMA(1, 0, At, B0); PG8_BAR; PG8_SCHED;
            PG8_STAGE(PG8_SB(0, 1), b2 + hstepB, voffB);
            PG8_WAIT_V(6); PG8_BAR; PG8_MMA(1, 1, At, B1); PG8_BAR;
            PG8_LDB(B0, 1, 0); PG8_SCHED; PG8_LDA(At, 1, 0); PG8_STAGE(PG8_SA(0, 1), a2 + hstepA, voffA);
            PG8_WAIT_L(8); PG8_BAR; PG8_WAIT_L(0); PG8_MMA(0, 0, At, B0); PG8_BAR; PG8_SCHED;
            PG8_LDB(B1, 1, 1); PG8_STAGE(PG8_SB(1, 0), b3, voffB);
            PG8_BAR; PG8_WAIT_L(0); PG8_MMA(0, 1, At, B1); PG8_BAR;
            PG8_LDA(At, 1, 1); PG8_STAGE(PG8_SA(1, 0), a3, voffA);
            PG8_BAR; PG8_WAIT_L(0); PG8_MMA(1, 0, At, B0); PG8_BAR; PG8_SCHED;
            PG8_STAGE(PG8_SB(1, 1), b3 + hstepB, voffB);
            PG8_WAIT_V(6); PG8_BAR; PG8_MMA(1, 1, At, B1); PG8_BAR;
        }
        E(acc, cur, wr, wc, fr, fq);
        if (!has_next) break;
#pragma unroll
        for (int a = 0; a < 2; ++a)
#pragma unroll
            for (int b = 0; b < 2; ++b)
#pragma unroll
                for (int m = 0; m < 4; ++m)
#pragma unroll
                    for (int n = 0; n < 2; ++n) acc[a][b][m][n] = (f32x4){0.f, 0.f, 0.f, 0.f};
        cur = nxt; cA = nA; cB = nB; ++ui;
    }
    PG8_WAIT_V(0);
    if (wr == 0) PG8_BAR;
    PG8_BAR;
#undef PG8_SA
#undef PG8_SB
#undef PG8_STAGE
#undef PG8_LDA
#undef PG8_LDB
#undef PG8_MMA
#undef PG8_WAIT_V
#undef PG8_WAIT_L
#undef PG8_BAR
#undef PG8_SCHED
}
}
using pg8::Unit;
typedef const f32x4 (&AccRef)[2][2][4][2];

__device__ __forceinline__ u32x4 pack8(f32x4 a, f32x4 b) { u32x4 w; w.x = cvt_pk_bf16(a[0], a[1]); w.y = cvt_pk_bf16(a[2], a[3]); w.z = cvt_pk_bf16(b[0], b[1]); w.w = cvt_pk_bf16(b[2], b[3]); return w; }

struct EpiProj {
    bf16_t *u5, *q, *k, *v, *sg, *ga, *gb; const LAS double* ropef;
    __device__ __forceinline__ void operator()(AccRef acc, const Unit& u, int wr, int wc, int fr, int fq) const {
        const int pn = u.pn;
#pragma unroll
        for (int ai = 0; ai < 2; ++ai)
#pragma unroll
            for (int m = 0; m < 4; ++m) {
                const int row = u.pm * 256 + ai * 128 + wr * 64 + m * 16 + fr;
#pragma unroll
                for (int bj = 0; bj < 2; ++bj) {
                    const int col = pn * 256 + bj * 128 + wc * 32 + 8 * fq;
                    f32x4 v0 = acc[ai][bj][m][0], v1 = acc[ai][bj][m][1];
                    if (pn < 2) {
                        if (row < NVALID) {
                            int item, t;
                            if (row < NREAL) { item = row >> 5; t = row & 31; } else { const int mr = row - NREAL; item = IT_REAL + (mr >> 4); t = 16 + (mr & 15); }
                            const int g = col >> 4, h0 = col & 15;
                            *(u32x4*)(u5 + ((size_t)(g * IT_PAD + item) * LDA5 + t * 16 + h0)) = pack8(v0, v1);
                        }
                    } else if (pn < 6) {
                        const int cq = col - 512, isk = cq >> 9, cc = cq & 511, i0 = (cc & 127) >> 1;
                        const int pos = row < NPR ? 16 + (row & 4095) : (row < NREAL ? 16 + ((row - NPR) & 2047) : ((row - NREAL) & 15));
                        const float sc = isk ? 1.0f : 0.08838834764831845f;
                        float o[8];
#pragma unroll
                        for (int pi = 0; pi < 4; ++pi) {
                            float s, c; sincos_rev((double)pos * ropef[i0 + pi], s, c);
                            const float x1 = pi < 2 ? v0[2 * pi] : v1[2 * pi - 4], x2 = pi < 2 ? v0[2 * pi + 1] : v1[2 * pi - 3];
                            o[2 * pi] = (x1 * c - x2 * s) * sc; o[2 * pi + 1] = (x1 * s + x2 * c) * sc;
                        }
                        u32x4 w; w.x = cvt_pk_bf16(o[0], o[1]); w.y = cvt_pk_bf16(o[2], o[3]); w.z = cvt_pk_bf16(o[4], o[5]); w.w = cvt_pk_bf16(o[6], o[7]);
                        *(u32x4*)((isk ? k : q) + (size_t)row * 512 + cc) = w;
                    } else if (pn < 10) {
                        *(u32x4*)(v + (size_t)row * 1024 + (col - 1536)) = pack8(v0, v1);
                    } else if (row < NREAL) {
                        if (pn < 14) {
#pragma unroll
                            for (int j = 0; j < 4; ++j) { v0[j] = siluf_(v0[j]); v1[j] = siluf_(v1[j]); }
                            *(u32x4*)(sg + (size_t)row * 1024 + (col - 2560)) = pack8(v0, v1);
                        } else {
#pragma unroll
                            for (int j = 0; j < 4; ++j) { v0[j] = sigmoidf_(v0[j]); v1[j] = sigmoidf_(v1[j]); }
                            if (pn < 18) *(u32x4*)(ga + (size_t)row * 1024 + (col - 3584)) = pack8(v0, v1);
                            else *(u32x4*)(gb + (size_t)row * 1024 + (col - 4608)) = pack8(v0, v1);
                        }
                    }
                }
            }
    }
};

struct EpiSink {
    float* p; int flag;
    __device__ __forceinline__ void operator()(AccRef acc, const Unit& u, int wr, int wc, int fr, int fq) const {
        if (flag) {
#pragma unroll
            for (int ai = 0; ai < 2; ++ai)
#pragma unroll
                for (int m = 0; m < 4; ++m)
#pragma unroll
                    for (int bj = 0; bj < 2; ++bj) { p[(ai * 8 + m * 2 + bj) * 8 + fr] = acc[ai][bj][m][0][0] + acc[ai][bj][m][1][1]; }
        }
    }
};

struct EpiSloc {
    float* sloc;
    __device__ __forceinline__ void operator()(AccRef acc, const Unit& u, int wr, int wc, int fr, int fq) const {
#pragma unroll
        for (int ai = 0; ai < 2; ++ai)
#pragma unroll
            for (int m = 0; m < 4; ++m) {
                const int row = u.pm * 256 + ai * 128 + wr * 64 + m * 16 + fr;
#pragma unroll
                for (int bj = 0; bj < 2; ++bj) {
                    const int col = bj * 128 + wc * 32 + 8 * fq;
                    float* p = sloc + ((size_t)u.g * IT_PAD + row) * 256 + col;
                    *(f32x4*)p = acc[ai][bj][m][0]; *(f32x4*)(p + 4) = acc[ai][bj][m][1];
                }
            }
    }
};

struct EpiY {
    bf16_t* y;
    __device__ __forceinline__ void operator()(AccRef acc, const Unit& u, int wr, int wc, int fr, int fq) const {
#pragma unroll
        for (int ai = 0; ai < 2; ++ai)
#pragma unroll
            for (int m = 0; m < 4; ++m) {
                const int item = u.pm * 256 + ai * 128 + wr * 64 + m * 16 + fr;
                if (item < IT_REAL) {
#pragma unroll
                    for (int bj = 0; bj < 2; ++bj) {
                        const int col = u.pn * 256 + bj * 128 + wc * 32 + 8 * fq, to = col >> 4, ho = col & 15;
                        f32x4 v0 = acc[ai][bj][m][0], v1 = acc[ai][bj][m][1];
#pragma unroll
                        for (int j = 0; j < 4; ++j) { v0[j] = gelu_tanh(v0[j]); v1[j] = gelu_tanh(v1[j]); }
                        *(u32x4*)(y + (size_t)(item * 32 + to) * 512 + u.g * 16 + ho) = pack8(v0, v1);
                    }
                }
            }
    }
};

struct EpiGlu {
    bf16_t* ga;
    __device__ __forceinline__ void operator()(AccRef acc, const Unit& u, int wr, int wc, int fr, int fq) const {
        u32x4 gw[2][4];
#pragma unroll
        for (int ai = 0; ai < 2; ++ai)
#pragma unroll
            for (int m = 0; m < 4; ++m) {
                const int row = u.pm * 256 + ai * 128 + wr * 64 + m * 16 + fr;
                gw[ai][m] = *(const u32x4*)(ga + (size_t)row * 1024 + u.pn * 128 + wc * 32 + 8 * fq);
            }
#pragma unroll
        for (int ai = 0; ai < 2; ++ai)
#pragma unroll
            for (int m = 0; m < 4; ++m) {
                const int row = u.pm * 256 + ai * 128 + wr * 64 + m * 16 + fr;
                bf16_t* p = ga + (size_t)row * 1024 + u.pn * 128 + wc * 32 + 8 * fq;
                const u32x4 g = gw[ai][m];
                const f32x4 a0 = acc[ai][0][m][0], a1 = acc[ai][0][m][1], g0 = acc[ai][1][m][0], g1 = acc[ai][1][m][1];
                f32x4 r0, r1;
                r0[0] = bflo(g.x) * a0[0] * sigmoidf_(g0[0]); r0[1] = bfhi(g.x) * a0[1] * sigmoidf_(g0[1]);
                r0[2] = bflo(g.y) * a0[2] * sigmoidf_(g0[2]); r0[3] = bfhi(g.y) * a0[3] * sigmoidf_(g0[3]);
                r1[0] = bflo(g.z) * a1[0] * sigmoidf_(g1[0]); r1[1] = bfhi(g.z) * a1[1] * sigmoidf_(g1[1]);
                r1[2] = bflo(g.w) * a1[2] * sigmoidf_(g1[2]); r1[3] = bfhi(g.w) * a1[3] * sigmoidf_(g1[3]);
                *(u32x4*)p = pack8(r0, r1);
            }
    }
};

struct EpiRet {
    const bf16_t *pa, *gb; bf16_t* mixed;
    __device__ __forceinline__ void operator()(AccRef acc, const Unit& u, int wr, int wc, int fr, int fq) const {
#pragma unroll
        for (int ai = 0; ai < 2; ++ai) {
            u32x4 pw[4][2], gw[4][2];
#pragma unroll
            for (int m = 0; m < 4; ++m)
#pragma unroll
                for (int bj = 0; bj < 2; ++bj) {
                    const int row = u.pm * 256 + ai * 128 + wr * 64 + m * 16 + fr;
                    const size_t o = (size_t)row * 1024 + u.pn * 256 + bj * 128 + wc * 32 + 8 * fq;
                    pw[m][bj] = *(const u32x4*)(pa + o); gw[m][bj] = *(const u32x4*)(gb + o);
                }
#pragma unroll
            for (int m = 0; m < 4; ++m)
#pragma unroll
                for (int bj = 0; bj < 2; ++bj) {
                    const int row = u.pm * 256 + ai * 128 + wr * 64 + m * 16 + fr;
                    const size_t o = (size_t)row * 1024 + u.pn * 256 + bj * 128 + wc * 32 + 8 * fq;
                    const u32x4 p = pw[m][bj], g = gw[m][bj];
                    const f32x4 a0 = acc[ai][bj][m][0], a1 = acc[ai][bj][m][1];
                    f32x4 r0, r1;
                    r0[0] = bflo(p.x) + bflo(g.x) * a0[0]; r0[1] = bfhi(p.x) + bfhi(g.x) * a0[1];
                    r0[2] = bflo(p.y) + bflo(g.y) * a0[2]; r0[3] = bfhi(p.y) + bfhi(g.y) * a0[3];
                    r1[0] = bflo(p.z) + bflo(g.z) * a1[0]; r1[1] = bfhi(p.z) + bfhi(g.z) * a1[1];
                    r1[2] = bflo(p.w) + bflo(g.w) * a1[2]; r1[3] = bfhi(p.w) + bfhi(g.w) * a1[3];
                    *(u32x4*)(mixed + o) = pack8(r0, r1);
                }
            __builtin_amdgcn_sched_barrier(0);
        }
    }
};

template <int MODE>
struct EpiRes {
    const float *xp, *xs; bf16_t* hb; float* ssq;
    __device__ __forceinline__ void operator()(AccRef acc, const Unit& u, int wr, int wc, int fr, int fq) const {
#pragma unroll
        for (int ai = 0; ai < 2; ++ai) {
            f32x4 x0[4][2], x1[4][2]; u32x4 hw[4][2];
#pragma unroll
            for (int m = 0; m < 4; ++m)
#pragma unroll
                for (int bj = 0; bj < 2; ++bj) {
                    const int row = u.pm * 256 + ai * 128 + wr * 64 + m * 16 + fr, col = u.pn * 256 + bj * 128 + wc * 32 + 8 * fq;
                    if (MODE == 0) {
                        const float* src = (row < NPR ? xp + (size_t)row * 1024 : xs + (size_t)(row - NPR) * 1024) + col;
                        x0[m][bj] = *(const f32x4*)src; x1[m][bj] = *(const f32x4*)(src + 4);
                    } else hw[m][bj] = *(const u32x4*)(hb + (size_t)row * 1024 + col);
                }
#pragma unroll
            for (int m = 0; m < 4; ++m) {
                const int row = u.pm * 256 + ai * 128 + wr * 64 + m * 16 + fr;
                float ss = 0.f;
#pragma unroll
                for (int bj = 0; bj < 2; ++bj) {
                    const int col = u.pn * 256 + bj * 128 + wc * 32 + 8 * fq;
                    f32x4 h0, h1;
                    if (MODE == 0) { h0 = x0[m][bj]; h1 = x1[m][bj]; }
                    else { const u32x4 w = hw[m][bj]; h0 = (f32x4){bflo(w.x), bfhi(w.x), bflo(w.y), bfhi(w.y)}; h1 = (f32x4){bflo(w.z), bfhi(w.z), bflo(w.w), bfhi(w.w)}; }
                    h0 = h0 + acc[ai][bj][m][0]; h1 = h1 + acc[ai][bj][m][1];
                    *(u32x4*)(hb + (size_t)row * 1024 + col) = pack8(h0, h1);
                    ss += (h0[0] * h0[0] + h0[1] * h0[1]) + (h0[2] * h0[2] + h0[3] * h0[3]) + (h1[0] * h1[0] + h1[1] * h1[1]) + (h1[2] * h1[2] + h1[3] * h1[3]);
                }
                ss += __shfl_xor(ss, 16); ss += __shfl_xor(ss, 32);
                if (fq == 0) ssq[(size_t)row * 16 + u.pn * 4 + wc] = ss;
            }
            __builtin_amdgcn_sched_barrier(0);
        }
    }
};

struct EpiFfi {
    const float* ssq; bf16_t* act;
    __device__ __forceinline__ void operator()(AccRef acc, const Unit& u, int wr, int wc, int fr, int fq) const {
        f32x4 sp[2][4];
#pragma unroll
        for (int ai = 0; ai < 2; ++ai)
#pragma unroll
            for (int m = 0; m < 4; ++m) {
                const int row = u.pm * 256 + ai * 128 + wr * 64 + m * 16 + fr;
                sp[ai][m] = *(const f32x4*)(ssq + (size_t)row * 16 + 4 * fq);
            }
#pragma unroll
        for (int ai = 0; ai < 2; ++ai)
#pragma unroll
            for (int m = 0; m < 4; ++m) {
                const int row = u.pm * 256 + ai * 128 + wr * 64 + m * 16 + fr;
                float tot = (sp[ai][m][0] + sp[ai][m][1]) + (sp[ai][m][2] + sp[ai][m][3]);
                tot += __shfl_xor(tot, 16); tot += __shfl_xor(tot, 32);
                const float rstd = rsqrtf(tot * (1.0f / 1024.0f) + EPS);
                const f32x4 g0 = acc[ai][0][m][0], g1 = acc[ai][0][m][1], u0 = acc[ai][1][m][0], u1 = acc[ai][1][m][1];
                f32x4 r0, r1;
#pragma unroll
                for (int j = 0; j < 4; ++j) { r0[j] = siluf_(rstd * g0[j]) * (rstd * u0[j]); r1[j] = siluf_(rstd * g1[j]) * (rstd * u1[j]); }
                *(u32x4*)(act + (size_t)row * DFF + u.pn * 128 + wc * 32 + 8 * fq) = pack8(r0, r1);
            }
    }
};

__device__ __forceinline__ void p0_s5gen(const Args& a, LAS float* L, int g, int qd) {
    const int tid = threadIdx.x;
    LAS float* Kt = L;
    LAS float* Ap = L + 16384;
    LAS float* Bb = Ap + 33 * 64 * 2;
    LAS float* Cc = Bb + 2048;
    bf16_t* bts = (bf16_t*)(a.ws + OFF_BTS) + (size_t)g * 256 * 512;
    bf16_t* bty = (bf16_t*)(a.ws + OFF_BTY) + (size_t)g * 512 * 768;
    float* attab = (float*)(a.ws + OFF_AT);
    bf16_t* u5 = (bf16_t*)(a.ws + OFF_U5);
    if (qd == 0) for (int e = tid; e < 24 * 256; e += 512) { const int b = e >> 8, kk = e & 255; u5[((size_t)g * IT_PAD + IT_REAL + b) * LDA5 + kk] = 0; }
    for (int dir = 0; dir < 2; ++dir) {
        const int pg = dir * 32 + g;
        const double dt = exp((double)a.in[7][pg]);
        for (int idx = tid; idx < 33 * 64; idx += 512) {
            const int p = idx & 63, d = idx >> 6;
            const double lr = a.in[5][pg * 64 + p], li = a.in[6][pg * 64 + p];
            const float mag = (float)exp(lr * dt * d);
            float s, c; sincos_rev(li * dt * d, s, c);
            Ap[idx * 2] = mag * c; Ap[idx * 2 + 1] = mag * s;
            if (d == 32 && qd == 0) { attab[(pg * 64 + p) * 2] = mag * c; attab[(pg * 64 + p) * 2 + 1] = mag * s; }
        }
        for (int idx = tid; idx < 1024; idx += 512) {
            const int p = idx >> 4, h = idx & 15;
            const double lr = a.in[5][pg * 64 + p], li = a.in[6][pg * 64 + p];
            const double zr = lr * dt, zi = li * dt, mag = exp(zr);
            float sh, ch, s1, c1; sincos_rev(0.5 * zi, sh, ch); sincos_rev(zi, s1, c1);
            const double nr = mag * (-2.0 * (double)sh * (double)sh) + expm1(zr);
            const double abi = mag * (double)s1, den = lr * lr + li * li;
            const double cre = (nr * lr + abi * li) / den, cim = (abi * lr - nr * li) / den;
            const double br = a.in[8][(size_t)(pg * 64 + p) * 16 + h], bi = a.in[9][(size_t)(pg * 64 + p) * 16 + h];
            Bb[idx * 2] = (float)(cre * br - cim * bi); Bb[idx * 2 + 1] = (float)(cre * bi + cim * br);
        }
        for (int idx = tid; idx < 1024; idx += 512) {
            Cc[idx * 2] = a.in[10][(size_t)pg * 1024 + idx]; Cc[idx * 2 + 1] = a.in[11][(size_t)pg * 1024 + idx];
        }
        __syncthreads();
        for (int e = tid; e < 8192; e += 512) {
            const int d = e >> 8, ho = (e >> 4) & 15, hi = e & 15;
            float sum = 0.f;
            for (int p = 0; p < 64; ++p) {
                const float cr = Cc[(ho * 64 + p) * 2], ci = Cc[(ho * 64 + p) * 2 + 1], ar = Ap[(d * 64 + p) * 2], ai = Ap[(d * 64 + p) * 2 + 1];
                const float br = Bb[(p * 16 + hi) * 2], bi = Bb[(p * 16 + hi) * 2 + 1];
                const float car = cr * ar - ci * ai, cai = cr * ai + ci * ar;
                sum += car * br - cai * bi;
            }
            Kt[dir * 8192 + e] = sum;
        }
        for (int e = qd * 16384 + tid; e < (qd + 1) * 16384; e += 512) {
            const int k = e & 511, nn = e >> 9, c = nn >> 6, p = nn & 63, t = k >> 4, hi = k & 15;
            const int dd = dir == 0 ? (T5 - 1 - t) : t;
            const float ar = Ap[(dd * 64 + p) * 2], ai = Ap[(dd * 64 + p) * 2 + 1], br = Bb[(p * 16 + hi) * 2], bi = Bb[(p * 16 + hi) * 2 + 1];
            const float val = c ? (ar * bi + ai * br) : (ar * br - ai * bi);
            bts[(size_t)(dir * 128 + nn) * 512 + k] = f2bf(val);
        }
        for (int e = qd * 16384 + tid; e < (qd + 1) * 16384; e += 512) {
            const int kk = e & 127, n = e >> 7, c = kk >> 6, p = kk & 63, to = n >> 4, ho = n & 15;
            const int dd = dir == 0 ? (to + 1) : (T5 - to);
            const float cr = Cc[(ho * 64 + p) * 2], ci = Cc[(ho * 64 + p) * 2 + 1], ar = Ap[(dd * 64 + p) * 2], ai = Ap[(dd * 64 + p) * 2 + 1];
            const float val = c ? -(cr * ai + ci * ar) : (cr * ar - ci * ai);
            bty[(size_t)n * 768 + 512 + dir * 128 + kk] = f2bf(val);
        }
        __syncthreads();
    }
    for (int e = qd * 65536 + tid; e < (qd + 1) * 65536; e += 512) {
        const int k = e & 511, n = e >> 9, to = n >> 4, ho = n & 15, ti = k >> 4, hi = k & 15;
        float val = 0.f;
        if (to >= ti) val += Kt[((to - ti) * 16 + ho) * 16 + hi];
        if (ti >= to) val += Kt[8192 + ((ti - to) * 16 + ho) * 16 + hi];
        if (to == ti && ho == hi) val += a.in[12][g * 16 + ho];
        bty[(size_t)n * 768 + k] = f2bf(val);
    }
    __syncthreads();
}

__device__ __forceinline__ int src_col(int kind, int n) {
    if (kind == 1) { if (n >= 512 && n < 1536) { const int r = n - 512, seg = r >> 7, dp = r & 127; return 512 + seg * 128 + (dp >> 1) + 64 * (dp & 1); } return n; }
    if (kind == 2) { const int pn = n >> 8, bj = (n >> 7) & 1, cc = n & 127; return bj * 1024 + pn * 128 + cc; }
    if (kind == 3) { const int pn = n >> 8, bj = (n >> 7) & 1, cc = n & 127; return bj * DFF + pn * 128 + cc; }
    return n;
}
__device__ __forceinline__ void p0_wtile(const float* W, int K, int N, bf16_t* WT, int kind, const float* kscale, int tile2, LAS float* L) {
    const int tid = threadIdx.x, nkt = K >> 6;
    int n0[2], k0[2];
#pragma unroll
    for (int q = 0; q < 2; ++q) { const int tile = 2 * tile2 + q; n0[q] = (tile / nkt) * 64; k0[q] = (tile % nkt) * 64; }
    float v[2][8];
#pragma unroll
    for (int q = 0; q < 2; ++q)
#pragma unroll
        for (int it = 0; it < 8; ++it) {
            const int idx = tid + it * 512, kk = idx >> 6, j = idx & 63;
            v[q][it] = W[(size_t)(k0[q] + kk) * N + src_col(kind, n0[q] + j)];
        }
#pragma unroll
    for (int q = 0; q < 2; ++q)
#pragma unroll
        for (int it = 0; it < 8; ++it) {
            const int idx = tid + it * 512, kk = idx >> 6, j = idx & 63;
            float x = v[q][it];
            if (kscale) x *= kscale[k0[q] + kk];
            L[q * 4160 + kk * 65 + j] = x;
        }
    __syncthreads();
#pragma unroll
    for (int q = 0; q < 2; ++q)
#pragma unroll
        for (int it = 0; it < 4; ++it) {
            const int idx = tid + it * 512, j = idx >> 5, kp = idx & 31;
            *(unsigned*)(WT + (size_t)(n0[q] + j) * K + k0[q] + 2 * kp) = cvt_pk_bf16(L[q * 4160 + (2 * kp) * 65 + j], L[q * 4160 + (2 * kp + 1) * 65 + j]);
        }
    __syncthreads();
}

__device__ __forceinline__ void phase0(const Args& a, LAS unsigned char* lds) {
    LAS float* L = (LAS float*)lds;
    const int tid = threadIdx.x, wave = tid >> 6, lane = tid & 63;
    constexpr int T_IN = 88 * 16 / 2, T_GLU = 32 * 8 / 2, T_RET = 128, T_OUT = 128, T_FFI = 88 * 16 / 2, T_FFO = 16 * 44 / 2;
    constexpr int NW = 128 + T_IN + T_GLU + T_RET + T_OUT + T_FFI + T_FFO, NRM = RPAD / 32;
    unsigned* qctr = (unsigned*)(a.ws + OFF_BAR) + 32;
    LAS int* qslot = (LAS int*)(lds + 131072 + 512);
    for (;;) {
        __syncthreads();
        if (tid == 0) *qslot = (int)__hip_atomic_fetch_add(qctr, 1u, __ATOMIC_RELAXED, __HIP_MEMORY_SCOPE_AGENT);
        __syncthreads();
        const int w = *qslot;
        if (w >= NW + NRM) break;
        int r = w;
        if (r < 128) { p0_s5gen(a, L, r >> 2, r & 3); continue; } r -= 128;
        if (r < T_IN) { p0_wtile(a.in[4], 1024, INW, (bf16_t*)(a.ws + OFF_WIN), 1, nullptr, r, L); continue; } r -= T_IN;
        if (r < T_GLU) { p0_wtile(a.in[13], 512, 2048, (bf16_t*)(a.ws + OFF_WGLU), 2, nullptr, r, L); continue; } r -= T_GLU;
        if (r < T_RET) { p0_wtile(a.in[15], 1024, 1024, (bf16_t*)(a.ws + OFF_WRET), 0, nullptr, r, L); continue; } r -= T_RET;
        if (r < T_OUT) { p0_wtile(a.in[16], 1024, 1024, (bf16_t*)(a.ws + OFF_WOUT), 0, nullptr, r, L); continue; } r -= T_OUT;
        if (r < T_FFI) { p0_wtile(a.in[18], 1024, INW, (bf16_t*)(a.ws + OFF_WFFI), 3, a.in[17], r, L); continue; } r -= T_FFI;
        if (r < T_FFO) { p0_wtile(a.in[19], DFF, 1024, (bf16_t*)(a.ws + OFF_WFFO), 0, nullptr, r, L); continue; } r -= T_FFO;
        const int rowb = r * 32 + wave * 4;
        const float* xr[4]; f32x4 v[4][4];
#pragma unroll
        for (int q = 0; q < 4; ++q) {
            const int row = rowb + q;
            xr[q] = row < NPR ? a.in[0] + (size_t)row * 1024 : (row < NREAL ? a.in[1] + (size_t)(row - NPR) * 1024 : a.in[2] + (size_t)((row - NREAL) & 15) * 1024);
#pragma unroll
            for (int j = 0; j < 4; ++j) v[q][j] = (row < NVALID) ? *(const f32x4*)(xr[q] + (j * 64 + lane) * 4) : (f32x4){0.f, 0.f, 0.f, 0.f};
        }
        f32x4 gg[4];
#pragma unroll
        for (int j = 0; j < 4; ++j) gg[j] = *(const f32x4*)(a.in[3] + (j * 64 + lane) * 4);
#pragma unroll
        for (int q = 0; q < 4; ++q) {
            float sq = 0.f;
#pragma unroll
            for (int j = 0; j < 4; ++j) sq += (v[q][j][0] * v[q][j][0] + v[q][j][1] * v[q][j][1]) + (v[q][j][2] * v[q][j][2] + v[q][j][3] * v[q][j][3]);
            const float rstd = rsqrtf(wave_sum(sq) * (1.0f / 1024.0f) + EPS);
            bf16_t* orow = (bf16_t*)(a.ws + OFF_N1) + (size_t)(rowb + q) * 1024;
#pragma unroll
            for (int j = 0; j < 4; ++j) {
                u32x2 o; o.x = cvt_pk_bf16(v[q][j][0] * rstd * gg[j][0], v[q][j][1] * rstd * gg[j][1]); o.y = cvt_pk_bf16(v[q][j][2] * rstd * gg[j][2], v[q][j][3] * rstd * gg[j][3]);
                *(u32x2*)(orow + (j * 64 + lane) * 4) = o;
            }
        }
    }
}

__device__ __forceinline__ void s5_scan(const Args& a) {
    const float* attab = (const float*)(a.ws + OFF_AT);
    const float* sloc = (const float*)(a.ws + OFF_SLOC);
    bf16_t* u5 = (bf16_t*)(a.ws + OFF_U5);
    for (int id = blockIdx.x * 512 + threadIdx.x; id < 24 * 32 * 2 * 64; id += gridDim.x * 512) {
        const int p = id & 63, dir = (id >> 6) & 1, g = (id >> 7) & 31, b = id >> 12;
        const float atr = attab[((dir * 32 + g) * 64 + p) * 2], ati = attab[((dir * 32 + g) * 64 + p) * 2 + 1];
        const int nck = b < 16 ? 128 : 64, base = b < 16 ? b * 128 : 2048 + (b - 16) * 64, mitem = IT_REAL + b;
        const float* sl = sloc + (size_t)g * IT_PAD * 256 + dir * 128 + p;
        bf16_t* ub = u5 + (size_t)g * IT_PAD * LDA5 + 512 + dir * 128 + p;
        float sr = 0.f, si = 0.f;
        if (dir == 0) {
            ub[(size_t)mitem * LDA5] = 0; ub[(size_t)mitem * LDA5 + 64] = 0;
            sr = sl[(size_t)mitem * 256]; si = sl[(size_t)mitem * 256 + 64];
            for (int c0 = 0; c0 < nck; c0 += 16) {
                float lr[16], li[16];
#pragma unroll
                for (int j = 0; j < 16; ++j) { lr[j] = sl[(size_t)(base + c0 + j) * 256]; li[j] = sl[(size_t)(base + c0 + j) * 256 + 64]; }
#pragma unroll
                for (int j = 0; j < 16; ++j) {
                    const size_t it = (size_t)(base + c0 + j);
                    ub[it * LDA5] = f2bf(sr); ub[it * LDA5 + 64] = f2bf(si);
                    const float nr = atr * sr - ati * si + lr[j], ni = atr * si + ati * sr + li[j];
                    sr = nr; si = ni;
                }
            }
        } else {
            for (int c0 = nck - 16; c0 >= 0; c0 -= 16) {
                float lr[16], li[16];
#pragma unroll
                for (int j = 0; j < 16; ++j) { lr[j] = sl[(size_t)(base + c0 + j) * 256]; li[j] = sl[(size_t)(base + c0 + j) * 256 + 64]; }
#pragma unroll
                for (int j = 15; j >= 0; --j) {
                    const size_t it = (size_t)(base + c0 + j);
                    ub[it * LDA5] = f2bf(sr); ub[it * LDA5 + 64] = f2bf(si);
                    const float nr = atr * sr - ati * si + lr[j], ni = atr * si + ati * sr + li[j];
                    sr = nr; si = ni;
                }
            }
            ub[(size_t)mitem * LDA5] = f2bf(sr); ub[(size_t)mitem * LDA5 + 64] = f2bf(si);
        }
    }
}

constexpr int LDR = 136;
__device__ __forceinline__ float bf2f(bf16_t h) { return __uint_as_float(((unsigned)h) << 16); }

__device__ __forceinline__ void tr_store_pair(LAS bf16_t* img, int f0, int s2, u32x4 r0, u32x4 r1) {
    LAS unsigned* p = (LAS unsigned*)(img + f0 * LDR + s2);
    p[0 * (LDR / 2)] = (r0.x & 0xFFFFu) | (r1.x << 16); p[1 * (LDR / 2)] = (r0.x >> 16) | (r1.x & 0xFFFF0000u);
    p[2 * (LDR / 2)] = (r0.y & 0xFFFFu) | (r1.y << 16); p[3 * (LDR / 2)] = (r0.y >> 16) | (r1.y & 0xFFFF0000u);
    p[4 * (LDR / 2)] = (r0.z & 0xFFFFu) | (r1.z << 16); p[5 * (LDR / 2)] = (r0.z >> 16) | (r1.z & 0xFFFF0000u);
    p[6 * (LDR / 2)] = (r0.w & 0xFFFFu) | (r1.w << 16); p[7 * (LDR / 2)] = (r0.w >> 16) | (r1.w & 0xFFFF0000u);
}
__device__ __forceinline__ void tr_store_pair_scaled(LAS bf16_t* img, int f0, int s2, u32x4 r0, u32x4 r1, float w0, float w1) {
    LAS unsigned* p = (LAS unsigned*)(img + f0 * LDR + s2);
    p[0 * (LDR / 2)] = cvt_pk_bf16(bflo(r0.x) * w0, bflo(r1.x) * w1); p[1 * (LDR / 2)] = cvt_pk_bf16(bfhi(r0.x) * w0, bfhi(r1.x) * w1);
    p[2 * (LDR / 2)] = cvt_pk_bf16(bflo(r0.y) * w0, bflo(r1.y) * w1); p[3 * (LDR / 2)] = cvt_pk_bf16(bfhi(r0.y) * w0, bfhi(r1.y) * w1);
    p[4 * (LDR / 2)] = cvt_pk_bf16(bflo(r0.z) * w0, bflo(r1.z) * w1); p[5 * (LDR / 2)] = cvt_pk_bf16(bfhi(r0.z) * w0, bfhi(r1.z) * w1);
    p[6 * (LDR / 2)] = cvt_pk_bf16(bflo(r0.w) * w0, bflo(r1.w) * w1); p[7 * (LDR / 2)] = cvt_pk_bf16(bfhi(r0.w) * w0, bfhi(r1.w) * w1);
}

#define LDS_BARRIER() do { asm volatile("s_waitcnt lgkmcnt(0)" ::: "memory"); __builtin_amdgcn_s_barrier(); asm volatile("" ::: "memory"); } while (0)
__device__ __forceinline__ void ret_pass_a(const Args& a, LAS unsigned char* lds) {
    LAS bf16_t* KT = (LAS bf16_t*)lds;
    LAS bf16_t* VT = KT + 128 * LDR;
    const int tid0 = threadIdx.x;
    const bf16_t* kb = (const bf16_t*)(a.ws + OFF_K); const bf16_t* vb = (const bf16_t*)(a.ws + OFF_V);
    bf16_t* stb = (bf16_t*)(a.ws + OFF_ST);
    for (int item = blockIdx.x; item < 192; item += gridDim.x) {
        int tid = tid0; asm volatile("" : "+v"(tid));
        const int w = tid >> 6, lane = tid & 63, fr = lane & 15, fq = lane >> 4;
        int b, h, dir;
        if (item < 128) { b = item >> 3; h = (item >> 1) & 3; dir = item & 1; } else { const int j = item - 128; b = 16 + (j >> 3); h = (j >> 1) & 3; dir = j & 1; }
        const int NC = b < 16 ? 32 : 16, rbase = b < 16 ? b * 4096 : NPR + (b - 16) * 2048, ebase = b < 16 ? b * 33 : 528 + (b - 16) * 17;
        const float lg = logsigf_(a.in[14][dir * 4 + h]);
        const float carry = __expf(lg * 128.f);
        const int s2 = 2 * (8 * w + (lane & 7)), pg = lane >> 3;
        const float wk0 = dir == 0 ? __expf(lg * (float)(127 - s2)) : __expf(lg * (float)s2);
        const float wk1 = dir == 0 ? __expf(lg * (float)(126 - s2)) : __expf(lg * (float)(s2 + 1));
        f32x4 acc[2][8];
#pragma unroll
        for (int et = 0; et < 2; ++et)
#pragma unroll
            for (int dtl = 0; dtl < 8; ++dtl) acc[et][dtl] = (f32x4){0.f, 0.f, 0.f, 0.f};
        const int nsteps = dir == 0 ? NC : NC;
        u32x4 rk[2][2], rv[4][2];
        auto load_chunk = [&](int n) {
            int row0; bool valid = true;
            if (n == 0) { valid = s2 >= 112; row0 = NREAL + b * 16 + (s2 - 112); } else row0 = rbase + (n - 1) * 128 + s2;
#pragma unroll
            for (int it = 0; it < 2; ++it)
#pragma unroll
                for (int r = 0; r < 2; ++r) {
                    rk[it][r] = (u32x4){0u, 0u, 0u, 0u};
                    if (valid) rk[it][r] = *(const u32x4*)(kb + (size_t)(row0 + r) * 512 + h * 128 + (pg + 8 * it) * 8);
                }
#pragma unroll
            for (int it = 0; it < 4; ++it)
#pragma unroll
                for (int r = 0; r < 2; ++r) {
                    rv[it][r] = (u32x4){0u, 0u, 0u, 0u};
                    if (valid) rv[it][r] = *(const u32x4*)(vb + (size_t)(row0 + r) * 1024 + h * 256 + (pg + 8 * it) * 8);
                }
        };
        load_chunk(dir == 0 ? 0 : NC);
        for (int step = 0; step < nsteps; ++step) {
            const int n = dir == 0 ? step : NC - step;
            {
                bf16_t* spn = stb + ((size_t)((ebase + n) * 4 + h) * 2 + dir) * 32768;
#pragma unroll
                for (int et = 0; et < 2; ++et)
#pragma unroll
                    for (int dtl = 0; dtl < 8; ++dtl) {
                        u32x2 o; o.x = cvt_pk_bf16(acc[et][dtl][0], acc[et][dtl][1]); o.y = cvt_pk_bf16(acc[et][dtl][2], acc[et][dtl][3]);
                        *(u32x2*)(spn + (size_t)(32 * w + 16 * et + fr) * 128 + 16 * dtl + 4 * fq) = o;
                    }
            }
            LDS_BARRIER();
#pragma unroll
            for (int it = 0; it < 2; ++it) tr_store_pair_scaled(KT, (pg + 8 * it) * 8, s2, rk[it][0], rk[it][1], wk0, wk1);
#pragma unroll
            for (int it = 0; it < 4; ++it) tr_store_pair(VT, (pg + 8 * it) * 8, s2, rv[it][0], rv[it][1]);
            if (step + 1 < nsteps) load_chunk(dir == 0 ? step + 1 : NC - step - 1);
            LDS_BARRIER();
#pragma unroll
            for (int et = 0; et < 2; ++et)
#pragma unroll
                for (int dtl = 0; dtl < 8; ++dtl) acc[et][dtl] = acc[et][dtl] * carry;
#pragma unroll
            for (int ks = 0; ks < 4; ++ks) {
                bf16x8 vf[2];
#pragma unroll
                for (int et = 0; et < 2; ++et) vf[et] = *(const LAS bf16x8*)(VT + (32 * w + 16 * et + fr) * LDR + 32 * ks + 8 * fq);
#pragma unroll
                for (int dtl = 0; dtl < 8; ++dtl) {
                    const bf16x8 kf = *(const LAS bf16x8*)(KT + (16 * dtl + fr) * LDR + 32 * ks + 8 * fq);
#pragma unroll
                    for (int et = 0; et < 2; ++et) acc[et][dtl] = __builtin_amdgcn_mfma_f32_16x16x32_bf16(kf, vf[et], acc[et][dtl], 0, 0, 0);
                }
            }
        }
        if (dir == 0) {
            bf16_t* spn = stb + ((size_t)((ebase + NC) * 4 + h) * 2 + dir) * 32768;
#pragma unroll
            for (int et = 0; et < 2; ++et)
#pragma unroll
                for (int dtl = 0; dtl < 8; ++dtl) {
                    u32x2 o; o.x = cvt_pk_bf16(acc[et][dtl][0], acc[et][dtl][1]); o.y = cvt_pk_bf16(acc[et][dtl][2], acc[et][dtl][3]);
                    *(u32x2*)(spn + (size_t)(32 * w + 16 * et + fr) * 128 + 16 * dtl + 4 * fq) = o;
                }
        }
        LDS_BARRIER();
    }
}

__device__ __forceinline__ void ret_pass_b(const Args& a, LAS unsigned char* lds) {
    LAS bf16_t* KL = (LAS bf16_t*)lds;
    LAS bf16_t* BG = KL + 128 * LDR;
    const int tid0 = threadIdx.x;
    const bf16_t* qb = (const bf16_t*)(a.ws + OFF_Q); const bf16_t* kb = (const bf16_t*)(a.ws + OFF_K); const bf16_t* vb = (const bf16_t*)(a.ws + OFF_V);
    const bf16_t* stb = (const bf16_t*)(a.ws + OFF_ST);
    bf16_t* sg = (bf16_t*)a.out;
    u32x4 rk[4], rb[8]; bf16x8 qf[4];
    auto item_info = [&](int item, int& r0, int& h, const bf16_t*& sfp) {
        const int rc = item >> 2; h = item & 3;
        int b, n; if (rc < 512) { b = rc >> 5; n = (rc & 31) + 1; } else { b = 16 + ((rc - 512) >> 4); n = ((rc - 512) & 15) + 1; }
        const int ebase = b < 16 ? b * 33 : 528 + (b - 16) * 17; r0 = rc * 128;
        sfp = stb + ((size_t)((ebase + n) * 4 + h) * 2 + 0) * 32768;
    };
    auto load_item_head = [&](int item, int tid) {
        int r0, h; const bf16_t* sfp; item_info(item, r0, h, sfp);
#pragma unroll
        for (int it = 0; it < 8; ++it) { const int idx = tid + it * 512, e = idx >> 4, pc = idx & 15; rb[it] = *(const u32x4*)(sfp + (size_t)e * 128 + pc * 8); }
    };
    auto load_item_kq = [&](int item, int tid) {
        int r0, h; const bf16_t* sfp; item_info(item, r0, h, sfp);
        const int w = tid >> 6, lane = tid & 63, fr = lane & 15, fq = lane >> 4;
#pragma unroll
        for (int it = 0; it < 4; ++it) { const int idx = tid + it * 512, s = idx >> 4, pc = idx & 15; rk[it] = *(const u32x4*)(kb + (size_t)(r0 + s) * 512 + h * 128 + pc * 8); }
#pragma unroll
        for (int ks = 0; ks < 4; ++ks) qf[ks] = *(const bf16x8*)(qb + (size_t)(r0 + 16 * w + fr) * 512 + h * 128 + 32 * ks + 8 * fq);
    };
    if ((int)blockIdx.x < 2560) { load_item_head(blockIdx.x, tid0); load_item_kq(blockIdx.x, tid0); }
    for (int item = blockIdx.x; item < 2560; item += gridDim.x) {
        int tid = tid0; asm volatile("" : "+v"(tid));
        const int w = tid >> 6, lane = tid & 63, fr = lane & 15, fq = lane >> 4;
        int r0, h; const bf16_t* sfp; item_info(item, r0, h, sfp);
        const bf16_t* sbp = sfp + 32768;
        const float lgf = logsigf_(a.in[14][h]), lgb = logsigf_(a.in[14][4 + h]);
        const int crow = 16 * w + fr;
        LDS_BARRIER();
#pragma unroll
        for (int it = 0; it < 4; ++it) { const int idx = tid + it * 512, s = idx >> 4, pc = idx & 15; *(LAS u32x4*)(KL + s * LDR + pc * 8) = rk[it]; }
#pragma unroll
        for (int it = 0; it < 8; ++it) { const int idx = tid + it * 512, e = idx >> 4, pc = idx & 15; *(LAS u32x4*)(BG + e * LDR + pc * 8) = rb[it]; }
#pragma unroll
        for (int it = 0; it < 8; ++it) { const int idx = tid + it * 512, e = idx >> 4, pc = idx & 15; rb[it] = *(const u32x4*)(sbp + (size_t)e * 128 + pc * 8); }
        LDS_BARRIER();
        f32x4 sacc[8];
#pragma unroll
        for (int st = 0; st < 8; ++st) sacc[st] = (f32x4){0.f, 0.f, 0.f, 0.f};
#pragma unroll
        for (int ks = 0; ks < 4; ++ks)
#pragma unroll
            for (int st = 0; st < 8; ++st) {
                const bf16x8 kf = *(const LAS bf16x8*)(KL + (16 * st + fr) * LDR + 32 * ks + 8 * fq);
                sacc[st] = __builtin_amdgcn_mfma_f32_16x16x32_bf16(kf, qf[ks], sacc[st], 0, 0, 0);
                if (st == 7) __builtin_amdgcn_sched_barrier(0);
            }
        bf16x8 pf[4];
#pragma unroll
        for (int t = 0; t < 4; ++t) {
            float pv[8];
#pragma unroll
            for (int hh = 0; hh < 2; ++hh)
#pragma unroll
                for (int j = 0; j < 4; ++j) {
                    const int spp = 16 * (2 * t + hh) + 4 * fq + j, diff = crow - spp;
                    const float dec = diff >= 0 ? __expf(lgf * (float)diff) : __expf(-lgb * (float)diff);
                    pv[hh * 4 + j] = sacc[2 * t + hh][j] * dec;
                }
            u32x4 pw; pw.x = cvt_pk_bf16(pv[0], pv[1]); pw.y = cvt_pk_bf16(pv[2], pv[3]); pw.z = cvt_pk_bf16(pv[4], pv[5]); pw.w = cvt_pk_bf16(pv[6], pv[7]);
            pf[t] = __builtin_bit_cast(bf16x8, pw);
        }
        f32x4 o[16];
#pragma unroll
        for (int et = 0; et < 16; ++et) o[et] = (f32x4){0.f, 0.f, 0.f, 0.f};
#pragma unroll
        for (int ks = 0; ks < 4; ++ks)
#pragma unroll
            for (int et = 0; et < 16; ++et) {
                const bf16x8 sf = *(const LAS bf16x8*)(BG + (16 * et + fr) * LDR + 32 * ks + 8 * fq);
                o[et] = __builtin_amdgcn_mfma_f32_16x16x32_bf16(sf, qf[ks], o[et], 0, 0, 0);
                if ((et & 7) == 7) __builtin_amdgcn_sched_barrier(0);
            }
        const float wqf = __expf(lgf * (float)(crow + 1)), wqb = __expf(lgb * (float)(128 - crow));
        const float ratio = wqf / wqb;
#pragma unroll
        for (int et = 0; et < 16; ++et) o[et] = o[et] * ratio;
        LDS_BARRIER();
#pragma unroll
        for (int it = 0; it < 8; ++it) { const int idx = tid + it * 512, e = idx >> 4, pc = idx & 15; *(LAS u32x4*)(BG + e * LDR + pc * 8) = rb[it]; }
        {
            const int s2 = 2 * (8 * w + (lane & 7));
#pragma unroll
            for (int it = 0; it < 4; ++it)
#pragma unroll
                for (int r = 0; r < 2; ++r) rb[it * 2 + r] = *(const u32x4*)(vb + (size_t)(r0 + s2 + r) * 1024 + h * 256 + ((lane >> 3) + 8 * it) * 8);
        }
        LDS_BARRIER();
#pragma unroll
        for (int ks = 0; ks < 4; ++ks)
#pragma unroll
            for (int et = 0; et < 16; ++et) {
                const bf16x8 sf = *(const LAS bf16x8*)(BG + (16 * et + fr) * LDR + 32 * ks + 8 * fq);
                o[et] = __builtin_amdgcn_mfma_f32_16x16x32_bf16(sf, qf[ks], o[et], 0, 0, 0);
                if ((et & 7) == 7) __builtin_amdgcn_sched_barrier(0);
            }
#pragma unroll
        for (int et = 0; et < 16; ++et) o[et] = o[et] * wqb;
        LDS_BARRIER();
#pragma unroll
        for (int it = 0; it < 4; ++it) tr_store_pair(BG, ((lane >> 3) + 8 * it) * 8, 2 * (8 * w + (lane & 7)), rb[it * 2], rb[it * 2 + 1]);
        if (item + (int)gridDim.x < 2560) load_item_head(item + gridDim.x, tid);
        LDS_BARRIER();
#pragma unroll
        for (int t = 0; t < 4; ++t)
#pragma unroll
            for (int et = 0; et < 16; ++et) {
                const u32x2 lo = *(const LAS u32x2*)(BG + (16 * et + fr) * LDR + 32 * t + 4 * fq);
                const u32x2 hi = *(const LAS u32x2*)(BG + (16 * et + fr) * LDR + 32 * t + 16 + 4 * fq);
                const u32x4 vw = (u32x4){lo.x, lo.y, hi.x, hi.y};
                o[et] = __builtin_amdgcn_mfma_f32_16x16x32_bf16(__builtin_bit_cast(bf16x8, vw), pf[t], o[et], 0, 0, 0);
                if ((et & 7) == 7) __builtin_amdgcn_sched_barrier(0);
            }
        float ss = 0.f;
#pragma unroll
        for (int et = 0; et < 16; ++et) ss += (o[et][0] * o[et][0] + o[et][1] * o[et][1]) + (o[et][2] * o[et][2] + o[et][3] * o[et][3]);
        ss += __shfl_xor(ss, 16); ss += __shfl_xor(ss, 32);
        const float rn = rsqrtf(ss * (1.0f / 256.0f) + EPS);
        bf16_t* gp = sg + (size_t)(r0 + crow) * 1024 + h * 256 + 4 * fq;
        u32x2 gwv[16];
#pragma unroll
        for (int et = 0; et < 16; ++et) gwv[et] = *(const u32x2*)(gp + 16 * et);
        if (item + (int)gridDim.x < 2560) load_item_kq(item + gridDim.x, tid);
#pragma unroll
        for (int et = 0; et < 16; ++et) {
            const u32x2 gw = gwv[et];
            u32x2 ow; ow.x = cvt_pk_bf16(o[et][0] * rn * bflo(gw.x), o[et][1] * rn * bfhi(gw.x)); ow.y = cvt_pk_bf16(o[et][2] * rn * bflo(gw.y), o[et][3] * rn * bfhi(gw.y));
            *(u32x2*)(gp + 16 * et) = ow;
        }
    }
    LDS_BARRIER();
}

__device__ __forceinline__ void final_norm(const Args& a) {
    const int wave = threadIdx.x >> 6, lane = threadIdx.x & 63;
    const float* ssq = (const float*)(a.ws + OFF_SSQ2);
    f32x4 gg[4];
#pragma unroll
    for (int j = 0; j < 4; ++j) gg[j] = *(const f32x4*)(a.in[20] + (j * 64 + lane) * 4);
    for (int rowb = (blockIdx.x * 8 + wave) * 4; rowb < NREAL; rowb += gridDim.x * 32) {
        float part[4]; u32x2 w[4][4];
#pragma unroll
        for (int q = 0; q < 4; ++q) {
            part[q] = lane < 16 ? ssq[(size_t)(rowb + q) * 16 + lane] : 0.f;
            const bf16_t* hrow = (const bf16_t*)(a.ws + OFF_H1B) + (size_t)(rowb + q) * 1024;
#pragma unroll
            for (int j = 0; j < 4; ++j) w[q][j] = *(const u32x2*)(hrow + (j * 64 + lane) * 4);
        }
#pragma unroll
        for (int q = 0; q < 4; ++q) {
            const float rstd = rsqrtf(wave_sum(part[q]) * (1.0f / 1024.0f) + EPS);
            float* orow = a.out + (size_t)(rowb + q) * 1024;
#pragma unroll
            for (int j = 0; j < 4; ++j) {
                f32x4 v;
                v[0] = bflo(w[q][j].x) * rstd * gg[j][0]; v[1] = bfhi(w[q][j].x) * rstd * gg[j][1]; v[2] = bflo(w[q][j].y) * rstd * gg[j][2]; v[3] = bfhi(w[q][j].y) * rstd * gg[j][3];
                *(f32x4*)(orow + (j * 64 + lane) * 4) = v;
            }
        }
    }
}

template <int ph>
__device__ __forceinline__ void run_phase(const Args& a, LAS unsigned char* lds) {
    unsigned char* ws = a.ws;
    bf16_t* dob = (bf16_t*)a.out;
    bf16_t* sgp = dob; bf16_t* gap = dob + (size_t)NREAL * 1024;
#ifdef ONLY_PH
    if (ph != ONLY_PH) return;
#endif
    switch (ph) {
    case 0: phase0(a, lds); break;
    case 1: {
        pg8::Gemm g{(const bf16_t*)(ws + OFF_N1), (const bf16_t*)(ws + OFF_WIN), 1024, 1024, 1024, RPAD / 256, INW / 256, 1, 0, 0, STG};
        EpiProj E{(bf16_t*)(ws + OFF_U5), (bf16_t*)(ws + OFF_Q), (bf16_t*)(ws + OFF_K), (bf16_t*)(ws + OFF_V), sgp, gap, (bf16_t*)(ws + OFF_GB), (const LAS double*)(lds + 131072)};
        pg8::gemm_phase(lds, g, E);
    } break;
    case 2: {
        pg8::Gemm g{(const bf16_t*)(ws + OFF_U5), (const bf16_t*)(ws + OFF_BTS), LDA5, 512, 512, IT_PAD / 256, 1, 32, (size_t)IT_PAD * LDA5, (size_t)256 * 512, 0};
        EpiSloc E{(float*)(ws + OFF_SLOC)};
        pg8::gemm_phase(lds, g, E);
    } break;
    case 3: s5_scan(a); break;
    case 4: {
        pg8::Gemm g{(const bf16_t*)(ws + OFF_U5), (const bf16_t*)(ws + OFF_BTY), LDA5, 768, 768, IT_PAD / 256, 2, 32, (size_t)IT_PAD * LDA5, (size_t)512 * 768, 0};
        EpiY E{(bf16_t*)(ws + OFF_YSSM)};
        pg8::gemm_phase(lds, g, E);
    } break;
    case 5: {
        pg8::Gemm g{(const bf16_t*)(ws + OFF_YSSM), (const bf16_t*)(ws + OFF_WGLU), 512, 512, 512, NREAL / 256, 8, 1, 0, 0, STG};
        EpiGlu E{gap};
        pg8::gemm_phase(lds, g, E);
    } break;
    case 6: ret_pass_a(a, lds); break;
    case 7: ret_pass_b(a, lds); break;
    case 8: {
        pg8::Gemm g{sgp, (const bf16_t*)(ws + OFF_WRET), 1024, 1024, 1024, NREAL / 256, 4, 1, 0, 0, STG};
        EpiRet E{gap, (const bf16_t*)(ws + OFF_GB), (bf16_t*)(ws + OFF_MIXED)};
        pg8::gemm_phase(lds, g, E);
    } break;
    case 9: {
        pg8::Gemm g{(const bf16_t*)(ws + OFF_MIXED), (const bf16_t*)(ws + OFF_WOUT), 1024, 1024, 1024, NREAL / 256, 4, 1, 0, 0, STG};
        EpiRes<0> E{a.in[0], a.in[1], (bf16_t*)(ws + OFF_H1B), (float*)(ws + OFF_SSQ1)};
        pg8::gemm_phase(lds, g, E);
    } break;
    case 10: {
        pg8::Gemm g{(const bf16_t*)(ws + OFF_H1B), (const bf16_t*)(ws + OFF_WFFI), 1024, 1024, 1024, NREAL / 256, INW / 256, 1, 0, 0, STG};
        EpiFfi E{(const float*)(ws + OFF_SSQ1), (bf16_t*)(ws + OFF_ACT)};
        pg8::gemm_phase(lds, g, E);
    } break;
    case 11: {
        pg8::Gemm g{(const bf16_t*)(ws + OFF_ACT), (const bf16_t*)(ws + OFF_WFFO), DFF, DFF, DFF, NREAL / 256, 4, 1, 0, 0, STG};
        EpiRes<1> E{nullptr, nullptr, (bf16_t*)(ws + OFF_H1B), (float*)(ws + OFF_SSQ2)};
        pg8::gemm_phase(lds, g, E);
    } break;
    case 12: final_norm(a); break;
    default: break;
    }
}

__device__ __forceinline__ void grid_barrier(unsigned* ctr, unsigned target) {
    asm volatile("s_waitcnt vmcnt(0) lgkmcnt(0)" ::: "memory");
    __syncthreads();
    if (threadIdx.x == 0) {
        __builtin_amdgcn_fence(__ATOMIC_RELEASE, "agent");
        asm volatile("s_waitcnt vmcnt(0)" ::: "memory");
        __hip_atomic_fetch_add(ctr, 1u, __ATOMIC_RELAXED, __HIP_MEMORY_SCOPE_AGENT);
        unsigned spins = 0;
        while (__hip_atomic_load(ctr, __ATOMIC_RELAXED, __HIP_MEMORY_SCOPE_AGENT) < target && ++spins < (1u << 24)) __builtin_amdgcn_s_sleep(2);
        __builtin_amdgcn_fence(__ATOMIC_ACQUIRE, "agent");
        asm volatile("s_waitcnt vmcnt(0)" ::: "memory");
    }
    __syncthreads();
}

template <bool COOP>
__global__ __launch_bounds__(512, 2) void fwd_kernel(Args a) {
    extern __shared__ __attribute__((aligned(16))) unsigned char shm[];
    LAS unsigned char* lds = (LAS unsigned char*)shm;
    if (threadIdx.x < 64) ((LAS double*)(lds + 131072))[threadIdx.x] = exp2(-(double)threadIdx.x * (13.287712379549449 / 64.0));
    __syncthreads();
#define RUN_PH(P) if (a.ph_lo <= P && P < a.ph_hi) { run_phase<P>(a, lds); if ((DBL_MASK >> P) & 1) run_phase<P>(a, lds); if (COOP && P + 1 < a.ph_hi) { if (P == 0) { __threadfence(); cg::this_grid().sync(); } else grid_barrier((unsigned*)(a.ws + OFF_BAR), (unsigned)P * gridDim.x); } }
    RUN_PH(0) RUN_PH(1) RUN_PH(2) RUN_PH(3) RUN_PH(4) RUN_PH(5) RUN_PH(6) RUN_PH(7) RUN_PH(8) RUN_PH(9) RUN_PH(10) RUN_PH(11) RUN_PH(12)
#undef RUN_PH
}

extern "C" void kernel_launch(void* const* d_in, const int* in_sizes, int n_in, void* d_out, int out_size, void* d_ws, size_t ws_size, hipStream_t stream) {
    static int grid = 0;
    if (grid == 0) {
        if (n_in != 21 || ws_size < WS_NEED || out_size != NREAL * 1024) { fprintf(stderr, "kernel_launch: unexpected shapes (n_in %d, ws %zu need %zu, out %d)\n", n_in, ws_size, (size_t)WS_NEED, out_size); grid = -1; return; }
        int dev = 0, cus = 0;
        hipGetDevice(&dev); hipDeviceGetAttribute(&cus, hipDeviceAttributeMultiprocessorCount, dev);
        hipFuncSetAttribute((const void*)fwd_kernel<true>, hipFuncAttributeMaxDynamicSharedMemorySize, LDS_BYTES);
        hipFuncSetAttribute((const void*)fwd_kernel<false>, hipFuncAttributeMaxDynamicSharedMemorySize, LDS_BYTES);
        int per_cu = 0;
        hipOccupancyMaxActiveBlocksPerMultiprocessor(&per_cu, (const void*)fwd_kernel<true>, 512, LDS_BYTES);
        if (per_cu < 1) { fprintf(stderr, "kernel_launch: occupancy query says %d blocks per CU\n", per_cu); per_cu = 1; }
        (void)hipGetLastError();
        grid = cus * 1;
    }
    if (grid < 0) return;
    Args a{};
    for (int i = 0; i < 21; ++i) a.in[i] = (const float*)d_in[i];
    a.out = (float*)d_out; a.ws = (unsigned char*)d_ws;
#if COOP_MODE
    hipMemsetAsync((char*)d_ws + OFF_BAR, 0, 256, stream);
    a.ph_lo = 0; a.ph_hi = NPHASE;
    void* args[] = {&a};
    hipError_t e = hipLaunchCooperativeKernel((const void*)fwd_kernel<true>, dim3(grid), dim3(512), args, LDS_BYTES, stream);
    if (e != hipSuccess) fprintf(stderr, "cooperative launch failed: %s (grid %d)\n", hipGetErrorString(e), grid);
#else
    for (int ph = 0; ph < NPHASE; ++ph) {
        a.ph_lo = ph; a.ph_hi = ph + 1;
        hipLaunchKernelGGL(fwd_kernel<false>, dim3(grid), dim3(512), LDS_BYTES, stream, a);
    }
#endif
}
```

```cpp
#include <hip/hip_runtime.h>
#include <hip/hip_cooperative_groups.h>
#include <cstdio>
#include <cstdint>
namespace cg = cooperative_groups;

#ifndef COOP_MODE
#define COOP_MODE 1
#endif

#define DBL_MASK 0x0
#define LAS __attribute__((address_space(3)))
typedef unsigned short bf16_t;
typedef short bf16x8 __attribute__((ext_vector_type(8)));
typedef float f32x4 __attribute__((ext_vector_type(4)));
typedef unsigned u32x4 __attribute__((ext_vector_type(4)));
typedef unsigned u32x2 __attribute__((ext_vector_type(2)));

constexpr int D = 1024, NREAL = 81920, NPR = 65536, RPAD = 82432, NVALID = 82304;
constexpr int INW = 5632, DFF = 2816;
constexpr int T5 = 32, IT_REAL = 2560, IT_PAD = 2816, LDA5 = 768;
constexpr float EPS = 1e-6f;

constexpr size_t OFF_WIN = 0;
constexpr size_t OFF_WGLU = OFF_WIN + (size_t)INW * D * 2;
constexpr size_t OFF_WRET = OFF_WGLU + (size_t)2048 * 512 * 2;
constexpr size_t OFF_WOUT = OFF_WRET + (size_t)D * D * 2;
constexpr size_t OFF_WFFI = OFF_WOUT + (size_t)D * D * 2;
constexpr size_t OFF_WFFO = OFF_WFFI + (size_t)INW * D * 2;
constexpr size_t OFF_AT = OFF_WFFO + (size_t)D * DFF * 2;
constexpr size_t OFF_BAR = OFF_AT + 32768;
constexpr size_t OFF_Q = OFF_AT + 65536;
constexpr size_t OFF_K = OFF_Q + (size_t)RPAD * 512 * 2;
constexpr size_t OFF_V = OFF_K + (size_t)RPAD * 512 * 2;
constexpr size_t OFF_GB = OFF_V + (size_t)RPAD * D * 2;
constexpr size_t OFF_SSQ1 = OFF_GB + (size_t)NREAL * D * 2;
constexpr size_t OFF_SSQ2 = OFF_SSQ1 + (size_t)NREAL * 16 * 4;
constexpr size_t OFF_X = OFF_SSQ2 + (size_t)NREAL * 16 * 4;
constexpr size_t OFF_N1 = OFF_X;
constexpr size_t OFF_YSSM = OFF_X;
constexpr size_t OFF_U5 = OFF_N1 + (size_t)RPAD * D * 2;
constexpr size_t OFF_BTY = OFF_U5 + (size_t)32 * IT_PAD * LDA5 * 2;
constexpr size_t OFF_BTS = OFF_BTY + (size_t)32 * 512 * 768 * 2;
constexpr size_t OFF_SLOC = OFF_BTS + (size_t)32 * 256 * 512 * 2;
constexpr size_t END_X03 = OFF_SLOC + (size_t)32 * IT_PAD * 256 * 4;
constexpr size_t OFF_ST = OFF_X;
constexpr size_t END_ST = OFF_ST + (size_t)664 * 8 * 65536;
constexpr size_t OFF_ACT = OFF_X;
constexpr size_t END_ACT = OFF_ACT + (size_t)NREAL * DFF * 2;
constexpr size_t OFF_MIXED = OFF_Q;
constexpr size_t OFF_H1B = OFF_V;
constexpr size_t cmax(size_t a, size_t b) { return a > b ? a : b; }
constexpr size_t WS_NEED = cmax(END_X03, cmax(END_ST, END_ACT));

constexpr int LDS_BYTES = 131072 + 1024;
constexpr int NPHASE = 13;
constexpr int STG = 0;

struct Args {
    const float* in[21];
    float* out;
    unsigned char* ws;
    int ph_lo, ph_hi;
};

__device__ __forceinline__ unsigned cvt_pk_bf16(float lo, float hi) { unsigned r; asm volatile("v_cvt_pk_bf16_f32 %0, %1, %2" : "=v"(r) : "v"(lo), "v"(hi)); return r; }
__device__ __forceinline__ bf16_t f2bf(float f) { return (bf16_t)(cvt_pk_bf16(f, 0.f) & 0xFFFFu); }
__device__ __forceinline__ float bflo(unsigned w) { return __uint_as_float(w << 16); }
__device__ __forceinline__ float bfhi(unsigned w) { return __uint_as_float(w & 0xFFFF0000u); }
__device__ __forceinline__ float sigmoidf_(float x) { return __fdividef(1.0f, 1.0f + __expf(-x)); }
__device__ __forceinline__ float siluf_(float x) { return x * sigmoidf_(x); }
__device__ __forceinline__ float gelu_tanh(float x) { const float z = 0.7978845608028654f * (x + 0.044715f * x * x * x); return x * sigmoidf_(2.0f * z); }
__device__ __forceinline__ float logsigf_(float x) { return fminf(x, 0.f) - log1pf(__expf(-fabsf(x))); }
__device__ __forceinline__ float wave_sum(float v) {
#pragma unroll
    for (int o = 1; o < 64; o <<= 1) v += __shfl_xor(v, o);
    return v;
}
__device__ __forceinline__ void sincos_rev(double ang, float& s, float& c) {
    double x = ang * 0.15915494309189535; x -= rint(x);
    const float xf = (float)x;
    s = __builtin_amdgcn_sinf(xf); c = __builtin_amdgcn_cosf(xf);
}

namespace pg8 {
constexpr int BM = 256, BK = 64, HALF = 128, HTB = HALF * BK * 2, STAGE_BYTES = 8 * HTB, NXCD = 8, WGM = 8;
__device__ __forceinline__ int lds_byte(int r, int c) { const int st = (r >> 4) * 2 + (c >> 5), rr = r & 15, cc = c & 31, ob = rr * 64 + cc * 2; return st * 1024 + (ob ^ (((ob >> 9) & 1) << 5)); }
__device__ __forceinline__ void stage_rc(int b, int& R, int& C) { const int st = b / 1024, sb = b % 1024, swz = sb ^ (((sb >> 9) & 1) << 5); R = (st >> 1) * 16 + swz / 64; C = (st & 1) * 32 + (swz % 64) / 2; }
__device__ __forceinline__ int perm32(int rho) { const int n = rho >> 4, i = rho & 15; return 8 * (i >> 2) + 4 * n + (i & 3); }

struct Unit { int pm, pn, g; };
struct Gemm { const bf16_t* A; const bf16_t* Bt; int lda, ldb, K, nM, nN, nb; size_t sA, sB; int stagger; };

struct Order {
    int nM, nN, nwg, total, G, c;
    __device__ void init(int nM_, int nN_, int nb, int G_, int c_) { nM = nM_; nN = nN_; nwg = nM * nN; total = nwg * nb; G = G_; c = c_; }
    __device__ bool next(int i, Unit& u) const {
        const long L = (long)i * G + c; if (L >= total) return false;
        u.g = (int)(L / nwg); int wgid = (int)(L % nwg);
        { const int q = nwg / NXCD, r = nwg % NXCD, xcd = wgid % NXCD, off = wgid / NXCD; wgid = (xcd < r ? xcd * (q + 1) : r * (q + 1) + (xcd - r) * q) + off; }
        const int nig = WGM * nN, gid = wgid / nig, fm = gid * WGM, gsz = (nM - fm) < WGM ? (nM - fm) : WGM;
        u.pm = fm + ((wgid % nig) % gsz); u.pn = (wgid % nig) / gsz; return true;
    }
};

template <class Epi>
__device__ __forceinline__ void gemm_phase(LAS unsigned char* lds, const Gemm g, const Epi& E) {
    const int tid = threadIdx.x, wid = __builtin_amdgcn_readfirstlane(tid >> 6), lane = tid & 63, wr = wid >> 2, wc = wid & 3, fr = lane & 15, fq = lane >> 4;
    const int K = g.K, nt = K / BK;
    Order S; S.init(g.nM, g.nN, g.nb, (int)gridDim.x, (int)blockIdx.x);
    unsigned voffA[2], voffB[2];
#pragma unroll
    for (int i = 0; i < 2; ++i) { int R, C; stage_rc(tid * 16 + i * 8192, R, C); const int Rb = (R & ~31) + perm32(R & 31);
        voffA[i] = (unsigned)(R * g.lda + C) * 2u; voffB[i] = (unsigned)(Rb * g.ldb + C) * 2u; }
    const size_t kstep = (size_t)(BK * 2);
    const size_t hstepA = (size_t)HALF * g.lda * 2, hstepB = (size_t)HALF * g.ldb * 2;
    const size_t tstepA = 2 * hstepA, tstepB = 2 * hstepB;
    const unsigned ldsw = (unsigned)wid * 1024u;
    const int aoff = lds_byte(wr * 64 + fr, fq * 8), boff = lds_byte(wc * 32 + fr, fq * 8);
#define PG8_SA(b, h) (((b) * 2 + (h)) * HTB)
#define PG8_SB(b, h) ((4 + (b) * 2 + (h)) * HTB)
#define PG8_STAGE(bufoff, gbase, voff) do { _Pragma("unroll") for (int _i = 0; _i < 2; ++_i) \
        __builtin_amdgcn_global_load_lds((const unsigned*)((const char*)(gbase) + (voff)[_i]), (LAS unsigned*)(lds + (bufoff) + ldsw + _i * 8192), 16, 0, 0); } while (0)
#define PG8_LDA(dst, b, h) do { _Pragma("unroll") for (int m = 0; m < 4; ++m) _Pragma("unroll") for (int k = 0; k < 2; ++k) dst[m][k] = *(const LAS bf16x8*)(lds + PG8_SA(b, h) + aoff + m * 2048 + k * 1024); } while (0)
#define PG8_LDB(dst, b, h) do { _Pragma("unroll") for (int n = 0; n < 2; ++n) _Pragma("unroll") for (int k = 0; k < 2; ++k) dst[n][k] = *(const LAS bf16x8*)(lds + PG8_SB(b, h) + boff + n * 2048 + k * 1024); } while (0)
#define PG8_MMA(ai, bj, At, Bt) do { __builtin_amdgcn_s_setprio(1); _Pragma("unroll") for (int m = 0; m < 4; ++m) _Pragma("unroll") for (int n = 0; n < 2; ++n) _Pragma("unroll") for (int k = 0; k < 2; ++k) \
        acc[ai][bj][m][n] = __builtin_amdgcn_mfma_f32_16x16x32_bf16(Bt[n][k], At[m][k], acc[ai][bj][m][n], 0, 0, 0); __builtin_amdgcn_s_setprio(0); } while (0)
#define PG8_WAIT_V(n) asm volatile("s_waitcnt vmcnt(" #n ")" ::: "memory")
#define PG8_WAIT_L(n) asm volatile("s_waitcnt lgkmcnt(" #n ")" ::: "memory")
#define PG8_BAR __builtin_amdgcn_s_barrier()
#define PG8_SCHED __builtin_amdgcn_sched_barrier(0)
    Unit cur, nxt; int ui = 0;
    if (!S.next(0, cur)) return;
    if (g.stagger) {
        const unsigned long long t0 = __builtin_amdgcn_s_memrealtime(), wt = (unsigned long long)((blockIdx.x & 3) * g.stagger);
        while (__builtin_amdgcn_s_memrealtime() - t0 < wt) __builtin_amdgcn_s_sleep(16);
    }
    f32x4 acc[2][2][4][2];
#pragma unroll
    for (int a = 0; a < 2; ++a)
#pragma unroll
        for (int b = 0; b < 2; ++b)
#pragma unroll
            for (int m = 0; m < 4; ++m)
#pragma unroll
                for (int n = 0; n < 2; ++n) acc[a][b][m][n] = (f32x4){0.f, 0.f, 0.f, 0.f};
    bf16x8 At[4][2], B0[2][2], B1[2][2];
    const char* cA = (const char*)g.A + ((size_t)cur.g * g.sA) * 2 + (size_t)cur.pm * tstepA;
    const char* cB = (const char*)g.Bt + ((size_t)cur.g * g.sB) * 2 + (size_t)cur.pn * tstepB;
    PG8_STAGE(PG8_SB(0, 0), cB, voffB); PG8_STAGE(PG8_SA(0, 0), cA, voffA); PG8_STAGE(PG8_SB(0, 1), cB + hstepB, voffB); PG8_STAGE(PG8_SA(0, 1), cA + hstepA, voffA);
    if (wr == 1) PG8_BAR;
    PG8_WAIT_V(4); PG8_BAR;
    PG8_STAGE(PG8_SB(1, 0), cB + kstep, voffB); PG8_STAGE(PG8_SA(1, 0), cA + kstep, voffA); PG8_STAGE(PG8_SB(1, 1), cB + hstepB + kstep, voffB);
    PG8_WAIT_V(6); PG8_BAR;
    for (;;) {
        const bool has_next = S.next(ui + 1, nxt);
        const char* nA = has_next ? (const char*)g.A + ((size_t)nxt.g * g.sA) * 2 + (size_t)nxt.pm * tstepA : cA;
        const char* nB = has_next ? (const char*)g.Bt + ((size_t)nxt.g * g.sB) * 2 + (size_t)nxt.pn * tstepB : cB;
        for (int t = 0; t < nt; t += 2) {
            const bool last = (t == nt - 2);
            const char* a1 = cA + (size_t)(t + 1) * kstep;
            const char* a2 = last ? nA : cA + (size_t)(t + 2) * kstep; const char* b2 = last ? nB : cB + (size_t)(t + 2) * kstep;
            const char* a3 = a2 + kstep; const char* b3 = b2 + kstep;
            PG8_LDB(B0, 0, 0); PG8_SCHED; PG8_LDA(At, 0, 0); PG8_STAGE(PG8_SA(1, 1), a1 + hstepA, voffA);
            PG8_WAIT_L(8); PG8_BAR; PG8_WAIT_L(0); PG8_MMA(0, 0, At, B0); PG8_BAR; PG8_SCHED;
            PG8_LDB(B1, 0, 1); PG8_STAGE(PG8_SB(0, 0), b2, voffB);
            PG8_BAR; PG8_WAIT_L(0); PG8_MMA(0, 1, At, B1); PG8_BAR;
            PG8_LDA(At, 0, 1); PG8_STAGE(PG8_SA(0, 0), a2, voffA);
            PG8_BAR; PG8_WAIT_L(0); PG8_MMA(1, 0, At, B0); PG8_BAR; PG8_SCHED;
            PG8_STAGE(PG8_SB(0, 1), b2 + hstepB, voffB);
            PG8_WAIT_V(6); PG8_BAR; PG8_MMA(1, 1, At, B1); PG8_BAR;
            PG8_LDB(B0, 1, 0); PG8_SCHED; PG8_LDA(At, 1, 0); PG8_STAGE(PG8_SA(0, 1), a2 + hstepA, voffA);
            PG8_WAIT_L(8); PG8_BAR; PG8_WAIT_L(0); PG8_MMA(0, 0, At, B0); PG8_BAR; PG8_SCHED;
            PG8_LDB(B1, 1, 1); PG8_STAGE(PG8_SB(1, 0), b3, voffB);
            PG8_BAR; PG8_WAIT_L(0); PG8_MMA(0, 1, At, B1); PG8_BAR;
            PG8_LDA(At, 1, 1); PG8_STAGE(PG8_SA(1, 0), a3, voffA);
            PG8_BAR; PG8_WAIT_L(0); PG8_MMA(1, 0, At, B0); PG8_BAR; PG8_SCHED;
            PG8_STAGE(PG8_SB(1, 1), b3 + hstepB, voffB);
            PG8_WAIT_V(6); PG8_BAR; PG8_MMA(1, 1, At, B1); PG8_BAR;
        }
        E(acc, cur, wr, wc, fr, fq);
        if (!has_next) break;
#pragma unroll
        for (int a = 0; a < 2; ++a)
#pragma unroll
            for (int b = 0; b < 2; ++b)
#pragma unroll
                for (int m = 0; m < 4; ++m)
#pragma unroll
                    for (int n = 0; n < 2; ++n) acc[a][b][m][n] = (f32x4){0.f, 0.f, 0.f, 0.f};
        cur = nxt; cA = nA; cB = nB; ++ui;
    }
    PG8_WAIT_V(0);
    if (wr == 0) PG8_BAR;
    PG8_BAR;
#undef PG8_SA
#undef PG8_SB
#undef PG8_STAGE
#undef PG8_LDA
#undef PG8_LDB
#undef PG8_MMA
#undef PG8_WAIT_V
#undef PG8_WAIT_L
#undef PG8_BAR
#undef PG8_SCHED
}
}
using pg8::Unit;
typedef const f32x4 (&AccRef)[2][2][4][2];

__device__ __forceinline__ u32x4 pack8(f32x4 a, f32x4 b) { u32x4 w; w.x = cvt_pk_bf16(a[0], a[1]); w.y = cvt_pk_bf16(a[2], a[3]); w.z = cvt_pk_bf16(b[0], b[1]); w.w = cvt_pk_bf16(b[2], b[3]); return w; }

struct EpiProj {
    bf16_t *u5, *q, *k, *v, *sg, *ga, *gb; const LAS double* ropef;
    __device__ __forceinline__ void operator()(AccRef acc, const Unit& u, int wr, int wc, int fr, int fq) const {
        const int pn = u.pn;
#pragma unroll
        for (int ai = 0; ai < 2; ++ai)
#pragma unroll
            for (int m = 0; m < 4; ++m) {
                const int row = u.pm * 256 + ai * 128 + wr * 64 + m * 16 + fr;
#pragma unroll
                for (int bj = 0; bj < 2; ++bj) {
                    const int col = pn * 256 + bj * 128 + wc * 32 + 8 * fq;
                    f32x4 v0 = acc[ai][bj][m][0], v1 = acc[ai][bj][m][1];
                    if (pn < 2) {
                        if (row < NVALID) {
                            int item, t;
                            if (row < NREAL) { item = row >> 5; t = row & 31; } else { const int mr = row - NREAL; item = IT_REAL + (mr >> 4); t = 16 + (mr & 15); }
                            const int g = col >> 4, h0 = col & 15;
                            *(u32x4*)(u5 + ((size_t)(g * IT_PAD + item) * LDA5 + t * 16 + h0)) = pack8(v0, v1);
                        }
                    } else if (pn < 6) {
                        const int cq = col - 512, isk = cq >> 9, cc = cq & 511, i0 = (cc & 127) >> 1;
                        const int pos = row < NPR ? 16 + (row & 4095) : (row < NREAL ? 16 + ((row - NPR) & 2047) : ((row - NREAL) & 15));
                        const float sc = isk ? 1.0f : 0.08838834764831845f;
                        float o[8];
#pragma unroll
                        for (int pi = 0; pi < 4; ++pi) {
                            float s, c; sincos_rev((double)pos * ropef[i0 + pi], s, c);
                            const float x1 = pi < 2 ? v0[2 * pi] : v1[2 * pi - 4], x2 = pi < 2 ? v0[2 * pi + 1] : v1[2 * pi - 3];
                            o[2 * pi] = (x1 * c - x2 * s) * sc; o[2 * pi + 1] = (x1 * s + x2 * c) * sc;
                        }
                        u32x4 w; w.x = cvt_pk_bf16(o[0], o[1]); w.y = cvt_pk_bf16(o[2], o[3]); w.z = cvt_pk_bf16(o[4], o[5]); w.w = cvt_pk_bf16(o[6], o[7]);
                        *(u32x4*)((isk ? k : q) + (size_t)row * 512 + cc) = w;
                    } else if (pn < 10) {
                        *(u32x4*)(v + (size_t)row * 1024 + (col - 1536)) = pack8(v0, v1);
                    } else if (row < NREAL) {
                        if (pn < 14) {
#pragma unroll
                            for (int j = 0; j < 4; ++j) { v0[j] = siluf_(v0[j]); v1[j] = siluf_(v1[j]); }
                            *(u32x4*)(sg + (size_t)row * 1024 + (col - 2560)) = pack8(v0, v1);
                        } else {
#pragma unroll
                            for (int j = 0; j < 4; ++j) { v0[j] = sigmoidf_(v0[j]); v1[j] = sigmoidf_(v1[j]); }
                            if (pn < 18) *(u32x4*)(ga + (size_t)row * 1024 + (col - 3584)) = pack8(v0, v1);
                            else *(u32x4*)(gb + (size_t)row * 1024 + (col - 4608)) = pack8(v0, v1);
                        }
                    }
                }
            }
    }
};

struct EpiSink {
    float* p; int flag;
    __device__ __forceinline__ void operator()(AccRef acc, const Unit& u, int wr, int wc, int fr, int fq) const {
        if (flag) {
#pragma unroll
            for (int ai = 0; ai < 2; ++ai)
#pragma unroll
                for (int m = 0; m < 4; ++m)
#pragma unroll
                    for (int bj = 0; bj < 2; ++bj) { p[(ai * 8 + m * 2 + bj) * 8 + fr] = acc[ai][bj][m][0][0] + acc[ai][bj][m][1][1]; }
        }
    }
};

struct EpiSloc {
    float* sloc;
    __device__ __forceinline__ void operator()(AccRef acc, const Unit& u, int wr, int wc, int fr, int fq) const {
#pragma unroll
        for (int ai = 0; ai < 2; ++ai)
#pragma unroll
            for (int m = 0; m < 4; ++m) {
                const int row = u.pm * 256 + ai * 128 + wr * 64 + m * 16 + fr;
#pragma unroll
                for (int bj = 0; bj < 2; ++bj) {
                    const int col = bj * 128 + wc * 32 + 8 * fq;
                    float* p = sloc + ((size_t)u.g * IT_PAD + row) * 256 + col;
                    *(f32x4*)p = acc[ai][bj][m][0]; *(f32x4*)(p + 4) = acc[ai][bj][m][1];
                }
            }
    }
};

struct EpiY {
    bf16_t* y;
    __device__ __forceinline__ void operator()(AccRef acc, const Unit& u, int wr, int wc, int fr, int fq) const {
#pragma unroll
        for (int ai = 0; ai < 2; ++ai)
#pragma unroll
            for (int m = 0; m < 4; ++m) {
                const int item = u.pm * 256 + ai * 128 + wr * 64 + m * 16 + fr;
                if (item < IT_REAL) {
#pragma unroll
                    for (int bj = 0; bj < 2; ++bj) {
                        const int col = u.pn * 256 + bj * 128 + wc * 32 + 8 * fq, to = col >> 4, ho = col & 15;
                        f32x4 v0 = acc[ai][bj][m][0], v1 = acc[ai][bj][m][1];
#pragma unroll
                        for (int j = 0; j < 4; ++j) { v0[j] = gelu_tanh(v0[j]); v1[j] = gelu_tanh(v1[j]); }
                        *(u32x4*)(y + (size_t)(item * 32 + to) * 512 + u.g * 16 + ho) = pack8(v0, v1);
                    }
                }
            }
    }
};

struct EpiGlu {
    bf16_t* ga;
    __device__ __forceinline__ void operator()(AccRef acc, const Unit& u, int wr, int wc, int fr, int fq) const {
        u32x4 gw[2][4];
#pragma unroll
        for (int ai = 0; ai < 2; ++ai)
#pragma unroll
            for (int m = 0; m < 4; ++m) {
                const int row = u.pm * 256 + ai * 128 + wr * 64 + m * 16 + fr;
                gw[ai][m] = *(const u32x4*)(ga + (size_t)row * 1024 + u.pn * 128 + wc * 32 + 8 * fq);
            }
#pragma unroll
        for (int ai = 0; ai < 2; ++ai)
#pragma unroll
            for (int m = 0; m < 4; ++m) {
                const int row = u.pm * 256 + ai * 128 + wr * 64 + m * 16 + fr;
                bf16_t* p = ga + (size_t)row * 1024 + u.pn * 128 + wc * 32 + 8 * fq;
                const u32x4 g = gw[ai][m];
                const f32x4 a0 = acc[ai][0][m][0], a1 = acc[ai][0][m][1], g0 = acc[ai][1][m][0], g1 = acc[ai][1][m][1];
                f32x4 r0, r1;
                r0[0] = bflo(g.x) * a0[0] * sigmoidf_(g0[0]); r0[1] = bfhi(g.x) * a0[1] * sigmoidf_(g0[1]);
                r0[2] = bflo(g.y) * a0[2] * sigmoidf_(g0[2]); r0[3] = bfhi(g.y) * a0[3] * sigmoidf_(g0[3]);
                r1[0] = bflo(g.z) * a1[0] * sigmoidf_(g1[0]); r1[1] = bfhi(g.z) * a1[1] * sigmoidf_(g1[1]);
                r1[2] = bflo(g.w) * a1[2] * sigmoidf_(g1[2]); r1[3] = bfhi(g.w) * a1[3] * sigmoidf_(g1[3]);
                *(u32x4*)p = pack8(r0, r1);
            }
    }
};

struct EpiRet {
    const bf16_t *pa, *gb; bf16_t* mixed;
    __device__ __forceinline__ void operator()(AccRef acc, const Unit& u, int wr, int wc, int fr, int fq) const {
#pragma unroll
        for (int ai = 0; ai < 2; ++ai) {
            u32x4 pw[4][2], gw[4][2];
#pragma unroll
            for (int m = 0; m < 4; ++m)
#pragma unroll
                for (int bj = 0; bj < 2; ++bj) {
                    const int row = u.pm * 256 + ai * 128 + wr * 64 + m * 16 + fr;
                    const size_t o = (size_t)row * 1024 + u.pn * 256 + bj * 128 + wc * 32 + 8 * fq;
                    pw[m][bj] = *(const u32x4*)(pa + o); gw[m][bj] = *(const u32x4*)(gb + o);
                }
#pragma unroll
            for (int m = 0; m < 4; ++m)
#pragma unroll
                for (int bj = 0; bj < 2; ++bj) {
                    const int row = u.pm * 256 + ai * 128 + wr * 64 + m * 16 + fr;
                    const size_t o = (size_t)row * 1024 + u.pn * 256 + bj * 128 + wc * 32 + 8 * fq;
                    const u32x4 p = pw[m][bj], g = gw[m][bj];
                    const f32x4 a0 = acc[ai][bj][m][0], a1 = acc[ai][bj][m][1];
                    f32x4 r0, r1;
                    r0[0] = bflo(p.x) + bflo(g.x) * a0[0]; r0[1] = bfhi(p.x) + bfhi(g.x) * a0[1];
                    r0[2] = bflo(p.y) + bflo(g.y) * a0[2]; r0[3] = bfhi(p.y) + bfhi(g.y) * a0[3];
                    r1[0] = bflo(p.z) + bflo(g.z) * a1[0]; r1[1] = bfhi(p.z) + bfhi(g.z) * a1[1];
                    r1[2] = bflo(p.w) + bflo(g.w) * a1[2]; r1[3] = bfhi(p.w) + bfhi(g.w) * a1[3];
                    *(u32x4*)(mixed + o) = pack8(r0, r1);
                }
            __builtin_amdgcn_sched_barrier(0);
        }
    }
};

template <int MODE>
struct EpiRes {
    const float *xp, *xs; bf16_t* hb; float* ssq;
    __device__ __forceinline__ void operator()(AccRef acc, const Unit& u, int wr, int wc, int fr, int fq) const {
#pragma unroll
        for (int ai = 0; ai < 2; ++ai) {
            f32x4 x0[4][2], x1[4][2]; u32x4 hw[4][2];
#pragma unroll
            for (int m = 0; m < 4; ++m)
#pragma unroll
                for (int bj = 0; bj < 2; ++bj) {
                    const int row = u.pm * 256 + ai * 128 + wr * 64 + m * 16 + fr, col = u.pn * 256 + bj * 128 + wc * 32 + 8 * fq;
                    if (MODE == 0) {
                        const float* src = (row < NPR ? xp + (size_t)row * 1024 : xs + (size_t)(row - NPR) * 1024) + col;
                        x0[m][bj] = *(const f32x4*)src; x1[m][bj] = *(const f32x4*)(src + 4);
                    } else hw[m][bj] = *(const u32x4*)(hb + (size_t)row * 1024 + col);
                }
#pragma unroll
            for (int m = 0; m < 4; ++m) {
                const int row = u.pm * 256 + ai * 128 + wr * 64 + m * 16 + fr;
                float ss = 0.f;
#pragma unroll
                for (int bj = 0; bj < 2; ++bj) {
                    const int col = u.pn * 256 + bj * 128 + wc * 32 + 8 * fq;
                    f32x4 h0, h1;
                    if (MODE == 0) { h0 = x0[m][bj]; h1 = x1[m][bj]; }
                    else { const u32x4 w = hw[m][bj]; h0 = (f32x4){bflo(w.x), bfhi(w.x), bflo(w.y), bfhi(w.y)}; h1 = (f32x4){bflo(w.z), bfhi(w.z), bflo(w.w), bfhi(w.w)}; }
                    h0 = h0 + acc[ai][bj][m][0]; h1 = h1 + acc[ai][bj][m][1];
                    *(u32x4*)(hb + (size_t)row * 1024 + col) = pack8(h0, h1);
                    ss += (h0[0] * h0[0] + h0[1] * h0[1]) + (h0[2] * h0[2] + h0[3] * h0[3]) + (h1[0] * h1[0] + h1[1] * h1[1]) + (h1[2] * h1[2] + h1[3] * h1[3]);
                }
                ss += __shfl_xor(ss, 16); ss += __shfl_xor(ss, 32);
                if (fq == 0) ssq[(size_t)row * 16 + u.pn * 4 + wc] = ss;
            }
            __builtin_amdgcn_sched_barrier(0);
        }
    }
};

struct EpiFfi {
    const float* ssq; bf16_t* act;
    __device__ __forceinline__ void operator()(AccRef acc, const Unit& u, int wr, int wc, int fr, int fq) const {
        f32x4 sp[2][4];
#pragma unroll
        for (int ai = 0; ai < 2; ++ai)
#pragma unroll
            for (int m = 0; m < 4; ++m) {
                const int row = u.pm * 256 + ai * 128 + wr * 64 + m * 16 + fr;
                sp[ai][m] = *(const f32x4*)(ssq + (size_t)row * 16 + 4 * fq);
            }
#pragma unroll
        for (int ai = 0; ai < 2; ++ai)
#pragma unroll
            for (int m = 0; m < 4; ++m) {
                const int row = u.pm * 256 + ai * 128 + wr * 64 + m * 16 + fr;
                float tot = (sp[ai][m][0] + sp[ai][m][1]) + (sp[ai][m][2] + sp[ai][m][3]);
                tot += __shfl_xor(tot, 16); tot += __shfl_xor(tot, 32);
                const float rstd = rsqrtf(tot * (1.0f / 1024.0f) + EPS);
                const f32x4 g0 = acc[ai][0][m][0], g1 = acc[ai][0][m][1], u0 = acc[ai][1][m][0], u1 = acc[ai][1][m][1];
                f32x4 r0, r1;
#pragma unroll
                for (int j = 0; j < 4; ++j) { r0[j] = siluf_(rstd * g0[j]) * (rstd * u0[j]); r1[j] = siluf_(rstd * g1[j]) * (rstd * u1[j]); }
                *(u32x4*)(act + (size_t)row * DFF + u.pn * 128 + wc * 32 + 8 * fq) = pack8(r0, r1);
            }
    }
};

__device__ __forceinline__ void p0_s5gen(const Args& a, LAS float* L, int g, int qd) {
    const int tid = threadIdx.x;
    LAS float* Kt = L;
    LAS float* Ap = L + 16384;
    LAS float* Bb = Ap + 33 * 64 * 2;
    LAS float* Cc = Bb + 2048;
    bf16_t* bts = (bf16_t*)(a.ws + OFF_BTS) + (size_t)g * 256 * 512;
    bf16_t* bty = (bf16_t*)(a.ws + OFF_BTY) + (size_t)g * 512 * 768;
    float* attab = (float*)(a.ws + OFF_AT);
    bf16_t* u5 = (bf16_t*)(a.ws + OFF_U5);
    if (qd == 0) for (int e = tid; e < 24 * 256; e += 512) { const int b = e >> 8, kk = e & 255; u5[((size_t)g * IT_PAD + IT_REAL + b) * LDA5 + kk] = 0; }
    for (int dir = 0; dir < 2; ++dir) {
        const int pg = dir * 32 + g;
        const double dt = exp((double)a.in[7][pg]);
        for (int idx = tid; idx < 33 * 64; idx += 512) {
            const int p = idx & 63, d = idx >> 6;
            const double lr = a.in[5][pg * 64 + p], li = a.in[6][pg * 64 + p];
            const float mag = (float)exp(lr * dt * d);
            float s, c; sincos_rev(li * dt * d, s, c);
            Ap[idx * 2] = mag * c; Ap[idx * 2 + 1] = mag * s;
            if (d == 32 && qd == 0) { attab[(pg * 64 + p) * 2] = mag * c; attab[(pg * 64 + p) * 2 + 1] = mag * s; }
        }
        for (int idx = tid; idx < 1024; idx += 512) {
            const int p = idx >> 4, h = idx & 15;
            const double lr = a.in[5][pg * 64 + p], li = a.in[6][pg * 64 + p];
            const double zr = lr * dt, zi = li * dt, mag = exp(zr);
            float sh, ch, s1, c1; sincos_rev(0.5 * zi, sh, ch); sincos_rev(zi, s1, c1);
            const double nr = mag * (-2.0 * (double)sh * (double)sh) + expm1(zr);
            const double abi = mag * (double)s1, den = lr * lr + li * li;
            const double cre = (nr * lr + abi * li) / den, cim = (abi * lr - nr * li) / den;
            const double br = a.in[8][(size_t)(pg * 64 + p) * 16 + h], bi = a.in[9][(size_t)(pg * 64 + p) * 16 + h];
            Bb[idx * 2] = (float)(cre * br - cim * bi); Bb[idx * 2 + 1] = (float)(cre * bi + cim * br);
        }
        for (int idx = tid; idx < 1024; idx += 512) {
            Cc[idx * 2] = a.in[10][(size_t)pg * 1024 + idx]; Cc[idx * 2 + 1] = a.in[11][(size_t)pg * 1024 + idx];
        }
        __syncthreads();
        for (int e = tid; e < 8192; e += 512) {
            const int d = e >> 8, ho = (e >> 4) & 15, hi = e & 15;
            float sum = 0.f;
            for (int p = 0; p < 64; ++p) {
                const float cr = Cc[(ho * 64 + p) * 2], ci = Cc[(ho * 64 + p) * 2 + 1], ar = Ap[(d * 64 + p) * 2], ai = Ap[(d * 64 + p) * 2 + 1];
                const float br = Bb[(p * 16 + hi) * 2], bi = Bb[(p * 16 + hi) * 2 + 1];
                const float car = cr * ar - ci * ai, cai = cr * ai + ci * ar;
                sum += car * br - cai * bi;
            }
            Kt[dir * 8192 + e] = sum;
        }
        for (int e = qd * 16384 + tid; e < (qd + 1) * 16384; e += 512) {
            const int k = e & 511, nn = e >> 9, c = nn >> 6, p = nn & 63, t = k >> 4, hi = k & 15;
            const int dd = dir == 0 ? (T5 - 1 - t) : t;
            const float ar = Ap[(dd * 64 + p) * 2], ai = Ap[(dd * 64 + p) * 2 + 1], br = Bb[(p * 16 + hi) * 2], bi = Bb[(p * 16 + hi) * 2 + 1];
            const float val = c ? (ar * bi + ai * br) : (ar * br - ai * bi);
            bts[(size_t)(dir * 128 + nn) * 512 + k] = f2bf(val);
        }
        for (int e = qd * 16384 + tid; e < (qd + 1) * 16384; e += 512) {
            const int kk = e & 127, n = e >> 7, c = kk >> 6, p = kk & 63, to = n >> 4, ho = n & 15;
            const int dd = dir == 0 ? (to + 1) : (T5 - to);
            const float cr = Cc[(ho * 64 + p) * 2], ci = Cc[(ho * 64 + p) * 2 + 1], ar = Ap[(dd * 64 + p) * 2], ai = Ap[(dd * 64 + p) * 2 + 1];
            const float val = c ? -(cr * ai + ci * ar) : (cr * ar - ci * ai);
            bty[(size_t)n * 768 + 512 + dir * 128 + kk] = f2bf(val);
        }
        __syncthreads();
    }
    for (int e = qd * 65536 + tid; e < (qd + 1) * 65536; e += 512) {
        const int k = e & 511, n = e >> 9, to = n >> 4, ho = n & 15, ti = k >> 4, hi = k & 15;
        float val = 0.f;
        if (to >= ti) val += Kt[((to - ti) * 16 + ho) * 16 + hi];
        if (ti >= to) val += Kt[8192 + ((ti - to) * 16 + ho) * 16 + hi];
        if (to == ti && ho == hi) val += a.in[12][g * 16 + ho];
        bty[(size_t)n * 768 + k] = f2bf(val);
    }
    __syncthreads();
}

__device__ __forceinline__ int src_col(int kind, int n) {
    if (kind == 1) { if (n >= 512 && n < 1536) { const int r = n - 512, seg = r >> 7, dp = r & 127; return 512 + seg * 128 + (dp >> 1) + 64 * (dp & 1); } return n; }
    if (kind == 2) { const int pn = n >> 8, bj = (n >> 7) & 1, cc = n & 127; return bj * 1024 + pn * 128 + cc; }
    if (kind == 3) { const int pn = n >> 8, bj = (n >> 7) & 1, cc = n & 127; return bj * DFF + pn * 128 + cc; }
    return n;
}
__device__ __forceinline__ void p0_wtile(const float* W, int K, int N, bf16_t* WT, int kind, const float* kscale, int tile2, LAS float* L) {
    const int tid = threadIdx.x, nkt = K >> 6;
    int n0[2], k0[2];
#pragma unroll
    for (int q = 0; q < 2; ++q) { const int tile = 2 * tile2 + q; n0[q] = (tile / nkt) * 64; k0[q] = (tile % nkt) * 64; }
    float v[2][8];
#pragma unroll
    for (int q = 0; q < 2; ++q)
#pragma unroll
        for (int it = 0; it < 8; ++it) {
            const int idx = tid + it * 512, kk = idx >> 6, j = idx & 63;
            v[q][it] = W[(size_t)(k0[q] + kk) * N + src_col(kind, n0[q] + j)];
        }
#pragma unroll
    for (int q = 0; q < 2; ++q)
#pragma unroll
        for (int it = 0; it < 8; ++it) {
            const int idx = tid + it * 512, kk = idx >> 6, j = idx & 63;
            float x = v[q][it];
            if (kscale) x *= kscale[k0[q] + kk];
            L[q * 4160 + kk * 65 + j] = x;
        }
    __syncthreads();
#pragma unroll
    for (int q = 0; q < 2; ++q)
#pragma unroll
        for (int it = 0; it < 4; ++it) {
            const int idx = tid + it * 512, j = idx >> 5, kp = idx & 31;
            *(unsigned*)(WT + (size_t)(n0[q] + j) * K + k0[q] + 2 * kp) = cvt_pk_bf16(L[q * 4160 + (2 * kp) * 65 + j], L[q * 4160 + (2 * kp + 1) * 65 + j]);
        }
    __syncthreads();
}

__device__ __forceinline__ void phase0(const Args& a, LAS unsigned char* lds) {
    LAS float* L = (LAS float*)lds;
    const int tid = threadIdx.x, wave = tid >> 6, lane = tid & 63;
    constexpr int T_IN = 88 * 16 / 2, T_GLU = 32 * 8 / 2, T_RET = 128, T_OUT = 128, T_FFI = 88 * 16 / 2, T_FFO = 16 * 44 / 2;
    constexpr int NW = 128 + T_IN + T_GLU + T_RET + T_OUT + T_FFI + T_FFO, NRM = RPAD / 32;
    unsigned* qctr = (unsigned*)(a.ws + OFF_BAR) + 32;
    LAS int* qslot = (LAS int*)(lds + 131072 + 512);
    for (;;) {
        __syncthreads();
        if (tid == 0) *qslot = (int)__hip_atomic_fetch_add(qctr, 1u, __ATOMIC_RELAXED, __HIP_MEMORY_SCOPE_AGENT);
        __syncthreads();
        const int w = *qslot;
        if (w >= NW + NRM) break;
        int r = w;
        if (r < 128) { p0_s5gen(a, L, r >> 2, r & 3); continue; } r -= 128;
        if (r < T_IN) { p0_wtile(a.in[4], 1024, INW, (bf16_t*)(a.ws + OFF_WIN), 1, nullptr, r, L); continue; } r -= T_IN;
        if (r < T_GLU) { p0_wtile(a.in[13], 512, 2048, (bf16_t*)(a.ws + OFF_WGLU), 2, nullptr, r, L); continue; } r -= T_GLU;
        if (r < T_RET) { p0_wtile(a.in[15], 1024, 1024, (bf16_t*)(a.ws + OFF_WRET), 0, nullptr, r, L); continue; } r -= T_RET;
        if (r < T_OUT) { p0_wtile(a.in[16], 1024, 1024, (bf16_t*)(a.ws + OFF_WOUT), 0, nullptr, r, L); continue; } r -= T_OUT;
        if (r < T_FFI) { p0_wtile(a.in[18], 1024, INW, (bf16_t*)(a.ws + OFF_WFFI), 3, a.in[17], r, L); continue; } r -= T_FFI;
        if (r < T_FFO) { p0_wtile(a.in[19], DFF, 1024, (bf16_t*)(a.ws + OFF_WFFO), 0, nullptr, r, L); continue; } r -= T_FFO;
        const int rowb = r * 32 + wave * 4;
        const float* xr[4]; f32x4 v[4][4];
#pragma unroll
        for (int q = 0; q < 4; ++q) {
            const int row = rowb + q;
            xr[q] = row < NPR ? a.in[0] + (size_t)row * 1024 : (row < NREAL ? a.in[1] + (size_t)(row - NPR) * 1024 : a.in[2] + (size_t)((row - NREAL) & 15) * 1024);
#pragma unroll
            for (int j = 0; j < 4; ++j) v[q][j] = (row < NVALID) ? *(const f32x4*)(xr[q] + (j * 64 + lane) * 4) : (f32x4){0.f, 0.f, 0.f, 0.f};
        }
        f32x4 gg[4];
#pragma unroll
        for (int j = 0; j < 4; ++j) gg[j] = *(const f32x4*)(a.in[3] + (j * 64 + lane) * 4);
#pragma unroll
        for (int q = 0; q < 4; ++q) {
            float sq = 0.f;
#pragma unroll
            for (int j = 0; j < 4; ++j) sq += (v[q][j][0] * v[q][j][0] + v[q][j][1] * v[q][j][1]) + (v[q][j][2] * v[q][j][2] + v[q][j][3] * v[q][j][3]);
            const float rstd = rsqrtf(wave_sum(sq) * (1.0f / 1024.0f) + EPS);
            bf16_t* orow = (bf16_t*)(a.ws + OFF_N1) + (size_t)(rowb + q) * 1024;
#pragma unroll
            for (int j = 0; j < 4; ++j) {
                u32x2 o; o.x = cvt_pk_bf16(v[q][j][0] * rstd * gg[j][0], v[q][j][1] * rstd * gg[j][1]); o.y = cvt_pk_bf16(v[q][j][2] * rstd * gg[j][2], v[q][j][3] * rstd * gg[j][3]);
                *(u32x2*)(orow + (j * 64 + lane) * 4) = o;
            }
        }
    }
}

__device__ __forceinline__ void s5_scan(const Args& a) {
    const float* attab = (const float*)(a.ws + OFF_AT);
    const float* sloc = (const float*)(a.ws + OFF_SLOC);
    bf16_t* u5 = (bf16_t*)(a.ws + OFF_U5);
    for (int id = blockIdx.x * 512 + threadIdx.x; id < 24 * 32 * 2 * 64; id += gridDim.x * 512) {
        const int p = id & 63, dir = (id >> 6) & 1, g = (id >> 7) & 31, b = id >> 12;
        const float atr = attab[((dir * 32 + g) * 64 + p) * 2], ati = attab[((dir * 32 + g) * 64 + p) * 2 + 1];
        const int nck = b < 16 ? 128 : 64, base = b < 16 ? b * 128 : 2048 + (b - 16) * 64, mitem = IT_REAL + b;
        const float* sl = sloc + (size_t)g * IT_PAD * 256 + dir * 128 + p;
        bf16_t* ub = u5 + (size_t)g * IT_PAD * LDA5 + 512 + dir * 128 + p;
        float sr = 0.f, si = 0.f;
        if (dir == 0) {
            ub[(size_t)mitem * LDA5] = 0; ub[(size_t)mitem * LDA5 + 64] = 0;
            sr = sl[(size_t)mitem * 256]; si = sl[(size_t)mitem * 256 + 64];
            for (int c0 = 0; c0 < nck; c0 += 16) {
                float lr[16], li[16];
#pragma unroll
                for (int j = 0; j < 16; ++j) { lr[j] = sl[(size_t)(base + c0 + j) * 256]; li[j] = sl[(size_t)(base + c0 + j) * 256 + 64]; }
#pragma unroll
                for (int j = 0; j < 16; ++j) {
                    const size_t it = (size_t)(base + c0 + j);
                    ub[it * LDA5] = f2bf(sr); ub[it * LDA5 + 64] = f2bf(si);
                    const float nr = atr * sr - ati * si + lr[j], ni = atr * si + ati * sr + li[j];
                    sr = nr; si = ni;
                }
            }
        } else {
            for (int c0 = nck - 16; c0 >= 0; c0 -= 16) {
                float lr[16], li[16];
#pragma unroll
                for (int j = 0; j < 16; ++j) { lr[j] = sl[(size_t)(base + c0 + j) * 256]; li[j] = sl[(size_t)(base + c0 + j) * 256 + 64]; }
#pragma unroll
                for (int j = 15; j >= 0; --j) {
                    const size_t it = (size_t)(base + c0 + j);
                    ub[it * LDA5] = f2bf(sr); ub[it * LDA5 + 64] = f2bf(si);
                    const float nr = atr * sr - ati * si + lr[j], ni = atr * si + ati * sr + li[j];
                    sr = nr; si = ni;
                }
            }
            ub[(size_t)mitem * LDA5] = f2bf(sr); ub[(size_t)mitem * LDA5 + 64] = f2bf(si);
        }
    }
}

constexpr int LDR = 136;
__device__ __forceinline__ float bf2f(bf16_t h) { return __uint_as_float(((unsigned)h) << 16); }

__device__ __forceinline__ void tr_store_pair(LAS bf16_t* img, int f0, int s2, u32x4 r0, u32x4 r1) {
    LAS unsigned* p = (LAS unsigned*)(img + f0 * LDR + s2);
    p[0 * (LDR / 2)] = (r0.x & 0xFFFFu) | (r1.x << 16); p[1 * (LDR / 2)] = (r0.x >> 16) | (r1.x & 0xFFFF0000u);
    p[2 * (LDR / 2)] = (r0.y & 0xFFFFu) | (r1.y << 16); p[3 * (LDR / 2)] = (r0.y >> 16) | (r1.y & 0xFFFF0000u);
    p[4 * (LDR / 2)] = (r0.z & 0xFFFFu) | (r1.z << 16); p[5 * (LDR / 2)] = (r0.z >> 16) | (r1.z & 0xFFFF0000u);
    p[6 * (LDR / 2)] = (r0.w & 0xFFFFu) | (r1.w << 16); p[7 * (LDR / 2)] = (r0.w >> 16) | (r1.w & 0xFFFF0000u);
}
__device__ __forceinline__ void tr_store_pair_scaled(LAS bf16_t* img, int f0, int s2, u32x4 r0, u32x4 r1, float w0, float w1) {
    LAS unsigned* p = (LAS unsigned*)(img + f0 * LDR + s2);
    p[0 * (LDR / 2)] = cvt_pk_bf16(bflo(r0.x) * w0, bflo(r1.x) * w1); p[1 * (LDR / 2)] = cvt_pk_bf16(bfhi(r0.x) * w0, bfhi(r1.x) * w1);
    p[2 * (LDR / 2)] = cvt_pk_bf16(bflo(r0.y) * w0, bflo(r1.y) * w1); p[3 * (LDR / 2)] = cvt_pk_bf16(bfhi(r0.y) * w0, bfhi(r1.y) * w1);
    p[4 * (LDR / 2)] = cvt_pk_bf16(bflo(r0.z) * w0, bflo(r1.z) * w1); p[5 * (LDR / 2)] = cvt_pk_bf16(bfhi(r0.z) * w0, bfhi(r1.z) * w1);
    p[6 * (LDR / 2)] = cvt_pk_bf16(bflo(r0.w) * w0, bflo(r1.w) * w1); p[7 * (LDR / 2)] = cvt_pk_bf16(bfhi(r0.w) * w0, bfhi(r1.w) * w1);
}

#define LDS_BARRIER() do { asm volatile("s_waitcnt lgkmcnt(0)" ::: "memory"); __builtin_amdgcn_s_barrier(); asm volatile("" ::: "memory"); } while (0)
__device__ __forceinline__ void ret_pass_a(const Args& a, LAS unsigned char* lds) {
    LAS bf16_t* KT = (LAS bf16_t*)lds;
    LAS bf16_t* VT = KT + 128 * LDR;
    const int tid0 = threadIdx.x;
    const bf16_t* kb = (const bf16_t*)(a.ws + OFF_K); const bf16_t* vb = (const bf16_t*)(a.ws + OFF_V);
    bf16_t* stb = (bf16_t*)(a.ws + OFF_ST);
    for (int item = blockIdx.x; item < 192; item += gridDim.x) {
        int tid = tid0; asm volatile("" : "+v"(tid));
        const int w = tid >> 6, lane = tid & 63, fr = lane & 15, fq = lane >> 4;
        int b, h, dir;
        if (item < 128) { b = item >> 3; h = (item >> 1) & 3; dir = item & 1; } else { const int j = item - 128; b = 16 + (j >> 3); h = (j >> 1) & 3; dir = j & 1; }
        const int NC = b < 16 ? 32 : 16, rbase = b < 16 ? b * 4096 : NPR + (b - 16) * 2048, ebase = b < 16 ? b * 33 : 528 + (b - 16) * 17;
        const float lg = logsigf_(a.in[14][dir * 4 + h]);
        const float carry = __expf(lg * 128.f);
        const int s2 = 2 * (8 * w + (lane & 7)), pg = lane >> 3;
        const float wk0 = dir == 0 ? __expf(lg * (float)(127 - s2)) : __expf(lg * (float)s2);
        const float wk1 = dir == 0 ? __expf(lg * (float)(126 - s2)) : __expf(lg * (float)(s2 + 1));
        f32x4 acc[2][8];
#pragma unroll
        for (int et = 0; et < 2; ++et)
#pragma unroll
            for (int dtl = 0; dtl < 8; ++dtl) acc[et][dtl] = (f32x4){0.f, 0.f, 0.f, 0.f};
        const int nsteps = dir == 0 ? NC : NC;
        u32x4 rk[2][2], rv[4][2];
        auto load_chunk = [&](int n) {
            int row0; bool valid = true;
            if (n == 0) { valid = s2 >= 112; row0 = NREAL + b * 16 + (s2 - 112); } else row0 = rbase + (n - 1) * 128 + s2;
#pragma unroll
            for (int it = 0; it < 2; ++it)
#pragma unroll
                for (int r = 0; r < 2; ++r) {
                    rk[it][r] = (u32x4){0u, 0u, 0u, 0u};
                    if (valid) rk[it][r] = *(const u32x4*)(kb + (size_t)(row0 + r) * 512 + h * 128 + (pg + 8 * it) * 8);
                }
#pragma unroll
            for (int it = 0; it < 4; ++it)
#pragma unroll
                for (int r = 0; r < 2; ++r) {
                    rv[it][r] = (u32x4){0u, 0u, 0u, 0u};
                    if (valid) rv[it][r] = *(const u32x4*)(vb + (size_t)(row0 + r) * 1024 + h * 256 + (pg + 8 * it) * 8);
                }
        };
        load_chunk(dir == 0 ? 0 : NC);
        for (int step = 0; step < nsteps; ++step) {
            const int n = dir == 0 ? step : NC - step;
            {
                bf16_t* spn = stb + ((size_t)((ebase + n) * 4 + h) * 2 + dir) * 32768;
#pragma unroll
                for (int et = 0; et < 2; ++et)
#pragma unroll
                    for (int dtl = 0; dtl < 8; ++dtl) {
                        u32x2 o; o.x = cvt_pk_bf16(acc[et][dtl][0], acc[et][dtl][1]); o.y = cvt_pk_bf16(acc[et][dtl][2], acc[et][dtl][3]);
                        *(u32x2*)(spn + (size_t)(32 * w + 16 * et + fr) * 128 + 16 * dtl + 4 * fq) = o;
                    }
            }
            LDS_BARRIER();
#pragma unroll
            for (int it = 0; it < 2; ++it) tr_store_pair_scaled(KT, (pg + 8 * it) * 8, s2, rk[it][0], rk[it][1], wk0, wk1);
#pragma unroll
            for (int it = 0; it < 4; ++it) tr_store_pair(VT, (pg + 8 * it) * 8, s2, rv[it][0], rv[it][1]);
            if (step + 1 < nsteps) load_chunk(dir == 0 ? step + 1 : NC - step - 1);
            LDS_BARRIER();
#pragma unroll
            for (int et = 0; et < 2; ++et)
#pragma unroll
                for (int dtl = 0; dtl < 8; ++dtl) acc[et][dtl] = acc[et][dtl] * carry;
#pragma unroll
            for (int ks = 0; ks < 4; ++ks) {
                bf16x8 vf[2];
#pragma unroll
                for (int et = 0; et < 2; ++et) vf[et] = *(const LAS bf16x8*)(VT + (32 * w + 16 * et + fr) * LDR + 32 * ks + 8 * fq);
#pragma unroll
                for (int dtl = 0; dtl < 8; ++dtl) {
                    const bf16x8 kf = *(const LAS bf16x8*)(KT + (16 * dtl + fr) * LDR + 32 * ks + 8 * fq);
#pragma unroll
                    for (int et = 0; et < 2; ++et) acc[et][dtl] = __builtin_amdgcn_mfma_f32_16x16x32_bf16(kf, vf[et], acc[et][dtl], 0, 0, 0);
                }
            }
        }
        if (dir == 0) {
            bf16_t* spn = stb + ((size_t)((ebase + NC) * 4 + h) * 2 + dir) * 32768;
#pragma unroll
            for (int et = 0; et < 2; ++et)
#pragma unroll
                for (int dtl = 0; dtl < 8; ++dtl) {
                    u32x2 o; o.x = cvt_pk_bf16(acc[et][dtl][0], acc[et][dtl][1]); o.y = cvt_pk_bf16(acc[et][dtl][2], acc[et][dtl][3]);
                    *(u32x2*)(spn + (size_t)(32 * w + 16 * et + fr) * 128 + 16 * dtl + 4 * fq) = o;
                }
        }
        LDS_BARRIER();
    }
}

__device__ __forceinline__ void ret_pass_b(const Args& a, LAS unsigned char* lds) {
    LAS bf16_t* KL = (LAS bf16_t*)lds;
    LAS bf16_t* BG = KL + 128 * LDR;
    const int tid0 = threadIdx.x;
    const bf16_t* qb = (const bf16_t*)(a.ws + OFF_Q); const bf16_t* kb = (const bf16_t*)(a.ws + OFF_K); const bf16_t* vb = (const bf16_t*)(a.ws + OFF_V);
    const bf16_t* stb = (const bf16_t*)(a.ws + OFF_ST);
    bf16_t* sg = (bf16_t*)a.out;
    u32x4 rk[4], rb[8]; bf16x8 qf[4];
    auto item_info = [&](int item, int& r0, int& h, const bf16_t*& sfp) {
        const int rc = item >> 2; h = item & 3;
        int b, n; if (rc < 512) { b = rc >> 5; n = (rc & 31) + 1; } else { b = 16 + ((rc - 512) >> 4); n = ((rc - 512) & 15) + 1; }
        const int ebase = b < 16 ? b * 33 : 528 + (b - 16) * 17; r0 = rc * 128;
        sfp = stb + ((size_t)((ebase + n) * 4 + h) * 2 + 0) * 32768;
    };
    auto load_item_head = [&](int item, int tid) {
        int r0, h; const bf16_t* sfp; item_info(item, r0, h, sfp);
#pragma unroll
        for (int it = 0; it < 8; ++it) { const int idx = tid + it * 512, e = idx >> 4, pc = idx & 15; rb[it] = *(const u32x4*)(sfp + (size_t)e * 128 + pc * 8); }
    };
    auto load_item_kq = [&](int item, int tid) {
        int r0, h; const bf16_t* sfp; item_info(item, r0, h, sfp);
        const int w = tid >> 6, lane = tid & 63, fr = lane & 15, fq = lane >> 4;
#pragma unroll
        for (int it = 0; it < 4; ++it) { const int idx = tid + it * 512, s = idx >> 4, pc = idx & 15; rk[it] = *(const u32x4*)(kb + (size_t)(r0 + s) * 512 + h * 128 + pc * 8); }
#pragma unroll
        for (int ks = 0; ks < 4; ++ks) qf[ks] = *(const bf16x8*)(qb + (size_t)(r0 + 16 * w + fr) * 512 + h * 128 + 32 * ks + 8 * fq);
    };
    if ((int)blockIdx.x < 2560) { load_item_head(blockIdx.x, tid0); load_item_kq(blockIdx.x, tid0); }
    for (int item = blockIdx.x; item < 2560; item += gridDim.x) {
        int tid = tid0; asm volatile("" : "+v"(tid));
        const int w = tid >> 6, lane = tid & 63, fr = lane & 15, fq = lane >> 4;
        int r0, h; const bf16_t* sfp; item_info(item, r0, h, sfp);
        const bf16_t* sbp = sfp + 32768;
        const float lgf = logsigf_(a.in[14][h]), lgb = logsigf_(a.in[14][4 + h]);
        const int crow = 16 * w + fr;
        LDS_BARRIER();
#pragma unroll
        for (int it = 0; it < 4; ++it) { const int idx = tid + it * 512, s = idx >> 4, pc = idx & 15; *(LAS u32x4*)(KL + s * LDR + pc * 8) = rk[it]; }
#pragma unroll
        for (int it = 0; it < 8; ++it) { const int idx = tid + it * 512, e = idx >> 4, pc = idx & 15; *(LAS u32x4*)(BG + e * LDR + pc * 8) = rb[it]; }
#pragma unroll
        for (int it = 0; it < 8; ++it) { const int idx = tid + it * 512, e = idx >> 4, pc = idx & 15; rb[it] = *(const u32x4*)(sbp + (size_t)e * 128 + pc * 8); }
        LDS_BARRIER();
        f32x4 sacc[8];
#pragma unroll
        for (int st = 0; st < 8; ++st) sacc[st] = (f32x4){0.f, 0.f, 0.f, 0.f};
#pragma unroll
        for (int ks = 0; ks < 4; ++ks)
#pragma unroll
            for (int st = 0; st < 8; ++st) {
                const bf16x8 kf = *(const LAS bf16x8*)(KL + (16 * st + fr) * LDR + 32 * ks + 8 * fq);
                sacc[st] = __builtin_amdgcn_mfma_f32_16x16x32_bf16(kf, qf[ks], sacc[st], 0, 0, 0);
                if (st == 7) __builtin_amdgcn_sched_barrier(0);
            }
        bf16x8 pf[4];
#pragma unroll
        for (int t = 0; t < 4; ++t) {
            float pv[8];
#pragma unroll
            for (int hh = 0; hh < 2; ++hh)
#pragma unroll
                for (int j = 0; j < 4; ++j) {
                    const int spp = 16 * (2 * t + hh) + 4 * fq + j, diff = crow - spp;
                    const float dec = diff >= 0 ? __expf(lgf * (float)diff) : __expf(-lgb * (float)diff);
                    pv[hh * 4 + j] = sacc[2 * t + hh][j] * dec;
                }
            u32x4 pw; pw.x = cvt_pk_bf16(pv[0], pv[1]); pw.y = cvt_pk_bf16(pv[2], pv[3]); pw.z = cvt_pk_bf16(pv[4], pv[5]); pw.w = cvt_pk_bf16(pv[6], pv[7]);
            pf[t] = __builtin_bit_cast(bf16x8, pw);
        }
        f32x4 o[16];
#pragma unroll
        for (int et = 0; et < 16; ++et) o[et] = (f32x4){0.f, 0.f, 0.f, 0.f};
#pragma unroll
        for (int ks = 0; ks < 4; ++ks)
#pragma unroll
            for (int et = 0; et < 16; ++et) {
                const bf16x8 sf = *(const LAS bf16x8*)(BG + (16 * et + fr) * LDR + 32 * ks + 8 * fq);
                o[et] = __builtin_amdgcn_mfma_f32_16x16x32_bf16(sf, qf[ks], o[et], 0, 0, 0);
                if ((et & 7) == 7) __builtin_amdgcn_sched_barrier(0);
            }
        const float wqf = __expf(lgf * (float)(crow + 1)), wqb = __expf(lgb * (float)(128 - crow));
        const float ratio = wqf / wqb;
#pragma unroll
        for (int et = 0; et < 16; ++et) o[et] = o[et] * ratio;
        LDS_BARRIER();
#pragma unroll
        for (int it = 0; it < 8; ++it) { const int idx = tid + it * 512, e = idx >> 4, pc = idx & 15; *(LAS u32x4*)(BG + e * LDR + pc * 8) = rb[it]; }
        {
            const int s2 = 2 * (8 * w + (lane & 7));
#pragma unroll
            for (int it = 0; it < 4; ++it)
#pragma unroll
                for (int r = 0; r < 2; ++r) rb[it * 2 + r] = *(const u32x4*)(vb + (size_t)(r0 + s2 + r) * 1024 + h * 256 + ((lane >> 3) + 8 * it) * 8);
        }
        LDS_BARRIER();
#pragma unroll
        for (int ks = 0; ks < 4; ++ks)
#pragma unroll
            for (int et = 0; et < 16; ++et) {
                const bf16x8 sf = *(const LAS bf16x8*)(BG + (16 * et + fr) * LDR + 32 * ks + 8 * fq);
                o[et] = __builtin_amdgcn_mfma_f32_16x16x32_bf16(sf, qf[ks], o[et], 0, 0, 0);
                if ((et & 7) == 7) __builtin_amdgcn_sched_barrier(0);
            }
#pragma unroll
        for (int et = 0; et < 16; ++et) o[et] = o[et] * wqb;
        LDS_BARRIER();
#pragma unroll
        for (int it = 0; it < 4; ++it) tr_store_pair(BG, ((lane >> 3) + 8 * it) * 8, 2 * (8 * w + (lane & 7)), rb[it * 2], rb[it * 2 + 1]);
        if (item + (int)gridDim.x < 2560) load_item_head(item + gridDim.x, tid);
        LDS_BARRIER();
#pragma unroll
        for (int t = 0; t < 4; ++t)
#pragma unroll
            for (int et = 0; et < 16; ++et) {
                const u32x2 lo = *(const LAS u32x2*)(BG + (16 * et + fr) * LDR + 32 * t + 4 * fq);
                const u32x2 hi = *(const LAS u32x2*)(BG + (16 * et + fr) * LDR + 32 * t + 16 + 4 * fq);
                const u32x4 vw = (u32x4){lo.x, lo.y, hi.x, hi.y};
                o[et] = __builtin_amdgcn_mfma_f32_16x16x32_bf16(__builtin_bit_cast(bf16x8, vw), pf[t], o[et], 0, 0, 0);
                if ((et & 7) == 7) __builtin_amdgcn_sched_barrier(0);
            }
        float ss = 0.f;
#pragma unroll
        for (int et = 0; et < 16; ++et) ss += (o[et][0] * o[et][0] + o[et][1] * o[et][1]) + (o[et][2] * o[et][2] + o[et][3] * o[et][3]);
        ss += __shfl_xor(ss, 16); ss += __shfl_xor(ss, 32);
        const float rn = rsqrtf(ss * (1.0f / 256.0f) + EPS);
        bf16_t* gp = sg + (size_t)(r0 + crow) * 1024 + h * 256 + 4 * fq;
        u32x2 gwv[16];
#pragma unroll
        for (int et = 0; et < 16; ++et) gwv[et] = *(const u32x2*)(gp + 16 * et);
        if (item + (int)gridDim.x < 2560) load_item_kq(item + gridDim.x, tid);
#pragma unroll
        for (int et = 0; et < 16; ++et) {
            const u32x2 gw = gwv[et];
            u32x2 ow; ow.x = cvt_pk_bf16(o[et][0] * rn * bflo(gw.x), o[et][1] * rn * bfhi(gw.x)); ow.y = cvt_pk_bf16(o[et][2] * rn * bflo(gw.y), o[et][3] * rn * bfhi(gw.y));
            *(u32x2*)(gp + 16 * et) = ow;
        }
    }
    LDS_BARRIER();
}

__device__ __forceinline__ void final_norm(const Args& a) {
    const int wave = threadIdx.x >> 6, lane = threadIdx.x & 63;
    const float* ssq = (const float*)(a.ws + OFF_SSQ2);
    f32x4 gg[4];
#pragma unroll
    for (int j = 0; j < 4; ++j) gg[j] = *(const f32x4*)(a.in[20] + (j * 64 + lane) * 4);
    for (int rowb = (blockIdx.x * 8 + wave) * 4; rowb < NREAL; rowb += gridDim.x * 32) {
        float part[4]; u32x2 w[4][4];
#pragma unroll
        for (int q = 0; q < 4; ++q) {
            part[q] = lane < 16 ? ssq[(size_t)(rowb + q) * 16 + lane] : 0.f;
            const bf16_t* hrow = (const bf16_t*)(a.ws + OFF_H1B) + (size_t)(rowb + q) * 1024;
#pragma unroll
            for (int j = 0; j < 4; ++j) w[q][j] = *(const u32x2*)(hrow + (j * 64 + lane) * 4);
        }
#pragma unroll
        for (int q = 0; q < 4; ++q) {
            const float rstd = rsqrtf(wave_sum(part[q]) * (1.0f / 1024.0f) + EPS);
            float* orow = a.out + (size_t)(rowb + q) * 1024;
#pragma unroll
            for (int j = 0; j < 4; ++j) {
                f32x4 v;
                v[0] = bflo(w[q][j].x) * rstd * gg[j][0]; v[1] = bfhi(w[q][j].x) * rstd * gg[j][1]; v[2] = bflo(w[q][j].y) * rstd * gg[j][2]; v[3] = bfhi(w[q][j].y) * rstd * gg[j][3];
                *(f32x4*)(orow + (j * 64 + lane) * 4) = v;
            }
        }
    }
}

template <int ph>
__device__ __forceinline__ void run_phase(const Args& a, LAS unsigned char* lds) {
    unsigned char* ws = a.ws;
    bf16_t* dob = (bf16_t*)a.out;
    bf16_t* sgp = dob; bf16_t* gap = dob + (size_t)NREAL * 1024;
#ifdef ONLY_PH
    if (ph != ONLY_PH) return;
#endif
    switch (ph) {
    case 0: phase0(a, lds); break;
    case 1: {
        pg8::Gemm g{(const bf16_t*)(ws + OFF_N1), (const bf16_t*)(ws + OFF_WIN), 1024, 1024, 1024, RPAD / 256, INW / 256, 1, 0, 0, STG};
        EpiProj E{(bf16_t*)(ws + OFF_U5), (bf16_t*)(ws + OFF_Q), (bf16_t*)(ws + OFF_K), (bf16_t*)(ws + OFF_V), sgp, gap, (bf16_t*)(ws + OFF_GB), (const LAS double*)(lds + 131072)};
        pg8::gemm_phase(lds, g, E);
    } break;
    case 2: {
        pg8::Gemm g{(const bf16_t*)(ws + OFF_U5), (const bf16_t*)(ws + OFF_BTS), LDA5, 512, 512, IT_PAD / 256, 1, 32, (size_t)IT_PAD * LDA5, (size_t)256 * 512, 0};
        EpiSloc E{(float*)(ws + OFF_SLOC)};
        pg8::gemm_phase(lds, g, E);
    } break;
    case 3: s5_scan(a); break;
    case 4: {
        pg8::Gemm g{(const bf16_t*)(ws + OFF_U5), (const bf16_t*)(ws + OFF_BTY), LDA5, 768, 768, IT_PAD / 256, 2, 32, (size_t)IT_PAD * LDA5, (size_t)512 * 768, 0};
        EpiY E{(bf16_t*)(ws + OFF_YSSM)};
        pg8::gemm_phase(lds, g, E);
    } break;
    case 5: {
        pg8::Gemm g{(const bf16_t*)(ws + OFF_YSSM), (const bf16_t*)(ws + OFF_WGLU), 512, 512, 512, NREAL / 256, 8, 1, 0, 0, STG};
        EpiGlu E{gap};
        pg8::gemm_phase(lds, g, E);
    } break;
    case 6: ret_pass_a(a, lds); break;
    case 7: ret_pass_b(a, lds); break;
    case 8: {
        pg8::Gemm g{sgp, (const bf16_t*)(ws + OFF_WRET), 1024, 1024, 1024, NREAL / 256, 4, 1, 0, 0, STG};
        EpiRet E{gap, (const bf16_t*)(ws + OFF_GB), (bf16_t*)(ws + OFF_MIXED)};
        pg8::gemm_phase(lds, g, E);
    } break;
    case 9: {
        pg8::Gemm g{(const bf16_t*)(ws + OFF_MIXED), (const bf16_t*)(ws + OFF_WOUT), 1024, 1024, 1024, NREAL / 256, 4, 1, 0, 0, STG};
        EpiRes<0> E{a.in[0], a.in[1], (bf16_t*)(ws + OFF_H1B), (float*)(ws + OFF_SSQ1)};
        pg8::gemm_phase(lds, g, E);
    } break;
    case 10: {
        pg8::Gemm g{(const bf16_t*)(ws + OFF_H1B), (const bf16_t*)(ws + OFF_WFFI), 1024, 1024, 1024, NREAL / 256, INW / 256, 1, 0, 0, STG};
        EpiFfi E{(const float*)(ws + OFF_SSQ1), (bf16_t*)(ws + OFF_ACT)};
        pg8::gemm_phase(lds, g, E);
    } break;
    case 11: {
        pg8::Gemm g{(const bf16_t*)(ws + OFF_ACT), (const bf16_t*)(ws + OFF_WFFO), DFF, DFF, DFF, NREAL / 256, 4, 1, 0, 0, STG};
        EpiRes<1> E{nullptr, nullptr, (bf16_t*)(ws + OFF_H1B), (float*)(ws + OFF_SSQ2)};
        pg8::gemm_phase(lds, g, E);
    } break;
    case 12: final_norm(a); break;
    default: break;
    }
}

__device__ __forceinline__ void grid_barrier(unsigned* ctr, unsigned target) {
    asm volatile("s_waitcnt vmcnt(0) lgkmcnt(0)" ::: "memory");
    __syncthreads();
    if (threadIdx.x == 0) {
        __builtin_amdgcn_fence(__ATOMIC_RELEASE, "agent");
        asm volatile("s_waitcnt vmcnt(0)" ::: "memory");
        __hip_atomic_fetch_add(ctr, 1u, __ATOMIC_RELAXED, __HIP_MEMORY_SCOPE_AGENT);
        unsigned spins = 0;
        while (__hip_atomic_load(ctr, __ATOMIC_RELAXED, __HIP_MEMORY_SCOPE_AGENT) < target && ++spins < (1u << 24)) __builtin_amdgcn_s_sleep(2);
        __builtin_amdgcn_fence(__ATOMIC_ACQUIRE, "agent");
        asm volatile("s_waitcnt vmcnt(0)" ::: "memory");
    }
    __syncthreads();
}

template <bool COOP>
__global__ __launch_bounds__(512, 2) void fwd_kernel(Args a) {
    extern __shared__ __attribute__((aligned(16))) unsigned char shm[];
    LAS unsigned char* lds = (LAS unsigned char*)shm;
    if (threadIdx.x < 64) ((LAS double*)(lds + 131072))[threadIdx.x] = exp2(-(double)threadIdx.x * (13.287712379549449 / 64.0));
    __syncthreads();
    if (COOP && a.ph_hi > NPHASE) cg::this_grid().sync();
#define RUN_PH(P) if (a.ph_lo <= P && P < a.ph_hi) { run_phase<P>(a, lds); if ((DBL_MASK >> P) & 1) run_phase<P>(a, lds); if (COOP && P + 1 < a.ph_hi) { grid_barrier((unsigned*)(a.ws + OFF_BAR), (unsigned)(P + 1) * gridDim.x); } }
    RUN_PH(0) RUN_PH(1) RUN_PH(2) RUN_PH(3) RUN_PH(4) RUN_PH(5) RUN_PH(6) RUN_PH(7) RUN_PH(8) RUN_PH(9) RUN_PH(10) RUN_PH(11) RUN_PH(12)
#undef RUN_PH
}

extern "C" void kernel_launch(void* const* d_in, const int* in_sizes, int n_in, void* d_out, int out_size, void* d_ws, size_t ws_size, hipStream_t stream) {
    static int grid = 0;
    if (grid == 0) {
        if (n_in != 21 || ws_size < WS_NEED || out_size != NREAL * 1024) { fprintf(stderr, "kernel_launch: unexpected shapes (n_in %d, ws %zu need %zu, out %d)\n", n_in, ws_size, (size_t)WS_NEED, out_size); grid = -1; return; }
        int dev = 0, cus = 0;
        hipGetDevice(&dev); hipDeviceGetAttribute(&cus, hipDeviceAttributeMultiprocessorCount, dev);
        hipFuncSetAttribute((const void*)fwd_kernel<true>, hipFuncAttributeMaxDynamicSharedMemorySize, LDS_BYTES);
        hipFuncSetAttribute((const void*)fwd_kernel<false>, hipFuncAttributeMaxDynamicSharedMemorySize, LDS_BYTES);
        int per_cu = 0;
        hipOccupancyMaxActiveBlocksPerMultiprocessor(&per_cu, (const void*)fwd_kernel<true>, 512, LDS_BYTES);
        if (per_cu < 1) { fprintf(stderr, "kernel_launch: occupancy query says %d blocks per CU\n", per_cu); per_cu = 1; }
        (void)hipGetLastError();
        grid = cus * 1;
    }
    if (grid < 0) return;
    Args a{};
    for (int i = 0; i < 21; ++i) a.in[i] = (const float*)d_in[i];
    a.out = (float*)d_out; a.ws = (unsigned char*)d_ws;
#if COOP_MODE
    hipMemsetAsync((char*)d_ws + OFF_BAR, 0, 256, stream);
    a.ph_lo = 0; a.ph_hi = NPHASE;
    void* args[] = {&a};
    hipError_t e = hipLaunchCooperativeKernel((const void*)fwd_kernel<true>, dim3(grid), dim3(512), args, LDS_BYTES, stream);
    if (e != hipSuccess) fprintf(stderr, "cooperative launch failed: %s (grid %d)\n", hipGetErrorString(e), grid);
#else
    for (int ph = 0; ph < NPHASE; ++ph) {
        a.ph_lo = ph; a.ph_hi = ph + 1;
        hipLaunchKernelGGL(fwd_kernel<false>, dim3(grid), dim3(512), LDS_BYTES, stream, a);
    }
#endif
}
```

```cpp
#include <hip/hip_runtime.h>
#include <hip/hip_cooperative_groups.h>
#include <cstdio>
#include <cstdint>
namespace cg = cooperative_groups;

#ifndef COOP_MODE
#define COOP_MODE 1
#endif

#define DBL_MASK 0x0
#define LAS __attribute__((address_space(3)))
typedef unsigned short bf16_t;
typedef short bf16x8 __attribute__((ext_vector_type(8)));
typedef float f32x4 __attribute__((ext_vector_type(4)));
typedef unsigned u32x4 __attribute__((ext_vector_type(4)));
typedef unsigned u32x2 __attribute__((ext_vector_type(2)));

constexpr int D = 1024, NREAL = 81920, NPR = 65536, RPAD = 82432, NVALID = 82304;
constexpr int INW = 5632, DFF = 2816;
constexpr int T5 = 32, IT_REAL = 2560, IT_PAD = 2816, LDA5 = 768;
constexpr float EPS = 1e-6f;

constexpr size_t OFF_WIN = 0;
constexpr size_t OFF_WGLU = OFF_WIN + (size_t)INW * D * 2;
constexpr size_t OFF_WRET = OFF_WGLU + (size_t)2048 * 512 * 2;
constexpr size_t OFF_WOUT = OFF_WRET + (size_t)D * D * 2;
constexpr size_t OFF_WFFI = OFF_WOUT + (size_t)D * D * 2;
constexpr size_t OFF_WFFO = OFF_WFFI + (size_t)INW * D * 2;
constexpr size_t OFF_AT = OFF_WFFO + (size_t)D * DFF * 2;
constexpr size_t OFF_BAR = OFF_AT + 32768;
constexpr size_t OFF_Q = OFF_AT + 65536;
constexpr size_t OFF_K = OFF_Q + (size_t)RPAD * 512 * 2;
constexpr size_t OFF_V = OFF_K + (size_t)RPAD * 512 * 2;
constexpr size_t OFF_GB = OFF_V + (size_t)RPAD * D * 2;
constexpr size_t OFF_SSQ1 = OFF_GB + (size_t)NREAL * D * 2;
constexpr size_t OFF_SSQ2 = OFF_SSQ1 + (size_t)NREAL * 16 * 4;
constexpr size_t OFF_X = OFF_SSQ2 + (size_t)NREAL * 16 * 4;
constexpr size_t OFF_N1 = OFF_X;
constexpr size_t OFF_YSSM = OFF_X;
constexpr size_t OFF_U5 = OFF_N1 + (size_t)RPAD * D * 2;
constexpr size_t OFF_BTY = OFF_U5 + (size_t)32 * IT_PAD * LDA5 * 2;
constexpr size_t OFF_BTS = OFF_BTY + (size_t)32 * 512 * 768 * 2;
constexpr size_t OFF_SLOC = OFF_BTS + (size_t)32 * 256 * 512 * 2;
constexpr size_t END_X03 = OFF_SLOC + (size_t)32 * IT_PAD * 256 * 4;
constexpr size_t OFF_ST = OFF_X;
constexpr size_t END_ST = OFF_ST + (size_t)664 * 8 * 65536;
constexpr size_t OFF_ACT = OFF_X;
constexpr size_t END_ACT = OFF_ACT + (size_t)NREAL * DFF * 2;
constexpr size_t OFF_MIXED = OFF_Q;
constexpr size_t OFF_H1B = OFF_V;
constexpr size_t cmax(size_t a, size_t b) { return a > b ? a : b; }
constexpr size_t WS_NEED = cmax(END_X03, cmax(END_ST, END_ACT));

constexpr int LDS_BYTES = 131072 + 1024;
constexpr int NPHASE = 13;
constexpr int STG = 0;

struct Args {
    const float* in[21];
    float* out;
    unsigned char* ws;
    int ph_lo, ph_hi;
};

__device__ __forceinline__ unsigned cvt_pk_bf16(float lo, float hi) { unsigned r; asm volatile("v_cvt_pk_bf16_f32 %0, %1, %2" : "=v"(r) : "v"(lo), "v"(hi)); return r; }
__device__ __forceinline__ bf16_t f2bf(float f) { return (bf16_t)(cvt_pk_bf16(f, 0.f) & 0xFFFFu); }
__device__ __forceinline__ float bflo(unsigned w) { return __uint_as_float(w << 16); }
__device__ __forceinline__ float bfhi(unsigned w) { return __uint_as_float(w & 0xFFFF0000u); }
__device__ __forceinline__ float sigmoidf_(float x) { return __fdividef(1.0f, 1.0f + __expf(-x)); }
__device__ __forceinline__ float siluf_(float x) { return x * sigmoidf_(x); }
__device__ __forceinline__ float gelu_tanh(float x) { const float z = 0.7978845608028654f * (x + 0.044715f * x * x * x); return x * sigmoidf_(2.0f * z); }
__device__ __forceinline__ float logsigf_(float x) { return fminf(x, 0.f) - log1pf(__expf(-fabsf(x))); }
__device__ __forceinline__ float wave_sum(float v) {
#pragma unroll
    for (int o = 1; o < 64; o <<= 1) v += __shfl_xor(v, o);
    return v;
}
__device__ __forceinline__ void sincos_rev(double ang, float& s, float& c) {
    double x = ang * 0.15915494309189535; x -= rint(x);
    const float xf = (float)x;
    s = __builtin_amdgcn_sinf(xf); c = __builtin_amdgcn_cosf(xf);
}

namespace pg8 {
constexpr int BM = 256, BK = 64, HALF = 128, HTB = HALF * BK * 2, STAGE_BYTES = 8 * HTB, NXCD = 8, WGM = 8;
__device__ __forceinline__ int lds_byte(int r, int c) { const int st = (r >> 4) * 2 + (c >> 5), rr = r & 15, cc = c & 31, ob = rr * 64 + cc * 2; return st * 1024 + (ob ^ (((ob >> 9) & 1) << 5)); }
__device__ __forceinline__ void stage_rc(int b, int& R, int& C) { const int st = b / 1024, sb = b % 1024, swz = sb ^ (((sb >> 9) & 1) << 5); R = (st >> 1) * 16 + swz / 64; C = (st & 1) * 32 + (swz % 64) / 2; }
__device__ __forceinline__ int perm32(int rho) { const int n = rho >> 4, i = rho & 15; return 8 * (i >> 2) + 4 * n + (i & 3); }

struct Unit { int pm, pn, g; };
struct Gemm { const bf16_t* A; const bf16_t* Bt; int lda, ldb, K, nM, nN, nb; size_t sA, sB; int stagger; };

struct Order {
    int nM, nN, nwg, total, G, c;
    __device__ void init(int nM_, int nN_, int nb, int G_, int c_) { nM = nM_; nN = nN_; nwg = nM * nN; total = nwg * nb; G = G_; c = c_; }
    __device__ bool next(int i, Unit& u) const {
        const long L = (long)i * G + c; if (L >= total) return false;
        u.g = (int)(L / nwg); int wgid = (int)(L % nwg);
        { const int q = nwg / NXCD, r = nwg % NXCD, xcd = wgid % NXCD, off = wgid / NXCD; wgid = (xcd < r ? xcd * (q + 1) : r * (q + 1) + (xcd - r) * q) + off; }
        const int nig = WGM * nN, gid = wgid / nig, fm = gid * WGM, gsz = (nM - fm) < WGM ? (nM - fm) : WGM;
        u.pm = fm + ((wgid % nig) % gsz); u.pn = (wgid % nig) / gsz; return true;
    }
};

template <class Epi>
__device__ __forceinline__ void gemm_phase(LAS unsigned char* lds, const Gemm g, const Epi& E) {
    const int tid = threadIdx.x, wid = __builtin_amdgcn_readfirstlane(tid >> 6), lane = tid & 63, wr = wid >> 2, wc = wid & 3, fr = lane & 15, fq = lane >> 4;
    const int K = g.K, nt = K / BK;
    Order S; S.init(g.nM, g.nN, g.nb, (int)gridDim.x, (int)blockIdx.x);
    unsigned voffA[2], voffB[2];
#pragma unroll
    for (int i = 0; i < 2; ++i) { int R, C; stage_rc(tid * 16 + i * 8192, R, C); const int Rb = (R & ~31) + perm32(R & 31);
        voffA[i] = (unsigned)(R * g.lda + C) * 2u; voffB[i] = (unsigned)(Rb * g.ldb + C) * 2u; }
    const size_t kstep = (size_t)(BK * 2);
    const size_t hstepA = (size_t)HALF * g.lda * 2, hstepB = (size_t)HALF * g.ldb * 2;
    const size_t tstepA = 2 * hstepA, tstepB = 2 * hstepB;
    const unsigned ldsw = (unsigned)wid * 1024u;
    const int aoff = lds_byte(wr * 64 + fr, fq * 8), boff = lds_byte(wc * 32 + fr, fq * 8);
#define PG8_SA(b, h) (((b) * 2 + (h)) * HTB)
#define PG8_SB(b, h) ((4 + (b) * 2 + (h)) * HTB)
#define PG8_STAGE(bufoff, gbase, voff) do { _Pragma("unroll") for (int _i = 0; _i < 2; ++_i) \
        __builtin_amdgcn_global_load_lds((const unsigned*)((const char*)(gbase) + (voff)[_i]), (LAS unsigned*)(lds + (bufoff) + ldsw + _i * 8192), 16, 0, 0); } while (0)
#define PG8_LDA(dst, b, h) do { _Pragma("unroll") for (int m = 0; m < 4; ++m) _Pragma("unroll") for (int k = 0; k < 2; ++k) dst[m][k] = *(const LAS bf16x8*)(lds + PG8_SA(b, h) + aoff + m * 2048 + k * 1024); } while (0)
#define PG8_LDB(dst, b, h) do { _Pragma("unroll") for (int n = 0; n < 2; ++n) _Pragma("unroll") for (int k = 0; k < 2; ++k) dst[n][k] = *(const LAS bf16x8*)(lds + PG8_SB(b, h) + boff + n * 2048 + k * 1024); } while (0)
#define PG8_MMA(ai, bj, At, Bt) do { __builtin_amdgcn_s_setprio(1); _Pragma("unroll") for (int m = 0; m < 4; ++m) _Pragma("unroll") for (int n = 0; n < 2; ++n) _Pragma("unroll") for (int k = 0; k < 2; ++k) \
        acc[ai][bj][m][n] = __builtin_amdgcn_mfma_f32_16x16x32_bf16(Bt[n][k], At[m][k], acc[ai][bj][m][n], 0, 0, 0); __builtin_amdgcn_s_setprio(0); } while (0)
#define PG8_WAIT_V(n) asm volatile("s_waitcnt vmcnt(" #n ")" ::: "memory")
#define PG8_WAIT_L(n) asm volatile("s_waitcnt lgkmcnt(" #n ")" ::: "memory")
#define PG8_BAR __builtin_amdgcn_s_barrier()
#define PG8_SCHED __builtin_amdgcn_sched_barrier(0)
    Unit cur, nxt; int ui = 0;
    if (!S.next(0, cur)) return;
    if (g.stagger) {
        const unsigned long long t0 = __builtin_amdgcn_s_memrealtime(), wt = (unsigned long long)((blockIdx.x & 3) * g.stagger);
        while (__builtin_amdgcn_s_memrealtime() - t0 < wt) __builtin_amdgcn_s_sleep(16);
    }
    f32x4 acc[2][2][4][2];
#pragma unroll
    for (int a = 0; a < 2; ++a)
#pragma unroll
        for (int b = 0; b < 2; ++b)
#pragma unroll
            for (int m = 0; m < 4; ++m)
#pragma unroll
                for (int n = 0; n < 2; ++n) acc[a][b][m][n] = (f32x4){0.f, 0.f, 0.f, 0.f};
    bf16x8 At[4][2], B0[2][2], B1[2][2];
    const char* cA = (const char*)g.A + ((size_t)cur.g * g.sA) * 2 + (size_t)cur.pm * tstepA;
    const char* cB = (const char*)g.Bt + ((size_t)cur.g * g.sB) * 2 + (size_t)cur.pn * tstepB;
    PG8_STAGE(PG8_SB(0, 0), cB, voffB); PG8_STAGE(PG8_SA(0, 0), cA, voffA); PG8_STAGE(PG8_SB(0, 1), cB + hstepB, voffB); PG8_STAGE(PG8_SA(0, 1), cA + hstepA, voffA);
    if (wr == 1) PG8_BAR;
    PG8_WAIT_V(4); PG8_BAR;
    PG8_STAGE(PG8_SB(1, 0), cB + kstep, voffB); PG8_STAGE(PG8_SA(1, 0), cA + kstep, voffA); PG8_STAGE(PG8_SB(1, 1), cB + hstepB + kstep, voffB);
    PG8_WAIT_V(6); PG8_BAR;
    for (;;) {
        const bool has_next = S.next(ui + 1, nxt);
        const char* nA = has_next ? (const char*)g.A + ((size_t)nxt.g * g.sA) * 2 + (size_t)nxt.pm * tstepA : cA;
        const char* nB = has_next ? (const char*)g.Bt + ((size_t)nxt.g * g.sB) * 2 + (size_t)nxt.pn * tstepB : cB;
        for (int t = 0; t < nt; t += 2) {
            const bool last = (t == nt - 2);
            const char* a1 = cA + (size_t)(t + 1) * kstep;
            const char* a2 = last ? nA : cA + (size_t)(t + 2) * kstep; const char* b2 = last ? nB : cB + (size_t)(t + 2) * kstep;
            const char* a3 = a2 + kstep; const char* b3 = b2 + kstep;
            PG8_LDB(B0, 0, 0); PG8_SCHED; PG8_LDA(At, 0, 0); PG8_STAGE(PG8_SA(1, 1), a1 + hstepA, voffA);
            PG8_WAIT_L(8); PG8_BAR; PG8_WAIT_L(0); PG8_MMA(0, 0, At, B0); PG8_BAR; PG8_SCHED;
            PG8_LDB(B1, 0, 1); PG8_STAGE(PG8_SB(0, 0), b2, voffB);
            PG8_BAR; PG8_WAIT_L(0); PG8_MMA(0, 1, At, B1); PG8_BAR;
            PG8_LDA(At, 0, 1); PG8_STAGE(PG8_SA(0, 0), a2, voffA);
            PG8_BAR; PG8_WAIT_L(0); PG8_MMA(1, 0, At, B0); PG8_BAR; PG8_SCHED;
            PG8_STAGE(PG8_SB(0, 1), b2 + hstepB, voffB);
            PG8_WAIT_V(6); PG8_BAR; PG8_MMA(1, 1, At, B1); PG8_BAR;
            PG8_LDB(B0, 1, 0); PG8_SCHED; PG8_LDA(At, 1, 0); PG8_STAGE(PG8_SA(0, 1), a2 + hstepA, voffA);
            PG8_WAIT_L(8); PG8_BAR; PG8_WAIT_L(0); PG8_MMA(0, 0, At, B0); PG8_BAR; PG8_SCHED;
            PG8_LDB(B1, 1, 1); PG8_STAGE(PG8_SB(1, 0), b3, voffB);
            PG8_BAR; PG8_WAIT_L(0); PG8_MMA(0, 1, At, B1); PG8_BAR;
            PG8_LDA(At, 1, 1); PG8_STAGE(PG8_SA(1, 0), a3, voffA);
            PG8_BAR; PG8_WAIT_L(0); PG8_MMA(1, 0, At, B0); PG8_BAR; PG8_SCHED;
            PG8_STAGE(PG8_SB(1, 1), b3 + hstepB, voffB);
            PG8_WAIT_V(6); PG8_BAR; PG8_MMA(1, 1, At, B1); PG8_BAR;
        }
        E(acc, cur, wr, wc, fr, fq);
        if (!has_next) break;
#pragma unroll
        for (int a = 0; a < 2; ++a)
#pragma unroll
            for (int b = 0; b < 2; ++b)
#pragma unroll
                for (int m = 0; m < 4; ++m)
#pragma unroll
                    for (int n = 0; n < 2; ++n) acc[a][b][m][n] = (f32x4){0.f, 0.f, 0.f, 0.f};
        cur = nxt; cA = nA; cB = nB; ++ui;
    }
    PG8_WAIT_V(0);
    if (wr == 0) PG8_BAR;
    PG8_BAR;
#undef PG8_SA
#undef PG8_SB
#undef PG8_STAGE
#undef PG8_LDA
#undef PG8_LDB
#undef PG8_MMA
#undef PG8_WAIT_V
#undef PG8_WAIT_L
#undef PG8_BAR
#undef PG8_SCHED
}
}
using pg8::Unit;
typedef const f32x4 (&AccRef)[2][2][4][2];

__device__ __forceinline__ u32x4 pack8(f32x4 a, f32x4 b) { u32x4 w; w.x = cvt_pk_bf16(a[0], a[1]); w.y = cvt_pk_bf16(a[2], a[3]); w.z = cvt_pk_bf16(b[0], b[1]); w.w = cvt_pk_bf16(b[2], b[3]); return w; }

struct EpiProj {
    bf16_t *u5, *q, *k, *v, *sg, *ga, *gb; const LAS double* ropef;
    __device__ __forceinline__ void operator()(AccRef acc, const Unit& u, int wr, int wc, int fr, int fq) const {
        const int pn = u.pn;
#pragma unroll
        for (int ai = 0; ai < 2; ++ai)
#pragma unroll
            for (int m = 0; m < 4; ++m) {
                const int row = u.pm * 256 + ai * 128 + wr * 64 + m * 16 + fr;
#pragma unroll
                for (int bj = 0; bj < 2; ++bj) {
                    const int col = pn * 256 + bj * 128 + wc * 32 + 8 * fq;
                    f32x4 v0 = acc[ai][bj][m][0], v1 = acc[ai][bj][m][1];
                    if (pn < 2) {
                        if (row < NVALID) {
                            int item, t;
                            if (row < NREAL) { item = row >> 5; t = row & 31; } else { const int mr = row - NREAL; item = IT_REAL + (mr >> 4); t = 16 + (mr & 15); }
                            const int g = col >> 4, h0 = col & 15;
                            *(u32x4*)(u5 + ((size_t)(g * IT_PAD + item) * LDA5 + t * 16 + h0)) = pack8(v0, v1);
                        }
                    } else if (pn < 6) {
                        const int cq = col - 512, isk = cq >> 9, cc = cq & 511, i0 = (cc & 127) >> 1;
                        const int pos = row < NPR ? 16 + (row & 4095) : (row < NREAL ? 16 + ((row - NPR) & 2047) : ((row - NREAL) & 15));
                        const float sc = isk ? 1.0f : 0.08838834764831845f;
                        float o[8];
#pragma unroll
                        for (int pi = 0; pi < 4; ++pi) {
                            float s, c; sincos_rev((double)pos * ropef[i0 + pi], s, c);
                            const float x1 = pi < 2 ? v0[2 * pi] : v1[2 * pi - 4], x2 = pi < 2 ? v0[2 * pi + 1] : v1[2 * pi - 3];
                            o[2 * pi] = (x1 * c - x2 * s) * sc; o[2 * pi + 1] = (x1 * s + x2 * c) * sc;
                        }
                        u32x4 w; w.x = cvt_pk_bf16(o[0], o[1]); w.y = cvt_pk_bf16(o[2], o[3]); w.z = cvt_pk_bf16(o[4], o[5]); w.w = cvt_pk_bf16(o[6], o[7]);
                        *(u32x4*)((isk ? k : q) + (size_t)row * 512 + cc) = w;
                    } else if (pn < 10) {
                        *(u32x4*)(v + (size_t)row * 1024 + (col - 1536)) = pack8(v0, v1);
                    } else if (row < NREAL) {
                        if (pn < 14) {
#pragma unroll
                            for (int j = 0; j < 4; ++j) { v0[j] = siluf_(v0[j]); v1[j] = siluf_(v1[j]); }
                            *(u32x4*)(sg + (size_t)row * 1024 + (col - 2560)) = pack8(v0, v1);
                        } else {
#pragma unroll
                            for (int j = 0; j < 4; ++j) { v0[j] = sigmoidf_(v0[j]); v1[j] = sigmoidf_(v1[j]); }
                            if (pn < 18) *(u32x4*)(ga + (size_t)row * 1024 + (col - 3584)) = pack8(v0, v1);
                            else *(u32x4*)(gb + (size_t)row * 1024 + (col - 4608)) = pack8(v0, v1);
                        }
                    }
                }
            }
    }
};

struct EpiSink {
    float* p; int flag;
    __device__ __forceinline__ void operator()(AccRef acc, const Unit& u, int wr, int wc, int fr, int fq) const {
        if (flag) {
#pragma unroll
            for (int ai = 0; ai < 2; ++ai)
#pragma unroll
                for (int m = 0; m < 4; ++m)
#pragma unroll
                    for (int bj = 0; bj < 2; ++bj) { p[(ai * 8 + m * 2 + bj) * 8 + fr] = acc[ai][bj][m][0][0] + acc[ai][bj][m][1][1]; }
        }
    }
};

struct EpiSloc {
    float* sloc;
    __device__ __forceinline__ void operator()(AccRef acc, const Unit& u, int wr, int wc, int fr, int fq) const {
#pragma unroll
        for (int ai = 0; ai < 2; ++ai)
#pragma unroll
            for (int m = 0; m < 4; ++m) {
                const int row = u.pm * 256 + ai * 128 + wr * 64 + m * 16 + fr;
#pragma unroll
                for (int bj = 0; bj < 2; ++bj) {
                    const int col = bj * 128 + wc * 32 + 8 * fq;
                    float* p = sloc + ((size_t)u.g * IT_PAD + row) * 256 + col;
                    *(f32x4*)p = acc[ai][bj][m][0]; *(f32x4*)(p + 4) = acc[ai][bj][m][1];
                }
            }
    }
};

struct EpiY {
    bf16_t* y;
    __device__ __forceinline__ void operator()(AccRef acc, const Unit& u, int wr, int wc, int fr, int fq) const {
#pragma unroll
        for (int ai = 0; ai < 2; ++ai)
#pragma unroll
            for (int m = 0; m < 4; ++m) {
                const int item = u.pm * 256 + ai * 128 + wr * 64 + m * 16 + fr;
                if (item < IT_REAL) {
#pragma unroll
                    for (int bj = 0; bj < 2; ++bj) {
                        const int col = u.pn * 256 + bj * 128 + wc * 32 + 8 * fq, to = col >> 4, ho = col & 15;
                        f32x4 v0 = acc[ai][bj][m][0], v1 = acc[ai][bj][m][1];
#pragma unroll
                        for (int j = 0; j < 4; ++j) { v0[j] = gelu_tanh(v0[j]); v1[j] = gelu_tanh(v1[j]); }
                        *(u32x4*)(y + (size_t)(item * 32 + to) * 512 + u.g * 16 + ho) = pack8(v0, v1);
                    }
                }
            }
    }
};

struct EpiGlu {
    bf16_t* ga;
    __device__ __forceinline__ void operator()(AccRef acc, const Unit& u, int wr, int wc, int fr, int fq) const {
        u32x4 gw[2][4];
#pragma unroll
        for (int ai = 0; ai < 2; ++ai)
#pragma unroll
            for (int m = 0; m < 4; ++m) {
                const int row = u.pm * 256 + ai * 128 + wr * 64 + m * 16 + fr;
                gw[ai][m] = *(const u32x4*)(ga + (size_t)row * 1024 + u.pn * 128 + wc * 32 + 8 * fq);
            }
#pragma unroll
        for (int ai = 0; ai < 2; ++ai)
#pragma unroll
            for (int m = 0; m < 4; ++m) {
                const int row = u.pm * 256 + ai * 128 + wr * 64 + m * 16 + fr;
                bf16_t* p = ga + (size_t)row * 1024 + u.pn * 128 + wc * 32 + 8 * fq;
                const u32x4 g = gw[ai][m];
                const f32x4 a0 = acc[ai][0][m][0], a1 = acc[ai][0][m][1], g0 = acc[ai][1][m][0], g1 = acc[ai][1][m][1];
                f32x4 r0, r1;
                r0[0] = bflo(g.x) * a0[0] * sigmoidf_(g0[0]); r0[1] = bfhi(g.x) * a0[1] * sigmoidf_(g0[1]);
                r0[2] = bflo(g.y) * a0[2] * sigmoidf_(g0[2]); r0[3] = bfhi(g.y) * a0[3] * sigmoidf_(g0[3]);
                r1[0] = bflo(g.z) * a1[0] * sigmoidf_(g1[0]); r1[1] = bfhi(g.z) * a1[1] * sigmoidf_(g1[1]);
                r1[2] = bflo(g.w) * a1[2] * sigmoidf_(g1[2]); r1[3] = bfhi(g.w) * a1[3] * sigmoidf_(g1[3]);
                *(u32x4*)p = pack8(r0, r1);
            }
    }
};

struct EpiRet {
    const bf16_t *pa, *gb; bf16_t* mixed;
    __device__ __forceinline__ void operator()(AccRef acc, const Unit& u, int wr, int wc, int fr, int fq) const {
#pragma unroll
        for (int ai = 0; ai < 2; ++ai) {
            u32x4 pw[4][2], gw[4][2];
#pragma unroll
            for (int m = 0; m < 4; ++m)
#pragma unroll
                for (int bj = 0; bj < 2; ++bj) {
                    const int row = u.pm * 256 + ai * 128 + wr * 64 + m * 16 + fr;
                    const size_t o = (size_t)row * 1024 + u.pn * 256 + bj * 128 + wc * 32 + 8 * fq;
                    pw[m][bj] = *(const u32x4*)(pa + o); gw[m][bj] = *(const u32x4*)(gb + o);
                }
#pragma unroll
            for (int m = 0; m < 4; ++m)
#pragma unroll
                for (int bj = 0; bj < 2; ++bj) {
                    const int row = u.pm * 256 + ai * 128 + wr * 64 + m * 16 + fr;
                    const size_t o = (size_t)row * 1024 + u.pn * 256 + bj * 128 + wc * 32 + 8 * fq;
                    const u32x4 p = pw[m][bj], g = gw[m][bj];
                    const f32x4 a0 = acc[ai][bj][m][0], a1 = acc[ai][bj][m][1];
                    f32x4 r0, r1;
                    r0[0] = bflo(p.x) + bflo(g.x) * a0[0]; r0[1] = bfhi(p.x) + bfhi(g.x) * a0[1];
                    r0[2] = bflo(p.y) + bflo(g.y) * a0[2]; r0[3] = bfhi(p.y) + bfhi(g.y) * a0[3];
                    r1[0] = bflo(p.z) + bflo(g.z) * a1[0]; r1[1] = bfhi(p.z) + bfhi(g.z) * a1[1];
                    r1[2] = bflo(p.w) + bflo(g.w) * a1[2]; r1[3] = bfhi(p.w) + bfhi(g.w) * a1[3];
                    *(u32x4*)(mixed + o) = pack8(r0, r1);
                }
            __builtin_amdgcn_sched_barrier(0);
        }
    }
};

template <int MODE>
struct EpiRes {
    const float *xp, *xs; bf16_t* hb; float* ssq;
    __device__ __forceinline__ void operator()(AccRef acc, const Unit& u, int wr, int wc, int fr, int fq) const {
#pragma unroll
        for (int ai = 0; ai < 2; ++ai) {
            f32x4 x0[4][2], x1[4][2]; u32x4 hw[4][2];
#pragma unroll
            for (int m = 0; m < 4; ++m)
#pragma unroll
                for (int bj = 0; bj < 2; ++bj) {
                    const int row = u.pm * 256 + ai * 128 + wr * 64 + m * 16 + fr, col = u.pn * 256 + bj * 128 + wc * 32 + 8 * fq;
                    if (MODE == 0) {
                        const float* src = (row < NPR ? xp + (size_t)row * 1024 : xs + (size_t)(row - NPR) * 1024) + col;
                        x0[m][bj] = *(const f32x4*)src; x1[m][bj] = *(const f32x4*)(src + 4);
                    } else hw[m][bj] = *(const u32x4*)(hb + (size_t)row * 1024 + col);
                }
#pragma unroll
            for (int m = 0; m < 4; ++m) {
                const int row = u.pm * 256 + ai * 128 + wr * 64 + m * 16 + fr;
                float ss = 0.f;
#pragma unroll
                for (int bj = 0; bj < 2; ++bj) {
                    const int col = u.pn * 256 + bj * 128 + wc * 32 + 8 * fq;
                    f32x4 h0, h1;
                    if (MODE == 0) { h0 = x0[m][bj]; h1 = x1[m][bj]; }
                    else { const u32x4 w = hw[m][bj]; h0 = (f32x4){bflo(w.x), bfhi(w.x), bflo(w.y), bfhi(w.y)}; h1 = (f32x4){bflo(w.z), bfhi(w.z), bflo(w.w), bfhi(w.w)}; }
                    h0 = h0 + acc[ai][bj][m][0]; h1 = h1 + acc[ai][bj][m][1];
                    *(u32x4*)(hb + (size_t)row * 1024 + col) = pack8(h0, h1);
                    ss += (h0[0] * h0[0] + h0[1] * h0[1]) + (h0[2] * h0[2] + h0[3] * h0[3]) + (h1[0] * h1[0] + h1[1] * h1[1]) + (h1[2] * h1[2] + h1[3] * h1[3]);
                }
                ss += __shfl_xor(ss, 16); ss += __shfl_xor(ss, 32);
                if (fq == 0) ssq[(size_t)row * 16 + u.pn * 4 + wc] = ss;
            }
            __builtin_amdgcn_sched_barrier(0);
        }
    }
};

struct EpiFfi {
    const float* ssq; bf16_t* act;
    __device__ __forceinline__ void operator()(AccRef acc, const Unit& u, int wr, int wc, int fr, int fq) const {
        f32x4 sp[2][4];
#pragma unroll
        for (int ai = 0; ai < 2; ++ai)
#pragma unroll
            for (int m = 0; m < 4; ++m) {
                const int row = u.pm * 256 + ai * 128 + wr * 64 + m * 16 + fr;
                sp[ai][m] = *(const f32x4*)(ssq + (size_t)row * 16 + 4 * fq);
            }
#pragma unroll
        for (int ai = 0; ai < 2; ++ai)
#pragma unroll
            for (int m = 0; m < 4; ++m) {
                const int row = u.pm * 256 + ai * 128 + wr * 64 + m * 16 + fr;
                float tot = (sp[ai][m][0] + sp[ai][m][1]) + (sp[ai][m][2] + sp[ai][m][3]);
                tot += __shfl_xor(tot, 16); tot += __shfl_xor(tot, 32);
                const float rstd = rsqrtf(tot * (1.0f / 1024.0f) + EPS);
                const f32x4 g0 = acc[ai][0][m][0], g1 = acc[ai][0][m][1], u0 = acc[ai][1][m][0], u1 = acc[ai][1][m][1];
                f32x4 r0, r1;
#pragma unroll
                for (int j = 0; j < 4; ++j) { r0[j] = siluf_(rstd * g0[j]) * (rstd * u0[j]); r1[j] = siluf_(rstd * g1[j]) * (rstd * u1[j]); }
                *(u32x4*)(act + (size_t)row * DFF + u.pn * 128 + wc * 32 + 8 * fq) = pack8(r0, r1);
            }
    }
};

__device__ __forceinline__ void p0_s5gen(const Args& a, LAS float* L, int g, int qd) {
    const int tid = threadIdx.x;
    LAS float* Kt = L;
    LAS float* Ap = L + 16384;
    LAS float* Bb = Ap + 33 * 64 * 2;
    LAS float* Cc = Bb + 2048;
    bf16_t* bts = (bf16_t*)(a.ws + OFF_BTS) + (size_t)g * 256 * 512;
    bf16_t* bty = (bf16_t*)(a.ws + OFF_BTY) + (size_t)g * 512 * 768;
    float* attab = (float*)(a.ws + OFF_AT);
    bf16_t* u5 = (bf16_t*)(a.ws + OFF_U5);
    if (qd == 0) for (int e = tid; e < 24 * 256; e += 512) { const int b = e >> 8, kk = e & 255; u5[((size_t)g * IT_PAD + IT_REAL + b) * LDA5 + kk] = 0; }
    for (int dir = 0; dir < 2; ++dir) {
        const int pg = dir * 32 + g;
        const double dt = exp((double)a.in[7][pg]);
        for (int idx = tid; idx < 33 * 64; idx += 512) {
            const int p = idx & 63, d = idx >> 6;
            const double lr = a.in[5][pg * 64 + p], li = a.in[6][pg * 64 + p];
            const float mag = (float)exp(lr * dt * d);
            float s, c; sincos_rev(li * dt * d, s, c);
            Ap[idx * 2] = mag * c; Ap[idx * 2 + 1] = mag * s;
            if (d == 32 && qd == 0) { attab[(pg * 64 + p) * 2] = mag * c; attab[(pg * 64 + p) * 2 + 1] = mag * s; }
        }
        for (int idx = tid; idx < 1024; idx += 512) {
            const int p = idx >> 4, h = idx & 15;
            const double lr = a.in[5][pg * 64 + p], li = a.in[6][pg * 64 + p];
            const double zr = lr * dt, zi = li * dt, mag = exp(zr);
            float sh, ch, s1, c1; sincos_rev(0.5 * zi, sh, ch); sincos_rev(zi, s1, c1);
            const double nr = mag * (-2.0 * (double)sh * (double)sh) + expm1(zr);
            const double abi = mag * (double)s1, den = lr * lr + li * li;
            const double cre = (nr * lr + abi * li) / den, cim = (abi * lr - nr * li) / den;
            const double br = a.in[8][(size_t)(pg * 64 + p) * 16 + h], bi = a.in[9][(size_t)(pg * 64 + p) * 16 + h];
            Bb[idx * 2] = (float)(cre * br - cim * bi); Bb[idx * 2 + 1] = (float)(cre * bi + cim * br);
        }
        for (int idx = tid; idx < 1024; idx += 512) {
            Cc[idx * 2] = a.in[10][(size_t)pg * 1024 + idx]; Cc[idx * 2 + 1] = a.in[11][(size_t)pg * 1024 + idx];
        }
        __syncthreads();
        for (int e = tid; e < 8192; e += 512) {
            const int d = e >> 8, ho = (e >> 4) & 15, hi = e & 15;
            float sum = 0.f;
            for (int p = 0; p < 64; ++p) {
                const float cr = Cc[(ho * 64 + p) * 2], ci = Cc[(ho * 64 + p) * 2 + 1], ar = Ap[(d * 64 + p) * 2], ai = Ap[(d * 64 + p) * 2 + 1];
                const float br = Bb[(p * 16 + hi) * 2], bi = Bb[(p * 16 + hi) * 2 + 1];
                const float car = cr * ar - ci * ai, cai = cr * ai + ci * ar;
                sum += car * br - cai * bi;
            }
            Kt[dir * 8192 + e] = sum;
        }
        for (int e = qd * 16384 + tid; e < (qd + 1) * 16384; e += 512) {
            const int k = e & 511, nn = e >> 9, c = nn >> 6, p = nn & 63, t = k >> 4, hi = k & 15;
            const int dd = dir == 0 ? (T5 - 1 - t) : t;
            const float ar = Ap[(dd * 64 + p) * 2], ai = Ap[(dd * 64 + p) * 2 + 1], br = Bb[(p * 16 + hi) * 2], bi = Bb[(p * 16 + hi) * 2 + 1];
            const float val = c ? (ar * bi + ai * br) : (ar * br - ai * bi);
            bts[(size_t)(dir * 128 + nn) * 512 + k] = f2bf(val);
        }
        for (int e = qd * 16384 + tid; e < (qd + 1) * 16384; e += 512) {
            const int kk = e & 127, n = e >> 7, c = kk >> 6, p = kk & 63, to = n >> 4, ho = n & 15;
            const int dd = dir == 0 ? (to + 1) : (T5 - to);
            const float cr = Cc[(ho * 64 + p) * 2], ci = Cc[(ho * 64 + p) * 2 + 1], ar = Ap[(dd * 64 + p) * 2], ai = Ap[(dd * 64 + p) * 2 + 1];
            const float val = c ? -(cr * ai + ci * ar) : (cr * ar - ci * ai);
            bty[(size_t)n * 768 + 512 + dir * 128 + kk] = f2bf(val);
        }
        __syncthreads();
    }
    for (int e = qd * 65536 + tid; e < (qd + 1) * 65536; e += 512) {
        const int k = e & 511, n = e >> 9, to = n >> 4, ho = n & 15, ti = k >> 4, hi = k & 15;
        float val = 0.f;
        if (to >= ti) val += Kt[((to - ti) * 16 + ho) * 16 + hi];
        if (ti >= to) val += Kt[8192 + ((ti - to) * 16 + ho) * 16 + hi];
        if (to == ti && ho == hi) val += a.in[12][g * 16 + ho];
        bty[(size_t)n * 768 + k] = f2bf(val);
    }
    __syncthreads();
}

__device__ __forceinline__ int src_col(int kind, int n) {
    if (kind == 1) { if (n >= 512 && n < 1536) { const int r = n - 512, seg = r >> 7, dp = r & 127; return 512 + seg * 128 + (dp >> 1) + 64 * (dp & 1); } return n; }
    if (kind == 2) { const int pn = n >> 8, bj = (n >> 7) & 1, cc = n & 127; return bj * 1024 + pn * 128 + cc; }
    if (kind == 3) { const int pn = n >> 8, bj = (n >> 7) & 1, cc = n & 127; return bj * DFF + pn * 128 + cc; }
    return n;
}
__device__ __forceinline__ void p0_wtile(const float* W, int K, int N, bf16_t* WT, int kind, const float* kscale, int tile2, LAS float* L) {
    const int tid = threadIdx.x, nkt = K >> 6;
    int n0[2], k0[2];
#pragma unroll
    for (int q = 0; q < 2; ++q) { const int tile = 2 * tile2 + q; n0[q] = (tile / nkt) * 64; k0[q] = (tile % nkt) * 64; }
    float v[2][8];
#pragma unroll
    for (int q = 0; q < 2; ++q)
#pragma unroll
        for (int it = 0; it < 8; ++it) {
            const int idx = tid + it * 512, kk = idx >> 6, j = idx & 63;
            v[q][it] = W[(size_t)(k0[q] + kk) * N + src_col(kind, n0[q] + j)];
        }
#pragma unroll
    for (int q = 0; q < 2; ++q)
#pragma unroll
        for (int it = 0; it < 8; ++it) {
            const int idx = tid + it * 512, kk = idx >> 6, j = idx & 63;
            float x = v[q][it];
            if (kscale) x *= kscale[k0[q] + kk];
            L[q * 4160 + kk * 65 + j] = x;
        }
    __syncthreads();
#pragma unroll
    for (int q = 0; q < 2; ++q)
#pragma unroll
        for (int it = 0; it < 4; ++it) {
            const int idx = tid + it * 512, j = idx >> 5, kp = idx & 31;
            *(unsigned*)(WT + (size_t)(n0[q] + j) * K + k0[q] + 2 * kp) = cvt_pk_bf16(L[q * 4160 + (2 * kp) * 65 + j], L[q * 4160 + (2 * kp + 1) * 65 + j]);
        }
    __syncthreads();
}

__device__ __forceinline__ void phase0(const Args& a, LAS unsigned char* lds) {
    LAS float* L = (LAS float*)lds;
    const int tid = threadIdx.x, wave = tid >> 6, lane = tid & 63;
    constexpr int T_IN = 88 * 16 / 2, T_GLU = 32 * 8 / 2, T_RET = 128, T_OUT = 128, T_FFI = 88 * 16 / 2, T_FFO = 16 * 44 / 2;
    constexpr int NW = 128 + T_IN + T_GLU + T_RET + T_OUT + T_FFI + T_FFO, NRM = RPAD / 32;
    unsigned* qctr = (unsigned*)(a.ws + OFF_BAR) + 4096;
    LAS int* qslot = (LAS int*)(lds + 131072 + 512);
    for (;;) {
        __syncthreads();
        if (tid == 0) *qslot = (int)__hip_atomic_fetch_add(qctr, 1u, __ATOMIC_RELAXED, __HIP_MEMORY_SCOPE_AGENT);
        __syncthreads();
        const int w = *qslot;
        if (w >= NW + NRM) break;
        int r = w;
        if (r < 128) { p0_s5gen(a, L, r >> 2, r & 3); continue; } r -= 128;
        if (r < T_IN) { p0_wtile(a.in[4], 1024, INW, (bf16_t*)(a.ws + OFF_WIN), 1, nullptr, r, L); continue; } r -= T_IN;
        if (r < T_GLU) { p0_wtile(a.in[13], 512, 2048, (bf16_t*)(a.ws + OFF_WGLU), 2, nullptr, r, L); continue; } r -= T_GLU;
        if (r < T_RET) { p0_wtile(a.in[15], 1024, 1024, (bf16_t*)(a.ws + OFF_WRET), 0, nullptr, r, L); continue; } r -= T_RET;
        if (r < T_OUT) { p0_wtile(a.in[16], 1024, 1024, (bf16_t*)(a.ws + OFF_WOUT), 0, nullptr, r, L); continue; } r -= T_OUT;
        if (r < T_FFI) { p0_wtile(a.in[18], 1024, INW, (bf16_t*)(a.ws + OFF_WFFI), 3, a.in[17], r, L); continue; } r -= T_FFI;
        if (r < T_FFO) { p0_wtile(a.in[19], DFF, 1024, (bf16_t*)(a.ws + OFF_WFFO), 0, nullptr, r, L); continue; } r -= T_FFO;
        const int rowb = r * 32 + wave * 4;
        const float* xr[4]; f32x4 v[4][4];
#pragma unroll
        for (int q = 0; q < 4; ++q) {
            const int row = rowb + q;
            xr[q] = row < NPR ? a.in[0] + (size_t)row * 1024 : (row < NREAL ? a.in[1] + (size_t)(row - NPR) * 1024 : a.in[2] + (size_t)((row - NREAL) & 15) * 1024);
#pragma unroll
            for (int j = 0; j < 4; ++j) v[q][j] = (row < NVALID) ? *(const f32x4*)(xr[q] + (j * 64 + lane) * 4) : (f32x4){0.f, 0.f, 0.f, 0.f};
        }
        f32x4 gg[4];
#pragma unroll
        for (int j = 0; j < 4; ++j) gg[j] = *(const f32x4*)(a.in[3] + (j * 64 + lane) * 4);
#pragma unroll
        for (int q = 0; q < 4; ++q) {
            float sq = 0.f;
#pragma unroll
            for (int j = 0; j < 4; ++j) sq += (v[q][j][0] * v[q][j][0] + v[q][j][1] * v[q][j][1]) + (v[q][j][2] * v[q][j][2] + v[q][j][3] * v[q][j][3]);
            const float rstd = rsqrtf(wave_sum(sq) * (1.0f / 1024.0f) + EPS);
            bf16_t* orow = (bf16_t*)(a.ws + OFF_N1) + (size_t)(rowb + q) * 1024;
#pragma unroll
            for (int j = 0; j < 4; ++j) {
                u32x2 o; o.x = cvt_pk_bf16(v[q][j][0] * rstd * gg[j][0], v[q][j][1] * rstd * gg[j][1]); o.y = cvt_pk_bf16(v[q][j][2] * rstd * gg[j][2], v[q][j][3] * rstd * gg[j][3]);
                *(u32x2*)(orow + (j * 64 + lane) * 4) = o;
            }
        }
    }
}

__device__ __forceinline__ void s5_scan(const Args& a) {
    const float* attab = (const float*)(a.ws + OFF_AT);
    const float* sloc = (const float*)(a.ws + OFF_SLOC);
    bf16_t* u5 = (bf16_t*)(a.ws + OFF_U5);
    for (int id = blockIdx.x * 512 + threadIdx.x; id < 24 * 32 * 2 * 64; id += gridDim.x * 512) {
        const int p = id & 63, dir = (id >> 6) & 1, g = (id >> 7) & 31, b = id >> 12;
        const float atr = attab[((dir * 32 + g) * 64 + p) * 2], ati = attab[((dir * 32 + g) * 64 + p) * 2 + 1];
        const int nck = b < 16 ? 128 : 64, base = b < 16 ? b * 128 : 2048 + (b - 16) * 64, mitem = IT_REAL + b;
        const float* sl = sloc + (size_t)g * IT_PAD * 256 + dir * 128 + p;
        bf16_t* ub = u5 + (size_t)g * IT_PAD * LDA5 + 512 + dir * 128 + p;
        float sr = 0.f, si = 0.f;
        if (dir == 0) {
            ub[(size_t)mitem * LDA5] = 0; ub[(size_t)mitem * LDA5 + 64] = 0;
            sr = sl[(size_t)mitem * 256]; si = sl[(size_t)mitem * 256 + 64];
            for (int c0 = 0; c0 < nck; c0 += 16) {
                float lr[16], li[16];
#pragma unroll
                for (int j = 0; j < 16; ++j) { lr[j] = sl[(size_t)(base + c0 + j) * 256]; li[j] = sl[(size_t)(base + c0 + j) * 256 + 64]; }
#pragma unroll
                for (int j = 0; j < 16; ++j) {
                    const size_t it = (size_t)(base + c0 + j);
                    ub[it * LDA5] = f2bf(sr); ub[it * LDA5 + 64] = f2bf(si);
                    const float nr = atr * sr - ati * si + lr[j], ni = atr * si + ati * sr + li[j];
                    sr = nr; si = ni;
                }
            }
        } else {
            for (int c0 = nck - 16; c0 >= 0; c0 -= 16) {
                float lr[16], li[16];
#pragma unroll
                for (int j = 0; j < 16; ++j) { lr[j] = sl[(size_t)(base + c0 + j) * 256]; li[j] = sl[(size_t)(base + c0 + j) * 256 + 64]; }
#pragma unroll
                for (int j = 15; j >= 0; --j) {
                    const size_t it = (size_t)(base + c0 + j);
                    ub[it * LDA5] = f2bf(sr); ub[it * LDA5 + 64] = f2bf(si);
                    const float nr = atr * sr - ati * si + lr[j], ni = atr * si + ati * sr + li[j];
                    sr = nr; si = ni;
                }
            }
            ub[(size_t)mitem * LDA5] = f2bf(sr); ub[(size_t)mitem * LDA5 + 64] = f2bf(si);
        }
    }
}

constexpr int LDR = 136;
__device__ __forceinline__ float bf2f(bf16_t h) { return __uint_as_float(((unsigned)h) << 16); }

__device__ __forceinline__ void tr_store_pair(LAS bf16_t* img, int f0, int s2, u32x4 r0, u32x4 r1) {
    LAS unsigned* p = (LAS unsigned*)(img + f0 * LDR + s2);
    p[0 * (LDR / 2)] = (r0.x & 0xFFFFu) | (r1.x << 16); p[1 * (LDR / 2)] = (r0.x >> 16) | (r1.x & 0xFFFF0000u);
    p[2 * (LDR / 2)] = (r0.y & 0xFFFFu) | (r1.y << 16); p[3 * (LDR / 2)] = (r0.y >> 16) | (r1.y & 0xFFFF0000u);
    p[4 * (LDR / 2)] = (r0.z & 0xFFFFu) | (r1.z << 16); p[5 * (LDR / 2)] = (r0.z >> 16) | (r1.z & 0xFFFF0000u);
    p[6 * (LDR / 2)] = (r0.w & 0xFFFFu) | (r1.w << 16); p[7 * (LDR / 2)] = (r0.w >> 16) | (r1.w & 0xFFFF0000u);
}
__device__ __forceinline__ void tr_store_pair_scaled(LAS bf16_t* img, int f0, int s2, u32x4 r0, u32x4 r1, float w0, float w1) {
    LAS unsigned* p = (LAS unsigned*)(img + f0 * LDR + s2);
    p[0 * (LDR / 2)] = cvt_pk_bf16(bflo(r0.x) * w0, bflo(r1.x) * w1); p[1 * (LDR / 2)] = cvt_pk_bf16(bfhi(r0.x) * w0, bfhi(r1.x) * w1);
    p[2 * (LDR / 2)] = cvt_pk_bf16(bflo(r0.y) * w0, bflo(r1.y) * w1); p[3 * (LDR / 2)] = cvt_pk_bf16(bfhi(r0.y) * w0, bfhi(r1.y) * w1);
    p[4 * (LDR / 2)] = cvt_pk_bf16(bflo(r0.z) * w0, bflo(r1.z) * w1); p[5 * (LDR / 2)] = cvt_pk_bf16(bfhi(r0.z) * w0, bfhi(r1.z) * w1);
    p[6 * (LDR / 2)] = cvt_pk_bf16(bflo(r0.w) * w0, bflo(r1.w) * w1); p[7 * (LDR / 2)] = cvt_pk_bf16(bfhi(r0.w) * w0, bfhi(r1.w) * w1);
}

#define LDS_BARRIER() do { asm volatile("s_waitcnt lgkmcnt(0)" ::: "memory"); __builtin_amdgcn_s_barrier(); asm volatile("" ::: "memory"); } while (0)
__device__ __forceinline__ void ret_pass_a(const Args& a, LAS unsigned char* lds) {
    LAS bf16_t* KT = (LAS bf16_t*)lds;
    LAS bf16_t* VT = KT + 128 * LDR;
    const int tid0 = threadIdx.x;
    const bf16_t* kb = (const bf16_t*)(a.ws + OFF_K); const bf16_t* vb = (const bf16_t*)(a.ws + OFF_V);
    bf16_t* stb = (bf16_t*)(a.ws + OFF_ST);
    for (int item = blockIdx.x; item < 192; item += gridDim.x) {
        int tid = tid0; asm volatile("" : "+v"(tid));
        const int w = tid >> 6, lane = tid & 63, fr = lane & 15, fq = lane >> 4;
        int b, h, dir;
        if (item < 128) { b = item >> 3; h = (item >> 1) & 3; dir = item & 1; } else { const int j = item - 128; b = 16 + (j >> 3); h = (j >> 1) & 3; dir = j & 1; }
        const int NC = b < 16 ? 32 : 16, rbase = b < 16 ? b * 4096 : NPR + (b - 16) * 2048, ebase = b < 16 ? b * 33 : 528 + (b - 16) * 17;
        const float lg = logsigf_(a.in[14][dir * 4 + h]);
        const float carry = __expf(lg * 128.f);
        const int s2 = 2 * (8 * w + (lane & 7)), pg = lane >> 3;
        const float wk0 = dir == 0 ? __expf(lg * (float)(127 - s2)) : __expf(lg * (float)s2);
        const float wk1 = dir == 0 ? __expf(lg * (float)(126 - s2)) : __expf(lg * (float)(s2 + 1));
        f32x4 acc[2][8];
#pragma unroll
        for (int et = 0; et < 2; ++et)
#pragma unroll
            for (int dtl = 0; dtl < 8; ++dtl) acc[et][dtl] = (f32x4){0.f, 0.f, 0.f, 0.f};
        const int nsteps = dir == 0 ? NC : NC;
        u32x4 rk[2][2], rv[4][2];
        auto load_chunk = [&](int n) {
            int row0; bool valid = true;
            if (n == 0) { valid = s2 >= 112; row0 = NREAL + b * 16 + (s2 - 112); } else row0 = rbase + (n - 1) * 128 + s2;
#pragma unroll
            for (int it = 0; it < 2; ++it)
#pragma unroll
                for (int r = 0; r < 2; ++r) {
                    rk[it][r] = (u32x4){0u, 0u, 0u, 0u};
                    if (valid) rk[it][r] = *(const u32x4*)(kb + (size_t)(row0 + r) * 512 + h * 128 + (pg + 8 * it) * 8);
                }
#pragma unroll
            for (int it = 0; it < 4; ++it)
#pragma unroll
                for (int r = 0; r < 2; ++r) {
                    rv[it][r] = (u32x4){0u, 0u, 0u, 0u};
                    if (valid) rv[it][r] = *(const u32x4*)(vb + (size_t)(row0 + r) * 1024 + h * 256 + (pg + 8 * it) * 8);
                }
        };
        load_chunk(dir == 0 ? 0 : NC);
        for (int step = 0; step < nsteps; ++step) {
            const int n = dir == 0 ? step : NC - step;
            {
                bf16_t* spn = stb + ((size_t)((ebase + n) * 4 + h) * 2 + dir) * 32768;
#pragma unroll
                for (int et = 0; et < 2; ++et)
#pragma unroll
                    for (int dtl = 0; dtl < 8; ++dtl) {
                        u32x2 o; o.x = cvt_pk_bf16(acc[et][dtl][0], acc[et][dtl][1]); o.y = cvt_pk_bf16(acc[et][dtl][2], acc[et][dtl][3]);
                        *(u32x2*)(spn + (size_t)(32 * w + 16 * et + fr) * 128 + 16 * dtl + 4 * fq) = o;
                    }
            }
            LDS_BARRIER();
#pragma unroll
            for (int it = 0; it < 2; ++it) tr_store_pair_scaled(KT, (pg + 8 * it) * 8, s2, rk[it][0], rk[it][1], wk0, wk1);
#pragma unroll
            for (int it = 0; it < 4; ++it) tr_store_pair(VT, (pg + 8 * it) * 8, s2, rv[it][0], rv[it][1]);
            if (step + 1 < nsteps) load_chunk(dir == 0 ? step + 1 : NC - step - 1);
            LDS_BARRIER();
#pragma unroll
            for (int et = 0; et < 2; ++et)
#pragma unroll
                for (int dtl = 0; dtl < 8; ++dtl) acc[et][dtl] = acc[et][dtl] * carry;
#pragma unroll
            for (int ks = 0; ks < 4; ++ks) {
                bf16x8 vf[2];
#pragma unroll
                for (int et = 0; et < 2; ++et) vf[et] = *(const LAS bf16x8*)(VT + (32 * w + 16 * et + fr) * LDR + 32 * ks + 8 * fq);
#pragma unroll
                for (int dtl = 0; dtl < 8; ++dtl) {
                    const bf16x8 kf = *(const LAS bf16x8*)(KT + (16 * dtl + fr) * LDR + 32 * ks + 8 * fq);
#pragma unroll
                    for (int et = 0; et < 2; ++et) acc[et][dtl] = __builtin_amdgcn_mfma_f32_16x16x32_bf16(kf, vf[et], acc[et][dtl], 0, 0, 0);
                }
            }
        }
        if (dir == 0) {
            bf16_t* spn = stb + ((size_t)((ebase + NC) * 4 + h) * 2 + dir) * 32768;
#pragma unroll
            for (int et = 0; et < 2; ++et)
#pragma unroll
                for (int dtl = 0; dtl < 8; ++dtl) {
                    u32x2 o; o.x = cvt_pk_bf16(acc[et][dtl][0], acc[et][dtl][1]); o.y = cvt_pk_bf16(acc[et][dtl][2], acc[et][dtl][3]);
                    *(u32x2*)(spn + (size_t)(32 * w + 16 * et + fr) * 128 + 16 * dtl + 4 * fq) = o;
                }
        }
        LDS_BARRIER();
    }
}

__device__ __forceinline__ void ret_pass_b(const Args& a, LAS unsigned char* lds) {
    LAS bf16_t* KL = (LAS bf16_t*)lds;
    LAS bf16_t* BG = KL + 128 * LDR;
    const int tid0 = threadIdx.x;
    const bf16_t* qb = (const bf16_t*)(a.ws + OFF_Q); const bf16_t* kb = (const bf16_t*)(a.ws + OFF_K); const bf16_t* vb = (const bf16_t*)(a.ws + OFF_V);
    const bf16_t* stb = (const bf16_t*)(a.ws + OFF_ST);
    bf16_t* sg = (bf16_t*)a.out;
    u32x4 rk[4], rb[8]; bf16x8 qf[4];
    auto item_info = [&](int item, int& r0, int& h, const bf16_t*& sfp) {
        const int rc = item >> 2; h = item & 3;
        int b, n; if (rc < 512) { b = rc >> 5; n = (rc & 31) + 1; } else { b = 16 + ((rc - 512) >> 4); n = ((rc - 512) & 15) + 1; }
        const int ebase = b < 16 ? b * 33 : 528 + (b - 16) * 17; r0 = rc * 128;
        sfp = stb + ((size_t)((ebase + n) * 4 + h) * 2 + 0) * 32768;
    };
    auto load_item_head = [&](int item, int tid) {
        int r0, h; const bf16_t* sfp; item_info(item, r0, h, sfp);
#pragma unroll
        for (int it = 0; it < 8; ++it) { const int idx = tid + it * 512, e = idx >> 4, pc = idx & 15; rb[it] = *(const u32x4*)(sfp + (size_t)e * 128 + pc * 8); }
    };
    auto load_item_kq = [&](int item, int tid) {
        int r0, h; const bf16_t* sfp; item_info(item, r0, h, sfp);
        const int w = tid >> 6, lane = tid & 63, fr = lane & 15, fq = lane >> 4;
#pragma unroll
        for (int it = 0; it < 4; ++it) { const int idx = tid + it * 512, s = idx >> 4, pc = idx & 15; rk[it] = *(const u32x4*)(kb + (size_t)(r0 + s) * 512 + h * 128 + pc * 8); }
#pragma unroll
        for (int ks = 0; ks < 4; ++ks) qf[ks] = *(const bf16x8*)(qb + (size_t)(r0 + 16 * w + fr) * 512 + h * 128 + 32 * ks + 8 * fq);
    };
    if ((int)blockIdx.x < 2560) { load_item_head(blockIdx.x, tid0); load_item_kq(blockIdx.x, tid0); }
    for (int item = blockIdx.x; item < 2560; item += gridDim.x) {
        int tid = tid0; asm volatile("" : "+v"(tid));
        const int w = tid >> 6, lane = tid & 63, fr = lane & 15, fq = lane >> 4;
        int r0, h; const bf16_t* sfp; item_info(item, r0, h, sfp);
        const bf16_t* sbp = sfp + 32768;
        const float lgf = logsigf_(a.in[14][h]), lgb = logsigf_(a.in[14][4 + h]);
        const int crow = 16 * w + fr;
        LDS_BARRIER();
#pragma unroll
        for (int it = 0; it < 4; ++it) { const int idx = tid + it * 512, s = idx >> 4, pc = idx & 15; *(LAS u32x4*)(KL + s * LDR + pc * 8) = rk[it]; }
#pragma unroll
        for (int it = 0; it < 8; ++it) { const int idx = tid + it * 512, e = idx >> 4, pc = idx & 15; *(LAS u32x4*)(BG + e * LDR + pc * 8) = rb[it]; }
#pragma unroll
        for (int it = 0; it < 8; ++it) { const int idx = tid + it * 512, e = idx >> 4, pc = idx & 15; rb[it] = *(const u32x4*)(sbp + (size_t)e * 128 + pc * 8); }
        LDS_BARRIER();
        f32x4 sacc[8];
#pragma unroll
        for (int st = 0; st < 8; ++st) sacc[st] = (f32x4){0.f, 0.f, 0.f, 0.f};
#pragma unroll
        for (int ks = 0; ks < 4; ++ks)
#pragma unroll
            for (int st = 0; st < 8; ++st) {
                const bf16x8 kf = *(const LAS bf16x8*)(KL + (16 * st + fr) * LDR + 32 * ks + 8 * fq);
                sacc[st] = __builtin_amdgcn_mfma_f32_16x16x32_bf16(kf, qf[ks], sacc[st], 0, 0, 0);
                if (st == 7) __builtin_amdgcn_sched_barrier(0);
            }
        bf16x8 pf[4];
#pragma unroll
        for (int t = 0; t < 4; ++t) {
            float pv[8];
#pragma unroll
            for (int hh = 0; hh < 2; ++hh)
#pragma unroll
                for (int j = 0; j < 4; ++j) {
                    const int spp = 16 * (2 * t + hh) + 4 * fq + j, diff = crow - spp;
                    const float dec = diff >= 0 ? __expf(lgf * (float)diff) : __expf(-lgb * (float)diff);
                    pv[hh * 4 + j] = sacc[2 * t + hh][j] * dec;
                }
            u32x4 pw; pw.x = cvt_pk_bf16(pv[0], pv[1]); pw.y = cvt_pk_bf16(pv[2], pv[3]); pw.z = cvt_pk_bf16(pv[4], pv[5]); pw.w = cvt_pk_bf16(pv[6], pv[7]);
            pf[t] = __builtin_bit_cast(bf16x8, pw);
        }
        f32x4 o[16];
#pragma unroll
        for (int et = 0; et < 16; ++et) o[et] = (f32x4){0.f, 0.f, 0.f, 0.f};
#pragma unroll
        for (int ks = 0; ks < 4; ++ks)
#pragma unroll
            for (int et = 0; et < 16; ++et) {
                const bf16x8 sf = *(const LAS bf16x8*)(BG + (16 * et + fr) * LDR + 32 * ks + 8 * fq);
                o[et] = __builtin_amdgcn_mfma_f32_16x16x32_bf16(sf, qf[ks], o[et], 0, 0, 0);
                if ((et & 7) == 7) __builtin_amdgcn_sched_barrier(0);
            }
        const float wqf = __expf(lgf * (float)(crow + 1)), wqb = __expf(lgb * (float)(128 - crow));
        const float ratio = wqf / wqb;
#pragma unroll
        for (int et = 0; et < 16; ++et) o[et] = o[et] * ratio;
        LDS_BARRIER();
#pragma unroll
        for (int it = 0; it < 8; ++it) { const int idx = tid + it * 512, e = idx >> 4, pc = idx & 15; *(LAS u32x4*)(BG + e * LDR + pc * 8) = rb[it]; }
        {
            const int s2 = 2 * (8 * w + (lane & 7));
#pragma unroll
            for (int it = 0; it < 4; ++it)
#pragma unroll
                for (int r = 0; r < 2; ++r) rb[it * 2 + r] = *(const u32x4*)(vb + (size_t)(r0 + s2 + r) * 1024 + h * 256 + ((lane >> 3) + 8 * it) * 8);
        }
        LDS_BARRIER();
#pragma unroll
        for (int ks = 0; ks < 4; ++ks)
#pragma unroll
            for (int et = 0; et < 16; ++et) {
                const bf16x8 sf = *(const LAS bf16x8*)(BG + (16 * et + fr) * LDR + 32 * ks + 8 * fq);
                o[et] = __builtin_amdgcn_mfma_f32_16x16x32_bf16(sf, qf[ks], o[et], 0, 0, 0);
                if ((et & 7) == 7) __builtin_amdgcn_sched_barrier(0);
            }
#pragma unroll
        for (int et = 0; et < 16; ++et) o[et] = o[et] * wqb;
        LDS_BARRIER();
#pragma unroll
        for (int it = 0; it < 4; ++it) tr_store_pair(BG, ((lane >> 3) + 8 * it) * 8, 2 * (8 * w + (lane & 7)), rb[it * 2], rb[it * 2 + 1]);
        if (item + (int)gridDim.x < 2560) load_item_head(item + gridDim.x, tid);
        LDS_BARRIER();
#pragma unroll
        for (int t = 0; t < 4; ++t)
#pragma unroll
            for (int et = 0; et < 16; ++et) {
                const u32x2 lo = *(const LAS u32x2*)(BG + (16 * et + fr) * LDR + 32 * t + 4 * fq);
                const u32x2 hi = *(const LAS u32x2*)(BG + (16 * et + fr) * LDR + 32 * t + 16 + 4 * fq);
                const u32x4 vw = (u32x4){lo.x, lo.y, hi.x, hi.y};
                o[et] = __builtin_amdgcn_mfma_f32_16x16x32_bf16(__builtin_bit_cast(bf16x8, vw), pf[t], o[et], 0, 0, 0);
                if ((et & 7) == 7) __builtin_amdgcn_sched_barrier(0);
            }
        float ss = 0.f;
#pragma unroll
        for (int et = 0; et < 16; ++et) ss += (o[et][0] * o[et][0] + o[et][1] * o[et][1]) + (o[et][2] * o[et][2] + o[et][3] * o[et][3]);
        ss += __shfl_xor(ss, 16); ss += __shfl_xor(ss, 32);
        const float rn = rsqrtf(ss * (1.0f / 256.0f) + EPS);
        bf16_t* gp = sg + (size_t)(r0 + crow) * 1024 + h * 256 + 4 * fq;
        u32x2 gwv[16];
#pragma unroll
        for (int et = 0; et < 16; ++et) gwv[et] = *(const u32x2*)(gp + 16 * et);
        if (item + (int)gridDim.x < 2560) load_item_kq(item + gridDim.x, tid);
#pragma unroll
        for (int et = 0; et < 16; ++et) {
            const u32x2 gw = gwv[et];
            u32x2 ow; ow.x = cvt_pk_bf16(o[et][0] * rn * bflo(gw.x), o[et][1] * rn * bfhi(gw.x)); ow.y = cvt_pk_bf16(o[et][2] * rn * bflo(gw.y), o[et][3] * rn * bfhi(gw.y));
            *(u32x2*)(gp + 16 * et) = ow;
        }
    }
    LDS_BARRIER();
}

__device__ __forceinline__ void final_norm(const Args& a) {
    const int wave = threadIdx.x >> 6, lane = threadIdx.x & 63;
    const float* ssq = (const float*)(a.ws + OFF_SSQ2);
    f32x4 gg[4];
#pragma unroll
    for (int j = 0; j < 4; ++j) gg[j] = *(const f32x4*)(a.in[20] + (j * 64 + lane) * 4);
    for (int rowb = (blockIdx.x * 8 + wave) * 4; rowb < NREAL; rowb += gridDim.x * 32) {
        float part[4]; u32x2 w[4][4];
#pragma unroll
        for (int q = 0; q < 4; ++q) {
            part[q] = lane < 16 ? ssq[(size_t)(rowb + q) * 16 + lane] : 0.f;
            const bf16_t* hrow = (const bf16_t*)(a.ws + OFF_H1B) + (size_t)(rowb + q) * 1024;
#pragma unroll
            for (int j = 0; j < 4; ++j) w[q][j] = *(const u32x2*)(hrow + (j * 64 + lane) * 4);
        }
#pragma unroll
        for (int q = 0; q < 4; ++q) {
            const float rstd = rsqrtf(wave_sum(part[q]) * (1.0f / 1024.0f) + EPS);
            float* orow = a.out + (size_t)(rowb + q) * 1024;
#pragma unroll
            for (int j = 0; j < 4; ++j) {
                f32x4 v;
                v[0] = bflo(w[q][j].x) * rstd * gg[j][0]; v[1] = bfhi(w[q][j].x) * rstd * gg[j][1]; v[2] = bflo(w[q][j].y) * rstd * gg[j][2]; v[3] = bfhi(w[q][j].y) * rstd * gg[j][3];
                *(f32x4*)(orow + (j * 64 + lane) * 4) = v;
            }
        }
    }
}

template <int ph>
__device__ __forceinline__ void run_phase(const Args& a, LAS unsigned char* lds) {
    unsigned char* ws = a.ws;
    bf16_t* dob = (bf16_t*)a.out;
    bf16_t* sgp = dob; bf16_t* gap = dob + (size_t)NREAL * 1024;
#ifdef ONLY_PH
    if (ph != ONLY_PH) return;
#endif
    switch (ph) {
    case 0: phase0(a, lds); break;
    case 1: {
        pg8::Gemm g{(const bf16_t*)(ws + OFF_N1), (const bf16_t*)(ws + OFF_WIN), 1024, 1024, 1024, RPAD / 256, INW / 256, 1, 0, 0, STG};
        EpiProj E{(bf16_t*)(ws + OFF_U5), (bf16_t*)(ws + OFF_Q), (bf16_t*)(ws + OFF_K), (bf16_t*)(ws + OFF_V), sgp, gap, (bf16_t*)(ws + OFF_GB), (const LAS double*)(lds + 131072)};
        pg8::gemm_phase(lds, g, E);
    } break;
    case 2: {
        pg8::Gemm g{(const bf16_t*)(ws + OFF_U5), (const bf16_t*)(ws + OFF_BTS), LDA5, 512, 512, IT_PAD / 256, 1, 32, (size_t)IT_PAD * LDA5, (size_t)256 * 512, 0};
        EpiSloc E{(float*)(ws + OFF_SLOC)};
        pg8::gemm_phase(lds, g, E);
    } break;
    case 3: s5_scan(a); break;
    case 4: {
        pg8::Gemm g{(const bf16_t*)(ws + OFF_U5), (const bf16_t*)(ws + OFF_BTY), LDA5, 768, 768, IT_PAD / 256, 2, 32, (size_t)IT_PAD * LDA5, (size_t)512 * 768, 0};
        EpiY E{(bf16_t*)(ws + OFF_YSSM)};
        pg8::gemm_phase(lds, g, E);
    } break;
    case 5: {
        pg8::Gemm g{(const bf16_t*)(ws + OFF_YSSM), (const bf16_t*)(ws + OFF_WGLU), 512, 512, 512, NREAL / 256, 8, 1, 0, 0, STG};
        EpiGlu E{gap};
        pg8::gemm_phase(lds, g, E);
    } break;
    case 6: ret_pass_a(a, lds); break;
    case 7: ret_pass_b(a, lds); break;
    case 8: {
        pg8::Gemm g{sgp, (const bf16_t*)(ws + OFF_WRET), 1024, 1024, 1024, NREAL / 256, 4, 1, 0, 0, STG};
        EpiRet E{gap, (const bf16_t*)(ws + OFF_GB), (bf16_t*)(ws + OFF_MIXED)};
        pg8::gemm_phase(lds, g, E);
    } break;
    case 9: {
        pg8::Gemm g{(const bf16_t*)(ws + OFF_MIXED), (const bf16_t*)(ws + OFF_WOUT), 1024, 1024, 1024, NREAL / 256, 4, 1, 0, 0, STG};
        EpiRes<0> E{a.in[0], a.in[1], (bf16_t*)(ws + OFF_H1B), (float*)(ws + OFF_SSQ1)};
        pg8::gemm_phase(lds, g, E);
    } break;
    case 10: {
        pg8::Gemm g{(const bf16_t*)(ws + OFF_H1B), (const bf16_t*)(ws + OFF_WFFI), 1024, 1024, 1024, NREAL / 256, INW / 256, 1, 0, 0, STG};
        EpiFfi E{(const float*)(ws + OFF_SSQ1), (bf16_t*)(ws + OFF_ACT)};
        pg8::gemm_phase(lds, g, E);
    } break;
    case 11: {
        pg8::Gemm g{(const bf16_t*)(ws + OFF_ACT), (const bf16_t*)(ws + OFF_WFFO), DFF, DFF, DFF, NREAL / 256, 4, 1, 0, 0, STG};
        EpiRes<1> E{nullptr, nullptr, (bf16_t*)(ws + OFF_H1B), (float*)(ws + OFF_SSQ2)};
        pg8::gemm_phase(lds, g, E);
    } break;
    case 12: final_norm(a); break;
    default: break;
    }
}

#define XB_TMO      128
#define XB_XCNT(j)  (256  + 64 * (j))
#define XB_XSUB(j)  (1280 + 64 * (j))
#define XB_XGEN(j)  (2304 + 64 * (j))
#define XB_TOP      3328
#define XB_TOPGEN   3392
#define XCD_BAR_WORDS 3456
#define XB_SPIN_CAP (1u << 18)

__device__ __forceinline__ unsigned xb_ld(unsigned* p)              { return __hip_atomic_load(p, __ATOMIC_RELAXED, __HIP_MEMORY_SCOPE_AGENT); }
__device__ __forceinline__ unsigned xb_add(unsigned* p, unsigned v) { return __hip_atomic_fetch_add(p, v, __ATOMIC_RELAXED, __HIP_MEMORY_SCOPE_AGENT); }
__device__ __forceinline__ unsigned xb_xcc_id() { return (unsigned)__builtin_amdgcn_s_getreg((3 << 11) | 20) & 0xFu; }
#define XB_SPIN(cond, bar) do { unsigned _sp = 0; while (cond) { __builtin_amdgcn_s_sleep(1); \
    if ((++_sp & 255u) == 0u) { if (xb_ld(&(bar)[XB_TMO])) break; if (_sp > XB_SPIN_CAP) { atomicAdd(&(bar)[XB_TMO], 1u); break; } } } } while (0)

struct XcdBarrier {
    unsigned* bar; unsigned x;
    volatile LAS unsigned* st;
};

__device__ __forceinline__ XcdBarrier xcd_barrier_post(unsigned* bar, volatile LAS unsigned* st) {
    XcdBarrier b; b.bar = bar; b.x = xb_xcc_id(); b.st = st;
    if (threadIdx.x == 0) (void)xb_add(&bar[XB_XCNT(b.x)], 1u);
    return b;
}
__device__ __forceinline__ void xcd_barrier_complete(unsigned* bar, unsigned x, unsigned& nloc, unsigned& nx) {
    const unsigned G = gridDim.x * gridDim.y * gridDim.z;
    unsigned sum, cnt, mine, sp = 0u;
    for (;;) {
        sum = 0u; cnt = 0u; mine = 0u;
#pragma unroll
        for (unsigned j = 0; j < 16; ++j) { const unsigned c = xb_ld(&bar[XB_XCNT(j)]); sum += c; cnt += (c > 0u) ? 1u : 0u; mine = (j == x) ? c : mine; }
        if (sum == G) break;
        __builtin_amdgcn_s_sleep(1);
        if ((++sp & 255u) == 0u) { if (xb_ld(&bar[XB_TMO])) break; if (sp > XB_SPIN_CAP) { atomicAdd(&bar[XB_TMO], 1u); break; } }
    }
    nloc = mine > 0u ? mine : 1u; nx = cnt > 0u ? cnt : 1u;
}

__device__ __forceinline__ void xcd_barrier(const XcdBarrier& b) {
    asm volatile("s_waitcnt vmcnt(0)" ::: "memory");
    __syncthreads();
    if (threadIdx.x == 0) {
        unsigned* bar = b.bar;
        __builtin_amdgcn_s_waitcnt(0);
        unsigned nloc = b.st[0], nx = b.st[1];
        if (nloc == 0u) { xcd_barrier_complete(bar, b.x, nloc, nx); b.st[0] = nloc; b.st[1] = nx; }
        const unsigned old = xb_add(&bar[XB_XSUB(b.x)], 1u);
        const unsigned gen = old / nloc;
        if (old + 1u == (gen + 1u) * nloc) {
            __builtin_amdgcn_fence(__ATOMIC_RELEASE, "agent");
            asm volatile("s_waitcnt vmcnt(0)" ::: "memory");
            const unsigned og = xb_add(&bar[XB_TOP], 1u);
            const unsigned tg = og / nx;
            if (og + 1u == (tg + 1u) * nx) xb_add(&bar[XB_TOPGEN], 1u);
            else XB_SPIN(xb_ld(&bar[XB_TOPGEN]) == tg, bar);
            __builtin_amdgcn_fence(__ATOMIC_ACQUIRE, "agent");
            xb_add(&bar[XB_XGEN(b.x)], 1u);
            asm volatile("s_waitcnt vmcnt(0)" ::: "memory");
        } else {
            XB_SPIN(xb_ld(&bar[XB_XGEN(b.x)]) == gen, bar);
            __builtin_amdgcn_fence(__ATOMIC_ACQUIRE, "agent");
            asm volatile("s_waitcnt vmcnt(0)" ::: "memory");
        }
    }
    __syncthreads();
}


__device__ __forceinline__ void grid_barrier(unsigned* ctr, unsigned target) {
    asm volatile("s_waitcnt vmcnt(0) lgkmcnt(0)" ::: "memory");
    __syncthreads();
    if (threadIdx.x == 0) {
        __builtin_amdgcn_fence(__ATOMIC_RELEASE, "agent");
        asm volatile("s_waitcnt vmcnt(0)" ::: "memory");
        __hip_atomic_fetch_add(ctr, 1u, __ATOMIC_RELAXED, __HIP_MEMORY_SCOPE_AGENT);
        unsigned spins = 0;
        while (__hip_atomic_load(ctr, __ATOMIC_RELAXED, __HIP_MEMORY_SCOPE_AGENT) < target && ++spins < (1u << 24)) __builtin_amdgcn_s_sleep(2);
        __builtin_amdgcn_fence(__ATOMIC_ACQUIRE, "agent");
        asm volatile("s_waitcnt vmcnt(0)" ::: "memory");
    }
    __syncthreads();
}

template <bool COOP>
__global__ __launch_bounds__(512, 2) void fwd_kernel(Args a) {
    extern __shared__ __attribute__((aligned(16))) unsigned char shm[];
    LAS unsigned char* lds = (LAS unsigned char*)shm;
    if (threadIdx.x < 64) ((LAS double*)(lds + 131072))[threadIdx.x] = exp2(-(double)threadIdx.x * (13.287712379549449 / 64.0));
    volatile LAS unsigned* xst = (volatile LAS unsigned*)(lds + 131072 + 528);
    if (threadIdx.x == 0) { xst[0] = 0u; xst[1] = 0u; }
    __syncthreads();
    XcdBarrier xb{}; if (COOP) xb = xcd_barrier_post((unsigned*)(a.ws + OFF_BAR), xst);
    if (COOP && a.ph_hi > NPHASE) cg::this_grid().sync();
#define RUN_PH(P) if (a.ph_lo <= P && P < a.ph_hi) { run_phase<P>(a, lds); if ((DBL_MASK >> P) & 1) run_phase<P>(a, lds); if (COOP && P + 1 < a.ph_hi) { xcd_barrier(xb); } }
    RUN_PH(0) RUN_PH(1) RUN_PH(2) RUN_PH(3) RUN_PH(4) RUN_PH(5) RUN_PH(6) RUN_PH(7) RUN_PH(8) RUN_PH(9) RUN_PH(10) RUN_PH(11) RUN_PH(12)
#undef RUN_PH
}

extern "C" void kernel_launch(void* const* d_in, const int* in_sizes, int n_in, void* d_out, int out_size, void* d_ws, size_t ws_size, hipStream_t stream) {
    static int grid = 0;
    if (grid == 0) {
        if (n_in != 21 || ws_size < WS_NEED || out_size != NREAL * 1024) { fprintf(stderr, "kernel_launch: unexpected shapes (n_in %d, ws %zu need %zu, out %d)\n", n_in, ws_size, (size_t)WS_NEED, out_size); grid = -1; return; }
        int dev = 0, cus = 0;
        hipGetDevice(&dev); hipDeviceGetAttribute(&cus, hipDeviceAttributeMultiprocessorCount, dev);
        hipFuncSetAttribute((const void*)fwd_kernel<true>, hipFuncAttributeMaxDynamicSharedMemorySize, LDS_BYTES);
        hipFuncSetAttribute((const void*)fwd_kernel<false>, hipFuncAttributeMaxDynamicSharedMemorySize, LDS_BYTES);
        int per_cu = 0;
        hipOccupancyMaxActiveBlocksPerMultiprocessor(&per_cu, (const void*)fwd_kernel<true>, 512, LDS_BYTES);
        if (per_cu < 1) { fprintf(stderr, "kernel_launch: occupancy query says %d blocks per CU\n", per_cu); per_cu = 1; }
        (void)hipGetLastError();
        grid = cus * 1;
    }
    if (grid < 0) return;
    Args a{};
    for (int i = 0; i < 21; ++i) a.in[i] = (const float*)d_in[i];
    a.out = (float*)d_out; a.ws = (unsigned char*)d_ws;
#if COOP_MODE
    hipMemsetAsync((char*)d_ws + OFF_BAR, 0, 4096 * 4 + 256, stream);
    a.ph_lo = 0; a.ph_hi = NPHASE;
    void* args[] = {&a};
    hipError_t e = hipLaunchCooperativeKernel((const void*)fwd_kernel<true>, dim3(grid), dim3(512), args, LDS_BYTES, stream);
    if (e != hipSuccess) fprintf(stderr, "cooperative launch failed: %s (grid %d)\n", hipGetErrorString(e), grid);
#else
    for (int ph = 0; ph < NPHASE; ++ph) {
        a.ph_lo = ph; a.ph_hi = ph + 1;
        hipLaunchKernelGGL(fwd_kernel<false>, dim3(grid), dim3(512), LDS_BYTES, stream, a);
    }
#endif
}
```

```cpp
#include <hip/hip_runtime.h>
#include <hip/hip_cooperative_groups.h>
#include <cstdio>
#include <cstdint>
namespace cg = cooperative_groups;

#ifndef COOP_MODE
#define COOP_MODE 1
#endif

#define DBL_MASK 0x0
#define LAS __attribute__((address_space(3)))
typedef unsigned short bf16_t;
typedef short bf16x8 __attribute__((ext_vector_type(8)));
typedef float f32x4 __attribute__((ext_vector_type(4)));
typedef unsigned u32x4 __attribute__((ext_vector_type(4)));
typedef unsigned u32x2 __attribute__((ext_vector_type(2)));

constexpr int D = 1024, NREAL = 81920, NPR = 65536, RPAD = 82432, NVALID = 82304;
constexpr int INW = 5632, DFF = 2816;
constexpr int T5 = 32, IT_REAL = 2560, IT_PAD = 2816, LDA5 = 768;
constexpr float EPS = 1e-6f;

constexpr size_t OFF_WIN = 0;
constexpr size_t OFF_WGLU = OFF_WIN + (size_t)INW * D * 2;
constexpr size_t OFF_WRET = OFF_WGLU + (size_t)2048 * 512 * 2;
constexpr size_t OFF_WOUT = OFF_WRET + (size_t)D * D * 2;
constexpr size_t OFF_WFFI = OFF_WOUT + (size_t)D * D * 2;
constexpr size_t OFF_WFFO = OFF_WFFI + (size_t)INW * D * 2;
constexpr size_t OFF_AT = OFF_WFFO + (size_t)D * DFF * 2;
constexpr size_t OFF_BAR = OFF_AT + 32768;
constexpr size_t OFF_Q = OFF_AT + 65536;
constexpr size_t OFF_K = OFF_Q + (size_t)RPAD * 512 * 2;
constexpr size_t OFF_V = OFF_K + (size_t)RPAD * 512 * 2;
constexpr size_t OFF_GB = OFF_V + (size_t)RPAD * D * 2;
constexpr size_t OFF_SSQ1 = OFF_GB + (size_t)NREAL * D * 2;
constexpr size_t OFF_SSQ2 = OFF_SSQ1 + (size_t)NREAL * 16 * 4;
constexpr size_t OFF_X = OFF_SSQ2 + (size_t)NREAL * 16 * 4;
constexpr size_t OFF_N1 = OFF_X;
constexpr size_t OFF_YSSM = OFF_X + (size_t)664 * 8 * 65536;
constexpr size_t OFF_U5 = OFF_N1 + (size_t)RPAD * D * 2;
constexpr size_t OFF_BTY = OFF_U5 + (size_t)32 * IT_PAD * LDA5 * 2;
constexpr size_t OFF_BTS = OFF_BTY + (size_t)32 * 512 * 768 * 2;
constexpr size_t OFF_SLOC = OFF_BTS + (size_t)32 * 256 * 512 * 2;
constexpr size_t END_X03 = OFF_SLOC + (size_t)32 * IT_PAD * 256 * 4;
constexpr size_t OFF_ST = OFF_X;
constexpr size_t END_ST = OFF_ST + (size_t)664 * 8 * 65536;
constexpr size_t OFF_ACT = OFF_X;
constexpr size_t END_ACT = OFF_ACT + (size_t)NREAL * DFF * 2;
constexpr size_t OFF_MIXED = OFF_Q;
constexpr size_t OFF_H1B = OFF_V;
constexpr size_t cmax(size_t a, size_t b) { return a > b ? a : b; }
constexpr size_t WS_NEED = cmax(END_X03, cmax(END_ST, END_ACT));

constexpr int LDS_BYTES = 131072 + 1024;
constexpr int NPHASE = 13;
constexpr int GLU_SPLIT = 64 * 14;
constexpr int STG = 0;

struct Args {
    const float* in[21];
    float* out;
    unsigned char* ws;
    int ph_lo, ph_hi;
};

__device__ __forceinline__ unsigned cvt_pk_bf16(float lo, float hi) { unsigned r; asm volatile("v_cvt_pk_bf16_f32 %0, %1, %2" : "=v"(r) : "v"(lo), "v"(hi)); return r; }
__device__ __forceinline__ bf16_t f2bf(float f) { return (bf16_t)(cvt_pk_bf16(f, 0.f) & 0xFFFFu); }
__device__ __forceinline__ float bflo(unsigned w) { return __uint_as_float(w << 16); }
__device__ __forceinline__ float bfhi(unsigned w) { return __uint_as_float(w & 0xFFFF0000u); }
__device__ __forceinline__ float sigmoidf_(float x) { return __fdividef(1.0f, 1.0f + __expf(-x)); }
__device__ __forceinline__ float siluf_(float x) { return x * sigmoidf_(x); }
__device__ __forceinline__ float gelu_tanh(float x) { const float z = 0.7978845608028654f * (x + 0.044715f * x * x * x); return x * sigmoidf_(2.0f * z); }
__device__ __forceinline__ float logsigf_(float x) { return fminf(x, 0.f) - log1pf(__expf(-fabsf(x))); }
__device__ __forceinline__ float wave_sum(float v) {
#pragma unroll
    for (int o = 1; o < 64; o <<= 1) v += __shfl_xor(v, o);
    return v;
}
__device__ __forceinline__ void sincos_rev(double ang, float& s, float& c) {
    double x = ang * 0.15915494309189535; x -= rint(x);
    const float xf = (float)x;
    s = __builtin_amdgcn_sinf(xf); c = __builtin_amdgcn_cosf(xf);
}

namespace pg8 {
constexpr int BM = 256, BK = 64, HALF = 128, HTB = HALF * BK * 2, STAGE_BYTES = 8 * HTB, NXCD = 8, WGM = 8;
__device__ __forceinline__ int lds_byte(int r, int c) { const int st = (r >> 4) * 2 + (c >> 5), rr = r & 15, cc = c & 31, ob = rr * 64 + cc * 2; return st * 1024 + (ob ^ (((ob >> 9) & 1) << 5)); }
__device__ __forceinline__ void stage_rc(int b, int& R, int& C) { const int st = b / 1024, sb = b % 1024, swz = sb ^ (((sb >> 9) & 1) << 5); R = (st >> 1) * 16 + swz / 64; C = (st & 1) * 32 + (swz % 64) / 2; }
__device__ __forceinline__ int perm32(int rho) { const int n = rho >> 4, i = rho & 15; return 8 * (i >> 2) + 4 * n + (i & 3); }

struct Unit { int pm, pn, g; };
struct Gemm { const bf16_t* A; const bf16_t* Bt; int lda, ldb, K, nM, nN, nb; size_t sA, sB; int stagger; int G, c, u0, u1; };

struct Order {
    int nM, nN, nwg, total, G, c, u0;
    __device__ void init(int nM_, int nN_, int nb, int G_, int c_, int u0_, int u1_) { nM = nM_; nN = nN_; nwg = nM * nN; total = u1_ > 0 ? u1_ : nwg * nb; G = G_; c = c_; u0 = u0_; }
    __device__ bool next(int i, Unit& u) const {
        const long L = (long)u0 + (long)i * G + c; if (L >= total) return false;
        u.g = (int)(L / nwg); int wgid = (int)(L % nwg);
        { const int q = nwg / NXCD, r = nwg % NXCD, xcd = wgid % NXCD, off = wgid / NXCD; wgid = (xcd < r ? xcd * (q + 1) : r * (q + 1) + (xcd - r) * q) + off; }
        const int nig = WGM * nN, gid = wgid / nig, fm = gid * WGM, gsz = (nM - fm) < WGM ? (nM - fm) : WGM;
        u.pm = fm + ((wgid % nig) % gsz); u.pn = (wgid % nig) / gsz; return true;
    }
};

template <class Epi>
__device__ __forceinline__ void gemm_phase(LAS unsigned char* lds, const Gemm g, const Epi& E) {
    const int tid = threadIdx.x, wid = __builtin_amdgcn_readfirstlane(tid >> 6), lane = tid & 63, wr = wid >> 2, wc = wid & 3, fr = lane & 15, fq = lane >> 4;
    const int K = g.K, nt = K / BK;
    Order S; S.init(g.nM, g.nN, g.nb, g.G > 0 ? g.G : (int)gridDim.x, g.G > 0 ? g.c : (int)blockIdx.x, g.u0, g.u1);
    unsigned voffA[2], voffB[2];
#pragma unroll
    for (int i = 0; i < 2; ++i) { int R, C; stage_rc(tid * 16 + i * 8192, R, C); const int Rb = (R & ~31) + perm32(R & 31);
        voffA[i] = (unsigned)(R * g.lda + C) * 2u; voffB[i] = (unsigned)(Rb * g.ldb + C) * 2u; }
    const size_t kstep = (size_t)(BK * 2);
    const size_t hstepA = (size_t)HALF * g.lda * 2, hstepB = (size_t)HALF * g.ldb * 2;
    const size_t tstepA = 2 * hstepA, tstepB = 2 * hstepB;
    const unsigned ldsw = (unsigned)wid * 1024u;
    const int aoff = lds_byte(wr * 64 + fr, fq * 8), boff = lds_byte(wc * 32 + fr, fq * 8);
#define PG8_SA(b, h) (((b) * 2 + (h)) * HTB)
#define PG8_SB(b, h) ((4 + (b) * 2 + (h)) * HTB)
#define PG8_STAGE(bufoff, gbase, voff) do { _Pragma("unroll") for (int _i = 0; _i < 2; ++_i) \
        __builtin_amdgcn_global_load_lds((const unsigned*)((const char*)(gbase) + (voff)[_i]), (LAS unsigned*)(lds + (bufoff) + ldsw + _i * 8192), 16, 0, 0); } while (0)
#define PG8_LDA(dst, b, h) do { _Pragma("unroll") for (int m = 0; m < 4; ++m) _Pragma("unroll") for (int k = 0; k < 2; ++k) dst[m][k] = *(const LAS bf16x8*)(lds + PG8_SA(b, h) + aoff + m * 2048 + k * 1024); } while (0)
#define PG8_LDB(dst, b, h) do { _Pragma("unroll") for (int n = 0; n < 2; ++n) _Pragma("unroll") for (int k = 0; k < 2; ++k) dst[n][k] = *(const LAS bf16x8*)(lds + PG8_SB(b, h) + boff + n * 2048 + k * 1024); } while (0)
#define PG8_MMA(ai, bj, At, Bt) do { __builtin_amdgcn_s_setprio(1); _Pragma("unroll") for (int m = 0; m < 4; ++m) _Pragma("unroll") for (int n = 0; n < 2; ++n) _Pragma("unroll") for (int k = 0; k < 2; ++k) \
        acc[ai][bj][m][n] = __builtin_amdgcn_mfma_f32_16x16x32_bf16(Bt[n][k], At[m][k], acc[ai][bj][m][n], 0, 0, 0); __builtin_amdgcn_s_setprio(0); } while (0)
#define PG8_WAIT_V(n) asm volatile("s_waitcnt vmcnt(" #n ")" ::: "memory")
#define PG8_WAIT_L(n) asm volatile("s_waitcnt lgkmcnt(" #n ")" ::: "memory")
#define PG8_BAR __builtin_amdgcn_s_barrier()
#define PG8_SCHED __builtin_amdgcn_sched_barrier(0)
    Unit cur, nxt; int ui = 0;
    if (!S.next(0, cur)) return;
    if (g.stagger) {
        const unsigned long long t0 = __builtin_amdgcn_s_memrealtime(), wt = (unsigned long long)((blockIdx.x & 3) * g.stagger);
        while (__builtin_amdgcn_s_memrealtime() - t0 < wt) __builtin_amdgcn_s_sleep(16);
    }
    f32x4 acc[2][2][4][2];
#pragma unroll
    for (int a = 0; a < 2; ++a)
#pragma unroll
        for (int b = 0; b < 2; ++b)
#pragma unroll
            for (int m = 0; m < 4; ++m)
#pragma unroll
                for (int n = 0; n < 2; ++n) acc[a][b][m][n] = (f32x4){0.f, 0.f, 0.f, 0.f};
    bf16x8 At[4][2], B0[2][2], B1[2][2];
    const char* cA = (const char*)g.A + ((size_t)cur.g * g.sA) * 2 + (size_t)cur.pm * tstepA;
    const char* cB = (const char*)g.Bt + ((size_t)cur.g * g.sB) * 2 + (size_t)cur.pn * tstepB;
    PG8_STAGE(PG8_SB(0, 0), cB, voffB); PG8_STAGE(PG8_SA(0, 0), cA, voffA); PG8_STAGE(PG8_SB(0, 1), cB + hstepB, voffB); PG8_STAGE(PG8_SA(0, 1), cA + hstepA, voffA);
    if (wr == 1) PG8_BAR;
    PG8_WAIT_V(4); PG8_BAR;
    PG8_STAGE(PG8_SB(1, 0), cB + kstep, voffB); PG8_STAGE(PG8_SA(1, 0), cA + kstep, voffA); PG8_STAGE(PG8_SB(1, 1), cB + hstepB + kstep, voffB);
    PG8_WAIT_V(6); PG8_BAR;
    for (;;) {
        const bool has_next = S.next(ui + 1, nxt);
        const char* nA = has_next ? (const char*)g.A + ((size_t)nxt.g * g.sA) * 2 + (size_t)nxt.pm * tstepA : cA;
        const char* nB = has_next ? (const char*)g.Bt + ((size_t)nxt.g * g.sB) * 2 + (size_t)nxt.pn * tstepB : cB;
        for (int t = 0; t < nt; t += 2) {
            const bool last = (t == nt - 2);
            const char* a1 = cA + (size_t)(t + 1) * kstep;
            const char* a2 = last ? nA : cA + (size_t)(t + 2) * kstep; const char* b2 = last ? nB : cB + (size_t)(t + 2) * kstep;
            const char* a3 = a2 + kstep; const char* b3 = b2 + kstep;
            PG8_LDB(B0, 0, 0); PG8_SCHED; PG8_LDA(At, 0, 0); PG8_STAGE(PG8_SA(1, 1), a1 + hstepA, voffA);
            PG8_WAIT_L(8); PG8_BAR; PG8_WAIT_L(0); PG8_MMA(0, 0, At, B0); PG8_BAR; PG8_SCHED;
            PG8_LDB(B1, 0, 1); PG8_STAGE(PG8_SB(0, 0), b2, voffB);
            PG8_BAR; PG8_WAIT_L(0); PG8_MMA(0, 1, At, B1); PG8_BAR;
            PG8_LDA(At, 0, 1); PG8_STAGE(PG8_SA(0, 0), a2, voffA);
            PG8_BAR; PG8_WAIT_L(0); PG8_MMA(1, 0, At, B0); PG8_BAR; PG8_SCHED;
            PG8_STAGE(PG8_SB(0, 1), b2 + hstepB, voffB);
            PG8_WAIT_V(6); PG8_BAR; PG8_MMA(1, 1, At, B1); PG8_BAR;
            PG8_LDB(B0, 1, 0); PG8_SCHED; PG8_LDA(At, 1, 0); PG8_STAGE(PG8_SA(0, 1), a2 + hstepA, voffA);
            PG8_WAIT_L(8); PG8_BAR; PG8_WAIT_L(0); PG8_MMA(0, 0, At, B0); PG8_BAR; PG8_SCHED;
            PG8_LDB(B1, 1, 1); PG8_STAGE(PG8_SB(1, 0), b3, voffB);
            PG8_BAR; PG8_WAIT_L(0); PG8_MMA(0, 1, At, B1); PG8_BAR;
            PG8_LDA(At, 1, 1); PG8_STAGE(PG8_SA(1, 0), a3, voffA);
            PG8_BAR; PG8_WAIT_L(0); PG8_MMA(1, 0, At, B0); PG8_BAR; PG8_SCHED;
            PG8_STAGE(PG8_SB(1, 1), b3 + hstepB, voffB);
            PG8_WAIT_V(6); PG8_BAR; PG8_MMA(1, 1, At, B1); PG8_BAR;
        }
        E(acc, cur, wr, wc, fr, fq);
        if (!has_next) break;
#pragma unroll
        for (int a = 0; a < 2; ++a)
#pragma unroll
            for (int b = 0; b < 2; ++b)
#pragma unroll
                for (int m = 0; m < 4; ++m)
#pragma unroll
                    for (int n = 0; n < 2; ++n) acc[a][b][m][n] = (f32x4){0.f, 0.f, 0.f, 0.f};
        cur = nxt; cA = nA; cB = nB; ++ui;
    }
    PG8_WAIT_V(0);
    if (wr == 0) PG8_BAR;
    PG8_BAR;
#undef PG8_SA
#undef PG8_SB
#undef PG8_STAGE
#undef PG8_LDA
#undef PG8_LDB
#undef PG8_MMA
#undef PG8_WAIT_V
#undef PG8_WAIT_L
#undef PG8_BAR
#undef PG8_SCHED
}
}
using pg8::Unit;
typedef const f32x4 (&AccRef)[2][2][4][2];

__device__ __forceinline__ u32x4 pack8(f32x4 a, f32x4 b) { u32x4 w; w.x = cvt_pk_bf16(a[0], a[1]); w.y = cvt_pk_bf16(a[2], a[3]); w.z = cvt_pk_bf16(b[0], b[1]); w.w = cvt_pk_bf16(b[2], b[3]); return w; }

struct EpiProj {
    bf16_t *u5, *q, *k, *v, *sg, *ga, *gb; const LAS double* ropef;
    __device__ __forceinline__ void operator()(AccRef acc, const Unit& u, int wr, int wc, int fr, int fq) const {
        const int pn = u.pn;
#pragma unroll
        for (int ai = 0; ai < 2; ++ai)
#pragma unroll
            for (int m = 0; m < 4; ++m) {
                const int row = u.pm * 256 + ai * 128 + wr * 64 + m * 16 + fr;
#pragma unroll
                for (int bj = 0; bj < 2; ++bj) {
                    const int col = pn * 256 + bj * 128 + wc * 32 + 8 * fq;
                    f32x4 v0 = acc[ai][bj][m][0], v1 = acc[ai][bj][m][1];
                    if (pn < 2) {
                        if (row < NVALID) {
                            int item, t;
                            if (row < NREAL) { item = row >> 5; t = row & 31; } else { const int mr = row - NREAL; item = IT_REAL + (mr >> 4); t = 16 + (mr & 15); }
                            const int g = col >> 4, h0 = col & 15;
                            *(u32x4*)(u5 + ((size_t)(g * IT_PAD + item) * LDA5 + t * 16 + h0)) = pack8(v0, v1);
                        }
                    } else if (pn < 6) {
                        const int cq = col - 512, isk = cq >> 9, cc = cq & 511, i0 = (cc & 127) >> 1;
                        const int pos = row < NPR ? 16 + (row & 4095) : (row < NREAL ? 16 + ((row - NPR) & 2047) : ((row - NREAL) & 15));
                        const float sc = isk ? 1.0f : 0.08838834764831845f;
                        float o[8];
#pragma unroll
                        for (int pi = 0; pi < 4; ++pi) {
                            float s, c; sincos_rev((double)pos * ropef[i0 + pi], s, c);
                            const float x1 = pi < 2 ? v0[2 * pi] : v1[2 * pi - 4], x2 = pi < 2 ? v0[2 * pi + 1] : v1[2 * pi - 3];
                            o[2 * pi] = (x1 * c - x2 * s) * sc; o[2 * pi + 1] = (x1 * s + x2 * c) * sc;
                        }
                        u32x4 w; w.x = cvt_pk_bf16(o[0], o[1]); w.y = cvt_pk_bf16(o[2], o[3]); w.z = cvt_pk_bf16(o[4], o[5]); w.w = cvt_pk_bf16(o[6], o[7]);
                        *(u32x4*)((isk ? k : q) + (size_t)row * 512 + cc) = w;
                    } else if (pn < 10) {
                        *(u32x4*)(v + (size_t)row * 1024 + (col - 1536)) = pack8(v0, v1);
                    } else if (row < NREAL) {
                        if (pn < 14) {
#pragma unroll
                            for (int j = 0; j < 4; ++j) { v0[j] = siluf_(v0[j]); v1[j] = siluf_(v1[j]); }
                            *(u32x4*)(sg + (size_t)row * 1024 + (col - 2560)) = pack8(v0, v1);
                        } else {
#pragma unroll
                            for (int j = 0; j < 4; ++j) { v0[j] = sigmoidf_(v0[j]); v1[j] = sigmoidf_(v1[j]); }
                            if (pn < 18) *(u32x4*)(ga + (size_t)row * 1024 + (col - 3584)) = pack8(v0, v1);
                            else *(u32x4*)(gb + (size_t)row * 1024 + (col - 4608)) = pack8(v0, v1);
                        }
                    }
                }
            }
    }
};

struct EpiSink {
    float* p; int flag;
    __device__ __forceinline__ void operator()(AccRef acc, const Unit& u, int wr, int wc, int fr, int fq) const {
        if (flag) {
#pragma unroll
            for (int ai = 0; ai < 2; ++ai)
#pragma unroll
                for (int m = 0; m < 4; ++m)
#pragma unroll
                    for (int bj = 0; bj < 2; ++bj) { p[(ai * 8 + m * 2 + bj) * 8 + fr] = acc[ai][bj][m][0][0] + acc[ai][bj][m][1][1]; }
        }
    }
};

struct EpiSloc {
    float* sloc;
    __device__ __forceinline__ void operator()(AccRef acc, const Unit& u, int wr, int wc, int fr, int fq) const {
#pragma unroll
        for (int ai = 0; ai < 2; ++ai)
#pragma unroll
            for (int m = 0; m < 4; ++m) {
                const int row = u.pm * 256 + ai * 128 + wr * 64 + m * 16 + fr;
#pragma unroll
                for (int bj = 0; bj < 2; ++bj) {
                    const int col = bj * 128 + wc * 32 + 8 * fq;
                    float* p = sloc + ((size_t)u.g * IT_PAD + row) * 256 + col;
                    *(f32x4*)p = acc[ai][bj][m][0]; *(f32x4*)(p + 4) = acc[ai][bj][m][1];
                }
            }
    }
};

struct EpiY {
    bf16_t* y;
    __device__ __forceinline__ void operator()(AccRef acc, const Unit& u, int wr, int wc, int fr, int fq) const {
#pragma unroll
        for (int ai = 0; ai < 2; ++ai)
#pragma unroll
            for (int m = 0; m < 4; ++m) {
                const int item = u.pm * 256 + ai * 128 + wr * 64 + m * 16 + fr;
                if (item < IT_REAL) {
#pragma unroll
                    for (int bj = 0; bj < 2; ++bj) {
                        const int col = u.pn * 256 + bj * 128 + wc * 32 + 8 * fq, to = col >> 4, ho = col & 15;
                        f32x4 v0 = acc[ai][bj][m][0], v1 = acc[ai][bj][m][1];
#pragma unroll
                        for (int j = 0; j < 4; ++j) { v0[j] = gelu_tanh(v0[j]); v1[j] = gelu_tanh(v1[j]); }
                        *(u32x4*)(y + (size_t)(item * 32 + to) * 512 + u.g * 16 + ho) = pack8(v0, v1);
                    }
                }
            }
    }
};

struct EpiGlu {
    bf16_t* ga;
    __device__ __forceinline__ void operator()(AccRef acc, const Unit& u, int wr, int wc, int fr, int fq) const {
        u32x4 gw[2][4];
#pragma unroll
        for (int ai = 0; ai < 2; ++ai)
#pragma unroll
            for (int m = 0; m < 4; ++m) {
                const int row = u.pm * 256 + ai * 128 + wr * 64 + m * 16 + fr;
                gw[ai][m] = *(const u32x4*)(ga + (size_t)row * 1024 + u.pn * 128 + wc * 32 + 8 * fq);
            }
#pragma unroll
        for (int ai = 0; ai < 2; ++ai)
#pragma unroll
            for (int m = 0; m < 4; ++m) {
                const int row = u.pm * 256 + ai * 128 + wr * 64 + m * 16 + fr;
                bf16_t* p = ga + (size_t)row * 1024 + u.pn * 128 + wc * 32 + 8 * fq;
                const u32x4 g = gw[ai][m];
                const f32x4 a0 = acc[ai][0][m][0], a1 = acc[ai][0][m][1], g0 = acc[ai][1][m][0], g1 = acc[ai][1][m][1];
                f32x4 r0, r1;
                r0[0] = bflo(g.x) * a0[0] * sigmoidf_(g0[0]); r0[1] = bfhi(g.x) * a0[1] * sigmoidf_(g0[1]);
                r0[2] = bflo(g.y) * a0[2] * sigmoidf_(g0[2]); r0[3] = bfhi(g.y) * a0[3] * sigmoidf_(g0[3]);
                r1[0] = bflo(g.z) * a1[0] * sigmoidf_(g1[0]); r1[1] = bfhi(g.z) * a1[1] * sigmoidf_(g1[1]);
                r1[2] = bflo(g.w) * a1[2] * sigmoidf_(g1[2]); r1[3] = bfhi(g.w) * a1[3] * sigmoidf_(g1[3]);
                *(u32x4*)p = pack8(r0, r1);
            }
    }
};

struct EpiRet {
    const bf16_t *pa, *gb; bf16_t* mixed;
    __device__ __forceinline__ void operator()(AccRef acc, const Unit& u, int wr, int wc, int fr, int fq) const {
#pragma unroll
        for (int ai = 0; ai < 2; ++ai) {
            u32x4 pw[4][2], gw[4][2];
#pragma unroll
            for (int m = 0; m < 4; ++m)
#pragma unroll
                for (int bj = 0; bj < 2; ++bj) {
                    const int row = u.pm * 256 + ai * 128 + wr * 64 + m * 16 + fr;
                    const size_t o = (size_t)row * 1024 + u.pn * 256 + bj * 128 + wc * 32 + 8 * fq;
                    pw[m][bj] = *(const u32x4*)(pa + o); gw[m][bj] = *(const u32x4*)(gb + o);
                }
#pragma unroll
            for (int m = 0; m < 4; ++m)
#pragma unroll
                for (int bj = 0; bj < 2; ++bj) {
                    const int row = u.pm * 256 + ai * 128 + wr * 64 + m * 16 + fr;
                    const size_t o = (size_t)row * 1024 + u.pn * 256 + bj * 128 + wc * 32 + 8 * fq;
                    const u32x4 p = pw[m][bj], g = gw[m][bj];
                    const f32x4 a0 = acc[ai][bj][m][0], a1 = acc[ai][bj][m][1];
                    f32x4 r0, r1;
                    r0[0] = bflo(p.x) + bflo(g.x) * a0[0]; r0[1] = bfhi(p.x) + bfhi(g.x) * a0[1];
                    r0[2] = bflo(p.y) + bflo(g.y) * a0[2]; r0[3] = bfhi(p.y) + bfhi(g.y) * a0[3];
                    r1[0] = bflo(p.z) + bflo(g.z) * a1[0]; r1[1] = bfhi(p.z) + bfhi(g.z) * a1[1];
                    r1[2] = bflo(p.w) + bflo(g.w) * a1[2]; r1[3] = bfhi(p.w) + bfhi(g.w) * a1[3];
                    *(u32x4*)(mixed + o) = pack8(r0, r1);
                }
            __builtin_amdgcn_sched_barrier(0);
        }
    }
};

template <int MODE>
struct EpiRes {
    const float *xp, *xs; bf16_t* hb; float* ssq;
    __device__ __forceinline__ void operator()(AccRef acc, const Unit& u, int wr, int wc, int fr, int fq) const {
#pragma unroll
        for (int ai = 0; ai < 2; ++ai) {
            f32x4 x0[4][2], x1[4][2]; u32x4 hw[4][2];
#pragma unroll
            for (int m = 0; m < 4; ++m)
#pragma unroll
                for (int bj = 0; bj < 2; ++bj) {
                    const int row = u.pm * 256 + ai * 128 + wr * 64 + m * 16 + fr, col = u.pn * 256 + bj * 128 + wc * 32 + 8 * fq;
                    if (MODE == 0) {
                        const float* src = (row < NPR ? xp + (size_t)row * 1024 : xs + (size_t)(row - NPR) * 1024) + col;
                        x0[m][bj] = *(const f32x4*)src; x1[m][bj] = *(const f32x4*)(src + 4);
                    } else hw[m][bj] = *(const u32x4*)(hb + (size_t)row * 1024 + col);
                }
#pragma unroll
            for (int m = 0; m < 4; ++m) {
                const int row = u.pm * 256 + ai * 128 + wr * 64 + m * 16 + fr;
                float ss = 0.f;
#pragma unroll
                for (int bj = 0; bj < 2; ++bj) {
                    const int col = u.pn * 256 + bj * 128 + wc * 32 + 8 * fq;
                    f32x4 h0, h1;
                    if (MODE == 0) { h0 = x0[m][bj]; h1 = x1[m][bj]; }
                    else { const u32x4 w = hw[m][bj]; h0 = (f32x4){bflo(w.x), bfhi(w.x), bflo(w.y), bfhi(w.y)}; h1 = (f32x4){bflo(w.z), bfhi(w.z), bflo(w.w), bfhi(w.w)}; }
                    h0 = h0 + acc[ai][bj][m][0]; h1 = h1 + acc[ai][bj][m][1];
                    *(u32x4*)(hb + (size_t)row * 1024 + col) = pack8(h0, h1);
                    ss += (h0[0] * h0[0] + h0[1] * h0[1]) + (h0[2] * h0[2] + h0[3] * h0[3]) + (h1[0] * h1[0] + h1[1] * h1[1]) + (h1[2] * h1[2] + h1[3] * h1[3]);
                }
                ss += __shfl_xor(ss, 16); ss += __shfl_xor(ss, 32);
                if (fq == 0) ssq[(size_t)row * 16 + u.pn * 4 + wc] = ss;
            }
            __builtin_amdgcn_sched_barrier(0);
        }
    }
};

struct EpiFfi {
    const float* ssq; bf16_t* act;
    __device__ __forceinline__ void operator()(AccRef acc, const Unit& u, int wr, int wc, int fr, int fq) const {
        f32x4 sp[2][4];
#pragma unroll
        for (int ai = 0; ai < 2; ++ai)
#pragma unroll
            for (int m = 0; m < 4; ++m) {
                const int row = u.pm * 256 + ai * 128 + wr * 64 + m * 16 + fr;
                sp[ai][m] = *(const f32x4*)(ssq + (size_t)row * 16 + 4 * fq);
            }
#pragma unroll
        for (int ai = 0; ai < 2; ++ai)
#pragma unroll
            for (int m = 0; m < 4; ++m) {
                const int row = u.pm * 256 + ai * 128 + wr * 64 + m * 16 + fr;
                float tot = (sp[ai][m][0] + sp[ai][m][1]) + (sp[ai][m][2] + sp[ai][m][3]);
                tot += __shfl_xor(tot, 16); tot += __shfl_xor(tot, 32);
                const float rstd = rsqrtf(tot * (1.0f / 1024.0f) + EPS);
                const f32x4 g0 = acc[ai][0][m][0], g1 = acc[ai][0][m][1], u0 = acc[ai][1][m][0], u1 = acc[ai][1][m][1];
                f32x4 r0, r1;
#pragma unroll
                for (int j = 0; j < 4; ++j) { r0[j] = siluf_(rstd * g0[j]) * (rstd * u0[j]); r1[j] = siluf_(rstd * g1[j]) * (rstd * u1[j]); }
                *(u32x4*)(act + (size_t)row * DFF + u.pn * 128 + wc * 32 + 8 * fq) = pack8(r0, r1);
            }
    }
};

__device__ __forceinline__ void p0_s5gen(const Args& a, LAS float* L, int g, int qd) {
    const int tid = threadIdx.x;
    LAS float* Kt = L;
    LAS float* Ap = L + 16384;
    LAS float* Bb = Ap + 33 * 64 * 2;
    LAS float* Cc = Bb + 2048;
    bf16_t* bts = (bf16_t*)(a.ws + OFF_BTS) + (size_t)g * 256 * 512;
    bf16_t* bty = (bf16_t*)(a.ws + OFF_BTY) + (size_t)g * 512 * 768;
    float* attab = (float*)(a.ws + OFF_AT);
    bf16_t* u5 = (bf16_t*)(a.ws + OFF_U5);
    if (qd == 0) for (int e = tid; e < 24 * 256; e += 512) { const int b = e >> 8, kk = e & 255; u5[((size_t)g * IT_PAD + IT_REAL + b) * LDA5 + kk] = 0; }
    for (int dir = 0; dir < 2; ++dir) {
        const int pg = dir * 32 + g;
        const double dt = exp((double)a.in[7][pg]);
        for (int idx = tid; idx < 33 * 64; idx += 512) {
            const int p = idx & 63, d = idx >> 6;
            const double lr = a.in[5][pg * 64 + p], li = a.in[6][pg * 64 + p];
            const float mag = (float)exp(lr * dt * d);
            float s, c; sincos_rev(li * dt * d, s, c);
            Ap[idx * 2] = mag * c; Ap[idx * 2 + 1] = mag * s;
            if (d == 32 && qd == 0) { attab[(pg * 64 + p) * 2] = mag * c; attab[(pg * 64 + p) * 2 + 1] = mag * s; }
        }
        for (int idx = tid; idx < 1024; idx += 512) {
            const int p = idx >> 4, h = idx & 15;
            const double lr = a.in[5][pg * 64 + p], li = a.in[6][pg * 64 + p];
            const double zr = lr * dt, zi = li * dt, mag = exp(zr);
            float sh, ch, s1, c1; sincos_rev(0.5 * zi, sh, ch); sincos_rev(zi, s1, c1);
            const double nr = mag * (-2.0 * (double)sh * (double)sh) + expm1(zr);
            const double abi = mag * (double)s1, den = lr * lr + li * li;
            const double cre = (nr * lr + abi * li) / den, cim = (abi * lr - nr * li) / den;
            const double br = a.in[8][(size_t)(pg * 64 + p) * 16 + h], bi = a.in[9][(size_t)(pg * 64 + p) * 16 + h];
            Bb[idx * 2] = (float)(cre * br - cim * bi); Bb[idx * 2 + 1] = (float)(cre * bi + cim * br);
        }
        for (int idx = tid; idx < 1024; idx += 512) {
            Cc[idx * 2] = a.in[10][(size_t)pg * 1024 + idx]; Cc[idx * 2 + 1] = a.in[11][(size_t)pg * 1024 + idx];
        }
        __syncthreads();
        for (int e = tid; e < 8192; e += 512) {
            const int d = e >> 8, ho = (e >> 4) & 15, hi = e & 15;
            float sum = 0.f;
            for (int p = 0; p < 64; ++p) {
                const float cr = Cc[(ho * 64 + p) * 2], ci = Cc[(ho * 64 + p) * 2 + 1], ar = Ap[(d * 64 + p) * 2], ai = Ap[(d * 64 + p) * 2 + 1];
                const float br = Bb[(p * 16 + hi) * 2], bi = Bb[(p * 16 + hi) * 2 + 1];
                const float car = cr * ar - ci * ai, cai = cr * ai + ci * ar;
                sum += car * br - cai * bi;
            }
            Kt[dir * 8192 + e] = sum;
        }
        for (int e = qd * 16384 + tid; e < (qd + 1) * 16384; e += 512) {
            const int k = e & 511, nn = e >> 9, c = nn >> 6, p = nn & 63, t = k >> 4, hi = k & 15;
            const int dd = dir == 0 ? (T5 - 1 - t) : t;
            const float ar = Ap[(dd * 64 + p) * 2], ai = Ap[(dd * 64 + p) * 2 + 1], br = Bb[(p * 16 + hi) * 2], bi = Bb[(p * 16 + hi) * 2 + 1];
            const float val = c ? (ar * bi + ai * br) : (ar * br - ai * bi);
            bts[(size_t)(dir * 128 + nn) * 512 + k] = f2bf(val);
        }
        for (int e = qd * 16384 + tid; e < (qd + 1) * 16384; e += 512) {
            const int kk = e & 127, n = e >> 7, c = kk >> 6, p = kk & 63, to = n >> 4, ho = n & 15;
            const int dd = dir == 0 ? (to + 1) : (T5 - to);
            const float cr = Cc[(ho * 64 + p) * 2], ci = Cc[(ho * 64 + p) * 2 + 1], ar = Ap[(dd * 64 + p) * 2], ai = Ap[(dd * 64 + p) * 2 + 1];
            const float val = c ? -(cr * ai + ci * ar) : (cr * ar - ci * ai);
            bty[(size_t)n * 768 + 512 + dir * 128 + kk] = f2bf(val);
        }
        __syncthreads();
    }
    for (int e = qd * 65536 + tid; e < (qd + 1) * 65536; e += 512) {
        const int k = e & 511, n = e >> 9, to = n >> 4, ho = n & 15, ti = k >> 4, hi = k & 15;
        float val = 0.f;
        if (to >= ti) val += Kt[((to - ti) * 16 + ho) * 16 + hi];
        if (ti >= to) val += Kt[8192 + ((ti - to) * 16 + ho) * 16 + hi];
        if (to == ti && ho == hi) val += a.in[12][g * 16 + ho];
        bty[(size_t)n * 768 + k] = f2bf(val);
    }
    __syncthreads();
}

__device__ __forceinline__ int src_col(int kind, int n) {
    if (kind == 1) { if (n >= 512 && n < 1536) { const int r = n - 512, seg = r >> 7, dp = r & 127; return 512 + seg * 128 + (dp >> 1) + 64 * (dp & 1); } return n; }
    if (kind == 2) { const int pn = n >> 8, bj = (n >> 7) & 1, cc = n & 127; return bj * 1024 + pn * 128 + cc; }
    if (kind == 3) { const int pn = n >> 8, bj = (n >> 7) & 1, cc = n & 127; return bj * DFF + pn * 128 + cc; }
    return n;
}
__device__ __forceinline__ void p0_wtile(const float* W, int K, int N, bf16_t* WT, int kind, const float* kscale, int tile2, LAS float* L) {
    const int tid = threadIdx.x, nkt = K >> 6;
    int n0[2], k0[2];
#pragma unroll
    for (int q = 0; q < 2; ++q) { const int tile = 2 * tile2 + q; n0[q] = (tile / nkt) * 64; k0[q] = (tile % nkt) * 64; }
    float v[2][8];
#pragma unroll
    for (int q = 0; q < 2; ++q)
#pragma unroll
        for (int it = 0; it < 8; ++it) {
            const int idx = tid + it * 512, kk = idx >> 6, j = idx & 63;
            v[q][it] = W[(size_t)(k0[q] + kk) * N + src_col(kind, n0[q] + j)];
        }
#pragma unroll
    for (int q = 0; q < 2; ++q)
#pragma unroll
        for (int it = 0; it < 8; ++it) {
            const int idx = tid + it * 512, kk = idx >> 6, j = idx & 63;
            float x = v[q][it];
            if (kscale) x *= kscale[k0[q] + kk];
            L[q * 4160 + kk * 65 + j] = x;
        }
    __syncthreads();
#pragma unroll
    for (int q = 0; q < 2; ++q)
#pragma unroll
        for (int it = 0; it < 4; ++it) {
            const int idx = tid + it * 512, j = idx >> 5, kp = idx & 31;
            *(unsigned*)(WT + (size_t)(n0[q] + j) * K + k0[q] + 2 * kp) = cvt_pk_bf16(L[q * 4160 + (2 * kp) * 65 + j], L[q * 4160 + (2 * kp + 1) * 65 + j]);
        }
    __syncthreads();
}

__device__ __forceinline__ void phase0(const Args& a, LAS unsigned char* lds) {
    LAS float* L = (LAS float*)lds;
    const int tid = threadIdx.x, wave = tid >> 6, lane = tid & 63;
    constexpr int T_IN = 88 * 16 / 2, T_GLU = 32 * 8 / 2, T_RET = 128, T_OUT = 128, T_FFI = 88 * 16 / 2, T_FFO = 16 * 44 / 2;
    constexpr int NW = 128 + T_IN + T_GLU + T_RET + T_OUT + T_FFI + T_FFO, NRM = RPAD / 32;
    unsigned* qctr = (unsigned*)(a.ws + OFF_BAR) + 4096;
    LAS int* qslot = (LAS int*)(lds + 131072 + 512);
    for (;;) {
        __syncthreads();
        if (tid == 0) *qslot = (int)__hip_atomic_fetch_add(qctr, 1u, __ATOMIC_RELAXED, __HIP_MEMORY_SCOPE_AGENT);
        __syncthreads();
        const int w = *qslot;
        if (w >= NW + NRM) break;
        int r = w;
        if (r < 128) { p0_s5gen(a, L, r >> 2, r & 3); continue; } r -= 128;
        if (r < T_IN) { p0_wtile(a.in[4], 1024, INW, (bf16_t*)(a.ws + OFF_WIN), 1, nullptr, r, L); continue; } r -= T_IN;
        if (r < T_GLU) { p0_wtile(a.in[13], 512, 2048, (bf16_t*)(a.ws + OFF_WGLU), 2, nullptr, r, L); continue; } r -= T_GLU;
        if (r < T_RET) { p0_wtile(a.in[15], 1024, 1024, (bf16_t*)(a.ws + OFF_WRET), 0, nullptr, r, L); continue; } r -= T_RET;
        if (r < T_OUT) { p0_wtile(a.in[16], 1024, 1024, (bf16_t*)(a.ws + OFF_WOUT), 0, nullptr, r, L); continue; } r -= T_OUT;
        if (r < T_FFI) { p0_wtile(a.in[18], 1024, INW, (bf16_t*)(a.ws + OFF_WFFI), 3, a.in[17], r, L); continue; } r -= T_FFI;
        if (r < T_FFO) { p0_wtile(a.in[19], DFF, 1024, (bf16_t*)(a.ws + OFF_WFFO), 0, nullptr, r, L); continue; } r -= T_FFO;
        const int rowb = r * 32 + wave * 4;
        const float* xr[4]; f32x4 v[4][4];
#pragma unroll
        for (int q = 0; q < 4; ++q) {
            const int row = rowb + q;
            xr[q] = row < NPR ? a.in[0] + (size_t)row * 1024 : (row < NREAL ? a.in[1] + (size_t)(row - NPR) * 1024 : a.in[2] + (size_t)((row - NREAL) & 15) * 1024);
#pragma unroll
            for (int j = 0; j < 4; ++j) v[q][j] = (row < NVALID) ? *(const f32x4*)(xr[q] + (j * 64 + lane) * 4) : (f32x4){0.f, 0.f, 0.f, 0.f};
        }
        f32x4 gg[4];
#pragma unroll
        for (int j = 0; j < 4; ++j) gg[j] = *(const f32x4*)(a.in[3] + (j * 64 + lane) * 4);
#pragma unroll
        for (int q = 0; q < 4; ++q) {
            float sq = 0.f;
#pragma unroll
            for (int j = 0; j < 4; ++j) sq += (v[q][j][0] * v[q][j][0] + v[q][j][1] * v[q][j][1]) + (v[q][j][2] * v[q][j][2] + v[q][j][3] * v[q][j][3]);
            const float rstd = rsqrtf(wave_sum(sq) * (1.0f / 1024.0f) + EPS);
            bf16_t* orow = (bf16_t*)(a.ws + OFF_N1) + (size_t)(rowb + q) * 1024;
#pragma unroll
            for (int j = 0; j < 4; ++j) {
                u32x2 o; o.x = cvt_pk_bf16(v[q][j][0] * rstd * gg[j][0], v[q][j][1] * rstd * gg[j][1]); o.y = cvt_pk_bf16(v[q][j][2] * rstd * gg[j][2], v[q][j][3] * rstd * gg[j][3]);
                *(u32x2*)(orow + (j * 64 + lane) * 4) = o;
            }
        }
    }
}

__device__ __forceinline__ void s5_scan(const Args& a) {
    const float* attab = (const float*)(a.ws + OFF_AT);
    const float* sloc = (const float*)(a.ws + OFF_SLOC);
    bf16_t* u5 = (bf16_t*)(a.ws + OFF_U5);
    for (int id = blockIdx.x * 512 + threadIdx.x; id < 24 * 32 * 2 * 64; id += gridDim.x * 512) {
        const int p = id & 63, dir = (id >> 6) & 1, g = (id >> 7) & 31, b = id >> 12;
        const float atr = attab[((dir * 32 + g) * 64 + p) * 2], ati = attab[((dir * 32 + g) * 64 + p) * 2 + 1];
        const int nck = b < 16 ? 128 : 64, base = b < 16 ? b * 128 : 2048 + (b - 16) * 64, mitem = IT_REAL + b;
        const float* sl = sloc + (size_t)g * IT_PAD * 256 + dir * 128 + p;
        bf16_t* ub = u5 + (size_t)g * IT_PAD * LDA5 + 512 + dir * 128 + p;
        float sr = 0.f, si = 0.f;
        if (dir == 0) {
            ub[(size_t)mitem * LDA5] = 0; ub[(size_t)mitem * LDA5 + 64] = 0;
            sr = sl[(size_t)mitem * 256]; si = sl[(size_t)mitem * 256 + 64];
            for (int c0 = 0; c0 < nck; c0 += 16) {
                float lr[16], li[16];
#pragma unroll
                for (int j = 0; j < 16; ++j) { lr[j] = sl[(size_t)(base + c0 + j) * 256]; li[j] = sl[(size_t)(base + c0 + j) * 256 + 64]; }
#pragma unroll
                for (int j = 0; j < 16; ++j) {
                    const size_t it = (size_t)(base + c0 + j);
                    ub[it * LDA5] = f2bf(sr); ub[it * LDA5 + 64] = f2bf(si);
                    const float nr = atr * sr - ati * si + lr[j], ni = atr * si + ati * sr + li[j];
                    sr = nr; si = ni;
                }
            }
        } else {
            for (int c0 = nck - 16; c0 >= 0; c0 -= 16) {
                float lr[16], li[16];
#pragma unroll
                for (int j = 0; j < 16; ++j) { lr[j] = sl[(size_t)(base + c0 + j) * 256]; li[j] = sl[(size_t)(base + c0 + j) * 256 + 64]; }
#pragma unroll
                for (int j = 15; j >= 0; --j) {
                    const size_t it = (size_t)(base + c0 + j);
                    ub[it * LDA5] = f2bf(sr); ub[it * LDA5 + 64] = f2bf(si);
                    const float nr = atr * sr - ati * si + lr[j], ni = atr * si + ati * sr + li[j];
                    sr = nr; si = ni;
                }
            }
            ub[(size_t)mitem * LDA5] = f2bf(sr); ub[(size_t)mitem * LDA5 + 64] = f2bf(si);
        }
    }
}

constexpr int LDR = 136;
__device__ __forceinline__ float bf2f(bf16_t h) { return __uint_as_float(((unsigned)h) << 16); }

__device__ __forceinline__ void tr_store_pair(LAS bf16_t* img, int f0, int s2, u32x4 r0, u32x4 r1) {
    LAS unsigned* p = (LAS unsigned*)(img + f0 * LDR + s2);
    p[0 * (LDR / 2)] = (r0.x & 0xFFFFu) | (r1.x << 16); p[1 * (LDR / 2)] = (r0.x >> 16) | (r1.x & 0xFFFF0000u);
    p[2 * (LDR / 2)] = (r0.y & 0xFFFFu) | (r1.y << 16); p[3 * (LDR / 2)] = (r0.y >> 16) | (r1.y & 0xFFFF0000u);
    p[4 * (LDR / 2)] = (r0.z & 0xFFFFu) | (r1.z << 16); p[5 * (LDR / 2)] = (r0.z >> 16) | (r1.z & 0xFFFF0000u);
    p[6 * (LDR / 2)] = (r0.w & 0xFFFFu) | (r1.w << 16); p[7 * (LDR / 2)] = (r0.w >> 16) | (r1.w & 0xFFFF0000u);
}
__device__ __forceinline__ void tr_store_pair_scaled(LAS bf16_t* img, int f0, int s2, u32x4 r0, u32x4 r1, float w0, float w1) {
    LAS unsigned* p = (LAS unsigned*)(img + f0 * LDR + s2);
    p[0 * (LDR / 2)] = cvt_pk_bf16(bflo(r0.x) * w0, bflo(r1.x) * w1); p[1 * (LDR / 2)] = cvt_pk_bf16(bfhi(r0.x) * w0, bfhi(r1.x) * w1);
    p[2 * (LDR / 2)] = cvt_pk_bf16(bflo(r0.y) * w0, bflo(r1.y) * w1); p[3 * (LDR / 2)] = cvt_pk_bf16(bfhi(r0.y) * w0, bfhi(r1.y) * w1);
    p[4 * (LDR / 2)] = cvt_pk_bf16(bflo(r0.z) * w0, bflo(r1.z) * w1); p[5 * (LDR / 2)] = cvt_pk_bf16(bfhi(r0.z) * w0, bfhi(r1.z) * w1);
    p[6 * (LDR / 2)] = cvt_pk_bf16(bflo(r0.w) * w0, bflo(r1.w) * w1); p[7 * (LDR / 2)] = cvt_pk_bf16(bfhi(r0.w) * w0, bfhi(r1.w) * w1);
}

#define LDS_BARRIER() do { asm volatile("s_waitcnt lgkmcnt(0)" ::: "memory"); __builtin_amdgcn_s_barrier(); asm volatile("" ::: "memory"); } while (0)
__device__ __forceinline__ void ret_pass_a(const Args& a, LAS unsigned char* lds) {
    LAS bf16_t* KT = (LAS bf16_t*)lds;
    LAS bf16_t* VT = KT + 128 * LDR;
    const int tid0 = threadIdx.x;
    const bf16_t* kb = (const bf16_t*)(a.ws + OFF_K); const bf16_t* vb = (const bf16_t*)(a.ws + OFF_V);
    bf16_t* stb = (bf16_t*)(a.ws + OFF_ST);
    for (int item = blockIdx.x; item < 192; item += gridDim.x) {
        int tid = tid0; asm volatile("" : "+v"(tid));
        const int w = tid >> 6, lane = tid & 63, fr = lane & 15, fq = lane >> 4;
        int b, h, dir;
        if (item < 128) { b = item >> 3; h = (item >> 1) & 3; dir = item & 1; } else { const int j = item - 128; b = 16 + (j >> 3); h = (j >> 1) & 3; dir = j & 1; }
        const int NC = b < 16 ? 32 : 16, rbase = b < 16 ? b * 4096 : NPR + (b - 16) * 2048, ebase = b < 16 ? b * 33 : 528 + (b - 16) * 17;
        const float lg = logsigf_(a.in[14][dir * 4 + h]);
        const float carry = __expf(lg * 128.f);
        const int s2 = 2 * (8 * w + (lane & 7)), pg = lane >> 3;
        const float wk0 = dir == 0 ? __expf(lg * (float)(127 - s2)) : __expf(lg * (float)s2);
        const float wk1 = dir == 0 ? __expf(lg * (float)(126 - s2)) : __expf(lg * (float)(s2 + 1));
        f32x4 acc[2][8];
#pragma unroll
        for (int et = 0; et < 2; ++et)
#pragma unroll
            for (int dtl = 0; dtl < 8; ++dtl) acc[et][dtl] = (f32x4){0.f, 0.f, 0.f, 0.f};
        const int nsteps = dir == 0 ? NC : NC;
        u32x4 rk[2][2], rv[4][2];
        auto load_chunk = [&](int n) {
            int row0; bool valid = true;
            if (n == 0) { valid = s2 >= 112; row0 = NREAL + b * 16 + (s2 - 112); } else row0 = rbase + (n - 1) * 128 + s2;
#pragma unroll
            for (int it = 0; it < 2; ++it)
#pragma unroll
                for (int r = 0; r < 2; ++r) {
                    rk[it][r] = (u32x4){0u, 0u, 0u, 0u};
                    if (valid) rk[it][r] = *(const u32x4*)(kb + (size_t)(row0 + r) * 512 + h * 128 + (pg + 8 * it) * 8);
                }
#pragma unroll
            for (int it = 0; it < 4; ++it)
#pragma unroll
                for (int r = 0; r < 2; ++r) {
                    rv[it][r] = (u32x4){0u, 0u, 0u, 0u};
                    if (valid) rv[it][r] = *(const u32x4*)(vb + (size_t)(row0 + r) * 1024 + h * 256 + (pg + 8 * it) * 8);
                }
        };
        load_chunk(dir == 0 ? 0 : NC);
        for (int step = 0; step < nsteps; ++step) {
            const int n = dir == 0 ? step : NC - step;
            {
                bf16_t* spn = stb + ((size_t)((ebase + n) * 4 + h) * 2 + dir) * 32768;
#pragma unroll
                for (int et = 0; et < 2; ++et)
#pragma unroll
                    for (int dtl = 0; dtl < 8; ++dtl) {
                        u32x2 o; o.x = cvt_pk_bf16(acc[et][dtl][0], acc[et][dtl][1]); o.y = cvt_pk_bf16(acc[et][dtl][2], acc[et][dtl][3]);
                        *(u32x2*)(spn + (size_t)(32 * w + 16 * et + fr) * 128 + 16 * dtl + 4 * fq) = o;
                    }
            }
            LDS_BARRIER();
#pragma unroll
            for (int it = 0; it < 2; ++it) tr_store_pair_scaled(KT, (pg + 8 * it) * 8, s2, rk[it][0], rk[it][1], wk0, wk1);
#pragma unroll
            for (int it = 0; it < 4; ++it) tr_store_pair(VT, (pg + 8 * it) * 8, s2, rv[it][0], rv[it][1]);
            if (step + 1 < nsteps) load_chunk(dir == 0 ? step + 1 : NC - step - 1);
            LDS_BARRIER();
#pragma unroll
            for (int et = 0; et < 2; ++et)
#pragma unroll
                for (int dtl = 0; dtl < 8; ++dtl) acc[et][dtl] = acc[et][dtl] * carry;
#pragma unroll
            for (int ks = 0; ks < 4; ++ks) {
                bf16x8 vf[2];
#pragma unroll
                for (int et = 0; et < 2; ++et) vf[et] = *(const LAS bf16x8*)(VT + (32 * w + 16 * et + fr) * LDR + 32 * ks + 8 * fq);
#pragma unroll
                for (int dtl = 0; dtl < 8; ++dtl) {
                    const bf16x8 kf = *(const LAS bf16x8*)(KT + (16 * dtl + fr) * LDR + 32 * ks + 8 * fq);
#pragma unroll
                    for (int et = 0; et < 2; ++et) acc[et][dtl] = __builtin_amdgcn_mfma_f32_16x16x32_bf16(kf, vf[et], acc[et][dtl], 0, 0, 0);
                }
            }
        }
        if (dir == 0) {
            bf16_t* spn = stb + ((size_t)((ebase + NC) * 4 + h) * 2 + dir) * 32768;
#pragma unroll
            for (int et = 0; et < 2; ++et)
#pragma unroll
                for (int dtl = 0; dtl < 8; ++dtl) {
                    u32x2 o; o.x = cvt_pk_bf16(acc[et][dtl][0], acc[et][dtl][1]); o.y = cvt_pk_bf16(acc[et][dtl][2], acc[et][dtl][3]);
                    *(u32x2*)(spn + (size_t)(32 * w + 16 * et + fr) * 128 + 16 * dtl + 4 * fq) = o;
                }
        }
        LDS_BARRIER();
    }
}

__device__ __forceinline__ void ret_pass_b(const Args& a, LAS unsigned char* lds) {
    LAS bf16_t* KL = (LAS bf16_t*)lds;
    LAS bf16_t* BG = KL + 128 * LDR;
    const int tid0 = threadIdx.x;
    const bf16_t* qb = (const bf16_t*)(a.ws + OFF_Q); const bf16_t* kb = (const bf16_t*)(a.ws + OFF_K); const bf16_t* vb = (const bf16_t*)(a.ws + OFF_V);
    const bf16_t* stb = (const bf16_t*)(a.ws + OFF_ST);
    bf16_t* sg = (bf16_t*)a.out;
    u32x4 rk[4], rb[8]; bf16x8 qf[4];
    auto item_info = [&](int item, int& r0, int& h, const bf16_t*& sfp) {
        const int rc = item >> 2; h = item & 3;
        int b, n; if (rc < 512) { b = rc >> 5; n = (rc & 31) + 1; } else { b = 16 + ((rc - 512) >> 4); n = ((rc - 512) & 15) + 1; }
        const int ebase = b < 16 ? b * 33 : 528 + (b - 16) * 17; r0 = rc * 128;
        sfp = stb + ((size_t)((ebase + n) * 4 + h) * 2 + 0) * 32768;
    };
    auto load_item_head = [&](int item, int tid) {
        int r0, h; const bf16_t* sfp; item_info(item, r0, h, sfp);
#pragma unroll
        for (int it = 0; it < 8; ++it) { const int idx = tid + it * 512, e = idx >> 4, pc = idx & 15; rb[it] = *(const u32x4*)(sfp + (size_t)e * 128 + pc * 8); }
    };
    auto load_item_kq = [&](int item, int tid) {
        int r0, h; const bf16_t* sfp; item_info(item, r0, h, sfp);
        const int w = tid >> 6, lane = tid & 63, fr = lane & 15, fq = lane >> 4;
#pragma unroll
        for (int it = 0; it < 4; ++it) { const int idx = tid + it * 512, s = idx >> 4, pc = idx & 15; rk[it] = *(const u32x4*)(kb + (size_t)(r0 + s) * 512 + h * 128 + pc * 8); }
#pragma unroll
        for (int ks = 0; ks < 4; ++ks) qf[ks] = *(const bf16x8*)(qb + (size_t)(r0 + 16 * w + fr) * 512 + h * 128 + 32 * ks + 8 * fq);
    };
    if ((int)blockIdx.x < 2560) { load_item_head(blockIdx.x, tid0); load_item_kq(blockIdx.x, tid0); }
    for (int item = blockIdx.x; item < 2560; item += gridDim.x) {
        int tid = tid0; asm volatile("" : "+v"(tid));
        const int w = tid >> 6, lane = tid & 63, fr = lane & 15, fq = lane >> 4;
        int r0, h; const bf16_t* sfp; item_info(item, r0, h, sfp);
        const bf16_t* sbp = sfp + 32768;
        const float lgf = logsigf_(a.in[14][h]), lgb = logsigf_(a.in[14][4 + h]);
        const int crow = 16 * w + fr;
        LDS_BARRIER();
#pragma unroll
        for (int it = 0; it < 4; ++it) { const int idx = tid + it * 512, s = idx >> 4, pc = idx & 15; *(LAS u32x4*)(KL + s * LDR + pc * 8) = rk[it]; }
#pragma unroll
        for (int it = 0; it < 8; ++it) { const int idx = tid + it * 512, e = idx >> 4, pc = idx & 15; *(LAS u32x4*)(BG + e * LDR + pc * 8) = rb[it]; }
#pragma unroll
        for (int it = 0; it < 8; ++it) { const int idx = tid + it * 512, e = idx >> 4, pc = idx & 15; rb[it] = *(const u32x4*)(sbp + (size_t)e * 128 + pc * 8); }
        LDS_BARRIER();
        f32x4 sacc[8];
#pragma unroll
        for (int st = 0; st < 8; ++st) sacc[st] = (f32x4){0.f, 0.f, 0.f, 0.f};
#pragma unroll
        for (int ks = 0; ks < 4; ++ks)
#pragma unroll
            for (int st = 0; st < 8; ++st) {
                const bf16x8 kf = *(const LAS bf16x8*)(KL + (16 * st + fr) * LDR + 32 * ks + 8 * fq);
                sacc[st] = __builtin_amdgcn_mfma_f32_16x16x32_bf16(kf, qf[ks], sacc[st], 0, 0, 0);
                if (st == 7) __builtin_amdgcn_sched_barrier(0);
            }
        bf16x8 pf[4];
#pragma unroll
        for (int t = 0; t < 4; ++t) {
            float pv[8];
#pragma unroll
            for (int hh = 0; hh < 2; ++hh)
#pragma unroll
                for (int j = 0; j < 4; ++j) {
                    const int spp = 16 * (2 * t + hh) + 4 * fq + j, diff = crow - spp;
                    const float dec = diff >= 0 ? __expf(lgf * (float)diff) : __expf(-lgb * (float)diff);
                    pv[hh * 4 + j] = sacc[2 * t + hh][j] * dec;
                }
            u32x4 pw; pw.x = cvt_pk_bf16(pv[0], pv[1]); pw.y = cvt_pk_bf16(pv[2], pv[3]); pw.z = cvt_pk_bf16(pv[4], pv[5]); pw.w = cvt_pk_bf16(pv[6], pv[7]);
            pf[t] = __builtin_bit_cast(bf16x8, pw);
        }
        f32x4 o[16];
#pragma unroll
        for (int et = 0; et < 16; ++et) o[et] = (f32x4){0.f, 0.f, 0.f, 0.f};
#pragma unroll
        for (int ks = 0; ks < 4; ++ks)
#pragma unroll
            for (int et = 0; et < 16; ++et) {
                const bf16x8 sf = *(const LAS bf16x8*)(BG + (16 * et + fr) * LDR + 32 * ks + 8 * fq);
                o[et] = __builtin_amdgcn_mfma_f32_16x16x32_bf16(sf, qf[ks], o[et], 0, 0, 0);
                if ((et & 7) == 7) __builtin_amdgcn_sched_barrier(0);
            }
        const float wqf = __expf(lgf * (float)(crow + 1)), wqb = __expf(lgb * (float)(128 - crow));
        const float ratio = wqf / wqb;
#pragma unroll
        for (int et = 0; et < 16; ++et) o[et] = o[et] * ratio;
        LDS_BARRIER();
#pragma unroll
        for (int it = 0; it < 8; ++it) { const int idx = tid + it * 512, e = idx >> 4, pc = idx & 15; *(LAS u32x4*)(BG + e * LDR + pc * 8) = rb[it]; }
        {
            const int s2 = 2 * (8 * w + (lane & 7));
#pragma unroll
            for (int it = 0; it < 4; ++it)
#pragma unroll
                for (int r = 0; r < 2; ++r) rb[it * 2 + r] = *(const u32x4*)(vb + (size_t)(r0 + s2 + r) * 1024 + h * 256 + ((lane >> 3) + 8 * it) * 8);
        }
        LDS_BARRIER();
#pragma unroll
        for (int ks = 0; ks < 4; ++ks)
#pragma unroll
            for (int et = 0; et < 16; ++et) {
                const bf16x8 sf = *(const LAS bf16x8*)(BG + (16 * et + fr) * LDR + 32 * ks + 8 * fq);
                o[et] = __builtin_amdgcn_mfma_f32_16x16x32_bf16(sf, qf[ks], o[et], 0, 0, 0);
                if ((et & 7) == 7) __builtin_amdgcn_sched_barrier(0);
            }
#pragma unroll
        for (int et = 0; et < 16; ++et) o[et] = o[et] * wqb;
        LDS_BARRIER();
#pragma unroll
        for (int it = 0; it < 4; ++it) tr_store_pair(BG, ((lane >> 3) + 8 * it) * 8, 2 * (8 * w + (lane & 7)), rb[it * 2], rb[it * 2 + 1]);
        if (item + (int)gridDim.x < 2560) load_item_head(item + gridDim.x, tid);
        LDS_BARRIER();
#pragma unroll
        for (int t = 0; t < 4; ++t)
#pragma unroll
            for (int et = 0; et < 16; ++et) {
                const u32x2 lo = *(const LAS u32x2*)(BG + (16 * et + fr) * LDR + 32 * t + 4 * fq);
                const u32x2 hi = *(const LAS u32x2*)(BG + (16 * et + fr) * LDR + 32 * t + 16 + 4 * fq);
                const u32x4 vw = (u32x4){lo.x, lo.y, hi.x, hi.y};
                o[et] = __builtin_amdgcn_mfma_f32_16x16x32_bf16(__builtin_bit_cast(bf16x8, vw), pf[t], o[et], 0, 0, 0);
                if ((et & 7) == 7) __builtin_amdgcn_sched_barrier(0);
            }
        float ss = 0.f;
#pragma unroll
        for (int et = 0; et < 16; ++et) ss += (o[et][0] * o[et][0] + o[et][1] * o[et][1]) + (o[et][2] * o[et][2] + o[et][3] * o[et][3]);
        ss += __shfl_xor(ss, 16); ss += __shfl_xor(ss, 32);
        const float rn = rsqrtf(ss * (1.0f / 256.0f) + EPS);
        bf16_t* gp = sg + (size_t)(r0 + crow) * 1024 + h * 256 + 4 * fq;
        u32x2 gwv[16];
#pragma unroll
        for (int et = 0; et < 16; ++et) gwv[et] = *(const u32x2*)(gp + 16 * et);
        if (item + (int)gridDim.x < 2560) load_item_kq(item + gridDim.x, tid);
#pragma unroll
        for (int et = 0; et < 16; ++et) {
            const u32x2 gw = gwv[et];
            u32x2 ow; ow.x = cvt_pk_bf16(o[et][0] * rn * bflo(gw.x), o[et][1] * rn * bfhi(gw.x)); ow.y = cvt_pk_bf16(o[et][2] * rn * bflo(gw.y), o[et][3] * rn * bfhi(gw.y));
            *(u32x2*)(gp + 16 * et) = ow;
        }
    }
    LDS_BARRIER();
}

__device__ __forceinline__ void final_norm(const Args& a) {
    const int wave = threadIdx.x >> 6, lane = threadIdx.x & 63;
    const float* ssq = (const float*)(a.ws + OFF_SSQ2);
    f32x4 gg[4];
#pragma unroll
    for (int j = 0; j < 4; ++j) gg[j] = *(const f32x4*)(a.in[20] + (j * 64 + lane) * 4);
    for (int rowb = (blockIdx.x * 8 + wave) * 4; rowb < NREAL; rowb += gridDim.x * 32) {
        float part[4]; u32x2 w[4][4];
#pragma unroll
        for (int q = 0; q < 4; ++q) {
            part[q] = lane < 16 ? ssq[(size_t)(rowb + q) * 16 + lane] : 0.f;
            const bf16_t* hrow = (const bf16_t*)(a.ws + OFF_H1B) + (size_t)(rowb + q) * 1024;
#pragma unroll
            for (int j = 0; j < 4; ++j) w[q][j] = *(const u32x2*)(hrow + (j * 64 + lane) * 4);
        }
#pragma unroll
        for (int q = 0; q < 4; ++q) {
            const float rstd = rsqrtf(wave_sum(part[q]) * (1.0f / 1024.0f) + EPS);
            float* orow = a.out + (size_t)(rowb + q) * 1024;
#pragma unroll
            for (int j = 0; j < 4; ++j) {
                f32x4 v;
                v[0] = bflo(w[q][j].x) * rstd * gg[j][0]; v[1] = bfhi(w[q][j].x) * rstd * gg[j][1]; v[2] = bflo(w[q][j].y) * rstd * gg[j][2]; v[3] = bfhi(w[q][j].y) * rstd * gg[j][3];
                *(f32x4*)(orow + (j * 64 + lane) * 4) = v;
            }
        }
    }
}

template <int ph>
__device__ __forceinline__ void run_phase(const Args& a, LAS unsigned char* lds) {
    unsigned char* ws = a.ws;
    bf16_t* dob = (bf16_t*)a.out;
    bf16_t* sgp = dob; bf16_t* gap = dob + (size_t)NREAL * 1024;
#ifdef ONLY_PH
    if (ph != ONLY_PH) return;
#endif
    switch (ph) {
    case 0: phase0(a, lds); break;
    case 1: {
        pg8::Gemm g{(const bf16_t*)(ws + OFF_N1), (const bf16_t*)(ws + OFF_WIN), 1024, 1024, 1024, RPAD / 256, INW / 256, 1, 0, 0, STG};
        EpiProj E{(bf16_t*)(ws + OFF_U5), (bf16_t*)(ws + OFF_Q), (bf16_t*)(ws + OFF_K), (bf16_t*)(ws + OFF_V), sgp, gap, (bf16_t*)(ws + OFF_GB), (const LAS double*)(lds + 131072)};
        pg8::gemm_phase(lds, g, E);
    } break;
    case 2: {
        pg8::Gemm g{(const bf16_t*)(ws + OFF_U5), (const bf16_t*)(ws + OFF_BTS), LDA5, 512, 512, IT_PAD / 256, 1, 32, (size_t)IT_PAD * LDA5, (size_t)256 * 512, 0};
        EpiSloc E{(float*)(ws + OFF_SLOC)};
        pg8::gemm_phase(lds, g, E);
    } break;
    case 3: s5_scan(a); break;
    case 4: {
        pg8::Gemm g{(const bf16_t*)(ws + OFF_U5), (const bf16_t*)(ws + OFF_BTY), LDA5, 768, 768, IT_PAD / 256, 2, 32, (size_t)IT_PAD * LDA5, (size_t)512 * 768, 0};
        EpiY E{(bf16_t*)(ws + OFF_YSSM)};
        pg8::gemm_phase(lds, g, E);
    } break;
    case 5: {
        ret_pass_a(a, lds);
        const int sub = (int)blockIdx.x - 192;
        pg8::Gemm g{(const bf16_t*)(ws + OFF_YSSM), (const bf16_t*)(ws + OFF_WGLU), 512, 512, 512, NREAL / 256, 8, 1, 0, 0, STG, 64, sub < 0 ? 0 : sub, sub < 0 ? GLU_SPLIT : 0, GLU_SPLIT};
        EpiGlu E{gap};
        pg8::gemm_phase(lds, g, E);
    } break;
    case 6: {
        pg8::Gemm g{(const bf16_t*)(ws + OFF_YSSM), (const bf16_t*)(ws + OFF_WGLU), 512, 512, 512, NREAL / 256, 8, 1, 0, 0, STG, (int)gridDim.x, (int)blockIdx.x, GLU_SPLIT, 2560};
        EpiGlu E{gap};
        pg8::gemm_phase(lds, g, E);
    } break;
    case 7: ret_pass_b(a, lds); break;
    case 8: {
        pg8::Gemm g{sgp, (const bf16_t*)(ws + OFF_WRET), 1024, 1024, 1024, NREAL / 256, 4, 1, 0, 0, STG};
        EpiRet E{gap, (const bf16_t*)(ws + OFF_GB), (bf16_t*)(ws + OFF_MIXED)};
        pg8::gemm_phase(lds, g, E);
    } break;
    case 9: {
        pg8::Gemm g{(const bf16_t*)(ws + OFF_MIXED), (const bf16_t*)(ws + OFF_WOUT), 1024, 1024, 1024, NREAL / 256, 4, 1, 0, 0, STG};
        EpiRes<0> E{a.in[0], a.in[1], (bf16_t*)(ws + OFF_H1B), (float*)(ws + OFF_SSQ1)};
        pg8::gemm_phase(lds, g, E);
    } break;
    case 10: {
        pg8::Gemm g{(const bf16_t*)(ws + OFF_H1B), (const bf16_t*)(ws + OFF_WFFI), 1024, 1024, 1024, NREAL / 256, INW / 256, 1, 0, 0, STG};
        EpiFfi E{(const float*)(ws + OFF_SSQ1), (bf16_t*)(ws + OFF_ACT)};
        pg8::gemm_phase(lds, g, E);
    } break;
    case 11: {
        pg8::Gemm g{(const bf16_t*)(ws + OFF_ACT), (const bf16_t*)(ws + OFF_WFFO), DFF, DFF, DFF, NREAL / 256, 4, 1, 0, 0, STG};
        EpiRes<1> E{nullptr, nullptr, (bf16_t*)(ws + OFF_H1B), (float*)(ws + OFF_SSQ2)};
        pg8::gemm_phase(lds, g, E);
    } break;
    case 12: final_norm(a); break;
    default: break;
    }
}

#define XB_TMO      128
#define XB_XCNT(j)  (256  + 64 * (j))
#define XB_XSUB(j)  (1280 + 64 * (j))
#define XB_XGEN(j)  (2304 + 64 * (j))
#define XB_TOP      3328
#define XB_TOPGEN   3392
#define XCD_BAR_WORDS 3456
#define XB_SPIN_CAP (1u << 18)

__device__ __forceinline__ unsigned xb_ld(unsigned* p)              { return __hip_atomic_load(p, __ATOMIC_RELAXED, __HIP_MEMORY_SCOPE_AGENT); }
__device__ __forceinline__ unsigned xb_add(unsigned* p, unsigned v) { return __hip_atomic_fetch_add(p, v, __ATOMIC_RELAXED, __HIP_MEMORY_SCOPE_AGENT); }
__device__ __forceinline__ unsigned xb_xcc_id() { return (unsigned)__builtin_amdgcn_s_getreg((3 << 11) | 20) & 0xFu; }
#define XB_SPIN(cond, bar) do { unsigned _sp = 0; while (cond) { __builtin_amdgcn_s_sleep(1); \
    if ((++_sp & 255u) == 0u) { if (xb_ld(&(bar)[XB_TMO])) break; if (_sp > XB_SPIN_CAP) { atomicAdd(&(bar)[XB_TMO], 1u); break; } } } } while (0)

struct XcdBarrier {
    unsigned* bar; unsigned x;
    volatile LAS unsigned* st;
};

__device__ __forceinline__ XcdBarrier xcd_barrier_post(unsigned* bar, volatile LAS unsigned* st) {
    XcdBarrier b; b.bar = bar; b.x = xb_xcc_id(); b.st = st;
    if (threadIdx.x == 0) (void)xb_add(&bar[XB_XCNT(b.x)], 1u);
    return b;
}
__device__ __forceinline__ void xcd_barrier_complete(unsigned* bar, unsigned x, unsigned& nloc, unsigned& nx) {
    const unsigned G = gridDim.x * gridDim.y * gridDim.z;
    unsigned sum, cnt, mine, sp = 0u;
    for (;;) {
        sum = 0u; cnt = 0u; mine = 0u;
#pragma unroll
        for (unsigned j = 0; j < 16; ++j) { const unsigned c = xb_ld(&bar[XB_XCNT(j)]); sum += c; cnt += (c > 0u) ? 1u : 0u; mine = (j == x) ? c : mine; }
        if (sum == G) break;
        __builtin_amdgcn_s_sleep(1);
        if ((++sp & 255u) == 0u) { if (xb_ld(&bar[XB_TMO])) break; if (sp > XB_SPIN_CAP) { atomicAdd(&bar[XB_TMO], 1u); break; } }
    }
    nloc = mine > 0u ? mine : 1u; nx = cnt > 0u ? cnt : 1u;
}

__device__ __forceinline__ void xcd_barrier(const XcdBarrier& b) {
    asm volatile("s_waitcnt vmcnt(0)" ::: "memory");
    __syncthreads();
    if (threadIdx.x == 0) {
        unsigned* bar = b.bar;
        __builtin_amdgcn_s_waitcnt(0);
        unsigned nloc = b.st[0], nx = b.st[1];
        if (nloc == 0u) { xcd_barrier_complete(bar, b.x, nloc, nx); b.st[0] = nloc; b.st[1] = nx; }
        const unsigned old = xb_add(&bar[XB_XSUB(b.x)], 1u);
        const unsigned gen = old / nloc;
        if (old + 1u == (gen + 1u) * nloc) {
            __builtin_amdgcn_fence(__ATOMIC_RELEASE, "agent");
            asm volatile("s_waitcnt vmcnt(0)" ::: "memory");
            const unsigned og = xb_add(&bar[XB_TOP], 1u);
            const unsigned tg = og / nx;
            if (og + 1u == (tg + 1u) * nx) xb_add(&bar[XB_TOPGEN], 1u);
            else XB_SPIN(xb_ld(&bar[XB_TOPGEN]) == tg, bar);
            __builtin_amdgcn_fence(__ATOMIC_ACQUIRE, "agent");
            xb_add(&bar[XB_XGEN(b.x)], 1u);
            asm volatile("s_waitcnt vmcnt(0)" ::: "memory");
        } else {
            XB_SPIN(xb_ld(&bar[XB_XGEN(b.x)]) == gen, bar);
            __builtin_amdgcn_fence(__ATOMIC_ACQUIRE, "agent");
            asm volatile("s_waitcnt vmcnt(0)" ::: "memory");
        }
    }
    __syncthreads();
}


__device__ __forceinline__ void grid_barrier(unsigned* ctr, unsigned target) {
    asm volatile("s_waitcnt vmcnt(0) lgkmcnt(0)" ::: "memory");
    __syncthreads();
    if (threadIdx.x == 0) {
        __builtin_amdgcn_fence(__ATOMIC_RELEASE, "agent");
        asm volatile("s_waitcnt vmcnt(0)" ::: "memory");
        __hip_atomic_fetch_add(ctr, 1u, __ATOMIC_RELAXED, __HIP_MEMORY_SCOPE_AGENT);
        unsigned spins = 0;
        while (__hip_atomic_load(ctr, __ATOMIC_RELAXED, __HIP_MEMORY_SCOPE_AGENT) < target && ++spins < (1u << 24)) __builtin_amdgcn_s_sleep(2);
        __builtin_amdgcn_fence(__ATOMIC_ACQUIRE, "agent");
        asm volatile("s_waitcnt vmcnt(0)" ::: "memory");
    }
    __syncthreads();
}

template <bool COOP>
__global__ __launch_bounds__(512, 2) void fwd_kernel(Args a) {
    extern __shared__ __attribute__((aligned(16))) unsigned char shm[];
    LAS unsigned char* lds = (LAS unsigned char*)shm;
    if (threadIdx.x < 64) ((LAS double*)(lds + 131072))[threadIdx.x] = exp2(-(double)threadIdx.x * (13.287712379549449 / 64.0));
    volatile LAS unsigned* xst = (volatile LAS unsigned*)(lds + 131072 + 528);
    if (threadIdx.x == 0) { xst[0] = 0u; xst[1] = 0u; }
    __syncthreads();
    XcdBarrier xb{}; if (COOP) xb = xcd_barrier_post((unsigned*)(a.ws + OFF_BAR), xst);
    if (COOP && a.ph_hi > NPHASE) cg::this_grid().sync();
#define RUN_PH(P) if (a.ph_lo <= P && P < a.ph_hi) { run_phase<P>(a, lds); if ((DBL_MASK >> P) & 1) run_phase<P>(a, lds); if (COOP && P + 1 < a.ph_hi) { xcd_barrier(xb); } }
    RUN_PH(0) RUN_PH(1) RUN_PH(2) RUN_PH(3) RUN_PH(4) RUN_PH(5) RUN_PH(6) RUN_PH(7) RUN_PH(8) RUN_PH(9) RUN_PH(10) RUN_PH(11) RUN_PH(12)
#undef RUN_PH
}

extern "C" void kernel_launch(void* const* d_in, const int* in_sizes, int n_in, void* d_out, int out_size, void* d_ws, size_t ws_size, hipStream_t stream) {
    static int grid = 0;
    if (grid == 0) {
        if (n_in != 21 || ws_size < WS_NEED || out_size != NREAL * 1024) { fprintf(stderr, "kernel_launch: unexpected shapes (n_in %d, ws %zu need %zu, out %d)\n", n_in, ws_size, (size_t)WS_NEED, out_size); grid = -1; return; }
        int dev = 0, cus = 0;
        hipGetDevice(&dev); hipDeviceGetAttribute(&cus, hipDeviceAttributeMultiprocessorCount, dev);
        hipFuncSetAttribute((const void*)fwd_kernel<true>, hipFuncAttributeMaxDynamicSharedMemorySize, LDS_BYTES);
        hipFuncSetAttribute((const void*)fwd_kernel<false>, hipFuncAttributeMaxDynamicSharedMemorySize, LDS_BYTES);
        int per_cu = 0;
        hipOccupancyMaxActiveBlocksPerMultiprocessor(&per_cu, (const void*)fwd_kernel<true>, 512, LDS_BYTES);
        if (per_cu < 1) { fprintf(stderr, "kernel_launch: occupancy query says %d blocks per CU\n", per_cu); per_cu = 1; }
        (void)hipGetLastError();
        grid = cus * 1;
    }
    if (grid < 0) return;
    Args a{};
    for (int i = 0; i < 21; ++i) a.in[i] = (const float*)d_in[i];
    a.out = (float*)d_out; a.ws = (unsigned char*)d_ws;
#if COOP_MODE
    hipMemsetAsync((char*)d_ws + OFF_BAR, 0, 4096 * 4 + 256, stream);
    a.ph_lo = 0; a.ph_hi = NPHASE;
    void* args[] = {&a};
    hipError_t e = hipLaunchCooperativeKernel((const void*)fwd_kernel<true>, dim3(grid), dim3(512), args, LDS_BYTES, stream);
    if (e != hipSuccess) fprintf(stderr, "cooperative launch failed: %s (grid %d)\n", hipGetErrorString(e), grid);
#else
    for (int ph = 0; ph < NPHASE; ++ph) {
        a.ph_lo = ph; a.ph_hi = ph + 1;
        hipLaunchKernelGGL(fwd_kernel<false>, dim3(grid), dim3(512), LDS_BYTES, stream, a);
    }
#endif
}
```

```cpp
#include <hip/hip_runtime.h>
#include <hip/hip_cooperative_groups.h>
#include <cstdio>
#include <cstdint>
namespace cg = cooperative_groups;

#ifndef COOP_MODE
#define COOP_MODE 1
#endif

#define DBL_MASK 0x0
#define LAS __attribute__((address_space(3)))
typedef unsigned short bf16_t;
typedef short bf16x8 __attribute__((ext_vector_type(8)));
typedef float f32x4 __attribute__((ext_vector_type(4)));
typedef unsigned u32x4 __attribute__((ext_vector_type(4)));
typedef unsigned u32x2 __attribute__((ext_vector_type(2)));

constexpr int D = 1024, NREAL = 81920, NPR = 65536, RPAD = 82432, NVALID = 82304;
constexpr int INW = 5632, DFF = 2816;
constexpr int T5 = 32, IT_REAL = 2560, IT_PAD = 2816, LDA5 = 768;
constexpr float EPS = 1e-6f;

constexpr size_t OFF_WIN = 0;
constexpr size_t OFF_WGLU = OFF_WIN + (size_t)INW * D * 2;
constexpr size_t OFF_WRET = OFF_WGLU + (size_t)2048 * 512 * 2;
constexpr size_t OFF_WOUT = OFF_WRET + (size_t)D * D * 2;
constexpr size_t OFF_WFFI = OFF_WOUT + (size_t)D * D * 2;
constexpr size_t OFF_WFFO = OFF_WFFI + (size_t)INW * D * 2;
constexpr size_t OFF_AT = OFF_WFFO + (size_t)D * DFF * 2;
constexpr size_t OFF_BAR = OFF_AT + 32768;
constexpr size_t OFF_Q = OFF_AT + 65536;
constexpr size_t OFF_K = OFF_Q + (size_t)RPAD * 512 * 2;
constexpr size_t OFF_V = OFF_K + (size_t)RPAD * 512 * 2;
constexpr size_t OFF_GB = OFF_V + (size_t)RPAD * D * 2;
constexpr size_t OFF_SSQ1 = OFF_GB + (size_t)NREAL * D * 2;
constexpr size_t OFF_SSQ2 = OFF_SSQ1 + (size_t)NREAL * 16 * 4;
constexpr size_t OFF_X = OFF_SSQ2 + (size_t)NREAL * 16 * 4;
constexpr size_t OFF_N1 = OFF_X;
constexpr size_t OFF_YSSM = OFF_X + (size_t)664 * 8 * 65536;
constexpr size_t OFF_U5 = OFF_N1 + (size_t)RPAD * D * 2;
constexpr size_t OFF_BTY = OFF_U5 + (size_t)32 * IT_PAD * LDA5 * 2;
constexpr size_t OFF_BTS = OFF_BTY + (size_t)32 * 512 * 768 * 2;
constexpr size_t OFF_SLOC = OFF_BTS + (size_t)32 * 256 * 512 * 2;
constexpr size_t END_X03 = OFF_SLOC + (size_t)32 * IT_PAD * 256 * 4;
constexpr size_t OFF_ST = OFF_X;
constexpr size_t END_ST = OFF_ST + (size_t)664 * 8 * 65536;
constexpr size_t OFF_ACT = OFF_X;
constexpr size_t END_ACT = OFF_ACT + (size_t)NREAL * DFF * 2;
constexpr size_t OFF_MIXED = OFF_Q;
constexpr size_t OFF_H1B = OFF_V;
constexpr size_t cmax(size_t a, size_t b) { return a > b ? a : b; }
constexpr size_t WS_NEED = cmax(END_X03, cmax(END_ST, END_ACT));

constexpr int LDS_BYTES = 131072 + 1024;
constexpr int NPHASE = 13;
constexpr int GLU_SPLIT = 64 * 14, GLU_SPLIT2 = GLU_SPLIT + 64 * 6;
constexpr int STG = 0;

struct Args {
    const float* in[21];
    float* out;
    unsigned char* ws;
    int ph_lo, ph_hi;
};

__device__ __forceinline__ unsigned cvt_pk_bf16(float lo, float hi) { unsigned r; asm volatile("v_cvt_pk_bf16_f32 %0, %1, %2" : "=v"(r) : "v"(lo), "v"(hi)); return r; }
__device__ __forceinline__ bf16_t f2bf(float f) { return (bf16_t)(cvt_pk_bf16(f, 0.f) & 0xFFFFu); }
__device__ __forceinline__ float bflo(unsigned w) { return __uint_as_float(w << 16); }
__device__ __forceinline__ float bfhi(unsigned w) { return __uint_as_float(w & 0xFFFF0000u); }
__device__ __forceinline__ float sigmoidf_(float x) { return __fdividef(1.0f, 1.0f + __expf(-x)); }
__device__ __forceinline__ float siluf_(float x) { return x * sigmoidf_(x); }
__device__ __forceinline__ float gelu_tanh(float x) { const float z = 0.7978845608028654f * (x + 0.044715f * x * x * x); return x * sigmoidf_(2.0f * z); }
__device__ __forceinline__ float logsigf_(float x) { return fminf(x, 0.f) - log1pf(__expf(-fabsf(x))); }
__device__ __forceinline__ float wave_sum(float v) {
#pragma unroll
    for (int o = 1; o < 64; o <<= 1) v += __shfl_xor(v, o);
    return v;
}
__device__ __forceinline__ void sincos_rev(double ang, float& s, float& c) {
    double x = ang * 0.15915494309189535; x -= rint(x);
    const float xf = (float)x;
    s = __builtin_amdgcn_sinf(xf); c = __builtin_amdgcn_cosf(xf);
}

namespace pg8 {
constexpr int BM = 256, BK = 64, HALF = 128, HTB = HALF * BK * 2, STAGE_BYTES = 8 * HTB, NXCD = 8, WGM = 8;
__device__ __forceinline__ int lds_byte(int r, int c) { const int st = (r >> 4) * 2 + (c >> 5), rr = r & 15, cc = c & 31, ob = rr * 64 + cc * 2; return st * 1024 + (ob ^ (((ob >> 9) & 1) << 5)); }
__device__ __forceinline__ void stage_rc(int b, int& R, int& C) { const int st = b / 1024, sb = b % 1024, swz = sb ^ (((sb >> 9) & 1) << 5); R = (st >> 1) * 16 + swz / 64; C = (st & 1) * 32 + (swz % 64) / 2; }
__device__ __forceinline__ int perm32(int rho) { const int n = rho >> 4, i = rho & 15; return 8 * (i >> 2) + 4 * n + (i & 3); }

struct Unit { int pm, pn, g; };
struct Gemm { const bf16_t* A; const bf16_t* Bt; int lda, ldb, K, nM, nN, nb; size_t sA, sB; int stagger; int G, c, u0, u1; };

struct Order {
    int nM, nN, nwg, total, G, c, u0;
    __device__ void init(int nM_, int nN_, int nb, int G_, int c_, int u0_, int u1_) { nM = nM_; nN = nN_; nwg = nM * nN; total = u1_ > 0 ? u1_ : nwg * nb; G = G_; c = c_; u0 = u0_; }
    __device__ bool next(int i, Unit& u) const {
        const long L = (long)u0 + (long)i * G + c; if (L >= total) return false;
        u.g = (int)(L / nwg); int wgid = (int)(L % nwg);
        { const int q = nwg / NXCD, r = nwg % NXCD, xcd = wgid % NXCD, off = wgid / NXCD; wgid = (xcd < r ? xcd * (q + 1) : r * (q + 1) + (xcd - r) * q) + off; }
        const int nig = WGM * nN, gid = wgid / nig, fm = gid * WGM, gsz = (nM - fm) < WGM ? (nM - fm) : WGM;
        u.pm = fm + ((wgid % nig) % gsz); u.pn = (wgid % nig) / gsz; return true;
    }
};

template <class Epi>
__device__ __forceinline__ void gemm_phase(LAS unsigned char* lds, const Gemm g, const Epi& E) {
    const int tid = threadIdx.x, wid = __builtin_amdgcn_readfirstlane(tid >> 6), lane = tid & 63, wr = wid >> 2, wc = wid & 3, fr = lane & 15, fq = lane >> 4;
    const int K = g.K, nt = K / BK;
    Order S; S.init(g.nM, g.nN, g.nb, g.G > 0 ? g.G : (int)gridDim.x, g.G > 0 ? g.c : (int)blockIdx.x, g.u0, g.u1);
    unsigned voffA[2], voffB[2];
#pragma unroll
    for (int i = 0; i < 2; ++i) { int R, C; stage_rc(tid * 16 + i * 8192, R, C); const int Rb = (R & ~31) + perm32(R & 31);
        voffA[i] = (unsigned)(R * g.lda + C) * 2u; voffB[i] = (unsigned)(Rb * g.ldb + C) * 2u; }
    const size_t kstep = (size_t)(BK * 2);
    const size_t hstepA = (size_t)HALF * g.lda * 2, hstepB = (size_t)HALF * g.ldb * 2;
    const size_t tstepA = 2 * hstepA, tstepB = 2 * hstepB;
    const unsigned ldsw = (unsigned)wid * 1024u;
    const int aoff = lds_byte(wr * 64 + fr, fq * 8), boff = lds_byte(wc * 32 + fr, fq * 8);
#define PG8_SA(b, h) (((b) * 2 + (h)) * HTB)
#define PG8_SB(b, h) ((4 + (b) * 2 + (h)) * HTB)
#define PG8_STAGE(bufoff, gbase, voff) do { _Pragma("unroll") for (int _i = 0; _i < 2; ++_i) \
        __builtin_amdgcn_global_load_lds((const unsigned*)((const char*)(gbase) + (voff)[_i]), (LAS unsigned*)(lds + (bufoff) + ldsw + _i * 8192), 16, 0, 0); } while (0)
#define PG8_LDA(dst, b, h) do { _Pragma("unroll") for (int m = 0; m < 4; ++m) _Pragma("unroll") for (int k = 0; k < 2; ++k) dst[m][k] = *(const LAS bf16x8*)(lds + PG8_SA(b, h) + aoff + m * 2048 + k * 1024); } while (0)
#define PG8_LDB(dst, b, h) do { _Pragma("unroll") for (int n = 0; n < 2; ++n) _Pragma("unroll") for (int k = 0; k < 2; ++k) dst[n][k] = *(const LAS bf16x8*)(lds + PG8_SB(b, h) + boff + n * 2048 + k * 1024); } while (0)
#define PG8_MMA(ai, bj, At, Bt) do { __builtin_amdgcn_s_setprio(1); _Pragma("unroll") for (int m = 0; m < 4; ++m) _Pragma("unroll") for (int n = 0; n < 2; ++n) _Pragma("unroll") for (int k = 0; k < 2; ++k) \
        acc[ai][bj][m][n] = __builtin_amdgcn_mfma_f32_16x16x32_bf16(Bt[n][k], At[m][k], acc[ai][bj][m][n], 0, 0, 0); __builtin_amdgcn_s_setprio(0); } while (0)
#define PG8_WAIT_V(n) asm volatile("s_waitcnt vmcnt(" #n ")" ::: "memory")
#define PG8_WAIT_L(n) asm volatile("s_waitcnt lgkmcnt(" #n ")" ::: "memory")
#define PG8_BAR __builtin_amdgcn_s_barrier()
#define PG8_SCHED __builtin_amdgcn_sched_barrier(0)
    Unit cur, nxt; int ui = 0;
    if (!S.next(0, cur)) return;
    if (g.stagger) {
        const unsigned long long t0 = __builtin_amdgcn_s_memrealtime(), wt = (unsigned long long)((blockIdx.x & 3) * g.stagger);
        while (__builtin_amdgcn_s_memrealtime() - t0 < wt) __builtin_amdgcn_s_sleep(16);
    }
    f32x4 acc[2][2][4][2];
#pragma unroll
    for (int a = 0; a < 2; ++a)
#pragma unroll
        for (int b = 0; b < 2; ++b)
#pragma unroll
            for (int m = 0; m < 4; ++m)
#pragma unroll
                for (int n = 0; n < 2; ++n) acc[a][b][m][n] = (f32x4){0.f, 0.f, 0.f, 0.f};
    bf16x8 At[4][2], B0[2][2], B1[2][2];
    const char* cA = (const char*)g.A + ((size_t)cur.g * g.sA) * 2 + (size_t)cur.pm * tstepA;
    const char* cB = (const char*)g.Bt + ((size_t)cur.g * g.sB) * 2 + (size_t)cur.pn * tstepB;
    PG8_STAGE(PG8_SB(0, 0), cB, voffB); PG8_STAGE(PG8_SA(0, 0), cA, voffA); PG8_STAGE(PG8_SB(0, 1), cB + hstepB, voffB); PG8_STAGE(PG8_SA(0, 1), cA + hstepA, voffA);
    if (wr == 1) PG8_BAR;
    PG8_WAIT_V(4); PG8_BAR;
    PG8_STAGE(PG8_SB(1, 0), cB + kstep, voffB); PG8_STAGE(PG8_SA(1, 0), cA + kstep, voffA); PG8_STAGE(PG8_SB(1, 1), cB + hstepB + kstep, voffB);
    PG8_WAIT_V(6); PG8_BAR;
    for (;;) {
        const bool has_next = S.next(ui + 1, nxt);
        const char* nA = has_next ? (const char*)g.A + ((size_t)nxt.g * g.sA) * 2 + (size_t)nxt.pm * tstepA : cA;
        const char* nB = has_next ? (const char*)g.Bt + ((size_t)nxt.g * g.sB) * 2 + (size_t)nxt.pn * tstepB : cB;
        for (int t = 0; t < nt; t += 2) {
            const bool last = (t == nt - 2);
            const char* a1 = cA + (size_t)(t + 1) * kstep;
            const char* a2 = last ? nA : cA + (size_t)(t + 2) * kstep; const char* b2 = last ? nB : cB + (size_t)(t + 2) * kstep;
            const char* a3 = a2 + kstep; const char* b3 = b2 + kstep;
            PG8_LDB(B0, 0, 0); PG8_SCHED; PG8_LDA(At, 0, 0); PG8_STAGE(PG8_SA(1, 1), a1 + hstepA, voffA);
            PG8_WAIT_L(8); PG8_BAR; PG8_WAIT_L(0); PG8_MMA(0, 0, At, B0); PG8_BAR; PG8_SCHED;
            PG8_LDB(B1, 0, 1); PG8_STAGE(PG8_SB(0, 0), b2, voffB);
            PG8_BAR; PG8_WAIT_L(0); PG8_MMA(0, 1, At, B1); PG8_BAR;
            PG8_LDA(At, 0, 1); PG8_STAGE(PG8_SA(0, 0), a2, voffA);
            PG8_BAR; PG8_WAIT_L(0); PG8_MMA(1, 0, At, B0); PG8_BAR; PG8_SCHED;
            PG8_STAGE(PG8_SB(0, 1), b2 + hstepB, voffB);
            PG8_WAIT_V(6); PG8_BAR; PG8_MMA(1, 1, At, B1); PG8_BAR;
            PG8_LDB(B0, 1, 0); PG8_SCHED; PG8_LDA(At, 1, 0); PG8_STAGE(PG8_SA(0, 1), a2 + hstepA, voffA);
            PG8_WAIT_L(8); PG8_BAR; PG8_WAIT_L(0); PG8_MMA(0, 0, At, B0); PG8_BAR; PG8_SCHED;
            PG8_LDB(B1, 1, 1); PG8_STAGE(PG8_SB(1, 0), b3, voffB);
            PG8_BAR; PG8_WAIT_L(0); PG8_MMA(0, 1, At, B1); PG8_BAR;
            PG8_LDA(At, 1, 1); PG8_STAGE(PG8_SA(1, 0), a3, voffA);
            PG8_BAR; PG8_WAIT_L(0); PG8_MMA(1, 0, At, B0); PG8_BAR; PG8_SCHED;
            PG8_STAGE(PG8_SB(1, 1), b3 + hstepB, voffB);
            PG8_WAIT_V(6); PG8_BAR; PG8_MMA(1, 1, At, B1); PG8_BAR;
        }
        E(acc, cur, wr, wc, fr, fq);
        if (!has_next) break;
#pragma unroll
        for (int a = 0; a < 2; ++a)
#pragma unroll
            for (int b = 0; b < 2; ++b)
#pragma unroll
                for (int m = 0; m < 4; ++m)
#pragma unroll
                    for (int n = 0; n < 2; ++n) acc[a][b][m][n] = (f32x4){0.f, 0.f, 0.f, 0.f};
        cur = nxt; cA = nA; cB = nB; ++ui;
    }
    PG8_WAIT_V(0);
    if (wr == 0) PG8_BAR;
    PG8_BAR;
#undef PG8_SA
#undef PG8_SB
#undef PG8_STAGE
#undef PG8_LDA
#undef PG8_LDB
#undef PG8_MMA
#undef PG8_WAIT_V
#undef PG8_WAIT_L
#undef PG8_BAR
#undef PG8_SCHED
}
}
using pg8::Unit;
typedef const f32x4 (&AccRef)[2][2][4][2];

__device__ __forceinline__ u32x4 pack8(f32x4 a, f32x4 b) { u32x4 w; w.x = cvt_pk_bf16(a[0], a[1]); w.y = cvt_pk_bf16(a[2], a[3]); w.z = cvt_pk_bf16(b[0], b[1]); w.w = cvt_pk_bf16(b[2], b[3]); return w; }

struct EpiProj {
    bf16_t *u5, *q, *k, *v, *sg, *ga, *gb; const LAS double* ropef;
    __device__ __forceinline__ void operator()(AccRef acc, const Unit& u, int wr, int wc, int fr, int fq) const {
        const int pn = u.pn;
#pragma unroll
        for (int ai = 0; ai < 2; ++ai)
#pragma unroll
            for (int m = 0; m < 4; ++m) {
                const int row = u.pm * 256 + ai * 128 + wr * 64 + m * 16 + fr;
#pragma unroll
                for (int bj = 0; bj < 2; ++bj) {
                    const int col = pn * 256 + bj * 128 + wc * 32 + 8 * fq;
                    f32x4 v0 = acc[ai][bj][m][0], v1 = acc[ai][bj][m][1];
                    if (pn < 2) {
                        if (row < NVALID) {
                            int item, t;
                            if (row < NREAL) { item = row >> 5; t = row & 31; } else { const int mr = row - NREAL; item = IT_REAL + (mr >> 4); t = 16 + (mr & 15); }
                            const int g = col >> 4, h0 = col & 15;
                            *(u32x4*)(u5 + ((size_t)(g * IT_PAD + item) * LDA5 + t * 16 + h0)) = pack8(v0, v1);
                        }
                    } else if (pn < 6) {
                        const int cq = col - 512, isk = cq >> 9, cc = cq & 511, i0 = (cc & 127) >> 1;
                        const int pos = row < NPR ? 16 + (row & 4095) : (row < NREAL ? 16 + ((row - NPR) & 2047) : ((row - NREAL) & 15));
                        const float sc = isk ? 1.0f : 0.08838834764831845f;
                        float o[8];
#pragma unroll
                        for (int pi = 0; pi < 4; ++pi) {
                            float s, c; sincos_rev((double)pos * ropef[i0 + pi], s, c);
                            const float x1 = pi < 2 ? v0[2 * pi] : v1[2 * pi - 4], x2 = pi < 2 ? v0[2 * pi + 1] : v1[2 * pi - 3];
                            o[2 * pi] = (x1 * c - x2 * s) * sc; o[2 * pi + 1] = (x1 * s + x2 * c) * sc;
                        }
                        u32x4 w; w.x = cvt_pk_bf16(o[0], o[1]); w.y = cvt_pk_bf16(o[2], o[3]); w.z = cvt_pk_bf16(o[4], o[5]); w.w = cvt_pk_bf16(o[6], o[7]);
                        *(u32x4*)((isk ? k : q) + (size_t)row * 512 + cc) = w;
                    } else if (pn < 10) {
                        *(u32x4*)(v + (size_t)row * 1024 + (col - 1536)) = pack8(v0, v1);
                    } else if (row < NREAL) {
                        if (pn < 14) {
#pragma unroll
                            for (int j = 0; j < 4; ++j) { v0[j] = siluf_(v0[j]); v1[j] = siluf_(v1[j]); }
                            *(u32x4*)(sg + (size_t)row * 1024 + (col - 2560)) = pack8(v0, v1);
                        } else {
#pragma unroll
                            for (int j = 0; j < 4; ++j) { v0[j] = sigmoidf_(v0[j]); v1[j] = sigmoidf_(v1[j]); }
                            if (pn < 18) *(u32x4*)(ga + (size_t)row * 1024 + (col - 3584)) = pack8(v0, v1);
                            else *(u32x4*)(gb + (size_t)row * 1024 + (col - 4608)) = pack8(v0, v1);
                        }
                    }
                }
            }
    }
};

struct EpiSink {
    float* p; int flag;
    __device__ __forceinline__ void operator()(AccRef acc, const Unit& u, int wr, int wc, int fr, int fq) const {
        if (flag) {
#pragma unroll
            for (int ai = 0; ai < 2; ++ai)
#pragma unroll
                for (int m = 0; m < 4; ++m)
#pragma unroll
                    for (int bj = 0; bj < 2; ++bj) { p[(ai * 8 + m * 2 + bj) * 8 + fr] = acc[ai][bj][m][0][0] + acc[ai][bj][m][1][1]; }
        }
    }
};

struct EpiSloc {
    float* sloc;
    __device__ __forceinline__ void operator()(AccRef acc, const Unit& u, int wr, int wc, int fr, int fq) const {
#pragma unroll
        for (int ai = 0; ai < 2; ++ai)
#pragma unroll
            for (int m = 0; m < 4; ++m) {
                const int row = u.pm * 256 + ai * 128 + wr * 64 + m * 16 + fr;
#pragma unroll
                for (int bj = 0; bj < 2; ++bj) {
                    const int col = bj * 128 + wc * 32 + 8 * fq;
                    float* p = sloc + ((size_t)u.g * IT_PAD + row) * 256 + col;
                    *(f32x4*)p = acc[ai][bj][m][0]; *(f32x4*)(p + 4) = acc[ai][bj][m][1];
                }
            }
    }
};

struct EpiY {
    bf16_t* y;
    __device__ __forceinline__ void operator()(AccRef acc, const Unit& u, int wr, int wc, int fr, int fq) const {
#pragma unroll
        for (int ai = 0; ai < 2; ++ai)
#pragma unroll
            for (int m = 0; m < 4; ++m) {
                const int item = u.pm * 256 + ai * 128 + wr * 64 + m * 16 + fr;
                if (item < IT_REAL) {
#pragma unroll
                    for (int bj = 0; bj < 2; ++bj) {
                        const int col = u.pn * 256 + bj * 128 + wc * 32 + 8 * fq, to = col >> 4, ho = col & 15;
                        f32x4 v0 = acc[ai][bj][m][0], v1 = acc[ai][bj][m][1];
#pragma unroll
                        for (int j = 0; j < 4; ++j) { v0[j] = gelu_tanh(v0[j]); v1[j] = gelu_tanh(v1[j]); }
                        *(u32x4*)(y + (size_t)(item * 32 + to) * 512 + u.g * 16 + ho) = pack8(v0, v1);
                    }
                }
            }
    }
};

struct EpiGlu {
    bf16_t* ga;
    __device__ __forceinline__ void operator()(AccRef acc, const Unit& u, int wr, int wc, int fr, int fq) const {
        u32x4 gw[2][4];
#pragma unroll
        for (int ai = 0; ai < 2; ++ai)
#pragma unroll
            for (int m = 0; m < 4; ++m) {
                const int row = u.pm * 256 + ai * 128 + wr * 64 + m * 16 + fr;
                gw[ai][m] = *(const u32x4*)(ga + (size_t)row * 1024 + u.pn * 128 + wc * 32 + 8 * fq);
            }
#pragma unroll
        for (int ai = 0; ai < 2; ++ai)
#pragma unroll
            for (int m = 0; m < 4; ++m) {
                const int row = u.pm * 256 + ai * 128 + wr * 64 + m * 16 + fr;
                bf16_t* p = ga + (size_t)row * 1024 + u.pn * 128 + wc * 32 + 8 * fq;
                const u32x4 g = gw[ai][m];
                const f32x4 a0 = acc[ai][0][m][0], a1 = acc[ai][0][m][1], g0 = acc[ai][1][m][0], g1 = acc[ai][1][m][1];
                f32x4 r0, r1;
                r0[0] = bflo(g.x) * a0[0] * sigmoidf_(g0[0]); r0[1] = bfhi(g.x) * a0[1] * sigmoidf_(g0[1]);
                r0[2] = bflo(g.y) * a0[2] * sigmoidf_(g0[2]); r0[3] = bfhi(g.y) * a0[3] * sigmoidf_(g0[3]);
                r1[0] = bflo(g.z) * a1[0] * sigmoidf_(g1[0]); r1[1] = bfhi(g.z) * a1[1] * sigmoidf_(g1[1]);
                r1[2] = bflo(g.w) * a1[2] * sigmoidf_(g1[2]); r1[3] = bfhi(g.w) * a1[3] * sigmoidf_(g1[3]);
                *(u32x4*)p = pack8(r0, r1);
            }
    }
};

struct EpiRet {
    const bf16_t *pa, *gb; bf16_t* mixed;
    __device__ __forceinline__ void operator()(AccRef acc, const Unit& u, int wr, int wc, int fr, int fq) const {
#pragma unroll
        for (int ai = 0; ai < 2; ++ai) {
            u32x4 pw[4][2], gw[4][2];
#pragma unroll
            for (int m = 0; m < 4; ++m)
#pragma unroll
                for (int bj = 0; bj < 2; ++bj) {
                    const int row = u.pm * 256 + ai * 128 + wr * 64 + m * 16 + fr;
                    const size_t o = (size_t)row * 1024 + u.pn * 256 + bj * 128 + wc * 32 + 8 * fq;
                    pw[m][bj] = *(const u32x4*)(pa + o); gw[m][bj] = *(const u32x4*)(gb + o);
                }
#pragma unroll
            for (int m = 0; m < 4; ++m)
#pragma unroll
                for (int bj = 0; bj < 2; ++bj) {
                    const int row = u.pm * 256 + ai * 128 + wr * 64 + m * 16 + fr;
                    const size_t o = (size_t)row * 1024 + u.pn * 256 + bj * 128 + wc * 32 + 8 * fq;
                    const u32x4 p = pw[m][bj], g = gw[m][bj];
                    const f32x4 a0 = acc[ai][bj][m][0], a1 = acc[ai][bj][m][1];
                    f32x4 r0, r1;
                    r0[0] = bflo(p.x) + bflo(g.x) * a0[0]; r0[1] = bfhi(p.x) + bfhi(g.x) * a0[1];
                    r0[2] = bflo(p.y) + bflo(g.y) * a0[2]; r0[3] = bfhi(p.y) + bfhi(g.y) * a0[3];
                    r1[0] = bflo(p.z) + bflo(g.z) * a1[0]; r1[1] = bfhi(p.z) + bfhi(g.z) * a1[1];
                    r1[2] = bflo(p.w) + bflo(g.w) * a1[2]; r1[3] = bfhi(p.w) + bfhi(g.w) * a1[3];
                    *(u32x4*)(mixed + o) = pack8(r0, r1);
                }
            __builtin_amdgcn_sched_barrier(0);
        }
    }
};

template <int MODE>
struct EpiRes {
    const float *xp, *xs; bf16_t* hb; float* ssq;
    __device__ __forceinline__ void operator()(AccRef acc, const Unit& u, int wr, int wc, int fr, int fq) const {
#pragma unroll
        for (int ai = 0; ai < 2; ++ai) {
            f32x4 x0[4][2], x1[4][2]; u32x4 hw[4][2];
#pragma unroll
            for (int m = 0; m < 4; ++m)
#pragma unroll
                for (int bj = 0; bj < 2; ++bj) {
                    const int row = u.pm * 256 + ai * 128 + wr * 64 + m * 16 + fr, col = u.pn * 256 + bj * 128 + wc * 32 + 8 * fq;
                    if (MODE == 0) {
                        const float* src = (row < NPR ? xp + (size_t)row * 1024 : xs + (size_t)(row - NPR) * 1024) + col;
                        x0[m][bj] = *(const f32x4*)src; x1[m][bj] = *(const f32x4*)(src + 4);
                    } else hw[m][bj] = *(const u32x4*)(hb + (size_t)row * 1024 + col);
                }
#pragma unroll
            for (int m = 0; m < 4; ++m) {
                const int row = u.pm * 256 + ai * 128 + wr * 64 + m * 16 + fr;
                float ss = 0.f;
#pragma unroll
                for (int bj = 0; bj < 2; ++bj) {
                    const int col = u.pn * 256 + bj * 128 + wc * 32 + 8 * fq;
                    f32x4 h0, h1;
                    if (MODE == 0) { h0 = x0[m][bj]; h1 = x1[m][bj]; }
                    else { const u32x4 w = hw[m][bj]; h0 = (f32x4){bflo(w.x), bfhi(w.x), bflo(w.y), bfhi(w.y)}; h1 = (f32x4){bflo(w.z), bfhi(w.z), bflo(w.w), bfhi(w.w)}; }
                    h0 = h0 + acc[ai][bj][m][0]; h1 = h1 + acc[ai][bj][m][1];
                    *(u32x4*)(hb + (size_t)row * 1024 + col) = pack8(h0, h1);
                    ss += (h0[0] * h0[0] + h0[1] * h0[1]) + (h0[2] * h0[2] + h0[3] * h0[3]) + (h1[0] * h1[0] + h1[1] * h1[1]) + (h1[2] * h1[2] + h1[3] * h1[3]);
                }
                ss += __shfl_xor(ss, 16); ss += __shfl_xor(ss, 32);
                if (fq == 0) ssq[(size_t)row * 16 + u.pn * 4 + wc] = ss;
            }
            __builtin_amdgcn_sched_barrier(0);
        }
    }
};

struct EpiFfi {
    const float* ssq; bf16_t* act;
    __device__ __forceinline__ void operator()(AccRef acc, const Unit& u, int wr, int wc, int fr, int fq) const {
        f32x4 sp[2][4];
#pragma unroll
        for (int ai = 0; ai < 2; ++ai)
#pragma unroll
            for (int m = 0; m < 4; ++m) {
                const int row = u.pm * 256 + ai * 128 + wr * 64 + m * 16 + fr;
                sp[ai][m] = *(const f32x4*)(ssq + (size_t)row * 16 + 4 * fq);
            }
#pragma unroll
        for (int ai = 0; ai < 2; ++ai)
#pragma unroll
            for (int m = 0; m < 4; ++m) {
                const int row = u.pm * 256 + ai * 128 + wr * 64 + m * 16 + fr;
                float tot = (sp[ai][m][0] + sp[ai][m][1]) + (sp[ai][m][2] + sp[ai][m][3]);
                tot += __shfl_xor(tot, 16); tot += __shfl_xor(tot, 32);
                const float rstd = rsqrtf(tot * (1.0f / 1024.0f) + EPS);
                const f32x4 g0 = acc[ai][0][m][0], g1 = acc[ai][0][m][1], u0 = acc[ai][1][m][0], u1 = acc[ai][1][m][1];
                f32x4 r0, r1;
#pragma unroll
                for (int j = 0; j < 4; ++j) { r0[j] = siluf_(rstd * g0[j]) * (rstd * u0[j]); r1[j] = siluf_(rstd * g1[j]) * (rstd * u1[j]); }
                *(u32x4*)(act + (size_t)row * DFF + u.pn * 128 + wc * 32 + 8 * fq) = pack8(r0, r1);
            }
    }
};

__device__ __forceinline__ void p0_s5gen(const Args& a, LAS float* L, int g, int qd) {
    const int tid = threadIdx.x;
    LAS float* Kt = L;
    LAS float* Ap = L + 16384;
    LAS float* Bb = Ap + 33 * 64 * 2;
    LAS float* Cc = Bb + 2048;
    bf16_t* bts = (bf16_t*)(a.ws + OFF_BTS) + (size_t)g * 256 * 512;
    bf16_t* bty = (bf16_t*)(a.ws + OFF_BTY) + (size_t)g * 512 * 768;
    float* attab = (float*)(a.ws + OFF_AT);
    bf16_t* u5 = (bf16_t*)(a.ws + OFF_U5);
    if (qd == 0) for (int e = tid; e < 24 * 256; e += 512) { const int b = e >> 8, kk = e & 255; u5[((size_t)g * IT_PAD + IT_REAL + b) * LDA5 + kk] = 0; }
    for (int dir = 0; dir < 2; ++dir) {
        const int pg = dir * 32 + g;
        const double dt = exp((double)a.in[7][pg]);
        for (int idx = tid; idx < 33 * 64; idx += 512) {
            const int p = idx & 63, d = idx >> 6;
            const double lr = a.in[5][pg * 64 + p], li = a.in[6][pg * 64 + p];
            const float mag = (float)exp(lr * dt * d);
            float s, c; sincos_rev(li * dt * d, s, c);
            Ap[idx * 2] = mag * c; Ap[idx * 2 + 1] = mag * s;
            if (d == 32 && qd == 0) { attab[(pg * 64 + p) * 2] = mag * c; attab[(pg * 64 + p) * 2 + 1] = mag * s; }
        }
        for (int idx = tid; idx < 1024; idx += 512) {
            const int p = idx >> 4, h = idx & 15;
            const double lr = a.in[5][pg * 64 + p], li = a.in[6][pg * 64 + p];
            const double zr = lr * dt, zi = li * dt, mag = exp(zr);
            float sh, ch, s1, c1; sincos_rev(0.5 * zi, sh, ch); sincos_rev(zi, s1, c1);
            const double nr = mag * (-2.0 * (double)sh * (double)sh) + expm1(zr);
            const double abi = mag * (double)s1, den = lr * lr + li * li;
            const double cre = (nr * lr + abi * li) / den, cim = (abi * lr - nr * li) / den;
            const double br = a.in[8][(size_t)(pg * 64 + p) * 16 + h], bi = a.in[9][(size_t)(pg * 64 + p) * 16 + h];
            Bb[idx * 2] = (float)(cre * br - cim * bi); Bb[idx * 2 + 1] = (float)(cre * bi + cim * br);
        }
        for (int idx = tid; idx < 1024; idx += 512) {
            Cc[idx * 2] = a.in[10][(size_t)pg * 1024 + idx]; Cc[idx * 2 + 1] = a.in[11][(size_t)pg * 1024 + idx];
        }
        __syncthreads();
        for (int e = tid; e < 8192; e += 512) {
            const int d = e >> 8, ho = (e >> 4) & 15, hi = e & 15;
            float sum = 0.f;
            for (int p = 0; p < 64; ++p) {
                const float cr = Cc[(ho * 64 + p) * 2], ci = Cc[(ho * 64 + p) * 2 + 1], ar = Ap[(d * 64 + p) * 2], ai = Ap[(d * 64 + p) * 2 + 1];
                const float br = Bb[(p * 16 + hi) * 2], bi = Bb[(p * 16 + hi) * 2 + 1];
                const float car = cr * ar - ci * ai, cai = cr * ai + ci * ar;
                sum += car * br - cai * bi;
            }
            Kt[dir * 8192 + e] = sum;
        }
        for (int e = qd * 16384 + tid; e < (qd + 1) * 16384; e += 512) {
            const int k = e & 511, nn = e >> 9, c = nn >> 6, p = nn & 63, t = k >> 4, hi = k & 15;
            const int dd = dir == 0 ? (T5 - 1 - t) : t;
            const float ar = Ap[(dd * 64 + p) * 2], ai = Ap[(dd * 64 + p) * 2 + 1], br = Bb[(p * 16 + hi) * 2], bi = Bb[(p * 16 + hi) * 2 + 1];
            const float val = c ? (ar * bi + ai * br) : (ar * br - ai * bi);
            bts[(size_t)(dir * 128 + nn) * 512 + k] = f2bf(val);
        }
        for (int e = qd * 16384 + tid; e < (qd + 1) * 16384; e += 512) {
            const int kk = e & 127, n = e >> 7, c = kk >> 6, p = kk & 63, to = n >> 4, ho = n & 15;
            const int dd = dir == 0 ? (to + 1) : (T5 - to);
            const float cr = Cc[(ho * 64 + p) * 2], ci = Cc[(ho * 64 + p) * 2 + 1], ar = Ap[(dd * 64 + p) * 2], ai = Ap[(dd * 64 + p) * 2 + 1];
            const float val = c ? -(cr * ai + ci * ar) : (cr * ar - ci * ai);
            bty[(size_t)n * 768 + 512 + dir * 128 + kk] = f2bf(val);
        }
        __syncthreads();
    }
    for (int e = qd * 65536 + tid; e < (qd + 1) * 65536; e += 512) {
        const int k = e & 511, n = e >> 9, to = n >> 4, ho = n & 15, ti = k >> 4, hi = k & 15;
        float val = 0.f;
        if (to >= ti) val += Kt[((to - ti) * 16 + ho) * 16 + hi];
        if (ti >= to) val += Kt[8192 + ((ti - to) * 16 + ho) * 16 + hi];
        if (to == ti && ho == hi) val += a.in[12][g * 16 + ho];
        bty[(size_t)n * 768 + k] = f2bf(val);
    }
    __syncthreads();
}

__device__ __forceinline__ int src_col(int kind, int n) {
    if (kind == 1) { if (n >= 512 && n < 1536) { const int r = n - 512, seg = r >> 7, dp = r & 127; return 512 + seg * 128 + (dp >> 1) + 64 * (dp & 1); } return n; }
    if (kind == 2) { const int pn = n >> 8, bj = (n >> 7) & 1, cc = n & 127; return bj * 1024 + pn * 128 + cc; }
    if (kind == 3) { const int pn = n >> 8, bj = (n >> 7) & 1, cc = n & 127; return bj * DFF + pn * 128 + cc; }
    return n;
}
__device__ __forceinline__ void p0_wtile(const float* W, int K, int N, bf16_t* WT, int kind, const float* kscale, int tile2, LAS float* L) {
    const int tid = threadIdx.x, nkt = K >> 6;
    int n0[2], k0[2];
#pragma unroll
    for (int q = 0; q < 2; ++q) { const int tile = 2 * tile2 + q; n0[q] = (tile / nkt) * 64; k0[q] = (tile % nkt) * 64; }
    float v[2][8];
#pragma unroll
    for (int q = 0; q < 2; ++q)
#pragma unroll
        for (int it = 0; it < 8; ++it) {
            const int idx = tid + it * 512, kk = idx >> 6, j = idx & 63;
            v[q][it] = W[(size_t)(k0[q] + kk) * N + src_col(kind, n0[q] + j)];
        }
#pragma unroll
    for (int q = 0; q < 2; ++q)
#pragma unroll
        for (int it = 0; it < 8; ++it) {
            const int idx = tid + it * 512, kk = idx >> 6, j = idx & 63;
            float x = v[q][it];
            if (kscale) x *= kscale[k0[q] + kk];
            L[q * 4160 + kk * 65 + j] = x;
        }
    __syncthreads();
#pragma unroll
    for (int q = 0; q < 2; ++q)
#pragma unroll
        for (int it = 0; it < 4; ++it) {
            const int idx = tid + it * 512, j = idx >> 5, kp = idx & 31;
            *(unsigned*)(WT + (size_t)(n0[q] + j) * K + k0[q] + 2 * kp) = cvt_pk_bf16(L[q * 4160 + (2 * kp) * 65 + j], L[q * 4160 + (2 * kp + 1) * 65 + j]);
        }
    __syncthreads();
}

__device__ __forceinline__ void phase0(const Args& a, LAS unsigned char* lds) {
    LAS float* L = (LAS float*)lds;
    const int tid = threadIdx.x, wave = tid >> 6, lane = tid & 63;
    constexpr int T_IN = 88 * 16 / 2, T_GLU = 32 * 8 / 2, T_RET = 128, T_OUT = 128, T_FFI = 88 * 16 / 2, T_FFO = 16 * 44 / 2;
    constexpr int NW = 128 + T_IN + T_GLU + T_RET + T_OUT + T_FFI + T_FFO, NRM = RPAD / 32;
    unsigned* qctr = (unsigned*)(a.ws + OFF_BAR) + 4096;
    LAS int* qslot = (LAS int*)(lds + 131072 + 512);
    for (;;) {
        __syncthreads();
        if (tid == 0) *qslot = (int)__hip_atomic_fetch_add(qctr, 1u, __ATOMIC_RELAXED, __HIP_MEMORY_SCOPE_AGENT);
        __syncthreads();
        const int w = *qslot;
        if (w >= NW + NRM) break;
        int r = w;
        if (r < 128) { p0_s5gen(a, L, r >> 2, r & 3); continue; } r -= 128;
        if (r < T_IN) { p0_wtile(a.in[4], 1024, INW, (bf16_t*)(a.ws + OFF_WIN), 1, nullptr, r, L); continue; } r -= T_IN;
        if (r < T_GLU) { p0_wtile(a.in[13], 512, 2048, (bf16_t*)(a.ws + OFF_WGLU), 2, nullptr, r, L); continue; } r -= T_GLU;
        if (r < T_RET) { p0_wtile(a.in[15], 1024, 1024, (bf16_t*)(a.ws + OFF_WRET), 0, nullptr, r, L); continue; } r -= T_RET;
        if (r < T_OUT) { p0_wtile(a.in[16], 1024, 1024, (bf16_t*)(a.ws + OFF_WOUT), 0, nullptr, r, L); continue; } r -= T_OUT;
        if (r < T_FFI) { p0_wtile(a.in[18], 1024, INW, (bf16_t*)(a.ws + OFF_WFFI), 3, a.in[17], r, L); continue; } r -= T_FFI;
        if (r < T_FFO) { p0_wtile(a.in[19], DFF, 1024, (bf16_t*)(a.ws + OFF_WFFO), 0, nullptr, r, L); continue; } r -= T_FFO;
        const int rowb = r * 32 + wave * 4;
        const float* xr[4]; f32x4 v[4][4];
#pragma unroll
        for (int q = 0; q < 4; ++q) {
            const int row = rowb + q;
            xr[q] = row < NPR ? a.in[0] + (size_t)row * 1024 : (row < NREAL ? a.in[1] + (size_t)(row - NPR) * 1024 : a.in[2] + (size_t)((row - NREAL) & 15) * 1024);
#pragma unroll
            for (int j = 0; j < 4; ++j) v[q][j] = (row < NVALID) ? *(const f32x4*)(xr[q] + (j * 64 + lane) * 4) : (f32x4){0.f, 0.f, 0.f, 0.f};
        }
        f32x4 gg[4];
#pragma unroll
        for (int j = 0; j < 4; ++j) gg[j] = *(const f32x4*)(a.in[3] + (j * 64 + lane) * 4);
#pragma unroll
        for (int q = 0; q < 4; ++q) {
            float sq = 0.f;
#pragma unroll
            for (int j = 0; j < 4; ++j) sq += (v[q][j][0] * v[q][j][0] + v[q][j][1] * v[q][j][1]) + (v[q][j][2] * v[q][j][2] + v[q][j][3] * v[q][j][3]);
            const float rstd = rsqrtf(wave_sum(sq) * (1.0f / 1024.0f) + EPS);
            bf16_t* orow = (bf16_t*)(a.ws + OFF_N1) + (size_t)(rowb + q) * 1024;
#pragma unroll
            for (int j = 0; j < 4; ++j) {
                u32x2 o; o.x = cvt_pk_bf16(v[q][j][0] * rstd * gg[j][0], v[q][j][1] * rstd * gg[j][1]); o.y = cvt_pk_bf16(v[q][j][2] * rstd * gg[j][2], v[q][j][3] * rstd * gg[j][3]);
                *(u32x2*)(orow + (j * 64 + lane) * 4) = o;
            }
        }
    }
}

__device__ __forceinline__ void s5_scan(const Args& a) {
    const float* attab = (const float*)(a.ws + OFF_AT);
    const float* sloc = (const float*)(a.ws + OFF_SLOC);
    bf16_t* u5 = (bf16_t*)(a.ws + OFF_U5);
    for (int id = blockIdx.x * 512 + threadIdx.x; id < 24 * 32 * 2 * 64; id += gridDim.x * 512) {
        const int p = id & 63, dir = (id >> 6) & 1, g = (id >> 7) & 31, b = id >> 12;
        const float atr = attab[((dir * 32 + g) * 64 + p) * 2], ati = attab[((dir * 32 + g) * 64 + p) * 2 + 1];
        const int nck = b < 16 ? 128 : 64, base = b < 16 ? b * 128 : 2048 + (b - 16) * 64, mitem = IT_REAL + b;
        const float* sl = sloc + (size_t)g * IT_PAD * 256 + dir * 128 + p;
        bf16_t* ub = u5 + (size_t)g * IT_PAD * LDA5 + 512 + dir * 128 + p;
        float sr = 0.f, si = 0.f;
        if (dir == 0) {
            ub[(size_t)mitem * LDA5] = 0; ub[(size_t)mitem * LDA5 + 64] = 0;
            sr = sl[(size_t)mitem * 256]; si = sl[(size_t)mitem * 256 + 64];
            for (int c0 = 0; c0 < nck; c0 += 16) {
                float lr[16], li[16];
#pragma unroll
                for (int j = 0; j < 16; ++j) { lr[j] = sl[(size_t)(base + c0 + j) * 256]; li[j] = sl[(size_t)(base + c0 + j) * 256 + 64]; }
#pragma unroll
                for (int j = 0; j < 16; ++j) {
                    const size_t it = (size_t)(base + c0 + j);
                    ub[it * LDA5] = f2bf(sr); ub[it * LDA5 + 64] = f2bf(si);
                    const float nr = atr * sr - ati * si + lr[j], ni = atr * si + ati * sr + li[j];
                    sr = nr; si = ni;
                }
            }
        } else {
            for (int c0 = nck - 16; c0 >= 0; c0 -= 16) {
                float lr[16], li[16];
#pragma unroll
                for (int j = 0; j < 16; ++j) { lr[j] = sl[(size_t)(base + c0 + j) * 256]; li[j] = sl[(size_t)(base + c0 + j) * 256 + 64]; }
#pragma unroll
                for (int j = 15; j >= 0; --j) {
                    const size_t it = (size_t)(base + c0 + j);
                    ub[it * LDA5] = f2bf(sr); ub[it * LDA5 + 64] = f2bf(si);
                    const float nr = atr * sr - ati * si + lr[j], ni = atr * si + ati * sr + li[j];
                    sr = nr; si = ni;
                }
            }
            ub[(size_t)mitem * LDA5] = f2bf(sr); ub[(size_t)mitem * LDA5 + 64] = f2bf(si);
        }
    }
}

constexpr int LDR = 136;
__device__ __forceinline__ float bf2f(bf16_t h) { return __uint_as_float(((unsigned)h) << 16); }

__device__ __forceinline__ void tr_store_pair(LAS bf16_t* img, int f0, int s2, u32x4 r0, u32x4 r1) {
    LAS unsigned* p = (LAS unsigned*)(img + f0 * LDR + s2);
    p[0 * (LDR / 2)] = (r0.x & 0xFFFFu) | (r1.x << 16); p[1 * (LDR / 2)] = (r0.x >> 16) | (r1.x & 0xFFFF0000u);
    p[2 * (LDR / 2)] = (r0.y & 0xFFFFu) | (r1.y << 16); p[3 * (LDR / 2)] = (r0.y >> 16) | (r1.y & 0xFFFF0000u);
    p[4 * (LDR / 2)] = (r0.z & 0xFFFFu) | (r1.z << 16); p[5 * (LDR / 2)] = (r0.z >> 16) | (r1.z & 0xFFFF0000u);
    p[6 * (LDR / 2)] = (r0.w & 0xFFFFu) | (r1.w << 16); p[7 * (LDR / 2)] = (r0.w >> 16) | (r1.w & 0xFFFF0000u);
}
__device__ __forceinline__ void tr_store_pair_scaled(LAS bf16_t* img, int f0, int s2, u32x4 r0, u32x4 r1, float w0, float w1) {
    LAS unsigned* p = (LAS unsigned*)(img + f0 * LDR + s2);
    p[0 * (LDR / 2)] = cvt_pk_bf16(bflo(r0.x) * w0, bflo(r1.x) * w1); p[1 * (LDR / 2)] = cvt_pk_bf16(bfhi(r0.x) * w0, bfhi(r1.x) * w1);
    p[2 * (LDR / 2)] = cvt_pk_bf16(bflo(r0.y) * w0, bflo(r1.y) * w1); p[3 * (LDR / 2)] = cvt_pk_bf16(bfhi(r0.y) * w0, bfhi(r1.y) * w1);
    p[4 * (LDR / 2)] = cvt_pk_bf16(bflo(r0.z) * w0, bflo(r1.z) * w1); p[5 * (LDR / 2)] = cvt_pk_bf16(bfhi(r0.z) * w0, bfhi(r1.z) * w1);
    p[6 * (LDR / 2)] = cvt_pk_bf16(bflo(r0.w) * w0, bflo(r1.w) * w1); p[7 * (LDR / 2)] = cvt_pk_bf16(bfhi(r0.w) * w0, bfhi(r1.w) * w1);
}

#define LDS_BARRIER() do { asm volatile("s_waitcnt lgkmcnt(0)" ::: "memory"); __builtin_amdgcn_s_barrier(); asm volatile("" ::: "memory"); } while (0)
__device__ __forceinline__ void ret_pass_a(const Args& a, LAS unsigned char* lds) {
    LAS bf16_t* KT = (LAS bf16_t*)lds;
    LAS bf16_t* VT = KT + 128 * LDR;
    const int tid0 = threadIdx.x;
    const bf16_t* kb = (const bf16_t*)(a.ws + OFF_K); const bf16_t* vb = (const bf16_t*)(a.ws + OFF_V);
    bf16_t* stb = (bf16_t*)(a.ws + OFF_ST);
    for (int item = blockIdx.x; item < 192; item += gridDim.x) {
        int tid = tid0; asm volatile("" : "+v"(tid));
        const int w = tid >> 6, lane = tid & 63, fr = lane & 15, fq = lane >> 4;
        int b, h, dir;
        if (item < 128) { b = item >> 3; h = (item >> 1) & 3; dir = item & 1; } else { const int j = item - 128; b = 16 + (j >> 3); h = (j >> 1) & 3; dir = j & 1; }
        const int NC = b < 16 ? 32 : 16, rbase = b < 16 ? b * 4096 : NPR + (b - 16) * 2048, ebase = b < 16 ? b * 33 : 528 + (b - 16) * 17;
        const float lg = logsigf_(a.in[14][dir * 4 + h]);
        const float carry = __expf(lg * 128.f);
        const int s2 = 2 * (8 * w + (lane & 7)), pg = lane >> 3;
        const float wk0 = dir == 0 ? __expf(lg * (float)(127 - s2)) : __expf(lg * (float)s2);
        const float wk1 = dir == 0 ? __expf(lg * (float)(126 - s2)) : __expf(lg * (float)(s2 + 1));
        f32x4 acc[2][8];
#pragma unroll
        for (int et = 0; et < 2; ++et)
#pragma unroll
            for (int dtl = 0; dtl < 8; ++dtl) acc[et][dtl] = (f32x4){0.f, 0.f, 0.f, 0.f};
        const int nsteps = dir == 0 ? NC : NC;
        u32x4 rk[2][2], rv[4][2];
        auto load_chunk = [&](int n) {
            int row0; bool valid = true;
            if (n == 0) { valid = s2 >= 112; row0 = NREAL + b * 16 + (s2 - 112); } else row0 = rbase + (n - 1) * 128 + s2;
#pragma unroll
            for (int it = 0; it < 2; ++it)
#pragma unroll
                for (int r = 0; r < 2; ++r) {
                    rk[it][r] = (u32x4){0u, 0u, 0u, 0u};
                    if (valid) rk[it][r] = *(const u32x4*)(kb + (size_t)(row0 + r) * 512 + h * 128 + (pg + 8 * it) * 8);
                }
#pragma unroll
            for (int it = 0; it < 4; ++it)
#pragma unroll
                for (int r = 0; r < 2; ++r) {
                    rv[it][r] = (u32x4){0u, 0u, 0u, 0u};
                    if (valid) rv[it][r] = *(const u32x4*)(vb + (size_t)(row0 + r) * 1024 + h * 256 + (pg + 8 * it) * 8);
                }
        };
        load_chunk(dir == 0 ? 0 : NC);
        for (int step = 0; step < nsteps; ++step) {
            const int n = dir == 0 ? step : NC - step;
            {
                bf16_t* spn = stb + ((size_t)((ebase + n) * 4 + h) * 2 + dir) * 32768;
#pragma unroll
                for (int et = 0; et < 2; ++et)
#pragma unroll
                    for (int dtl = 0; dtl < 8; ++dtl) {
                        u32x2 o; o.x = cvt_pk_bf16(acc[et][dtl][0], acc[et][dtl][1]); o.y = cvt_pk_bf16(acc[et][dtl][2], acc[et][dtl][3]);
                        *(u32x2*)(spn + (size_t)(32 * w + 16 * et + fr) * 128 + 16 * dtl + 4 * fq) = o;
                    }
            }
            LDS_BARRIER();
#pragma unroll
            for (int it = 0; it < 2; ++it) tr_store_pair_scaled(KT, (pg + 8 * it) * 8, s2, rk[it][0], rk[it][1], wk0, wk1);
#pragma unroll
            for (int it = 0; it < 4; ++it) tr_store_pair(VT, (pg + 8 * it) * 8, s2, rv[it][0], rv[it][1]);
            if (step + 1 < nsteps) load_chunk(dir == 0 ? step + 1 : NC - step - 1);
            LDS_BARRIER();
#pragma unroll
            for (int et = 0; et < 2; ++et)
#pragma unroll
                for (int dtl = 0; dtl < 8; ++dtl) acc[et][dtl] = acc[et][dtl] * carry;
#pragma unroll
            for (int ks = 0; ks < 4; ++ks) {
                bf16x8 vf[2];
#pragma unroll
                for (int et = 0; et < 2; ++et) vf[et] = *(const LAS bf16x8*)(VT + (32 * w + 16 * et + fr) * LDR + 32 * ks + 8 * fq);
#pragma unroll
                for (int dtl = 0; dtl < 8; ++dtl) {
                    const bf16x8 kf = *(const LAS bf16x8*)(KT + (16 * dtl + fr) * LDR + 32 * ks + 8 * fq);
#pragma unroll
                    for (int et = 0; et < 2; ++et) acc[et][dtl] = __builtin_amdgcn_mfma_f32_16x16x32_bf16(kf, vf[et], acc[et][dtl], 0, 0, 0);
                }
            }
        }
        if (dir == 0) {
            bf16_t* spn = stb + ((size_t)((ebase + NC) * 4 + h) * 2 + dir) * 32768;
#pragma unroll
            for (int et = 0; et < 2; ++et)
#pragma unroll
                for (int dtl = 0; dtl < 8; ++dtl) {
                    u32x2 o; o.x = cvt_pk_bf16(acc[et][dtl][0], acc[et][dtl][1]); o.y = cvt_pk_bf16(acc[et][dtl][2], acc[et][dtl][3]);
                    *(u32x2*)(spn + (size_t)(32 * w + 16 * et + fr) * 128 + 16 * dtl + 4 * fq) = o;
                }
        }
        LDS_BARRIER();
    }
}

__device__ __forceinline__ void ret_pass_b(const Args& a, LAS unsigned char* lds) {
    LAS bf16_t* KL = (LAS bf16_t*)lds;
    LAS bf16_t* BG = KL + 128 * LDR;
    const int tid0 = threadIdx.x;
    const bf16_t* qb = (const bf16_t*)(a.ws + OFF_Q); const bf16_t* kb = (const bf16_t*)(a.ws + OFF_K); const bf16_t* vb = (const bf16_t*)(a.ws + OFF_V);
    const bf16_t* stb = (const bf16_t*)(a.ws + OFF_ST);
    bf16_t* sg = (bf16_t*)a.out;
    u32x4 rk[4], rb[8]; bf16x8 qf[4];
    auto item_info = [&](int item, int& r0, int& h, const bf16_t*& sfp) {
        const int rc = item >> 2; h = item & 3;
        int b, n; if (rc < 512) { b = rc >> 5; n = (rc & 31) + 1; } else { b = 16 + ((rc - 512) >> 4); n = ((rc - 512) & 15) + 1; }
        const int ebase = b < 16 ? b * 33 : 528 + (b - 16) * 17; r0 = rc * 128;
        sfp = stb + ((size_t)((ebase + n) * 4 + h) * 2 + 0) * 32768;
    };
    auto load_item_head = [&](int item, int tid) {
        int r0, h; const bf16_t* sfp; item_info(item, r0, h, sfp);
#pragma unroll
        for (int it = 0; it < 8; ++it) { const int idx = tid + it * 512, e = idx >> 4, pc = idx & 15; rb[it] = *(const u32x4*)(sfp + (size_t)e * 128 + pc * 8); }
    };
    auto load_item_kq = [&](int item, int tid) {
        int r0, h; const bf16_t* sfp; item_info(item, r0, h, sfp);
        const int w = tid >> 6, lane = tid & 63, fr = lane & 15, fq = lane >> 4;
#pragma unroll
        for (int it = 0; it < 4; ++it) { const int idx = tid + it * 512, s = idx >> 4, pc = idx & 15; rk[it] = *(const u32x4*)(kb + (size_t)(r0 + s) * 512 + h * 128 + pc * 8); }
#pragma unroll
        for (int ks = 0; ks < 4; ++ks) qf[ks] = *(const bf16x8*)(qb + (size_t)(r0 + 16 * w + fr) * 512 + h * 128 + 32 * ks + 8 * fq);
    };
    if ((int)blockIdx.x < 2560) { load_item_head(blockIdx.x, tid0); load_item_kq(blockIdx.x, tid0); }
    for (int item = blockIdx.x; item < 2560; item += gridDim.x) {
        int tid = tid0; asm volatile("" : "+v"(tid));
        const int w = tid >> 6, lane = tid & 63, fr = lane & 15, fq = lane >> 4;
        int r0, h; const bf16_t* sfp; item_info(item, r0, h, sfp);
        const bf16_t* sbp = sfp + 32768;
        const float lgf = logsigf_(a.in[14][h]), lgb = logsigf_(a.in[14][4 + h]);
        const int crow = 16 * w + fr;
        LDS_BARRIER();
#pragma unroll
        for (int it = 0; it < 4; ++it) { const int idx = tid + it * 512, s = idx >> 4, pc = idx & 15; *(LAS u32x4*)(KL + s * LDR + pc * 8) = rk[it]; }
#pragma unroll
        for (int it = 0; it < 8; ++it) { const int idx = tid + it * 512, e = idx >> 4, pc = idx & 15; *(LAS u32x4*)(BG + e * LDR + pc * 8) = rb[it]; }
#pragma unroll
        for (int it = 0; it < 8; ++it) { const int idx = tid + it * 512, e = idx >> 4, pc = idx & 15; rb[it] = *(const u32x4*)(sbp + (size_t)e * 128 + pc * 8); }
        LDS_BARRIER();
        f32x4 sacc[8];
#pragma unroll
        for (int st = 0; st < 8; ++st) sacc[st] = (f32x4){0.f, 0.f, 0.f, 0.f};
#pragma unroll
        for (int ks = 0; ks < 4; ++ks)
#pragma unroll
            for (int st = 0; st < 8; ++st) {
                const bf16x8 kf = *(const LAS bf16x8*)(KL + (16 * st + fr) * LDR + 32 * ks + 8 * fq);
                sacc[st] = __builtin_amdgcn_mfma_f32_16x16x32_bf16(kf, qf[ks], sacc[st], 0, 0, 0);
                if (st == 7) __builtin_amdgcn_sched_barrier(0);
            }
        bf16x8 pf[4];
#pragma unroll
        for (int t = 0; t < 4; ++t) {
            float pv[8];
#pragma unroll
            for (int hh = 0; hh < 2; ++hh)
#pragma unroll
                for (int j = 0; j < 4; ++j) {
                    const int spp = 16 * (2 * t + hh) + 4 * fq + j, diff = crow - spp;
                    const float dec = diff >= 0 ? __expf(lgf * (float)diff) : __expf(-lgb * (float)diff);
                    pv[hh * 4 + j] = sacc[2 * t + hh][j] * dec;
                }
            u32x4 pw; pw.x = cvt_pk_bf16(pv[0], pv[1]); pw.y = cvt_pk_bf16(pv[2], pv[3]); pw.z = cvt_pk_bf16(pv[4], pv[5]); pw.w = cvt_pk_bf16(pv[6], pv[7]);
            pf[t] = __builtin_bit_cast(bf16x8, pw);
        }
        f32x4 o[16];
#pragma unroll
        for (int et = 0; et < 16; ++et) o[et] = (f32x4){0.f, 0.f, 0.f, 0.f};
#pragma unroll
        for (int ks = 0; ks < 4; ++ks)
#pragma unroll
            for (int et = 0; et < 16; ++et) {
                const bf16x8 sf = *(const LAS bf16x8*)(BG + (16 * et + fr) * LDR + 32 * ks + 8 * fq);
                o[et] = __builtin_amdgcn_mfma_f32_16x16x32_bf16(sf, qf[ks], o[et], 0, 0, 0);
                if ((et & 7) == 7) __builtin_amdgcn_sched_barrier(0);
            }
        const float wqf = __expf(lgf * (float)(crow + 1)), wqb = __expf(lgb * (float)(128 - crow));
        const float ratio = wqf / wqb;
#pragma unroll
        for (int et = 0; et < 16; ++et) o[et] = o[et] * ratio;
        LDS_BARRIER();
#pragma unroll
        for (int it = 0; it < 8; ++it) { const int idx = tid + it * 512, e = idx >> 4, pc = idx & 15; *(LAS u32x4*)(BG + e * LDR + pc * 8) = rb[it]; }
        {
            const int s2 = 2 * (8 * w + (lane & 7));
#pragma unroll
            for (int it = 0; it < 4; ++it)
#pragma unroll
                for (int r = 0; r < 2; ++r) rb[it * 2 + r] = *(const u32x4*)(vb + (size_t)(r0 + s2 + r) * 1024 + h * 256 + ((lane >> 3) + 8 * it) * 8);
        }
        LDS_BARRIER();
#pragma unroll
        for (int ks = 0; ks < 4; ++ks)
#pragma unroll
            for (int et = 0; et < 16; ++et) {
                const bf16x8 sf = *(const LAS bf16x8*)(BG + (16 * et + fr) * LDR + 32 * ks + 8 * fq);
                o[et] = __builtin_amdgcn_mfma_f32_16x16x32_bf16(sf, qf[ks], o[et], 0, 0, 0);
                if ((et & 7) == 7) __builtin_amdgcn_sched_barrier(0);
            }
#pragma unroll
        for (int et = 0; et < 16; ++et) o[et] = o[et] * wqb;
        LDS_BARRIER();
#pragma unroll
        for (int it = 0; it < 4; ++it) tr_store_pair(BG, ((lane >> 3) + 8 * it) * 8, 2 * (8 * w + (lane & 7)), rb[it * 2], rb[it * 2 + 1]);
        if (item + (int)gridDim.x < 2560) load_item_head(item + gridDim.x, tid);
        LDS_BARRIER();
#pragma unroll
        for (int t = 0; t < 4; ++t)
#pragma unroll
            for (int et = 0; et < 16; ++et) {
                const u32x2 lo = *(const LAS u32x2*)(BG + (16 * et + fr) * LDR + 32 * t + 4 * fq);
                const u32x2 hi = *(const LAS u32x2*)(BG + (16 * et + fr) * LDR + 32 * t + 16 + 4 * fq);
                const u32x4 vw = (u32x4){lo.x, lo.y, hi.x, hi.y};
                o[et] = __builtin_amdgcn_mfma_f32_16x16x32_bf16(__builtin_bit_cast(bf16x8, vw), pf[t], o[et], 0, 0, 0);
                if ((et & 7) == 7) __builtin_amdgcn_sched_barrier(0);
            }
        float ss = 0.f;
#pragma unroll
        for (int et = 0; et < 16; ++et) ss += (o[et][0] * o[et][0] + o[et][1] * o[et][1]) + (o[et][2] * o[et][2] + o[et][3] * o[et][3]);
        ss += __shfl_xor(ss, 16); ss += __shfl_xor(ss, 32);
        const float rn = rsqrtf(ss * (1.0f / 256.0f) + EPS);
        bf16_t* gp = sg + (size_t)(r0 + crow) * 1024 + h * 256 + 4 * fq;
        u32x2 gwv[16];
#pragma unroll
        for (int et = 0; et < 16; ++et) gwv[et] = *(const u32x2*)(gp + 16 * et);
        if (item + (int)gridDim.x < 2560) load_item_kq(item + gridDim.x, tid);
#pragma unroll
        for (int et = 0; et < 16; ++et) {
            const u32x2 gw = gwv[et];
            u32x2 ow; ow.x = cvt_pk_bf16(o[et][0] * rn * bflo(gw.x), o[et][1] * rn * bfhi(gw.x)); ow.y = cvt_pk_bf16(o[et][2] * rn * bflo(gw.y), o[et][3] * rn * bfhi(gw.y));
            *(u32x2*)(gp + 16 * et) = ow;
        }
    }
    LDS_BARRIER();
}

__device__ __forceinline__ void final_norm(const Args& a) {
    const int wave = threadIdx.x >> 6, lane = threadIdx.x & 63;
    const float* ssq = (const float*)(a.ws + OFF_SSQ2);
    f32x4 gg[4];
#pragma unroll
    for (int j = 0; j < 4; ++j) gg[j] = *(const f32x4*)(a.in[20] + (j * 64 + lane) * 4);
    for (int rowb = (blockIdx.x * 8 + wave) * 4; rowb < NREAL; rowb += gridDim.x * 32) {
        float part[4]; u32x2 w[4][4];
#pragma unroll
        for (int q = 0; q < 4; ++q) {
            part[q] = lane < 16 ? ssq[(size_t)(rowb + q) * 16 + lane] : 0.f;
            const bf16_t* hrow = (const bf16_t*)(a.ws + OFF_H1B) + (size_t)(rowb + q) * 1024;
#pragma unroll
            for (int j = 0; j < 4; ++j) w[q][j] = *(const u32x2*)(hrow + (j * 64 + lane) * 4);
        }
#pragma unroll
        for (int q = 0; q < 4; ++q) {
            const float rstd = rsqrtf(wave_sum(part[q]) * (1.0f / 1024.0f) + EPS);
            float* orow = a.out + (size_t)(rowb + q) * 1024;
#pragma unroll
            for (int j = 0; j < 4; ++j) {
                f32x4 v;
                v[0] = bflo(w[q][j].x) * rstd * gg[j][0]; v[1] = bfhi(w[q][j].x) * rstd * gg[j][1]; v[2] = bflo(w[q][j].y) * rstd * gg[j][2]; v[3] = bfhi(w[q][j].y) * rstd * gg[j][3];
                *(f32x4*)(orow + (j * 64 + lane) * 4) = v;
            }
        }
    }
}

template <int ph>
__device__ __forceinline__ void run_phase(const Args& a, LAS unsigned char* lds) {
    unsigned char* ws = a.ws;
    bf16_t* dob = (bf16_t*)a.out;
    bf16_t* sgp = dob; bf16_t* gap = dob + (size_t)NREAL * 1024;
#ifdef ONLY_PH
    if (ph != ONLY_PH) return;
#endif
    switch (ph) {
    case 0: phase0(a, lds); break;
    case 1: {
        pg8::Gemm g{(const bf16_t*)(ws + OFF_N1), (const bf16_t*)(ws + OFF_WIN), 1024, 1024, 1024, RPAD / 256, INW / 256, 1, 0, 0, STG};
        EpiProj E{(bf16_t*)(ws + OFF_U5), (bf16_t*)(ws + OFF_Q), (bf16_t*)(ws + OFF_K), (bf16_t*)(ws + OFF_V), sgp, gap, (bf16_t*)(ws + OFF_GB), (const LAS double*)(lds + 131072)};
        pg8::gemm_phase(lds, g, E);
    } break;
    case 2: {
        pg8::Gemm g{(const bf16_t*)(ws + OFF_U5), (const bf16_t*)(ws + OFF_BTS), LDA5, 512, 512, IT_PAD / 256, 1, 32, (size_t)IT_PAD * LDA5, (size_t)256 * 512, 0};
        EpiSloc E{(float*)(ws + OFF_SLOC)};
        pg8::gemm_phase(lds, g, E);
    } break;
    case 3: s5_scan(a); break;
    case 4: {
        pg8::Gemm g{(const bf16_t*)(ws + OFF_U5), (const bf16_t*)(ws + OFF_BTY), LDA5, 768, 768, IT_PAD / 256, 2, 32, (size_t)IT_PAD * LDA5, (size_t)512 * 768, 0};
        EpiY E{(bf16_t*)(ws + OFF_YSSM)};
        pg8::gemm_phase(lds, g, E);
    } break;
    case 5: {
        ret_pass_a(a, lds);
        const int bx = (int)blockIdx.x, sub = bx >= 192 ? bx - 192 : (bx >= 128 ? bx - 128 : 0);
        const int u0 = bx >= 192 ? 0 : (bx >= 128 ? GLU_SPLIT : GLU_SPLIT2), u1 = bx >= 192 ? GLU_SPLIT : GLU_SPLIT2;
        pg8::Gemm g{(const bf16_t*)(ws + OFF_YSSM), (const bf16_t*)(ws + OFF_WGLU), 512, 512, 512, NREAL / 256, 8, 1, 0, 0, STG, 64, sub, u0, u1};
        EpiGlu E{gap};
        pg8::gemm_phase(lds, g, E);
    } break;
    case 6: {
        pg8::Gemm g{(const bf16_t*)(ws + OFF_YSSM), (const bf16_t*)(ws + OFF_WGLU), 512, 512, 512, NREAL / 256, 8, 1, 0, 0, STG, (int)gridDim.x, (int)blockIdx.x, GLU_SPLIT2, 2560};
        EpiGlu E{gap};
        pg8::gemm_phase(lds, g, E);
    } break;
    case 7: ret_pass_b(a, lds); break;
    case 8: {
        pg8::Gemm g{sgp, (const bf16_t*)(ws + OFF_WRET), 1024, 1024, 1024, NREAL / 256, 4, 1, 0, 0, STG};
        EpiRet E{gap, (const bf16_t*)(ws + OFF_GB), (bf16_t*)(ws + OFF_MIXED)};
        pg8::gemm_phase(lds, g, E);
    } break;
    case 9: {
        pg8::Gemm g{(const bf16_t*)(ws + OFF_MIXED), (const bf16_t*)(ws + OFF_WOUT), 1024, 1024, 1024, NREAL / 256, 4, 1, 0, 0, STG};
        EpiRes<0> E{a.in[0], a.in[1], (bf16_t*)(ws + OFF_H1B), (float*)(ws + OFF_SSQ1)};
        pg8::gemm_phase(lds, g, E);
    } break;
    case 10: {
        pg8::Gemm g{(const bf16_t*)(ws + OFF_H1B), (const bf16_t*)(ws + OFF_WFFI), 1024, 1024, 1024, NREAL / 256, INW / 256, 1, 0, 0, STG};
        EpiFfi E{(const float*)(ws + OFF_SSQ1), (bf16_t*)(ws + OFF_ACT)};
        pg8::gemm_phase(lds, g, E);
    } break;
    case 11: {
        pg8::Gemm g{(const bf16_t*)(ws + OFF_ACT), (const bf16_t*)(ws + OFF_WFFO), DFF, DFF, DFF, NREAL / 256, 4, 1, 0, 0, STG};
        EpiRes<1> E{nullptr, nullptr, (bf16_t*)(ws + OFF_H1B), (float*)(ws + OFF_SSQ2)};
        pg8::gemm_phase(lds, g, E);
    } break;
    case 12: final_norm(a); break;
    default: break;
    }
}

#define XB_TMO      128
#define XB_XCNT(j)  (256  + 64 * (j))
#define XB_XSUB(j)  (1280 + 64 * (j))
#define XB_XGEN(j)  (2304 + 64 * (j))
#define XB_TOP      3328
#define XB_TOPGEN   3392
#define XCD_BAR_WORDS 3456
#define XB_SPIN_CAP (1u << 18)

__device__ __forceinline__ unsigned xb_ld(unsigned* p)              { return __hip_atomic_load(p, __ATOMIC_RELAXED, __HIP_MEMORY_SCOPE_AGENT); }
__device__ __forceinline__ unsigned xb_add(unsigned* p, unsigned v) { return __hip_atomic_fetch_add(p, v, __ATOMIC_RELAXED, __HIP_MEMORY_SCOPE_AGENT); }
__device__ __forceinline__ unsigned xb_xcc_id() { return (unsigned)__builtin_amdgcn_s_getreg((3 << 11) | 20) & 0xFu; }
#define XB_SPIN(cond, bar) do { unsigned _sp = 0; while (cond) { __builtin_amdgcn_s_sleep(1); \
    if ((++_sp & 255u) == 0u) { if (xb_ld(&(bar)[XB_TMO])) break; if (_sp > XB_SPIN_CAP) { atomicAdd(&(bar)[XB_TMO], 1u); break; } } } } while (0)

struct XcdBarrier {
    unsigned* bar; unsigned x;
    volatile LAS unsigned* st;
};

__device__ __forceinline__ XcdBarrier xcd_barrier_post(unsigned* bar, volatile LAS unsigned* st) {
    XcdBarrier b; b.bar = bar; b.x = xb_xcc_id(); b.st = st;
    if (threadIdx.x == 0) (void)xb_add(&bar[XB_XCNT(b.x)], 1u);
    return b;
}
__device__ __forceinline__ void xcd_barrier_complete(unsigned* bar, unsigned x, unsigned& nloc, unsigned& nx) {
    const unsigned G = gridDim.x * gridDim.y * gridDim.z;
    unsigned sum, cnt, mine, sp = 0u;
    for (;;) {
        sum = 0u; cnt = 0u; mine = 0u;
#pragma unroll
        for (unsigned j = 0; j < 16; ++j) { const unsigned c = xb_ld(&bar[XB_XCNT(j)]); sum += c; cnt += (c > 0u) ? 1u : 0u; mine = (j == x) ? c : mine; }
        if (sum == G) break;
        __builtin_amdgcn_s_sleep(1);
        if ((++sp & 255u) == 0u) { if (xb_ld(&bar[XB_TMO])) break; if (sp > XB_SPIN_CAP) { atomicAdd(&bar[XB_TMO], 1u); break; } }
    }
    nloc = mine > 0u ? mine : 1u; nx = cnt > 0u ? cnt : 1u;
}

__device__ __forceinline__ void xcd_barrier(const XcdBarrier& b) {
    asm volatile("s_waitcnt vmcnt(0)" ::: "memory");
    __syncthreads();
    if (threadIdx.x == 0) {
        unsigned* bar = b.bar;
        __builtin_amdgcn_s_waitcnt(0);
        unsigned nloc = b.st[0], nx = b.st[1];
        if (nloc == 0u) { xcd_barrier_complete(bar, b.x, nloc, nx); b.st[0] = nloc; b.st[1] = nx; }
        const unsigned old = xb_add(&bar[XB_XSUB(b.x)], 1u);
        const unsigned gen = old / nloc;
        if (old + 1u == (gen + 1u) * nloc) {
            __builtin_amdgcn_fence(__ATOMIC_RELEASE, "agent");
            asm volatile("s_waitcnt vmcnt(0)" ::: "memory");
            const unsigned og = xb_add(&bar[XB_TOP], 1u);
            const unsigned tg = og / nx;
            if (og + 1u == (tg + 1u) * nx) xb_add(&bar[XB_TOPGEN], 1u);
            else XB_SPIN(xb_ld(&bar[XB_TOPGEN]) == tg, bar);
            __builtin_amdgcn_fence(__ATOMIC_ACQUIRE, "agent");
            xb_add(&bar[XB_XGEN(b.x)], 1u);
            asm volatile("s_waitcnt vmcnt(0)" ::: "memory");
        } else {
            XB_SPIN(xb_ld(&bar[XB_XGEN(b.x)]) == gen, bar);
            __builtin_amdgcn_fence(__ATOMIC_ACQUIRE, "agent");
            asm volatile("s_waitcnt vmcnt(0)" ::: "memory");
        }
    }
    __syncthreads();
}


__device__ __forceinline__ void grid_barrier(unsigned* ctr, unsigned target) {
    asm volatile("s_waitcnt vmcnt(0) lgkmcnt(0)" ::: "memory");
    __syncthreads();
    if (threadIdx.x == 0) {
        __builtin_amdgcn_fence(__ATOMIC_RELEASE, "agent");
        asm volatile("s_waitcnt vmcnt(0)" ::: "memory");
        __hip_atomic_fetch_add(ctr, 1u, __ATOMIC_RELAXED, __HIP_MEMORY_SCOPE_AGENT);
        unsigned spins = 0;
        while (__hip_atomic_load(ctr, __ATOMIC_RELAXED, __HIP_MEMORY_SCOPE_AGENT) < target && ++spins < (1u << 24)) __builtin_amdgcn_s_sleep(2);
        __builtin_amdgcn_fence(__ATOMIC_ACQUIRE, "agent");
        asm volatile("s_waitcnt vmcnt(0)" ::: "memory");
    }
    __syncthreads();
}

template <bool COOP>
__global__ __launch_bounds__(512, 2) void fwd_kernel(Args a) {
    extern __shared__ __attribute__((aligned(16))) unsigned char shm[];
    LAS unsigned char* lds = (LAS unsigned char*)shm;
    if (threadIdx.x < 64) ((LAS double*)(lds + 131072))[threadIdx.x] = exp2(-(double)threadIdx.x * (13.287712379549449 / 64.0));
    volatile LAS unsigned* xst = (volatile LAS unsigned*)(lds + 131072 + 528);
    if (threadIdx.x == 0) { xst[0] = 0u; xst[1] = 0u; }
    __syncthreads();
    XcdBarrier xb{}; if (COOP) xb = xcd_barrier_post((unsigned*)(a.ws + OFF_BAR), xst);
    if (COOP && a.ph_hi > NPHASE) cg::this_grid().sync();
#define RUN_PH(P) if (a.ph_lo <= P && P < a.ph_hi) { run_phase<P>(a, lds); if ((DBL_MASK >> P) & 1) run_phase<P>(a, lds); if (COOP && P + 1 < a.ph_hi) { xcd_barrier(xb); } }
    RUN_PH(0) RUN_PH(1) RUN_PH(2) RUN_PH(3) RUN_PH(4) RUN_PH(5) RUN_PH(6) RUN_PH(7) RUN_PH(8) RUN_PH(9) RUN_PH(10) RUN_PH(11) RUN_PH(12)
#undef RUN_PH
}

extern "C" void kernel_launch(void* const* d_in, const int* in_sizes, int n_in, void* d_out, int out_size, void* d_ws, size_t ws_size, hipStream_t stream) {
    static int grid = 0;
    if (grid == 0) {
        if (n_in != 21 || ws_size < WS_NEED || out_size != NREAL * 1024) { fprintf(stderr, "kernel_launch: unexpected shapes (n_in %d, ws %zu need %zu, out %d)\n", n_in, ws_size, (size_t)WS_NEED, out_size); grid = -1; return; }
        int dev = 0, cus = 0;
        hipGetDevice(&dev); hipDeviceGetAttribute(&cus, hipDeviceAttributeMultiprocessorCount, dev);
        hipFuncSetAttribute((const void*)fwd_kernel<true>, hipFuncAttributeMaxDynamicSharedMemorySize, LDS_BYTES);
        hipFuncSetAttribute((const void*)fwd_kernel<false>, hipFuncAttributeMaxDynamicSharedMemorySize, LDS_BYTES);
        int per_cu = 0;
        hipOccupancyMaxActiveBlocksPerMultiprocessor(&per_cu, (const void*)fwd_kernel<true>, 512, LDS_BYTES);
        if (per_cu < 1) { fprintf(stderr, "kernel_launch: occupancy query says %d blocks per CU\n", per_cu); per_cu = 1; }
        (void)hipGetLastError();
        grid = cus * 1;
    }
    if (grid < 0) return;
    Args a{};
    for (int i = 0; i < 21; ++i) a.in[i] = (const float*)d_in[i];
    a.out = (float*)d_out; a.ws = (unsigned char*)d_ws;
#if COOP_MODE
    hipMemsetAsync((char*)d_ws + OFF_BAR, 0, 4096 * 4 + 256, stream);
    a.ph_lo = 0; a.ph_hi = NPHASE;
    void* args[] = {&a};
    hipError_t e = hipLaunchCooperativeKernel((const void*)fwd_kernel<true>, dim3(grid), dim3(512), args, LDS_BYTES, stream);
    if (e != hipSuccess) fprintf(stderr, "cooperative launch failed: %s (grid %d)\n", hipGetErrorString(e), grid);
#else
    for (int ph = 0; ph < NPHASE; ++ph) {
        a.ph_lo = ph; a.ph_hi = ph + 1;
        hipLaunchKernelGGL(fwd_kernel<false>, dim3(grid), dim3(512), LDS_BYTES, stream, a);
    }
#endif
}
```

```cpp
#include <hip/hip_runtime.h>
#include <hip/hip_cooperative_groups.h>
#include <cstdio>
#include <cstdint>
namespace cg = cooperative_groups;

#ifndef COOP_MODE
#define COOP_MODE 1
#endif

#define DBL_MASK 0x0
#define LAS __attribute__((address_space(3)))
typedef unsigned short bf16_t;
typedef short bf16x8 __attribute__((ext_vector_type(8)));
typedef float f32x4 __attribute__((ext_vector_type(4)));
typedef unsigned u32x4 __attribute__((ext_vector_type(4)));
typedef unsigned u32x2 __attribute__((ext_vector_type(2)));

constexpr int D = 1024, NREAL = 81920, NPR = 65536, RPAD = 82432, NVALID = 82304;
constexpr int INW = 5632, DFF = 2816;
constexpr int T5 = 32, IT_REAL = 2560, IT_PAD = 2816, LDA5 = 768;
constexpr float EPS = 1e-6f;

constexpr size_t OFF_WIN = 0;
constexpr size_t OFF_WGLU = OFF_WIN + (size_t)INW * D * 2;
constexpr size_t OFF_WRET = OFF_WGLU + (size_t)2048 * 512 * 2;
constexpr size_t OFF_WOUT = OFF_WRET + (size_t)D * D * 2;
constexpr size_t OFF_WFFI = OFF_WOUT + (size_t)D * D * 2;
constexpr size_t OFF_WFFO = OFF_WFFI + (size_t)INW * D * 2;
constexpr size_t OFF_AT = OFF_WFFO + (size_t)D * DFF * 2;
constexpr size_t OFF_BAR = OFF_AT + 32768;
constexpr size_t OFF_Q = OFF_AT + 65536;
constexpr size_t OFF_K = OFF_Q + (size_t)RPAD * 512 * 2;
constexpr size_t OFF_V = OFF_K + (size_t)RPAD * 512 * 2;
constexpr size_t OFF_GB = OFF_V + (size_t)RPAD * D * 2;
constexpr size_t OFF_SSQ1 = OFF_GB + (size_t)NREAL * D * 2;
constexpr size_t OFF_SSQ2 = OFF_SSQ1 + (size_t)NREAL * 16 * 4;
constexpr size_t OFF_X = OFF_SSQ2 + (size_t)NREAL * 16 * 4;
constexpr size_t OFF_N1 = OFF_X;
constexpr size_t OFF_YSSM = OFF_X + (size_t)664 * 8 * 65536;
constexpr size_t OFF_U5 = OFF_N1 + (size_t)RPAD * D * 2;
constexpr size_t OFF_BTY = OFF_U5 + (size_t)32 * IT_PAD * LDA5 * 2;
constexpr size_t OFF_BTS = OFF_BTY + (size_t)32 * 512 * 768 * 2;
constexpr size_t OFF_SLOC = OFF_BTS + (size_t)32 * 256 * 512 * 2;
constexpr size_t END_X03 = OFF_SLOC + (size_t)32 * IT_PAD * 256 * 4;
constexpr size_t OFF_ST = OFF_X;
constexpr size_t END_ST = OFF_ST + (size_t)664 * 8 * 65536;
constexpr size_t OFF_ACT = OFF_X;
constexpr size_t END_ACT = OFF_ACT + (size_t)NREAL * DFF * 2;
constexpr size_t OFF_MIXED = OFF_Q;
constexpr size_t OFF_H1B = OFF_V;
constexpr size_t cmax(size_t a, size_t b) { return a > b ? a : b; }
constexpr size_t WS_NEED = cmax(END_X03, cmax(END_ST, END_ACT));

constexpr int LDS_BYTES = 131072 + 1024;
constexpr int NPHASE = 13;
constexpr int GLU_SPLIT = 64 * 14, GLU_SPLIT2 = GLU_SPLIT + 64 * 6;
constexpr int STG = 0;

struct Args {
    const float* in[21];
    float* out;
    unsigned char* ws;
    int ph_lo, ph_hi;
};

__device__ __forceinline__ unsigned cvt_pk_bf16(float lo, float hi) { unsigned r; asm volatile("v_cvt_pk_bf16_f32 %0, %1, %2" : "=v"(r) : "v"(lo), "v"(hi)); return r; }
__device__ __forceinline__ bf16_t f2bf(float f) { return (bf16_t)(cvt_pk_bf16(f, 0.f) & 0xFFFFu); }
__device__ __forceinline__ float bflo(unsigned w) { return __uint_as_float(w << 16); }
__device__ __forceinline__ float bfhi(unsigned w) { return __uint_as_float(w & 0xFFFF0000u); }
__device__ __forceinline__ float sigmoidf_(float x) { return __fdividef(1.0f, 1.0f + __expf(-x)); }
__device__ __forceinline__ float siluf_(float x) { return x * sigmoidf_(x); }
__device__ __forceinline__ float gelu_tanh(float x) { const float z = 0.7978845608028654f * (x + 0.044715f * x * x * x); return x * sigmoidf_(2.0f * z); }
__device__ __forceinline__ float logsigf_(float x) { return fminf(x, 0.f) - log1pf(__expf(-fabsf(x))); }
__device__ __forceinline__ float wave_sum(float v) {
#pragma unroll
    for (int o = 1; o < 64; o <<= 1) v += __shfl_xor(v, o);
    return v;
}
__device__ __forceinline__ void sincos_rev(double ang, float& s, float& c) {
    double x = ang * 0.15915494309189535; x -= rint(x);
    const float xf = (float)x;
    s = __builtin_amdgcn_sinf(xf); c = __builtin_amdgcn_cosf(xf);
}

namespace pg8 {
constexpr int BM = 256, BK = 64, HALF = 128, HTB = HALF * BK * 2, STAGE_BYTES = 8 * HTB, NXCD = 8, WGM = 8;
__device__ __forceinline__ int lds_byte(int r, int c) { const int st = (r >> 4) * 2 + (c >> 5), rr = r & 15, cc = c & 31, ob = rr * 64 + cc * 2; return st * 1024 + (ob ^ (((ob >> 9) & 1) << 5)); }
__device__ __forceinline__ void stage_rc(int b, int& R, int& C) { const int st = b / 1024, sb = b % 1024, swz = sb ^ (((sb >> 9) & 1) << 5); R = (st >> 1) * 16 + swz / 64; C = (st & 1) * 32 + (swz % 64) / 2; }
__device__ __forceinline__ int perm32(int rho) { const int n = rho >> 4, i = rho & 15; return 8 * (i >> 2) + 4 * n + (i & 3); }

struct Unit { int pm, pn, g; };
struct Gemm { const bf16_t* A; const bf16_t* Bt; int lda, ldb, K, nM, nN, nb; size_t sA, sB; int stagger; int G, c, u0, u1; };

struct Order {
    int nM, nN, nwg, total, G, c, u0;
    __device__ void init(int nM_, int nN_, int nb, int G_, int c_, int u0_, int u1_) { nM = nM_; nN = nN_; nwg = nM * nN; total = u1_ > 0 ? u1_ : nwg * nb; G = G_; c = c_; u0 = u0_; }
    __device__ bool next(int i, Unit& u) const {
        const long L = (long)u0 + (long)i * G + c; if (L >= total) return false;
        u.g = (int)(L / nwg); int wgid = (int)(L % nwg);
        { const int q = nwg / NXCD, r = nwg % NXCD, xcd = wgid % NXCD, off = wgid / NXCD; wgid = (xcd < r ? xcd * (q + 1) : r * (q + 1) + (xcd - r) * q) + off; }
        const int nig = WGM * nN, gid = wgid / nig, fm = gid * WGM, gsz = (nM - fm) < WGM ? (nM - fm) : WGM;
        u.pm = fm + ((wgid % nig) % gsz); u.pn = (wgid % nig) / gsz; return true;
    }
};

template <class Epi>
__device__ __forceinline__ void gemm_phase(LAS unsigned char* lds, const Gemm g, const Epi& E) {
    const int tid = threadIdx.x, wid = __builtin_amdgcn_readfirstlane(tid >> 6), lane = tid & 63, wr = wid >> 2, wc = wid & 3, fr = lane & 15, fq = lane >> 4;
    const int K = g.K, nt = K / BK;
    Order S; S.init(g.nM, g.nN, g.nb, g.G > 0 ? g.G : (int)gridDim.x, g.G > 0 ? g.c : (int)blockIdx.x, g.u0, g.u1);
    unsigned voffA[2], voffB[2];
#pragma unroll
    for (int i = 0; i < 2; ++i) { int R, C; stage_rc(tid * 16 + i * 8192, R, C); const int Rb = (R & ~31) + perm32(R & 31);
        voffA[i] = (unsigned)(R * g.lda + C) * 2u; voffB[i] = (unsigned)(Rb * g.ldb + C) * 2u; }
    const size_t kstep = (size_t)(BK * 2);
    const size_t hstepA = (size_t)HALF * g.lda * 2, hstepB = (size_t)HALF * g.ldb * 2;
    const size_t tstepA = 2 * hstepA, tstepB = 2 * hstepB;
    const unsigned ldsw = (unsigned)wid * 1024u;
    const int aoff = lds_byte(wr * 64 + fr, fq * 8), boff = lds_byte(wc * 32 + fr, fq * 8);
#define PG8_SA(b, h) (((b) * 2 + (h)) * HTB)
#define PG8_SB(b, h) ((4 + (b) * 2 + (h)) * HTB)
#define PG8_STAGE(bufoff, gbase, voff) do { _Pragma("unroll") for (int _i = 0; _i < 2; ++_i) \
        __builtin_amdgcn_global_load_lds((const unsigned*)((const char*)(gbase) + (voff)[_i]), (LAS unsigned*)(lds + (bufoff) + ldsw + _i * 8192), 16, 0, 0); } while (0)
#define PG8_LDA(dst, b, h) do { _Pragma("unroll") for (int m = 0; m < 4; ++m) _Pragma("unroll") for (int k = 0; k < 2; ++k) dst[m][k] = *(const LAS bf16x8*)(lds + PG8_SA(b, h) + aoff + m * 2048 + k * 1024); } while (0)
#define PG8_LDB(dst, b, h) do { _Pragma("unroll") for (int n = 0; n < 2; ++n) _Pragma("unroll") for (int k = 0; k < 2; ++k) dst[n][k] = *(const LAS bf16x8*)(lds + PG8_SB(b, h) + boff + n * 2048 + k * 1024); } while (0)
#define PG8_MMA(ai, bj, At, Bt) do { __builtin_amdgcn_s_setprio(1); _Pragma("unroll") for (int m = 0; m < 4; ++m) _Pragma("unroll") for (int n = 0; n < 2; ++n) _Pragma("unroll") for (int k = 0; k < 2; ++k) \
        acc[ai][bj][m][n] = __builtin_amdgcn_mfma_f32_16x16x32_bf16(Bt[n][k], At[m][k], acc[ai][bj][m][n], 0, 0, 0); __builtin_amdgcn_s_setprio(0); } while (0)
#define PG8_WAIT_V(n) asm volatile("s_waitcnt vmcnt(" #n ")" ::: "memory")
#define PG8_WAIT_L(n) asm volatile("s_waitcnt lgkmcnt(" #n ")" ::: "memory")
#define PG8_BAR __builtin_amdgcn_s_barrier()
#define PG8_SCHED __builtin_amdgcn_sched_barrier(0)
    Unit cur, nxt; int ui = 0;
    if (!S.next(0, cur)) return;
    if (g.stagger) {
        const unsigned long long t0 = __builtin_amdgcn_s_memrealtime(), wt = (unsigned long long)((blockIdx.x & 3) * g.stagger);
        while (__builtin_amdgcn_s_memrealtime() - t0 < wt) __builtin_amdgcn_s_sleep(16);
    }
    f32x4 acc[2][2][4][2];
#pragma unroll
    for (int a = 0; a < 2; ++a)
#pragma unroll
        for (int b = 0; b < 2; ++b)
#pragma unroll
            for (int m = 0; m < 4; ++m)
#pragma unroll
                for (int n = 0; n < 2; ++n) acc[a][b][m][n] = (f32x4){0.f, 0.f, 0.f, 0.f};
    bf16x8 At[4][2], B0[2][2], B1[2][2];
    const char* cA = (const char*)g.A + ((size_t)cur.g * g.sA) * 2 + (size_t)cur.pm * tstepA;
    const char* cB = (const char*)g.Bt + ((size_t)cur.g * g.sB) * 2 + (size_t)cur.pn * tstepB;
    PG8_STAGE(PG8_SB(0, 0), cB, voffB); PG8_STAGE(PG8_SA(0, 0), cA, voffA); PG8_STAGE(PG8_SB(0, 1), cB + hstepB, voffB); PG8_STAGE(PG8_SA(0, 1), cA + hstepA, voffA);
    if (wr == 1) PG8_BAR;
    PG8_WAIT_V(4); PG8_BAR;
    PG8_STAGE(PG8_SB(1, 0), cB + kstep, voffB); PG8_STAGE(PG8_SA(1, 0), cA + kstep, voffA); PG8_STAGE(PG8_SB(1, 1), cB + hstepB + kstep, voffB);
    PG8_WAIT_V(6); PG8_BAR;
    for (;;) {
        const bool has_next = S.next(ui + 1, nxt);
        const char* nA = has_next ? (const char*)g.A + ((size_t)nxt.g * g.sA) * 2 + (size_t)nxt.pm * tstepA : cA;
        const char* nB = has_next ? (const char*)g.Bt + ((size_t)nxt.g * g.sB) * 2 + (size_t)nxt.pn * tstepB : cB;
        for (int t = 0; t < nt; t += 2) {
            const bool last = (t == nt - 2);
            const char* a1 = cA + (size_t)(t + 1) * kstep;
            const char* a2 = last ? nA : cA + (size_t)(t + 2) * kstep; const char* b2 = last ? nB : cB + (size_t)(t + 2) * kstep;
            const char* a3 = a2 + kstep; const char* b3 = b2 + kstep;
            PG8_LDB(B0, 0, 0); PG8_SCHED; PG8_LDA(At, 0, 0); PG8_STAGE(PG8_SA(1, 1), a1 + hstepA, voffA);
            PG8_WAIT_L(8); PG8_BAR; PG8_WAIT_L(0); PG8_MMA(0, 0, At, B0); PG8_BAR; PG8_SCHED;
            PG8_LDB(B1, 0, 1); PG8_STAGE(PG8_SB(0, 0), b2, voffB);
            PG8_BAR; PG8_WAIT_L(0); PG8_MMA(0, 1, At, B1); PG8_BAR;
            PG8_LDA(At, 0, 1); PG8_STAGE(PG8_SA(0, 0), a2, voffA);
            PG8_BAR; PG8_WAIT_L(0); PG8_MMA(1, 0, At, B0); PG8_BAR; PG8_SCHED;
            PG8_STAGE(PG8_SB(0, 1), b2 + hstepB, voffB);
            PG8_WAIT_V(6); PG8_BAR; PG8_MMA(1, 1, At, B1); PG8_BAR;
            PG8_LDB(B0, 1, 0); PG8_SCHED; PG8_LDA(At, 1, 0); PG8_STAGE(PG8_SA(0, 1), a2 + hstepA, voffA);
            PG8_WAIT_L(8); PG8_BAR; PG8_WAIT_L(0); PG8_MMA(0, 0, At, B0); PG8_BAR; PG8_SCHED;
            PG8_LDB(B1, 1, 1); PG8_STAGE(PG8_SB(1, 0), b3, voffB);
            PG8_BAR; PG8_WAIT_L(0); PG8_MMA(0, 1, At, B1); PG8_BAR;
            PG8_LDA(At, 1, 1); PG8_STAGE(PG8_SA(1, 0), a3, voffA);
            PG8_BAR; PG8_WAIT_L(0); PG8_MMA(1, 0, At, B0); PG8_BAR; PG8_SCHED;
            PG8_STAGE(PG8_SB(1, 1), b3 + hstepB, voffB);
            PG8_WAIT_V(6); PG8_BAR; PG8_MMA(1, 1, At, B1); PG8_BAR;
        }
        E(acc, cur, wr, wc, fr, fq);
        if (!has_next) break;
#pragma unroll
        for (int a = 0; a < 2; ++a)
#pragma unroll
            for (int b = 0; b < 2; ++b)
#pragma unroll
                for (int m = 0; m < 4; ++m)
#pragma unroll
                    for (int n = 0; n < 2; ++n) acc[a][b][m][n] = (f32x4){0.f, 0.f, 0.f, 0.f};
        cur = nxt; cA = nA; cB = nB; ++ui;
    }
    PG8_WAIT_V(0);
    if (wr == 0) PG8_BAR;
    PG8_BAR;
#undef PG8_SA
#undef PG8_SB
#undef PG8_STAGE
#undef PG8_LDA
#undef PG8_LDB
#undef PG8_MMA
#undef PG8_WAIT_V
#undef PG8_WAIT_L
#undef PG8_BAR
#undef PG8_SCHED
}
}
using pg8::Unit;
typedef const f32x4 (&AccRef)[2][2][4][2];

__device__ __forceinline__ u32x4 pack8(f32x4 a, f32x4 b) { u32x4 w; w.x = cvt_pk_bf16(a[0], a[1]); w.y = cvt_pk_bf16(a[2], a[3]); w.z = cvt_pk_bf16(b[0], b[1]); w.w = cvt_pk_bf16(b[2], b[3]); return w; }

struct EpiProj {
    bf16_t *u5, *q, *k, *v, *sg, *ga, *gb; const LAS double* ropef;
    __device__ __forceinline__ void operator()(AccRef acc, const Unit& u, int wr, int wc, int fr, int fq) const {
        const int pn = u.pn;
#pragma unroll
        for (int ai = 0; ai < 2; ++ai)
#pragma unroll
            for (int m = 0; m < 4; ++m) {
                const int row = u.pm * 256 + ai * 128 + wr * 64 + m * 16 + fr;
#pragma unroll
                for (int bj = 0; bj < 2; ++bj) {
                    const int col = pn * 256 + bj * 128 + wc * 32 + 8 * fq;
                    f32x4 v0 = acc[ai][bj][m][0], v1 = acc[ai][bj][m][1];
                    if (pn < 2) {
                        if (row < NVALID) {
                            int item, t;
                            if (row < NREAL) { item = row >> 5; t = row & 31; } else { const int mr = row - NREAL; item = IT_REAL + (mr >> 4); t = 16 + (mr & 15); }
                            const int g = col >> 4, h0 = col & 15;
                            *(u32x4*)(u5 + ((size_t)(g * IT_PAD + item) * LDA5 + t * 16 + h0)) = pack8(v0, v1);
                        }
                    } else if (pn < 6) {
                        const int cq = col - 512, isk = cq >> 9, cc = cq & 511, i0 = (cc & 127) >> 1;
                        const int pos = row < NPR ? 16 + (row & 4095) : (row < NREAL ? 16 + ((row - NPR) & 2047) : ((row - NREAL) & 15));
                        const float sc = isk ? 1.0f : 0.08838834764831845f;
                        float o[8];
#pragma unroll
                        for (int pi = 0; pi < 4; ++pi) {
                            float s, c; sincos_rev((double)pos * ropef[i0 + pi], s, c);
                            const float x1 = pi < 2 ? v0[2 * pi] : v1[2 * pi - 4], x2 = pi < 2 ? v0[2 * pi + 1] : v1[2 * pi - 3];
                            o[2 * pi] = (x1 * c - x2 * s) * sc; o[2 * pi + 1] = (x1 * s + x2 * c) * sc;
                        }
                        u32x4 w; w.x = cvt_pk_bf16(o[0], o[1]); w.y = cvt_pk_bf16(o[2], o[3]); w.z = cvt_pk_bf16(o[4], o[5]); w.w = cvt_pk_bf16(o[6], o[7]);
                        *(u32x4*)((isk ? k : q) + (size_t)row * 512 + cc) = w;
                    } else if (pn < 10) {
                        *(u32x4*)(v + (size_t)row * 1024 + (col - 1536)) = pack8(v0, v1);
                    } else if (row < NREAL) {
                        if (pn < 14) {
#pragma unroll
                            for (int j = 0; j < 4; ++j) { v0[j] = siluf_(v0[j]); v1[j] = siluf_(v1[j]); }
                            *(u32x4*)(sg + (size_t)row * 1024 + (col - 2560)) = pack8(v0, v1);
                        } else {
#pragma unroll
                            for (int j = 0; j < 4; ++j) { v0[j] = sigmoidf_(v0[j]); v1[j] = sigmoidf_(v1[j]); }
                            if (pn < 18) *(u32x4*)(ga + (size_t)row * 1024 + (col - 3584)) = pack8(v0, v1);
                            else *(u32x4*)(gb + (size_t)row * 1024 + (col - 4608)) = pack8(v0, v1);
                        }
                    }
                }
            }
    }
};

struct EpiSink {
    float* p; int flag;
    __device__ __forceinline__ void operator()(AccRef acc, const Unit& u, int wr, int wc, int fr, int fq) const {
        if (flag) {
#pragma unroll
            for (int ai = 0; ai < 2; ++ai)
#pragma unroll
                for (int m = 0; m < 4; ++m)
#pragma unroll
                    for (int bj = 0; bj < 2; ++bj) { p[(ai * 8 + m * 2 + bj) * 8 + fr] = acc[ai][bj][m][0][0] + acc[ai][bj][m][1][1]; }
        }
    }
};

struct EpiSloc {
    float* sloc;
    __device__ __forceinline__ void operator()(AccRef acc, const Unit& u, int wr, int wc, int fr, int fq) const {
#pragma unroll
        for (int ai = 0; ai < 2; ++ai)
#pragma unroll
            for (int m = 0; m < 4; ++m) {
                const int row = u.pm * 256 + ai * 128 + wr * 64 + m * 16 + fr;
#pragma unroll
                for (int bj = 0; bj < 2; ++bj) {
                    const int col = bj * 128 + wc * 32 + 8 * fq;
                    float* p = sloc + ((size_t)u.g * IT_PAD + row) * 256 + col;
                    *(f32x4*)p = acc[ai][bj][m][0]; *(f32x4*)(p + 4) = acc[ai][bj][m][1];
                }
            }
    }
};

struct EpiY {
    bf16_t* y;
    __device__ __forceinline__ void operator()(AccRef acc, const Unit& u, int wr, int wc, int fr, int fq) const {
#pragma unroll
        for (int ai = 0; ai < 2; ++ai)
#pragma unroll
            for (int m = 0; m < 4; ++m) {
                const int item = u.pm * 256 + ai * 128 + wr * 64 + m * 16 + fr;
                if (item < IT_REAL) {
#pragma unroll
                    for (int bj = 0; bj < 2; ++bj) {
                        const int col = u.pn * 256 + bj * 128 + wc * 32 + 8 * fq, to = col >> 4, ho = col & 15;
                        f32x4 v0 = acc[ai][bj][m][0], v1 = acc[ai][bj][m][1];
#pragma unroll
                        for (int j = 0; j < 4; ++j) { v0[j] = gelu_tanh(v0[j]); v1[j] = gelu_tanh(v1[j]); }
                        *(u32x4*)(y + (size_t)(item * 32 + to) * 512 + u.g * 16 + ho) = pack8(v0, v1);
                    }
                }
            }
    }
};

struct EpiGlu {
    bf16_t* ga;
    __device__ __forceinline__ void operator()(AccRef acc, const Unit& u, int wr, int wc, int fr, int fq) const {
        u32x4 gw[2][4];
#pragma unroll
        for (int ai = 0; ai < 2; ++ai)
#pragma unroll
            for (int m = 0; m < 4; ++m) {
                const int row = u.pm * 256 + ai * 128 + wr * 64 + m * 16 + fr;
                gw[ai][m] = *(const u32x4*)(ga + (size_t)row * 1024 + u.pn * 128 + wc * 32 + 8 * fq);
            }
#pragma unroll
        for (int ai = 0; ai < 2; ++ai)
#pragma unroll
            for (int m = 0; m < 4; ++m) {
                const int row = u.pm * 256 + ai * 128 + wr * 64 + m * 16 + fr;
                bf16_t* p = ga + (size_t)row * 1024 + u.pn * 128 + wc * 32 + 8 * fq;
                const u32x4 g = gw[ai][m];
                const f32x4 a0 = acc[ai][0][m][0], a1 = acc[ai][0][m][1], g0 = acc[ai][1][m][0], g1 = acc[ai][1][m][1];
                f32x4 r0, r1;
                r0[0] = bflo(g.x) * a0[0] * sigmoidf_(g0[0]); r0[1] = bfhi(g.x) * a0[1] * sigmoidf_(g0[1]);
                r0[2] = bflo(g.y) * a0[2] * sigmoidf_(g0[2]); r0[3] = bfhi(g.y) * a0[3] * sigmoidf_(g0[3]);
                r1[0] = bflo(g.z) * a1[0] * sigmoidf_(g1[0]); r1[1] = bfhi(g.z) * a1[1] * sigmoidf_(g1[1]);
                r1[2] = bflo(g.w) * a1[2] * sigmoidf_(g1[2]); r1[3] = bfhi(g.w) * a1[3] * sigmoidf_(g1[3]);
                *(u32x4*)p = pack8(r0, r1);
            }
    }
};

struct EpiRet {
    const bf16_t *pa, *gb; bf16_t* mixed;
    __device__ __forceinline__ void operator()(AccRef acc, const Unit& u, int wr, int wc, int fr, int fq) const {
#pragma unroll
        for (int ai = 0; ai < 2; ++ai) {
            u32x4 pw[4][2], gw[4][2];
#pragma unroll
            for (int m = 0; m < 4; ++m)
#pragma unroll
                for (int bj = 0; bj < 2; ++bj) {
                    const int row = u.pm * 256 + ai * 128 + wr * 64 + m * 16 + fr;
                    const size_t o = (size_t)row * 1024 + u.pn * 256 + bj * 128 + wc * 32 + 8 * fq;
                    pw[m][bj] = *(const u32x4*)(pa + o); gw[m][bj] = *(const u32x4*)(gb + o);
                }
#pragma unroll
            for (int m = 0; m < 4; ++m)
#pragma unroll
                for (int bj = 0; bj < 2; ++bj) {
                    const int row = u.pm * 256 + ai * 128 + wr * 64 + m * 16 + fr;
                    const size_t o = (size_t)row * 1024 + u.pn * 256 + bj * 128 + wc * 32 + 8 * fq;
                    const u32x4 p = pw[m][bj], g = gw[m][bj];
                    const f32x4 a0 = acc[ai][bj][m][0], a1 = acc[ai][bj][m][1];
                    f32x4 r0, r1;
                    r0[0] = bflo(p.x) + bflo(g.x) * a0[0]; r0[1] = bfhi(p.x) + bfhi(g.x) * a0[1];
                    r0[2] = bflo(p.y) + bflo(g.y) * a0[2]; r0[3] = bfhi(p.y) + bfhi(g.y) * a0[3];
                    r1[0] = bflo(p.z) + bflo(g.z) * a1[0]; r1[1] = bfhi(p.z) + bfhi(g.z) * a1[1];
                    r1[2] = bflo(p.w) + bflo(g.w) * a1[2]; r1[3] = bfhi(p.w) + bfhi(g.w) * a1[3];
                    *(u32x4*)(mixed + o) = pack8(r0, r1);
                }
            __builtin_amdgcn_sched_barrier(0);
        }
    }
};

template <int MODE>
struct EpiRes {
    const float *xp, *xs; bf16_t* hb; float* ssq;
    __device__ __forceinline__ void operator()(AccRef acc, const Unit& u, int wr, int wc, int fr, int fq) const {
#pragma unroll
        for (int ai = 0; ai < 2; ++ai) {
            f32x4 x0[4][2], x1[4][2]; u32x4 hw[4][2];
#pragma unroll
            for (int m = 0; m < 4; ++m)
#pragma unroll
                for (int bj = 0; bj < 2; ++bj) {
                    const int row = u.pm * 256 + ai * 128 + wr * 64 + m * 16 + fr, col = u.pn * 256 + bj * 128 + wc * 32 + 8 * fq;
                    if (MODE == 0) {
                        const float* src = (row < NPR ? xp + (size_t)row * 1024 : xs + (size_t)(row - NPR) * 1024) + col;
                        x0[m][bj] = *(const f32x4*)src; x1[m][bj] = *(const f32x4*)(src + 4);
                    } else hw[m][bj] = *(const u32x4*)(hb + (size_t)row * 1024 + col);
                }
#pragma unroll
            for (int m = 0; m < 4; ++m) {
                const int row = u.pm * 256 + ai * 128 + wr * 64 + m * 16 + fr;
                float ss = 0.f;
#pragma unroll
                for (int bj = 0; bj < 2; ++bj) {
                    const int col = u.pn * 256 + bj * 128 + wc * 32 + 8 * fq;
                    f32x4 h0, h1;
                    if (MODE == 0) { h0 = x0[m][bj]; h1 = x1[m][bj]; }
                    else { const u32x4 w = hw[m][bj]; h0 = (f32x4){bflo(w.x), bfhi(w.x), bflo(w.y), bfhi(w.y)}; h1 = (f32x4){bflo(w.z), bfhi(w.z), bflo(w.w), bfhi(w.w)}; }
                    h0 = h0 + acc[ai][bj][m][0]; h1 = h1 + acc[ai][bj][m][1];
                    *(u32x4*)(hb + (size_t)row * 1024 + col) = pack8(h0, h1);
                    ss += (h0[0] * h0[0] + h0[1] * h0[1]) + (h0[2] * h0[2] + h0[3] * h0[3]) + (h1[0] * h1[0] + h1[1] * h1[1]) + (h1[2] * h1[2] + h1[3] * h1[3]);
                }
                ss += __shfl_xor(ss, 16); ss += __shfl_xor(ss, 32);
                if (fq == 0) ssq[(size_t)row * 16 + u.pn * 4 + wc] = ss;
            }
            __builtin_amdgcn_sched_barrier(0);
        }
    }
};

struct EpiFfi {
    const float* ssq; bf16_t* act;
    __device__ __forceinline__ void operator()(AccRef acc, const Unit& u, int wr, int wc, int fr, int fq) const {
        f32x4 sp[2][4];
#pragma unroll
        for (int ai = 0; ai < 2; ++ai)
#pragma unroll
            for (int m = 0; m < 4; ++m) {
                const int row = u.pm * 256 + ai * 128 + wr * 64 + m * 16 + fr;
                sp[ai][m] = *(const f32x4*)(ssq + (size_t)row * 16 + 4 * fq);
            }
#pragma unroll
        for (int ai = 0; ai < 2; ++ai)
#pragma unroll
            for (int m = 0; m < 4; ++m) {
                const int row = u.pm * 256 + ai * 128 + wr * 64 + m * 16 + fr;
                float tot = (sp[ai][m][0] + sp[ai][m][1]) + (sp[ai][m][2] + sp[ai][m][3]);
                tot += __shfl_xor(tot, 16); tot += __shfl_xor(tot, 32);
                const float rstd = rsqrtf(tot * (1.0f / 1024.0f) + EPS);
                const f32x4 g0 = acc[ai][0][m][0], g1 = acc[ai][0][m][1], u0 = acc[ai][1][m][0], u1 = acc[ai][1][m][1];
                f32x4 r0, r1;
#pragma unroll
                for (int j = 0; j < 4; ++j) { r0[j] = siluf_(rstd * g0[j]) * (rstd * u0[j]); r1[j] = siluf_(rstd * g1[j]) * (rstd * u1[j]); }
                *(u32x4*)(act + (size_t)row * DFF + u.pn * 128 + wc * 32 + 8 * fq) = pack8(r0, r1);
            }
    }
};

__device__ __forceinline__ void p0_s5gen(const Args& a, LAS float* L, int g, int qd) {
    const int tid = threadIdx.x;
    LAS float* Kt = L;
    LAS float* Ap = L + 16384;
    LAS float* Bb = Ap + 33 * 64 * 2;
    LAS float* Cc = Bb + 2048;
    bf16_t* bts = (bf16_t*)(a.ws + OFF_BTS) + (size_t)g * 256 * 512;
    bf16_t* bty = (bf16_t*)(a.ws + OFF_BTY) + (size_t)g * 512 * 768;
    float* attab = (float*)(a.ws + OFF_AT);
    bf16_t* u5 = (bf16_t*)(a.ws + OFF_U5);
    if (qd == 0) for (int e = tid; e < 24 * 256; e += 512) { const int b = e >> 8, kk = e & 255; u5[((size_t)g * IT_PAD + IT_REAL + b) * LDA5 + kk] = 0; }
    for (int dir = 0; dir < 2; ++dir) {
        const int pg = dir * 32 + g;
        const double dt = exp((double)a.in[7][pg]);
        for (int idx = tid; idx < 33 * 64; idx += 512) {
            const int p = idx & 63, d = idx >> 6;
            const double lr = a.in[5][pg * 64 + p], li = a.in[6][pg * 64 + p];
            const float mag = (float)exp(lr * dt * d);
            float s, c; sincos_rev(li * dt * d, s, c);
            Ap[idx * 2] = mag * c; Ap[idx * 2 + 1] = mag * s;
            if (d == 32 && qd == 0) { attab[(pg * 64 + p) * 2] = mag * c; attab[(pg * 64 + p) * 2 + 1] = mag * s; }
        }
        for (int idx = tid; idx < 1024; idx += 512) {
            const int p = idx >> 4, h = idx & 15;
            const double lr = a.in[5][pg * 64 + p], li = a.in[6][pg * 64 + p];
            const double zr = lr * dt, zi = li * dt, mag = exp(zr);
            float sh, ch, s1, c1; sincos_rev(0.5 * zi, sh, ch); sincos_rev(zi, s1, c1);
            const double nr = mag * (-2.0 * (double)sh * (double)sh) + expm1(zr);
            const double abi = mag * (double)s1, den = lr * lr + li * li;
            const double cre = (nr * lr + abi * li) / den, cim = (abi * lr - nr * li) / den;
            const double br = a.in[8][(size_t)(pg * 64 + p) * 16 + h], bi = a.in[9][(size_t)(pg * 64 + p) * 16 + h];
            Bb[idx * 2] = (float)(cre * br - cim * bi); Bb[idx * 2 + 1] = (float)(cre * bi + cim * br);
        }
        for (int idx = tid; idx < 1024; idx += 512) {
            Cc[idx * 2] = a.in[10][(size_t)pg * 1024 + idx]; Cc[idx * 2 + 1] = a.in[11][(size_t)pg * 1024 + idx];
        }
        __syncthreads();
        for (int e = tid; e < 8192; e += 512) {
            const int d = e >> 8, ho = (e >> 4) & 15, hi = e & 15;
            float sum = 0.f;
            for (int p = 0; p < 64; ++p) {
                const float cr = Cc[(ho * 64 + p) * 2], ci = Cc[(ho * 64 + p) * 2 + 1], ar = Ap[(d * 64 + p) * 2], ai = Ap[(d * 64 + p) * 2 + 1];
                const float br = Bb[(p * 16 + hi) * 2], bi = Bb[(p * 16 + hi) * 2 + 1];
                const float car = cr * ar - ci * ai, cai = cr * ai + ci * ar;
                sum += car * br - cai * bi;
            }
            Kt[dir * 8192 + e] = sum;
        }
        for (int e = qd * 16384 + tid; e < (qd + 1) * 16384; e += 512) {
            const int k = e & 511, nn = e >> 9, c = nn >> 6, p = nn & 63, t = k >> 4, hi = k & 15;
            const int dd = dir == 0 ? (T5 - 1 - t) : t;
            const float ar = Ap[(dd * 64 + p) * 2], ai = Ap[(dd * 64 + p) * 2 + 1], br = Bb[(p * 16 + hi) * 2], bi = Bb[(p * 16 + hi) * 2 + 1];
            const float val = c ? (ar * bi + ai * br) : (ar * br - ai * bi);
            bts[(size_t)(dir * 128 + nn) * 512 + k] = f2bf(val);
        }
        for (int e = qd * 16384 + tid; e < (qd + 1) * 16384; e += 512) {
            const int kk = e & 127, n = e >> 7, c = kk >> 6, p = kk & 63, to = n >> 4, ho = n & 15;
            const int dd = dir == 0 ? (to + 1) : (T5 - to);
            const float cr = Cc[(ho * 64 + p) * 2], ci = Cc[(ho * 64 + p) * 2 + 1], ar = Ap[(dd * 64 + p) * 2], ai = Ap[(dd * 64 + p) * 2 + 1];
            const float val = c ? -(cr * ai + ci * ar) : (cr * ar - ci * ai);
            bty[(size_t)n * 768 + 512 + dir * 128 + kk] = f2bf(val);
        }
        __syncthreads();
    }
    for (int e = qd * 65536 + tid; e < (qd + 1) * 65536; e += 512) {
        const int k = e & 511, n = e >> 9, to = n >> 4, ho = n & 15, ti = k >> 4, hi = k & 15;
        float val = 0.f;
        if (to >= ti) val += Kt[((to - ti) * 16 + ho) * 16 + hi];
        if (ti >= to) val += Kt[8192 + ((ti - to) * 16 + ho) * 16 + hi];
        if (to == ti && ho == hi) val += a.in[12][g * 16 + ho];
        bty[(size_t)n * 768 + k] = f2bf(val);
    }
    __syncthreads();
}

__device__ __forceinline__ int src_col(int kind, int n) {
    if (kind == 1) { if (n >= 512 && n < 1536) { const int r = n - 512, seg = r >> 7, dp = r & 127; return 512 + seg * 128 + (dp >> 1) + 64 * (dp & 1); } return n; }
    if (kind == 2) { const int pn = n >> 8, bj = (n >> 7) & 1, cc = n & 127; return bj * 1024 + pn * 128 + cc; }
    if (kind == 3) { const int pn = n >> 8, bj = (n >> 7) & 1, cc = n & 127; return bj * DFF + pn * 128 + cc; }
    return n;
}
__device__ __forceinline__ void p0_wtile(const float* W, int K, int N, bf16_t* WT, int kind, const float* kscale, int tile2, LAS float* L) {
    const int tid = threadIdx.x, nkt = K >> 6;
    int n0[2], k0[2];
#pragma unroll
    for (int q = 0; q < 2; ++q) { const int tile = 2 * tile2 + q; n0[q] = (tile / nkt) * 64; k0[q] = (tile % nkt) * 64; }
    float v[2][8];
#pragma unroll
    for (int q = 0; q < 2; ++q)
#pragma unroll
        for (int it = 0; it < 8; ++it) {
            const int idx = tid + it * 512, kk = idx >> 6, j = idx & 63;
            v[q][it] = W[(size_t)(k0[q] + kk) * N + src_col(kind, n0[q] + j)];
        }
#pragma unroll
    for (int q = 0; q < 2; ++q)
#pragma unroll
        for (int it = 0; it < 8; ++it) {
            const int idx = tid + it * 512, kk = idx >> 6, j = idx & 63;
            float x = v[q][it];
            if (kscale) x *= kscale[k0[q] + kk];
            L[q * 4160 + kk * 65 + j] = x;
        }
    __syncthreads();
#pragma unroll
    for (int q = 0; q < 2; ++q)
#pragma unroll
        for (int it = 0; it < 4; ++it) {
            const int idx = tid + it * 512, j = idx >> 5, kp = idx & 31;
            *(unsigned*)(WT + (size_t)(n0[q] + j) * K + k0[q] + 2 * kp) = cvt_pk_bf16(L[q * 4160 + (2 * kp) * 65 + j], L[q * 4160 + (2 * kp + 1) * 65 + j]);
        }
    __syncthreads();
}

__device__ __forceinline__ void phase0(const Args& a, LAS unsigned char* lds) {
    LAS float* L = (LAS float*)lds;
    const int tid = threadIdx.x, wave = tid >> 6, lane = tid & 63;
    constexpr int T_IN = 88 * 16 / 2, T_GLU = 32 * 8 / 2, T_RET = 128, T_OUT = 128, T_FFI = 88 * 16 / 2, T_FFO = 16 * 44 / 2;
    constexpr int NW = 128 + T_IN + T_GLU + T_RET + T_OUT, NRM = RPAD / 32;
    unsigned* qctr = (unsigned*)(a.ws + OFF_BAR) + 4096;
    LAS int* qslot = (LAS int*)(lds + 131072 + 512);
    for (;;) {
        __syncthreads();
        if (tid == 0) *qslot = (int)__hip_atomic_fetch_add(qctr, 1u, __ATOMIC_RELAXED, __HIP_MEMORY_SCOPE_AGENT);
        __syncthreads();
        const int w = *qslot;
        if (w >= NW + NRM) break;
        int r = w;
        if (r < 128) { p0_s5gen(a, L, r >> 2, r & 3); continue; } r -= 128;
        if (r < T_IN) { p0_wtile(a.in[4], 1024, INW, (bf16_t*)(a.ws + OFF_WIN), 1, nullptr, r, L); continue; } r -= T_IN;
        if (r < T_GLU) { p0_wtile(a.in[13], 512, 2048, (bf16_t*)(a.ws + OFF_WGLU), 2, nullptr, r, L); continue; } r -= T_GLU;
        if (r < T_RET) { p0_wtile(a.in[15], 1024, 1024, (bf16_t*)(a.ws + OFF_WRET), 0, nullptr, r, L); continue; } r -= T_RET;
        if (r < T_OUT) { p0_wtile(a.in[16], 1024, 1024, (bf16_t*)(a.ws + OFF_WOUT), 0, nullptr, r, L); continue; } r -= T_OUT;

        const int rowb = r * 32 + wave * 4;
        const float* xr[4]; f32x4 v[4][4];
#pragma unroll
        for (int q = 0; q < 4; ++q) {
            const int row = rowb + q;
            xr[q] = row < NPR ? a.in[0] + (size_t)row * 1024 : (row < NREAL ? a.in[1] + (size_t)(row - NPR) * 1024 : a.in[2] + (size_t)((row - NREAL) & 15) * 1024);
#pragma unroll
            for (int j = 0; j < 4; ++j) v[q][j] = (row < NVALID) ? *(const f32x4*)(xr[q] + (j * 64 + lane) * 4) : (f32x4){0.f, 0.f, 0.f, 0.f};
        }
        f32x4 gg[4];
#pragma unroll
        for (int j = 0; j < 4; ++j) gg[j] = *(const f32x4*)(a.in[3] + (j * 64 + lane) * 4);
#pragma unroll
        for (int q = 0; q < 4; ++q) {
            float sq = 0.f;
#pragma unroll
            for (int j = 0; j < 4; ++j) sq += (v[q][j][0] * v[q][j][0] + v[q][j][1] * v[q][j][1]) + (v[q][j][2] * v[q][j][2] + v[q][j][3] * v[q][j][3]);
            const float rstd = rsqrtf(wave_sum(sq) * (1.0f / 1024.0f) + EPS);
            bf16_t* orow = (bf16_t*)(a.ws + OFF_N1) + (size_t)(rowb + q) * 1024;
#pragma unroll
            for (int j = 0; j < 4; ++j) {
                u32x2 o; o.x = cvt_pk_bf16(v[q][j][0] * rstd * gg[j][0], v[q][j][1] * rstd * gg[j][1]); o.y = cvt_pk_bf16(v[q][j][2] * rstd * gg[j][2], v[q][j][3] * rstd * gg[j][3]);
                *(u32x2*)(orow + (j * 64 + lane) * 4) = o;
            }
        }
    }
}

__device__ __forceinline__ void s5_scan(const Args& a) {
    const float* attab = (const float*)(a.ws + OFF_AT);
    const float* sloc = (const float*)(a.ws + OFF_SLOC);
    bf16_t* u5 = (bf16_t*)(a.ws + OFF_U5);
    for (int id = blockIdx.x * 512 + threadIdx.x; id < 24 * 32 * 2 * 64; id += gridDim.x * 512) {
        const int p = id & 63, dir = (id >> 6) & 1, g = (id >> 7) & 31, b = id >> 12;
        const float atr = attab[((dir * 32 + g) * 64 + p) * 2], ati = attab[((dir * 32 + g) * 64 + p) * 2 + 1];
        const int nck = b < 16 ? 128 : 64, base = b < 16 ? b * 128 : 2048 + (b - 16) * 64, mitem = IT_REAL + b;
        const float* sl = sloc + (size_t)g * IT_PAD * 256 + dir * 128 + p;
        bf16_t* ub = u5 + (size_t)g * IT_PAD * LDA5 + 512 + dir * 128 + p;
        float sr = 0.f, si = 0.f;
        if (dir == 0) {
            ub[(size_t)mitem * LDA5] = 0; ub[(size_t)mitem * LDA5 + 64] = 0;
            sr = sl[(size_t)mitem * 256]; si = sl[(size_t)mitem * 256 + 64];
            for (int c0 = 0; c0 < nck; c0 += 16) {
                float lr[16], li[16];
#pragma unroll
                for (int j = 0; j < 16; ++j) { lr[j] = sl[(size_t)(base + c0 + j) * 256]; li[j] = sl[(size_t)(base + c0 + j) * 256 + 64]; }
#pragma unroll
                for (int j = 0; j < 16; ++j) {
                    const size_t it = (size_t)(base + c0 + j);
                    ub[it * LDA5] = f2bf(sr); ub[it * LDA5 + 64] = f2bf(si);
                    const float nr = atr * sr - ati * si + lr[j], ni = atr * si + ati * sr + li[j];
                    sr = nr; si = ni;
                }
            }
        } else {
            for (int c0 = nck - 16; c0 >= 0; c0 -= 16) {
                float lr[16], li[16];
#pragma unroll
                for (int j = 0; j < 16; ++j) { lr[j] = sl[(size_t)(base + c0 + j) * 256]; li[j] = sl[(size_t)(base + c0 + j) * 256 + 64]; }
#pragma unroll
                for (int j = 15; j >= 0; --j) {
                    const size_t it = (size_t)(base + c0 + j);
                    ub[it * LDA5] = f2bf(sr); ub[it * LDA5 + 64] = f2bf(si);
                    const float nr = atr * sr - ati * si + lr[j], ni = atr * si + ati * sr + li[j];
                    sr = nr; si = ni;
                }
            }
            ub[(size_t)mitem * LDA5] = f2bf(sr); ub[(size_t)mitem * LDA5 + 64] = f2bf(si);
        }
    }
}

constexpr int LDR = 136;
__device__ __forceinline__ float bf2f(bf16_t h) { return __uint_as_float(((unsigned)h) << 16); }

__device__ __forceinline__ void tr_store_pair(LAS bf16_t* img, int f0, int s2, u32x4 r0, u32x4 r1) {
    LAS unsigned* p = (LAS unsigned*)(img + f0 * LDR + s2);
    p[0 * (LDR / 2)] = (r0.x & 0xFFFFu) | (r1.x << 16); p[1 * (LDR / 2)] = (r0.x >> 16) | (r1.x & 0xFFFF0000u);
    p[2 * (LDR / 2)] = (r0.y & 0xFFFFu) | (r1.y << 16); p[3 * (LDR / 2)] = (r0.y >> 16) | (r1.y & 0xFFFF0000u);
    p[4 * (LDR / 2)] = (r0.z & 0xFFFFu) | (r1.z << 16); p[5 * (LDR / 2)] = (r0.z >> 16) | (r1.z & 0xFFFF0000u);
    p[6 * (LDR / 2)] = (r0.w & 0xFFFFu) | (r1.w << 16); p[7 * (LDR / 2)] = (r0.w >> 16) | (r1.w & 0xFFFF0000u);
}
__device__ __forceinline__ void tr_store_pair_scaled(LAS bf16_t* img, int f0, int s2, u32x4 r0, u32x4 r1, float w0, float w1) {
    LAS unsigned* p = (LAS unsigned*)(img + f0 * LDR + s2);
    p[0 * (LDR / 2)] = cvt_pk_bf16(bflo(r0.x) * w0, bflo(r1.x) * w1); p[1 * (LDR / 2)] = cvt_pk_bf16(bfhi(r0.x) * w0, bfhi(r1.x) * w1);
    p[2 * (LDR / 2)] = cvt_pk_bf16(bflo(r0.y) * w0, bflo(r1.y) * w1); p[3 * (LDR / 2)] = cvt_pk_bf16(bfhi(r0.y) * w0, bfhi(r1.y) * w1);
    p[4 * (LDR / 2)] = cvt_pk_bf16(bflo(r0.z) * w0, bflo(r1.z) * w1); p[5 * (LDR / 2)] = cvt_pk_bf16(bfhi(r0.z) * w0, bfhi(r1.z) * w1);
    p[6 * (LDR / 2)] = cvt_pk_bf16(bflo(r0.w) * w0, bflo(r1.w) * w1); p[7 * (LDR / 2)] = cvt_pk_bf16(bfhi(r0.w) * w0, bfhi(r1.w) * w1);
}

#define LDS_BARRIER() do { asm volatile("s_waitcnt lgkmcnt(0)" ::: "memory"); __builtin_amdgcn_s_barrier(); asm volatile("" ::: "memory"); } while (0)
__device__ __forceinline__ void ret_pass_a(const Args& a, LAS unsigned char* lds) {
    LAS bf16_t* KT = (LAS bf16_t*)lds;
    LAS bf16_t* VT = KT + 128 * LDR;
    const int tid0 = threadIdx.x;
    const bf16_t* kb = (const bf16_t*)(a.ws + OFF_K); const bf16_t* vb = (const bf16_t*)(a.ws + OFF_V);
    bf16_t* stb = (bf16_t*)(a.ws + OFF_ST);
    for (int item = blockIdx.x; item < 192; item += gridDim.x) {
        int tid = tid0; asm volatile("" : "+v"(tid));
        const int w = tid >> 6, lane = tid & 63, fr = lane & 15, fq = lane >> 4;
        int b, h, dir;
        if (item < 128) { b = item >> 3; h = (item >> 1) & 3; dir = item & 1; } else { const int j = item - 128; b = 16 + (j >> 3); h = (j >> 1) & 3; dir = j & 1; }
        const int NC = b < 16 ? 32 : 16, rbase = b < 16 ? b * 4096 : NPR + (b - 16) * 2048, ebase = b < 16 ? b * 33 : 528 + (b - 16) * 17;
        const float lg = logsigf_(a.in[14][dir * 4 + h]);
        const float carry = __expf(lg * 128.f);
        const int s2 = 2 * (8 * w + (lane & 7)), pg = lane >> 3;
        const float wk0 = dir == 0 ? __expf(lg * (float)(127 - s2)) : __expf(lg * (float)s2);
        const float wk1 = dir == 0 ? __expf(lg * (float)(126 - s2)) : __expf(lg * (float)(s2 + 1));
        f32x4 acc[2][8];
#pragma unroll
        for (int et = 0; et < 2; ++et)
#pragma unroll
            for (int dtl = 0; dtl < 8; ++dtl) acc[et][dtl] = (f32x4){0.f, 0.f, 0.f, 0.f};
        const int nsteps = dir == 0 ? NC : NC;
        u32x4 rk[2][2], rv[4][2];
        auto load_chunk = [&](int n) {
            int row0; bool valid = true;
            if (n == 0) { valid = s2 >= 112; row0 = NREAL + b * 16 + (s2 - 112); } else row0 = rbase + (n - 1) * 128 + s2;
#pragma unroll
            for (int it = 0; it < 2; ++it)
#pragma unroll
                for (int r = 0; r < 2; ++r) {
                    rk[it][r] = (u32x4){0u, 0u, 0u, 0u};
                    if (valid) rk[it][r] = *(const u32x4*)(kb + (size_t)(row0 + r) * 512 + h * 128 + (pg + 8 * it) * 8);
                }
#pragma unroll
            for (int it = 0; it < 4; ++it)
#pragma unroll
                for (int r = 0; r < 2; ++r) {
                    rv[it][r] = (u32x4){0u, 0u, 0u, 0u};
                    if (valid) rv[it][r] = *(const u32x4*)(vb + (size_t)(row0 + r) * 1024 + h * 256 + (pg + 8 * it) * 8);
                }
        };
        load_chunk(dir == 0 ? 0 : NC);
        for (int step = 0; step < nsteps; ++step) {
            const int n = dir == 0 ? step : NC - step;
            {
                bf16_t* spn = stb + ((size_t)((ebase + n) * 4 + h) * 2 + dir) * 32768;
#pragma unroll
                for (int et = 0; et < 2; ++et)
#pragma unroll
                    for (int dtl = 0; dtl < 8; ++dtl) {
                        u32x2 o; o.x = cvt_pk_bf16(acc[et][dtl][0], acc[et][dtl][1]); o.y = cvt_pk_bf16(acc[et][dtl][2], acc[et][dtl][3]);
                        *(u32x2*)(spn + (size_t)(32 * w + 16 * et + fr) * 128 + 16 * dtl + 4 * fq) = o;
                    }
            }
            LDS_BARRIER();
#pragma unroll
            for (int it = 0; it < 2; ++it) tr_store_pair_scaled(KT, (pg + 8 * it) * 8, s2, rk[it][0], rk[it][1], wk0, wk1);
#pragma unroll
            for (int it = 0; it < 4; ++it) tr_store_pair(VT, (pg + 8 * it) * 8, s2, rv[it][0], rv[it][1]);
            if (step + 1 < nsteps) load_chunk(dir == 0 ? step + 1 : NC - step - 1);
            LDS_BARRIER();
#pragma unroll
            for (int et = 0; et < 2; ++et)
#pragma unroll
                for (int dtl = 0; dtl < 8; ++dtl) acc[et][dtl] = acc[et][dtl] * carry;
#pragma unroll
            for (int ks = 0; ks < 4; ++ks) {
                bf16x8 vf[2];
#pragma unroll
                for (int et = 0; et < 2; ++et) vf[et] = *(const LAS bf16x8*)(VT + (32 * w + 16 * et + fr) * LDR + 32 * ks + 8 * fq);
#pragma unroll
                for (int dtl = 0; dtl < 8; ++dtl) {
                    const bf16x8 kf = *(const LAS bf16x8*)(KT + (16 * dtl + fr) * LDR + 32 * ks + 8 * fq);
#pragma unroll
                    for (int et = 0; et < 2; ++et) acc[et][dtl] = __builtin_amdgcn_mfma_f32_16x16x32_bf16(kf, vf[et], acc[et][dtl], 0, 0, 0);
                }
            }
        }
        if (dir == 0) {
            bf16_t* spn = stb + ((size_t)((ebase + NC) * 4 + h) * 2 + dir) * 32768;
#pragma unroll
            for (int et = 0; et < 2; ++et)
#pragma unroll
                for (int dtl = 0; dtl < 8; ++dtl) {
                    u32x2 o; o.x = cvt_pk_bf16(acc[et][dtl][0], acc[et][dtl][1]); o.y = cvt_pk_bf16(acc[et][dtl][2], acc[et][dtl][3]);
                    *(u32x2*)(spn + (size_t)(32 * w + 16 * et + fr) * 128 + 16 * dtl + 4 * fq) = o;
                }
        }
        LDS_BARRIER();
    }
}

__device__ __forceinline__ void ret_pass_b(const Args& a, LAS unsigned char* lds) {
    LAS bf16_t* KL = (LAS bf16_t*)lds;
    LAS bf16_t* BG = KL + 128 * LDR;
    const int tid0 = threadIdx.x;
    const bf16_t* qb = (const bf16_t*)(a.ws + OFF_Q); const bf16_t* kb = (const bf16_t*)(a.ws + OFF_K); const bf16_t* vb = (const bf16_t*)(a.ws + OFF_V);
    const bf16_t* stb = (const bf16_t*)(a.ws + OFF_ST);
    bf16_t* sg = (bf16_t*)a.out;
    u32x4 rk[4], rb[8]; bf16x8 qf[4];
    auto item_info = [&](int item, int& r0, int& h, const bf16_t*& sfp) {
        const int rc = item >> 2; h = item & 3;
        int b, n; if (rc < 512) { b = rc >> 5; n = (rc & 31) + 1; } else { b = 16 + ((rc - 512) >> 4); n = ((rc - 512) & 15) + 1; }
        const int ebase = b < 16 ? b * 33 : 528 + (b - 16) * 17; r0 = rc * 128;
        sfp = stb + ((size_t)((ebase + n) * 4 + h) * 2 + 0) * 32768;
    };
    auto load_item_head = [&](int item, int tid) {
        int r0, h; const bf16_t* sfp; item_info(item, r0, h, sfp);
#pragma unroll
        for (int it = 0; it < 8; ++it) { const int idx = tid + it * 512, e = idx >> 4, pc = idx & 15; rb[it] = *(const u32x4*)(sfp + (size_t)e * 128 + pc * 8); }
    };
    auto load_item_kq = [&](int item, int tid) {
        int r0, h; const bf16_t* sfp; item_info(item, r0, h, sfp);
        const int w = tid >> 6, lane = tid & 63, fr = lane & 15, fq = lane >> 4;
#pragma unroll
        for (int it = 0; it < 4; ++it) { const int idx = tid + it * 512, s = idx >> 4, pc = idx & 15; rk[it] = *(const u32x4*)(kb + (size_t)(r0 + s) * 512 + h * 128 + pc * 8); }
#pragma unroll
        for (int ks = 0; ks < 4; ++ks) qf[ks] = *(const bf16x8*)(qb + (size_t)(r0 + 16 * w + fr) * 512 + h * 128 + 32 * ks + 8 * fq);
    };
    if ((int)blockIdx.x < 2560) { load_item_head(blockIdx.x, tid0); load_item_kq(blockIdx.x, tid0); }
    for (int item = blockIdx.x; item < 2560; item += gridDim.x) {
        int tid = tid0; asm volatile("" : "+v"(tid));
        const int w = tid >> 6, lane = tid & 63, fr = lane & 15, fq = lane >> 4;
        int r0, h; const bf16_t* sfp; item_info(item, r0, h, sfp);
        const bf16_t* sbp = sfp + 32768;
        const float lgf = logsigf_(a.in[14][h]), lgb = logsigf_(a.in[14][4 + h]);
        const int crow = 16 * w + fr;
        LDS_BARRIER();
#pragma unroll
        for (int it = 0; it < 4; ++it) { const int idx = tid + it * 512, s = idx >> 4, pc = idx & 15; *(LAS u32x4*)(KL + s * LDR + pc * 8) = rk[it]; }
#pragma unroll
        for (int it = 0; it < 8; ++it) { const int idx = tid + it * 512, e = idx >> 4, pc = idx & 15; *(LAS u32x4*)(BG + e * LDR + pc * 8) = rb[it]; }
#pragma unroll
        for (int it = 0; it < 8; ++it) { const int idx = tid + it * 512, e = idx >> 4, pc = idx & 15; rb[it] = *(const u32x4*)(sbp + (size_t)e * 128 + pc * 8); }
        LDS_BARRIER();
        f32x4 sacc[8];
#pragma unroll
        for (int st = 0; st < 8; ++st) sacc[st] = (f32x4){0.f, 0.f, 0.f, 0.f};
#pragma unroll
        for (int ks = 0; ks < 4; ++ks)
#pragma unroll
            for (int st = 0; st < 8; ++st) {
                const bf16x8 kf = *(const LAS bf16x8*)(KL + (16 * st + fr) * LDR + 32 * ks + 8 * fq);
                sacc[st] = __builtin_amdgcn_mfma_f32_16x16x32_bf16(kf, qf[ks], sacc[st], 0, 0, 0);
                if (st == 7) __builtin_amdgcn_sched_barrier(0);
            }
        bf16x8 pf[4];
#pragma unroll
        for (int t = 0; t < 4; ++t) {
            float pv[8];
#pragma unroll
            for (int hh = 0; hh < 2; ++hh)
#pragma unroll
                for (int j = 0; j < 4; ++j) {
                    const int spp = 16 * (2 * t + hh) + 4 * fq + j, diff = crow - spp;
                    const float dec = diff >= 0 ? __expf(lgf * (float)diff) : __expf(-lgb * (float)diff);
                    pv[hh * 4 + j] = sacc[2 * t + hh][j] * dec;
                }
            u32x4 pw; pw.x = cvt_pk_bf16(pv[0], pv[1]); pw.y = cvt_pk_bf16(pv[2], pv[3]); pw.z = cvt_pk_bf16(pv[4], pv[5]); pw.w = cvt_pk_bf16(pv[6], pv[7]);
            pf[t] = __builtin_bit_cast(bf16x8, pw);
        }
        f32x4 o[16];
#pragma unroll
        for (int et = 0; et < 16; ++et) o[et] = (f32x4){0.f, 0.f, 0.f, 0.f};
#pragma unroll
        for (int ks = 0; ks < 4; ++ks)
#pragma unroll
            for (int et = 0; et < 16; ++et) {
                const bf16x8 sf = *(const LAS bf16x8*)(BG + (16 * et + fr) * LDR + 32 * ks + 8 * fq);
                o[et] = __builtin_amdgcn_mfma_f32_16x16x32_bf16(sf, qf[ks], o[et], 0, 0, 0);
                if ((et & 7) == 7) __builtin_amdgcn_sched_barrier(0);
            }
        const float wqf = __expf(lgf * (float)(crow + 1)), wqb = __expf(lgb * (float)(128 - crow));
        const float ratio = wqf / wqb;
#pragma unroll
        for (int et = 0; et < 16; ++et) o[et] = o[et] * ratio;
        LDS_BARRIER();
#pragma unroll
        for (int it = 0; it < 8; ++it) { const int idx = tid + it * 512, e = idx >> 4, pc = idx & 15; *(LAS u32x4*)(BG + e * LDR + pc * 8) = rb[it]; }
        {
            const int s2 = 2 * (8 * w + (lane & 7));
#pragma unroll
            for (int it = 0; it < 4; ++it)
#pragma unroll
                for (int r = 0; r < 2; ++r) rb[it * 2 + r] = *(const u32x4*)(vb + (size_t)(r0 + s2 + r) * 1024 + h * 256 + ((lane >> 3) + 8 * it) * 8);
        }
        LDS_BARRIER();
#pragma unroll
        for (int ks = 0; ks < 4; ++ks)
#pragma unroll
            for (int et = 0; et < 16; ++et) {
                const bf16x8 sf = *(const LAS bf16x8*)(BG + (16 * et + fr) * LDR + 32 * ks + 8 * fq);
                o[et] = __builtin_amdgcn_mfma_f32_16x16x32_bf16(sf, qf[ks], o[et], 0, 0, 0);
                if ((et & 7) == 7) __builtin_amdgcn_sched_barrier(0);
            }
#pragma unroll
        for (int et = 0; et < 16; ++et) o[et] = o[et] * wqb;
        LDS_BARRIER();
#pragma unroll
        for (int it = 0; it < 4; ++it) tr_store_pair(BG, ((lane >> 3) + 8 * it) * 8, 2 * (8 * w + (lane & 7)), rb[it * 2], rb[it * 2 + 1]);
        if (item + (int)gridDim.x < 2560) load_item_head(item + gridDim.x, tid);
        LDS_BARRIER();
#pragma unroll
        for (int t = 0; t < 4; ++t)
#pragma unroll
            for (int et = 0; et < 16; ++et) {
                const u32x2 lo = *(const LAS u32x2*)(BG + (16 * et + fr) * LDR + 32 * t + 4 * fq);
                const u32x2 hi = *(const LAS u32x2*)(BG + (16 * et + fr) * LDR + 32 * t + 16 + 4 * fq);
                const u32x4 vw = (u32x4){lo.x, lo.y, hi.x, hi.y};
                o[et] = __builtin_amdgcn_mfma_f32_16x16x32_bf16(__builtin_bit_cast(bf16x8, vw), pf[t], o[et], 0, 0, 0);
                if ((et & 7) == 7) __builtin_amdgcn_sched_barrier(0);
            }
        float ss = 0.f;
#pragma unroll
        for (int et = 0; et < 16; ++et) ss += (o[et][0] * o[et][0] + o[et][1] * o[et][1]) + (o[et][2] * o[et][2] + o[et][3] * o[et][3]);
        ss += __shfl_xor(ss, 16); ss += __shfl_xor(ss, 32);
        const float rn = rsqrtf(ss * (1.0f / 256.0f) + EPS);
        bf16_t* gp = sg + (size_t)(r0 + crow) * 1024 + h * 256 + 4 * fq;
        u32x2 gwv[16];
#pragma unroll
        for (int et = 0; et < 16; ++et) gwv[et] = *(const u32x2*)(gp + 16 * et);
        if (item + (int)gridDim.x < 2560) load_item_kq(item + gridDim.x, tid);
#pragma unroll
        for (int et = 0; et < 16; ++et) {
            const u32x2 gw = gwv[et];
            u32x2 ow; ow.x = cvt_pk_bf16(o[et][0] * rn * bflo(gw.x), o[et][1] * rn * bfhi(gw.x)); ow.y = cvt_pk_bf16(o[et][2] * rn * bflo(gw.y), o[et][3] * rn * bfhi(gw.y));
            *(u32x2*)(gp + 16 * et) = ow;
        }
    }
    LDS_BARRIER();
}

__device__ __forceinline__ void final_norm(const Args& a) {
    const int wave = threadIdx.x >> 6, lane = threadIdx.x & 63;
    const float* ssq = (const float*)(a.ws + OFF_SSQ2);
    f32x4 gg[4];
#pragma unroll
    for (int j = 0; j < 4; ++j) gg[j] = *(const f32x4*)(a.in[20] + (j * 64 + lane) * 4);
    for (int rowb = (blockIdx.x * 8 + wave) * 4; rowb < NREAL; rowb += gridDim.x * 32) {
        float part[4]; u32x2 w[4][4];
#pragma unroll
        for (int q = 0; q < 4; ++q) {
            part[q] = lane < 16 ? ssq[(size_t)(rowb + q) * 16 + lane] : 0.f;
            const bf16_t* hrow = (const bf16_t*)(a.ws + OFF_H1B) + (size_t)(rowb + q) * 1024;
#pragma unroll
            for (int j = 0; j < 4; ++j) w[q][j] = *(const u32x2*)(hrow + (j * 64 + lane) * 4);
        }
#pragma unroll
        for (int q = 0; q < 4; ++q) {
            const float rstd = rsqrtf(wave_sum(part[q]) * (1.0f / 1024.0f) + EPS);
            float* orow = a.out + (size_t)(rowb + q) * 1024;
#pragma unroll
            for (int j = 0; j < 4; ++j) {
                f32x4 v;
                v[0] = bflo(w[q][j].x) * rstd * gg[j][0]; v[1] = bfhi(w[q][j].x) * rstd * gg[j][1]; v[2] = bflo(w[q][j].y) * rstd * gg[j][2]; v[3] = bfhi(w[q][j].y) * rstd * gg[j][3];
                *(f32x4*)(orow + (j * 64 + lane) * 4) = v;
            }
        }
    }
}

template <int ph>
__device__ __forceinline__ void run_phase(const Args& a, LAS unsigned char* lds) {
    unsigned char* ws = a.ws;
    bf16_t* dob = (bf16_t*)a.out;
    bf16_t* sgp = dob; bf16_t* gap = dob + (size_t)NREAL * 1024;
#ifdef ONLY_PH
    if (ph != ONLY_PH) return;
#endif
    switch (ph) {
    case 0: phase0(a, lds); break;
    case 1: {
        pg8::Gemm g{(const bf16_t*)(ws + OFF_N1), (const bf16_t*)(ws + OFF_WIN), 1024, 1024, 1024, RPAD / 256, INW / 256, 1, 0, 0, STG};
        EpiProj E{(bf16_t*)(ws + OFF_U5), (bf16_t*)(ws + OFF_Q), (bf16_t*)(ws + OFF_K), (bf16_t*)(ws + OFF_V), sgp, gap, (bf16_t*)(ws + OFF_GB), (const LAS double*)(lds + 131072)};
        pg8::gemm_phase(lds, g, E);
        constexpr int T_FFI = 88 * 16 / 2, T_FFO = 16 * 44 / 2, FIRST = (RPAD / 256) * (INW / 256) - 27 * 256;
        const int nblk = (int)gridDim.x, first = nblk == 256 ? FIRST : 0;
        if ((int)blockIdx.x >= first) {
            __syncthreads();
            for (int r = (int)blockIdx.x - first; r < T_FFI + T_FFO; r += nblk - first) {
                if (r < T_FFI) p0_wtile(a.in[18], 1024, INW, (bf16_t*)(ws + OFF_WFFI), 3, a.in[17], r, (LAS float*)lds);
                else p0_wtile(a.in[19], DFF, 1024, (bf16_t*)(ws + OFF_WFFO), 0, nullptr, r - T_FFI, (LAS float*)lds);
            }
        }
    } break;
    case 2: {
        pg8::Gemm g{(const bf16_t*)(ws + OFF_U5), (const bf16_t*)(ws + OFF_BTS), LDA5, 512, 512, IT_PAD / 256, 1, 32, (size_t)IT_PAD * LDA5, (size_t)256 * 512, 0};
        EpiSloc E{(float*)(ws + OFF_SLOC)};
        pg8::gemm_phase(lds, g, E);
    } break;
    case 3: s5_scan(a); break;
    case 4: {
        pg8::Gemm g{(const bf16_t*)(ws + OFF_U5), (const bf16_t*)(ws + OFF_BTY), LDA5, 768, 768, IT_PAD / 256, 2, 32, (size_t)IT_PAD * LDA5, (size_t)512 * 768, 0};
        EpiY E{(bf16_t*)(ws + OFF_YSSM)};
        pg8::gemm_phase(lds, g, E);
    } break;
    case 5: {
        ret_pass_a(a, lds);
        const int bx = (int)blockIdx.x, sub = bx >= 192 ? bx - 192 : (bx >= 128 ? bx - 128 : 0);
        const int u0 = bx >= 192 ? 0 : (bx >= 128 ? GLU_SPLIT : GLU_SPLIT2), u1 = bx >= 192 ? GLU_SPLIT : GLU_SPLIT2;
        pg8::Gemm g{(const bf16_t*)(ws + OFF_YSSM), (const bf16_t*)(ws + OFF_WGLU), 512, 512, 512, NREAL / 256, 8, 1, 0, 0, STG, 64, sub, u0, u1};
        EpiGlu E{gap};
        pg8::gemm_phase(lds, g, E);
    } break;
    case 6: {
        pg8::Gemm g{(const bf16_t*)(ws + OFF_YSSM), (const bf16_t*)(ws + OFF_WGLU), 512, 512, 512, NREAL / 256, 8, 1, 0, 0, STG, (int)gridDim.x, (int)blockIdx.x, GLU_SPLIT2, 2560};
        EpiGlu E{gap};
        pg8::gemm_phase(lds, g, E);
    } break;
    case 7: ret_pass_b(a, lds); break;
    case 8: {
        pg8::Gemm g{sgp, (const bf16_t*)(ws + OFF_WRET), 1024, 1024, 1024, NREAL / 256, 4, 1, 0, 0, STG};
        EpiRet E{gap, (const bf16_t*)(ws + OFF_GB), (bf16_t*)(ws + OFF_MIXED)};
        pg8::gemm_phase(lds, g, E);
    } break;
    case 9: {
        pg8::Gemm g{(const bf16_t*)(ws + OFF_MIXED), (const bf16_t*)(ws + OFF_WOUT), 1024, 1024, 1024, NREAL / 256, 4, 1, 0, 0, STG};
        EpiRes<0> E{a.in[0], a.in[1], (bf16_t*)(ws + OFF_H1B), (float*)(ws + OFF_SSQ1)};
        pg8::gemm_phase(lds, g, E);
    } break;
    case 10: {
        pg8::Gemm g{(const bf16_t*)(ws + OFF_H1B), (const bf16_t*)(ws + OFF_WFFI), 1024, 1024, 1024, NREAL / 256, INW / 256, 1, 0, 0, STG};
        EpiFfi E{(const float*)(ws + OFF_SSQ1), (bf16_t*)(ws + OFF_ACT)};
        pg8::gemm_phase(lds, g, E);
    } break;
    case 11: {
        pg8::Gemm g{(const bf16_t*)(ws + OFF_ACT), (const bf16_t*)(ws + OFF_WFFO), DFF, DFF, DFF, NREAL / 256, 4, 1, 0, 0, STG};
        EpiRes<1> E{nullptr, nullptr, (bf16_t*)(ws + OFF_H1B), (float*)(ws + OFF_SSQ2)};
        pg8::gemm_phase(lds, g, E);
    } break;
    case 12: final_norm(a); break;
    default: break;
    }
}

#define XB_TMO      128
#define XB_XCNT(j)  (256  + 64 * (j))
#define XB_XSUB(j)  (1280 + 64 * (j))
#define XB_XGEN(j)  (2304 + 64 * (j))
#define XB_TOP      3328
#define XB_TOPGEN   3392
#define XCD_BAR_WORDS 3456
#define XB_SPIN_CAP (1u << 18)

__device__ __forceinline__ unsigned xb_ld(unsigned* p)              { return __hip_atomic_load(p, __ATOMIC_RELAXED, __HIP_MEMORY_SCOPE_AGENT); }
__device__ __forceinline__ unsigned xb_add(unsigned* p, unsigned v) { return __hip_atomic_fetch_add(p, v, __ATOMIC_RELAXED, __HIP_MEMORY_SCOPE_AGENT); }
__device__ __forceinline__ unsigned xb_xcc_id() { return (unsigned)__builtin_amdgcn_s_getreg((3 << 11) | 20) & 0xFu; }
#define XB_SPIN(cond, bar) do { unsigned _sp = 0; while (cond) { __builtin_amdgcn_s_sleep(1); \
    if ((++_sp & 255u) == 0u) { if (xb_ld(&(bar)[XB_TMO])) break; if (_sp > XB_SPIN_CAP) { atomicAdd(&(bar)[XB_TMO], 1u); break; } } } } while (0)

struct XcdBarrier {
    unsigned* bar; unsigned x;
    volatile LAS unsigned* st;
};

__device__ __forceinline__ XcdBarrier xcd_barrier_post(unsigned* bar, volatile LAS unsigned* st) {
    XcdBarrier b; b.bar = bar; b.x = xb_xcc_id(); b.st = st;
    if (threadIdx.x == 0) (void)xb_add(&bar[XB_XCNT(b.x)], 1u);
    return b;
}
__device__ __forceinline__ void xcd_barrier_complete(unsigned* bar, unsigned x, unsigned& nloc, unsigned& nx) {
    const unsigned G = gridDim.x * gridDim.y * gridDim.z;
    unsigned sum, cnt, mine, sp = 0u;
    for (;;) {
        sum = 0u; cnt = 0u; mine = 0u;
#pragma unroll
        for (unsigned j = 0; j < 16; ++j) { const unsigned c = xb_ld(&bar[XB_XCNT(j)]); sum += c; cnt += (c > 0u) ? 1u : 0u; mine = (j == x) ? c : mine; }
        if (sum == G) break;
        __builtin_amdgcn_s_sleep(1);
        if ((++sp & 255u) == 0u) { if (xb_ld(&bar[XB_TMO])) break; if (sp > XB_SPIN_CAP) { atomicAdd(&bar[XB_TMO], 1u); break; } }
    }
    nloc = mine > 0u ? mine : 1u; nx = cnt > 0u ? cnt : 1u;
}

__device__ __forceinline__ void xcd_barrier(const XcdBarrier& b) {
    asm volatile("s_waitcnt vmcnt(0)" ::: "memory");
    __syncthreads();
    if (threadIdx.x == 0) {
        unsigned* bar = b.bar;
        __builtin_amdgcn_s_waitcnt(0);
        unsigned nloc = b.st[0], nx = b.st[1];
        if (nloc == 0u) { xcd_barrier_complete(bar, b.x, nloc, nx); b.st[0] = nloc; b.st[1] = nx; }
        const unsigned old = xb_add(&bar[XB_XSUB(b.x)], 1u);
        const unsigned gen = old / nloc;
        if (old + 1u == (gen + 1u) * nloc) {
            __builtin_amdgcn_fence(__ATOMIC_RELEASE, "agent");
            asm volatile("s_waitcnt vmcnt(0)" ::: "memory");
            const unsigned og = xb_add(&bar[XB_TOP], 1u);
            const unsigned tg = og / nx;
            if (og + 1u == (tg + 1u) * nx) xb_add(&bar[XB_TOPGEN], 1u);
            else XB_SPIN(xb_ld(&bar[XB_TOPGEN]) == tg, bar);
            __builtin_amdgcn_fence(__ATOMIC_ACQUIRE, "agent");
            xb_add(&bar[XB_XGEN(b.x)], 1u);
            asm volatile("s_waitcnt vmcnt(0)" ::: "memory");
        } else {
            XB_SPIN(xb_ld(&bar[XB_XGEN(b.x)]) == gen, bar);
            __builtin_amdgcn_fence(__ATOMIC_ACQUIRE, "agent");
            asm volatile("s_waitcnt vmcnt(0)" ::: "memory");
        }
    }
    __syncthreads();
}


__device__ __forceinline__ void grid_barrier(unsigned* ctr, unsigned target) {
    asm volatile("s_waitcnt vmcnt(0) lgkmcnt(0)" ::: "memory");
    __syncthreads();
    if (threadIdx.x == 0) {
        __builtin_amdgcn_fence(__ATOMIC_RELEASE, "agent");
        asm volatile("s_waitcnt vmcnt(0)" ::: "memory");
        __hip_atomic_fetch_add(ctr, 1u, __ATOMIC_RELAXED, __HIP_MEMORY_SCOPE_AGENT);
        unsigned spins = 0;
        while (__hip_atomic_load(ctr, __ATOMIC_RELAXED, __HIP_MEMORY_SCOPE_AGENT) < target && ++spins < (1u << 24)) __builtin_amdgcn_s_sleep(2);
        __builtin_amdgcn_fence(__ATOMIC_ACQUIRE, "agent");
        asm volatile("s_waitcnt vmcnt(0)" ::: "memory");
    }
    __syncthreads();
}

template <bool COOP>
__global__ __launch_bounds__(512, 2) void fwd_kernel(Args a) {
    extern __shared__ __attribute__((aligned(16))) unsigned char shm[];
    LAS unsigned char* lds = (LAS unsigned char*)shm;
    if (threadIdx.x < 64) ((LAS double*)(lds + 131072))[threadIdx.x] = exp2(-(double)threadIdx.x * (13.287712379549449 / 64.0));
    volatile LAS unsigned* xst = (volatile LAS unsigned*)(lds + 131072 + 528);
    if (threadIdx.x == 0) { xst[0] = 0u; xst[1] = 0u; }
    __syncthreads();
    XcdBarrier xb{}; if (COOP) xb = xcd_barrier_post((unsigned*)(a.ws + OFF_BAR), xst);
    if (COOP && a.ph_hi > NPHASE) cg::this_grid().sync();
#define RUN_PH(P) if (a.ph_lo <= P && P < a.ph_hi) { run_phase<P>(a, lds); if ((DBL_MASK >> P) & 1) run_phase<P>(a, lds); if (COOP && P + 1 < a.ph_hi) { xcd_barrier(xb); } }
    RUN_PH(0) RUN_PH(1) RUN_PH(2) RUN_PH(3) RUN_PH(4) RUN_PH(5) RUN_PH(6) RUN_PH(7) RUN_PH(8) RUN_PH(9) RUN_PH(10) RUN_PH(11) RUN_PH(12)
#undef RUN_PH
}

extern "C" void kernel_launch(void* const* d_in, const int* in_sizes, int n_in, void* d_out, int out_size, void* d_ws, size_t ws_size, hipStream_t stream) {
    static int grid = 0;
    if (grid == 0) {
        if (n_in != 21 || ws_size < WS_NEED || out_size != NREAL * 1024) { fprintf(stderr, "kernel_launch: unexpected shapes (n_in %d, ws %zu need %zu, out %d)\n", n_in, ws_size, (size_t)WS_NEED, out_size); grid = -1; return; }
        int dev = 0, cus = 0;
        hipGetDevice(&dev); hipDeviceGetAttribute(&cus, hipDeviceAttributeMultiprocessorCount, dev);
        hipFuncSetAttribute((const void*)fwd_kernel<true>, hipFuncAttributeMaxDynamicSharedMemorySize, LDS_BYTES);
#if !COOP_MODE
        hipFuncSetAttribute((const void*)fwd_kernel<false>, hipFuncAttributeMaxDynamicSharedMemorySize, LDS_BYTES);
#endif
        int per_cu = 0;
        hipOccupancyMaxActiveBlocksPerMultiprocessor(&per_cu, (const void*)fwd_kernel<true>, 512, LDS_BYTES);
        if (per_cu < 1) { fprintf(stderr, "kernel_launch: occupancy query says %d blocks per CU\n", per_cu); per_cu = 1; }
        (void)hipGetLastError();
        grid = cus * 1;
    }
    if (grid < 0) return;
    Args a{};
    for (int i = 0; i < 21; ++i) a.in[i] = (const float*)d_in[i];
    a.out = (float*)d_out; a.ws = (unsigned char*)d_ws;
#if COOP_MODE
    hipMemsetAsync((char*)d_ws + OFF_BAR, 0, 4096 * 4 + 256, stream);
    a.ph_lo = 0; a.ph_hi = NPHASE;
    void* args[] = {&a};
    hipError_t e = hipLaunchCooperativeKernel((const void*)fwd_kernel<true>, dim3(grid), dim3(512), args, LDS_BYTES, stream);
    if (e != hipSuccess) fprintf(stderr, "cooperative launch failed: %s (grid %d)\n", hipGetErrorString(e), grid);
#else
    for (int ph = 0; ph < NPHASE; ++ph) {
        a.ph_lo = ph; a.ph_hi = ph + 1;
        hipLaunchKernelGGL(fwd_kernel<false>, dim3(grid), dim3(512), LDS_BYTES, stream, a);
    }
#endif
}
```

```cpp
#include <hip/hip_runtime.h>
#include <hip/hip_cooperative_groups.h>
#include <cstdio>
#include <cstdint>
namespace cg = cooperative_groups;

#ifndef COOP_MODE
#define COOP_MODE 1
#endif

#define DBL_MASK 0x0
#define LAS __attribute__((address_space(3)))
typedef unsigned short bf16_t;
typedef short bf16x8 __attribute__((ext_vector_type(8)));
typedef float f32x4 __attribute__((ext_vector_type(4)));
typedef unsigned u32x4 __attribute__((ext_vector_type(4)));
typedef unsigned u32x2 __attribute__((ext_vector_type(2)));

constexpr int D = 1024, NREAL = 81920, NPR = 65536, RPAD = 82432, NVALID = 82304;
constexpr int INW = 5632, DFF = 2816;
constexpr int T5 = 32, IT_REAL = 2560, IT_PAD = 2816, LDA5 = 768;
constexpr float EPS = 1e-6f;

constexpr size_t OFF_WIN = 0;
constexpr size_t OFF_WGLU = OFF_WIN + (size_t)INW * D * 2;
constexpr size_t OFF_WRET = OFF_WGLU + (size_t)2048 * 512 * 2;
constexpr size_t OFF_WOUT = OFF_WRET + (size_t)D * D * 2;
constexpr size_t OFF_WFFI = OFF_WOUT + (size_t)D * D * 2;
constexpr size_t OFF_WFFO = OFF_WFFI + (size_t)INW * D * 2;
constexpr size_t OFF_AT = OFF_WFFO + (size_t)D * DFF * 2;
constexpr size_t OFF_BAR = OFF_AT + 32768;
constexpr size_t OFF_Q = OFF_AT + 65536;
constexpr size_t OFF_K = OFF_Q + (size_t)RPAD * 512 * 2;
constexpr size_t OFF_V = OFF_K + (size_t)RPAD * 512 * 2;
constexpr size_t OFF_GB = OFF_V + (size_t)RPAD * D * 2;
constexpr size_t OFF_SSQ1 = OFF_GB + (size_t)NREAL * D * 2;
constexpr size_t OFF_SSQ2 = OFF_SSQ1 + (size_t)NREAL * 16 * 4;
constexpr size_t OFF_X = OFF_SSQ2 + (size_t)NREAL * 16 * 4;
constexpr size_t OFF_N1 = OFF_X;
constexpr size_t OFF_YSSM = OFF_X + (size_t)664 * 8 * 65536;
constexpr size_t OFF_U5 = OFF_N1 + (size_t)RPAD * D * 2;
constexpr size_t OFF_BTY = OFF_U5 + (size_t)32 * IT_PAD * LDA5 * 2;
constexpr size_t OFF_BTS = OFF_BTY + (size_t)32 * 512 * 768 * 2;
constexpr size_t OFF_SLOC = OFF_BTS + (size_t)32 * 256 * 512 * 2;
constexpr size_t END_X03 = OFF_SLOC + (size_t)32 * IT_PAD * 256 * 4;
constexpr size_t OFF_ST = OFF_X;
constexpr size_t END_ST = OFF_ST + (size_t)664 * 8 * 65536;
constexpr size_t OFF_ACT = OFF_X;
constexpr size_t END_ACT = OFF_ACT + (size_t)NREAL * DFF * 2;
constexpr size_t OFF_MIXED = OFF_Q;
constexpr size_t OFF_H1B = OFF_V;
constexpr size_t cmax(size_t a, size_t b) { return a > b ? a : b; }
constexpr size_t WS_NEED = cmax(END_X03, cmax(END_ST, END_ACT));

constexpr int LDS_BYTES = 131072 + 1024;
constexpr int NPHASE = 13;
constexpr int GLU_SPLIT = 64 * 14, GLU_SPLIT2 = GLU_SPLIT + 64 * 6;
constexpr int STG = 0;

struct Args {
    const float* in[21];
    float* out;
    unsigned char* ws;
    int ph_lo, ph_hi;
};

__device__ __forceinline__ unsigned cvt_pk_bf16(float lo, float hi) { unsigned r; asm volatile("v_cvt_pk_bf16_f32 %0, %1, %2" : "=v"(r) : "v"(lo), "v"(hi)); return r; }
__device__ __forceinline__ bf16_t f2bf(float f) { return (bf16_t)(cvt_pk_bf16(f, 0.f) & 0xFFFFu); }
__device__ __forceinline__ float bflo(unsigned w) { return __uint_as_float(w << 16); }
__device__ __forceinline__ float bfhi(unsigned w) { return __uint_as_float(w & 0xFFFF0000u); }
__device__ __forceinline__ float sigmoidf_(float x) { return __builtin_amdgcn_rcpf(1.0f + __builtin_amdgcn_exp2f(-1.4426950408889634f * x)); }
__device__ __forceinline__ float siluf_(float x) { return x * sigmoidf_(x); }
__device__ __forceinline__ float gelu_tanh(float x) { const float z = 0.7978845608028654f * (x + 0.044715f * x * x * x); return x * sigmoidf_(2.0f * z); }
__device__ __forceinline__ float logsigf_(float x) { return fminf(x, 0.f) - log1pf(__expf(-fabsf(x))); }
__device__ __forceinline__ float wave_sum(float v) {
#pragma unroll
    for (int o = 1; o < 64; o <<= 1) v += __shfl_xor(v, o);
    return v;
}
__device__ __forceinline__ void sincos_rev(double ang, float& s, float& c) {
    double x = ang * 0.15915494309189535; x -= rint(x);
    const float xf = (float)x;
    s = __builtin_amdgcn_sinf(xf); c = __builtin_amdgcn_cosf(xf);
}

namespace pg8 {
constexpr int BM = 256, BK = 64, HALF = 128, HTB = HALF * BK * 2, STAGE_BYTES = 8 * HTB, NXCD = 8, WGM = 8;
__device__ __forceinline__ int lds_byte(int r, int c) { const int st = (r >> 4) * 2 + (c >> 5), rr = r & 15, cc = c & 31, ob = rr * 64 + cc * 2; return st * 1024 + (ob ^ (((ob >> 9) & 1) << 5)); }
__device__ __forceinline__ void stage_rc(int b, int& R, int& C) { const int st = b / 1024, sb = b % 1024, swz = sb ^ (((sb >> 9) & 1) << 5); R = (st >> 1) * 16 + swz / 64; C = (st & 1) * 32 + (swz % 64) / 2; }
__device__ __forceinline__ int perm32(int rho) { const int n = rho >> 4, i = rho & 15; return 8 * (i >> 2) + 4 * n + (i & 3); }

struct Unit { int pm, pn, g; };
struct Gemm { const bf16_t* A; const bf16_t* Bt; int lda, ldb, K, nM, nN, nb; size_t sA, sB; int stagger; int G, c, u0, u1; };

struct Order {
    int nM, nN, nwg, total, G, c, u0;
    __device__ void init(int nM_, int nN_, int nb, int G_, int c_, int u0_, int u1_) { nM = nM_; nN = nN_; nwg = nM * nN; total = u1_ > 0 ? u1_ : nwg * nb; G = G_; c = c_; u0 = u0_; }
    __device__ bool next(int i, Unit& u) const {
        const long L = (long)u0 + (long)i * G + c; if (L >= total) return false;
        u.g = (int)(L / nwg); int wgid = (int)(L % nwg);
        { const int q = nwg / NXCD, r = nwg % NXCD, xcd = wgid % NXCD, off = wgid / NXCD; wgid = (xcd < r ? xcd * (q + 1) : r * (q + 1) + (xcd - r) * q) + off; }
        const int nig = WGM * nN, gid = wgid / nig, fm = gid * WGM, gsz = (nM - fm) < WGM ? (nM - fm) : WGM;
        u.pm = fm + ((wgid % nig) % gsz); u.pn = (wgid % nig) / gsz; return true;
    }
};

template <class Epi>
__device__ __forceinline__ void gemm_phase(LAS unsigned char* lds, const Gemm g, const Epi& E) {
    const int tid = threadIdx.x, wid = __builtin_amdgcn_readfirstlane(tid >> 6), lane = tid & 63, wr = wid >> 2, wc = wid & 3, fr = lane & 15, fq = lane >> 4;
    const int K = g.K, nt = K / BK;
    Order S; S.init(g.nM, g.nN, g.nb, g.G > 0 ? g.G : (int)gridDim.x, g.G > 0 ? g.c : (int)blockIdx.x, g.u0, g.u1);
    unsigned voffA[2], voffB[2];
#pragma unroll
    for (int i = 0; i < 2; ++i) { int R, C; stage_rc(tid * 16 + i * 8192, R, C); const int Rb = (R & ~31) + perm32(R & 31);
        voffA[i] = (unsigned)(R * g.lda + C) * 2u; voffB[i] = (unsigned)(Rb * g.ldb + C) * 2u; }
    const size_t kstep = (size_t)(BK * 2);
    const size_t hstepA = (size_t)HALF * g.lda * 2, hstepB = (size_t)HALF * g.ldb * 2;
    const size_t tstepA = 2 * hstepA, tstepB = 2 * hstepB;
    const unsigned ldsw = (unsigned)wid * 1024u;
    const int aoff = lds_byte(wr * 64 + fr, fq * 8), boff = lds_byte(wc * 32 + fr, fq * 8);
#define PG8_SA(b, h) (((b) * 2 + (h)) * HTB)
#define PG8_SB(b, h) ((4 + (b) * 2 + (h)) * HTB)
#define PG8_STAGE(bufoff, gbase, voff) do { _Pragma("unroll") for (int _i = 0; _i < 2; ++_i) \
        __builtin_amdgcn_global_load_lds((const unsigned*)((const char*)(gbase) + (voff)[_i]), (LAS unsigned*)(lds + (bufoff) + ldsw + _i * 8192), 16, 0, 0); } while (0)
#define PG8_LDA(dst, b, h) do { _Pragma("unroll") for (int m = 0; m < 4; ++m) _Pragma("unroll") for (int k = 0; k < 2; ++k) dst[m][k] = *(const LAS bf16x8*)(lds + PG8_SA(b, h) + aoff + m * 2048 + k * 1024); } while (0)
#define PG8_LDB(dst, b, h) do { _Pragma("unroll") for (int n = 0; n < 2; ++n) _Pragma("unroll") for (int k = 0; k < 2; ++k) dst[n][k] = *(const LAS bf16x8*)(lds + PG8_SB(b, h) + boff + n * 2048 + k * 1024); } while (0)
#define PG8_MMA(ai, bj, At, Bt) do { __builtin_amdgcn_s_setprio(1); _Pragma("unroll") for (int m = 0; m < 4; ++m) _Pragma("unroll") for (int n = 0; n < 2; ++n) _Pragma("unroll") for (int k = 0; k < 2; ++k) \
        acc[ai][bj][m][n] = __builtin_amdgcn_mfma_f32_16x16x32_bf16(Bt[n][k], At[m][k], acc[ai][bj][m][n], 0, 0, 0); __builtin_amdgcn_s_setprio(0); } while (0)
#define PG8_WAIT_V(n) asm volatile("s_waitcnt vmcnt(" #n ")" ::: "memory")
#define PG8_WAIT_L(n) asm volatile("s_waitcnt lgkmcnt(" #n ")" ::: "memory")
#define PG8_BAR __builtin_amdgcn_s_barrier()
#define PG8_SCHED __builtin_amdgcn_sched_barrier(0)
    Unit cur, nxt; int ui = 0;
    if (!S.next(0, cur)) return;
    if (g.stagger) {
        const unsigned long long t0 = __builtin_amdgcn_s_memrealtime(), wt = (unsigned long long)((blockIdx.x & 3) * g.stagger);
        while (__builtin_amdgcn_s_memrealtime() - t0 < wt) __builtin_amdgcn_s_sleep(16);
    }
    f32x4 acc[2][2][4][2];
#pragma unroll
    for (int a = 0; a < 2; ++a)
#pragma unroll
        for (int b = 0; b < 2; ++b)
#pragma unroll
            for (int m = 0; m < 4; ++m)
#pragma unroll
                for (int n = 0; n < 2; ++n) acc[a][b][m][n] = (f32x4){0.f, 0.f, 0.f, 0.f};
    bf16x8 At[4][2], B0[2][2], B1[2][2];
    const char* cA = (const char*)g.A + ((size_t)cur.g * g.sA) * 2 + (size_t)cur.pm * tstepA;
    const char* cB = (const char*)g.Bt + ((size_t)cur.g * g.sB) * 2 + (size_t)cur.pn * tstepB;
    PG8_STAGE(PG8_SB(0, 0), cB, voffB); PG8_STAGE(PG8_SA(0, 0), cA, voffA); PG8_STAGE(PG8_SB(0, 1), cB + hstepB, voffB); PG8_STAGE(PG8_SA(0, 1), cA + hstepA, voffA);
    if (wr == 1) PG8_BAR;
    PG8_WAIT_V(4); PG8_BAR;
    PG8_STAGE(PG8_SB(1, 0), cB + kstep, voffB); PG8_STAGE(PG8_SA(1, 0), cA + kstep, voffA); PG8_STAGE(PG8_SB(1, 1), cB + hstepB + kstep, voffB);
    PG8_WAIT_V(6); PG8_BAR;
    for (;;) {
        const bool has_next = S.next(ui + 1, nxt);
        const char* nA = has_next ? (const char*)g.A + ((size_t)nxt.g * g.sA) * 2 + (size_t)nxt.pm * tstepA : cA;
        const char* nB = has_next ? (const char*)g.Bt + ((size_t)nxt.g * g.sB) * 2 + (size_t)nxt.pn * tstepB : cB;
        for (int t = 0; t < nt; t += 2) {
            const bool last = (t == nt - 2);
            const char* a1 = cA + (size_t)(t + 1) * kstep;
            const char* a2 = last ? nA : cA + (size_t)(t + 2) * kstep; const char* b2 = last ? nB : cB + (size_t)(t + 2) * kstep;
            const char* a3 = a2 + kstep; const char* b3 = b2 + kstep;
            PG8_LDB(B0, 0, 0); PG8_SCHED; PG8_LDA(At, 0, 0); PG8_STAGE(PG8_SA(1, 1), a1 + hstepA, voffA);
            PG8_WAIT_L(8); PG8_BAR; PG8_WAIT_L(0); PG8_MMA(0, 0, At, B0); PG8_BAR; PG8_SCHED;
            PG8_LDB(B1, 0, 1); PG8_STAGE(PG8_SB(0, 0), b2, voffB);
            PG8_BAR; PG8_WAIT_L(0); PG8_MMA(0, 1, At, B1); PG8_BAR;
            PG8_LDA(At, 0, 1); PG8_STAGE(PG8_SA(0, 0), a2, voffA);
            PG8_BAR; PG8_WAIT_L(0); PG8_MMA(1, 0, At, B0); PG8_BAR; PG8_SCHED;
            PG8_STAGE(PG8_SB(0, 1), b2 + hstepB, voffB);
            PG8_WAIT_V(6); PG8_BAR; PG8_MMA(1, 1, At, B1); PG8_BAR;
            PG8_LDB(B0, 1, 0); PG8_SCHED; PG8_LDA(At, 1, 0); PG8_STAGE(PG8_SA(0, 1), a2 + hstepA, voffA);
            PG8_WAIT_L(8); PG8_BAR; PG8_WAIT_L(0); PG8_MMA(0, 0, At, B0); PG8_BAR; PG8_SCHED;
            PG8_LDB(B1, 1, 1); PG8_STAGE(PG8_SB(1, 0), b3, voffB);
            PG8_BAR; PG8_WAIT_L(0); PG8_MMA(0, 1, At, B1); PG8_BAR;
            PG8_LDA(At, 1, 1); PG8_STAGE(PG8_SA(1, 0), a3, voffA);
            PG8_BAR; PG8_WAIT_L(0); PG8_MMA(1, 0, At, B0); PG8_BAR; PG8_SCHED;
            PG8_STAGE(PG8_SB(1, 1), b3 + hstepB, voffB);
            PG8_WAIT_V(6); PG8_BAR; PG8_MMA(1, 1, At, B1); PG8_BAR;
        }
        E(acc, cur, wr, wc, fr, fq);
        if (!has_next) break;
#pragma unroll
        for (int a = 0; a < 2; ++a)
#pragma unroll
            for (int b = 0; b < 2; ++b)
#pragma unroll
                for (int m = 0; m < 4; ++m)
#pragma unroll
                    for (int n = 0; n < 2; ++n) acc[a][b][m][n] = (f32x4){0.f, 0.f, 0.f, 0.f};
        cur = nxt; cA = nA; cB = nB; ++ui;
    }
    PG8_WAIT_V(0);
    if (wr == 0) PG8_BAR;
    PG8_BAR;
#undef PG8_SA
#undef PG8_SB
#undef PG8_STAGE
#undef PG8_LDA
#undef PG8_LDB
#undef PG8_MMA
#undef PG8_WAIT_V
#undef PG8_WAIT_L
#undef PG8_BAR
#undef PG8_SCHED
}
}
using pg8::Unit;
typedef const f32x4 (&AccRef)[2][2][4][2];

__device__ __forceinline__ u32x4 pack8(f32x4 a, f32x4 b) { u32x4 w; w.x = cvt_pk_bf16(a[0], a[1]); w.y = cvt_pk_bf16(a[2], a[3]); w.z = cvt_pk_bf16(b[0], b[1]); w.w = cvt_pk_bf16(b[2], b[3]); return w; }

struct EpiProj {
    bf16_t *u5, *q, *k, *v, *sg, *ga, *gb; const LAS double* ropef;
    __device__ __forceinline__ void operator()(AccRef acc, const Unit& u, int wr, int wc, int fr, int fq) const {
        const int pn = u.pn;
#pragma unroll
        for (int ai = 0; ai < 2; ++ai)
#pragma unroll
            for (int m = 0; m < 4; ++m) {
                const int row = u.pm * 256 + ai * 128 + wr * 64 + m * 16 + fr;
#pragma unroll
                for (int bj = 0; bj < 2; ++bj) {
                    const int col = pn * 256 + bj * 128 + wc * 32 + 8 * fq;
                    f32x4 v0 = acc[ai][bj][m][0], v1 = acc[ai][bj][m][1];
                    if (pn < 2) {
                        if (row < NVALID) {
                            int item, t;
                            if (row < NREAL) { item = row >> 5; t = row & 31; } else { const int mr = row - NREAL; item = IT_REAL + (mr >> 4); t = 16 + (mr & 15); }
                            const int g = col >> 4, h0 = col & 15;
                            *(u32x4*)(u5 + ((size_t)(g * IT_PAD + item) * LDA5 + t * 16 + h0)) = pack8(v0, v1);
                        }
                    } else if (pn < 6) {
                        const int cq = col - 512, isk = cq >> 9, cc = cq & 511, i0 = (cc & 127) >> 1;
                        const int pos = row < NPR ? 16 + (row & 4095) : (row < NREAL ? 16 + ((row - NPR) & 2047) : ((row - NREAL) & 15));
                        const float sc = isk ? 1.0f : 0.08838834764831845f;
                        float o[8];
#pragma unroll
                        for (int pi = 0; pi < 4; ++pi) {
                            float s, c; sincos_rev((double)pos * ropef[i0 + pi], s, c);
                            const float x1 = pi < 2 ? v0[2 * pi] : v1[2 * pi - 4], x2 = pi < 2 ? v0[2 * pi + 1] : v1[2 * pi - 3];
                            o[2 * pi] = (x1 * c - x2 * s) * sc; o[2 * pi + 1] = (x1 * s + x2 * c) * sc;
                        }
                        u32x4 w; w.x = cvt_pk_bf16(o[0], o[1]); w.y = cvt_pk_bf16(o[2], o[3]); w.z = cvt_pk_bf16(o[4], o[5]); w.w = cvt_pk_bf16(o[6], o[7]);
                        *(u32x4*)((isk ? k : q) + (size_t)row * 512 + cc) = w;
                    } else if (pn < 10) {
                        *(u32x4*)(v + (size_t)row * 1024 + (col - 1536)) = pack8(v0, v1);
                    } else if (row < NREAL) {
                        if (pn < 14) {
#pragma unroll
                            for (int j = 0; j < 4; ++j) { v0[j] = siluf_(v0[j]); v1[j] = siluf_(v1[j]); }
                            *(u32x4*)(sg + (size_t)row * 1024 + (col - 2560)) = pack8(v0, v1);
                        } else {
#pragma unroll
                            for (int j = 0; j < 4; ++j) { v0[j] = sigmoidf_(v0[j]); v1[j] = sigmoidf_(v1[j]); }
                            if (pn < 18) *(u32x4*)(ga + (size_t)row * 1024 + (col - 3584)) = pack8(v0, v1);
                            else *(u32x4*)(gb + (size_t)row * 1024 + (col - 4608)) = pack8(v0, v1);
                        }
                    }
                }
            }
    }
};

struct EpiSink {
    float* p; int flag;
    __device__ __forceinline__ void operator()(AccRef acc, const Unit& u, int wr, int wc, int fr, int fq) const {
        if (flag) {
#pragma unroll
            for (int ai = 0; ai < 2; ++ai)
#pragma unroll
                for (int m = 0; m < 4; ++m)
#pragma unroll
                    for (int bj = 0; bj < 2; ++bj) { p[(ai * 8 + m * 2 + bj) * 8 + fr] = acc[ai][bj][m][0][0] + acc[ai][bj][m][1][1]; }
        }
    }
};

struct EpiSloc {
    float* sloc;
    __device__ __forceinline__ void operator()(AccRef acc, const Unit& u, int wr, int wc, int fr, int fq) const {
#pragma unroll
        for (int ai = 0; ai < 2; ++ai)
#pragma unroll
            for (int m = 0; m < 4; ++m) {
                const int row = u.pm * 256 + ai * 128 + wr * 64 + m * 16 + fr;
#pragma unroll
                for (int bj = 0; bj < 2; ++bj) {
                    const int col = bj * 128 + wc * 32 + 8 * fq;
                    float* p = sloc + ((size_t)u.g * IT_PAD + row) * 256 + col;
                    *(f32x4*)p = acc[ai][bj][m][0]; *(f32x4*)(p + 4) = acc[ai][bj][m][1];
                }
            }
    }
};

struct EpiY {
    bf16_t* y;
    __device__ __forceinline__ void operator()(AccRef acc, const Unit& u, int wr, int wc, int fr, int fq) const {
#pragma unroll
        for (int ai = 0; ai < 2; ++ai)
#pragma unroll
            for (int m = 0; m < 4; ++m) {
                const int item = u.pm * 256 + ai * 128 + wr * 64 + m * 16 + fr;
                if (item < IT_REAL) {
#pragma unroll
                    for (int bj = 0; bj < 2; ++bj) {
                        const int col = u.pn * 256 + bj * 128 + wc * 32 + 8 * fq, to = col >> 4, ho = col & 15;
                        f32x4 v0 = acc[ai][bj][m][0], v1 = acc[ai][bj][m][1];
#pragma unroll
                        for (int j = 0; j < 4; ++j) { v0[j] = gelu_tanh(v0[j]); v1[j] = gelu_tanh(v1[j]); }
                        *(u32x4*)(y + (size_t)(item * 32 + to) * 512 + u.g * 16 + ho) = pack8(v0, v1);
                    }
                }
            }
    }
};

struct EpiGlu {
    bf16_t* ga;
    __device__ __forceinline__ void operator()(AccRef acc, const Unit& u, int wr, int wc, int fr, int fq) const {
        u32x4 gw[2][4];
#pragma unroll
        for (int ai = 0; ai < 2; ++ai)
#pragma unroll
            for (int m = 0; m < 4; ++m) {
                const int row = u.pm * 256 + ai * 128 + wr * 64 + m * 16 + fr;
                gw[ai][m] = *(const u32x4*)(ga + (size_t)row * 1024 + u.pn * 128 + wc * 32 + 8 * fq);
            }
#pragma unroll
        for (int ai = 0; ai < 2; ++ai)
#pragma unroll
            for (int m = 0; m < 4; ++m) {
                const int row = u.pm * 256 + ai * 128 + wr * 64 + m * 16 + fr;
                bf16_t* p = ga + (size_t)row * 1024 + u.pn * 128 + wc * 32 + 8 * fq;
                const u32x4 g = gw[ai][m];
                const f32x4 a0 = acc[ai][0][m][0], a1 = acc[ai][0][m][1], g0 = acc[ai][1][m][0], g1 = acc[ai][1][m][1];
                f32x4 r0, r1;
                r0[0] = bflo(g.x) * a0[0] * sigmoidf_(g0[0]); r0[1] = bfhi(g.x) * a0[1] * sigmoidf_(g0[1]);
                r0[2] = bflo(g.y) * a0[2] * sigmoidf_(g0[2]); r0[3] = bfhi(g.y) * a0[3] * sigmoidf_(g0[3]);
                r1[0] = bflo(g.z) * a1[0] * sigmoidf_(g1[0]); r1[1] = bfhi(g.z) * a1[1] * sigmoidf_(g1[1]);
                r1[2] = bflo(g.w) * a1[2] * sigmoidf_(g1[2]); r1[3] = bfhi(g.w) * a1[3] * sigmoidf_(g1[3]);
                *(u32x4*)p = pack8(r0, r1);
            }
    }
};

struct EpiRet {
    const bf16_t *pa, *gb; bf16_t* mixed;
    __device__ __forceinline__ void operator()(AccRef acc, const Unit& u, int wr, int wc, int fr, int fq) const {
#pragma unroll
        for (int ai = 0; ai < 2; ++ai) {
            u32x4 pw[4][2], gw[4][2];
#pragma unroll
            for (int m = 0; m < 4; ++m)
#pragma unroll
                for (int bj = 0; bj < 2; ++bj) {
                    const int row = u.pm * 256 + ai * 128 + wr * 64 + m * 16 + fr;
                    const size_t o = (size_t)row * 1024 + u.pn * 256 + bj * 128 + wc * 32 + 8 * fq;
                    pw[m][bj] = *(const u32x4*)(pa + o); gw[m][bj] = *(const u32x4*)(gb + o);
                }
#pragma unroll
            for (int m = 0; m < 4; ++m)
#pragma unroll
                for (int bj = 0; bj < 2; ++bj) {
                    const int row = u.pm * 256 + ai * 128 + wr * 64 + m * 16 + fr;
                    const size_t o = (size_t)row * 1024 + u.pn * 256 + bj * 128 + wc * 32 + 8 * fq;
                    const u32x4 p = pw[m][bj], g = gw[m][bj];
                    const f32x4 a0 = acc[ai][bj][m][0], a1 = acc[ai][bj][m][1];
                    f32x4 r0, r1;
                    r0[0] = bflo(p.x) + bflo(g.x) * a0[0]; r0[1] = bfhi(p.x) + bfhi(g.x) * a0[1];
                    r0[2] = bflo(p.y) + bflo(g.y) * a0[2]; r0[3] = bfhi(p.y) + bfhi(g.y) * a0[3];
                    r1[0] = bflo(p.z) + bflo(g.z) * a1[0]; r1[1] = bfhi(p.z) + bfhi(g.z) * a1[1];
                    r1[2] = bflo(p.w) + bflo(g.w) * a1[2]; r1[3] = bfhi(p.w) + bfhi(g.w) * a1[3];
                    *(u32x4*)(mixed + o) = pack8(r0, r1);
                }
            __builtin_amdgcn_sched_barrier(0);
        }
    }
};

template <int MODE>
struct EpiRes {
    const float *xp, *xs; bf16_t* hb; float* ssq;
    __device__ __forceinline__ void operator()(AccRef acc, const Unit& u, int wr, int wc, int fr, int fq) const {
#pragma unroll
        for (int ai = 0; ai < 2; ++ai) {
            f32x4 x0[4][2], x1[4][2]; u32x4 hw[4][2];
#pragma unroll
            for (int m = 0; m < 4; ++m)
#pragma unroll
                for (int bj = 0; bj < 2; ++bj) {
                    const int row = u.pm * 256 + ai * 128 + wr * 64 + m * 16 + fr, col = u.pn * 256 + bj * 128 + wc * 32 + 8 * fq;
                    if (MODE == 0) {
                        const float* src = (row < NPR ? xp + (size_t)row * 1024 : xs + (size_t)(row - NPR) * 1024) + col;
                        x0[m][bj] = *(const f32x4*)src; x1[m][bj] = *(const f32x4*)(src + 4);
                    } else hw[m][bj] = *(const u32x4*)(hb + (size_t)row * 1024 + col);
                }
#pragma unroll
            for (int m = 0; m < 4; ++m) {
                const int row = u.pm * 256 + ai * 128 + wr * 64 + m * 16 + fr;
                float ss = 0.f;
#pragma unroll
                for (int bj = 0; bj < 2; ++bj) {
                    const int col = u.pn * 256 + bj * 128 + wc * 32 + 8 * fq;
                    f32x4 h0, h1;
                    if (MODE == 0) { h0 = x0[m][bj]; h1 = x1[m][bj]; }
                    else { const u32x4 w = hw[m][bj]; h0 = (f32x4){bflo(w.x), bfhi(w.x), bflo(w.y), bfhi(w.y)}; h1 = (f32x4){bflo(w.z), bfhi(w.z), bflo(w.w), bfhi(w.w)}; }
                    h0 = h0 + acc[ai][bj][m][0]; h1 = h1 + acc[ai][bj][m][1];
                    *(u32x4*)(hb + (size_t)row * 1024 + col) = pack8(h0, h1);
                    ss += (h0[0] * h0[0] + h0[1] * h0[1]) + (h0[2] * h0[2] + h0[3] * h0[3]) + (h1[0] * h1[0] + h1[1] * h1[1]) + (h1[2] * h1[2] + h1[3] * h1[3]);
                }
                ss += __shfl_xor(ss, 16); ss += __shfl_xor(ss, 32);
                if (fq == 0) ssq[(size_t)row * 16 + u.pn * 4 + wc] = ss;
            }
            __builtin_amdgcn_sched_barrier(0);
        }
    }
};

struct EpiFfi {
    const float* ssq; bf16_t* act;
    __device__ __forceinline__ void operator()(AccRef acc, const Unit& u, int wr, int wc, int fr, int fq) const {
        f32x4 sp[2][4];
#pragma unroll
        for (int ai = 0; ai < 2; ++ai)
#pragma unroll
            for (int m = 0; m < 4; ++m) {
                const int row = u.pm * 256 + ai * 128 + wr * 64 + m * 16 + fr;
                sp[ai][m] = *(const f32x4*)(ssq + (size_t)row * 16 + 4 * fq);
            }
#pragma unroll
        for (int ai = 0; ai < 2; ++ai)
#pragma unroll
            for (int m = 0; m < 4; ++m) {
                const int row = u.pm * 256 + ai * 128 + wr * 64 + m * 16 + fr;
                float tot = (sp[ai][m][0] + sp[ai][m][1]) + (sp[ai][m][2] + sp[ai][m][3]);
                tot += __shfl_xor(tot, 16); tot += __shfl_xor(tot, 32);
                const float rstd = rsqrtf(tot * (1.0f / 1024.0f) + EPS);
                const f32x4 g0 = acc[ai][0][m][0], g1 = acc[ai][0][m][1], u0 = acc[ai][1][m][0], u1 = acc[ai][1][m][1];
                f32x4 r0, r1;
#pragma unroll
                for (int j = 0; j < 4; ++j) { r0[j] = siluf_(rstd * g0[j]) * (rstd * u0[j]); r1[j] = siluf_(rstd * g1[j]) * (rstd * u1[j]); }
                *(u32x4*)(act + (size_t)row * DFF + u.pn * 128 + wc * 32 + 8 * fq) = pack8(r0, r1);
            }
    }
};

__device__ __forceinline__ void p0_s5gen(const Args& a, LAS float* L, int g, int qd) {
    const int tid = threadIdx.x;
    LAS float* Kt = L;
    LAS float* Ap = L + 16384;
    LAS float* Bb = Ap + 33 * 64 * 2;
    LAS float* Cc = Bb + 2048;
    bf16_t* bts = (bf16_t*)(a.ws + OFF_BTS) + (size_t)g * 256 * 512;
    bf16_t* bty = (bf16_t*)(a.ws + OFF_BTY) + (size_t)g * 512 * 768;
    float* attab = (float*)(a.ws + OFF_AT);
    bf16_t* u5 = (bf16_t*)(a.ws + OFF_U5);
    if (qd == 0) for (int e = tid; e < 24 * 256; e += 512) { const int b = e >> 8, kk = e & 255; u5[((size_t)g * IT_PAD + IT_REAL + b) * LDA5 + kk] = 0; }
    for (int dir = 0; dir < 2; ++dir) {
        const int pg = dir * 32 + g;
        const double dt = exp((double)a.in[7][pg]);
        for (int idx = tid; idx < 33 * 64; idx += 512) {
            const int p = idx & 63, d = idx >> 6;
            const double lr = a.in[5][pg * 64 + p], li = a.in[6][pg * 64 + p];
            const float mag = (float)exp(lr * dt * d);
            float s, c; sincos_rev(li * dt * d, s, c);
            Ap[idx * 2] = mag * c; Ap[idx * 2 + 1] = mag * s;
            if (d == 32 && qd == 0) { attab[(pg * 64 + p) * 2] = mag * c; attab[(pg * 64 + p) * 2 + 1] = mag * s; }
        }
        for (int idx = tid; idx < 1024; idx += 512) {
            const int p = idx >> 4, h = idx & 15;
            const double lr = a.in[5][pg * 64 + p], li = a.in[6][pg * 64 + p];
            const double zr = lr * dt, zi = li * dt, mag = exp(zr);
            float sh, ch, s1, c1; sincos_rev(0.5 * zi, sh, ch); sincos_rev(zi, s1, c1);
            const double nr = mag * (-2.0 * (double)sh * (double)sh) + expm1(zr);
            const double abi = mag * (double)s1, den = lr * lr + li * li;
            const double cre = (nr * lr + abi * li) / den, cim = (abi * lr - nr * li) / den;
            const double br = a.in[8][(size_t)(pg * 64 + p) * 16 + h], bi = a.in[9][(size_t)(pg * 64 + p) * 16 + h];
            Bb[idx * 2] = (float)(cre * br - cim * bi); Bb[idx * 2 + 1] = (float)(cre * bi + cim * br);
        }
        for (int idx = tid; idx < 1024; idx += 512) {
            Cc[idx * 2] = a.in[10][(size_t)pg * 1024 + idx]; Cc[idx * 2 + 1] = a.in[11][(size_t)pg * 1024 + idx];
        }
        __syncthreads();
        for (int e = tid; e < 8192; e += 512) {
            const int d = e >> 8, ho = (e >> 4) & 15, hi = e & 15;
            float sum = 0.f;
            for (int p = 0; p < 64; ++p) {
                const float cr = Cc[(ho * 64 + p) * 2], ci = Cc[(ho * 64 + p) * 2 + 1], ar = Ap[(d * 64 + p) * 2], ai = Ap[(d * 64 + p) * 2 + 1];
                const float br = Bb[(p * 16 + hi) * 2], bi = Bb[(p * 16 + hi) * 2 + 1];
                const float car = cr * ar - ci * ai, cai = cr * ai + ci * ar;
                sum += car * br - cai * bi;
            }
            Kt[dir * 8192 + e] = sum;
        }
        for (int e = qd * 16384 + tid; e < (qd + 1) * 16384; e += 512) {
            const int k = e & 511, nn = e >> 9, c = nn >> 6, p = nn & 63, t = k >> 4, hi = k & 15;
            const int dd = dir == 0 ? (T5 - 1 - t) : t;
            const float ar = Ap[(dd * 64 + p) * 2], ai = Ap[(dd * 64 + p) * 2 + 1], br = Bb[(p * 16 + hi) * 2], bi = Bb[(p * 16 + hi) * 2 + 1];
            const float val = c ? (ar * bi + ai * br) : (ar * br - ai * bi);
            bts[(size_t)(dir * 128 + nn) * 512 + k] = f2bf(val);
        }
        for (int e = qd * 16384 + tid; e < (qd + 1) * 16384; e += 512) {
            const int kk = e & 127, n = e >> 7, c = kk >> 6, p = kk & 63, to = n >> 4, ho = n & 15;
            const int dd = dir == 0 ? (to + 1) : (T5 - to);
            const float cr = Cc[(ho * 64 + p) * 2], ci = Cc[(ho * 64 + p) * 2 + 1], ar = Ap[(dd * 64 + p) * 2], ai = Ap[(dd * 64 + p) * 2 + 1];
            const float val = c ? -(cr * ai + ci * ar) : (cr * ar - ci * ai);
            bty[(size_t)n * 768 + 512 + dir * 128 + kk] = f2bf(val);
        }
        __syncthreads();
    }
    for (int e = qd * 65536 + tid; e < (qd + 1) * 65536; e += 512) {
        const int k = e & 511, n = e >> 9, to = n >> 4, ho = n & 15, ti = k >> 4, hi = k & 15;
        float val = 0.f;
        if (to >= ti) val += Kt[((to - ti) * 16 + ho) * 16 + hi];
        if (ti >= to) val += Kt[8192 + ((ti - to) * 16 + ho) * 16 + hi];
        if (to == ti && ho == hi) val += a.in[12][g * 16 + ho];
        bty[(size_t)n * 768 + k] = f2bf(val);
    }
    __syncthreads();
}

__device__ __forceinline__ int src_col(int kind, int n) {
    if (kind == 1) { if (n >= 512 && n < 1536) { const int r = n - 512, seg = r >> 7, dp = r & 127; return 512 + seg * 128 + (dp >> 1) + 64 * (dp & 1); } return n; }
    if (kind == 2) { const int pn = n >> 8, bj = (n >> 7) & 1, cc = n & 127; return bj * 1024 + pn * 128 + cc; }
    if (kind == 3) { const int pn = n >> 8, bj = (n >> 7) & 1, cc = n & 127; return bj * DFF + pn * 128 + cc; }
    return n;
}
__device__ __forceinline__ void p0_wtile(const float* W, int K, int N, bf16_t* WT, int kind, const float* kscale, int tile2, LAS float* L) {
    const int tid = threadIdx.x, nkt = K >> 6;
    int n0[2], k0[2];
#pragma unroll
    for (int q = 0; q < 2; ++q) { const int tile = 2 * tile2 + q; n0[q] = (tile / nkt) * 64; k0[q] = (tile % nkt) * 64; }
    float v[2][8];
#pragma unroll
    for (int q = 0; q < 2; ++q)
#pragma unroll
        for (int it = 0; it < 8; ++it) {
            const int idx = tid + it * 512, kk = idx >> 6, j = idx & 63;
            v[q][it] = W[(size_t)(k0[q] + kk) * N + src_col(kind, n0[q] + j)];
        }
#pragma unroll
    for (int q = 0; q < 2; ++q)
#pragma unroll
        for (int it = 0; it < 8; ++it) {
            const int idx = tid + it * 512, kk = idx >> 6, j = idx & 63;
            float x = v[q][it];
            if (kscale) x *= kscale[k0[q] + kk];
            L[q * 4160 + kk * 65 + j] = x;
        }
    __syncthreads();
#pragma unroll
    for (int q = 0; q < 2; ++q)
#pragma unroll
        for (int it = 0; it < 4; ++it) {
            const int idx = tid + it * 512, j = idx >> 5, kp = idx & 31;
            *(unsigned*)(WT + (size_t)(n0[q] + j) * K + k0[q] + 2 * kp) = cvt_pk_bf16(L[q * 4160 + (2 * kp) * 65 + j], L[q * 4160 + (2 * kp + 1) * 65 + j]);
        }
    __syncthreads();
}

__device__ __forceinline__ void phase0(const Args& a, LAS unsigned char* lds) {
    LAS float* L = (LAS float*)lds;
    const int tid = threadIdx.x, wave = tid >> 6, lane = tid & 63;
    constexpr int T_IN = 88 * 16 / 2, T_GLU = 32 * 8 / 2, T_RET = 128, T_OUT = 128, T_FFI = 88 * 16 / 2, T_FFO = 16 * 44 / 2;
    constexpr int NW = 128 + T_IN + T_GLU + T_RET + T_OUT, NRM = RPAD / 32;
    unsigned* qctr = (unsigned*)(a.ws + OFF_BAR) + 4096;
    LAS int* qslot = (LAS int*)(lds + 131072 + 512);
    for (;;) {
        __syncthreads();
        if (tid == 0) *qslot = (int)__hip_atomic_fetch_add(qctr, 1u, __ATOMIC_RELAXED, __HIP_MEMORY_SCOPE_AGENT);
        __syncthreads();
        const int w = *qslot;
        if (w >= NW + NRM) break;
        int r = w;
        if (r < 128) { p0_s5gen(a, L, r >> 2, r & 3); continue; } r -= 128;
        if (r < T_IN) { p0_wtile(a.in[4], 1024, INW, (bf16_t*)(a.ws + OFF_WIN), 1, nullptr, r, L); continue; } r -= T_IN;
        if (r < T_GLU) { p0_wtile(a.in[13], 512, 2048, (bf16_t*)(a.ws + OFF_WGLU), 2, nullptr, r, L); continue; } r -= T_GLU;
        if (r < T_RET) { p0_wtile(a.in[15], 1024, 1024, (bf16_t*)(a.ws + OFF_WRET), 0, nullptr, r, L); continue; } r -= T_RET;
        if (r < T_OUT) { p0_wtile(a.in[16], 1024, 1024, (bf16_t*)(a.ws + OFF_WOUT), 0, nullptr, r, L); continue; } r -= T_OUT;

        const int rowb = r * 32 + wave * 4;
        const float* xr[4]; f32x4 v[4][4];
#pragma unroll
        for (int q = 0; q < 4; ++q) {
            const int row = rowb + q;
            xr[q] = row < NPR ? a.in[0] + (size_t)row * 1024 : (row < NREAL ? a.in[1] + (size_t)(row - NPR) * 1024 : a.in[2] + (size_t)((row - NREAL) & 15) * 1024);
#pragma unroll
            for (int j = 0; j < 4; ++j) v[q][j] = (row < NVALID) ? *(const f32x4*)(xr[q] + (j * 64 + lane) * 4) : (f32x4){0.f, 0.f, 0.f, 0.f};
        }
        f32x4 gg[4];
#pragma unroll
        for (int j = 0; j < 4; ++j) gg[j] = *(const f32x4*)(a.in[3] + (j * 64 + lane) * 4);
#pragma unroll
        for (int q = 0; q < 4; ++q) {
            float sq = 0.f;
#pragma unroll
            for (int j = 0; j < 4; ++j) sq += (v[q][j][0] * v[q][j][0] + v[q][j][1] * v[q][j][1]) + (v[q][j][2] * v[q][j][2] + v[q][j][3] * v[q][j][3]);
            const float rstd = rsqrtf(wave_sum(sq) * (1.0f / 1024.0f) + EPS);
            bf16_t* orow = (bf16_t*)(a.ws + OFF_N1) + (size_t)(rowb + q) * 1024;
#pragma unroll
            for (int j = 0; j < 4; ++j) {
                u32x2 o; o.x = cvt_pk_bf16(v[q][j][0] * rstd * gg[j][0], v[q][j][1] * rstd * gg[j][1]); o.y = cvt_pk_bf16(v[q][j][2] * rstd * gg[j][2], v[q][j][3] * rstd * gg[j][3]);
                *(u32x2*)(orow + (j * 64 + lane) * 4) = o;
            }
        }
    }
}

__device__ __forceinline__ void s5_scan(const Args& a) {
    const float* attab = (const float*)(a.ws + OFF_AT);
    const float* sloc = (const float*)(a.ws + OFF_SLOC);
    bf16_t* u5 = (bf16_t*)(a.ws + OFF_U5);
    for (int id = blockIdx.x * 512 + threadIdx.x; id < 24 * 32 * 2 * 64; id += gridDim.x * 512) {
        const int p = id & 63, dir = (id >> 6) & 1, g = (id >> 7) & 31, b = id >> 12;
        const float atr = attab[((dir * 32 + g) * 64 + p) * 2], ati = attab[((dir * 32 + g) * 64 + p) * 2 + 1];
        const int nck = b < 16 ? 128 : 64, base = b < 16 ? b * 128 : 2048 + (b - 16) * 64, mitem = IT_REAL + b;
        const float* sl = sloc + (size_t)g * IT_PAD * 256 + dir * 128 + p;
        bf16_t* ub = u5 + (size_t)g * IT_PAD * LDA5 + 512 + dir * 128 + p;
        float sr = 0.f, si = 0.f;
        if (dir == 0) {
            ub[(size_t)mitem * LDA5] = 0; ub[(size_t)mitem * LDA5 + 64] = 0;
            sr = sl[(size_t)mitem * 256]; si = sl[(size_t)mitem * 256 + 64];
            for (int c0 = 0; c0 < nck; c0 += 16) {
                float lr[16], li[16];
#pragma unroll
                for (int j = 0; j < 16; ++j) { lr[j] = sl[(size_t)(base + c0 + j) * 256]; li[j] = sl[(size_t)(base + c0 + j) * 256 + 64]; }
#pragma unroll
                for (int j = 0; j < 16; ++j) {
                    const size_t it = (size_t)(base + c0 + j);
                    ub[it * LDA5] = f2bf(sr); ub[it * LDA5 + 64] = f2bf(si);
                    const float nr = atr * sr - ati * si + lr[j], ni = atr * si + ati * sr + li[j];
                    sr = nr; si = ni;
                }
            }
        } else {
            for (int c0 = nck - 16; c0 >= 0; c0 -= 16) {
                float lr[16], li[16];
#pragma unroll
                for (int j = 0; j < 16; ++j) { lr[j] = sl[(size_t)(base + c0 + j) * 256]; li[j] = sl[(size_t)(base + c0 + j) * 256 + 64]; }
#pragma unroll
                for (int j = 15; j >= 0; --j) {
                    const size_t it = (size_t)(base + c0 + j);
                    ub[it * LDA5] = f2bf(sr); ub[it * LDA5 + 64] = f2bf(si);
                    const float nr = atr * sr - ati * si + lr[j], ni = atr * si + ati * sr + li[j];
                    sr = nr; si = ni;
                }
            }
            ub[(size_t)mitem * LDA5] = f2bf(sr); ub[(size_t)mitem * LDA5 + 64] = f2bf(si);
        }
    }
}

constexpr int LDR = 136;
__device__ __forceinline__ float bf2f(bf16_t h) { return __uint_as_float(((unsigned)h) << 16); }

__device__ __forceinline__ void tr_store_pair(LAS bf16_t* img, int f0, int s2, u32x4 r0, u32x4 r1) {
    LAS unsigned* p = (LAS unsigned*)(img + f0 * LDR + s2);
    p[0 * (LDR / 2)] = (r0.x & 0xFFFFu) | (r1.x << 16); p[1 * (LDR / 2)] = (r0.x >> 16) | (r1.x & 0xFFFF0000u);
    p[2 * (LDR / 2)] = (r0.y & 0xFFFFu) | (r1.y << 16); p[3 * (LDR / 2)] = (r0.y >> 16) | (r1.y & 0xFFFF0000u);
    p[4 * (LDR / 2)] = (r0.z & 0xFFFFu) | (r1.z << 16); p[5 * (LDR / 2)] = (r0.z >> 16) | (r1.z & 0xFFFF0000u);
    p[6 * (LDR / 2)] = (r0.w & 0xFFFFu) | (r1.w << 16); p[7 * (LDR / 2)] = (r0.w >> 16) | (r1.w & 0xFFFF0000u);
}
__device__ __forceinline__ void tr_store_pair_scaled(LAS bf16_t* img, int f0, int s2, u32x4 r0, u32x4 r1, float w0, float w1) {
    LAS unsigned* p = (LAS unsigned*)(img + f0 * LDR + s2);
    p[0 * (LDR / 2)] = cvt_pk_bf16(bflo(r0.x) * w0, bflo(r1.x) * w1); p[1 * (LDR / 2)] = cvt_pk_bf16(bfhi(r0.x) * w0, bfhi(r1.x) * w1);
    p[2 * (LDR / 2)] = cvt_pk_bf16(bflo(r0.y) * w0, bflo(r1.y) * w1); p[3 * (LDR / 2)] = cvt_pk_bf16(bfhi(r0.y) * w0, bfhi(r1.y) * w1);
    p[4 * (LDR / 2)] = cvt_pk_bf16(bflo(r0.z) * w0, bflo(r1.z) * w1); p[5 * (LDR / 2)] = cvt_pk_bf16(bfhi(r0.z) * w0, bfhi(r1.z) * w1);
    p[6 * (LDR / 2)] = cvt_pk_bf16(bflo(r0.w) * w0, bflo(r1.w) * w1); p[7 * (LDR / 2)] = cvt_pk_bf16(bfhi(r0.w) * w0, bfhi(r1.w) * w1);
}

#define LDS_BARRIER() do { asm volatile("s_waitcnt lgkmcnt(0)" ::: "memory"); __builtin_amdgcn_s_barrier(); asm volatile("" ::: "memory"); } while (0)
__device__ __forceinline__ void ret_pass_a(const Args& a, LAS unsigned char* lds) {
    LAS bf16_t* KT = (LAS bf16_t*)lds;
    LAS bf16_t* VT = KT + 128 * LDR;
    const int tid0 = threadIdx.x;
    const bf16_t* kb = (const bf16_t*)(a.ws + OFF_K); const bf16_t* vb = (const bf16_t*)(a.ws + OFF_V);
    bf16_t* stb = (bf16_t*)(a.ws + OFF_ST);
    for (int item = blockIdx.x; item < 192; item += gridDim.x) {
        int tid = tid0; asm volatile("" : "+v"(tid));
        const int w = tid >> 6, lane = tid & 63, fr = lane & 15, fq = lane >> 4;
        int b, h, dir;
        if (item < 128) { b = item >> 3; h = (item >> 1) & 3; dir = item & 1; } else { const int j = item - 128; b = 16 + (j >> 3); h = (j >> 1) & 3; dir = j & 1; }
        const int NC = b < 16 ? 32 : 16, rbase = b < 16 ? b * 4096 : NPR + (b - 16) * 2048, ebase = b < 16 ? b * 33 : 528 + (b - 16) * 17;
        const float lg = logsigf_(a.in[14][dir * 4 + h]);
        const float carry = __expf(lg * 128.f);
        const int s2 = 2 * (8 * w + (lane & 7)), pg = lane >> 3;
        const float wk0 = dir == 0 ? __expf(lg * (float)(127 - s2)) : __expf(lg * (float)s2);
        const float wk1 = dir == 0 ? __expf(lg * (float)(126 - s2)) : __expf(lg * (float)(s2 + 1));
        f32x4 acc[2][8];
#pragma unroll
        for (int et = 0; et < 2; ++et)
#pragma unroll
            for (int dtl = 0; dtl < 8; ++dtl) acc[et][dtl] = (f32x4){0.f, 0.f, 0.f, 0.f};
        const int nsteps = dir == 0 ? NC : NC;
        u32x4 rk[2][2], rv[4][2];
        auto load_chunk = [&](int n) {
            int row0; bool valid = true;
            if (n == 0) { valid = s2 >= 112; row0 = NREAL + b * 16 + (s2 - 112); } else row0 = rbase + (n - 1) * 128 + s2;
#pragma unroll
            for (int it = 0; it < 2; ++it)
#pragma unroll
                for (int r = 0; r < 2; ++r) {
                    rk[it][r] = (u32x4){0u, 0u, 0u, 0u};
                    if (valid) rk[it][r] = *(const u32x4*)(kb + (size_t)(row0 + r) * 512 + h * 128 + (pg + 8 * it) * 8);
                }
#pragma unroll
            for (int it = 0; it < 4; ++it)
#pragma unroll
                for (int r = 0; r < 2; ++r) {
                    rv[it][r] = (u32x4){0u, 0u, 0u, 0u};
                    if (valid) rv[it][r] = *(const u32x4*)(vb + (size_t)(row0 + r) * 1024 + h * 256 + (pg + 8 * it) * 8);
                }
        };
        load_chunk(dir == 0 ? 0 : NC);
        for (int step = 0; step < nsteps; ++step) {
            const int n = dir == 0 ? step : NC - step;
            {
                bf16_t* spn = stb + ((size_t)((ebase + n) * 4 + h) * 2 + dir) * 32768;
#pragma unroll
                for (int et = 0; et < 2; ++et)
#pragma unroll
                    for (int dtl = 0; dtl < 8; ++dtl) {
                        u32x2 o; o.x = cvt_pk_bf16(acc[et][dtl][0], acc[et][dtl][1]); o.y = cvt_pk_bf16(acc[et][dtl][2], acc[et][dtl][3]);
                        *(u32x2*)(spn + (size_t)(32 * w + 16 * et + fr) * 128 + 16 * dtl + 4 * fq) = o;
                    }
            }
            LDS_BARRIER();
#pragma unroll
            for (int it = 0; it < 2; ++it) tr_store_pair_scaled(KT, (pg + 8 * it) * 8, s2, rk[it][0], rk[it][1], wk0, wk1);
#pragma unroll
            for (int it = 0; it < 4; ++it) tr_store_pair(VT, (pg + 8 * it) * 8, s2, rv[it][0], rv[it][1]);
            if (step + 1 < nsteps) load_chunk(dir == 0 ? step + 1 : NC - step - 1);
            LDS_BARRIER();
#pragma unroll
            for (int et = 0; et < 2; ++et)
#pragma unroll
                for (int dtl = 0; dtl < 8; ++dtl) acc[et][dtl] = acc[et][dtl] * carry;
#pragma unroll
            for (int ks = 0; ks < 4; ++ks) {
                bf16x8 vf[2];
#pragma unroll
                for (int et = 0; et < 2; ++et) vf[et] = *(const LAS bf16x8*)(VT + (32 * w + 16 * et + fr) * LDR + 32 * ks + 8 * fq);
#pragma unroll
                for (int dtl = 0; dtl < 8; ++dtl) {
                    const bf16x8 kf = *(const LAS bf16x8*)(KT + (16 * dtl + fr) * LDR + 32 * ks + 8 * fq);
#pragma unroll
                    for (int et = 0; et < 2; ++et) acc[et][dtl] = __builtin_amdgcn_mfma_f32_16x16x32_bf16(kf, vf[et], acc[et][dtl], 0, 0, 0);
                }
            }
        }
        if (dir == 0) {
            bf16_t* spn = stb + ((size_t)((ebase + NC) * 4 + h) * 2 + dir) * 32768;
#pragma unroll
            for (int et = 0; et < 2; ++et)
#pragma unroll
                for (int dtl = 0; dtl < 8; ++dtl) {
                    u32x2 o; o.x = cvt_pk_bf16(acc[et][dtl][0], acc[et][dtl][1]); o.y = cvt_pk_bf16(acc[et][dtl][2], acc[et][dtl][3]);
                    *(u32x2*)(spn + (size_t)(32 * w + 16 * et + fr) * 128 + 16 * dtl + 4 * fq) = o;
                }
        }
        LDS_BARRIER();
    }
}

__device__ __forceinline__ void ret_pass_b(const Args& a, LAS unsigned char* lds) {
    LAS bf16_t* KL = (LAS bf16_t*)lds;
    LAS bf16_t* BG = KL + 128 * LDR;
    const int tid0 = threadIdx.x;
    const bf16_t* qb = (const bf16_t*)(a.ws + OFF_Q); const bf16_t* kb = (const bf16_t*)(a.ws + OFF_K); const bf16_t* vb = (const bf16_t*)(a.ws + OFF_V);
    const bf16_t* stb = (const bf16_t*)(a.ws + OFF_ST);
    bf16_t* sg = (bf16_t*)a.out;
    u32x4 rk[4], rb[8]; bf16x8 qf[4];
    auto item_info = [&](int item, int& r0, int& h, const bf16_t*& sfp) {
        const int rc = item >> 2; h = item & 3;
        int b, n; if (rc < 512) { b = rc >> 5; n = (rc & 31) + 1; } else { b = 16 + ((rc - 512) >> 4); n = ((rc - 512) & 15) + 1; }
        const int ebase = b < 16 ? b * 33 : 528 + (b - 16) * 17; r0 = rc * 128;
        sfp = stb + ((size_t)((ebase + n) * 4 + h) * 2 + 0) * 32768;
    };
    auto load_item_head = [&](int item, int tid) {
        int r0, h; const bf16_t* sfp; item_info(item, r0, h, sfp);
#pragma unroll
        for (int it = 0; it < 8; ++it) { const int idx = tid + it * 512, e = idx >> 4, pc = idx & 15; rb[it] = *(const u32x4*)(sfp + (size_t)e * 128 + pc * 8); }
    };
    auto load_item_kq = [&](int item, int tid) {
        int r0, h; const bf16_t* sfp; item_info(item, r0, h, sfp);
        const int w = tid >> 6, lane = tid & 63, fr = lane & 15, fq = lane >> 4;
#pragma unroll
        for (int it = 0; it < 4; ++it) { const int idx = tid + it * 512, s = idx >> 4, pc = idx & 15; rk[it] = *(const u32x4*)(kb + (size_t)(r0 + s) * 512 + h * 128 + pc * 8); }
#pragma unroll
        for (int ks = 0; ks < 4; ++ks) qf[ks] = *(const bf16x8*)(qb + (size_t)(r0 + 16 * w + fr) * 512 + h * 128 + 32 * ks + 8 * fq);
    };
    if ((int)blockIdx.x < 2560) { load_item_head(blockIdx.x, tid0); load_item_kq(blockIdx.x, tid0); }
    for (int item = blockIdx.x; item < 2560; item += gridDim.x) {
        int tid = tid0; asm volatile("" : "+v"(tid));
        const int w = tid >> 6, lane = tid & 63, fr = lane & 15, fq = lane >> 4;
        int r0, h; const bf16_t* sfp; item_info(item, r0, h, sfp);
        const bf16_t* sbp = sfp + 32768;
        const float lgf = logsigf_(a.in[14][h]), lgb = logsigf_(a.in[14][4 + h]);
        const int crow = 16 * w + fr;
        LDS_BARRIER();
#pragma unroll
        for (int it = 0; it < 4; ++it) { const int idx = tid + it * 512, s = idx >> 4, pc = idx & 15; *(LAS u32x4*)(KL + s * LDR + pc * 8) = rk[it]; }
#pragma unroll
        for (int it = 0; it < 8; ++it) { const int idx = tid + it * 512, e = idx >> 4, pc = idx & 15; *(LAS u32x4*)(BG + e * LDR + pc * 8) = rb[it]; }
#pragma unroll
        for (int it = 0; it < 8; ++it) { const int idx = tid + it * 512, e = idx >> 4, pc = idx & 15; rb[it] = *(const u32x4*)(sbp + (size_t)e * 128 + pc * 8); }
        LDS_BARRIER();
        f32x4 sacc[8];
#pragma unroll
        for (int st = 0; st < 8; ++st) sacc[st] = (f32x4){0.f, 0.f, 0.f, 0.f};
#pragma unroll
        for (int ks = 0; ks < 4; ++ks)
#pragma unroll
            for (int st = 0; st < 8; ++st) {
                const bf16x8 kf = *(const LAS bf16x8*)(KL + (16 * st + fr) * LDR + 32 * ks + 8 * fq);
                sacc[st] = __builtin_amdgcn_mfma_f32_16x16x32_bf16(kf, qf[ks], sacc[st], 0, 0, 0);
                if (st == 7) __builtin_amdgcn_sched_barrier(0);
            }
        bf16x8 pf[4];
#pragma unroll
        for (int t = 0; t < 4; ++t) {
            float pv[8];
#pragma unroll
            for (int hh = 0; hh < 2; ++hh)
#pragma unroll
                for (int j = 0; j < 4; ++j) {
                    const int spp = 16 * (2 * t + hh) + 4 * fq + j, diff = crow - spp;
                    const float dec = diff >= 0 ? __expf(lgf * (float)diff) : __expf(-lgb * (float)diff);
                    pv[hh * 4 + j] = sacc[2 * t + hh][j] * dec;
                }
            u32x4 pw; pw.x = cvt_pk_bf16(pv[0], pv[1]); pw.y = cvt_pk_bf16(pv[2], pv[3]); pw.z = cvt_pk_bf16(pv[4], pv[5]); pw.w = cvt_pk_bf16(pv[6], pv[7]);
            pf[t] = __builtin_bit_cast(bf16x8, pw);
        }
        f32x4 o[16];
#pragma unroll
        for (int et = 0; et < 16; ++et) o[et] = (f32x4){0.f, 0.f, 0.f, 0.f};
#pragma unroll
        for (int ks = 0; ks < 4; ++ks)
#pragma unroll
            for (int et = 0; et < 16; ++et) {
                const bf16x8 sf = *(const LAS bf16x8*)(BG + (16 * et + fr) * LDR + 32 * ks + 8 * fq);
                o[et] = __builtin_amdgcn_mfma_f32_16x16x32_bf16(sf, qf[ks], o[et], 0, 0, 0);
                if ((et & 7) == 7) __builtin_amdgcn_sched_barrier(0);
            }
        const float wqf = __expf(lgf * (float)(crow + 1)), wqb = __expf(lgb * (float)(128 - crow));
        const float ratio = wqf / wqb;
#pragma unroll
        for (int et = 0; et < 16; ++et) o[et] = o[et] * ratio;
        LDS_BARRIER();
#pragma unroll
        for (int it = 0; it < 8; ++it) { const int idx = tid + it * 512, e = idx >> 4, pc = idx & 15; *(LAS u32x4*)(BG + e * LDR + pc * 8) = rb[it]; }
        {
            const int s2 = 2 * (8 * w + (lane & 7));
#pragma unroll
            for (int it = 0; it < 4; ++it)
#pragma unroll
                for (int r = 0; r < 2; ++r) rb[it * 2 + r] = *(const u32x4*)(vb + (size_t)(r0 + s2 + r) * 1024 + h * 256 + ((lane >> 3) + 8 * it) * 8);
        }
        LDS_BARRIER();
#pragma unroll
        for (int ks = 0; ks < 4; ++ks)
#pragma unroll
            for (int et = 0; et < 16; ++et) {
                const bf16x8 sf = *(const LAS bf16x8*)(BG + (16 * et + fr) * LDR + 32 * ks + 8 * fq);
                o[et] = __builtin_amdgcn_mfma_f32_16x16x32_bf16(sf, qf[ks], o[et], 0, 0, 0);
                if ((et & 7) == 7) __builtin_amdgcn_sched_barrier(0);
            }
#pragma unroll
        for (int et = 0; et < 16; ++et) o[et] = o[et] * wqb;
        LDS_BARRIER();
#pragma unroll
        for (int it = 0; it < 4; ++it) tr_store_pair(BG, ((lane >> 3) + 8 * it) * 8, 2 * (8 * w + (lane & 7)), rb[it * 2], rb[it * 2 + 1]);
        if (item + (int)gridDim.x < 2560) load_item_head(item + gridDim.x, tid);
        LDS_BARRIER();
#pragma unroll
        for (int t = 0; t < 4; ++t)
#pragma unroll
            for (int et = 0; et < 16; ++et) {
                const u32x2 lo = *(const LAS u32x2*)(BG + (16 * et + fr) * LDR + 32 * t + 4 * fq);
                const u32x2 hi = *(const LAS u32x2*)(BG + (16 * et + fr) * LDR + 32 * t + 16 + 4 * fq);
                const u32x4 vw = (u32x4){lo.x, lo.y, hi.x, hi.y};
                o[et] = __builtin_amdgcn_mfma_f32_16x16x32_bf16(__builtin_bit_cast(bf16x8, vw), pf[t], o[et], 0, 0, 0);
                if ((et & 7) == 7) __builtin_amdgcn_sched_barrier(0);
            }
        float ss = 0.f;
#pragma unroll
        for (int et = 0; et < 16; ++et) ss += (o[et][0] * o[et][0] + o[et][1] * o[et][1]) + (o[et][2] * o[et][2] + o[et][3] * o[et][3]);
        ss += __shfl_xor(ss, 16); ss += __shfl_xor(ss, 32);
        const float rn = rsqrtf(ss * (1.0f / 256.0f) + EPS);
        bf16_t* gp = sg + (size_t)(r0 + crow) * 1024 + h * 256 + 4 * fq;
        u32x2 gwv[16];
#pragma unroll
        for (int et = 0; et < 16; ++et) gwv[et] = *(const u32x2*)(gp + 16 * et);
        if (item + (int)gridDim.x < 2560) load_item_kq(item + gridDim.x, tid);
#pragma unroll
        for (int et = 0; et < 16; ++et) {
            const u32x2 gw = gwv[et];
            u32x2 ow; ow.x = cvt_pk_bf16(o[et][0] * rn * bflo(gw.x), o[et][1] * rn * bfhi(gw.x)); ow.y = cvt_pk_bf16(o[et][2] * rn * bflo(gw.y), o[et][3] * rn * bfhi(gw.y));
            *(u32x2*)(gp + 16 * et) = ow;
        }
    }
    LDS_BARRIER();
}

__device__ __forceinline__ void final_norm(const Args& a) {
    const int wave = threadIdx.x >> 6, lane = threadIdx.x & 63;
    const float* ssq = (const float*)(a.ws + OFF_SSQ2);
    f32x4 gg[4];
#pragma unroll
    for (int j = 0; j < 4; ++j) gg[j] = *(const f32x4*)(a.in[20] + (j * 64 + lane) * 4);
    for (int rowb = (blockIdx.x * 8 + wave) * 4; rowb < NREAL; rowb += gridDim.x * 32) {
        float part[4]; u32x2 w[4][4];
#pragma unroll
        for (int q = 0; q < 4; ++q) {
            part[q] = lane < 16 ? ssq[(size_t)(rowb + q) * 16 + lane] : 0.f;
            const bf16_t* hrow = (const bf16_t*)(a.ws + OFF_H1B) + (size_t)(rowb + q) * 1024;
#pragma unroll
            for (int j = 0; j < 4; ++j) w[q][j] = *(const u32x2*)(hrow + (j * 64 + lane) * 4);
        }
#pragma unroll
        for (int q = 0; q < 4; ++q) {
            const float rstd = rsqrtf(wave_sum(part[q]) * (1.0f / 1024.0f) + EPS);
            float* orow = a.out + (size_t)(rowb + q) * 1024;
#pragma unroll
            for (int j = 0; j < 4; ++j) {
                f32x4 v;
                v[0] = bflo(w[q][j].x) * rstd * gg[j][0]; v[1] = bfhi(w[q][j].x) * rstd * gg[j][1]; v[2] = bflo(w[q][j].y) * rstd * gg[j][2]; v[3] = bfhi(w[q][j].y) * rstd * gg[j][3];
                *(f32x4*)(orow + (j * 64 + lane) * 4) = v;
            }
        }
    }
}

template <int ph>
__device__ __forceinline__ void run_phase(const Args& a, LAS unsigned char* lds) {
    unsigned char* ws = a.ws;
    bf16_t* dob = (bf16_t*)a.out;
    bf16_t* sgp = dob; bf16_t* gap = dob + (size_t)NREAL * 1024;
#ifdef ONLY_PH
    if (ph != ONLY_PH) return;
#endif
    switch (ph) {
    case 0: phase0(a, lds); break;
    case 1: {
        pg8::Gemm g{(const bf16_t*)(ws + OFF_N1), (const bf16_t*)(ws + OFF_WIN), 1024, 1024, 1024, RPAD / 256, INW / 256, 1, 0, 0, STG};
        EpiProj E{(bf16_t*)(ws + OFF_U5), (bf16_t*)(ws + OFF_Q), (bf16_t*)(ws + OFF_K), (bf16_t*)(ws + OFF_V), sgp, gap, (bf16_t*)(ws + OFF_GB), (const LAS double*)(lds + 131072)};
        pg8::gemm_phase(lds, g, E);
        constexpr int T_FFI = 88 * 16 / 2, T_FFO = 16 * 44 / 2, FIRST = (RPAD / 256) * (INW / 256) - 27 * 256;
        const int nblk = (int)gridDim.x, first = nblk == 256 ? FIRST : 0;
        if ((int)blockIdx.x >= first) {
            __syncthreads();
            for (int r = (int)blockIdx.x - first; r < T_FFI + T_FFO; r += nblk - first) {
                if (r < T_FFI) p0_wtile(a.in[18], 1024, INW, (bf16_t*)(ws + OFF_WFFI), 3, a.in[17], r, (LAS float*)lds);
                else p0_wtile(a.in[19], DFF, 1024, (bf16_t*)(ws + OFF_WFFO), 0, nullptr, r - T_FFI, (LAS float*)lds);
            }
        }
    } break;
    case 2: {
        pg8::Gemm g{(const bf16_t*)(ws + OFF_U5), (const bf16_t*)(ws + OFF_BTS), LDA5, 512, 512, IT_PAD / 256, 1, 32, (size_t)IT_PAD * LDA5, (size_t)256 * 512, 0};
        EpiSloc E{(float*)(ws + OFF_SLOC)};
        pg8::gemm_phase(lds, g, E);
    } break;
    case 3: s5_scan(a); break;
    case 4: {
        pg8::Gemm g{(const bf16_t*)(ws + OFF_U5), (const bf16_t*)(ws + OFF_BTY), LDA5, 768, 768, IT_PAD / 256, 2, 32, (size_t)IT_PAD * LDA5, (size_t)512 * 768, 0};
        EpiY E{(bf16_t*)(ws + OFF_YSSM)};
        pg8::gemm_phase(lds, g, E);
    } break;
    case 5: {
        ret_pass_a(a, lds);
        const int bx = (int)blockIdx.x, sub = bx >= 192 ? bx - 192 : (bx >= 128 ? bx - 128 : 0);
        const int u0 = bx >= 192 ? 0 : (bx >= 128 ? GLU_SPLIT : GLU_SPLIT2), u1 = bx >= 192 ? GLU_SPLIT : GLU_SPLIT2;
        pg8::Gemm g{(const bf16_t*)(ws + OFF_YSSM), (const bf16_t*)(ws + OFF_WGLU), 512, 512, 512, NREAL / 256, 8, 1, 0, 0, STG, 64, sub, u0, u1};
        EpiGlu E{gap};
        pg8::gemm_phase(lds, g, E);
    } break;
    case 6: {
        pg8::Gemm g{(const bf16_t*)(ws + OFF_YSSM), (const bf16_t*)(ws + OFF_WGLU), 512, 512, 512, NREAL / 256, 8, 1, 0, 0, STG, (int)gridDim.x, (int)blockIdx.x, GLU_SPLIT2, 2560};
        EpiGlu E{gap};
        pg8::gemm_phase(lds, g, E);
    } break;
    case 7: ret_pass_b(a, lds); break;
    case 8: {
        pg8::Gemm g{sgp, (const bf16_t*)(ws + OFF_WRET), 1024, 1024, 1024, NREAL / 256, 4, 1, 0, 0, STG};
        EpiRet E{gap, (const bf16_t*)(ws + OFF_GB), (bf16_t*)(ws + OFF_MIXED)};
        pg8::gemm_phase(lds, g, E);
    } break;
    case 9: {
        pg8::Gemm g{(const bf16_t*)(ws + OFF_MIXED), (const bf16_t*)(ws + OFF_WOUT), 1024, 1024, 1024, NREAL / 256, 4, 1, 0, 0, STG};
        EpiRes<0> E{a.in[0], a.in[1], (bf16_t*)(ws + OFF_H1B), (float*)(ws + OFF_SSQ1)};
        pg8::gemm_phase(lds, g, E);
    } break;
    case 10: {
        pg8::Gemm g{(const bf16_t*)(ws + OFF_H1B), (const bf16_t*)(ws + OFF_WFFI), 1024, 1024, 1024, NREAL / 256, INW / 256, 1, 0, 0, STG};
        EpiFfi E{(const float*)(ws + OFF_SSQ1), (bf16_t*)(ws + OFF_ACT)};
        pg8::gemm_phase(lds, g, E);
    } break;
    case 11: {
        pg8::Gemm g{(const bf16_t*)(ws + OFF_ACT), (const bf16_t*)(ws + OFF_WFFO), DFF, DFF, DFF, NREAL / 256, 4, 1, 0, 0, STG};
        EpiRes<1> E{nullptr, nullptr, (bf16_t*)(ws + OFF_H1B), (float*)(ws + OFF_SSQ2)};
        pg8::gemm_phase(lds, g, E);
    } break;
    case 12: final_norm(a); break;
    default: break;
    }
}

#define XB_TMO      128
#define XB_XCNT(j)  (256  + 64 * (j))
#define XB_XSUB(j)  (1280 + 64 * (j))
#define XB_XGEN(j)  (2304 + 64 * (j))
#define XB_TOP      3328
#define XB_TOPGEN   3392
#define XCD_BAR_WORDS 3456
#define XB_SPIN_CAP (1u << 18)

__device__ __forceinline__ unsigned xb_ld(unsigned* p)              { return __hip_atomic_load(p, __ATOMIC_RELAXED, __HIP_MEMORY_SCOPE_AGENT); }
__device__ __forceinline__ unsigned xb_add(unsigned* p, unsigned v) { return __hip_atomic_fetch_add(p, v, __ATOMIC_RELAXED, __HIP_MEMORY_SCOPE_AGENT); }
__device__ __forceinline__ unsigned xb_xcc_id() { return (unsigned)__builtin_amdgcn_s_getreg((3 << 11) | 20) & 0xFu; }
#define XB_SPIN(cond, bar) do { unsigned _sp = 0; while (cond) { __builtin_amdgcn_s_sleep(1); \
    if ((++_sp & 255u) == 0u) { if (xb_ld(&(bar)[XB_TMO])) break; if (_sp > XB_SPIN_CAP) { atomicAdd(&(bar)[XB_TMO], 1u); break; } } } } while (0)

struct XcdBarrier {
    unsigned* bar; unsigned x;
    volatile LAS unsigned* st;
};

__device__ __forceinline__ XcdBarrier xcd_barrier_post(unsigned* bar, volatile LAS unsigned* st) {
    XcdBarrier b; b.bar = bar; b.x = xb_xcc_id(); b.st = st;
    if (threadIdx.x == 0) (void)xb_add(&bar[XB_XCNT(b.x)], 1u);
    return b;
}
__device__ __forceinline__ void xcd_barrier_complete(unsigned* bar, unsigned x, unsigned& nloc, unsigned& nx) {
    const unsigned G = gridDim.x * gridDim.y * gridDim.z;
    unsigned sum, cnt, mine, sp = 0u;
    for (;;) {
        sum = 0u; cnt = 0u; mine = 0u;
#pragma unroll
        for (unsigned j = 0; j < 16; ++j) { const unsigned c = xb_ld(&bar[XB_XCNT(j)]); sum += c; cnt += (c > 0u) ? 1u : 0u; mine = (j == x) ? c : mine; }
        if (sum == G) break;
        __builtin_amdgcn_s_sleep(1);
        if ((++sp & 255u) == 0u) { if (xb_ld(&bar[XB_TMO])) break; if (sp > XB_SPIN_CAP) { atomicAdd(&bar[XB_TMO], 1u); break; } }
    }
    nloc = mine > 0u ? mine : 1u; nx = cnt > 0u ? cnt : 1u;
}

__device__ __forceinline__ void xcd_barrier(const XcdBarrier& b) {
    asm volatile("s_waitcnt vmcnt(0)" ::: "memory");
    __syncthreads();
    if (threadIdx.x == 0) {
        unsigned* bar = b.bar;
        __builtin_amdgcn_s_waitcnt(0);
        unsigned nloc = b.st[0], nx = b.st[1];
        if (nloc == 0u) { xcd_barrier_complete(bar, b.x, nloc, nx); b.st[0] = nloc; b.st[1] = nx; }
        const unsigned old = xb_add(&bar[XB_XSUB(b.x)], 1u);
        const unsigned gen = old / nloc;
        if (old + 1u == (gen + 1u) * nloc) {
            __builtin_amdgcn_fence(__ATOMIC_RELEASE, "agent");
            asm volatile("s_waitcnt vmcnt(0)" ::: "memory");
            const unsigned og = xb_add(&bar[XB_TOP], 1u);
            const unsigned tg = og / nx;
            if (og + 1u == (tg + 1u) * nx) xb_add(&bar[XB_TOPGEN], 1u);
            else XB_SPIN(xb_ld(&bar[XB_TOPGEN]) == tg, bar);
            __builtin_amdgcn_fence(__ATOMIC_ACQUIRE, "agent");
            xb_add(&bar[XB_XGEN(b.x)], 1u);
            asm volatile("s_waitcnt vmcnt(0)" ::: "memory");
        } else {
            XB_SPIN(xb_ld(&bar[XB_XGEN(b.x)]) == gen, bar);
            __builtin_amdgcn_fence(__ATOMIC_ACQUIRE, "agent");
            asm volatile("s_waitcnt vmcnt(0)" ::: "memory");
        }
    }
    __syncthreads();
}


__device__ __forceinline__ void grid_barrier(unsigned* ctr, unsigned target) {
    asm volatile("s_waitcnt vmcnt(0) lgkmcnt(0)" ::: "memory");
    __syncthreads();
    if (threadIdx.x == 0) {
        __builtin_amdgcn_fence(__ATOMIC_RELEASE, "agent");
        asm volatile("s_waitcnt vmcnt(0)" ::: "memory");
        __hip_atomic_fetch_add(ctr, 1u, __ATOMIC_RELAXED, __HIP_MEMORY_SCOPE_AGENT);
        unsigned spins = 0;
        while (__hip_atomic_load(ctr, __ATOMIC_RELAXED, __HIP_MEMORY_SCOPE_AGENT) < target && ++spins < (1u << 24)) __builtin_amdgcn_s_sleep(2);
        __builtin_amdgcn_fence(__ATOMIC_ACQUIRE, "agent");
        asm volatile("s_waitcnt vmcnt(0)" ::: "memory");
    }
    __syncthreads();
}

template <bool COOP>
__global__ __launch_bounds__(512, 2) void fwd_kernel(Args a) {
    extern __shared__ __attribute__((aligned(16))) unsigned char shm[];
    LAS unsigned char* lds = (LAS unsigned char*)shm;
    if (threadIdx.x < 64) ((LAS double*)(lds + 131072))[threadIdx.x] = exp2(-(double)threadIdx.x * (13.287712379549449 / 64.0));
    volatile LAS unsigned* xst = (volatile LAS unsigned*)(lds + 131072 + 528);
    if (threadIdx.x == 0) { xst[0] = 0u; xst[1] = 0u; }
    __syncthreads();
    XcdBarrier xb{}; if (COOP) xb = xcd_barrier_post((unsigned*)(a.ws + OFF_BAR), xst);
    if (COOP && a.ph_hi > NPHASE) cg::this_grid().sync();
#define RUN_PH(P) if (a.ph_lo <= P && P < a.ph_hi) { run_phase<P>(a, lds); if ((DBL_MASK >> P) & 1) run_phase<P>(a, lds); if (COOP && P + 1 < a.ph_hi) { xcd_barrier(xb); } }
    RUN_PH(0) RUN_PH(1) RUN_PH(2) RUN_PH(3) RUN_PH(4) RUN_PH(5) RUN_PH(6) RUN_PH(7) RUN_PH(8) RUN_PH(9) RUN_PH(10) RUN_PH(11) RUN_PH(12)
#undef RUN_PH
}

extern "C" void kernel_launch(void* const* d_in, const int* in_sizes, int n_in, void* d_out, int out_size, void* d_ws, size_t ws_size, hipStream_t stream) {
    static int grid = 0;
    if (grid == 0) {
        if (n_in != 21 || ws_size < WS_NEED || out_size != NREAL * 1024) { fprintf(stderr, "kernel_launch: unexpected shapes (n_in %d, ws %zu need %zu, out %d)\n", n_in, ws_size, (size_t)WS_NEED, out_size); grid = -1; return; }
        int dev = 0, cus = 0;
        hipGetDevice(&dev); hipDeviceGetAttribute(&cus, hipDeviceAttributeMultiprocessorCount, dev);
        hipFuncSetAttribute((const void*)fwd_kernel<true>, hipFuncAttributeMaxDynamicSharedMemorySize, LDS_BYTES);
#if !COOP_MODE
        hipFuncSetAttribute((const void*)fwd_kernel<false>, hipFuncAttributeMaxDynamicSharedMemorySize, LDS_BYTES);
#endif
        int per_cu = 0;
        hipOccupancyMaxActiveBlocksPerMultiprocessor(&per_cu, (const void*)fwd_kernel<true>, 512, LDS_BYTES);
        if (per_cu < 1) { fprintf(stderr, "kernel_launch: occupancy query says %d blocks per CU\n", per_cu); per_cu = 1; }
        (void)hipGetLastError();
        grid = cus * 1;
    }
    if (grid < 0) return;
    Args a{};
    for (int i = 0; i < 21; ++i) a.in[i] = (const float*)d_in[i];
    a.out = (float*)d_out; a.ws = (unsigned char*)d_ws;
#if COOP_MODE
    hipMemsetAsync((char*)d_ws + OFF_BAR, 0, 4096 * 4 + 256, stream);
    a.ph_lo = 0; a.ph_hi = NPHASE;
    void* args[] = {&a};
    hipError_t e = hipLaunchCooperativeKernel((const void*)fwd_kernel<true>, dim3(grid), dim3(512), args, LDS_BYTES, stream);
    if (e != hipSuccess) fprintf(stderr, "cooperative launch failed: %s (grid %d)\n", hipGetErrorString(e), grid);
#else
    for (int ph = 0; ph < NPHASE; ++ph) {
        a.ph_lo = ph; a.ph_hi = ph + 1;
        hipLaunchKernelGGL(fwd_kernel<false>, dim3(grid), dim3(512), LDS_BYTES, stream, a);
    }
#endif
}
```

```cpp
#include <hip/hip_runtime.h>
#include <hip/hip_cooperative_groups.h>
#include <cstdio>
#include <cstdint>
namespace cg = cooperative_groups;

#ifndef COOP_MODE
#define COOP_MODE 1
#endif

#define DBL_MASK 0x0
#define LAS __attribute__((address_space(3)))
typedef unsigned short bf16_t;
typedef short bf16x8 __attribute__((ext_vector_type(8)));
typedef float f32x4 __attribute__((ext_vector_type(4)));
typedef unsigned u32x4 __attribute__((ext_vector_type(4)));
typedef unsigned u32x2 __attribute__((ext_vector_type(2)));

constexpr int D = 1024, NREAL = 81920, NPR = 65536, RPAD = 82432, NVALID = 82304;
constexpr int INW = 5632, DFF = 2816;
constexpr int T5 = 32, IT_REAL = 2560, IT_PAD = 2816, LDA5 = 768;
constexpr float EPS = 1e-6f;

constexpr size_t OFF_WIN = 0;
constexpr size_t OFF_WGLU = OFF_WIN + (size_t)INW * D * 2;
constexpr size_t OFF_WRET = OFF_WGLU + (size_t)2048 * 512 * 2;
constexpr size_t OFF_WOUT = OFF_WRET + (size_t)D * D * 2;
constexpr size_t OFF_WFFI = OFF_WOUT + (size_t)D * D * 2;
constexpr size_t OFF_WFFO = OFF_WFFI + (size_t)INW * D * 2;
constexpr size_t OFF_AT = OFF_WFFO + (size_t)D * DFF * 2;
constexpr size_t OFF_BAR = OFF_AT + 32768;
constexpr size_t OFF_Q = OFF_AT + 65536;
constexpr size_t OFF_K = OFF_Q + (size_t)RPAD * 512 * 2;
constexpr size_t OFF_V = OFF_K + (size_t)RPAD * 512 * 2;
constexpr size_t OFF_GB = OFF_V + (size_t)RPAD * D * 2;
constexpr size_t OFF_SSQ1 = OFF_GB + (size_t)NREAL * D * 2;
constexpr size_t OFF_SSQ2 = OFF_SSQ1 + (size_t)NREAL * 16 * 4;
constexpr size_t OFF_X = OFF_SSQ2 + (size_t)NREAL * 16 * 4;
constexpr size_t OFF_N1 = OFF_X;
constexpr size_t OFF_YSSM = OFF_X + (size_t)664 * 8 * 65536;
constexpr size_t OFF_U5 = OFF_N1 + (size_t)RPAD * D * 2;
constexpr size_t OFF_BTY = OFF_U5 + (size_t)32 * IT_PAD * LDA5 * 2;
constexpr size_t OFF_BTS = OFF_BTY + (size_t)32 * 512 * 768 * 2;
constexpr size_t OFF_SLOC = OFF_BTS + (size_t)32 * 256 * 512 * 2;
constexpr size_t END_X03 = OFF_SLOC + (size_t)32 * IT_PAD * 256 * 4;
constexpr size_t OFF_ST = OFF_X;
constexpr size_t END_ST = OFF_ST + (size_t)664 * 8 * 65536;
constexpr size_t OFF_ACT = OFF_X;
constexpr size_t END_ACT = OFF_ACT + (size_t)NREAL * DFF * 2;
constexpr size_t OFF_MIXED = OFF_Q;
constexpr size_t OFF_H1B = OFF_V;
constexpr size_t cmax(size_t a, size_t b) { return a > b ? a : b; }
constexpr size_t WS_NEED = cmax(END_X03, cmax(END_ST, END_ACT));

constexpr int LDS_BYTES = 131072 + 1024;
constexpr int NPHASE = 13;
constexpr int GLU_SPLIT = 64 * 14, GLU_SPLIT2 = GLU_SPLIT + 64 * 6;
constexpr int STG = 0;

struct Args {
    const float* in[21];
    float* out;
    unsigned char* ws;
    int ph_lo, ph_hi;
};

__device__ __forceinline__ unsigned cvt_pk_bf16(float lo, float hi) { unsigned r; asm volatile("v_cvt_pk_bf16_f32 %0, %1, %2" : "=v"(r) : "v"(lo), "v"(hi)); return r; }
__device__ __forceinline__ bf16_t f2bf(float f) { return (bf16_t)(cvt_pk_bf16(f, 0.f) & 0xFFFFu); }
__device__ __forceinline__ float bflo(unsigned w) { return __uint_as_float(w << 16); }
__device__ __forceinline__ float bfhi(unsigned w) { return __uint_as_float(w & 0xFFFF0000u); }
__device__ __forceinline__ float sigmoidf_(float x) { return __builtin_amdgcn_rcpf(1.0f + __builtin_amdgcn_exp2f(-1.4426950408889634f * x)); }
__device__ __forceinline__ float siluf_(float x) { return x * sigmoidf_(x); }
__device__ __forceinline__ float gelu_tanh(float x) { const float z = 0.7978845608028654f * (x + 0.044715f * x * x * x); return x * sigmoidf_(2.0f * z); }
__device__ __forceinline__ float logsigf_(float x) { return fminf(x, 0.f) - log1pf(__expf(-fabsf(x))); }
__device__ __forceinline__ float wave_sum(float v) {
#pragma unroll
    for (int o = 1; o < 64; o <<= 1) v += __shfl_xor(v, o);
    return v;
}
__device__ __forceinline__ void sincos_rev(double ang, float& s, float& c) {
    double x = ang * 0.15915494309189535; x -= rint(x);
    const float xf = (float)x;
    s = __builtin_amdgcn_sinf(xf); c = __builtin_amdgcn_cosf(xf);
}

namespace pg8 {
constexpr int BM = 256, BK = 64, HALF = 128, HTB = HALF * BK * 2, STAGE_BYTES = 8 * HTB, NXCD = 8, WGM = 8;
__device__ __forceinline__ int lds_byte(int r, int c) { const int st = (r >> 4) * 2 + (c >> 5), rr = r & 15, cc = c & 31, ob = rr * 64 + cc * 2; return st * 1024 + (ob ^ (((ob >> 9) & 1) << 5)); }
__device__ __forceinline__ void stage_rc(int b, int& R, int& C) { const int st = b / 1024, sb = b % 1024, swz = sb ^ (((sb >> 9) & 1) << 5); R = (st >> 1) * 16 + swz / 64; C = (st & 1) * 32 + (swz % 64) / 2; }
__device__ __forceinline__ int perm32(int rho) { const int n = rho >> 4, i = rho & 15; return 8 * (i >> 2) + 4 * n + (i & 3); }

struct Unit { int pm, pn, g; };
struct Gemm { const bf16_t* A; const bf16_t* Bt; int lda, ldb, K, nM, nN, nb; size_t sA, sB; int stagger; int G, c, u0, u1; };

struct Order {
    int nM, nN, nwg, total, G, c, u0;
    __device__ void init(int nM_, int nN_, int nb, int G_, int c_, int u0_, int u1_) { nM = nM_; nN = nN_; nwg = nM * nN; total = u1_ > 0 ? u1_ : nwg * nb; G = G_; c = c_; u0 = u0_; }
    __device__ bool next(int i, Unit& u) const {
        const long L = (long)u0 + (long)i * G + c; if (L >= total) return false;
        u.g = (int)(L / nwg); int wgid = (int)(L % nwg);
        { const int q = nwg / NXCD, r = nwg % NXCD, xcd = wgid % NXCD, off = wgid / NXCD; wgid = (xcd < r ? xcd * (q + 1) : r * (q + 1) + (xcd - r) * q) + off; }
        const int nig = WGM * nN, gid = wgid / nig, fm = gid * WGM, gsz = (nM - fm) < WGM ? (nM - fm) : WGM;
        u.pm = fm + ((wgid % nig) % gsz); u.pn = (wgid % nig) / gsz; return true;
    }
};

template <class Epi>
__device__ __forceinline__ void gemm_phase(LAS unsigned char* lds, const Gemm g, const Epi& E) {
    const int tid = threadIdx.x, wid = __builtin_amdgcn_readfirstlane(tid >> 6), lane = tid & 63, wr = wid >> 2, wc = wid & 3, fr = lane & 15, fq = lane >> 4;
    const int K = g.K, nt = K / BK;
    Order S; S.init(g.nM, g.nN, g.nb, g.G > 0 ? g.G : (int)gridDim.x, g.G > 0 ? g.c : (int)blockIdx.x, g.u0, g.u1);
    unsigned voffA[2], voffB[2];
#pragma unroll
    for (int i = 0; i < 2; ++i) { int R, C; stage_rc(tid * 16 + i * 8192, R, C); const int Rb = (R & ~31) + perm32(R & 31);
        voffA[i] = (unsigned)(R * g.lda + C) * 2u; voffB[i] = (unsigned)(Rb * g.ldb + C) * 2u; }
    const size_t kstep = (size_t)(BK * 2);
    const size_t hstepA = (size_t)HALF * g.lda * 2, hstepB = (size_t)HALF * g.ldb * 2;
    const size_t tstepA = 2 * hstepA, tstepB = 2 * hstepB;
    const unsigned ldsw = (unsigned)wid * 1024u;
    const int aoff = lds_byte(wr * 64 + fr, fq * 8), boff = lds_byte(wc * 32 + fr, fq * 8);
#define PG8_SA(b, h) (((b) * 2 + (h)) * HTB)
#define PG8_SB(b, h) ((4 + (b) * 2 + (h)) * HTB)
#define PG8_STAGE(bufoff, gbase, voff) do { _Pragma("unroll") for (int _i = 0; _i < 2; ++_i) \
        __builtin_amdgcn_global_load_lds((const unsigned*)((const char*)(gbase) + (voff)[_i]), (LAS unsigned*)(lds + (bufoff) + ldsw + _i * 8192), 16, 0, 0); } while (0)
#define PG8_LDA(dst, b, h) do { _Pragma("unroll") for (int m = 0; m < 4; ++m) _Pragma("unroll") for (int k = 0; k < 2; ++k) dst[m][k] = *(const LAS bf16x8*)(lds + PG8_SA(b, h) + aoff + m * 2048 + k * 1024); } while (0)
#define PG8_LDB(dst, b, h) do { _Pragma("unroll") for (int n = 0; n < 2; ++n) _Pragma("unroll") for (int k = 0; k < 2; ++k) dst[n][k] = *(const LAS bf16x8*)(lds + PG8_SB(b, h) + boff + n * 2048 + k * 1024); } while (0)
#define PG8_MMA(ai, bj, At, Bt) do { __builtin_amdgcn_s_setprio(1); _Pragma("unroll") for (int m = 0; m < 4; ++m) _Pragma("unroll") for (int n = 0; n < 2; ++n) _Pragma("unroll") for (int k = 0; k < 2; ++k) \
        acc[ai][bj][m][n] = __builtin_amdgcn_mfma_f32_16x16x32_bf16(Bt[n][k], At[m][k], acc[ai][bj][m][n], 0, 0, 0); __builtin_amdgcn_s_setprio(0); } while (0)
#define PG8_WAIT_V(n) asm volatile("s_waitcnt vmcnt(" #n ")" ::: "memory")
#define PG8_WAIT_L(n) asm volatile("s_waitcnt lgkmcnt(" #n ")" ::: "memory")
#define PG8_BAR __builtin_amdgcn_s_barrier()
#define PG8_SCHED __builtin_amdgcn_sched_barrier(0)
    Unit cur, nxt; int ui = 0;
    if (!S.next(0, cur)) return;
    if (g.stagger) {
        const unsigned long long t0 = __builtin_amdgcn_s_memrealtime(), wt = (unsigned long long)((blockIdx.x & 3) * g.stagger);
        while (__builtin_amdgcn_s_memrealtime() - t0 < wt) __builtin_amdgcn_s_sleep(16);
    }
    f32x4 acc[2][2][4][2];
#pragma unroll
    for (int a = 0; a < 2; ++a)
#pragma unroll
        for (int b = 0; b < 2; ++b)
#pragma unroll
            for (int m = 0; m < 4; ++m)
#pragma unroll
                for (int n = 0; n < 2; ++n) acc[a][b][m][n] = (f32x4){0.f, 0.f, 0.f, 0.f};
    bf16x8 At[4][2], B0[2][2], B1[2][2];
    const char* cA = (const char*)g.A + ((size_t)cur.g * g.sA) * 2 + (size_t)cur.pm * tstepA;
    const char* cB = (const char*)g.Bt + ((size_t)cur.g * g.sB) * 2 + (size_t)cur.pn * tstepB;
    PG8_STAGE(PG8_SB(0, 0), cB, voffB); PG8_STAGE(PG8_SA(0, 0), cA, voffA); PG8_STAGE(PG8_SB(0, 1), cB + hstepB, voffB); PG8_STAGE(PG8_SA(0, 1), cA + hstepA, voffA);
    if (wr == 1) PG8_BAR;
    PG8_WAIT_V(4); PG8_BAR;
    PG8_STAGE(PG8_SB(1, 0), cB + kstep, voffB); PG8_STAGE(PG8_SA(1, 0), cA + kstep, voffA); PG8_STAGE(PG8_SB(1, 1), cB + hstepB + kstep, voffB);
    PG8_WAIT_V(6); PG8_BAR;
    for (;;) {
        const bool has_next = S.next(ui + 1, nxt);
        const char* nA = has_next ? (const char*)g.A + ((size_t)nxt.g * g.sA) * 2 + (size_t)nxt.pm * tstepA : cA;
        const char* nB = has_next ? (const char*)g.Bt + ((size_t)nxt.g * g.sB) * 2 + (size_t)nxt.pn * tstepB : cB;
        for (int t = 0; t < nt; t += 2) {
            const bool last = (t == nt - 2);
            const char* a1 = cA + (size_t)(t + 1) * kstep;
            const char* a2 = last ? nA : cA + (size_t)(t + 2) * kstep; const char* b2 = last ? nB : cB + (size_t)(t + 2) * kstep;
            const char* a3 = a2 + kstep; const char* b3 = b2 + kstep;
            PG8_LDB(B0, 0, 0); PG8_SCHED; PG8_LDA(At, 0, 0); PG8_STAGE(PG8_SA(1, 1), a1 + hstepA, voffA);
            PG8_WAIT_L(8); PG8_BAR; PG8_WAIT_L(0); PG8_MMA(0, 0, At, B0); PG8_BAR; PG8_SCHED;
            PG8_LDB(B1, 0, 1); PG8_STAGE(PG8_SB(0, 0), b2, voffB);
            PG8_BAR; PG8_WAIT_L(0); PG8_MMA(0, 1, At, B1); PG8_BAR;
            PG8_LDA(At, 0, 1); PG8_STAGE(PG8_SA(0, 0), a2, voffA);
            PG8_BAR; PG8_WAIT_L(0); PG8_MMA(1, 0, At, B0); PG8_BAR; PG8_SCHED;
            PG8_STAGE(PG8_SB(0, 1), b2 + hstepB, voffB);
            PG8_WAIT_V(6); PG8_BAR; PG8_MMA(1, 1, At, B1); PG8_BAR;
            PG8_LDB(B0, 1, 0); PG8_SCHED; PG8_LDA(At, 1, 0); PG8_STAGE(PG8_SA(0, 1), a2 + hstepA, voffA);
            PG8_WAIT_L(8); PG8_BAR; PG8_WAIT_L(0); PG8_MMA(0, 0, At, B0); PG8_BAR; PG8_SCHED;
            PG8_LDB(B1, 1, 1); PG8_STAGE(PG8_SB(1, 0), b3, voffB);
            PG8_BAR; PG8_WAIT_L(0); PG8_MMA(0, 1, At, B1); PG8_BAR;
            PG8_LDA(At, 1, 1); PG8_STAGE(PG8_SA(1, 0), a3, voffA);
            PG8_BAR; PG8_WAIT_L(0); PG8_MMA(1, 0, At, B0); PG8_BAR; PG8_SCHED;
            PG8_STAGE(PG8_SB(1, 1), b3 + hstepB, voffB);
            PG8_WAIT_V(6); PG8_BAR; PG8_MMA(1, 1, At, B1); PG8_BAR;
        }
        E(acc, cur, wr, wc, fr, fq);
        if (!has_next) break;
#pragma unroll
        for (int a = 0; a < 2; ++a)
#pragma unroll
            for (int b = 0; b < 2; ++b)
#pragma unroll
                for (int m = 0; m < 4; ++m)
#pragma unroll
                    for (int n = 0; n < 2; ++n) acc[a][b][m][n] = (f32x4){0.f, 0.f, 0.f, 0.f};
        cur = nxt; cA = nA; cB = nB; ++ui;
    }
    PG8_WAIT_V(0);
    if (wr == 0) PG8_BAR;
    PG8_BAR;
#undef PG8_SA
#undef PG8_SB
#undef PG8_STAGE
#undef PG8_LDA
#undef PG8_LDB
#undef PG8_MMA
#undef PG8_WAIT_V
#undef PG8_WAIT_L
#undef PG8_BAR
#undef PG8_SCHED
}
}
using pg8::Unit;
typedef const f32x4 (&AccRef)[2][2][4][2];

__device__ __forceinline__ u32x4 pack8(f32x4 a, f32x4 b) { u32x4 w; w.x = cvt_pk_bf16(a[0], a[1]); w.y = cvt_pk_bf16(a[2], a[3]); w.z = cvt_pk_bf16(b[0], b[1]); w.w = cvt_pk_bf16(b[2], b[3]); return w; }

struct EpiProj {
    bf16_t *u5, *q, *k, *v, *sg, *ga, *gb; const LAS float* ropef;
    __device__ __forceinline__ void operator()(AccRef acc, const Unit& u, int wr, int wc, int fr, int fq) const {
        const int pn = u.pn;
#pragma unroll
        for (int ai = 0; ai < 2; ++ai)
#pragma unroll
            for (int m = 0; m < 4; ++m) {
                const int row = u.pm * 256 + ai * 128 + wr * 64 + m * 16 + fr;
#pragma unroll
                for (int bj = 0; bj < 2; ++bj) {
                    const int col = pn * 256 + bj * 128 + wc * 32 + 8 * fq;
                    f32x4 v0 = acc[ai][bj][m][0], v1 = acc[ai][bj][m][1];
                    if (pn < 2) {
                        if (row < NVALID) {
                            int item, t;
                            if (row < NREAL) { item = row >> 5; t = row & 31; } else { const int mr = row - NREAL; item = IT_REAL + (mr >> 4); t = 16 + (mr & 15); }
                            const int g = col >> 4, h0 = col & 15;
                            *(u32x4*)(u5 + ((size_t)(g * IT_PAD + item) * LDA5 + t * 16 + h0)) = pack8(v0, v1);
                        }
                    } else if (pn < 6) {
                        const int cq = col - 512, isk = cq >> 9, cc = cq & 511, i0 = (cc & 127) >> 1;
                        const int pos = row < NPR ? 16 + (row & 4095) : (row < NREAL ? 16 + ((row - NPR) & 2047) : ((row - NREAL) & 15));
                        const float sc = isk ? 1.0f : 0.08838834764831845f;
                        float o[8];
#pragma unroll
                        for (int pi = 0; pi < 4; ++pi) {
                            const float fp = (float)pos, t1 = fp * ropef[2 * (i0 + pi)];
                            const float rev = (t1 - rintf(t1)) + fp * ropef[2 * (i0 + pi) + 1];
                            const float s = __builtin_amdgcn_sinf(rev), c = __builtin_amdgcn_cosf(rev);
                            const float x1 = pi < 2 ? v0[2 * pi] : v1[2 * pi - 4], x2 = pi < 2 ? v0[2 * pi + 1] : v1[2 * pi - 3];
                            o[2 * pi] = (x1 * c - x2 * s) * sc; o[2 * pi + 1] = (x1 * s + x2 * c) * sc;
                        }
                        u32x4 w; w.x = cvt_pk_bf16(o[0], o[1]); w.y = cvt_pk_bf16(o[2], o[3]); w.z = cvt_pk_bf16(o[4], o[5]); w.w = cvt_pk_bf16(o[6], o[7]);
                        *(u32x4*)((isk ? k : q) + (size_t)row * 512 + cc) = w;
                    } else if (pn < 10) {
                        *(u32x4*)(v + (size_t)row * 1024 + (col - 1536)) = pack8(v0, v1);
                    } else if (row < NREAL) {
                        if (pn < 14) {
#pragma unroll
                            for (int j = 0; j < 4; ++j) { v0[j] = siluf_(v0[j]); v1[j] = siluf_(v1[j]); }
                            *(u32x4*)(sg + (size_t)row * 1024 + (col - 2560)) = pack8(v0, v1);
                        } else {
#pragma unroll
                            for (int j = 0; j < 4; ++j) { v0[j] = sigmoidf_(v0[j]); v1[j] = sigmoidf_(v1[j]); }
                            if (pn < 18) *(u32x4*)(ga + (size_t)row * 1024 + (col - 3584)) = pack8(v0, v1);
                            else *(u32x4*)(gb + (size_t)row * 1024 + (col - 4608)) = pack8(v0, v1);
                        }
                    }
                }
            }
    }
};

struct EpiSink {
    float* p; int flag;
    __device__ __forceinline__ void operator()(AccRef acc, const Unit& u, int wr, int wc, int fr, int fq) const {
        if (flag) {
#pragma unroll
            for (int ai = 0; ai < 2; ++ai)
#pragma unroll
                for (int m = 0; m < 4; ++m)
#pragma unroll
                    for (int bj = 0; bj < 2; ++bj) { p[(ai * 8 + m * 2 + bj) * 8 + fr] = acc[ai][bj][m][0][0] + acc[ai][bj][m][1][1]; }
        }
    }
};

struct EpiSloc {
    float* sloc;
    __device__ __forceinline__ void operator()(AccRef acc, const Unit& u, int wr, int wc, int fr, int fq) const {
#pragma unroll
        for (int ai = 0; ai < 2; ++ai)
#pragma unroll
            for (int m = 0; m < 4; ++m) {
                const int row = u.pm * 256 + ai * 128 + wr * 64 + m * 16 + fr;
#pragma unroll
                for (int bj = 0; bj < 2; ++bj) {
                    const int col = bj * 128 + wc * 32 + 8 * fq;
                    float* p = sloc + ((size_t)u.g * IT_PAD + row) * 256 + col;
                    *(f32x4*)p = acc[ai][bj][m][0]; *(f32x4*)(p + 4) = acc[ai][bj][m][1];
                }
            }
    }
};

struct EpiY {
    bf16_t* y;
    __device__ __forceinline__ void operator()(AccRef acc, const Unit& u, int wr, int wc, int fr, int fq) const {
#pragma unroll
        for (int ai = 0; ai < 2; ++ai)
#pragma unroll
            for (int m = 0; m < 4; ++m) {
                const int item = u.pm * 256 + ai * 128 + wr * 64 + m * 16 + fr;
                if (item < IT_REAL) {
#pragma unroll
                    for (int bj = 0; bj < 2; ++bj) {
                        const int col = u.pn * 256 + bj * 128 + wc * 32 + 8 * fq, to = col >> 4, ho = col & 15;
                        f32x4 v0 = acc[ai][bj][m][0], v1 = acc[ai][bj][m][1];
#pragma unroll
                        for (int j = 0; j < 4; ++j) { v0[j] = gelu_tanh(v0[j]); v1[j] = gelu_tanh(v1[j]); }
                        *(u32x4*)(y + (size_t)(item * 32 + to) * 512 + u.g * 16 + ho) = pack8(v0, v1);
                    }
                }
            }
    }
};

struct EpiGlu {
    bf16_t* ga;
    __device__ __forceinline__ void operator()(AccRef acc, const Unit& u, int wr, int wc, int fr, int fq) const {
        u32x4 gw[2][4];
#pragma unroll
        for (int ai = 0; ai < 2; ++ai)
#pragma unroll
            for (int m = 0; m < 4; ++m) {
                const int row = u.pm * 256 + ai * 128 + wr * 64 + m * 16 + fr;
                gw[ai][m] = *(const u32x4*)(ga + (size_t)row * 1024 + u.pn * 128 + wc * 32 + 8 * fq);
            }
#pragma unroll
        for (int ai = 0; ai < 2; ++ai)
#pragma unroll
            for (int m = 0; m < 4; ++m) {
                const int row = u.pm * 256 + ai * 128 + wr * 64 + m * 16 + fr;
                bf16_t* p = ga + (size_t)row * 1024 + u.pn * 128 + wc * 32 + 8 * fq;
                const u32x4 g = gw[ai][m];
                const f32x4 a0 = acc[ai][0][m][0], a1 = acc[ai][0][m][1], g0 = acc[ai][1][m][0], g1 = acc[ai][1][m][1];
                f32x4 r0, r1;
                r0[0] = bflo(g.x) * a0[0] * sigmoidf_(g0[0]); r0[1] = bfhi(g.x) * a0[1] * sigmoidf_(g0[1]);
                r0[2] = bflo(g.y) * a0[2] * sigmoidf_(g0[2]); r0[3] = bfhi(g.y) * a0[3] * sigmoidf_(g0[3]);
                r1[0] = bflo(g.z) * a1[0] * sigmoidf_(g1[0]); r1[1] = bfhi(g.z) * a1[1] * sigmoidf_(g1[1]);
                r1[2] = bflo(g.w) * a1[2] * sigmoidf_(g1[2]); r1[3] = bfhi(g.w) * a1[3] * sigmoidf_(g1[3]);
                *(u32x4*)p = pack8(r0, r1);
            }
    }
};

struct EpiRet {
    const bf16_t *pa, *gb; bf16_t* mixed;
    __device__ __forceinline__ void operator()(AccRef acc, const Unit& u, int wr, int wc, int fr, int fq) const {
#pragma unroll
        for (int ai = 0; ai < 2; ++ai) {
            u32x4 pw[4][2], gw[4][2];
#pragma unroll
            for (int m = 0; m < 4; ++m)
#pragma unroll
                for (int bj = 0; bj < 2; ++bj) {
                    const int row = u.pm * 256 + ai * 128 + wr * 64 + m * 16 + fr;
                    const size_t o = (size_t)row * 1024 + u.pn * 256 + bj * 128 + wc * 32 + 8 * fq;
                    pw[m][bj] = *(const u32x4*)(pa + o); gw[m][bj] = *(const u32x4*)(gb + o);
                }
#pragma unroll
            for (int m = 0; m < 4; ++m)
#pragma unroll
                for (int bj = 0; bj < 2; ++bj) {
                    const int row = u.pm * 256 + ai * 128 + wr * 64 + m * 16 + fr;
                    const size_t o = (size_t)row * 1024 + u.pn * 256 + bj * 128 + wc * 32 + 8 * fq;
                    const u32x4 p = pw[m][bj], g = gw[m][bj];
                    const f32x4 a0 = acc[ai][bj][m][0], a1 = acc[ai][bj][m][1];
                    f32x4 r0, r1;
                    r0[0] = bflo(p.x) + bflo(g.x) * a0[0]; r0[1] = bfhi(p.x) + bfhi(g.x) * a0[1];
                    r0[2] = bflo(p.y) + bflo(g.y) * a0[2]; r0[3] = bfhi(p.y) + bfhi(g.y) * a0[3];
                    r1[0] = bflo(p.z) + bflo(g.z) * a1[0]; r1[1] = bfhi(p.z) + bfhi(g.z) * a1[1];
                    r1[2] = bflo(p.w) + bflo(g.w) * a1[2]; r1[3] = bfhi(p.w) + bfhi(g.w) * a1[3];
                    *(u32x4*)(mixed + o) = pack8(r0, r1);
                }
            __builtin_amdgcn_sched_barrier(0);
        }
    }
};

template <int MODE>
struct EpiRes {
    const float *xp, *xs; bf16_t* hb; float* ssq;
    __device__ __forceinline__ void operator()(AccRef acc, const Unit& u, int wr, int wc, int fr, int fq) const {
#pragma unroll
        for (int ai = 0; ai < 2; ++ai) {
            f32x4 x0[4][2], x1[4][2]; u32x4 hw[4][2];
#pragma unroll
            for (int m = 0; m < 4; ++m)
#pragma unroll
                for (int bj = 0; bj < 2; ++bj) {
                    const int row = u.pm * 256 + ai * 128 + wr * 64 + m * 16 + fr, col = u.pn * 256 + bj * 128 + wc * 32 + 8 * fq;
                    if (MODE == 0) {
                        const float* src = (row < NPR ? xp + (size_t)row * 1024 : xs + (size_t)(row - NPR) * 1024) + col;
                        x0[m][bj] = *(const f32x4*)src; x1[m][bj] = *(const f32x4*)(src + 4);
                    } else hw[m][bj] = *(const u32x4*)(hb + (size_t)row * 1024 + col);
                }
#pragma unroll
            for (int m = 0; m < 4; ++m) {
                const int row = u.pm * 256 + ai * 128 + wr * 64 + m * 16 + fr;
                float ss = 0.f;
#pragma unroll
                for (int bj = 0; bj < 2; ++bj) {
                    const int col = u.pn * 256 + bj * 128 + wc * 32 + 8 * fq;
                    f32x4 h0, h1;
                    if (MODE == 0) { h0 = x0[m][bj]; h1 = x1[m][bj]; }
                    else { const u32x4 w = hw[m][bj]; h0 = (f32x4){bflo(w.x), bfhi(w.x), bflo(w.y), bfhi(w.y)}; h1 = (f32x4){bflo(w.z), bfhi(w.z), bflo(w.w), bfhi(w.w)}; }
                    h0 = h0 + acc[ai][bj][m][0]; h1 = h1 + acc[ai][bj][m][1];
                    *(u32x4*)(hb + (size_t)row * 1024 + col) = pack8(h0, h1);
                    ss += (h0[0] * h0[0] + h0[1] * h0[1]) + (h0[2] * h0[2] + h0[3] * h0[3]) + (h1[0] * h1[0] + h1[1] * h1[1]) + (h1[2] * h1[2] + h1[3] * h1[3]);
                }
                ss += __shfl_xor(ss, 16); ss += __shfl_xor(ss, 32);
                if (fq == 0) ssq[(size_t)row * 16 + u.pn * 4 + wc] = ss;
            }
            __builtin_amdgcn_sched_barrier(0);
        }
    }
};

struct EpiFfi {
    const float* ssq; bf16_t* act;
    __device__ __forceinline__ void operator()(AccRef acc, const Unit& u, int wr, int wc, int fr, int fq) const {
        f32x4 sp[2][4];
#pragma unroll
        for (int ai = 0; ai < 2; ++ai)
#pragma unroll
            for (int m = 0; m < 4; ++m) {
                const int row = u.pm * 256 + ai * 128 + wr * 64 + m * 16 + fr;
                sp[ai][m] = *(const f32x4*)(ssq + (size_t)row * 16 + 4 * fq);
            }
#pragma unroll
        for (int ai = 0; ai < 2; ++ai)
#pragma unroll
            for (int m = 0; m < 4; ++m) {
                const int row = u.pm * 256 + ai * 128 + wr * 64 + m * 16 + fr;
                float tot = (sp[ai][m][0] + sp[ai][m][1]) + (sp[ai][m][2] + sp[ai][m][3]);
                tot += __shfl_xor(tot, 16); tot += __shfl_xor(tot, 32);
                const float rstd = rsqrtf(tot * (1.0f / 1024.0f) + EPS);
                const f32x4 g0 = acc[ai][0][m][0], g1 = acc[ai][0][m][1], u0 = acc[ai][1][m][0], u1 = acc[ai][1][m][1];
                f32x4 r0, r1;
#pragma unroll
                for (int j = 0; j < 4; ++j) { r0[j] = siluf_(rstd * g0[j]) * (rstd * u0[j]); r1[j] = siluf_(rstd * g1[j]) * (rstd * u1[j]); }
                *(u32x4*)(act + (size_t)row * DFF + u.pn * 128 + wc * 32 + 8 * fq) = pack8(r0, r1);
            }
    }
};

__device__ __forceinline__ void p0_s5gen(const Args& a, LAS float* L, int g, int qd) {
    const int tid = threadIdx.x;
    LAS float* Kt = L;
    LAS float* Ap = L + 16384;
    LAS float* Bb = Ap + 33 * 64 * 2;
    LAS float* Cc = Bb + 2048;
    bf16_t* bts = (bf16_t*)(a.ws + OFF_BTS) + (size_t)g * 256 * 512;
    bf16_t* bty = (bf16_t*)(a.ws + OFF_BTY) + (size_t)g * 512 * 768;
    float* attab = (float*)(a.ws + OFF_AT);
    bf16_t* u5 = (bf16_t*)(a.ws + OFF_U5);
    if (qd == 0) for (int e = tid; e < 24 * 256; e += 512) { const int b = e >> 8, kk = e & 255; u5[((size_t)g * IT_PAD + IT_REAL + b) * LDA5 + kk] = 0; }
    for (int dir = 0; dir < 2; ++dir) {
        const int pg = dir * 32 + g;
        const double dt = exp((double)a.in[7][pg]);
        for (int idx = tid; idx < 33 * 64; idx += 512) {
            const int p = idx & 63, d = idx >> 6;
            const double lr = a.in[5][pg * 64 + p], li = a.in[6][pg * 64 + p];
            const float mag = (float)exp(lr * dt * d);
            float s, c; sincos_rev(li * dt * d, s, c);
            Ap[idx * 2] = mag * c; Ap[idx * 2 + 1] = mag * s;
            if (d == 32 && qd == 0) { attab[(pg * 64 + p) * 2] = mag * c; attab[(pg * 64 + p) * 2 + 1] = mag * s; }
        }
        for (int idx = tid; idx < 1024; idx += 512) {
            const int p = idx >> 4, h = idx & 15;
            const double lr = a.in[5][pg * 64 + p], li = a.in[6][pg * 64 + p];
            const double zr = lr * dt, zi = li * dt, mag = exp(zr);
            float sh, ch, s1, c1; sincos_rev(0.5 * zi, sh, ch); sincos_rev(zi, s1, c1);
            const double nr = mag * (-2.0 * (double)sh * (double)sh) + expm1(zr);
            const double abi = mag * (double)s1, den = lr * lr + li * li;
            const double cre = (nr * lr + abi * li) / den, cim = (abi * lr - nr * li) / den;
            const double br = a.in[8][(size_t)(pg * 64 + p) * 16 + h], bi = a.in[9][(size_t)(pg * 64 + p) * 16 + h];
            Bb[idx * 2] = (float)(cre * br - cim * bi); Bb[idx * 2 + 1] = (float)(cre * bi + cim * br);
        }
        for (int idx = tid; idx < 1024; idx += 512) {
            Cc[idx * 2] = a.in[10][(size_t)pg * 1024 + idx]; Cc[idx * 2 + 1] = a.in[11][(size_t)pg * 1024 + idx];
        }
        __syncthreads();
        for (int e = tid; e < 8192; e += 512) {
            const int d = e >> 8, ho = (e >> 4) & 15, hi = e & 15;
            float sum = 0.f;
            for (int p = 0; p < 64; ++p) {
                const float cr = Cc[(ho * 64 + p) * 2], ci = Cc[(ho * 64 + p) * 2 + 1], ar = Ap[(d * 64 + p) * 2], ai = Ap[(d * 64 + p) * 2 + 1];
                const float br = Bb[(p * 16 + hi) * 2], bi = Bb[(p * 16 + hi) * 2 + 1];
                const float car = cr * ar - ci * ai, cai = cr * ai + ci * ar;
                sum += car * br - cai * bi;
            }
            Kt[dir * 8192 + e] = sum;
        }
        for (int e = qd * 16384 + tid; e < (qd + 1) * 16384; e += 512) {
            const int k = e & 511, nn = e >> 9, c = nn >> 6, p = nn & 63, t = k >> 4, hi = k & 15;
            const int dd = dir == 0 ? (T5 - 1 - t) : t;
            const float ar = Ap[(dd * 64 + p) * 2], ai = Ap[(dd * 64 + p) * 2 + 1], br = Bb[(p * 16 + hi) * 2], bi = Bb[(p * 16 + hi) * 2 + 1];
            const float val = c ? (ar * bi + ai * br) : (ar * br - ai * bi);
            bts[(size_t)(dir * 128 + nn) * 512 + k] = f2bf(val);
        }
        for (int e = qd * 16384 + tid; e < (qd + 1) * 16384; e += 512) {
            const int kk = e & 127, n = e >> 7, c = kk >> 6, p = kk & 63, to = n >> 4, ho = n & 15;
            const int dd = dir == 0 ? (to + 1) : (T5 - to);
            const float cr = Cc[(ho * 64 + p) * 2], ci = Cc[(ho * 64 + p) * 2 + 1], ar = Ap[(dd * 64 + p) * 2], ai = Ap[(dd * 64 + p) * 2 + 1];
            const float val = c ? -(cr * ai + ci * ar) : (cr * ar - ci * ai);
            bty[(size_t)n * 768 + 512 + dir * 128 + kk] = f2bf(val);
        }
        __syncthreads();
    }
    for (int e = qd * 65536 + tid; e < (qd + 1) * 65536; e += 512) {
        const int k = e & 511, n = e >> 9, to = n >> 4, ho = n & 15, ti = k >> 4, hi = k & 15;
        float val = 0.f;
        if (to >= ti) val += Kt[((to - ti) * 16 + ho) * 16 + hi];
        if (ti >= to) val += Kt[8192 + ((ti - to) * 16 + ho) * 16 + hi];
        if (to == ti && ho == hi) val += a.in[12][g * 16 + ho];
        bty[(size_t)n * 768 + k] = f2bf(val);
    }
    __syncthreads();
}

__device__ __forceinline__ int src_col(int kind, int n) {
    if (kind == 1) { if (n >= 512 && n < 1536) { const int r = n - 512, seg = r >> 7, dp = r & 127; return 512 + seg * 128 + (dp >> 1) + 64 * (dp & 1); } return n; }
    if (kind == 2) { const int pn = n >> 8, bj = (n >> 7) & 1, cc = n & 127; return bj * 1024 + pn * 128 + cc; }
    if (kind == 3) { const int pn = n >> 8, bj = (n >> 7) & 1, cc = n & 127; return bj * DFF + pn * 128 + cc; }
    return n;
}
__device__ __forceinline__ void p0_wtile(const float* W, int K, int N, bf16_t* WT, int kind, const float* kscale, int tile2, LAS float* L) {
    const int tid = threadIdx.x, nkt = K >> 6;
    int n0[2], k0[2];
#pragma unroll
    for (int q = 0; q < 2; ++q) { const int tile = 2 * tile2 + q; n0[q] = (tile / nkt) * 64; k0[q] = (tile % nkt) * 64; }
    float v[2][8];
#pragma unroll
    for (int q = 0; q < 2; ++q)
#pragma unroll
        for (int it = 0; it < 8; ++it) {
            const int idx = tid + it * 512, kk = idx >> 6, j = idx & 63;
            v[q][it] = W[(size_t)(k0[q] + kk) * N + src_col(kind, n0[q] + j)];
        }
#pragma unroll
    for (int q = 0; q < 2; ++q)
#pragma unroll
        for (int it = 0; it < 8; ++it) {
            const int idx = tid + it * 512, kk = idx >> 6, j = idx & 63;
            float x = v[q][it];
            if (kscale) x *= kscale[k0[q] + kk];
            L[q * 4160 + kk * 65 + j] = x;
        }
    __syncthreads();
#pragma unroll
    for (int q = 0; q < 2; ++q)
#pragma unroll
        for (int it = 0; it < 4; ++it) {
            const int idx = tid + it * 512, j = idx >> 5, kp = idx & 31;
            *(unsigned*)(WT + (size_t)(n0[q] + j) * K + k0[q] + 2 * kp) = cvt_pk_bf16(L[q * 4160 + (2 * kp) * 65 + j], L[q * 4160 + (2 * kp + 1) * 65 + j]);
        }
    __syncthreads();
}

__device__ __forceinline__ void phase0(const Args& a, LAS unsigned char* lds) {
    LAS float* L = (LAS float*)lds;
    const int tid = threadIdx.x, wave = tid >> 6, lane = tid & 63;
    constexpr int T_IN = 88 * 16 / 2, T_GLU = 32 * 8 / 2, T_RET = 128, T_OUT = 128, T_FFI = 88 * 16 / 2, T_FFO = 16 * 44 / 2;
    constexpr int NW = 128 + T_IN + T_GLU + T_RET + T_OUT, NRM = RPAD / 32;
    unsigned* qctr = (unsigned*)(a.ws + OFF_BAR) + 4096;
    LAS int* qslot = (LAS int*)(lds + 131072 + 512);
    for (;;) {
        __syncthreads();
        if (tid == 0) *qslot = (int)__hip_atomic_fetch_add(qctr, 1u, __ATOMIC_RELAXED, __HIP_MEMORY_SCOPE_AGENT);
        __syncthreads();
        const int w = *qslot;
        if (w >= NW + NRM) break;
        int r = w;
        if (r < 128) { p0_s5gen(a, L, r >> 2, r & 3); continue; } r -= 128;
        if (r < T_IN) { p0_wtile(a.in[4], 1024, INW, (bf16_t*)(a.ws + OFF_WIN), 1, nullptr, r, L); continue; } r -= T_IN;
        if (r < T_GLU) { p0_wtile(a.in[13], 512, 2048, (bf16_t*)(a.ws + OFF_WGLU), 2, nullptr, r, L); continue; } r -= T_GLU;
        if (r < T_RET) { p0_wtile(a.in[15], 1024, 1024, (bf16_t*)(a.ws + OFF_WRET), 0, nullptr, r, L); continue; } r -= T_RET;
        if (r < T_OUT) { p0_wtile(a.in[16], 1024, 1024, (bf16_t*)(a.ws + OFF_WOUT), 0, nullptr, r, L); continue; } r -= T_OUT;

        const int rowb = r * 32 + wave * 4;
        const float* xr[4]; f32x4 v[4][4];
#pragma unroll
        for (int q = 0; q < 4; ++q) {
            const int row = rowb + q;
            xr[q] = row < NPR ? a.in[0] + (size_t)row * 1024 : (row < NREAL ? a.in[1] + (size_t)(row - NPR) * 1024 : a.in[2] + (size_t)((row - NREAL) & 15) * 1024);
#pragma unroll
            for (int j = 0; j < 4; ++j) v[q][j] = (row < NVALID) ? *(const f32x4*)(xr[q] + (j * 64 + lane) * 4) : (f32x4){0.f, 0.f, 0.f, 0.f};
        }
        f32x4 gg[4];
#pragma unroll
        for (int j = 0; j < 4; ++j) gg[j] = *(const f32x4*)(a.in[3] + (j * 64 + lane) * 4);
#pragma unroll
        for (int q = 0; q < 4; ++q) {
            float sq = 0.f;
#pragma unroll
            for (int j = 0; j < 4; ++j) sq += (v[q][j][0] * v[q][j][0] + v[q][j][1] * v[q][j][1]) + (v[q][j][2] * v[q][j][2] + v[q][j][3] * v[q][j][3]);
            const float rstd = rsqrtf(wave_sum(sq) * (1.0f / 1024.0f) + EPS);
            bf16_t* orow = (bf16_t*)(a.ws + OFF_N1) + (size_t)(rowb + q) * 1024;
#pragma unroll
            for (int j = 0; j < 4; ++j) {
                u32x2 o; o.x = cvt_pk_bf16(v[q][j][0] * rstd * gg[j][0], v[q][j][1] * rstd * gg[j][1]); o.y = cvt_pk_bf16(v[q][j][2] * rstd * gg[j][2], v[q][j][3] * rstd * gg[j][3]);
                *(u32x2*)(orow + (j * 64 + lane) * 4) = o;
            }
        }
    }
}

__device__ __forceinline__ void s5_scan(const Args& a) {
    const float* attab = (const float*)(a.ws + OFF_AT);
    const float* sloc = (const float*)(a.ws + OFF_SLOC);
    bf16_t* u5 = (bf16_t*)(a.ws + OFF_U5);
    for (int id = blockIdx.x * 512 + threadIdx.x; id < 24 * 32 * 2 * 64; id += gridDim.x * 512) {
        const int p = id & 63, dir = (id >> 6) & 1, g = (id >> 7) & 31, b = id >> 12;
        const float atr = attab[((dir * 32 + g) * 64 + p) * 2], ati = attab[((dir * 32 + g) * 64 + p) * 2 + 1];
        const int nck = b < 16 ? 128 : 64, base = b < 16 ? b * 128 : 2048 + (b - 16) * 64, mitem = IT_REAL + b;
        const float* sl = sloc + (size_t)g * IT_PAD * 256 + dir * 128 + p;
        bf16_t* ub = u5 + (size_t)g * IT_PAD * LDA5 + 512 + dir * 128 + p;
        float sr = 0.f, si = 0.f;
        if (dir == 0) {
            ub[(size_t)mitem * LDA5] = 0; ub[(size_t)mitem * LDA5 + 64] = 0;
            sr = sl[(size_t)mitem * 256]; si = sl[(size_t)mitem * 256 + 64];
            for (int c0 = 0; c0 < nck; c0 += 16) {
                float lr[16], li[16];
#pragma unroll
                for (int j = 0; j < 16; ++j) { lr[j] = sl[(size_t)(base + c0 + j) * 256]; li[j] = sl[(size_t)(base + c0 + j) * 256 + 64]; }
#pragma unroll
                for (int j = 0; j < 16; ++j) {
                    const size_t it = (size_t)(base + c0 + j);
                    ub[it * LDA5] = f2bf(sr); ub[it * LDA5 + 64] = f2bf(si);
                    const float nr = atr * sr - ati * si + lr[j], ni = atr * si + ati * sr + li[j];
                    sr = nr; si = ni;
                }
            }
        } else {
            for (int c0 = nck - 16; c0 >= 0; c0 -= 16) {
                float lr[16], li[16];
#pragma unroll
                for (int j = 0; j < 16; ++j) { lr[j] = sl[(size_t)(base + c0 + j) * 256]; li[j] = sl[(size_t)(base + c0 + j) * 256 + 64]; }
#pragma unroll
                for (int j = 15; j >= 0; --j) {
                    const size_t it = (size_t)(base + c0 + j);
                    ub[it * LDA5] = f2bf(sr); ub[it * LDA5 + 64] = f2bf(si);
                    const float nr = atr * sr - ati * si + lr[j], ni = atr * si + ati * sr + li[j];
                    sr = nr; si = ni;
                }
            }
            ub[(size_t)mitem * LDA5] = f2bf(sr); ub[(size_t)mitem * LDA5 + 64] = f2bf(si);
        }
    }
}

constexpr int LDR = 136;
__device__ __forceinline__ float bf2f(bf16_t h) { return __uint_as_float(((unsigned)h) << 16); }

__device__ __forceinline__ void tr_store_pair(LAS bf16_t* img, int f0, int s2, u32x4 r0, u32x4 r1) {
    LAS unsigned* p = (LAS unsigned*)(img + f0 * LDR + s2);
    p[0 * (LDR / 2)] = (r0.x & 0xFFFFu) | (r1.x << 16); p[1 * (LDR / 2)] = (r0.x >> 16) | (r1.x & 0xFFFF0000u);
    p[2 * (LDR / 2)] = (r0.y & 0xFFFFu) | (r1.y << 16); p[3 * (LDR / 2)] = (r0.y >> 16) | (r1.y & 0xFFFF0000u);
    p[4 * (LDR / 2)] = (r0.z & 0xFFFFu) | (r1.z << 16); p[5 * (LDR / 2)] = (r0.z >> 16) | (r1.z & 0xFFFF0000u);
    p[6 * (LDR / 2)] = (r0.w & 0xFFFFu) | (r1.w << 16); p[7 * (LDR / 2)] = (r0.w >> 16) | (r1.w & 0xFFFF0000u);
}
__device__ __forceinline__ void tr_store_pair_scaled(LAS bf16_t* img, int f0, int s2, u32x4 r0, u32x4 r1, float w0, float w1) {
    LAS unsigned* p = (LAS unsigned*)(img + f0 * LDR + s2);
    p[0 * (LDR / 2)] = cvt_pk_bf16(bflo(r0.x) * w0, bflo(r1.x) * w1); p[1 * (LDR / 2)] = cvt_pk_bf16(bfhi(r0.x) * w0, bfhi(r1.x) * w1);
    p[2 * (LDR / 2)] = cvt_pk_bf16(bflo(r0.y) * w0, bflo(r1.y) * w1); p[3 * (LDR / 2)] = cvt_pk_bf16(bfhi(r0.y) * w0, bfhi(r1.y) * w1);
    p[4 * (LDR / 2)] = cvt_pk_bf16(bflo(r0.z) * w0, bflo(r1.z) * w1); p[5 * (LDR / 2)] = cvt_pk_bf16(bfhi(r0.z) * w0, bfhi(r1.z) * w1);
    p[6 * (LDR / 2)] = cvt_pk_bf16(bflo(r0.w) * w0, bflo(r1.w) * w1); p[7 * (LDR / 2)] = cvt_pk_bf16(bfhi(r0.w) * w0, bfhi(r1.w) * w1);
}

#define LDS_BARRIER() do { asm volatile("s_waitcnt lgkmcnt(0)" ::: "memory"); __builtin_amdgcn_s_barrier(); asm volatile("" ::: "memory"); } while (0)
__device__ __forceinline__ void ret_pass_a(const Args& a, LAS unsigned char* lds) {
    LAS bf16_t* KT = (LAS bf16_t*)lds;
    LAS bf16_t* VT = KT + 128 * LDR;
    const int tid0 = threadIdx.x;
    const bf16_t* kb = (const bf16_t*)(a.ws + OFF_K); const bf16_t* vb = (const bf16_t*)(a.ws + OFF_V);
    bf16_t* stb = (bf16_t*)(a.ws + OFF_ST);
    for (int item = blockIdx.x; item < 192; item += gridDim.x) {
        int tid = tid0; asm volatile("" : "+v"(tid));
        const int w = tid >> 6, lane = tid & 63, fr = lane & 15, fq = lane >> 4;
        int b, h, dir;
        if (item < 128) { b = item >> 3; h = (item >> 1) & 3; dir = item & 1; } else { const int j = item - 128; b = 16 + (j >> 3); h = (j >> 1) & 3; dir = j & 1; }
        const int NC = b < 16 ? 32 : 16, rbase = b < 16 ? b * 4096 : NPR + (b - 16) * 2048, ebase = b < 16 ? b * 33 : 528 + (b - 16) * 17;
        const float lg = logsigf_(a.in[14][dir * 4 + h]);
        const float carry = __expf(lg * 128.f);
        const int s2 = 2 * (8 * w + (lane & 7)), pg = lane >> 3;
        const float wk0 = dir == 0 ? __expf(lg * (float)(127 - s2)) : __expf(lg * (float)s2);
        const float wk1 = dir == 0 ? __expf(lg * (float)(126 - s2)) : __expf(lg * (float)(s2 + 1));
        f32x4 acc[2][8];
#pragma unroll
        for (int et = 0; et < 2; ++et)
#pragma unroll
            for (int dtl = 0; dtl < 8; ++dtl) acc[et][dtl] = (f32x4){0.f, 0.f, 0.f, 0.f};
        const int nsteps = dir == 0 ? NC : NC;
        u32x4 rk[2][2], rv[4][2];
        auto load_chunk = [&](int n) {
            int row0; bool valid = true;
            if (n == 0) { valid = s2 >= 112; row0 = NREAL + b * 16 + (s2 - 112); } else row0 = rbase + (n - 1) * 128 + s2;
#pragma unroll
            for (int it = 0; it < 2; ++it)
#pragma unroll
                for (int r = 0; r < 2; ++r) {
                    rk[it][r] = (u32x4){0u, 0u, 0u, 0u};
                    if (valid) rk[it][r] = *(const u32x4*)(kb + (size_t)(row0 + r) * 512 + h * 128 + (pg + 8 * it) * 8);
                }
#pragma unroll
            for (int it = 0; it < 4; ++it)
#pragma unroll
                for (int r = 0; r < 2; ++r) {
                    rv[it][r] = (u32x4){0u, 0u, 0u, 0u};
                    if (valid) rv[it][r] = *(const u32x4*)(vb + (size_t)(row0 + r) * 1024 + h * 256 + (pg + 8 * it) * 8);
                }
        };
        load_chunk(dir == 0 ? 0 : NC);
        for (int step = 0; step < nsteps; ++step) {
            const int n = dir == 0 ? step : NC - step;
            {
                bf16_t* spn = stb + ((size_t)((ebase + n) * 4 + h) * 2 + dir) * 32768;
#pragma unroll
                for (int et = 0; et < 2; ++et)
#pragma unroll
                    for (int dtl = 0; dtl < 8; ++dtl) {
                        u32x2 o; o.x = cvt_pk_bf16(acc[et][dtl][0], acc[et][dtl][1]); o.y = cvt_pk_bf16(acc[et][dtl][2], acc[et][dtl][3]);
                        *(u32x2*)(spn + (size_t)(32 * w + 16 * et + fr) * 128 + 16 * dtl + 4 * fq) = o;
                    }
            }
            LDS_BARRIER();
#pragma unroll
            for (int it = 0; it < 2; ++it) tr_store_pair_scaled(KT, (pg + 8 * it) * 8, s2, rk[it][0], rk[it][1], wk0, wk1);
#pragma unroll
            for (int it = 0; it < 4; ++it) tr_store_pair(VT, (pg + 8 * it) * 8, s2, rv[it][0], rv[it][1]);
            if (step + 1 < nsteps) load_chunk(dir == 0 ? step + 1 : NC - step - 1);
            LDS_BARRIER();
#pragma unroll
            for (int et = 0; et < 2; ++et)
#pragma unroll
                for (int dtl = 0; dtl < 8; ++dtl) acc[et][dtl] = acc[et][dtl] * carry;
#pragma unroll
            for (int ks = 0; ks < 4; ++ks) {
                bf16x8 vf[2];
#pragma unroll
                for (int et = 0; et < 2; ++et) vf[et] = *(const LAS bf16x8*)(VT + (32 * w + 16 * et + fr) * LDR + 32 * ks + 8 * fq);
#pragma unroll
                for (int dtl = 0; dtl < 8; ++dtl) {
                    const bf16x8 kf = *(const LAS bf16x8*)(KT + (16 * dtl + fr) * LDR + 32 * ks + 8 * fq);
#pragma unroll
                    for (int et = 0; et < 2; ++et) acc[et][dtl] = __builtin_amdgcn_mfma_f32_16x16x32_bf16(kf, vf[et], acc[et][dtl], 0, 0, 0);
                }
            }
        }
        if (dir == 0) {
            bf16_t* spn = stb + ((size_t)((ebase + NC) * 4 + h) * 2 + dir) * 32768;
#pragma unroll
            for (int et = 0; et < 2; ++et)
#pragma unroll
                for (int dtl = 0; dtl < 8; ++dtl) {
                    u32x2 o; o.x = cvt_pk_bf16(acc[et][dtl][0], acc[et][dtl][1]); o.y = cvt_pk_bf16(acc[et][dtl][2], acc[et][dtl][3]);
                    *(u32x2*)(spn + (size_t)(32 * w + 16 * et + fr) * 128 + 16 * dtl + 4 * fq) = o;
                }
        }
        LDS_BARRIER();
    }
}

__device__ __forceinline__ void ret_pass_b(const Args& a, LAS unsigned char* lds) {
    LAS bf16_t* KL = (LAS bf16_t*)lds;
    LAS bf16_t* BG = KL + 128 * LDR;
    const int tid0 = threadIdx.x;
    const bf16_t* qb = (const bf16_t*)(a.ws + OFF_Q); const bf16_t* kb = (const bf16_t*)(a.ws + OFF_K); const bf16_t* vb = (const bf16_t*)(a.ws + OFF_V);
    const bf16_t* stb = (const bf16_t*)(a.ws + OFF_ST);
    bf16_t* sg = (bf16_t*)a.out;
    u32x4 rk[4], rb[8]; bf16x8 qf[4];
    auto item_info = [&](int item, int& r0, int& h, const bf16_t*& sfp) {
        const int rc = item >> 2; h = item & 3;
        int b, n; if (rc < 512) { b = rc >> 5; n = (rc & 31) + 1; } else { b = 16 + ((rc - 512) >> 4); n = ((rc - 512) & 15) + 1; }
        const int ebase = b < 16 ? b * 33 : 528 + (b - 16) * 17; r0 = rc * 128;
        sfp = stb + ((size_t)((ebase + n) * 4 + h) * 2 + 0) * 32768;
    };
    auto load_item_head = [&](int item, int tid) {
        int r0, h; const bf16_t* sfp; item_info(item, r0, h, sfp);
#pragma unroll
        for (int it = 0; it < 8; ++it) { const int idx = tid + it * 512, e = idx >> 4, pc = idx & 15; rb[it] = *(const u32x4*)(sfp + (size_t)e * 128 + pc * 8); }
    };
    auto load_item_kq = [&](int item, int tid) {
        int r0, h; const bf16_t* sfp; item_info(item, r0, h, sfp);
        const int w = tid >> 6, lane = tid & 63, fr = lane & 15, fq = lane >> 4;
#pragma unroll
        for (int it = 0; it < 4; ++it) { const int idx = tid + it * 512, s = idx >> 4, pc = idx & 15; rk[it] = *(const u32x4*)(kb + (size_t)(r0 + s) * 512 + h * 128 + pc * 8); }
#pragma unroll
        for (int ks = 0; ks < 4; ++ks) qf[ks] = *(const bf16x8*)(qb + (size_t)(r0 + 16 * w + fr) * 512 + h * 128 + 32 * ks + 8 * fq);
    };
    if ((int)blockIdx.x < 2560) { load_item_head(blockIdx.x, tid0); load_item_kq(blockIdx.x, tid0); }
    for (int item = blockIdx.x; item < 2560; item += gridDim.x) {
        int tid = tid0; asm volatile("" : "+v"(tid));
        const int w = tid >> 6, lane = tid & 63, fr = lane & 15, fq = lane >> 4;
        int r0, h; const bf16_t* sfp; item_info(item, r0, h, sfp);
        const bf16_t* sbp = sfp + 32768;
        const float lgf = logsigf_(a.in[14][h]), lgb = logsigf_(a.in[14][4 + h]);
        const int crow = 16 * w + fr;
        LDS_BARRIER();
#pragma unroll
        for (int it = 0; it < 4; ++it) { const int idx = tid + it * 512, s = idx >> 4, pc = idx & 15; *(LAS u32x4*)(KL + s * LDR + pc * 8) = rk[it]; }
#pragma unroll
        for (int it = 0; it < 8; ++it) { const int idx = tid + it * 512, e = idx >> 4, pc = idx & 15; *(LAS u32x4*)(BG + e * LDR + pc * 8) = rb[it]; }
#pragma unroll
        for (int it = 0; it < 8; ++it) { const int idx = tid + it * 512, e = idx >> 4, pc = idx & 15; rb[it] = *(const u32x4*)(sbp + (size_t)e * 128 + pc * 8); }
        LDS_BARRIER();
        f32x4 sacc[8];
#pragma unroll
        for (int st = 0; st < 8; ++st) sacc[st] = (f32x4){0.f, 0.f, 0.f, 0.f};
#pragma unroll
        for (int ks = 0; ks < 4; ++ks)
#pragma unroll
            for (int st = 0; st < 8; ++st) {
                const bf16x8 kf = *(const LAS bf16x8*)(KL + (16 * st + fr) * LDR + 32 * ks + 8 * fq);
                sacc[st] = __builtin_amdgcn_mfma_f32_16x16x32_bf16(kf, qf[ks], sacc[st], 0, 0, 0);
                if (st == 7) __builtin_amdgcn_sched_barrier(0);
            }
        bf16x8 pf[4];
#pragma unroll
        for (int t = 0; t < 4; ++t) {
            float pv[8];
#pragma unroll
            for (int hh = 0; hh < 2; ++hh)
#pragma unroll
                for (int j = 0; j < 4; ++j) {
                    const int spp = 16 * (2 * t + hh) + 4 * fq + j, diff = crow - spp;
                    const float dec = diff >= 0 ? __expf(lgf * (float)diff) : __expf(-lgb * (float)diff);
                    pv[hh * 4 + j] = sacc[2 * t + hh][j] * dec;
                }
            u32x4 pw; pw.x = cvt_pk_bf16(pv[0], pv[1]); pw.y = cvt_pk_bf16(pv[2], pv[3]); pw.z = cvt_pk_bf16(pv[4], pv[5]); pw.w = cvt_pk_bf16(pv[6], pv[7]);
            pf[t] = __builtin_bit_cast(bf16x8, pw);
        }
        f32x4 o[16];
#pragma unroll
        for (int et = 0; et < 16; ++et) o[et] = (f32x4){0.f, 0.f, 0.f, 0.f};
#pragma unroll
        for (int ks = 0; ks < 4; ++ks)
#pragma unroll
            for (int et = 0; et < 16; ++et) {
                const bf16x8 sf = *(const LAS bf16x8*)(BG + (16 * et + fr) * LDR + 32 * ks + 8 * fq);
                o[et] = __builtin_amdgcn_mfma_f32_16x16x32_bf16(sf, qf[ks], o[et], 0, 0, 0);
                if ((et & 7) == 7) __builtin_amdgcn_sched_barrier(0);
            }
        const float wqf = __expf(lgf * (float)(crow + 1)), wqb = __expf(lgb * (float)(128 - crow));
        const float ratio = wqf / wqb;
#pragma unroll
        for (int et = 0; et < 16; ++et) o[et] = o[et] * ratio;
        LDS_BARRIER();
#pragma unroll
        for (int it = 0; it < 8; ++it) { const int idx = tid + it * 512, e = idx >> 4, pc = idx & 15; *(LAS u32x4*)(BG + e * LDR + pc * 8) = rb[it]; }
        {
            const int s2 = 2 * (8 * w + (lane & 7));
#pragma unroll
            for (int it = 0; it < 4; ++it)
#pragma unroll
                for (int r = 0; r < 2; ++r) rb[it * 2 + r] = *(const u32x4*)(vb + (size_t)(r0 + s2 + r) * 1024 + h * 256 + ((lane >> 3) + 8 * it) * 8);
        }
        LDS_BARRIER();
#pragma unroll
        for (int ks = 0; ks < 4; ++ks)
#pragma unroll
            for (int et = 0; et < 16; ++et) {
                const bf16x8 sf = *(const LAS bf16x8*)(BG + (16 * et + fr) * LDR + 32 * ks + 8 * fq);
                o[et] = __builtin_amdgcn_mfma_f32_16x16x32_bf16(sf, qf[ks], o[et], 0, 0, 0);
                if ((et & 7) == 7) __builtin_amdgcn_sched_barrier(0);
            }
#pragma unroll
        for (int et = 0; et < 16; ++et) o[et] = o[et] * wqb;
        LDS_BARRIER();
#pragma unroll
        for (int it = 0; it < 4; ++it) tr_store_pair(BG, ((lane >> 3) + 8 * it) * 8, 2 * (8 * w + (lane & 7)), rb[it * 2], rb[it * 2 + 1]);
        if (item + (int)gridDim.x < 2560) load_item_head(item + gridDim.x, tid);
        LDS_BARRIER();
#pragma unroll
        for (int t = 0; t < 4; ++t)
#pragma unroll
            for (int et = 0; et < 16; ++et) {
                const u32x2 lo = *(const LAS u32x2*)(BG + (16 * et + fr) * LDR + 32 * t + 4 * fq);
                const u32x2 hi = *(const LAS u32x2*)(BG + (16 * et + fr) * LDR + 32 * t + 16 + 4 * fq);
                const u32x4 vw = (u32x4){lo.x, lo.y, hi.x, hi.y};
                o[et] = __builtin_amdgcn_mfma_f32_16x16x32_bf16(__builtin_bit_cast(bf16x8, vw), pf[t], o[et], 0, 0, 0);
                if ((et & 7) == 7) __builtin_amdgcn_sched_barrier(0);
            }
        float ss = 0.f;
#pragma unroll
        for (int et = 0; et < 16; ++et) ss += (o[et][0] * o[et][0] + o[et][1] * o[et][1]) + (o[et][2] * o[et][2] + o[et][3] * o[et][3]);
        ss += __shfl_xor(ss, 16); ss += __shfl_xor(ss, 32);
        const float rn = rsqrtf(ss * (1.0f / 256.0f) + EPS);
        bf16_t* gp = sg + (size_t)(r0 + crow) * 1024 + h * 256 + 4 * fq;
        u32x2 gwv[16];
#pragma unroll
        for (int et = 0; et < 16; ++et) gwv[et] = *(const u32x2*)(gp + 16 * et);
        if (item + (int)gridDim.x < 2560) load_item_kq(item + gridDim.x, tid);
#pragma unroll
        for (int et = 0; et < 16; ++et) {
            const u32x2 gw = gwv[et];
            u32x2 ow; ow.x = cvt_pk_bf16(o[et][0] * rn * bflo(gw.x), o[et][1] * rn * bfhi(gw.x)); ow.y = cvt_pk_bf16(o[et][2] * rn * bflo(gw.y), o[et][3] * rn * bfhi(gw.y));
            *(u32x2*)(gp + 16 * et) = ow;
        }
    }
    LDS_BARRIER();
}

__device__ __forceinline__ void final_norm(const Args& a) {
    const int wave = threadIdx.x >> 6, lane = threadIdx.x & 63;
    const float* ssq = (const float*)(a.ws + OFF_SSQ2);
    f32x4 gg[4];
#pragma unroll
    for (int j = 0; j < 4; ++j) gg[j] = *(const f32x4*)(a.in[20] + (j * 64 + lane) * 4);
    for (int rowb = (blockIdx.x * 8 + wave) * 4; rowb < NREAL; rowb += gridDim.x * 32) {
        float part[4]; u32x2 w[4][4];
#pragma unroll
        for (int q = 0; q < 4; ++q) {
            part[q] = lane < 16 ? ssq[(size_t)(rowb + q) * 16 + lane] : 0.f;
            const bf16_t* hrow = (const bf16_t*)(a.ws + OFF_H1B) + (size_t)(rowb + q) * 1024;
#pragma unroll
            for (int j = 0; j < 4; ++j) w[q][j] = *(const u32x2*)(hrow + (j * 64 + lane) * 4);
        }
#pragma unroll
        for (int q = 0; q < 4; ++q) {
            const float rstd = rsqrtf(wave_sum(part[q]) * (1.0f / 1024.0f) + EPS);
            float* orow = a.out + (size_t)(rowb + q) * 1024;
#pragma unroll
            for (int j = 0; j < 4; ++j) {
                f32x4 v;
                v[0] = bflo(w[q][j].x) * rstd * gg[j][0]; v[1] = bfhi(w[q][j].x) * rstd * gg[j][1]; v[2] = bflo(w[q][j].y) * rstd * gg[j][2]; v[3] = bfhi(w[q][j].y) * rstd * gg[j][3];
                *(f32x4*)(orow + (j * 64 + lane) * 4) = v;
            }
        }
    }
}

template <int ph>
__device__ __forceinline__ void run_phase(const Args& a, LAS unsigned char* lds) {
    unsigned char* ws = a.ws;
    bf16_t* dob = (bf16_t*)a.out;
    bf16_t* sgp = dob; bf16_t* gap = dob + (size_t)NREAL * 1024;
#ifdef ONLY_PH
    if (ph != ONLY_PH) return;
#endif
    switch (ph) {
    case 0: phase0(a, lds); break;
    case 1: {
        pg8::Gemm g{(const bf16_t*)(ws + OFF_N1), (const bf16_t*)(ws + OFF_WIN), 1024, 1024, 1024, RPAD / 256, INW / 256, 1, 0, 0, STG};
        EpiProj E{(bf16_t*)(ws + OFF_U5), (bf16_t*)(ws + OFF_Q), (bf16_t*)(ws + OFF_K), (bf16_t*)(ws + OFF_V), sgp, gap, (bf16_t*)(ws + OFF_GB), (const LAS float*)(lds + 131072)};
        pg8::gemm_phase(lds, g, E);
        constexpr int T_FFI = 88 * 16 / 2, T_FFO = 16 * 44 / 2, FIRST = (RPAD / 256) * (INW / 256) - 27 * 256;
        const int nblk = (int)gridDim.x, first = nblk == 256 ? FIRST : 0;
        if ((int)blockIdx.x >= first) {
            __syncthreads();
            for (int r = (int)blockIdx.x - first; r < T_FFI + T_FFO; r += nblk - first) {
                if (r < T_FFI) p0_wtile(a.in[18], 1024, INW, (bf16_t*)(ws + OFF_WFFI), 3, a.in[17], r, (LAS float*)lds);
                else p0_wtile(a.in[19], DFF, 1024, (bf16_t*)(ws + OFF_WFFO), 0, nullptr, r - T_FFI, (LAS float*)lds);
            }
        }
    } break;
    case 2: {
        pg8::Gemm g{(const bf16_t*)(ws + OFF_U5), (const bf16_t*)(ws + OFF_BTS), LDA5, 512, 512, IT_PAD / 256, 1, 32, (size_t)IT_PAD * LDA5, (size_t)256 * 512, 0};
        EpiSloc E{(float*)(ws + OFF_SLOC)};
        pg8::gemm_phase(lds, g, E);
    } break;
    case 3: s5_scan(a); break;
    case 4: {
        pg8::Gemm g{(const bf16_t*)(ws + OFF_U5), (const bf16_t*)(ws + OFF_BTY), LDA5, 768, 768, IT_PAD / 256, 2, 32, (size_t)IT_PAD * LDA5, (size_t)512 * 768, 0};
        EpiY E{(bf16_t*)(ws + OFF_YSSM)};
        pg8::gemm_phase(lds, g, E);
    } break;
    case 5: {
        ret_pass_a(a, lds);
        const int bx = (int)blockIdx.x, sub = bx >= 192 ? bx - 192 : (bx >= 128 ? bx - 128 : 0);
        const int u0 = bx >= 192 ? 0 : (bx >= 128 ? GLU_SPLIT : GLU_SPLIT2), u1 = bx >= 192 ? GLU_SPLIT : GLU_SPLIT2;
        pg8::Gemm g{(const bf16_t*)(ws + OFF_YSSM), (const bf16_t*)(ws + OFF_WGLU), 512, 512, 512, NREAL / 256, 8, 1, 0, 0, STG, 64, sub, u0, u1};
        EpiGlu E{gap};
        pg8::gemm_phase(lds, g, E);
    } break;
    case 6: {
        pg8::Gemm g{(const bf16_t*)(ws + OFF_YSSM), (const bf16_t*)(ws + OFF_WGLU), 512, 512, 512, NREAL / 256, 8, 1, 0, 0, STG, (int)gridDim.x, (int)blockIdx.x, GLU_SPLIT2, 2560};
        EpiGlu E{gap};
        pg8::gemm_phase(lds, g, E);
    } break;
    case 7: ret_pass_b(a, lds); break;
    case 8: {
        pg8::Gemm g{sgp, (const bf16_t*)(ws + OFF_WRET), 1024, 1024, 1024, NREAL / 256, 4, 1, 0, 0, STG};
        EpiRet E{gap, (const bf16_t*)(ws + OFF_GB), (bf16_t*)(ws + OFF_MIXED)};
        pg8::gemm_phase(lds, g, E);
    } break;
    case 9: {
        pg8::Gemm g{(const bf16_t*)(ws + OFF_MIXED), (const bf16_t*)(ws + OFF_WOUT), 1024, 1024, 1024, NREAL / 256, 4, 1, 0, 0, STG};
        EpiRes<0> E{a.in[0], a.in[1], (bf16_t*)(ws + OFF_H1B), (float*)(ws + OFF_SSQ1)};
        pg8::gemm_phase(lds, g, E);
    } break;
    case 10: {
        pg8::Gemm g{(const bf16_t*)(ws + OFF_H1B), (const bf16_t*)(ws + OFF_WFFI), 1024, 1024, 1024, NREAL / 256, INW / 256, 1, 0, 0, STG};
        EpiFfi E{(const float*)(ws + OFF_SSQ1), (bf16_t*)(ws + OFF_ACT)};
        pg8::gemm_phase(lds, g, E);
    } break;
    case 11: {
        pg8::Gemm g{(const bf16_t*)(ws + OFF_ACT), (const bf16_t*)(ws + OFF_WFFO), DFF, DFF, DFF, NREAL / 256, 4, 1, 0, 0, STG};
        EpiRes<1> E{nullptr, nullptr, (bf16_t*)(ws + OFF_H1B), (float*)(ws + OFF_SSQ2)};
        pg8::gemm_phase(lds, g, E);
    } break;
    case 12: final_norm(a); break;
    default: break;
    }
}

#define XB_TMO      128
#define XB_XCNT(j)  (256  + 64 * (j))
#define XB_XSUB(j)  (1280 + 64 * (j))
#define XB_XGEN(j)  (2304 + 64 * (j))
#define XB_TOP      3328
#define XB_TOPGEN   3392
#define XCD_BAR_WORDS 3456
#define XB_SPIN_CAP (1u << 18)

__device__ __forceinline__ unsigned xb_ld(unsigned* p)              { return __hip_atomic_load(p, __ATOMIC_RELAXED, __HIP_MEMORY_SCOPE_AGENT); }
__device__ __forceinline__ unsigned xb_add(unsigned* p, unsigned v) { return __hip_atomic_fetch_add(p, v, __ATOMIC_RELAXED, __HIP_MEMORY_SCOPE_AGENT); }
__device__ __forceinline__ unsigned xb_xcc_id() { return (unsigned)__builtin_amdgcn_s_getreg((3 << 11) | 20) & 0xFu; }
#define XB_SPIN(cond, bar) do { unsigned _sp = 0; while (cond) { __builtin_amdgcn_s_sleep(1); \
    if ((++_sp & 255u) == 0u) { if (xb_ld(&(bar)[XB_TMO])) break; if (_sp > XB_SPIN_CAP) { atomicAdd(&(bar)[XB_TMO], 1u); break; } } } } while (0)

struct XcdBarrier {
    unsigned* bar; unsigned x;
    volatile LAS unsigned* st;
};

__device__ __forceinline__ XcdBarrier xcd_barrier_post(unsigned* bar, volatile LAS unsigned* st) {
    XcdBarrier b; b.bar = bar; b.x = xb_xcc_id(); b.st = st;
    if (threadIdx.x == 0) (void)xb_add(&bar[XB_XCNT(b.x)], 1u);
    return b;
}
__device__ __forceinline__ void xcd_barrier_complete(unsigned* bar, unsigned x, unsigned& nloc, unsigned& nx) {
    const unsigned G = gridDim.x * gridDim.y * gridDim.z;
    unsigned sum, cnt, mine, sp = 0u;
    for (;;) {
        sum = 0u; cnt = 0u; mine = 0u;
#pragma unroll
        for (unsigned j = 0; j < 16; ++j) { const unsigned c = xb_ld(&bar[XB_XCNT(j)]); sum += c; cnt += (c > 0u) ? 1u : 0u; mine = (j == x) ? c : mine; }
        if (sum == G) break;
        __builtin_amdgcn_s_sleep(1);
        if ((++sp & 255u) == 0u) { if (xb_ld(&bar[XB_TMO])) break; if (sp > XB_SPIN_CAP) { atomicAdd(&bar[XB_TMO], 1u); break; } }
    }
    nloc = mine > 0u ? mine : 1u; nx = cnt > 0u ? cnt : 1u;
}

__device__ __forceinline__ void xcd_barrier(const XcdBarrier& b) {
    asm volatile("s_waitcnt vmcnt(0)" ::: "memory");
    __syncthreads();
    if (threadIdx.x == 0) {
        unsigned* bar = b.bar;
        __builtin_amdgcn_s_waitcnt(0);
        unsigned nloc = b.st[0], nx = b.st[1];
        if (nloc == 0u) { xcd_barrier_complete(bar, b.x, nloc, nx); b.st[0] = nloc; b.st[1] = nx; }
        const unsigned old = xb_add(&bar[XB_XSUB(b.x)], 1u);
        const unsigned gen = old / nloc;
        if (old + 1u == (gen + 1u) * nloc) {
            __builtin_amdgcn_fence(__ATOMIC_RELEASE, "agent");
            asm volatile("s_waitcnt vmcnt(0)" ::: "memory");
            const unsigned og = xb_add(&bar[XB_TOP], 1u);
            const unsigned tg = og / nx;
            if (og + 1u == (tg + 1u) * nx) xb_add(&bar[XB_TOPGEN], 1u);
            else XB_SPIN(xb_ld(&bar[XB_TOPGEN]) == tg, bar);
            __builtin_amdgcn_fence(__ATOMIC_ACQUIRE, "agent");
            xb_add(&bar[XB_XGEN(b.x)], 1u);
            asm volatile("s_waitcnt vmcnt(0)" ::: "memory");
        } else {
            XB_SPIN(xb_ld(&bar[XB_XGEN(b.x)]) == gen, bar);
            __builtin_amdgcn_fence(__ATOMIC_ACQUIRE, "agent");
            asm volatile("s_waitcnt vmcnt(0)" ::: "memory");
        }
    }
    __syncthreads();
}


__device__ __forceinline__ void grid_barrier(unsigned* ctr, unsigned target) {
    asm volatile("s_waitcnt vmcnt(0) lgkmcnt(0)" ::: "memory");
    __syncthreads();
    if (threadIdx.x == 0) {
        __builtin_amdgcn_fence(__ATOMIC_RELEASE, "agent");
        asm volatile("s_waitcnt vmcnt(0)" ::: "memory");
        __hip_atomic_fetch_add(ctr, 1u, __ATOMIC_RELAXED, __HIP_MEMORY_SCOPE_AGENT);
        unsigned spins = 0;
        while (__hip_atomic_load(ctr, __ATOMIC_RELAXED, __HIP_MEMORY_SCOPE_AGENT) < target && ++spins < (1u << 24)) __builtin_amdgcn_s_sleep(2);
        __builtin_amdgcn_fence(__ATOMIC_ACQUIRE, "agent");
        asm volatile("s_waitcnt vmcnt(0)" ::: "memory");
    }
    __syncthreads();
}

template <bool COOP>
__global__ __launch_bounds__(512, 2) void fwd_kernel(Args a) {
    extern __shared__ __attribute__((aligned(16))) unsigned char shm[];
    LAS unsigned char* lds = (LAS unsigned char*)shm;
    if (threadIdx.x < 64) {
        const double rd = exp2(-(double)threadIdx.x * (13.287712379549449 / 64.0)) * 0.15915494309189535;
        const float hi = __uint_as_float(__float_as_uint((float)rd) & 0xFFFFE000u), lo = (float)(rd - (double)hi);
        ((LAS float*)(lds + 131072))[2 * threadIdx.x] = hi; ((LAS float*)(lds + 131072))[2 * threadIdx.x + 1] = lo;
    }
    volatile LAS unsigned* xst = (volatile LAS unsigned*)(lds + 131072 + 528);
    if (threadIdx.x == 0) { xst[0] = 0u; xst[1] = 0u; }
    __syncthreads();
    XcdBarrier xb{}; if (COOP) xb = xcd_barrier_post((unsigned*)(a.ws + OFF_BAR), xst);
    if (COOP && a.ph_hi > NPHASE) cg::this_grid().sync();
#define RUN_PH(P) if (a.ph_lo <= P && P < a.ph_hi) { run_phase<P>(a, lds); if ((DBL_MASK >> P) & 1) run_phase<P>(a, lds); if (COOP && P + 1 < a.ph_hi) { xcd_barrier(xb); } }
    RUN_PH(0) RUN_PH(1) RUN_PH(2) RUN_PH(3) RUN_PH(4) RUN_PH(5) RUN_PH(6) RUN_PH(7) RUN_PH(8) RUN_PH(9) RUN_PH(10) RUN_PH(11) RUN_PH(12)
#undef RUN_PH
}

extern "C" void kernel_launch(void* const* d_in, const int* in_sizes, int n_in, void* d_out, int out_size, void* d_ws, size_t ws_size, hipStream_t stream) {
    static int grid = 0;
    if (grid == 0) {
        if (n_in != 21 || ws_size < WS_NEED || out_size != NREAL * 1024) { fprintf(stderr, "kernel_launch: unexpected shapes (n_in %d, ws %zu need %zu, out %d)\n", n_in, ws_size, (size_t)WS_NEED, out_size); grid = -1; return; }
        int dev = 0, cus = 0;
        hipGetDevice(&dev); hipDeviceGetAttribute(&cus, hipDeviceAttributeMultiprocessorCount, dev);
        hipFuncSetAttribute((const void*)fwd_kernel<true>, hipFuncAttributeMaxDynamicSharedMemorySize, LDS_BYTES);
#if !COOP_MODE
        hipFuncSetAttribute((const void*)fwd_kernel<false>, hipFuncAttributeMaxDynamicSharedMemorySize, LDS_BYTES);
#endif
        int per_cu = 0;
        hipOccupancyMaxActiveBlocksPerMultiprocessor(&per_cu, (const void*)fwd_kernel<true>, 512, LDS_BYTES);
        if (per_cu < 1) { fprintf(stderr, "kernel_launch: occupancy query says %d blocks per CU\n", per_cu); per_cu = 1; }
        (void)hipGetLastError();
        grid = cus * 1;
    }
    if (grid < 0) return;
    Args a{};
    for (int i = 0; i < 21; ++i) a.in[i] = (const float*)d_in[i];
    a.out = (float*)d_out; a.ws = (unsigned char*)d_ws;
#if COOP_MODE
    hipMemsetAsync((char*)d_ws + OFF_BAR, 0, 4096 * 4 + 256, stream);
    a.ph_lo = 0; a.ph_hi = NPHASE;
    void* args[] = {&a};
    hipError_t e = hipLaunchCooperativeKernel((const void*)fwd_kernel<true>, dim3(grid), dim3(512), args, LDS_BYTES, stream);
    if (e != hipSuccess) fprintf(stderr, "cooperative launch failed: %s (grid %d)\n", hipGetErrorString(e), grid);
#else
    for (int ph = 0; ph < NPHASE; ++ph) {
        a.ph_lo = ph; a.ph_hi = ph + 1;
        hipLaunchKernelGGL(fwd_kernel<false>, dim3(grid), dim3(512), LDS_BYTES, stream, a);
    }
#endif
}
```

```cpp
#include <hip/hip_runtime.h>
#include <hip/hip_cooperative_groups.h>
#include <cstdio>
#include <cstdint>
namespace cg = cooperative_groups;

#ifndef COOP_MODE
#define COOP_MODE 1
#endif

#define DBL_MASK 0x0
#define LAS __attribute__((address_space(3)))
typedef unsigned short bf16_t;
typedef short bf16x8 __attribute__((ext_vector_type(8)));
typedef float f32x4 __attribute__((ext_vector_type(4)));
typedef unsigned u32x4 __attribute__((ext_vector_type(4)));
typedef unsigned u32x2 __attribute__((ext_vector_type(2)));

constexpr int D = 1024, NREAL = 81920, NPR = 65536, RPAD = 82432, NVALID = 82304;
constexpr int INW = 5632, DFF = 2816;
constexpr int T5 = 32, IT_REAL = 2560, IT_PAD = 2816, LDA5 = 768;
constexpr float EPS = 1e-6f;

constexpr size_t OFF_WIN = 0;
constexpr size_t OFF_WGLU = OFF_WIN + (size_t)INW * D * 2;
constexpr size_t OFF_WRET = OFF_WGLU + (size_t)2048 * 512 * 2;
constexpr size_t OFF_WOUT = OFF_WRET + (size_t)D * D * 2;
constexpr size_t OFF_WFFI = OFF_WOUT + (size_t)D * D * 2;
constexpr size_t OFF_WFFO = OFF_WFFI + (size_t)INW * D * 2;
constexpr size_t OFF_AT = OFF_WFFO + (size_t)D * DFF * 2;
constexpr size_t OFF_BAR = OFF_AT + 32768;
constexpr size_t OFF_Q = OFF_AT + 65536;
constexpr size_t OFF_K = OFF_Q + (size_t)RPAD * 512 * 2;
constexpr size_t OFF_V = OFF_K + (size_t)RPAD * 512 * 2;
constexpr size_t OFF_GB = OFF_V + (size_t)RPAD * D * 2;
constexpr size_t OFF_SSQ1 = OFF_GB + (size_t)NREAL * D * 2;
constexpr size_t OFF_SSQ2 = OFF_SSQ1 + (size_t)NREAL * 16 * 4;
constexpr size_t OFF_X = OFF_SSQ2 + (size_t)NREAL * 16 * 4;
constexpr size_t OFF_N1 = OFF_X;
constexpr size_t OFF_YSSM = OFF_X + (size_t)664 * 8 * 65536;
constexpr size_t OFF_U5 = OFF_N1 + (size_t)RPAD * D * 2;
constexpr size_t OFF_BTY = OFF_U5 + (size_t)32 * IT_PAD * LDA5 * 2;
constexpr size_t OFF_BTS = OFF_BTY + (size_t)32 * 512 * 768 * 2;
constexpr size_t OFF_SLOC = OFF_BTS + (size_t)32 * 256 * 512 * 2;
constexpr size_t END_X03 = OFF_SLOC + (size_t)32 * IT_PAD * 256 * 4;
constexpr size_t OFF_ST = OFF_X;
constexpr size_t END_ST = OFF_ST + (size_t)664 * 8 * 65536;
constexpr size_t OFF_ACT = OFF_X;
constexpr size_t END_ACT = OFF_ACT + (size_t)NREAL * DFF * 2;
constexpr size_t OFF_MIXED = OFF_Q;
constexpr size_t OFF_H1B = OFF_V;
constexpr size_t cmax(size_t a, size_t b) { return a > b ? a : b; }
constexpr size_t WS_NEED = cmax(END_X03, cmax(END_ST, END_ACT));

constexpr int LDS_BYTES = 131072 + 1024;
constexpr int NPHASE = 13;
constexpr int GLU_SPLIT = 64 * 14, GLU_SPLIT2 = GLU_SPLIT + 64 * 6;
constexpr int STG = 0;

struct Args {
    const float* in[21];
    float* out;
    unsigned char* ws;
    int ph_lo, ph_hi;
};

__device__ __forceinline__ unsigned cvt_pk_bf16(float lo, float hi) { unsigned r; asm volatile("v_cvt_pk_bf16_f32 %0, %1, %2" : "=v"(r) : "v"(lo), "v"(hi)); return r; }
__device__ __forceinline__ bf16_t f2bf(float f) { return (bf16_t)(cvt_pk_bf16(f, 0.f) & 0xFFFFu); }
__device__ __forceinline__ float bflo(unsigned w) { return __uint_as_float(w << 16); }
__device__ __forceinline__ float bfhi(unsigned w) { return __uint_as_float(w & 0xFFFF0000u); }
__device__ __forceinline__ float sigmoidf_(float x) { return __builtin_amdgcn_rcpf(1.0f + __builtin_amdgcn_exp2f(-1.4426950408889634f * x)); }
__device__ __forceinline__ float siluf_(float x) { return x * sigmoidf_(x); }
__device__ __forceinline__ float gelu_tanh(float x) { const float z = 0.7978845608028654f * (x + 0.044715f * x * x * x); return x * sigmoidf_(2.0f * z); }
__device__ __forceinline__ float logsigf_(float x) { return fminf(x, 0.f) - log1pf(__expf(-fabsf(x))); }
__device__ __forceinline__ float wave_sum(float v) {
#pragma unroll
    for (int o = 1; o < 64; o <<= 1) v += __shfl_xor(v, o);
    return v;
}
__device__ __forceinline__ void sincos_rev(double ang, float& s, float& c) {
    double x = ang * 0.15915494309189535; x -= rint(x);
    const float xf = (float)x;
    s = __builtin_amdgcn_sinf(xf); c = __builtin_amdgcn_cosf(xf);
}

namespace pg8 {
constexpr int BM = 256, BK = 64, HALF = 128, HTB = HALF * BK * 2, STAGE_BYTES = 8 * HTB, NXCD = 8, WGM = 8;
__device__ __forceinline__ int lds_byte(int r, int c) { const int st = (r >> 4) * 2 + (c >> 5), rr = r & 15, cc = c & 31, ob = rr * 64 + cc * 2; return st * 1024 + (ob ^ (((ob >> 9) & 1) << 5)); }
__device__ __forceinline__ void stage_rc(int b, int& R, int& C) { const int st = b / 1024, sb = b % 1024, swz = sb ^ (((sb >> 9) & 1) << 5); R = (st >> 1) * 16 + swz / 64; C = (st & 1) * 32 + (swz % 64) / 2; }
__device__ __forceinline__ int perm32(int rho) { const int n = rho >> 4, i = rho & 15; return 8 * (i >> 2) + 4 * n + (i & 3); }

struct Unit { int pm, pn, g; };
struct Gemm { const bf16_t* A; const bf16_t* Bt; int lda, ldb, K, nM, nN, nb; size_t sA, sB; int stagger; int G, c, u0, u1; };

struct Order {
    int nM, nN, nwg, total, G, c, u0;
    __device__ void init(int nM_, int nN_, int nb, int G_, int c_, int u0_, int u1_) { nM = nM_; nN = nN_; nwg = nM * nN; total = u1_ > 0 ? u1_ : nwg * nb; G = G_; c = c_; u0 = u0_; }
    __device__ bool next(int i, Unit& u) const {
        const long L = (long)u0 + (long)i * G + c; if (L >= total) return false;
        u.g = (int)(L / nwg); int wgid = (int)(L % nwg);
        { const int q = nwg / NXCD, r = nwg % NXCD, xcd = wgid % NXCD, off = wgid / NXCD; wgid = (xcd < r ? xcd * (q + 1) : r * (q + 1) + (xcd - r) * q) + off; }
        const int nig = WGM * nN, gid = wgid / nig, fm = gid * WGM, gsz = (nM - fm) < WGM ? (nM - fm) : WGM;
        u.pm = fm + ((wgid % nig) % gsz); u.pn = (wgid % nig) / gsz; return true;
    }
};

template <class Epi>
__device__ __forceinline__ void gemm_phase(LAS unsigned char* lds, const Gemm g, const Epi& E) {
    const int tid = threadIdx.x, wid = __builtin_amdgcn_readfirstlane(tid >> 6), lane = tid & 63, wr = wid >> 2, wc = wid & 3, fr = lane & 15, fq = lane >> 4;
    const int K = g.K, nt = K / BK;
    Order S; S.init(g.nM, g.nN, g.nb, g.G > 0 ? g.G : (int)gridDim.x, g.G > 0 ? g.c : (int)blockIdx.x, g.u0, g.u1);
    unsigned voffA[2], voffB[2];
#pragma unroll
    for (int i = 0; i < 2; ++i) { int R, C; stage_rc(tid * 16 + i * 8192, R, C); const int Rb = (R & ~31) + perm32(R & 31);
        voffA[i] = (unsigned)(R * g.lda + C) * 2u; voffB[i] = (unsigned)(Rb * g.ldb + C) * 2u; }
    const size_t kstep = (size_t)(BK * 2);
    const size_t hstepA = (size_t)HALF * g.lda * 2, hstepB = (size_t)HALF * g.ldb * 2;
    const size_t tstepA = 2 * hstepA, tstepB = 2 * hstepB;
    const unsigned ldsw = (unsigned)wid * 1024u;
    const int aoff = lds_byte(wr * 64 + fr, fq * 8), boff = lds_byte(wc * 32 + fr, fq * 8);
#define PG8_SA(b, h) (((b) * 2 + (h)) * HTB)
#define PG8_SB(b, h) ((4 + (b) * 2 + (h)) * HTB)
#define PG8_STAGE(bufoff, gbase, voff) do { _Pragma("unroll") for (int _i = 0; _i < 2; ++_i) \
        __builtin_amdgcn_global_load_lds((const unsigned*)((const char*)(gbase) + (voff)[_i]), (LAS unsigned*)(lds + (bufoff) + ldsw + _i * 8192), 16, 0, 0); } while (0)
#define PG8_LDA(dst, b, h) do { _Pragma("unroll") for (int m = 0; m < 4; ++m) _Pragma("unroll") for (int k = 0; k < 2; ++k) dst[m][k] = *(const LAS bf16x8*)(lds + PG8_SA(b, h) + aoff + m * 2048 + k * 1024); } while (0)
#define PG8_LDB(dst, b, h) do { _Pragma("unroll") for (int n = 0; n < 2; ++n) _Pragma("unroll") for (int k = 0; k < 2; ++k) dst[n][k] = *(const LAS bf16x8*)(lds + PG8_SB(b, h) + boff + n * 2048 + k * 1024); } while (0)
#define PG8_MMA(ai, bj, At, Bt) do { __builtin_amdgcn_s_setprio(1); _Pragma("unroll") for (int m = 0; m < 4; ++m) _Pragma("unroll") for (int n = 0; n < 2; ++n) _Pragma("unroll") for (int k = 0; k < 2; ++k) \
        acc[ai][bj][m][n] = __builtin_amdgcn_mfma_f32_16x16x32_bf16(Bt[n][k], At[m][k], acc[ai][bj][m][n], 0, 0, 0); __builtin_amdgcn_s_setprio(0); } while (0)
#define PG8_WAIT_V(n) asm volatile("s_waitcnt vmcnt(" #n ")" ::: "memory")
#define PG8_WAIT_L(n) asm volatile("s_waitcnt lgkmcnt(" #n ")" ::: "memory")
#define PG8_BAR __builtin_amdgcn_s_barrier()
#define PG8_SCHED __builtin_amdgcn_sched_barrier(0)
    Unit cur, nxt; int ui = 0;
    if (!S.next(0, cur)) return;
    if (g.stagger) {
        const unsigned long long t0 = __builtin_amdgcn_s_memrealtime(), wt = (unsigned long long)((blockIdx.x & 3) * g.stagger);
        while (__builtin_amdgcn_s_memrealtime() - t0 < wt) __builtin_amdgcn_s_sleep(16);
    }
    f32x4 acc[2][2][4][2];
#pragma unroll
    for (int a = 0; a < 2; ++a)
#pragma unroll
        for (int b = 0; b < 2; ++b)
#pragma unroll
            for (int m = 0; m < 4; ++m)
#pragma unroll
                for (int n = 0; n < 2; ++n) acc[a][b][m][n] = (f32x4){0.f, 0.f, 0.f, 0.f};
    bf16x8 At[4][2], B0[2][2], B1[2][2];
    const char* cA = (const char*)g.A + ((size_t)cur.g * g.sA) * 2 + (size_t)cur.pm * tstepA;
    const char* cB = (const char*)g.Bt + ((size_t)cur.g * g.sB) * 2 + (size_t)cur.pn * tstepB;
    PG8_STAGE(PG8_SB(0, 0), cB, voffB); PG8_STAGE(PG8_SA(0, 0), cA, voffA); PG8_STAGE(PG8_SB(0, 1), cB + hstepB, voffB); PG8_STAGE(PG8_SA(0, 1), cA + hstepA, voffA);
    if (wr == 1) PG8_BAR;
    PG8_WAIT_V(4); PG8_BAR;
    PG8_STAGE(PG8_SB(1, 0), cB + kstep, voffB); PG8_STAGE(PG8_SA(1, 0), cA + kstep, voffA); PG8_STAGE(PG8_SB(1, 1), cB + hstepB + kstep, voffB);
    PG8_WAIT_V(6); PG8_BAR;
    for (;;) {
        const bool has_next = S.next(ui + 1, nxt);
        const char* nA = has_next ? (const char*)g.A + ((size_t)nxt.g * g.sA) * 2 + (size_t)nxt.pm * tstepA : cA;
        const char* nB = has_next ? (const char*)g.Bt + ((size_t)nxt.g * g.sB) * 2 + (size_t)nxt.pn * tstepB : cB;
        for (int t = 0; t < nt; t += 2) {
            const bool last = (t == nt - 2);
            const char* a1 = cA + (size_t)(t + 1) * kstep;
            const char* a2 = last ? nA : cA + (size_t)(t + 2) * kstep; const char* b2 = last ? nB : cB + (size_t)(t + 2) * kstep;
            const char* a3 = a2 + kstep; const char* b3 = b2 + kstep;
            PG8_LDB(B0, 0, 0); PG8_SCHED; PG8_LDA(At, 0, 0); PG8_STAGE(PG8_SA(1, 1), a1 + hstepA, voffA);
            PG8_WAIT_L(8); PG8_BAR; PG8_WAIT_L(0); PG8_MMA(0, 0, At, B0); PG8_BAR; PG8_SCHED;
            PG8_LDB(B1, 0, 1); PG8_STAGE(PG8_SB(0, 0), b2, voffB);
            PG8_BAR; PG8_WAIT_L(0); PG8_MMA(0, 1, At, B1); PG8_BAR;
            PG8_LDA(At, 0, 1); PG8_STAGE(PG8_SA(0, 0), a2, voffA);
            PG8_BAR; PG8_WAIT_L(0); PG8_MMA(1, 0, At, B0); PG8_BAR; PG8_SCHED;
            PG8_STAGE(PG8_SB(0, 1), b2 + hstepB, voffB);
            PG8_WAIT_V(6); PG8_BAR; PG8_MMA(1, 1, At, B1); PG8_BAR;
            PG8_LDB(B0, 1, 0); PG8_SCHED; PG8_LDA(At, 1, 0); PG8_STAGE(PG8_SA(0, 1), a2 + hstepA, voffA);
            PG8_WAIT_L(8); PG8_BAR; PG8_WAIT_L(0); PG8_MMA(0, 0, At, B0); PG8_BAR; PG8_SCHED;
            PG8_LDB(B1, 1, 1); PG8_STAGE(PG8_SB(1, 0), b3, voffB);
            PG8_BAR; PG8_WAIT_L(0); PG8_MMA(0, 1, At, B1); PG8_BAR;
            PG8_LDA(At, 1, 1); PG8_STAGE(PG8_SA(1, 0), a3, voffA);
            PG8_BAR; PG8_WAIT_L(0); PG8_MMA(1, 0, At, B0); PG8_BAR; PG8_SCHED;
            PG8_STAGE(PG8_SB(1, 1), b3 + hstepB, voffB);
            PG8_WAIT_V(6); PG8_BAR; PG8_MMA(1, 1, At, B1); PG8_BAR;
        }
        E(acc, cur, wr, wc, fr, fq);
        if (!has_next) break;
#pragma unroll
        for (int a = 0; a < 2; ++a)
#pragma unroll
            for (int b = 0; b < 2; ++b)
#pragma unroll
                for (int m = 0; m < 4; ++m)
#pragma unroll
                    for (int n = 0; n < 2; ++n) acc[a][b][m][n] = (f32x4){0.f, 0.f, 0.f, 0.f};
        cur = nxt; cA = nA; cB = nB; ++ui;
    }
    PG8_WAIT_V(0);
    if (wr == 0) PG8_BAR;
    PG8_BAR;
#undef PG8_SA
#undef PG8_SB
#undef PG8_STAGE
#undef PG8_LDA
#undef PG8_LDB
#undef PG8_MMA
#undef PG8_WAIT_V
#undef PG8_WAIT_L
#undef PG8_BAR
#undef PG8_SCHED
}
}
using pg8::Unit;
typedef const f32x4 (&AccRef)[2][2][4][2];

__device__ __forceinline__ u32x4 pack8(f32x4 a, f32x4 b) { u32x4 w; w.x = cvt_pk_bf16(a[0], a[1]); w.y = cvt_pk_bf16(a[2], a[3]); w.z = cvt_pk_bf16(b[0], b[1]); w.w = cvt_pk_bf16(b[2], b[3]); return w; }

struct EpiProj {
    bf16_t *u5, *q, *k, *v, *sg, *ga, *gb; const LAS float* ropef;
    __device__ __forceinline__ void operator()(AccRef acc, const Unit& u, int wr, int wc, int fr, int fq) const {
        const int pn = u.pn;
#pragma unroll
        for (int ai = 0; ai < 2; ++ai)
#pragma unroll
            for (int m = 0; m < 4; ++m) {
                const int row = u.pm * 256 + ai * 128 + wr * 64 + m * 16 + fr;
#pragma unroll
                for (int bj = 0; bj < 2; ++bj) {
                    const int col = pn * 256 + bj * 128 + wc * 32 + 8 * fq;
                    f32x4 v0 = acc[ai][bj][m][0], v1 = acc[ai][bj][m][1];
                    if (pn < 2) {
                        if (row < NVALID) {
                            int item, t;
                            if (row < NREAL) { item = row >> 5; t = row & 31; } else { const int mr = row - NREAL; item = IT_REAL + (mr >> 4); t = 16 + (mr & 15); }
                            const int g = col >> 4, h0 = col & 15;
                            *(u32x4*)(u5 + ((size_t)(g * IT_PAD + item) * LDA5 + t * 16 + h0)) = pack8(v0, v1);
                        }
                    } else if (pn < 6) {
                        const int cq = col - 512, isk = cq >> 9, cc = cq & 511, i0 = (cc & 127) >> 1;
                        const int pos = row < NPR ? 16 + (row & 4095) : (row < NREAL ? 16 + ((row - NPR) & 2047) : ((row - NREAL) & 15));
                        const float sc = isk ? 1.0f : 0.08838834764831845f;
                        float o[8];
#pragma unroll
                        for (int pi = 0; pi < 4; ++pi) {
                            const float fp = (float)pos, t1 = fp * ropef[2 * (i0 + pi)];
                            const float rev = (t1 - rintf(t1)) + fp * ropef[2 * (i0 + pi) + 1];
                            const float s = __builtin_amdgcn_sinf(rev), c = __builtin_amdgcn_cosf(rev);
                            const float x1 = pi < 2 ? v0[2 * pi] : v1[2 * pi - 4], x2 = pi < 2 ? v0[2 * pi + 1] : v1[2 * pi - 3];
                            o[2 * pi] = (x1 * c - x2 * s) * sc; o[2 * pi + 1] = (x1 * s + x2 * c) * sc;
                        }
                        u32x4 w; w.x = cvt_pk_bf16(o[0], o[1]); w.y = cvt_pk_bf16(o[2], o[3]); w.z = cvt_pk_bf16(o[4], o[5]); w.w = cvt_pk_bf16(o[6], o[7]);
                        *(u32x4*)((isk ? k : q) + (size_t)row * 512 + cc) = w;
                    } else if (pn < 10) {
                        *(u32x4*)(v + (size_t)row * 1024 + (col - 1536)) = pack8(v0, v1);
                    } else if (row < NREAL) {
                        if (pn < 14) {
#pragma unroll
                            for (int j = 0; j < 4; ++j) { v0[j] = siluf_(v0[j]); v1[j] = siluf_(v1[j]); }
                            *(u32x4*)(sg + (size_t)row * 1024 + (col - 2560)) = pack8(v0, v1);
                        } else {
#pragma unroll
                            for (int j = 0; j < 4; ++j) { v0[j] = sigmoidf_(v0[j]); v1[j] = sigmoidf_(v1[j]); }
                            if (pn < 18) *(u32x4*)(ga + (size_t)row * 1024 + (col - 3584)) = pack8(v0, v1);
                            else *(u32x4*)(gb + (size_t)row * 1024 + (col - 4608)) = pack8(v0, v1);
                        }
                    }
                }
            }
    }
};

struct EpiSink {
    float* p; int flag;
    __device__ __forceinline__ void operator()(AccRef acc, const Unit& u, int wr, int wc, int fr, int fq) const {
        if (flag) {
#pragma unroll
            for (int ai = 0; ai < 2; ++ai)
#pragma unroll
                for (int m = 0; m < 4; ++m)
#pragma unroll
                    for (int bj = 0; bj < 2; ++bj) { p[(ai * 8 + m * 2 + bj) * 8 + fr] = acc[ai][bj][m][0][0] + acc[ai][bj][m][1][1]; }
        }
    }
};

struct EpiSloc {
    float* sloc;
    __device__ __forceinline__ void operator()(AccRef acc, const Unit& u, int wr, int wc, int fr, int fq) const {
#pragma unroll
        for (int ai = 0; ai < 2; ++ai)
#pragma unroll
            for (int m = 0; m < 4; ++m) {
                const int row = u.pm * 256 + ai * 128 + wr * 64 + m * 16 + fr;
#pragma unroll
                for (int bj = 0; bj < 2; ++bj) {
                    const int col = bj * 128 + wc * 32 + 8 * fq;
                    float* p = sloc + ((size_t)u.g * IT_PAD + row) * 256 + col;
                    *(f32x4*)p = acc[ai][bj][m][0]; *(f32x4*)(p + 4) = acc[ai][bj][m][1];
                }
            }
    }
};

struct EpiY {
    bf16_t* y;
    __device__ __forceinline__ void operator()(AccRef acc, const Unit& u, int wr, int wc, int fr, int fq) const {
#pragma unroll
        for (int ai = 0; ai < 2; ++ai)
#pragma unroll
            for (int m = 0; m < 4; ++m) {
                const int item = u.pm * 256 + ai * 128 + wr * 64 + m * 16 + fr;
                if (item < IT_REAL) {
#pragma unroll
                    for (int bj = 0; bj < 2; ++bj) {
                        const int col = u.pn * 256 + bj * 128 + wc * 32 + 8 * fq, to = col >> 4, ho = col & 15;
                        f32x4 v0 = acc[ai][bj][m][0], v1 = acc[ai][bj][m][1];
#pragma unroll
                        for (int j = 0; j < 4; ++j) { v0[j] = gelu_tanh(v0[j]); v1[j] = gelu_tanh(v1[j]); }
                        *(u32x4*)(y + (size_t)(item * 32 + to) * 512 + u.g * 16 + ho) = pack8(v0, v1);
                    }
                }
            }
    }
};

struct EpiGlu {
    bf16_t* ga;
    __device__ __forceinline__ void operator()(AccRef acc, const Unit& u, int wr, int wc, int fr, int fq) const {
        u32x4 gw[2][4];
#pragma unroll
        for (int ai = 0; ai < 2; ++ai)
#pragma unroll
            for (int m = 0; m < 4; ++m) {
                const int row = u.pm * 256 + ai * 128 + wr * 64 + m * 16 + fr;
                gw[ai][m] = *(const u32x4*)(ga + (size_t)row * 1024 + u.pn * 128 + wc * 32 + 8 * fq);
            }
#pragma unroll
        for (int ai = 0; ai < 2; ++ai)
#pragma unroll
            for (int m = 0; m < 4; ++m) {
                const int row = u.pm * 256 + ai * 128 + wr * 64 + m * 16 + fr;
                bf16_t* p = ga + (size_t)row * 1024 + u.pn * 128 + wc * 32 + 8 * fq;
                const u32x4 g = gw[ai][m];
                const f32x4 a0 = acc[ai][0][m][0], a1 = acc[ai][0][m][1], g0 = acc[ai][1][m][0], g1 = acc[ai][1][m][1];
                f32x4 r0, r1;
                r0[0] = bflo(g.x) * a0[0] * sigmoidf_(g0[0]); r0[1] = bfhi(g.x) * a0[1] * sigmoidf_(g0[1]);
                r0[2] = bflo(g.y) * a0[2] * sigmoidf_(g0[2]); r0[3] = bfhi(g.y) * a0[3] * sigmoidf_(g0[3]);
                r1[0] = bflo(g.z) * a1[0] * sigmoidf_(g1[0]); r1[1] = bfhi(g.z) * a1[1] * sigmoidf_(g1[1]);
                r1[2] = bflo(g.w) * a1[2] * sigmoidf_(g1[2]); r1[3] = bfhi(g.w) * a1[3] * sigmoidf_(g1[3]);
                *(u32x4*)p = pack8(r0, r1);
            }
    }
};

struct EpiRet {
    const bf16_t *pa, *gb; bf16_t* mixed;
    __device__ __forceinline__ void operator()(AccRef acc, const Unit& u, int wr, int wc, int fr, int fq) const {
#pragma unroll
        for (int ai = 0; ai < 2; ++ai) {
            u32x4 pw[4][2], gw[4][2];
#pragma unroll
            for (int m = 0; m < 4; ++m)
#pragma unroll
                for (int bj = 0; bj < 2; ++bj) {
                    const int row = u.pm * 256 + ai * 128 + wr * 64 + m * 16 + fr;
                    const size_t o = (size_t)row * 1024 + u.pn * 256 + bj * 128 + wc * 32 + 8 * fq;
                    pw[m][bj] = *(const u32x4*)(pa + o); gw[m][bj] = *(const u32x4*)(gb + o);
                }
#pragma unroll
            for (int m = 0; m < 4; ++m)
#pragma unroll
                for (int bj = 0; bj < 2; ++bj) {
                    const int row = u.pm * 256 + ai * 128 + wr * 64 + m * 16 + fr;
                    const size_t o = (size_t)row * 1024 + u.pn * 256 + bj * 128 + wc * 32 + 8 * fq;
                    const u32x4 p = pw[m][bj], g = gw[m][bj];
                    const f32x4 a0 = acc[ai][bj][m][0], a1 = acc[ai][bj][m][1];
                    f32x4 r0, r1;
                    r0[0] = bflo(p.x) + bflo(g.x) * a0[0]; r0[1] = bfhi(p.x) + bfhi(g.x) * a0[1];
                    r0[2] = bflo(p.y) + bflo(g.y) * a0[2]; r0[3] = bfhi(p.y) + bfhi(g.y) * a0[3];
                    r1[0] = bflo(p.z) + bflo(g.z) * a1[0]; r1[1] = bfhi(p.z) + bfhi(g.z) * a1[1];
                    r1[2] = bflo(p.w) + bflo(g.w) * a1[2]; r1[3] = bfhi(p.w) + bfhi(g.w) * a1[3];
                    *(u32x4*)(mixed + o) = pack8(r0, r1);
                }
            __builtin_amdgcn_sched_barrier(0);
        }
    }
};

template <int MODE>
struct EpiRes {
    const float *xp, *xs; bf16_t* hb; float* ssq;
    __device__ __forceinline__ void operator()(AccRef acc, const Unit& u, int wr, int wc, int fr, int fq) const {
#pragma unroll
        for (int ai = 0; ai < 2; ++ai) {
            f32x4 x0[4][2], x1[4][2]; u32x4 hw[4][2];
#pragma unroll
            for (int m = 0; m < 4; ++m)
#pragma unroll
                for (int bj = 0; bj < 2; ++bj) {
                    const int row = u.pm * 256 + ai * 128 + wr * 64 + m * 16 + fr, col = u.pn * 256 + bj * 128 + wc * 32 + 8 * fq;
                    if (MODE == 0) {
                        const float* src = (row < NPR ? xp + (size_t)row * 1024 : xs + (size_t)(row - NPR) * 1024) + col;
                        x0[m][bj] = *(const f32x4*)src; x1[m][bj] = *(const f32x4*)(src + 4);
                    } else hw[m][bj] = *(const u32x4*)(hb + (size_t)row * 1024 + col);
                }
#pragma unroll
            for (int m = 0; m < 4; ++m) {
                const int row = u.pm * 256 + ai * 128 + wr * 64 + m * 16 + fr;
                float ss = 0.f;
#pragma unroll
                for (int bj = 0; bj < 2; ++bj) {
                    const int col = u.pn * 256 + bj * 128 + wc * 32 + 8 * fq;
                    f32x4 h0, h1;
                    if (MODE == 0) { h0 = x0[m][bj]; h1 = x1[m][bj]; }
                    else { const u32x4 w = hw[m][bj]; h0 = (f32x4){bflo(w.x), bfhi(w.x), bflo(w.y), bfhi(w.y)}; h1 = (f32x4){bflo(w.z), bfhi(w.z), bflo(w.w), bfhi(w.w)}; }
                    h0 = h0 + acc[ai][bj][m][0]; h1 = h1 + acc[ai][bj][m][1];
                    *(u32x4*)(hb + (size_t)row * 1024 + col) = pack8(h0, h1);
                    ss += (h0[0] * h0[0] + h0[1] * h0[1]) + (h0[2] * h0[2] + h0[3] * h0[3]) + (h1[0] * h1[0] + h1[1] * h1[1]) + (h1[2] * h1[2] + h1[3] * h1[3]);
                }
                ss += __shfl_xor(ss, 16); ss += __shfl_xor(ss, 32);
                if (fq == 0) ssq[(size_t)row * 16 + u.pn * 4 + wc] = ss;
            }
            __builtin_amdgcn_sched_barrier(0);
        }
    }
};

struct EpiFfi {
    const float* ssq; bf16_t* act;
    __device__ __forceinline__ void operator()(AccRef acc, const Unit& u, int wr, int wc, int fr, int fq) const {
        f32x4 sp[2][4];
#pragma unroll
        for (int ai = 0; ai < 2; ++ai)
#pragma unroll
            for (int m = 0; m < 4; ++m) {
                const int row = u.pm * 256 + ai * 128 + wr * 64 + m * 16 + fr;
                sp[ai][m] = *(const f32x4*)(ssq + (size_t)row * 16 + 4 * fq);
            }
#pragma unroll
        for (int ai = 0; ai < 2; ++ai)
#pragma unroll
            for (int m = 0; m < 4; ++m) {
                const int row = u.pm * 256 + ai * 128 + wr * 64 + m * 16 + fr;
                float tot = (sp[ai][m][0] + sp[ai][m][1]) + (sp[ai][m][2] + sp[ai][m][3]);
                tot += __shfl_xor(tot, 16); tot += __shfl_xor(tot, 32);
                const float rstd = rsqrtf(tot * (1.0f / 1024.0f) + EPS);
                const f32x4 g0 = acc[ai][0][m][0], g1 = acc[ai][0][m][1], u0 = acc[ai][1][m][0], u1 = acc[ai][1][m][1];
                f32x4 r0, r1;
#pragma unroll
                for (int j = 0; j < 4; ++j) { r0[j] = siluf_(rstd * g0[j]) * (rstd * u0[j]); r1[j] = siluf_(rstd * g1[j]) * (rstd * u1[j]); }
                *(u32x4*)(act + (size_t)row * DFF + u.pn * 128 + wc * 32 + 8 * fq) = pack8(r0, r1);
            }
    }
};

__device__ __forceinline__ void p0_s5gen(const Args& a, LAS float* L, int g, int qd) {
    const int tid = threadIdx.x;
    LAS float* Kt = L;
    LAS float* Ap = L + 16384;
    LAS float* Bb = Ap + 33 * 64 * 2;
    LAS float* Cc = Bb + 2048;
    bf16_t* bts = (bf16_t*)(a.ws + OFF_BTS) + (size_t)g * 256 * 512;
    bf16_t* bty = (bf16_t*)(a.ws + OFF_BTY) + (size_t)g * 512 * 768;
    float* attab = (float*)(a.ws + OFF_AT);
    bf16_t* u5 = (bf16_t*)(a.ws + OFF_U5);
    if (qd == 0) for (int e = tid; e < 24 * 256; e += 512) { const int b = e >> 8, kk = e & 255; u5[((size_t)g * IT_PAD + IT_REAL + b) * LDA5 + kk] = 0; }
    for (int dir = 0; dir < 2; ++dir) {
        const int pg = dir * 32 + g;
        const double dt = exp((double)a.in[7][pg]);
        for (int idx = tid; idx < 33 * 64; idx += 512) {
            const int p = idx & 63, d = idx >> 6;
            const double lr = a.in[5][pg * 64 + p], li = a.in[6][pg * 64 + p];
            const float mag = (float)exp(lr * dt * d);
            float s, c; sincos_rev(li * dt * d, s, c);
            Ap[idx * 2] = mag * c; Ap[idx * 2 + 1] = mag * s;
            if (d == 32 && qd == 0) { attab[(pg * 64 + p) * 2] = mag * c; attab[(pg * 64 + p) * 2 + 1] = mag * s; }
        }
        for (int idx = tid; idx < 1024; idx += 512) {
            const int p = idx >> 4, h = idx & 15;
            const double lr = a.in[5][pg * 64 + p], li = a.in[6][pg * 64 + p];
            const double zr = lr * dt, zi = li * dt, mag = exp(zr);
            float sh, ch, s1, c1; sincos_rev(0.5 * zi, sh, ch); sincos_rev(zi, s1, c1);
            const double nr = mag * (-2.0 * (double)sh * (double)sh) + expm1(zr);
            const double abi = mag * (double)s1, den = lr * lr + li * li;
            const double cre = (nr * lr + abi * li) / den, cim = (abi * lr - nr * li) / den;
            const double br = a.in[8][(size_t)(pg * 64 + p) * 16 + h], bi = a.in[9][(size_t)(pg * 64 + p) * 16 + h];
            Bb[idx * 2] = (float)(cre * br - cim * bi); Bb[idx * 2 + 1] = (float)(cre * bi + cim * br);
        }
        for (int idx = tid; idx < 1024; idx += 512) {
            Cc[idx * 2] = a.in[10][(size_t)pg * 1024 + idx]; Cc[idx * 2 + 1] = a.in[11][(size_t)pg * 1024 + idx];
        }
        __syncthreads();
        for (int e = tid; e < 8192; e += 512) {
            const int d = e >> 8, ho = (e >> 4) & 15, hi = e & 15;
            float sum = 0.f;
            for (int p = 0; p < 64; ++p) {
                const float cr = Cc[(ho * 64 + p) * 2], ci = Cc[(ho * 64 + p) * 2 + 1], ar = Ap[(d * 64 + p) * 2], ai = Ap[(d * 64 + p) * 2 + 1];
                const float br = Bb[(p * 16 + hi) * 2], bi = Bb[(p * 16 + hi) * 2 + 1];
                const float car = cr * ar - ci * ai, cai = cr * ai + ci * ar;
                sum += car * br - cai * bi;
            }
            Kt[dir * 8192 + e] = sum;
        }
        for (int e = qd * 16384 + tid; e < (qd + 1) * 16384; e += 512) {
            const int k = e & 511, nn = e >> 9, c = nn >> 6, p = nn & 63, t = k >> 4, hi = k & 15;
            const int dd = dir == 0 ? (T5 - 1 - t) : t;
            const float ar = Ap[(dd * 64 + p) * 2], ai = Ap[(dd * 64 + p) * 2 + 1], br = Bb[(p * 16 + hi) * 2], bi = Bb[(p * 16 + hi) * 2 + 1];
            const float val = c ? (ar * bi + ai * br) : (ar * br - ai * bi);
            bts[(size_t)(dir * 128 + nn) * 512 + k] = f2bf(val);
        }
        for (int e = qd * 16384 + tid; e < (qd + 1) * 16384; e += 512) {
            const int kk = e & 127, n = e >> 7, c = kk >> 6, p = kk & 63, to = n >> 4, ho = n & 15;
            const int dd = dir == 0 ? (to + 1) : (T5 - to);
            const float cr = Cc[(ho * 64 + p) * 2], ci = Cc[(ho * 64 + p) * 2 + 1], ar = Ap[(dd * 64 + p) * 2], ai = Ap[(dd * 64 + p) * 2 + 1];
            const float val = c ? -(cr * ai + ci * ar) : (cr * ar - ci * ai);
            bty[(size_t)n * 768 + 512 + dir * 128 + kk] = f2bf(val);
        }
        __syncthreads();
    }
    for (int e = qd * 65536 + tid; e < (qd + 1) * 65536; e += 512) {
        const int k = e & 511, n = e >> 9, to = n >> 4, ho = n & 15, ti = k >> 4, hi = k & 15;
        float val = 0.f;
        if (to >= ti) val += Kt[((to - ti) * 16 + ho) * 16 + hi];
        if (ti >= to) val += Kt[8192 + ((ti - to) * 16 + ho) * 16 + hi];
        if (to == ti && ho == hi) val += a.in[12][g * 16 + ho];
        bty[(size_t)n * 768 + k] = f2bf(val);
    }
    __syncthreads();
}

__device__ __forceinline__ int src_col(int kind, int n) {
    if (kind == 1) { if (n >= 512 && n < 1536) { const int r = n - 512, seg = r >> 7, dp = r & 127; return 512 + seg * 128 + (dp >> 1) + 64 * (dp & 1); } return n; }
    if (kind == 2) { const int pn = n >> 8, bj = (n >> 7) & 1, cc = n & 127; return bj * 1024 + pn * 128 + cc; }
    if (kind == 3) { const int pn = n >> 8, bj = (n >> 7) & 1, cc = n & 127; return bj * DFF + pn * 128 + cc; }
    return n;
}
__device__ __forceinline__ void p0_wtile(const float* W, int K, int N, bf16_t* WT, int kind, const float* kscale, int tile2, LAS float* L) {
    const int tid = threadIdx.x, nkt = K >> 6;
    int n0[2], k0[2];
#pragma unroll
    for (int q = 0; q < 2; ++q) { const int tile = 2 * tile2 + q; n0[q] = (tile / nkt) * 64; k0[q] = (tile % nkt) * 64; }
    float v[2][8];
#pragma unroll
    for (int q = 0; q < 2; ++q)
#pragma unroll
        for (int it = 0; it < 8; ++it) {
            const int idx = tid + it * 512, kk = idx >> 6, j = idx & 63;
            v[q][it] = W[(size_t)(k0[q] + kk) * N + src_col(kind, n0[q] + j)];
        }
#pragma unroll
    for (int q = 0; q < 2; ++q)
#pragma unroll
        for (int it = 0; it < 8; ++it) {
            const int idx = tid + it * 512, kk = idx >> 6, j = idx & 63;
            float x = v[q][it];
            if (kscale) x *= kscale[k0[q] + kk];
            L[q * 4160 + kk * 65 + j] = x;
        }
    __syncthreads();
#pragma unroll
    for (int q = 0; q < 2; ++q)
#pragma unroll
        for (int it = 0; it < 4; ++it) {
            const int idx = tid + it * 512, j = idx >> 5, kp = idx & 31;
            *(unsigned*)(WT + (size_t)(n0[q] + j) * K + k0[q] + 2 * kp) = cvt_pk_bf16(L[q * 4160 + (2 * kp) * 65 + j], L[q * 4160 + (2 * kp + 1) * 65 + j]);
        }
    __syncthreads();
}

__device__ __forceinline__ void phase0(const Args& a, LAS unsigned char* lds) {
    LAS float* L = (LAS float*)lds;
    const int tid = threadIdx.x, wave = tid >> 6, lane = tid & 63;
    constexpr int T_IN = 88 * 16 / 2, T_GLU = 32 * 8 / 2, T_RET = 128, T_OUT = 128, T_FFI = 88 * 16 / 2, T_FFO = 16 * 44 / 2;
    constexpr int NW = 128 + T_IN + T_GLU + T_RET + T_OUT, NRM = RPAD / 32;
    unsigned* qctr = (unsigned*)(a.ws + OFF_BAR) + 4096;
    LAS int* qslot = (LAS int*)(lds + 131072 + 512);
    for (;;) {
        __syncthreads();
        if (tid == 0) *qslot = (int)__hip_atomic_fetch_add(qctr, 1u, __ATOMIC_RELAXED, __HIP_MEMORY_SCOPE_AGENT);
        __syncthreads();
        const int w = *qslot;
        if (w >= NW + NRM) break;
        int r = w;
        if (r < 128) { p0_s5gen(a, L, r >> 2, r & 3); continue; } r -= 128;
        if (r < T_IN) { p0_wtile(a.in[4], 1024, INW, (bf16_t*)(a.ws + OFF_WIN), 1, nullptr, r, L); continue; } r -= T_IN;
        if (r < T_GLU) { p0_wtile(a.in[13], 512, 2048, (bf16_t*)(a.ws + OFF_WGLU), 2, nullptr, r, L); continue; } r -= T_GLU;
        if (r < T_RET) { p0_wtile(a.in[15], 1024, 1024, (bf16_t*)(a.ws + OFF_WRET), 0, nullptr, r, L); continue; } r -= T_RET;
        if (r < T_OUT) { p0_wtile(a.in[16], 1024, 1024, (bf16_t*)(a.ws + OFF_WOUT), 0, nullptr, r, L); continue; } r -= T_OUT;

        const int rowb = r * 32 + wave * 4;
        const float* xr[4]; f32x4 v[4][4];
#pragma unroll
        for (int q = 0; q < 4; ++q) {
            const int row = rowb + q;
            xr[q] = row < NPR ? a.in[0] + (size_t)row * 1024 : (row < NREAL ? a.in[1] + (size_t)(row - NPR) * 1024 : a.in[2] + (size_t)((row - NREAL) & 15) * 1024);
#pragma unroll
            for (int j = 0; j < 4; ++j) v[q][j] = (row < NVALID) ? *(const f32x4*)(xr[q] + (j * 64 + lane) * 4) : (f32x4){0.f, 0.f, 0.f, 0.f};
        }
        f32x4 gg[4];
#pragma unroll
        for (int j = 0; j < 4; ++j) gg[j] = *(const f32x4*)(a.in[3] + (j * 64 + lane) * 4);
#pragma unroll
        for (int q = 0; q < 4; ++q) {
            float sq = 0.f;
#pragma unroll
            for (int j = 0; j < 4; ++j) sq += (v[q][j][0] * v[q][j][0] + v[q][j][1] * v[q][j][1]) + (v[q][j][2] * v[q][j][2] + v[q][j][3] * v[q][j][3]);
            const float rstd = rsqrtf(wave_sum(sq) * (1.0f / 1024.0f) + EPS);
            bf16_t* orow = (bf16_t*)(a.ws + OFF_N1) + (size_t)(rowb + q) * 1024;
#pragma unroll
            for (int j = 0; j < 4; ++j) {
                u32x2 o; o.x = cvt_pk_bf16(v[q][j][0] * rstd * gg[j][0], v[q][j][1] * rstd * gg[j][1]); o.y = cvt_pk_bf16(v[q][j][2] * rstd * gg[j][2], v[q][j][3] * rstd * gg[j][3]);
                *(u32x2*)(orow + (j * 64 + lane) * 4) = o;
            }
        }
    }
}

__device__ __forceinline__ void s5_scan(const Args& a) {
    const float* attab = (const float*)(a.ws + OFF_AT);
    const float* sloc = (const float*)(a.ws + OFF_SLOC);
    bf16_t* u5 = (bf16_t*)(a.ws + OFF_U5);
    for (int id = blockIdx.x * 512 + threadIdx.x; id < 24 * 32 * 2 * 64; id += gridDim.x * 512) {
        const int p = id & 63, dir = (id >> 6) & 1, g = (id >> 7) & 31, b = id >> 12;
        const float atr = attab[((dir * 32 + g) * 64 + p) * 2], ati = attab[((dir * 32 + g) * 64 + p) * 2 + 1];
        const int nck = b < 16 ? 128 : 64, base = b < 16 ? b * 128 : 2048 + (b - 16) * 64, mitem = IT_REAL + b;
        const float* sl = sloc + (size_t)g * IT_PAD * 256 + dir * 128 + p;
        bf16_t* ub = u5 + (size_t)g * IT_PAD * LDA5 + 512 + dir * 128 + p;
        float sr = 0.f, si = 0.f;
        if (dir == 0) {
            ub[(size_t)mitem * LDA5] = 0; ub[(size_t)mitem * LDA5 + 64] = 0;
            sr = sl[(size_t)mitem * 256]; si = sl[(size_t)mitem * 256 + 64];
            for (int c0 = 0; c0 < nck; c0 += 16) {
                float lr[16], li[16];
#pragma unroll
                for (int j = 0; j < 16; ++j) { lr[j] = sl[(size_t)(base + c0 + j) * 256]; li[j] = sl[(size_t)(base + c0 + j) * 256 + 64]; }
#pragma unroll
                for (int j = 0; j < 16; ++j) {
                    const size_t it = (size_t)(base + c0 + j);
                    ub[it * LDA5] = f2bf(sr); ub[it * LDA5 + 64] = f2bf(si);
                    const float nr = atr * sr - ati * si + lr[j], ni = atr * si + ati * sr + li[j];
                    sr = nr; si = ni;
                }
            }
        } else {
            for (int c0 = nck - 16; c0 >= 0; c0 -= 16) {
                float lr[16], li[16];
#pragma unroll
                for (int j = 0; j < 16; ++j) { lr[j] = sl[(size_t)(base + c0 + j) * 256]; li[j] = sl[(size_t)(base + c0 + j) * 256 + 64]; }
#pragma unroll
                for (int j = 15; j >= 0; --j) {
                    const size_t it = (size_t)(base + c0 + j);
                    ub[it * LDA5] = f2bf(sr); ub[it * LDA5 + 64] = f2bf(si);
                    const float nr = atr * sr - ati * si + lr[j], ni = atr * si + ati * sr + li[j];
                    sr = nr; si = ni;
                }
            }
            ub[(size_t)mitem * LDA5] = f2bf(sr); ub[(size_t)mitem * LDA5 + 64] = f2bf(si);
        }
    }
}

constexpr int LDR = 136;
constexpr int LDRA = 144;
__device__ __forceinline__ float bf2f(bf16_t h) { return __uint_as_float(((unsigned)h) << 16); }

template <int LDR>
__device__ __forceinline__ void tr_store_pair(LAS bf16_t* img, int f0, int s2, u32x4 r0, u32x4 r1) {
    LAS unsigned* p = (LAS unsigned*)(img + f0 * LDR + s2);
    p[0 * (LDR / 2)] = (r0.x & 0xFFFFu) | (r1.x << 16); p[1 * (LDR / 2)] = (r0.x >> 16) | (r1.x & 0xFFFF0000u);
    p[2 * (LDR / 2)] = (r0.y & 0xFFFFu) | (r1.y << 16); p[3 * (LDR / 2)] = (r0.y >> 16) | (r1.y & 0xFFFF0000u);
    p[4 * (LDR / 2)] = (r0.z & 0xFFFFu) | (r1.z << 16); p[5 * (LDR / 2)] = (r0.z >> 16) | (r1.z & 0xFFFF0000u);
    p[6 * (LDR / 2)] = (r0.w & 0xFFFFu) | (r1.w << 16); p[7 * (LDR / 2)] = (r0.w >> 16) | (r1.w & 0xFFFF0000u);
}
template <int LDR>
__device__ __forceinline__ void tr_store_pair_scaled(LAS bf16_t* img, int f0, int s2, u32x4 r0, u32x4 r1, float w0, float w1) {
    LAS unsigned* p = (LAS unsigned*)(img + f0 * LDR + s2);
    p[0 * (LDR / 2)] = cvt_pk_bf16(bflo(r0.x) * w0, bflo(r1.x) * w1); p[1 * (LDR / 2)] = cvt_pk_bf16(bfhi(r0.x) * w0, bfhi(r1.x) * w1);
    p[2 * (LDR / 2)] = cvt_pk_bf16(bflo(r0.y) * w0, bflo(r1.y) * w1); p[3 * (LDR / 2)] = cvt_pk_bf16(bfhi(r0.y) * w0, bfhi(r1.y) * w1);
    p[4 * (LDR / 2)] = cvt_pk_bf16(bflo(r0.z) * w0, bflo(r1.z) * w1); p[5 * (LDR / 2)] = cvt_pk_bf16(bfhi(r0.z) * w0, bfhi(r1.z) * w1);
    p[6 * (LDR / 2)] = cvt_pk_bf16(bflo(r0.w) * w0, bflo(r1.w) * w1); p[7 * (LDR / 2)] = cvt_pk_bf16(bfhi(r0.w) * w0, bfhi(r1.w) * w1);
}

#define LDS_BARRIER() do { asm volatile("s_waitcnt lgkmcnt(0)" ::: "memory"); __builtin_amdgcn_s_barrier(); asm volatile("" ::: "memory"); } while (0)
__device__ __forceinline__ void ret_pass_a(const Args& a, LAS unsigned char* lds) {
    LAS bf16_t* KT = (LAS bf16_t*)lds;
    LAS bf16_t* VT = KT + 128 * LDRA;
    const int tid0 = threadIdx.x;
    const bf16_t* kb = (const bf16_t*)(a.ws + OFF_K); const bf16_t* vb = (const bf16_t*)(a.ws + OFF_V);
    bf16_t* stb = (bf16_t*)(a.ws + OFF_ST);
    for (int item = blockIdx.x; item < 192; item += gridDim.x) {
        int tid = tid0; asm volatile("" : "+v"(tid));
        const int w = tid >> 6, lane = tid & 63, fr = lane & 15, fq = lane >> 4;
        int b, h, dir;
        if (item < 128) { b = item >> 3; h = (item >> 1) & 3; dir = item & 1; } else { const int j = item - 128; b = 16 + (j >> 3); h = (j >> 1) & 3; dir = j & 1; }
        const int NC = b < 16 ? 32 : 16, rbase = b < 16 ? b * 4096 : NPR + (b - 16) * 2048, ebase = b < 16 ? b * 33 : 528 + (b - 16) * 17;
        const float lg = logsigf_(a.in[14][dir * 4 + h]);
        const float carry = __expf(lg * 128.f);
        const int s2 = 2 * (8 * w + (lane & 7)), pg = lane >> 3;
        const float wk0 = dir == 0 ? __expf(lg * (float)(127 - s2)) : __expf(lg * (float)s2);
        const float wk1 = dir == 0 ? __expf(lg * (float)(126 - s2)) : __expf(lg * (float)(s2 + 1));
        f32x4 acc[2][8];
#pragma unroll
        for (int et = 0; et < 2; ++et)
#pragma unroll
            for (int dtl = 0; dtl < 8; ++dtl) acc[et][dtl] = (f32x4){0.f, 0.f, 0.f, 0.f};
        const int nsteps = dir == 0 ? NC : NC;
        u32x4 rk[2][2], rv[4][2];
        auto load_chunk = [&](int n) {
            int row0; bool valid = true;
            if (n == 0) { valid = s2 >= 112; row0 = NREAL + b * 16 + (s2 - 112); } else row0 = rbase + (n - 1) * 128 + s2;
#pragma unroll
            for (int it = 0; it < 2; ++it)
#pragma unroll
                for (int r = 0; r < 2; ++r) {
                    rk[it][r] = (u32x4){0u, 0u, 0u, 0u};
                    if (valid) rk[it][r] = *(const u32x4*)(kb + (size_t)(row0 + r) * 512 + h * 128 + (pg + 8 * it) * 8);
                }
#pragma unroll
            for (int it = 0; it < 4; ++it)
#pragma unroll
                for (int r = 0; r < 2; ++r) {
                    rv[it][r] = (u32x4){0u, 0u, 0u, 0u};
                    if (valid) rv[it][r] = *(const u32x4*)(vb + (size_t)(row0 + r) * 1024 + h * 256 + (pg + 8 * it) * 8);
                }
        };
        load_chunk(dir == 0 ? 0 : NC);
        for (int step = 0; step < nsteps; ++step) {
            const int n = dir == 0 ? step : NC - step;
            {
                bf16_t* spn = stb + ((size_t)((ebase + n) * 4 + h) * 2 + dir) * 32768;
#pragma unroll
                for (int et = 0; et < 2; ++et)
#pragma unroll
                    for (int dtl = 0; dtl < 8; ++dtl) {
                        u32x2 o; o.x = cvt_pk_bf16(acc[et][dtl][0], acc[et][dtl][1]); o.y = cvt_pk_bf16(acc[et][dtl][2], acc[et][dtl][3]);
                        *(u32x2*)(spn + (size_t)(32 * w + 16 * et + fr) * 128 + 16 * dtl + 4 * fq) = o;
                    }
            }
            LDS_BARRIER();
#pragma unroll
            for (int it = 0; it < 2; ++it) tr_store_pair_scaled<LDRA>(KT, (pg + 8 * it) * 8, s2, rk[it][0], rk[it][1], wk0, wk1);
#pragma unroll
            for (int it = 0; it < 4; ++it) tr_store_pair<LDRA>(VT, (pg + 8 * it) * 8, s2, rv[it][0], rv[it][1]);
            if (step + 1 < nsteps) load_chunk(dir == 0 ? step + 1 : NC - step - 1);
            LDS_BARRIER();
#pragma unroll
            for (int et = 0; et < 2; ++et)
#pragma unroll
                for (int dtl = 0; dtl < 8; ++dtl) acc[et][dtl] = acc[et][dtl] * carry;
#pragma unroll
            for (int ks = 0; ks < 4; ++ks) {
                bf16x8 vf[2];
#pragma unroll
                for (int et = 0; et < 2; ++et) vf[et] = *(const LAS bf16x8*)(VT + (32 * w + 16 * et + fr) * LDRA + 32 * ks + 8 * fq);
#pragma unroll
                for (int dtl = 0; dtl < 8; ++dtl) {
                    const bf16x8 kf = *(const LAS bf16x8*)(KT + (16 * dtl + fr) * LDRA + 32 * ks + 8 * fq);
#pragma unroll
                    for (int et = 0; et < 2; ++et) acc[et][dtl] = __builtin_amdgcn_mfma_f32_16x16x32_bf16(kf, vf[et], acc[et][dtl], 0, 0, 0);
                }
            }
        }
        if (dir == 0) {
            bf16_t* spn = stb + ((size_t)((ebase + NC) * 4 + h) * 2 + dir) * 32768;
#pragma unroll
            for (int et = 0; et < 2; ++et)
#pragma unroll
                for (int dtl = 0; dtl < 8; ++dtl) {
                    u32x2 o; o.x = cvt_pk_bf16(acc[et][dtl][0], acc[et][dtl][1]); o.y = cvt_pk_bf16(acc[et][dtl][2], acc[et][dtl][3]);
                    *(u32x2*)(spn + (size_t)(32 * w + 16 * et + fr) * 128 + 16 * dtl + 4 * fq) = o;
                }
        }
        LDS_BARRIER();
    }
}

__device__ __forceinline__ void ret_pass_b(const Args& a, LAS unsigned char* lds) {
    LAS bf16_t* KL = (LAS bf16_t*)lds;
    LAS bf16_t* BG = KL + 128 * LDR;
    const int tid0 = threadIdx.x;
    const bf16_t* qb = (const bf16_t*)(a.ws + OFF_Q); const bf16_t* kb = (const bf16_t*)(a.ws + OFF_K); const bf16_t* vb = (const bf16_t*)(a.ws + OFF_V);
    const bf16_t* stb = (const bf16_t*)(a.ws + OFF_ST);
    bf16_t* sg = (bf16_t*)a.out;
    u32x4 rk[4], rb[8]; bf16x8 qf[4];
    auto item_info = [&](int item, int& r0, int& h, const bf16_t*& sfp) {
        const int rc = item >> 2; h = item & 3;
        int b, n; if (rc < 512) { b = rc >> 5; n = (rc & 31) + 1; } else { b = 16 + ((rc - 512) >> 4); n = ((rc - 512) & 15) + 1; }
        const int ebase = b < 16 ? b * 33 : 528 + (b - 16) * 17; r0 = rc * 128;
        sfp = stb + ((size_t)((ebase + n) * 4 + h) * 2 + 0) * 32768;
    };
    auto load_item_head = [&](int item, int tid) {
        int r0, h; const bf16_t* sfp; item_info(item, r0, h, sfp);
#pragma unroll
        for (int it = 0; it < 8; ++it) { const int idx = tid + it * 512, e = idx >> 4, pc = idx & 15; rb[it] = *(const u32x4*)(sfp + (size_t)e * 128 + pc * 8); }
    };
    auto load_item_kq = [&](int item, int tid) {
        int r0, h; const bf16_t* sfp; item_info(item, r0, h, sfp);
        const int w = tid >> 6, lane = tid & 63, fr = lane & 15, fq = lane >> 4;
#pragma unroll
        for (int it = 0; it < 4; ++it) { const int idx = tid + it * 512, s = idx >> 4, pc = idx & 15; rk[it] = *(const u32x4*)(kb + (size_t)(r0 + s) * 512 + h * 128 + pc * 8); }
#pragma unroll
        for (int ks = 0; ks < 4; ++ks) qf[ks] = *(const bf16x8*)(qb + (size_t)(r0 + 16 * w + fr) * 512 + h * 128 + 32 * ks + 8 * fq);
    };
    if ((int)blockIdx.x < 2560) { load_item_head(blockIdx.x, tid0); load_item_kq(blockIdx.x, tid0); }
    for (int item = blockIdx.x; item < 2560; item += gridDim.x) {
        int tid = tid0; asm volatile("" : "+v"(tid));
        const int w = tid >> 6, lane = tid & 63, fr = lane & 15, fq = lane >> 4;
        int r0, h; const bf16_t* sfp; item_info(item, r0, h, sfp);
        const bf16_t* sbp = sfp + 32768;
        const float lgf = logsigf_(a.in[14][h]), lgb = logsigf_(a.in[14][4 + h]);
        const int crow = 16 * w + fr;
        LDS_BARRIER();
#pragma unroll
        for (int it = 0; it < 4; ++it) { const int idx = tid + it * 512, s = idx >> 4, pc = idx & 15; *(LAS u32x4*)(KL + s * LDR + pc * 8) = rk[it]; }
#pragma unroll
        for (int it = 0; it < 8; ++it) { const int idx = tid + it * 512, e = idx >> 4, pc = idx & 15; *(LAS u32x4*)(BG + e * LDR + pc * 8) = rb[it]; }
#pragma unroll
        for (int it = 0; it < 8; ++it) { const int idx = tid + it * 512, e = idx >> 4, pc = idx & 15; rb[it] = *(const u32x4*)(sbp + (size_t)e * 128 + pc * 8); }
        LDS_BARRIER();
        f32x4 sacc[8];
#pragma unroll
        for (int st = 0; st < 8; ++st) sacc[st] = (f32x4){0.f, 0.f, 0.f, 0.f};
#pragma unroll
        for (int ks = 0; ks < 4; ++ks)
#pragma unroll
            for (int st = 0; st < 8; ++st) {
                const bf16x8 kf = *(const LAS bf16x8*)(KL + (16 * st + fr) * LDR + 32 * ks + 8 * fq);
                sacc[st] = __builtin_amdgcn_mfma_f32_16x16x32_bf16(kf, qf[ks], sacc[st], 0, 0, 0);
                if (st == 7) __builtin_amdgcn_sched_barrier(0);
            }
        bf16x8 pf[4];
#pragma unroll
        for (int t = 0; t < 4; ++t) {
            float pv[8];
#pragma unroll
            for (int hh = 0; hh < 2; ++hh)
#pragma unroll
                for (int j = 0; j < 4; ++j) {
                    const int spp = 16 * (2 * t + hh) + 4 * fq + j, diff = crow - spp;
                    const float dec = diff >= 0 ? __expf(lgf * (float)diff) : __expf(-lgb * (float)diff);
                    pv[hh * 4 + j] = sacc[2 * t + hh][j] * dec;
                }
            u32x4 pw; pw.x = cvt_pk_bf16(pv[0], pv[1]); pw.y = cvt_pk_bf16(pv[2], pv[3]); pw.z = cvt_pk_bf16(pv[4], pv[5]); pw.w = cvt_pk_bf16(pv[6], pv[7]);
            pf[t] = __builtin_bit_cast(bf16x8, pw);
        }
        f32x4 o[16];
#pragma unroll
        for (int et = 0; et < 16; ++et) o[et] = (f32x4){0.f, 0.f, 0.f, 0.f};
#pragma unroll
        for (int ks = 0; ks < 4; ++ks)
#pragma unroll
            for (int et = 0; et < 16; ++et) {
                const bf16x8 sf = *(const LAS bf16x8*)(BG + (16 * et + fr) * LDR + 32 * ks + 8 * fq);
                o[et] = __builtin_amdgcn_mfma_f32_16x16x32_bf16(sf, qf[ks], o[et], 0, 0, 0);
                if ((et & 7) == 7) __builtin_amdgcn_sched_barrier(0);
            }
        const float wqf = __expf(lgf * (float)(crow + 1)), wqb = __expf(lgb * (float)(128 - crow));
        const float ratio = wqf / wqb;
#pragma unroll
        for (int et = 0; et < 16; ++et) o[et] = o[et] * ratio;
        LDS_BARRIER();
#pragma unroll
        for (int it = 0; it < 8; ++it) { const int idx = tid + it * 512, e = idx >> 4, pc = idx & 15; *(LAS u32x4*)(BG + e * LDR + pc * 8) = rb[it]; }
        {
            const int s2 = 2 * (8 * w + (lane & 7));
#pragma unroll
            for (int it = 0; it < 4; ++it)
#pragma unroll
                for (int r = 0; r < 2; ++r) rb[it * 2 + r] = *(const u32x4*)(vb + (size_t)(r0 + s2 + r) * 1024 + h * 256 + ((lane >> 3) + 8 * it) * 8);
        }
        LDS_BARRIER();
#pragma unroll
        for (int ks = 0; ks < 4; ++ks)
#pragma unroll
            for (int et = 0; et < 16; ++et) {
                const bf16x8 sf = *(const LAS bf16x8*)(BG + (16 * et + fr) * LDR + 32 * ks + 8 * fq);
                o[et] = __builtin_amdgcn_mfma_f32_16x16x32_bf16(sf, qf[ks], o[et], 0, 0, 0);
                if ((et & 7) == 7) __builtin_amdgcn_sched_barrier(0);
            }
#pragma unroll
        for (int et = 0; et < 16; ++et) o[et] = o[et] * wqb;
        LDS_BARRIER();
#pragma unroll
        for (int it = 0; it < 4; ++it) tr_store_pair<LDR>(BG, ((lane >> 3) + 8 * it) * 8, 2 * (8 * w + (lane & 7)), rb[it * 2], rb[it * 2 + 1]);
        if (item + (int)gridDim.x < 2560) load_item_head(item + gridDim.x, tid);
        LDS_BARRIER();
#pragma unroll
        for (int t = 0; t < 4; ++t)
#pragma unroll
            for (int et = 0; et < 16; ++et) {
                const u32x2 lo = *(const LAS u32x2*)(BG + (16 * et + fr) * LDR + 32 * t + 4 * fq);
                const u32x2 hi = *(const LAS u32x2*)(BG + (16 * et + fr) * LDR + 32 * t + 16 + 4 * fq);
                const u32x4 vw = (u32x4){lo.x, lo.y, hi.x, hi.y};
                o[et] = __builtin_amdgcn_mfma_f32_16x16x32_bf16(__builtin_bit_cast(bf16x8, vw), pf[t], o[et], 0, 0, 0);
                if ((et & 7) == 7) __builtin_amdgcn_sched_barrier(0);
            }
        float ss = 0.f;
#pragma unroll
        for (int et = 0; et < 16; ++et) ss += (o[et][0] * o[et][0] + o[et][1] * o[et][1]) + (o[et][2] * o[et][2] + o[et][3] * o[et][3]);
        ss += __shfl_xor(ss, 16); ss += __shfl_xor(ss, 32);
        const float rn = rsqrtf(ss * (1.0f / 256.0f) + EPS);
        bf16_t* gp = sg + (size_t)(r0 + crow) * 1024 + h * 256 + 4 * fq;
        u32x2 gwv[16];
#pragma unroll
        for (int et = 0; et < 16; ++et) gwv[et] = *(const u32x2*)(gp + 16 * et);
        if (item + (int)gridDim.x < 2560) load_item_kq(item + gridDim.x, tid);
#pragma unroll
        for (int et = 0; et < 16; ++et) {
            const u32x2 gw = gwv[et];
            u32x2 ow; ow.x = cvt_pk_bf16(o[et][0] * rn * bflo(gw.x), o[et][1] * rn * bfhi(gw.x)); ow.y = cvt_pk_bf16(o[et][2] * rn * bflo(gw.y), o[et][3] * rn * bfhi(gw.y));
            *(u32x2*)(gp + 16 * et) = ow;
        }
    }
    LDS_BARRIER();
}

__device__ __forceinline__ void final_norm(const Args& a) {
    const int wave = threadIdx.x >> 6, lane = threadIdx.x & 63;
    const float* ssq = (const float*)(a.ws + OFF_SSQ2);
    f32x4 gg[4];
#pragma unroll
    for (int j = 0; j < 4; ++j) gg[j] = *(const f32x4*)(a.in[20] + (j * 64 + lane) * 4);
    for (int rowb = (blockIdx.x * 8 + wave) * 4; rowb < NREAL; rowb += gridDim.x * 32) {
        float part[4]; u32x2 w[4][4];
#pragma unroll
        for (int q = 0; q < 4; ++q) {
            part[q] = lane < 16 ? ssq[(size_t)(rowb + q) * 16 + lane] : 0.f;
            const bf16_t* hrow = (const bf16_t*)(a.ws + OFF_H1B) + (size_t)(rowb + q) * 1024;
#pragma unroll
            for (int j = 0; j < 4; ++j) w[q][j] = *(const u32x2*)(hrow + (j * 64 + lane) * 4);
        }
#pragma unroll
        for (int q = 0; q < 4; ++q) {
            const float rstd = rsqrtf(wave_sum(part[q]) * (1.0f / 1024.0f) + EPS);
            float* orow = a.out + (size_t)(rowb + q) * 1024;
#pragma unroll
            for (int j = 0; j < 4; ++j) {
                f32x4 v;
                v[0] = bflo(w[q][j].x) * rstd * gg[j][0]; v[1] = bfhi(w[q][j].x) * rstd * gg[j][1]; v[2] = bflo(w[q][j].y) * rstd * gg[j][2]; v[3] = bfhi(w[q][j].y) * rstd * gg[j][3];
                *(f32x4*)(orow + (j * 64 + lane) * 4) = v;
            }
        }
    }
}

template <int ph>
__device__ __forceinline__ void run_phase(const Args& a, LAS unsigned char* lds) {
    unsigned char* ws = a.ws;
    bf16_t* dob = (bf16_t*)a.out;
    bf16_t* sgp = dob; bf16_t* gap = dob + (size_t)NREAL * 1024;
#ifdef ONLY_PH
    if (ph != ONLY_PH) return;
#endif
    switch (ph) {
    case 0: phase0(a, lds); break;
    case 1: {
        pg8::Gemm g{(const bf16_t*)(ws + OFF_N1), (const bf16_t*)(ws + OFF_WIN), 1024, 1024, 1024, RPAD / 256, INW / 256, 1, 0, 0, STG};
        EpiProj E{(bf16_t*)(ws + OFF_U5), (bf16_t*)(ws + OFF_Q), (bf16_t*)(ws + OFF_K), (bf16_t*)(ws + OFF_V), sgp, gap, (bf16_t*)(ws + OFF_GB), (const LAS float*)(lds + 131072)};
        pg8::gemm_phase(lds, g, E);
        constexpr int T_FFI = 88 * 16 / 2, T_FFO = 16 * 44 / 2, FIRST = (RPAD / 256) * (INW / 256) - 27 * 256;
        const int nblk = (int)gridDim.x, first = nblk == 256 ? FIRST : 0;
        if ((int)blockIdx.x >= first) {
            __syncthreads();
            for (int r = (int)blockIdx.x - first; r < T_FFI + T_FFO; r += nblk - first) {
                if (r < T_FFI) p0_wtile(a.in[18], 1024, INW, (bf16_t*)(ws + OFF_WFFI), 3, a.in[17], r, (LAS float*)lds);
                else p0_wtile(a.in[19], DFF, 1024, (bf16_t*)(ws + OFF_WFFO), 0, nullptr, r - T_FFI, (LAS float*)lds);
            }
        }
    } break;
    case 2: {
        pg8::Gemm g{(const bf16_t*)(ws + OFF_U5), (const bf16_t*)(ws + OFF_BTS), LDA5, 512, 512, IT_PAD / 256, 1, 32, (size_t)IT_PAD * LDA5, (size_t)256 * 512, 0};
        EpiSloc E{(float*)(ws + OFF_SLOC)};
        pg8::gemm_phase(lds, g, E);
    } break;
    case 3: s5_scan(a); break;
    case 4: {
        pg8::Gemm g{(const bf16_t*)(ws + OFF_U5), (const bf16_t*)(ws + OFF_BTY), LDA5, 768, 768, IT_PAD / 256, 2, 32, (size_t)IT_PAD * LDA5, (size_t)512 * 768, 0};
        EpiY E{(bf16_t*)(ws + OFF_YSSM)};
        pg8::gemm_phase(lds, g, E);
    } break;
    case 5: {
        ret_pass_a(a, lds);
        const int bx = (int)blockIdx.x, sub = bx >= 192 ? bx - 192 : (bx >= 128 ? bx - 128 : 0);
        const int u0 = bx >= 192 ? 0 : (bx >= 128 ? GLU_SPLIT : GLU_SPLIT2), u1 = bx >= 192 ? GLU_SPLIT : GLU_SPLIT2;
        pg8::Gemm g{(const bf16_t*)(ws + OFF_YSSM), (const bf16_t*)(ws + OFF_WGLU), 512, 512, 512, NREAL / 256, 8, 1, 0, 0, STG, 64, sub, u0, u1};
        EpiGlu E{gap};
        pg8::gemm_phase(lds, g, E);
    } break;
    case 6: {
        pg8::Gemm g{(const bf16_t*)(ws + OFF_YSSM), (const bf16_t*)(ws + OFF_WGLU), 512, 512, 512, NREAL / 256, 8, 1, 0, 0, STG, (int)gridDim.x, (int)blockIdx.x, GLU_SPLIT2, 2560};
        EpiGlu E{gap};
        pg8::gemm_phase(lds, g, E);
    } break;
    case 7: ret_pass_b(a, lds); break;
    case 8: {
        pg8::Gemm g{sgp, (const bf16_t*)(ws + OFF_WRET), 1024, 1024, 1024, NREAL / 256, 4, 1, 0, 0, STG};
        EpiRet E{gap, (const bf16_t*)(ws + OFF_GB), (bf16_t*)(ws + OFF_MIXED)};
        pg8::gemm_phase(lds, g, E);
    } break;
    case 9: {
        pg8::Gemm g{(const bf16_t*)(ws + OFF_MIXED), (const bf16_t*)(ws + OFF_WOUT), 1024, 1024, 1024, NREAL / 256, 4, 1, 0, 0, STG};
        EpiRes<0> E{a.in[0], a.in[1], (bf16_t*)(ws + OFF_H1B), (float*)(ws + OFF_SSQ1)};
        pg8::gemm_phase(lds, g, E);
    } break;
    case 10: {
        pg8::Gemm g{(const bf16_t*)(ws + OFF_H1B), (const bf16_t*)(ws + OFF_WFFI), 1024, 1024, 1024, NREAL / 256, INW / 256, 1, 0, 0, STG};
        EpiFfi E{(const float*)(ws + OFF_SSQ1), (bf16_t*)(ws + OFF_ACT)};
        pg8::gemm_phase(lds, g, E);
    } break;
    case 11: {
        pg8::Gemm g{(const bf16_t*)(ws + OFF_ACT), (const bf16_t*)(ws + OFF_WFFO), DFF, DFF, DFF, NREAL / 256, 4, 1, 0, 0, STG};
        EpiRes<1> E{nullptr, nullptr, (bf16_t*)(ws + OFF_H1B), (float*)(ws + OFF_SSQ2)};
        pg8::gemm_phase(lds, g, E);
    } break;
    case 12: final_norm(a); break;
    default: break;
    }
}

#define XB_TMO      128
#define XB_XCNT(j)  (256  + 64 * (j))
#define XB_XSUB(j)  (1280 + 64 * (j))
#define XB_XGEN(j)  (2304 + 64 * (j))
#define XB_TOP      3328
#define XB_TOPGEN   3392
#define XCD_BAR_WORDS 3456
#define XB_SPIN_CAP (1u << 18)

__device__ __forceinline__ unsigned xb_ld(unsigned* p)              { return __hip_atomic_load(p, __ATOMIC_RELAXED, __HIP_MEMORY_SCOPE_AGENT); }
__device__ __forceinline__ unsigned xb_add(unsigned* p, unsigned v) { return __hip_atomic_fetch_add(p, v, __ATOMIC_RELAXED, __HIP_MEMORY_SCOPE_AGENT); }
__device__ __forceinline__ unsigned xb_xcc_id() { return (unsigned)__builtin_amdgcn_s_getreg((3 << 11) | 20) & 0xFu; }
#define XB_SPIN(cond, bar) do { unsigned _sp = 0; while (cond) { __builtin_amdgcn_s_sleep(1); \
    if ((++_sp & 255u) == 0u) { if (xb_ld(&(bar)[XB_TMO])) break; if (_sp > XB_SPIN_CAP) { atomicAdd(&(bar)[XB_TMO], 1u); break; } } } } while (0)

struct XcdBarrier {
    unsigned* bar; unsigned x;
    volatile LAS unsigned* st;
};

__device__ __forceinline__ XcdBarrier xcd_barrier_post(unsigned* bar, volatile LAS unsigned* st) {
    XcdBarrier b; b.bar = bar; b.x = xb_xcc_id(); b.st = st;
    if (threadIdx.x == 0) (void)xb_add(&bar[XB_XCNT(b.x)], 1u);
    return b;
}
__device__ __forceinline__ void xcd_barrier_complete(unsigned* bar, unsigned x, unsigned& nloc, unsigned& nx) {
    const unsigned G = gridDim.x * gridDim.y * gridDim.z;
    unsigned sum, cnt, mine, sp = 0u;
    for (;;) {
        sum = 0u; cnt = 0u; mine = 0u;
#pragma unroll
        for (unsigned j = 0; j < 16; ++j) { const unsigned c = xb_ld(&bar[XB_XCNT(j)]); sum += c; cnt += (c > 0u) ? 1u : 0u; mine = (j == x) ? c : mine; }
        if (sum == G) break;
        __builtin_amdgcn_s_sleep(1);
        if ((++sp & 255u) == 0u) { if (xb_ld(&bar[XB_TMO])) break; if (sp > XB_SPIN_CAP) { atomicAdd(&bar[XB_TMO], 1u); break; } }
    }
    nloc = mine > 0u ? mine : 1u; nx = cnt > 0u ? cnt : 1u;
}

__device__ __forceinline__ void xcd_barrier(const XcdBarrier& b) {
    asm volatile("s_waitcnt vmcnt(0)" ::: "memory");
    __syncthreads();
    if (threadIdx.x == 0) {
        unsigned* bar = b.bar;
        __builtin_amdgcn_s_waitcnt(0);
        unsigned nloc = b.st[0], nx = b.st[1];
        if (nloc == 0u) { xcd_barrier_complete(bar, b.x, nloc, nx); b.st[0] = nloc; b.st[1] = nx; }
        const unsigned old = xb_add(&bar[XB_XSUB(b.x)], 1u);
        const unsigned gen = old / nloc;
        if (old + 1u == (gen + 1u) * nloc) {
            __builtin_amdgcn_fence(__ATOMIC_RELEASE, "agent");
            asm volatile("s_waitcnt vmcnt(0)" ::: "memory");
            const unsigned og = xb_add(&bar[XB_TOP], 1u);
            const unsigned tg = og / nx;
            if (og + 1u == (tg + 1u) * nx) xb_add(&bar[XB_TOPGEN], 1u);
            else XB_SPIN(xb_ld(&bar[XB_TOPGEN]) == tg, bar);
            __builtin_amdgcn_fence(__ATOMIC_ACQUIRE, "agent");
            xb_add(&bar[XB_XGEN(b.x)], 1u);
            asm volatile("s_waitcnt vmcnt(0)" ::: "memory");
        } else {
            XB_SPIN(xb_ld(&bar[XB_XGEN(b.x)]) == gen, bar);
            __builtin_amdgcn_fence(__ATOMIC_ACQUIRE, "agent");
            asm volatile("s_waitcnt vmcnt(0)" ::: "memory");
        }
    }
    __syncthreads();
}


__device__ __forceinline__ void grid_barrier(unsigned* ctr, unsigned target) {
    asm volatile("s_waitcnt vmcnt(0) lgkmcnt(0)" ::: "memory");
    __syncthreads();
    if (threadIdx.x == 0) {
        __builtin_amdgcn_fence(__ATOMIC_RELEASE, "agent");
        asm volatile("s_waitcnt vmcnt(0)" ::: "memory");
        __hip_atomic_fetch_add(ctr, 1u, __ATOMIC_RELAXED, __HIP_MEMORY_SCOPE_AGENT);
        unsigned spins = 0;
        while (__hip_atomic_load(ctr, __ATOMIC_RELAXED, __HIP_MEMORY_SCOPE_AGENT) < target && ++spins < (1u << 24)) __builtin_amdgcn_s_sleep(2);
        __builtin_amdgcn_fence(__ATOMIC_ACQUIRE, "agent");
        asm volatile("s_waitcnt vmcnt(0)" ::: "memory");
    }
    __syncthreads();
}

template <bool COOP>
__global__ __launch_bounds__(512, 2) void fwd_kernel(Args a) {
    extern __shared__ __attribute__((aligned(16))) unsigned char shm[];
    LAS unsigned char* lds = (LAS unsigned char*)shm;
    if (threadIdx.x < 64) {
        const double rd = exp2(-(double)threadIdx.x * (13.287712379549449 / 64.0)) * 0.15915494309189535;
        const float hi = __uint_as_float(__float_as_uint((float)rd) & 0xFFFFE000u), lo = (float)(rd - (double)hi);
        ((LAS float*)(lds + 131072))[2 * threadIdx.x] = hi; ((LAS float*)(lds + 131072))[2 * threadIdx.x + 1] = lo;
    }
    volatile LAS unsigned* xst = (volatile LAS unsigned*)(lds + 131072 + 528);
    if (threadIdx.x == 0) { xst[0] = 0u; xst[1] = 0u; }
    __syncthreads();
    XcdBarrier xb{}; if (COOP) xb = xcd_barrier_post((unsigned*)(a.ws + OFF_BAR), xst);
    if (COOP && a.ph_hi > NPHASE) cg::this_grid().sync();
#define RUN_PH(P) if (a.ph_lo <= P && P < a.ph_hi) { run_phase<P>(a, lds); if ((DBL_MASK >> P) & 1) run_phase<P>(a, lds); if (COOP && P + 1 < a.ph_hi) { xcd_barrier(xb); } }
    RUN_PH(0) RUN_PH(1) RUN_PH(2) RUN_PH(3) RUN_PH(4) RUN_PH(5) RUN_PH(6) RUN_PH(7) RUN_PH(8) RUN_PH(9) RUN_PH(10) RUN_PH(11) RUN_PH(12)
#undef RUN_PH
}

extern "C" void kernel_launch(void* const* d_in, const int* in_sizes, int n_in, void* d_out, int out_size, void* d_ws, size_t ws_size, hipStream_t stream) {
    static int grid = 0;
    if (grid == 0) {
        if (n_in != 21 || ws_size < WS_NEED || out_size != NREAL * 1024) { fprintf(stderr, "kernel_launch: unexpected shapes (n_in %d, ws %zu need %zu, out %d)\n", n_in, ws_size, (size_t)WS_NEED, out_size); grid = -1; return; }
        int dev = 0, cus = 0;
        hipGetDevice(&dev); hipDeviceGetAttribute(&cus, hipDeviceAttributeMultiprocessorCount, dev);
        hipFuncSetAttribute((const void*)fwd_kernel<true>, hipFuncAttributeMaxDynamicSharedMemorySize, LDS_BYTES);
#if !COOP_MODE
        hipFuncSetAttribute((const void*)fwd_kernel<false>, hipFuncAttributeMaxDynamicSharedMemorySize, LDS_BYTES);
#endif
        int per_cu = 0;
        hipOccupancyMaxActiveBlocksPerMultiprocessor(&per_cu, (const void*)fwd_kernel<true>, 512, LDS_BYTES);
        if (per_cu < 1) { fprintf(stderr, "kernel_launch: occupancy query says %d blocks per CU\n", per_cu); per_cu = 1; }
        (void)hipGetLastError();
        grid = cus * 1;
    }
    if (grid < 0) return;
    Args a{};
    for (int i = 0; i < 21; ++i) a.in[i] = (const float*)d_in[i];
    a.out = (float*)d_out; a.ws = (unsigned char*)d_ws;
#if COOP_MODE
    hipMemsetAsync((char*)d_ws + OFF_BAR, 0, 4096 * 4 + 256, stream);
    a.ph_lo = 0; a.ph_hi = NPHASE;
    void* args[] = {&a};
    hipError_t e = hipLaunchCooperativeKernel((const void*)fwd_kernel<true>, dim3(grid), dim3(512), args, LDS_BYTES, stream);
    if (e != hipSuccess) fprintf(stderr, "cooperative launch failed: %s (grid %d)\n", hipGetErrorString(e), grid);
#else
    for (int ph = 0; ph < NPHASE; ++ph) {
        a.ph_lo = ph; a.ph_hi = ph + 1;
        hipLaunchKernelGGL(fwd_kernel<false>, dim3(grid), dim3(512), LDS_BYTES, stream, a);
    }
#endif
}
```

```cpp
#include <hip/hip_runtime.h>
#include <hip/hip_cooperative_groups.h>
#include <cstdio>
#include <cstdint>
namespace cg = cooperative_groups;

#ifndef COOP_MODE
#define COOP_MODE 1
#endif

#define DBL_MASK 0x0
#define LAS __attribute__((address_space(3)))
typedef unsigned short bf16_t;
typedef short bf16x8 __attribute__((ext_vector_type(8)));
typedef float f32x4 __attribute__((ext_vector_type(4)));
typedef unsigned u32x4 __attribute__((ext_vector_type(4)));
typedef unsigned u32x2 __attribute__((ext_vector_type(2)));

constexpr int D = 1024, NREAL = 81920, NPR = 65536, RPAD = 82432, NVALID = 82304;
constexpr int INW = 5632, DFF = 2816;
constexpr int T5 = 32, IT_REAL = 2560, IT_PAD = 2816, LDA5 = 768;
constexpr float EPS = 1e-6f;

constexpr size_t OFF_WIN = 0;
constexpr size_t OFF_WGLU = OFF_WIN + (size_t)INW * D * 2;
constexpr size_t OFF_WRET = OFF_WGLU + (size_t)2048 * 512 * 2;
constexpr size_t OFF_WOUT = OFF_WRET + (size_t)D * D * 2;
constexpr size_t OFF_WFFI = OFF_WOUT + (size_t)D * D * 2;
constexpr size_t OFF_WFFO = OFF_WFFI + (size_t)INW * D * 2;
constexpr size_t OFF_AT = OFF_WFFO + (size_t)D * DFF * 2;
constexpr size_t OFF_BAR = OFF_AT + 32768;
constexpr size_t OFF_Q = OFF_AT + 65536;
constexpr size_t OFF_K = OFF_Q + (size_t)RPAD * 512 * 2;
constexpr size_t OFF_V = OFF_K + (size_t)RPAD * 512 * 2;
constexpr size_t OFF_GB = OFF_V + (size_t)RPAD * D * 2;
constexpr size_t OFF_SSQ1 = OFF_GB + (size_t)NREAL * D * 2;
constexpr size_t OFF_SSQ2 = OFF_SSQ1 + (size_t)NREAL * 16 * 4;
constexpr size_t OFF_X = OFF_SSQ2 + (size_t)NREAL * 16 * 4;
constexpr size_t OFF_N1 = OFF_X;
constexpr size_t OFF_YSSM = OFF_X + (size_t)664 * 8 * 65536;
constexpr size_t OFF_U5 = OFF_N1 + (size_t)RPAD * D * 2;
constexpr size_t OFF_BTY = OFF_U5 + (size_t)32 * IT_PAD * LDA5 * 2;
constexpr size_t OFF_BTS = OFF_BTY + (size_t)32 * 512 * 768 * 2;
constexpr size_t OFF_SLOC = OFF_BTS + (size_t)32 * 256 * 512 * 2;
constexpr size_t END_X03 = OFF_SLOC + (size_t)32 * IT_PAD * 256 * 4;
constexpr size_t OFF_ST = OFF_X;
constexpr size_t END_ST = OFF_ST + (size_t)664 * 8 * 65536;
constexpr size_t OFF_ACT = OFF_X;
constexpr size_t END_ACT = OFF_ACT + (size_t)NREAL * DFF * 2;
constexpr size_t OFF_MIXED = OFF_Q;
constexpr size_t OFF_H1B = OFF_V;
constexpr size_t cmax(size_t a, size_t b) { return a > b ? a : b; }
constexpr size_t WS_NEED = cmax(END_X03, cmax(END_ST, END_ACT));

constexpr int LDS_BYTES = 131072 + 1024;
constexpr int NPHASE = 13;
constexpr int GLU_SPLIT = 64 * 14, GLU_SPLIT2 = GLU_SPLIT + 64 * 6;
constexpr int STG = 0;

struct Args {
    const float* in[21];
    float* out;
    unsigned char* ws;
    int ph_lo, ph_hi;
};

__device__ __forceinline__ unsigned cvt_pk_bf16(float lo, float hi) { unsigned r; asm volatile("v_cvt_pk_bf16_f32 %0, %1, %2" : "=v"(r) : "v"(lo), "v"(hi)); return r; }
__device__ __forceinline__ bf16_t f2bf(float f) { return (bf16_t)(cvt_pk_bf16(f, 0.f) & 0xFFFFu); }
__device__ __forceinline__ float bf2f(bf16_t h) { return __uint_as_float(((unsigned)h) << 16); }
__device__ __forceinline__ float bflo(unsigned w) { return __uint_as_float(w << 16); }
__device__ __forceinline__ float bfhi(unsigned w) { return __uint_as_float(w & 0xFFFF0000u); }
__device__ __forceinline__ float sigmoidf_(float x) { return __builtin_amdgcn_rcpf(1.0f + __builtin_amdgcn_exp2f(-1.4426950408889634f * x)); }
__device__ __forceinline__ float siluf_(float x) { return x * sigmoidf_(x); }
__device__ __forceinline__ float gelu_tanh(float x) { const float z = 0.7978845608028654f * (x + 0.044715f * x * x * x); return x * sigmoidf_(2.0f * z); }
__device__ __forceinline__ float logsigf_(float x) { return fminf(x, 0.f) - log1pf(__expf(-fabsf(x))); }
__device__ __forceinline__ float wave_sum(float v) {
#pragma unroll
    for (int o = 1; o < 64; o <<= 1) v += __shfl_xor(v, o);
    return v;
}
__device__ __forceinline__ void sincos_rev(double ang, float& s, float& c) {
    double x = ang * 0.15915494309189535; x -= rint(x);
    const float xf = (float)x;
    s = __builtin_amdgcn_sinf(xf); c = __builtin_amdgcn_cosf(xf);
}

namespace pg8 {
constexpr int BM = 256, BK = 64, HALF = 128, HTB = HALF * BK * 2, STAGE_BYTES = 8 * HTB, NXCD = 8, WGM = 8;
__device__ __forceinline__ int lds_byte(int r, int c) { const int st = (r >> 4) * 2 + (c >> 5), rr = r & 15, cc = c & 31, ob = rr * 64 + cc * 2; return st * 1024 + (ob ^ (((ob >> 9) & 1) << 5)); }
__device__ __forceinline__ void stage_rc(int b, int& R, int& C) { const int st = b / 1024, sb = b % 1024, swz = sb ^ (((sb >> 9) & 1) << 5); R = (st >> 1) * 16 + swz / 64; C = (st & 1) * 32 + (swz % 64) / 2; }
__device__ __forceinline__ int perm32(int rho) { const int n = rho >> 4, i = rho & 15; return 8 * (i >> 2) + 4 * n + (i & 3); }

struct Unit { int pm, pn, g; };
struct Gemm { const bf16_t* A; const bf16_t* Bt; int lda, ldb, K, nM, nN, nb; size_t sA, sB; int stagger; int G, c, u0, u1; };

struct Order {
    int nM, nN, nwg, total, G, c, u0;
    __device__ void init(int nM_, int nN_, int nb, int G_, int c_, int u0_, int u1_) { nM = nM_; nN = nN_; nwg = nM * nN; total = u1_ > 0 ? u1_ : nwg * nb; G = G_; c = c_; u0 = u0_; }
    __device__ bool next(int i, Unit& u) const {
        const long L = (long)u0 + (long)i * G + c; if (L >= total) return false;
        u.g = (int)(L / nwg); int wgid = (int)(L % nwg);
        { const int q = nwg / NXCD, r = nwg % NXCD, xcd = wgid % NXCD, off = wgid / NXCD; wgid = (xcd < r ? xcd * (q + 1) : r * (q + 1) + (xcd - r) * q) + off; }
        const int nig = WGM * nN, gid = wgid / nig, fm = gid * WGM, gsz = (nM - fm) < WGM ? (nM - fm) : WGM;
        u.pm = fm + ((wgid % nig) % gsz); u.pn = (wgid % nig) / gsz; return true;
    }
};

template <class Epi>
__device__ __forceinline__ void gemm_phase(LAS unsigned char* lds, const Gemm g, const Epi& E) {
    const int tid = threadIdx.x, wid = __builtin_amdgcn_readfirstlane(tid >> 6), lane = tid & 63, wr = wid >> 2, wc = wid & 3, fr = lane & 15, fq = lane >> 4;
    const int K = g.K, nt = K / BK;
    Order S; S.init(g.nM, g.nN, g.nb, g.G > 0 ? g.G : (int)gridDim.x, g.G > 0 ? g.c : (int)blockIdx.x, g.u0, g.u1);
    unsigned voffA[2], voffB[2];
#pragma unroll
    for (int i = 0; i < 2; ++i) { int R, C; stage_rc(tid * 16 + i * 8192, R, C); const int Rb = (R & ~31) + perm32(R & 31);
        voffA[i] = (unsigned)(R * g.lda + C) * 2u; voffB[i] = (unsigned)(Rb * g.ldb + C) * 2u; }
    const size_t kstep = (size_t)(BK * 2);
    const size_t hstepA = (size_t)HALF * g.lda * 2, hstepB = (size_t)HALF * g.ldb * 2;
    const size_t tstepA = 2 * hstepA, tstepB = 2 * hstepB;
    const unsigned ldsw = (unsigned)wid * 1024u;
    const int aoff = lds_byte(wr * 64 + fr, fq * 8), boff = lds_byte(wc * 32 + fr, fq * 8);
#define PG8_SA(b, h) (((b) * 2 + (h)) * HTB)
#define PG8_SB(b, h) ((4 + (b) * 2 + (h)) * HTB)
#define PG8_STAGE(bufoff, gbase, voff) do { _Pragma("unroll") for (int _i = 0; _i < 2; ++_i) \
        __builtin_amdgcn_global_load_lds((const unsigned*)((const char*)(gbase) + (voff)[_i]), (LAS unsigned*)(lds + (bufoff) + ldsw + _i * 8192), 16, 0, 0); } while (0)
#define PG8_LDA(dst, b, h) do { _Pragma("unroll") for (int m = 0; m < 4; ++m) _Pragma("unroll") for (int k = 0; k < 2; ++k) dst[m][k] = *(const LAS bf16x8*)(lds + PG8_SA(b, h) + aoff + m * 2048 + k * 1024); } while (0)
#define PG8_LDB(dst, b, h) do { _Pragma("unroll") for (int n = 0; n < 2; ++n) _Pragma("unroll") for (int k = 0; k < 2; ++k) dst[n][k] = *(const LAS bf16x8*)(lds + PG8_SB(b, h) + boff + n * 2048 + k * 1024); } while (0)
#define PG8_MMA(ai, bj, At, Bt) do { __builtin_amdgcn_s_setprio(1); _Pragma("unroll") for (int m = 0; m < 4; ++m) _Pragma("unroll") for (int n = 0; n < 2; ++n) _Pragma("unroll") for (int k = 0; k < 2; ++k) \
        acc[ai][bj][m][n] = __builtin_amdgcn_mfma_f32_16x16x32_bf16(Bt[n][k], At[m][k], acc[ai][bj][m][n], 0, 0, 0); __builtin_amdgcn_s_setprio(0); } while (0)
#define PG8_WAIT_V(n) asm volatile("s_waitcnt vmcnt(" #n ")" ::: "memory")
#define PG8_WAIT_L(n) asm volatile("s_waitcnt lgkmcnt(" #n ")" ::: "memory")
#define PG8_BAR __builtin_amdgcn_s_barrier()
#define PG8_SCHED __builtin_amdgcn_sched_barrier(0)
    Unit cur, nxt; int ui = 0;
    if (!S.next(0, cur)) return;
    if (g.stagger) {
        const unsigned long long t0 = __builtin_amdgcn_s_memrealtime(), wt = (unsigned long long)((blockIdx.x & 3) * g.stagger);
        while (__builtin_amdgcn_s_memrealtime() - t0 < wt) __builtin_amdgcn_s_sleep(16);
    }
    f32x4 acc[2][2][4][2];
#pragma unroll
    for (int a = 0; a < 2; ++a)
#pragma unroll
        for (int b = 0; b < 2; ++b)
#pragma unroll
            for (int m = 0; m < 4; ++m)
#pragma unroll
                for (int n = 0; n < 2; ++n) acc[a][b][m][n] = (f32x4){0.f, 0.f, 0.f, 0.f};
    bf16x8 At[4][2], B0[2][2], B1[2][2];
    const char* cA = (const char*)g.A + ((size_t)cur.g * g.sA) * 2 + (size_t)cur.pm * tstepA;
    const char* cB = (const char*)g.Bt + ((size_t)cur.g * g.sB) * 2 + (size_t)cur.pn * tstepB;
    PG8_STAGE(PG8_SB(0, 0), cB, voffB); PG8_STAGE(PG8_SA(0, 0), cA, voffA); PG8_STAGE(PG8_SB(0, 1), cB + hstepB, voffB); PG8_STAGE(PG8_SA(0, 1), cA + hstepA, voffA);
    if (wr == 1) PG8_BAR;
    PG8_WAIT_V(4); PG8_BAR;
    PG8_STAGE(PG8_SB(1, 0), cB + kstep, voffB); PG8_STAGE(PG8_SA(1, 0), cA + kstep, voffA); PG8_STAGE(PG8_SB(1, 1), cB + hstepB + kstep, voffB);
    PG8_WAIT_V(6); PG8_BAR;
    for (;;) {
        const bool has_next = S.next(ui + 1, nxt);
        const char* nA = has_next ? (const char*)g.A + ((size_t)nxt.g * g.sA) * 2 + (size_t)nxt.pm * tstepA : cA;
        const char* nB = has_next ? (const char*)g.Bt + ((size_t)nxt.g * g.sB) * 2 + (size_t)nxt.pn * tstepB : cB;
        for (int t = 0; t < nt; t += 2) {
            const bool last = (t == nt - 2);
            const char* a1 = cA + (size_t)(t + 1) * kstep;
            const char* a2 = last ? nA : cA + (size_t)(t + 2) * kstep; const char* b2 = last ? nB : cB + (size_t)(t + 2) * kstep;
            const char* a3 = a2 + kstep; const char* b3 = b2 + kstep;
            PG8_LDB(B0, 0, 0); PG8_SCHED; PG8_LDA(At, 0, 0); PG8_STAGE(PG8_SA(1, 1), a1 + hstepA, voffA);
            PG8_WAIT_L(8); PG8_BAR; PG8_WAIT_L(0); PG8_MMA(0, 0, At, B0); PG8_BAR; PG8_SCHED;
            PG8_LDB(B1, 0, 1); PG8_STAGE(PG8_SB(0, 0), b2, voffB);
            PG8_BAR; PG8_WAIT_L(0); PG8_MMA(0, 1, At, B1); PG8_BAR;
            PG8_LDA(At, 0, 1); PG8_STAGE(PG8_SA(0, 0), a2, voffA);
            PG8_BAR; PG8_WAIT_L(0); PG8_MMA(1, 0, At, B0); PG8_BAR; PG8_SCHED;
            PG8_STAGE(PG8_SB(0, 1), b2 + hstepB, voffB);
            PG8_WAIT_V(6); PG8_BAR; PG8_MMA(1, 1, At, B1); PG8_BAR;
            PG8_LDB(B0, 1, 0); PG8_SCHED; PG8_LDA(At, 1, 0); PG8_STAGE(PG8_SA(0, 1), a2 + hstepA, voffA);
            PG8_WAIT_L(8); PG8_BAR; PG8_WAIT_L(0); PG8_MMA(0, 0, At, B0); PG8_BAR; PG8_SCHED;
            PG8_LDB(B1, 1, 1); PG8_STAGE(PG8_SB(1, 0), b3, voffB);
            PG8_BAR; PG8_WAIT_L(0); PG8_MMA(0, 1, At, B1); PG8_BAR;
            PG8_LDA(At, 1, 1); PG8_STAGE(PG8_SA(1, 0), a3, voffA);
            PG8_BAR; PG8_WAIT_L(0); PG8_MMA(1, 0, At, B0); PG8_BAR; PG8_SCHED;
            PG8_STAGE(PG8_SB(1, 1), b3 + hstepB, voffB);
            PG8_WAIT_V(6); PG8_BAR; PG8_MMA(1, 1, At, B1); PG8_BAR;
        }
        E(acc, cur, wr, wc, fr, fq);
        if (!has_next) break;
#pragma unroll
        for (int a = 0; a < 2; ++a)
#pragma unroll
            for (int b = 0; b < 2; ++b)
#pragma unroll
                for (int m = 0; m < 4; ++m)
#pragma unroll
                    for (int n = 0; n < 2; ++n) acc[a][b][m][n] = (f32x4){0.f, 0.f, 0.f, 0.f};
        cur = nxt; cA = nA; cB = nB; ++ui;
    }
    PG8_WAIT_V(0);
    if (wr == 0) PG8_BAR;
    PG8_BAR;
#undef PG8_SA
#undef PG8_SB
#undef PG8_STAGE
#undef PG8_LDA
#undef PG8_LDB
#undef PG8_MMA
#undef PG8_WAIT_V
#undef PG8_WAIT_L
#undef PG8_BAR
#undef PG8_SCHED
}
}
using pg8::Unit;
typedef const f32x4 (&AccRef)[2][2][4][2];

__device__ __forceinline__ u32x4 pack8(f32x4 a, f32x4 b) { u32x4 w; w.x = cvt_pk_bf16(a[0], a[1]); w.y = cvt_pk_bf16(a[2], a[3]); w.z = cvt_pk_bf16(b[0], b[1]); w.w = cvt_pk_bf16(b[2], b[3]); return w; }

struct EpiProj {
    bf16_t *u5, *q, *k, *v, *sg, *ga, *gb; const LAS float* ropef;
    __device__ __forceinline__ void operator()(AccRef acc, const Unit& u, int wr, int wc, int fr, int fq) const {
        const int pn = u.pn;
#pragma unroll
        for (int ai = 0; ai < 2; ++ai)
#pragma unroll
            for (int m = 0; m < 4; ++m) {
                const int row = u.pm * 256 + ai * 128 + wr * 64 + m * 16 + fr;
#pragma unroll
                for (int bj = 0; bj < 2; ++bj) {
                    const int col = pn * 256 + bj * 128 + wc * 32 + 8 * fq;
                    f32x4 v0 = acc[ai][bj][m][0], v1 = acc[ai][bj][m][1];
                    if (pn < 2) {
                        if (row < NVALID) {
                            int item, t;
                            if (row < NREAL) { item = row >> 5; t = row & 31; } else { const int mr = row - NREAL; item = IT_REAL + (mr >> 4); t = 16 + (mr & 15); }
                            const int g = col >> 4, h0 = col & 15;
                            *(u32x4*)(u5 + ((size_t)(g * IT_PAD + item) * LDA5 + t * 16 + h0)) = pack8(v0, v1);
                        }
                    } else if (pn < 6) {
                        const int cq = col - 512, isk = cq >> 9, cc = cq & 511, i0 = (cc & 127) >> 1;
                        const int pos = row < NPR ? 16 + (row & 4095) : (row < NREAL ? 16 + ((row - NPR) & 2047) : ((row - NREAL) & 15));
                        const float sc = isk ? 1.0f : 0.08838834764831845f;
                        float o[8];
#pragma unroll
                        for (int pi = 0; pi < 4; ++pi) {
                            const float fp = (float)pos, t1 = fp * ropef[2 * (i0 + pi)];
                            const float rev = (t1 - rintf(t1)) + fp * ropef[2 * (i0 + pi) + 1];
                            const float s = __builtin_amdgcn_sinf(rev), c = __builtin_amdgcn_cosf(rev);
                            const float x1 = pi < 2 ? v0[2 * pi] : v1[2 * pi - 4], x2 = pi < 2 ? v0[2 * pi + 1] : v1[2 * pi - 3];
                            o[2 * pi] = (x1 * c - x2 * s) * sc; o[2 * pi + 1] = (x1 * s + x2 * c) * sc;
                        }
                        u32x4 w; w.x = cvt_pk_bf16(o[0], o[1]); w.y = cvt_pk_bf16(o[2], o[3]); w.z = cvt_pk_bf16(o[4], o[5]); w.w = cvt_pk_bf16(o[6], o[7]);
                        *(u32x4*)((isk ? k : q) + (size_t)row * 512 + cc) = w;
                    } else if (pn < 10) {
                        *(u32x4*)(v + (size_t)row * 1024 + (col - 1536)) = pack8(v0, v1);
                    } else if (row < NREAL) {
                        if (pn < 14) {
#pragma unroll
                            for (int j = 0; j < 4; ++j) { v0[j] = siluf_(v0[j]); v1[j] = siluf_(v1[j]); }
                            *(u32x4*)(sg + (size_t)row * 1024 + (col - 2560)) = pack8(v0, v1);
                        } else {
#pragma unroll
                            for (int j = 0; j < 4; ++j) { v0[j] = sigmoidf_(v0[j]); v1[j] = sigmoidf_(v1[j]); }
                            if (pn < 18) *(u32x4*)(ga + (size_t)row * 1024 + (col - 3584)) = pack8(v0, v1);
                            else *(u32x4*)(gb + (size_t)row * 1024 + (col - 4608)) = pack8(v0, v1);
                        }
                    }
                }
            }
    }
};

struct EpiSink {
    float* p; int flag;
    __device__ __forceinline__ void operator()(AccRef acc, const Unit& u, int wr, int wc, int fr, int fq) const {
        if (flag) {
#pragma unroll
            for (int ai = 0; ai < 2; ++ai)
#pragma unroll
                for (int m = 0; m < 4; ++m)
#pragma unroll
                    for (int bj = 0; bj < 2; ++bj) { p[(ai * 8 + m * 2 + bj) * 8 + fr] = acc[ai][bj][m][0][0] + acc[ai][bj][m][1][1]; }
        }
    }
};

struct EpiSloc {
    bf16_t* sloc;
    __device__ __forceinline__ void operator()(AccRef acc, const Unit& u, int wr, int wc, int fr, int fq) const {
#pragma unroll
        for (int ai = 0; ai < 2; ++ai)
#pragma unroll
            for (int m = 0; m < 4; ++m) {
                const int row = u.pm * 256 + ai * 128 + wr * 64 + m * 16 + fr;
#pragma unroll
                for (int bj = 0; bj < 2; ++bj) {
                    const int col = bj * 128 + wc * 32 + 8 * fq;
                    *(u32x4*)(sloc + ((size_t)u.g * IT_PAD + row) * 256 + col) = pack8(acc[ai][bj][m][0], acc[ai][bj][m][1]);
                }
            }
    }
};

struct EpiY {
    bf16_t* y;
    __device__ __forceinline__ void operator()(AccRef acc, const Unit& u, int wr, int wc, int fr, int fq) const {
#pragma unroll
        for (int ai = 0; ai < 2; ++ai)
#pragma unroll
            for (int m = 0; m < 4; ++m) {
                const int item = u.pm * 256 + ai * 128 + wr * 64 + m * 16 + fr;
                if (item < IT_REAL) {
#pragma unroll
                    for (int bj = 0; bj < 2; ++bj) {
                        const int col = u.pn * 256 + bj * 128 + wc * 32 + 8 * fq, to = col >> 4, ho = col & 15;
                        f32x4 v0 = acc[ai][bj][m][0], v1 = acc[ai][bj][m][1];
#pragma unroll
                        for (int j = 0; j < 4; ++j) { v0[j] = gelu_tanh(v0[j]); v1[j] = gelu_tanh(v1[j]); }
                        *(u32x4*)(y + (size_t)(item * 32 + to) * 512 + u.g * 16 + ho) = pack8(v0, v1);
                    }
                }
            }
    }
};

struct EpiGlu {
    bf16_t* ga;
    __device__ __forceinline__ void operator()(AccRef acc, const Unit& u, int wr, int wc, int fr, int fq) const {
        u32x4 gw[2][4];
#pragma unroll
        for (int ai = 0; ai < 2; ++ai)
#pragma unroll
            for (int m = 0; m < 4; ++m) {
                const int row = u.pm * 256 + ai * 128 + wr * 64 + m * 16 + fr;
                gw[ai][m] = *(const u32x4*)(ga + (size_t)row * 1024 + u.pn * 128 + wc * 32 + 8 * fq);
            }
#pragma unroll
        for (int ai = 0; ai < 2; ++ai)
#pragma unroll
            for (int m = 0; m < 4; ++m) {
                const int row = u.pm * 256 + ai * 128 + wr * 64 + m * 16 + fr;
                bf16_t* p = ga + (size_t)row * 1024 + u.pn * 128 + wc * 32 + 8 * fq;
                const u32x4 g = gw[ai][m];
                const f32x4 a0 = acc[ai][0][m][0], a1 = acc[ai][0][m][1], g0 = acc[ai][1][m][0], g1 = acc[ai][1][m][1];
                f32x4 r0, r1;
                r0[0] = bflo(g.x) * a0[0] * sigmoidf_(g0[0]); r0[1] = bfhi(g.x) * a0[1] * sigmoidf_(g0[1]);
                r0[2] = bflo(g.y) * a0[2] * sigmoidf_(g0[2]); r0[3] = bfhi(g.y) * a0[3] * sigmoidf_(g0[3]);
                r1[0] = bflo(g.z) * a1[0] * sigmoidf_(g1[0]); r1[1] = bfhi(g.z) * a1[1] * sigmoidf_(g1[1]);
                r1[2] = bflo(g.w) * a1[2] * sigmoidf_(g1[2]); r1[3] = bfhi(g.w) * a1[3] * sigmoidf_(g1[3]);
                *(u32x4*)p = pack8(r0, r1);
            }
    }
};

struct EpiRet {
    const bf16_t *pa, *gb; bf16_t* mixed;
    __device__ __forceinline__ void operator()(AccRef acc, const Unit& u, int wr, int wc, int fr, int fq) const {
#pragma unroll
        for (int ai = 0; ai < 2; ++ai) {
            u32x4 pw[4][2], gw[4][2];
#pragma unroll
            for (int m = 0; m < 4; ++m)
#pragma unroll
                for (int bj = 0; bj < 2; ++bj) {
                    const int row = u.pm * 256 + ai * 128 + wr * 64 + m * 16 + fr;
                    const size_t o = (size_t)row * 1024 + u.pn * 256 + bj * 128 + wc * 32 + 8 * fq;
                    pw[m][bj] = *(const u32x4*)(pa + o); gw[m][bj] = *(const u32x4*)(gb + o);
                }
#pragma unroll
            for (int m = 0; m < 4; ++m)
#pragma unroll
                for (int bj = 0; bj < 2; ++bj) {
                    const int row = u.pm * 256 + ai * 128 + wr * 64 + m * 16 + fr;
                    const size_t o = (size_t)row * 1024 + u.pn * 256 + bj * 128 + wc * 32 + 8 * fq;
                    const u32x4 p = pw[m][bj], g = gw[m][bj];
                    const f32x4 a0 = acc[ai][bj][m][0], a1 = acc[ai][bj][m][1];
                    f32x4 r0, r1;
                    r0[0] = bflo(p.x) + bflo(g.x) * a0[0]; r0[1] = bfhi(p.x) + bfhi(g.x) * a0[1];
                    r0[2] = bflo(p.y) + bflo(g.y) * a0[2]; r0[3] = bfhi(p.y) + bfhi(g.y) * a0[3];
                    r1[0] = bflo(p.z) + bflo(g.z) * a1[0]; r1[1] = bfhi(p.z) + bfhi(g.z) * a1[1];
                    r1[2] = bflo(p.w) + bflo(g.w) * a1[2]; r1[3] = bfhi(p.w) + bfhi(g.w) * a1[3];
                    *(u32x4*)(mixed + o) = pack8(r0, r1);
                }
            __builtin_amdgcn_sched_barrier(0);
        }
    }
};

template <int MODE>
struct EpiRes {
    const float *xp, *xs; bf16_t* hb; float* ssq;
    __device__ __forceinline__ void operator()(AccRef acc, const Unit& u, int wr, int wc, int fr, int fq) const {
#pragma unroll
        for (int ai = 0; ai < 2; ++ai) {
            f32x4 x0[4][2], x1[4][2]; u32x4 hw[4][2];
#pragma unroll
            for (int m = 0; m < 4; ++m)
#pragma unroll
                for (int bj = 0; bj < 2; ++bj) {
                    const int row = u.pm * 256 + ai * 128 + wr * 64 + m * 16 + fr, col = u.pn * 256 + bj * 128 + wc * 32 + 8 * fq;
                    if (MODE == 0) {
                        const float* src = (row < NPR ? xp + (size_t)row * 1024 : xs + (size_t)(row - NPR) * 1024) + col;
                        x0[m][bj] = *(const f32x4*)src; x1[m][bj] = *(const f32x4*)(src + 4);
                    } else hw[m][bj] = *(const u32x4*)(hb + (size_t)row * 1024 + col);
                }
#pragma unroll
            for (int m = 0; m < 4; ++m) {
                const int row = u.pm * 256 + ai * 128 + wr * 64 + m * 16 + fr;
                float ss = 0.f;
#pragma unroll
                for (int bj = 0; bj < 2; ++bj) {
                    const int col = u.pn * 256 + bj * 128 + wc * 32 + 8 * fq;
                    f32x4 h0, h1;
                    if (MODE == 0) { h0 = x0[m][bj]; h1 = x1[m][bj]; }
                    else { const u32x4 w = hw[m][bj]; h0 = (f32x4){bflo(w.x), bfhi(w.x), bflo(w.y), bfhi(w.y)}; h1 = (f32x4){bflo(w.z), bfhi(w.z), bflo(w.w), bfhi(w.w)}; }
                    h0 = h0 + acc[ai][bj][m][0]; h1 = h1 + acc[ai][bj][m][1];
                    *(u32x4*)(hb + (size_t)row * 1024 + col) = pack8(h0, h1);
                    ss += (h0[0] * h0[0] + h0[1] * h0[1]) + (h0[2] * h0[2] + h0[3] * h0[3]) + (h1[0] * h1[0] + h1[1] * h1[1]) + (h1[2] * h1[2] + h1[3] * h1[3]);
                }
                ss += __shfl_xor(ss, 16); ss += __shfl_xor(ss, 32);
                if (fq == 0) ssq[(size_t)row * 16 + u.pn * 4 + wc] = ss;
            }
            __builtin_amdgcn_sched_barrier(0);
        }
    }
};

struct EpiFfi {
    const float* ssq; bf16_t* act;
    __device__ __forceinline__ void operator()(AccRef acc, const Unit& u, int wr, int wc, int fr, int fq) const {
        f32x4 sp[2][4];
#pragma unroll
        for (int ai = 0; ai < 2; ++ai)
#pragma unroll
            for (int m = 0; m < 4; ++m) {
                const int row = u.pm * 256 + ai * 128 + wr * 64 + m * 16 + fr;
                sp[ai][m] = *(const f32x4*)(ssq + (size_t)row * 16 + 4 * fq);
            }
#pragma unroll
        for (int ai = 0; ai < 2; ++ai)
#pragma unroll
            for (int m = 0; m < 4; ++m) {
                const int row = u.pm * 256 + ai * 128 + wr * 64 + m * 16 + fr;
                float tot = (sp[ai][m][0] + sp[ai][m][1]) + (sp[ai][m][2] + sp[ai][m][3]);
                tot += __shfl_xor(tot, 16); tot += __shfl_xor(tot, 32);
                const float rstd = rsqrtf(tot * (1.0f / 1024.0f) + EPS);
                const f32x4 g0 = acc[ai][0][m][0], g1 = acc[ai][0][m][1], u0 = acc[ai][1][m][0], u1 = acc[ai][1][m][1];
                f32x4 r0, r1;
#pragma unroll
                for (int j = 0; j < 4; ++j) { r0[j] = siluf_(rstd * g0[j]) * (rstd * u0[j]); r1[j] = siluf_(rstd * g1[j]) * (rstd * u1[j]); }
                *(u32x4*)(act + (size_t)row * DFF + u.pn * 128 + wc * 32 + 8 * fq) = pack8(r0, r1);
            }
    }
};

__device__ __forceinline__ void p0_s5gen(const Args& a, LAS float* L, int g, int qd) {
    const int tid = threadIdx.x;
    LAS float* Kt = L;
    LAS float* Ap = L + 16384;
    LAS float* Bb = Ap + 33 * 64 * 2;
    LAS float* Cc = Bb + 2048;
    bf16_t* bts = (bf16_t*)(a.ws + OFF_BTS) + (size_t)g * 256 * 512;
    bf16_t* bty = (bf16_t*)(a.ws + OFF_BTY) + (size_t)g * 512 * 768;
    float* attab = (float*)(a.ws + OFF_AT);
    bf16_t* u5 = (bf16_t*)(a.ws + OFF_U5);
    if (qd == 0) for (int e = tid; e < 24 * 256; e += 512) { const int b = e >> 8, kk = e & 255; u5[((size_t)g * IT_PAD + IT_REAL + b) * LDA5 + kk] = 0; }
    for (int dir = 0; dir < 2; ++dir) {
        const int pg = dir * 32 + g;
        const double dt = exp((double)a.in[7][pg]);
        for (int idx = tid; idx < 33 * 64; idx += 512) {
            const int p = idx & 63, d = idx >> 6;
            const double lr = a.in[5][pg * 64 + p], li = a.in[6][pg * 64 + p];
            const float mag = (float)exp(lr * dt * d);
            float s, c; sincos_rev(li * dt * d, s, c);
            Ap[idx * 2] = mag * c; Ap[idx * 2 + 1] = mag * s;
            if (d == 32 && qd == 0) { attab[(pg * 64 + p) * 2] = mag * c; attab[(pg * 64 + p) * 2 + 1] = mag * s; }
        }
        for (int idx = tid; idx < 1024; idx += 512) {
            const int p = idx >> 4, h = idx & 15;
            const double lr = a.in[5][pg * 64 + p], li = a.in[6][pg * 64 + p];
            const double zr = lr * dt, zi = li * dt, mag = exp(zr);
            float sh, ch, s1, c1; sincos_rev(0.5 * zi, sh, ch); sincos_rev(zi, s1, c1);
            const double nr = mag * (-2.0 * (double)sh * (double)sh) + expm1(zr);
            const double abi = mag * (double)s1, den = lr * lr + li * li;
            const double cre = (nr * lr + abi * li) / den, cim = (abi * lr - nr * li) / den;
            const double br = a.in[8][(size_t)(pg * 64 + p) * 16 + h], bi = a.in[9][(size_t)(pg * 64 + p) * 16 + h];
            Bb[idx * 2] = (float)(cre * br - cim * bi); Bb[idx * 2 + 1] = (float)(cre * bi + cim * br);
        }
        for (int idx = tid; idx < 1024; idx += 512) {
            Cc[idx * 2] = a.in[10][(size_t)pg * 1024 + idx]; Cc[idx * 2 + 1] = a.in[11][(size_t)pg * 1024 + idx];
        }
        __syncthreads();
        for (int e = tid; e < 8192; e += 512) {
            const int d = e >> 8, ho = (e >> 4) & 15, hi = e & 15;
            float sum = 0.f;
            for (int p = 0; p < 64; ++p) {
                const float cr = Cc[(ho * 64 + p) * 2], ci = Cc[(ho * 64 + p) * 2 + 1], ar = Ap[(d * 64 + p) * 2], ai = Ap[(d * 64 + p) * 2 + 1];
                const float br = Bb[(p * 16 + hi) * 2], bi = Bb[(p * 16 + hi) * 2 + 1];
                const float car = cr * ar - ci * ai, cai = cr * ai + ci * ar;
                sum += car * br - cai * bi;
            }
            Kt[dir * 8192 + e] = sum;
        }
        for (int e = qd * 16384 + tid; e < (qd + 1) * 16384; e += 512) {
            const int k = e & 511, nn = e >> 9, c = nn >> 6, p = nn & 63, t = k >> 4, hi = k & 15;
            const int dd = dir == 0 ? (T5 - 1 - t) : t;
            const float ar = Ap[(dd * 64 + p) * 2], ai = Ap[(dd * 64 + p) * 2 + 1], br = Bb[(p * 16 + hi) * 2], bi = Bb[(p * 16 + hi) * 2 + 1];
            const float val = c ? (ar * bi + ai * br) : (ar * br - ai * bi);
            bts[(size_t)(dir * 128 + nn) * 512 + k] = f2bf(val);
        }
        for (int e = qd * 16384 + tid; e < (qd + 1) * 16384; e += 512) {
            const int kk = e & 127, n = e >> 7, c = kk >> 6, p = kk & 63, to = n >> 4, ho = n & 15;
            const int dd = dir == 0 ? (to + 1) : (T5 - to);
            const float cr = Cc[(ho * 64 + p) * 2], ci = Cc[(ho * 64 + p) * 2 + 1], ar = Ap[(dd * 64 + p) * 2], ai = Ap[(dd * 64 + p) * 2 + 1];
            const float val = c ? -(cr * ai + ci * ar) : (cr * ar - ci * ai);
            bty[(size_t)n * 768 + 512 + dir * 128 + kk] = f2bf(val);
        }
        __syncthreads();
    }
    for (int e = qd * 65536 + tid; e < (qd + 1) * 65536; e += 512) {
        const int k = e & 511, n = e >> 9, to = n >> 4, ho = n & 15, ti = k >> 4, hi = k & 15;
        float val = 0.f;
        if (to >= ti) val += Kt[((to - ti) * 16 + ho) * 16 + hi];
        if (ti >= to) val += Kt[8192 + ((ti - to) * 16 + ho) * 16 + hi];
        if (to == ti && ho == hi) val += a.in[12][g * 16 + ho];
        bty[(size_t)n * 768 + k] = f2bf(val);
    }
    __syncthreads();
}

__device__ __forceinline__ int src_col(int kind, int n) {
    if (kind == 1) { if (n >= 512 && n < 1536) { const int r = n - 512, seg = r >> 7, dp = r & 127; return 512 + seg * 128 + (dp >> 1) + 64 * (dp & 1); } return n; }
    if (kind == 2) { const int pn = n >> 8, bj = (n >> 7) & 1, cc = n & 127; return bj * 1024 + pn * 128 + cc; }
    if (kind == 3) { const int pn = n >> 8, bj = (n >> 7) & 1, cc = n & 127; return bj * DFF + pn * 128 + cc; }
    return n;
}
__device__ __forceinline__ void p0_wtile(const float* W, int K, int N, bf16_t* WT, int kind, const float* kscale, int tile2, LAS float* L) {
    const int tid = threadIdx.x, nkt = K >> 6;
    int n0[2], k0[2];
#pragma unroll
    for (int q = 0; q < 2; ++q) { const int tile = 2 * tile2 + q; n0[q] = (tile / nkt) * 64; k0[q] = (tile % nkt) * 64; }
    float v[2][8];
#pragma unroll
    for (int q = 0; q < 2; ++q)
#pragma unroll
        for (int it = 0; it < 8; ++it) {
            const int idx = tid + it * 512, kk = idx >> 6, j = idx & 63;
            v[q][it] = W[(size_t)(k0[q] + kk) * N + src_col(kind, n0[q] + j)];
        }
#pragma unroll
    for (int q = 0; q < 2; ++q)
#pragma unroll
        for (int it = 0; it < 8; ++it) {
            const int idx = tid + it * 512, kk = idx >> 6, j = idx & 63;
            float x = v[q][it];
            if (kscale) x *= kscale[k0[q] + kk];
            L[q * 4160 + kk * 65 + j] = x;
        }
    __syncthreads();
#pragma unroll
    for (int q = 0; q < 2; ++q)
#pragma unroll
        for (int it = 0; it < 4; ++it) {
            const int idx = tid + it * 512, j = idx >> 5, kp = idx & 31;
            *(unsigned*)(WT + (size_t)(n0[q] + j) * K + k0[q] + 2 * kp) = cvt_pk_bf16(L[q * 4160 + (2 * kp) * 65 + j], L[q * 4160 + (2 * kp + 1) * 65 + j]);
        }
    __syncthreads();
}

__device__ __forceinline__ void phase0(const Args& a, LAS unsigned char* lds) {
    LAS float* L = (LAS float*)lds;
    const int tid = threadIdx.x, wave = tid >> 6, lane = tid & 63;
    constexpr int T_IN = 88 * 16 / 2, T_GLU = 32 * 8 / 2, T_RET = 128, T_OUT = 128, T_FFI = 88 * 16 / 2, T_FFO = 16 * 44 / 2;
    constexpr int NW = 128 + T_IN + T_GLU + T_RET + T_OUT, NRM = RPAD / 32;
    unsigned* qctr = (unsigned*)(a.ws + OFF_BAR) + 4096;
    LAS int* qslot = (LAS int*)(lds + 131072 + 512);
    for (;;) {
        __syncthreads();
        if (tid == 0) *qslot = (int)__hip_atomic_fetch_add(qctr, 1u, __ATOMIC_RELAXED, __HIP_MEMORY_SCOPE_AGENT);
        __syncthreads();
        const int w = *qslot;
        if (w >= NW + NRM) break;
        int r = w;
        if (r < 128) { p0_s5gen(a, L, r >> 2, r & 3); continue; } r -= 128;
        if (r < T_IN) { p0_wtile(a.in[4], 1024, INW, (bf16_t*)(a.ws + OFF_WIN), 1, nullptr, r, L); continue; } r -= T_IN;
        if (r < T_GLU) { p0_wtile(a.in[13], 512, 2048, (bf16_t*)(a.ws + OFF_WGLU), 2, nullptr, r, L); continue; } r -= T_GLU;
        if (r < T_RET) { p0_wtile(a.in[15], 1024, 1024, (bf16_t*)(a.ws + OFF_WRET), 0, nullptr, r, L); continue; } r -= T_RET;
        if (r < T_OUT) { p0_wtile(a.in[16], 1024, 1024, (bf16_t*)(a.ws + OFF_WOUT), 0, nullptr, r, L); continue; } r -= T_OUT;

        const int rowb = r * 32 + wave * 4;
        const float* xr[4]; f32x4 v[4][4];
#pragma unroll
        for (int q = 0; q < 4; ++q) {
            const int row = rowb + q;
            xr[q] = row < NPR ? a.in[0] + (size_t)row * 1024 : (row < NREAL ? a.in[1] + (size_t)(row - NPR) * 1024 : a.in[2] + (size_t)((row - NREAL) & 15) * 1024);
#pragma unroll
            for (int j = 0; j < 4; ++j) v[q][j] = (row < NVALID) ? *(const f32x4*)(xr[q] + (j * 64 + lane) * 4) : (f32x4){0.f, 0.f, 0.f, 0.f};
        }
        f32x4 gg[4];
#pragma unroll
        for (int j = 0; j < 4; ++j) gg[j] = *(const f32x4*)(a.in[3] + (j * 64 + lane) * 4);
#pragma unroll
        for (int q = 0; q < 4; ++q) {
            float sq = 0.f;
#pragma unroll
            for (int j = 0; j < 4; ++j) sq += (v[q][j][0] * v[q][j][0] + v[q][j][1] * v[q][j][1]) + (v[q][j][2] * v[q][j][2] + v[q][j][3] * v[q][j][3]);
            const float rstd = rsqrtf(wave_sum(sq) * (1.0f / 1024.0f) + EPS);
            bf16_t* orow = (bf16_t*)(a.ws + OFF_N1) + (size_t)(rowb + q) * 1024;
#pragma unroll
            for (int j = 0; j < 4; ++j) {
                u32x2 o; o.x = cvt_pk_bf16(v[q][j][0] * rstd * gg[j][0], v[q][j][1] * rstd * gg[j][1]); o.y = cvt_pk_bf16(v[q][j][2] * rstd * gg[j][2], v[q][j][3] * rstd * gg[j][3]);
                *(u32x2*)(orow + (j * 64 + lane) * 4) = o;
            }
        }
    }
}

__device__ __forceinline__ void s5_scan(const Args& a) {
    const float* attab = (const float*)(a.ws + OFF_AT);
    const bf16_t* sloc = (const bf16_t*)(a.ws + OFF_SLOC);
    bf16_t* u5 = (bf16_t*)(a.ws + OFF_U5);
    for (int id = blockIdx.x * 512 + threadIdx.x; id < 24 * 32 * 2 * 64; id += gridDim.x * 512) {
        const int p = id & 63, dir = (id >> 6) & 1, g = (id >> 7) & 31, b = id >> 12;
        const float atr = attab[((dir * 32 + g) * 64 + p) * 2], ati = attab[((dir * 32 + g) * 64 + p) * 2 + 1];
        const int nck = b < 16 ? 128 : 64, base = b < 16 ? b * 128 : 2048 + (b - 16) * 64, mitem = IT_REAL + b;
        const bf16_t* sl = sloc + (size_t)g * IT_PAD * 256 + dir * 128 + p;
        bf16_t* ub = u5 + (size_t)g * IT_PAD * LDA5 + 512 + dir * 128 + p;
        float sr = 0.f, si = 0.f;
        if (dir == 0) {
            ub[(size_t)mitem * LDA5] = 0; ub[(size_t)mitem * LDA5 + 64] = 0;
            sr = bf2f(sl[(size_t)mitem * 256]); si = bf2f(sl[(size_t)mitem * 256 + 64]);
            for (int c0 = 0; c0 < nck; c0 += 16) {
                float lr[16], li[16];
#pragma unroll
                for (int j = 0; j < 16; ++j) { lr[j] = bf2f(sl[(size_t)(base + c0 + j) * 256]); li[j] = bf2f(sl[(size_t)(base + c0 + j) * 256 + 64]); }
#pragma unroll
                for (int j = 0; j < 16; ++j) {
                    const size_t it = (size_t)(base + c0 + j);
                    ub[it * LDA5] = f2bf(sr); ub[it * LDA5 + 64] = f2bf(si);
                    const float nr = atr * sr - ati * si + lr[j], ni = atr * si + ati * sr + li[j];
                    sr = nr; si = ni;
                }
            }
        } else {
            for (int c0 = nck - 16; c0 >= 0; c0 -= 16) {
                float lr[16], li[16];
#pragma unroll
                for (int j = 0; j < 16; ++j) { lr[j] = bf2f(sl[(size_t)(base + c0 + j) * 256]); li[j] = bf2f(sl[(size_t)(base + c0 + j) * 256 + 64]); }
#pragma unroll
                for (int j = 15; j >= 0; --j) {
                    const size_t it = (size_t)(base + c0 + j);
                    ub[it * LDA5] = f2bf(sr); ub[it * LDA5 + 64] = f2bf(si);
                    const float nr = atr * sr - ati * si + lr[j], ni = atr * si + ati * sr + li[j];
                    sr = nr; si = ni;
                }
            }
            ub[(size_t)mitem * LDA5] = f2bf(sr); ub[(size_t)mitem * LDA5 + 64] = f2bf(si);
        }
    }
}

constexpr int LDR = 136;
constexpr int LDRA = 144;

template <int LDR>
__device__ __forceinline__ void tr_store_pair(LAS bf16_t* img, int f0, int s2, u32x4 r0, u32x4 r1) {
    LAS unsigned* p = (LAS unsigned*)(img + f0 * LDR + s2);
    p[0 * (LDR / 2)] = (r0.x & 0xFFFFu) | (r1.x << 16); p[1 * (LDR / 2)] = (r0.x >> 16) | (r1.x & 0xFFFF0000u);
    p[2 * (LDR / 2)] = (r0.y & 0xFFFFu) | (r1.y << 16); p[3 * (LDR / 2)] = (r0.y >> 16) | (r1.y & 0xFFFF0000u);
    p[4 * (LDR / 2)] = (r0.z & 0xFFFFu) | (r1.z << 16); p[5 * (LDR / 2)] = (r0.z >> 16) | (r1.z & 0xFFFF0000u);
    p[6 * (LDR / 2)] = (r0.w & 0xFFFFu) | (r1.w << 16); p[7 * (LDR / 2)] = (r0.w >> 16) | (r1.w & 0xFFFF0000u);
}
template <int LDR>
__device__ __forceinline__ void tr_store_pair_scaled(LAS bf16_t* img, int f0, int s2, u32x4 r0, u32x4 r1, float w0, float w1) {
    LAS unsigned* p = (LAS unsigned*)(img + f0 * LDR + s2);
    p[0 * (LDR / 2)] = cvt_pk_bf16(bflo(r0.x) * w0, bflo(r1.x) * w1); p[1 * (LDR / 2)] = cvt_pk_bf16(bfhi(r0.x) * w0, bfhi(r1.x) * w1);
    p[2 * (LDR / 2)] = cvt_pk_bf16(bflo(r0.y) * w0, bflo(r1.y) * w1); p[3 * (LDR / 2)] = cvt_pk_bf16(bfhi(r0.y) * w0, bfhi(r1.y) * w1);
    p[4 * (LDR / 2)] = cvt_pk_bf16(bflo(r0.z) * w0, bflo(r1.z) * w1); p[5 * (LDR / 2)] = cvt_pk_bf16(bfhi(r0.z) * w0, bfhi(r1.z) * w1);
    p[6 * (LDR / 2)] = cvt_pk_bf16(bflo(r0.w) * w0, bflo(r1.w) * w1); p[7 * (LDR / 2)] = cvt_pk_bf16(bfhi(r0.w) * w0, bfhi(r1.w) * w1);
}

#define LDS_BARRIER() do { asm volatile("s_waitcnt lgkmcnt(0)" ::: "memory"); __builtin_amdgcn_s_barrier(); asm volatile("" ::: "memory"); } while (0)
__device__ __forceinline__ void ret_pass_a(const Args& a, LAS unsigned char* lds) {
    LAS bf16_t* KT = (LAS bf16_t*)lds;
    LAS bf16_t* VT = KT + 128 * LDRA;
    const int tid0 = threadIdx.x;
    const bf16_t* kb = (const bf16_t*)(a.ws + OFF_K); const bf16_t* vb = (const bf16_t*)(a.ws + OFF_V);
    bf16_t* stb = (bf16_t*)(a.ws + OFF_ST);
    for (int item = blockIdx.x; item < 192; item += gridDim.x) {
        int tid = tid0; asm volatile("" : "+v"(tid));
        const int w = tid >> 6, lane = tid & 63, fr = lane & 15, fq = lane >> 4;
        int b, h, dir;
        if (item < 128) { b = item >> 3; h = (item >> 1) & 3; dir = item & 1; } else { const int j = item - 128; b = 16 + (j >> 3); h = (j >> 1) & 3; dir = j & 1; }
        const int NC = b < 16 ? 32 : 16, rbase = b < 16 ? b * 4096 : NPR + (b - 16) * 2048, ebase = b < 16 ? b * 33 : 528 + (b - 16) * 17;
        const float lg = logsigf_(a.in[14][dir * 4 + h]);
        const float carry = __expf(lg * 128.f);
        const int s2 = 2 * (8 * w + (lane & 7)), pg = lane >> 3;
        const float wk0 = dir == 0 ? __expf(lg * (float)(127 - s2)) : __expf(lg * (float)s2);
        const float wk1 = dir == 0 ? __expf(lg * (float)(126 - s2)) : __expf(lg * (float)(s2 + 1));
        f32x4 acc[2][8];
#pragma unroll
        for (int et = 0; et < 2; ++et)
#pragma unroll
            for (int dtl = 0; dtl < 8; ++dtl) acc[et][dtl] = (f32x4){0.f, 0.f, 0.f, 0.f};
        const int nsteps = dir == 0 ? NC : NC;
        u32x4 rk[2][2], rv[4][2];
        auto load_chunk = [&](int n) {
            int row0; bool valid = true;
            if (n == 0) { valid = s2 >= 112; row0 = NREAL + b * 16 + (s2 - 112); } else row0 = rbase + (n - 1) * 128 + s2;
#pragma unroll
            for (int it = 0; it < 2; ++it)
#pragma unroll
                for (int r = 0; r < 2; ++r) {
                    rk[it][r] = (u32x4){0u, 0u, 0u, 0u};
                    if (valid) rk[it][r] = *(const u32x4*)(kb + (size_t)(row0 + r) * 512 + h * 128 + (pg + 8 * it) * 8);
                }
#pragma unroll
            for (int it = 0; it < 4; ++it)
#pragma unroll
                for (int r = 0; r < 2; ++r) {
                    rv[it][r] = (u32x4){0u, 0u, 0u, 0u};
                    if (valid) rv[it][r] = *(const u32x4*)(vb + (size_t)(row0 + r) * 1024 + h * 256 + (pg + 8 * it) * 8);
                }
        };
        load_chunk(dir == 0 ? 0 : NC);
        for (int step = 0; step < nsteps; ++step) {
            const int n = dir == 0 ? step : NC - step;
            {
                bf16_t* spn = stb + ((size_t)((ebase + n) * 4 + h) * 2 + dir) * 32768;
#pragma unroll
                for (int et = 0; et < 2; ++et)
#pragma unroll
                    for (int dtl = 0; dtl < 8; ++dtl) {
                        u32x2 o; o.x = cvt_pk_bf16(acc[et][dtl][0], acc[et][dtl][1]); o.y = cvt_pk_bf16(acc[et][dtl][2], acc[et][dtl][3]);
                        *(u32x2*)(spn + (size_t)(32 * w + 16 * et + fr) * 128 + 16 * dtl + 4 * fq) = o;
                    }
            }
            LDS_BARRIER();
#pragma unroll
            for (int it = 0; it < 2; ++it) tr_store_pair_scaled<LDRA>(KT, (pg + 8 * it) * 8, s2, rk[it][0], rk[it][1], wk0, wk1);
#pragma unroll
            for (int it = 0; it < 4; ++it) tr_store_pair<LDRA>(VT, (pg + 8 * it) * 8, s2, rv[it][0], rv[it][1]);
            if (step + 1 < nsteps) load_chunk(dir == 0 ? step + 1 : NC - step - 1);
            LDS_BARRIER();
#pragma unroll
            for (int et = 0; et < 2; ++et)
#pragma unroll
                for (int dtl = 0; dtl < 8; ++dtl) acc[et][dtl] = acc[et][dtl] * carry;
#pragma unroll
            for (int ks = 0; ks < 4; ++ks) {
                bf16x8 vf[2];
#pragma unroll
                for (int et = 0; et < 2; ++et) vf[et] = *(const LAS bf16x8*)(VT + (32 * w + 16 * et + fr) * LDRA + 32 * ks + 8 * fq);
#pragma unroll
                for (int dtl = 0; dtl < 8; ++dtl) {
                    const bf16x8 kf = *(const LAS bf16x8*)(KT + (16 * dtl + fr) * LDRA + 32 * ks + 8 * fq);
#pragma unroll
                    for (int et = 0; et < 2; ++et) acc[et][dtl] = __builtin_amdgcn_mfma_f32_16x16x32_bf16(kf, vf[et], acc[et][dtl], 0, 0, 0);
                }
            }
        }
        if (dir == 0) {
            bf16_t* spn = stb + ((size_t)((ebase + NC) * 4 + h) * 2 + dir) * 32768;
#pragma unroll
            for (int et = 0; et < 2; ++et)
#pragma unroll
                for (int dtl = 0; dtl < 8; ++dtl) {
                    u32x2 o; o.x = cvt_pk_bf16(acc[et][dtl][0], acc[et][dtl][1]); o.y = cvt_pk_bf16(acc[et][dtl][2], acc[et][dtl][3]);
                    *(u32x2*)(spn + (size_t)(32 * w + 16 * et + fr) * 128 + 16 * dtl + 4 * fq) = o;
                }
        }
        LDS_BARRIER();
    }
}

__device__ __forceinline__ void ret_pass_b(const Args& a, LAS unsigned char* lds) {
    LAS bf16_t* KL = (LAS bf16_t*)lds;
    LAS bf16_t* BG = KL + 128 * LDR;
    const int tid0 = threadIdx.x;
    const bf16_t* qb = (const bf16_t*)(a.ws + OFF_Q); const bf16_t* kb = (const bf16_t*)(a.ws + OFF_K); const bf16_t* vb = (const bf16_t*)(a.ws + OFF_V);
    const bf16_t* stb = (const bf16_t*)(a.ws + OFF_ST);
    bf16_t* sg = (bf16_t*)a.out;
    u32x4 rk[4], rb[8]; bf16x8 qf[4];
    auto item_info = [&](int item, int& r0, int& h, const bf16_t*& sfp) {
        const int rc = item >> 2; h = item & 3;
        int b, n; if (rc < 512) { b = rc >> 5; n = (rc & 31) + 1; } else { b = 16 + ((rc - 512) >> 4); n = ((rc - 512) & 15) + 1; }
        const int ebase = b < 16 ? b * 33 : 528 + (b - 16) * 17; r0 = rc * 128;
        sfp = stb + ((size_t)((ebase + n) * 4 + h) * 2 + 0) * 32768;
    };
    auto load_item_head = [&](int item, int tid) {
        int r0, h; const bf16_t* sfp; item_info(item, r0, h, sfp);
#pragma unroll
        for (int it = 0; it < 8; ++it) { const int idx = tid + it * 512, e = idx >> 4, pc = idx & 15; rb[it] = *(const u32x4*)(sfp + (size_t)e * 128 + pc * 8); }
    };
    auto load_item_kq = [&](int item, int tid) {
        int r0, h; const bf16_t* sfp; item_info(item, r0, h, sfp);
        const int w = tid >> 6, lane = tid & 63, fr = lane & 15, fq = lane >> 4;
#pragma unroll
        for (int it = 0; it < 4; ++it) { const int idx = tid + it * 512, s = idx >> 4, pc = idx & 15; rk[it] = *(const u32x4*)(kb + (size_t)(r0 + s) * 512 + h * 128 + pc * 8); }
#pragma unroll
        for (int ks = 0; ks < 4; ++ks) qf[ks] = *(const bf16x8*)(qb + (size_t)(r0 + 16 * w + fr) * 512 + h * 128 + 32 * ks + 8 * fq);
    };
    if ((int)blockIdx.x < 2560) { load_item_head(blockIdx.x, tid0); load_item_kq(blockIdx.x, tid0); }
    for (int item = blockIdx.x; item < 2560; item += gridDim.x) {
        int tid = tid0; asm volatile("" : "+v"(tid));
        const int w = tid >> 6, lane = tid & 63, fr = lane & 15, fq = lane >> 4;
        int r0, h; const bf16_t* sfp; item_info(item, r0, h, sfp);
        const bf16_t* sbp = sfp + 32768;
        const float lgf = logsigf_(a.in[14][h]), lgb = logsigf_(a.in[14][4 + h]);
        const int crow = 16 * w + fr;
        LDS_BARRIER();
#pragma unroll
        for (int it = 0; it < 4; ++it) { const int idx = tid + it * 512, s = idx >> 4, pc = idx & 15; *(LAS u32x4*)(KL + s * LDR + pc * 8) = rk[it]; }
#pragma unroll
        for (int it = 0; it < 8; ++it) { const int idx = tid + it * 512, e = idx >> 4, pc = idx & 15; *(LAS u32x4*)(BG + e * LDR + pc * 8) = rb[it]; }
#pragma unroll
        for (int it = 0; it < 8; ++it) { const int idx = tid + it * 512, e = idx >> 4, pc = idx & 15; rb[it] = *(const u32x4*)(sbp + (size_t)e * 128 + pc * 8); }
        LDS_BARRIER();
        f32x4 sacc[8];
#pragma unroll
        for (int st = 0; st < 8; ++st) sacc[st] = (f32x4){0.f, 0.f, 0.f, 0.f};
#pragma unroll
        for (int ks = 0; ks < 4; ++ks)
#pragma unroll
            for (int st = 0; st < 8; ++st) {
                const bf16x8 kf = *(const LAS bf16x8*)(KL + (16 * st + fr) * LDR + 32 * ks + 8 * fq);
                sacc[st] = __builtin_amdgcn_mfma_f32_16x16x32_bf16(kf, qf[ks], sacc[st], 0, 0, 0);
                if (st == 7) __builtin_amdgcn_sched_barrier(0);
            }
        bf16x8 pf[4];
#pragma unroll
        for (int t = 0; t < 4; ++t) {
            float pv[8];
#pragma unroll
            for (int hh = 0; hh < 2; ++hh)
#pragma unroll
                for (int j = 0; j < 4; ++j) {
                    const int spp = 16 * (2 * t + hh) + 4 * fq + j, diff = crow - spp;
                    const float dec = diff >= 0 ? __expf(lgf * (float)diff) : __expf(-lgb * (float)diff);
                    pv[hh * 4 + j] = sacc[2 * t + hh][j] * dec;
                }
            u32x4 pw; pw.x = cvt_pk_bf16(pv[0], pv[1]); pw.y = cvt_pk_bf16(pv[2], pv[3]); pw.z = cvt_pk_bf16(pv[4], pv[5]); pw.w = cvt_pk_bf16(pv[6], pv[7]);
            pf[t] = __builtin_bit_cast(bf16x8, pw);
        }
        f32x4 o[16];
#pragma unroll
        for (int et = 0; et < 16; ++et) o[et] = (f32x4){0.f, 0.f, 0.f, 0.f};
#pragma unroll
        for (int ks = 0; ks < 4; ++ks)
#pragma unroll
            for (int et = 0; et < 16; ++et) {
                const bf16x8 sf = *(const LAS bf16x8*)(BG + (16 * et + fr) * LDR + 32 * ks + 8 * fq);
                o[et] = __builtin_amdgcn_mfma_f32_16x16x32_bf16(sf, qf[ks], o[et], 0, 0, 0);
                if ((et & 7) == 7) __builtin_amdgcn_sched_barrier(0);
            }
        const float wqf = __expf(lgf * (float)(crow + 1)), wqb = __expf(lgb * (float)(128 - crow));
        const float ratio = wqf / wqb;
#pragma unroll
        for (int et = 0; et < 16; ++et) o[et] = o[et] * ratio;
        LDS_BARRIER();
#pragma unroll
        for (int it = 0; it < 8; ++it) { const int idx = tid + it * 512, e = idx >> 4, pc = idx & 15; *(LAS u32x4*)(BG + e * LDR + pc * 8) = rb[it]; }
        {
            const int s2 = 2 * (8 * w + (lane & 7));
#pragma unroll
            for (int it = 0; it < 4; ++it)
#pragma unroll
                for (int r = 0; r < 2; ++r) rb[it * 2 + r] = *(const u32x4*)(vb + (size_t)(r0 + s2 + r) * 1024 + h * 256 + ((lane >> 3) + 8 * it) * 8);
        }
        LDS_BARRIER();
#pragma unroll
        for (int ks = 0; ks < 4; ++ks)
#pragma unroll
            for (int et = 0; et < 16; ++et) {
                const bf16x8 sf = *(const LAS bf16x8*)(BG + (16 * et + fr) * LDR + 32 * ks + 8 * fq);
                o[et] = __builtin_amdgcn_mfma_f32_16x16x32_bf16(sf, qf[ks], o[et], 0, 0, 0);
                if ((et & 7) == 7) __builtin_amdgcn_sched_barrier(0);
            }
#pragma unroll
        for (int et = 0; et < 16; ++et) o[et] = o[et] * wqb;
        LDS_BARRIER();
#pragma unroll
        for (int it = 0; it < 4; ++it) tr_store_pair<LDR>(BG, ((lane >> 3) + 8 * it) * 8, 2 * (8 * w + (lane & 7)), rb[it * 2], rb[it * 2 + 1]);
        if (item + (int)gridDim.x < 2560) load_item_head(item + gridDim.x, tid);
        LDS_BARRIER();
#pragma unroll
        for (int t = 0; t < 4; ++t)
#pragma unroll
            for (int et = 0; et < 16; ++et) {
                const u32x2 lo = *(const LAS u32x2*)(BG + (16 * et + fr) * LDR + 32 * t + 4 * fq);
                const u32x2 hi = *(const LAS u32x2*)(BG + (16 * et + fr) * LDR + 32 * t + 16 + 4 * fq);
                const u32x4 vw = (u32x4){lo.x, lo.y, hi.x, hi.y};
                o[et] = __builtin_amdgcn_mfma_f32_16x16x32_bf16(__builtin_bit_cast(bf16x8, vw), pf[t], o[et], 0, 0, 0);
                if ((et & 7) == 7) __builtin_amdgcn_sched_barrier(0);
            }
        float ss = 0.f;
#pragma unroll
        for (int et = 0; et < 16; ++et) ss += (o[et][0] * o[et][0] + o[et][1] * o[et][1]) + (o[et][2] * o[et][2] + o[et][3] * o[et][3]);
        ss += __shfl_xor(ss, 16); ss += __shfl_xor(ss, 32);
        const float rn = rsqrtf(ss * (1.0f / 256.0f) + EPS);
        bf16_t* gp = sg + (size_t)(r0 + crow) * 1024 + h * 256 + 4 * fq;
        u32x2 gwv[16];
#pragma unroll
        for (int et = 0; et < 16; ++et) gwv[et] = *(const u32x2*)(gp + 16 * et);
        if (item + (int)gridDim.x < 2560) load_item_kq(item + gridDim.x, tid);
#pragma unroll
        for (int et = 0; et < 16; ++et) {
            const u32x2 gw = gwv[et];
            u32x2 ow; ow.x = cvt_pk_bf16(o[et][0] * rn * bflo(gw.x), o[et][1] * rn * bfhi(gw.x)); ow.y = cvt_pk_bf16(o[et][2] * rn * bflo(gw.y), o[et][3] * rn * bfhi(gw.y));
            *(u32x2*)(gp + 16 * et) = ow;
        }
    }
    LDS_BARRIER();
}

__device__ __forceinline__ void final_norm(const Args& a) {
    const int wave = threadIdx.x >> 6, lane = threadIdx.x & 63;
    const float* ssq = (const float*)(a.ws + OFF_SSQ2);
    f32x4 gg[4];
#pragma unroll
    for (int j = 0; j < 4; ++j) gg[j] = *(const f32x4*)(a.in[20] + (j * 64 + lane) * 4);
    for (int rowb = (blockIdx.x * 8 + wave) * 4; rowb < NREAL; rowb += gridDim.x * 32) {
        float part[4]; u32x2 w[4][4];
#pragma unroll
        for (int q = 0; q < 4; ++q) {
            part[q] = lane < 16 ? ssq[(size_t)(rowb + q) * 16 + lane] : 0.f;
            const bf16_t* hrow = (const bf16_t*)(a.ws + OFF_H1B) + (size_t)(rowb + q) * 1024;
#pragma unroll
            for (int j = 0; j < 4; ++j) w[q][j] = *(const u32x2*)(hrow + (j * 64 + lane) * 4);
        }
#pragma unroll
        for (int q = 0; q < 4; ++q) {
            const float rstd = rsqrtf(wave_sum(part[q]) * (1.0f / 1024.0f) + EPS);
            float* orow = a.out + (size_t)(rowb + q) * 1024;
#pragma unroll
            for (int j = 0; j < 4; ++j) {
                f32x4 v;
                v[0] = bflo(w[q][j].x) * rstd * gg[j][0]; v[1] = bfhi(w[q][j].x) * rstd * gg[j][1]; v[2] = bflo(w[q][j].y) * rstd * gg[j][2]; v[3] = bfhi(w[q][j].y) * rstd * gg[j][3];
                *(f32x4*)(orow + (j * 64 + lane) * 4) = v;
            }
        }
    }
}

template <int ph>
__device__ __forceinline__ void run_phase(const Args& a, LAS unsigned char* lds) {
    unsigned char* ws = a.ws;
    bf16_t* dob = (bf16_t*)a.out;
    bf16_t* sgp = dob; bf16_t* gap = dob + (size_t)NREAL * 1024;
#ifdef ONLY_PH
    if (ph != ONLY_PH) return;
#endif
    switch (ph) {
    case 0: phase0(a, lds); break;
    case 1: {
        pg8::Gemm g{(const bf16_t*)(ws + OFF_N1), (const bf16_t*)(ws + OFF_WIN), 1024, 1024, 1024, RPAD / 256, INW / 256, 1, 0, 0, STG};
        EpiProj E{(bf16_t*)(ws + OFF_U5), (bf16_t*)(ws + OFF_Q), (bf16_t*)(ws + OFF_K), (bf16_t*)(ws + OFF_V), sgp, gap, (bf16_t*)(ws + OFF_GB), (const LAS float*)(lds + 131072)};
        pg8::gemm_phase(lds, g, E);
        constexpr int T_FFI = 88 * 16 / 2, T_FFO = 16 * 44 / 2, FIRST = (RPAD / 256) * (INW / 256) - 27 * 256;
        const int nblk = (int)gridDim.x, first = nblk == 256 ? FIRST : 0;
        if ((int)blockIdx.x >= first) {
            __syncthreads();
            for (int r = (int)blockIdx.x - first; r < T_FFI + T_FFO; r += nblk - first) {
                if (r < T_FFI) p0_wtile(a.in[18], 1024, INW, (bf16_t*)(ws + OFF_WFFI), 3, a.in[17], r, (LAS float*)lds);
                else p0_wtile(a.in[19], DFF, 1024, (bf16_t*)(ws + OFF_WFFO), 0, nullptr, r - T_FFI, (LAS float*)lds);
            }
        }
    } break;
    case 2: {
        pg8::Gemm g{(const bf16_t*)(ws + OFF_U5), (const bf16_t*)(ws + OFF_BTS), LDA5, 512, 512, IT_PAD / 256, 1, 32, (size_t)IT_PAD * LDA5, (size_t)256 * 512, 0};
        EpiSloc E{(bf16_t*)(ws + OFF_SLOC)};
        pg8::gemm_phase(lds, g, E);
    } break;
    case 3: s5_scan(a); break;
    case 4: {
        pg8::Gemm g{(const bf16_t*)(ws + OFF_U5), (const bf16_t*)(ws + OFF_BTY), LDA5, 768, 768, IT_PAD / 256, 2, 32, (size_t)IT_PAD * LDA5, (size_t)512 * 768, 0};
        EpiY E{(bf16_t*)(ws + OFF_YSSM)};
        pg8::gemm_phase(lds, g, E);
    } break;
    case 5: {
        ret_pass_a(a, lds);
        const int bx = (int)blockIdx.x, sub = bx >= 192 ? bx - 192 : (bx >= 128 ? bx - 128 : 0);
        const int u0 = bx >= 192 ? 0 : (bx >= 128 ? GLU_SPLIT : GLU_SPLIT2), u1 = bx >= 192 ? GLU_SPLIT : GLU_SPLIT2;
        pg8::Gemm g{(const bf16_t*)(ws + OFF_YSSM), (const bf16_t*)(ws + OFF_WGLU), 512, 512, 512, NREAL / 256, 8, 1, 0, 0, STG, 64, sub, u0, u1};
        EpiGlu E{gap};
        pg8::gemm_phase(lds, g, E);
    } break;
    case 6: {
        pg8::Gemm g{(const bf16_t*)(ws + OFF_YSSM), (const bf16_t*)(ws + OFF_WGLU), 512, 512, 512, NREAL / 256, 8, 1, 0, 0, STG, (int)gridDim.x, (int)blockIdx.x, GLU_SPLIT2, 2560};
        EpiGlu E{gap};
        pg8::gemm_phase(lds, g, E);
    } break;
    case 7: ret_pass_b(a, lds); break;
    case 8: {
        pg8::Gemm g{sgp, (const bf16_t*)(ws + OFF_WRET), 1024, 1024, 1024, NREAL / 256, 4, 1, 0, 0, STG};
        EpiRet E{gap, (const bf16_t*)(ws + OFF_GB), (bf16_t*)(ws + OFF_MIXED)};
        pg8::gemm_phase(lds, g, E);
    } break;
    case 9: {
        pg8::Gemm g{(const bf16_t*)(ws + OFF_MIXED), (const bf16_t*)(ws + OFF_WOUT), 1024, 1024, 1024, NREAL / 256, 4, 1, 0, 0, STG};
        EpiRes<0> E{a.in[0], a.in[1], (bf16_t*)(ws + OFF_H1B), (float*)(ws + OFF_SSQ1)};
        pg8::gemm_phase(lds, g, E);
    } break;
    case 10: {
        pg8::Gemm g{(const bf16_t*)(ws + OFF_H1B), (const bf16_t*)(ws + OFF_WFFI), 1024, 1024, 1024, NREAL / 256, INW / 256, 1, 0, 0, STG};
        EpiFfi E{(const float*)(ws + OFF_SSQ1), (bf16_t*)(ws + OFF_ACT)};
        pg8::gemm_phase(lds, g, E);
    } break;
    case 11: {
        pg8::Gemm g{(const bf16_t*)(ws + OFF_ACT), (const bf16_t*)(ws + OFF_WFFO), DFF, DFF, DFF, NREAL / 256, 4, 1, 0, 0, STG};
        EpiRes<1> E{nullptr, nullptr, (bf16_t*)(ws + OFF_H1B), (float*)(ws + OFF_SSQ2)};
        pg8::gemm_phase(lds, g, E);
    } break;
    case 12: final_norm(a); break;
    default: break;
    }
}

#define XB_TMO      128
#define XB_XCNT(j)  (256  + 64 * (j))
#define XB_XSUB(j)  (1280 + 64 * (j))
#define XB_XGEN(j)  (2304 + 64 * (j))
#define XB_TOP      3328
#define XB_TOPGEN   3392
#define XCD_BAR_WORDS 3456
#define XB_SPIN_CAP (1u << 18)

__device__ __forceinline__ unsigned xb_ld(unsigned* p)              { return __hip_atomic_load(p, __ATOMIC_RELAXED, __HIP_MEMORY_SCOPE_AGENT); }
__device__ __forceinline__ unsigned xb_add(unsigned* p, unsigned v) { return __hip_atomic_fetch_add(p, v, __ATOMIC_RELAXED, __HIP_MEMORY_SCOPE_AGENT); }
__device__ __forceinline__ unsigned xb_xcc_id() { return (unsigned)__builtin_amdgcn_s_getreg((3 << 11) | 20) & 0xFu; }
#define XB_SPIN(cond, bar) do { unsigned _sp = 0; while (cond) { __builtin_amdgcn_s_sleep(1); \
    if ((++_sp & 255u) == 0u) { if (xb_ld(&(bar)[XB_TMO])) break; if (_sp > XB_SPIN_CAP) { atomicAdd(&(bar)[XB_TMO], 1u); break; } } } } while (0)

struct XcdBarrier {
    unsigned* bar; unsigned x;
    volatile LAS unsigned* st;
};

__device__ __forceinline__ XcdBarrier xcd_barrier_post(unsigned* bar, volatile LAS unsigned* st) {
    XcdBarrier b; b.bar = bar; b.x = xb_xcc_id(); b.st = st;
    if (threadIdx.x == 0) (void)xb_add(&bar[XB_XCNT(b.x)], 1u);
    return b;
}
__device__ __forceinline__ void xcd_barrier_complete(unsigned* bar, unsigned x, unsigned& nloc, unsigned& nx) {
    const unsigned G = gridDim.x * gridDim.y * gridDim.z;
    unsigned sum, cnt, mine, sp = 0u;
    for (;;) {
        sum = 0u; cnt = 0u; mine = 0u;
#pragma unroll
        for (unsigned j = 0; j < 16; ++j) { const unsigned c = xb_ld(&bar[XB_XCNT(j)]); sum += c; cnt += (c > 0u) ? 1u : 0u; mine = (j == x) ? c : mine; }
        if (sum == G) break;
        __builtin_amdgcn_s_sleep(1);
        if ((++sp & 255u) == 0u) { if (xb_ld(&bar[XB_TMO])) break; if (sp > XB_SPIN_CAP) { atomicAdd(&bar[XB_TMO], 1u); break; } }
    }
    nloc = mine > 0u ? mine : 1u; nx = cnt > 0u ? cnt : 1u;
}

__device__ __forceinline__ void xcd_barrier(const XcdBarrier& b) {
    asm volatile("s_waitcnt vmcnt(0)" ::: "memory");
    __syncthreads();
    if (threadIdx.x == 0) {
        unsigned* bar = b.bar;
        __builtin_amdgcn_s_waitcnt(0);
        unsigned nloc = b.st[0], nx = b.st[1];
        if (nloc == 0u) { xcd_barrier_complete(bar, b.x, nloc, nx); b.st[0] = nloc; b.st[1] = nx; }
        const unsigned old = xb_add(&bar[XB_XSUB(b.x)], 1u);
        const unsigned gen = old / nloc;
        if (old + 1u == (gen + 1u) * nloc) {
            __builtin_amdgcn_fence(__ATOMIC_RELEASE, "agent");
            asm volatile("s_waitcnt vmcnt(0)" ::: "memory");
            const unsigned og = xb_add(&bar[XB_TOP], 1u);
            const unsigned tg = og / nx;
            if (og + 1u == (tg + 1u) * nx) xb_add(&bar[XB_TOPGEN], 1u);
            else XB_SPIN(xb_ld(&bar[XB_TOPGEN]) == tg, bar);
            __builtin_amdgcn_fence(__ATOMIC_ACQUIRE, "agent");
            xb_add(&bar[XB_XGEN(b.x)], 1u);
            asm volatile("s_waitcnt vmcnt(0)" ::: "memory");
        } else {
            XB_SPIN(xb_ld(&bar[XB_XGEN(b.x)]) == gen, bar);
            __builtin_amdgcn_fence(__ATOMIC_ACQUIRE, "agent");
            asm volatile("s_waitcnt vmcnt(0)" ::: "memory");
        }
    }
    __syncthreads();
}


__device__ __forceinline__ void grid_barrier(unsigned* ctr, unsigned target) {
    asm volatile("s_waitcnt vmcnt(0) lgkmcnt(0)" ::: "memory");
    __syncthreads();
    if (threadIdx.x == 0) {
        __builtin_amdgcn_fence(__ATOMIC_RELEASE, "agent");
        asm volatile("s_waitcnt vmcnt(0)" ::: "memory");
        __hip_atomic_fetch_add(ctr, 1u, __ATOMIC_RELAXED, __HIP_MEMORY_SCOPE_AGENT);
        unsigned spins = 0;
        while (__hip_atomic_load(ctr, __ATOMIC_RELAXED, __HIP_MEMORY_SCOPE_AGENT) < target && ++spins < (1u << 24)) __builtin_amdgcn_s_sleep(2);
        __builtin_amdgcn_fence(__ATOMIC_ACQUIRE, "agent");
        asm volatile("s_waitcnt vmcnt(0)" ::: "memory");
    }
    __syncthreads();
}

template <bool COOP>
__global__ __launch_bounds__(512, 2) void fwd_kernel(Args a) {
    extern __shared__ __attribute__((aligned(16))) unsigned char shm[];
    LAS unsigned char* lds = (LAS unsigned char*)shm;
    if (threadIdx.x < 64) {
        const double rd = exp2(-(double)threadIdx.x * (13.287712379549449 / 64.0)) * 0.15915494309189535;
        const float hi = __uint_as_float(__float_as_uint((float)rd) & 0xFFFFE000u), lo = (float)(rd - (double)hi);
        ((LAS float*)(lds + 131072))[2 * threadIdx.x] = hi; ((LAS float*)(lds + 131072))[2 * threadIdx.x + 1] = lo;
    }
    volatile LAS unsigned* xst = (volatile LAS unsigned*)(lds + 131072 + 528);
    if (threadIdx.x == 0) { xst[0] = 0u; xst[1] = 0u; }
    __syncthreads();
    XcdBarrier xb{}; if (COOP) xb = xcd_barrier_post((unsigned*)(a.ws + OFF_BAR), xst);
    if (COOP && a.ph_hi > NPHASE) cg::this_grid().sync();
#define RUN_PH(P) if (a.ph_lo <= P && P < a.ph_hi) { run_phase<P>(a, lds); if ((DBL_MASK >> P) & 1) run_phase<P>(a, lds); if (COOP && P + 1 < a.ph_hi) { xcd_barrier(xb); } }
    RUN_PH(0) RUN_PH(1) RUN_PH(2) RUN_PH(3) RUN_PH(4) RUN_PH(5) RUN_PH(6) RUN_PH(7) RUN_PH(8) RUN_PH(9) RUN_PH(10) RUN_PH(11) RUN_PH(12)
#undef RUN_PH
}

extern "C" void kernel_launch(void* const* d_in, const int* in_sizes, int n_in, void* d_out, int out_size, void* d_ws, size_t ws_size, hipStream_t stream) {
    static int grid = 0;
    if (grid == 0) {
        if (n_in != 21 || ws_size < WS_NEED || out_size != NREAL * 1024) { fprintf(stderr, "kernel_launch: unexpected shapes (n_in %d, ws %zu need %zu, out %d)\n", n_in, ws_size, (size_t)WS_NEED, out_size); grid = -1; return; }
        int dev = 0, cus = 0;
        hipGetDevice(&dev); hipDeviceGetAttribute(&cus, hipDeviceAttributeMultiprocessorCount, dev);
        hipFuncSetAttribute((const void*)fwd_kernel<true>, hipFuncAttributeMaxDynamicSharedMemorySize, LDS_BYTES);
#if !COOP_MODE
        hipFuncSetAttribute((const void*)fwd_kernel<false>, hipFuncAttributeMaxDynamicSharedMemorySize, LDS_BYTES);
#endif
        int per_cu = 0;
        hipOccupancyMaxActiveBlocksPerMultiprocessor(&per_cu, (const void*)fwd_kernel<true>, 512, LDS_BYTES);
        if (per_cu < 1) { fprintf(stderr, "kernel_launch: occupancy query says %d blocks per CU\n", per_cu); per_cu = 1; }
        (void)hipGetLastError();
        grid = cus * 1;
    }
    if (grid < 0) return;
    Args a{};
    for (int i = 0; i < 21; ++i) a.in[i] = (const float*)d_in[i];
    a.out = (float*)d_out; a.ws = (unsigned char*)d_ws;
#if COOP_MODE
    hipMemsetAsync((char*)d_ws + OFF_BAR, 0, 4096 * 4 + 256, stream);
    a.ph_lo = 0; a.ph_hi = NPHASE;
    void* args[] = {&a};
    hipError_t e = hipLaunchCooperativeKernel((const void*)fwd_kernel<true>, dim3(grid), dim3(512), args, LDS_BYTES, stream);
    if (e != hipSuccess) fprintf(stderr, "cooperative launch failed: %s (grid %d)\n", hipGetErrorString(e), grid);
#else
    for (int ph = 0; ph < NPHASE; ++ph) {
        a.ph_lo = ph; a.ph_hi = ph + 1;
        hipLaunchKernelGGL(fwd_kernel<false>, dim3(grid), dim3(512), LDS_BYTES, stream, a);
    }
#endif
}
```
